# Optimizing an MI355X kernel written in HIP

```python
import math
import jax, jax.numpy as jnp
from jax import lax
import numpy as np

D_MODEL = 1024
BATCH = 4
SEQ = 8192
DEPTH = 2

HEAD_DIM = 64
D_MIX = D_MODEL
N_MIXERS = 4
N_GROUP_HEADS = D_MIX // (N_MIXERS * HEAD_DIM)
QB = 128
NEG = -1e30
TINY = 1e-30
BIG = 1e9
RMS_EPS = 1e-6

SWA_HEADS = N_GROUP_HEADS
SWA_KV_HEADS = 2
SWA_WINDOW = 128
MLA_HEADS = N_GROUP_HEADS
MLA_Q_RANK = 3 * D_MODEL // 16
MLA_KV_RANK = D_MODEL // 8
MLA_NOPE = 64
MLA_ROPE = 32
MLA_V = 64
ROPE_THETA = 10000.0
NSA_HEADS = N_GROUP_HEADS
NSA_CMP_LEN = 32
NSA_CMP_STRIDE = 16
NSA_CMP_HIDDEN = 128
NSA_SEL_BLOCK = 64
NSA_TOPN = 16
NSA_WINDOW = 512
NSA_N_BRANCH = 3
MOBA_HEADS = N_GROUP_HEADS
MOBA_BLOCK = 256
MOBA_TOPK = 3
D_FF = 4 * D_MODEL
N_ALIBI = SWA_HEADS + NSA_HEADS + MOBA_HEADS
N_ADA = 6

SWA_COLS = (SWA_HEADS + 2 * SWA_KV_HEADS) * HEAD_DIM
MLA_COLS = MLA_Q_RANK + MLA_KV_RANK + MLA_ROPE
NSA_COLS = NSA_HEADS * HEAD_DIM + 2 * NSA_N_BRANCH * HEAD_DIM + NSA_N_BRANCH * NSA_HEADS
MOBA_COLS = 3 * MOBA_HEADS * HEAD_DIM
D_IN = SWA_COLS + MLA_COLS + NSA_COLS + MOBA_COLS

kernel_name = 'hybrid_parallel_heads_swa_mla_nsa_moba'


def alibi_slopes():
    s = np.array([2.0 ** (-8.0 * (i + 1) / N_ALIBI) for i in range(N_ALIBI)], np.float32)
    return jnp.asarray(s[0::3]), jnp.asarray(s[1::3]), jnp.asarray(s[2::3])


def split_last(a, sizes):
    offs = np.cumsum([0] + list(sizes))
    return [a[..., int(offs[i]):int(offs[i + 1])] for i in range(len(sizes))]


def heads(t, n):
    B, S, W = t.shape
    return t.reshape(B, S, n, W // n).transpose(0, 2, 1, 3)


def merge_heads(t):
    B, H, S, d = t.shape
    return t.transpose(0, 2, 1, 3).reshape(B, S, H * d)


def unblock(o):
    nq, B, H, qb, d = o.shape
    return o.transpose(1, 2, 0, 3, 4).reshape(B, H, nq * qb, d)


def rmsnorm(x, g):
    xf = x.astype(jnp.float32)
    y = xf * lax.rsqrt(jnp.mean(xf * xf, axis=-1, keepdims=True) + RMS_EPS)
    return (y * g.astype(jnp.float32)).astype(x.dtype)


def rope(x, pos):
    half = x.shape[-1] // 2
    freqs = ROPE_THETA ** (-jnp.arange(half, dtype=jnp.float32) / half)
    ang = pos[:, None] * freqs[None, :]
    cos, sin = jnp.cos(ang), jnp.sin(ang)
    x1 = x[..., :half].astype(jnp.float32)
    x2 = x[..., half:].astype(jnp.float32)
    return jnp.concatenate([x1 * cos - x2 * sin, x1 * sin + x2 * cos], axis=-1).astype(x.dtype)


def masked_softmax(s, mask, sink=None):
    s = jnp.where(mask, s.astype(jnp.float32), NEG)
    m = jnp.max(s, axis=-1, keepdims=True)
    if sink is not None:
        m = jnp.maximum(m, sink)
    e = jnp.where(mask, jnp.exp(s - m), 0.0)
    den = jnp.sum(e, axis=-1, keepdims=True)
    if sink is not None:
        den = den + jnp.exp(sink - m)
    return e / jnp.maximum(den, TINY)


def banded_attention(q, k, v, window, slopes, sink=None):
    B, KVH, G, S, d = q.shape
    nq = S // QB
    nb = window // QB
    kw = (nb + 1) * QB

    def band(t):
        tb = t.reshape(B, KVH, nq, QB, d)
        tp = jnp.pad(tb, ((0, 0), (0, 0), (nb, 0), (0, 0), (0, 0)))
        return jnp.concatenate([tp[:, :, i:i + nq] for i in range(nb + 1)], axis=3)

    kb, vb = band(k), band(v)
    qb = q.reshape(B, KVH, G, nq, QB, d)
    s = jnp.einsum('bkgnqd,bknsd->bkgnqs', qb, kb) * (d ** -0.5)
    dist = nb * QB + jnp.arange(QB)[:, None] - jnp.arange(kw)[None, :]
    key_pos = (jnp.arange(nq)[:, None] - nb) * QB + jnp.arange(kw)[None, :]
    mask = ((dist >= 0) & (dist < window))[None, :, :] & (key_pos >= 0)[:, None, :]
    bias = -slopes.astype(jnp.float32)[:, :, None, None, None] * dist
    sink_b = None if sink is None else sink.astype(jnp.float32)[None, :, :, None, None, None]
    p = masked_softmax(s.astype(jnp.float32) + bias, mask, sink_b).astype(v.dtype)
    o = jnp.einsum('bkgnqs,bknsd->bkgnqd', p, vb)
    return o.reshape(B, KVH * G, S, d)


def causal_attention_blocks(q, k, v, scale):
    B, H, S, dq = q.shape
    nq = S // QB
    qb = q.reshape(B, H, nq, QB, dq).transpose(2, 0, 1, 3, 4)
    kpos = jnp.arange(S)

    def one(args):
        qi, n = args
        tq = n * QB + jnp.arange(QB)
        s = jnp.einsum('bhqd,bhsd->bhqs', qi, k) * scale
        p = masked_softmax(s, kpos[None, :] <= tq[:, None]).astype(v.dtype)
        return jnp.einsum('bhqs,bhsd->bhqd', p, v)

    return unblock(lax.map(one, (qb, jnp.arange(nq))))


def swa_mixer(z, sinks, slopes):
    G = SWA_HEADS // SWA_KV_HEADS
    q, k, v = split_last(z, [SWA_HEADS * HEAD_DIM, SWA_KV_HEADS * HEAD_DIM, SWA_KV_HEADS * HEAD_DIM])
    q = heads(q, SWA_HEADS)
    B, _, S, d = q.shape
    q = q.reshape(B, SWA_KV_HEADS, G, S, d)
    o = banded_attention(q, heads(k, SWA_KV_HEADS), heads(v, SWA_KV_HEADS), SWA_WINDOW,
                         slopes.reshape(SWA_KV_HEADS, G), sinks.reshape(SWA_KV_HEADS, G))
    return merge_heads(o)


def mla_mixer(z, q_norm_g, kv_norm_g, w_uq, w_ukv):
    cq, ckv, k_pe = split_last(z, [MLA_Q_RANK, MLA_KV_RANK, MLA_ROPE])
    B, S, _ = z.shape
    pos = jnp.arange(S, dtype=jnp.float32)
    q = heads(rmsnorm(cq, q_norm_g) @ w_uq, MLA_HEADS)
    kv = heads(rmsnorm(ckv, kv_norm_g) @ w_ukv, MLA_HEADS)
    q = jnp.concatenate([q[..., :MLA_NOPE], rope(q[..., MLA_NOPE:], pos)], axis=-1)
    k_pe = jnp.broadcast_to(rope(k_pe, pos)[:, None], (B, MLA_HEADS, S, MLA_ROPE))
    k = jnp.concatenate([kv[..., :MLA_NOPE], k_pe], axis=-1)
    v = kv[..., MLA_NOPE:]
    o = causal_attention_blocks(q, k, v, (MLA_NOPE + MLA_ROPE) ** -0.5)
    return merge_heads(o)


def nsa_mixer(z, slopes, pos_k, pos_v, ck_w1, ck_w2, cv_w1, cv_w2):
    d, H = HEAD_DIM, NSA_HEADS
    q, kc, vc, ks, vs, kw, vw, gl = split_last(z, [H * d, d, d, d, d, d, d, NSA_N_BRANCH * H])
    B, S, _ = z.shape
    q = heads(q, H)
    scale = d ** -0.5
    ratio = NSA_CMP_LEN // NSA_CMP_STRIDE
    n_cmp = S // NSA_CMP_STRIDE - ratio + 1

    def compress(t, pos_emb, w1, w2):
        ch = t.reshape(B, S // NSA_CMP_STRIDE, NSA_CMP_STRIDE, d)
        blk = jnp.concatenate([ch[:, i:i + n_cmp] for i in range(ratio)], axis=2) + pos_emb
        return jax.nn.gelu(blk.reshape(B, n_cmp, NSA_CMP_LEN * d) @ w1) @ w2

    k_cmp = compress(kc, pos_k, ck_w1, ck_w2)
    v_cmp = compress(vc, pos_v, cv_w1, cv_w2)
    cmp_end = jnp.arange(n_cmp) * NSA_CMP_STRIDE + NSA_CMP_LEN - 1
    n_sel = S // NSA_SEL_BLOCK
    topn = min(NSA_TOPN, n_sel)
    sel_ratio = NSA_SEL_BLOCK // NSA_CMP_STRIDE
    n_off = sel_ratio + ratio - 1
    k_sel = ks.reshape(B, n_sel, NSA_SEL_BLOCK, d)
    v_sel = vs.reshape(B, n_sel, NSA_SEL_BLOCK, d)
    nq = S // QB
    qb = q.reshape(B, H, nq, QB, d).transpose(2, 0, 1, 3, 4)
    m = slopes.astype(jnp.float32)[None, :, None, None]
    blk_ids = jnp.arange(n_sel)
    bi = jnp.arange(B)[:, None, None]
    nk = topn * NSA_SEL_BLOCK

    def one(args):
        qi, n = args
        tq = n * QB + jnp.arange(QB)
        dist_c = tq[:, None] - cmp_end[None, :]
        s_c = jnp.einsum('bhqd,bcd->bhqc', qi, k_cmp) * scale
        p_c = masked_softmax(s_c.astype(jnp.float32) - m * dist_c, dist_c >= 0)
        o_c = jnp.einsum('bhqc,bcd->bhqd', p_c.astype(v_cmp.dtype), v_cmp)
        pp = jnp.pad(p_c.sum(axis=1), ((0, 0), (0, 0), (ratio - 1, sel_ratio)))
        imp = sum(pp[..., o::sel_ratio][..., :n_sel] for o in range(n_off))
        cur = tq // NSA_SEL_BLOCK
        cand = blk_ids[None, :] <= cur[:, None]
        forced = (blk_ids[None, :] == 0) | (blk_ids[None, :] == cur[:, None]) | (blk_ids[None, :] == cur[:, None] - 1)
        imp = jnp.where(cand, jnp.where(forced, BIG, imp), NEG)
        _, idx = lax.top_k(imp, topn)
        valid = jnp.take_along_axis(jnp.broadcast_to(cand, imp.shape), idx, axis=-1)
        kg = k_sel[bi, idx].reshape(B, QB, nk, d)
        vg = v_sel[bi, idx].reshape(B, QB, nk, d)
        key_pos = (idx[..., None] * NSA_SEL_BLOCK + jnp.arange(NSA_SEL_BLOCK)).reshape(B, QB, nk)
        dist_s = tq[None, :, None] - key_pos
        mask_s = (jnp.repeat(valid, NSA_SEL_BLOCK, axis=-1) & (dist_s >= 0))[:, None]
        s_s = jnp.einsum('bhqd,bqkd->bhqk', qi, kg) * scale
        p_s = masked_softmax(s_s.astype(jnp.float32) - m * dist_s[:, None], mask_s)
        o_s = jnp.einsum('bhqk,bqkd->bhqd', p_s.astype(vg.dtype), vg)
        return o_c, o_s

    o_c, o_s = lax.map(one, (qb, jnp.arange(nq)))
    o_c, o_s = unblock(o_c), unblock(o_s)
    o_w = banded_attention(q[:, None], heads(kw, 1), heads(vw, 1), NSA_WINDOW, slopes[None, :], None)
    g = jax.nn.sigmoid(gl.astype(jnp.float32)).reshape(B, S, NSA_N_BRANCH, H).transpose(0, 3, 1, 2).astype(q.dtype)
    o = g[..., 0:1] * o_c + g[..., 1:2] * o_s + g[..., 2:3] * o_w
    return merge_heads(o)


def moba_mixer(z, slopes):
    d, H = HEAD_DIM, MOBA_HEADS
    q, k, v = [heads(t, H) for t in split_last(z, [H * d] * 3)]
    B, _, S, _ = q.shape
    scale = d ** -0.5
    n_blk = -(-S // MOBA_BLOCK)
    pad = n_blk * MOBA_BLOCK - S
    kp = jnp.pad(k, ((0, 0), (0, 0), (0, pad), (0, 0)))
    vp = jnp.pad(v, ((0, 0), (0, 0), (0, pad), (0, 0)))
    k_blk = kp.reshape(B, H, n_blk, MOBA_BLOCK, d)
    v_blk = vp.reshape(B, H, n_blk, MOBA_BLOCK, d)
    k_mean = jnp.mean(k_blk, axis=3)
    topk = min(MOBA_TOPK, n_blk)
    nq = S // QB
    qb = q.reshape(B, H, nq, QB, d).transpose(2, 0, 1, 3, 4)
    m = slopes.astype(jnp.float32)[None, :, None, None]
    bi = jnp.arange(B)[:, None, None, None]
    hi = jnp.arange(H)[None, :, None, None]
    blk_ids = jnp.arange(n_blk)
    ng = topk * MOBA_BLOCK

    def one(args):
        qi, n = args
        tq = n * QB + jnp.arange(QB)
        cur = (n * QB) // MOBA_BLOCK
        gate = jnp.einsum('bhqd,bhjd->bhqj', qi, k_mean).astype(jnp.float32)
        gate = jnp.where(blk_ids < cur, gate, NEG)
        _, idx = lax.top_k(gate, topk)
        valid = idx < cur
        kg = k_blk[bi, hi, idx].reshape(B, H, QB, ng, d)
        vg = v_blk[bi, hi, idx].reshape(B, H, QB, ng, d)
        key_pos = (idx[..., None] * MOBA_BLOCK + jnp.arange(MOBA_BLOCK)).reshape(B, H, QB, ng)
        s_g = jnp.einsum('bhqd,bhqkd->bhqk', qi, kg) * scale - m * (tq[:, None] - key_pos)
        mask_g = jnp.repeat(valid, MOBA_BLOCK, axis=-1)
        start = cur * MOBA_BLOCK
        k_own = lax.dynamic_slice_in_dim(kp, start, MOBA_BLOCK, axis=2)
        v_own = lax.dynamic_slice_in_dim(vp, start, MOBA_BLOCK, axis=2)
        dist_own = tq[:, None] - (start + jnp.arange(MOBA_BLOCK))[None, :]
        s_o = jnp.einsum('bhqd,bhsd->bhqs', qi, k_own) * scale - m * dist_own
        mask_o = jnp.broadcast_to(dist_own >= 0, s_o.shape)
        p = masked_softmax(jnp.concatenate([s_g, s_o], axis=-1),
                           jnp.concatenate([mask_g, mask_o], axis=-1)).astype(v.dtype)
        return (jnp.einsum('bhqk,bhqkd->bhqd', p[..., :ng], vg)
                + jnp.einsum('bhqs,bhsd->bhqd', p[..., ng:], v_own))

    return merge_heads(unblock(lax.map(one, (qb, jnp.arange(nq)))))


def setup_inputs(seed: int = 0) -> dict:
    key = jax.random.key(seed)
    ks = jax.random.split(key, 24)
    f32 = jnp.float32

    def nrm(k, shape, s):
        return jax.random.normal(k, shape, f32) * s

    return {
        'x': nrm(ks[0], (BATCH, SEQ, D_MODEL), 1.0),
        'c': nrm(ks[1], (BATCH, D_MODEL), 1.0),
        'norm_mix_g': 1.0 + nrm(ks[2], (DEPTH, D_MODEL), 0.02),
        'norm_mlp_g': 1.0 + nrm(ks[3], (DEPTH, D_MODEL), 0.02),
        'w_ada': nrm(ks[4], (DEPTH, D_MODEL, N_ADA * D_MODEL), 0.5 * D_MODEL ** -0.5),
        'b_ada': nrm(ks[5], (DEPTH, N_ADA * D_MODEL), 0.01),
        'w_in': nrm(ks[6], (DEPTH, D_MODEL, D_IN), D_MODEL ** -0.5),
        'w_out': nrm(ks[7], (DEPTH, D_MIX, D_MODEL), D_MIX ** -0.5),
        'swa_sinks': nrm(ks[8], (DEPTH, SWA_HEADS), 1.0),
        'mla_q_norm_g': 1.0 + nrm(ks[9], (DEPTH, MLA_Q_RANK), 0.02),
        'mla_kv_norm_g': 1.0 + nrm(ks[10], (DEPTH, MLA_KV_RANK), 0.02),
        'mla_w_uq': nrm(ks[11], (DEPTH, MLA_Q_RANK, MLA_HEADS * (MLA_NOPE + MLA_ROPE)), MLA_Q_RANK ** -0.5),
        'mla_w_ukv': nrm(ks[12], (DEPTH, MLA_KV_RANK, MLA_HEADS * (MLA_NOPE + MLA_V)), MLA_KV_RANK ** -0.5),
        'nsa_cmp_pos_k': nrm(ks[13], (DEPTH, NSA_CMP_LEN, HEAD_DIM), 0.02),
        'nsa_cmp_pos_v': nrm(ks[14], (DEPTH, NSA_CMP_LEN, HEAD_DIM), 0.02),
        'nsa_cmp_k_w1': nrm(ks[15], (DEPTH, NSA_CMP_LEN * HEAD_DIM, NSA_CMP_HIDDEN), (NSA_CMP_LEN * HEAD_DIM) ** -0.5),
        'nsa_cmp_k_w2': nrm(ks[16], (DEPTH, NSA_CMP_HIDDEN, HEAD_DIM), NSA_CMP_HIDDEN ** -0.5),
        'nsa_cmp_v_w1': nrm(ks[17], (DEPTH, NSA_CMP_LEN * HEAD_DIM, NSA_CMP_HIDDEN), (NSA_CMP_LEN * HEAD_DIM) ** -0.5),
        'nsa_cmp_v_w2': nrm(ks[18], (DEPTH, NSA_CMP_HIDDEN, HEAD_DIM), NSA_CMP_HIDDEN ** -0.5),
        'w_up': nrm(ks[19], (DEPTH, D_MODEL, D_FF), D_MODEL ** -0.5),
        'w_down': nrm(ks[20], (DEPTH, D_FF, D_MODEL), D_FF ** -0.5),
        'final_norm_g': 1.0 + nrm(ks[21], (D_MODEL,), 0.02),
    }


def reference(x, c, norm_mix_g, norm_mlp_g, w_ada, b_ada, w_in, w_out, swa_sinks,
              mla_q_norm_g, mla_kv_norm_g, mla_w_uq, mla_w_ukv,
              nsa_cmp_pos_k, nsa_cmp_pos_v, nsa_cmp_k_w1, nsa_cmp_k_w2, nsa_cmp_v_w1, nsa_cmp_v_w2,
              w_up, w_down, final_norm_g):
    slopes_a, slopes_c, slopes_d = alibi_slopes()
    c_act = jax.nn.silu(c)
    for l in range(DEPTH):
        mod = c_act @ w_ada[l] + b_ada[l]
        sh1, sc1, g1, sh2, sc2, g2 = [t[:, None, :] for t in jnp.split(mod, N_ADA, axis=-1)]
        h = rmsnorm(x, norm_mix_g[l]) * (1.0 + sc1) + sh1
        z = h @ w_in[l]
        za, zb, zc, zd = split_last(z, [SWA_COLS, MLA_COLS, NSA_COLS, MOBA_COLS])
        o = jnp.concatenate([
            swa_mixer(za, swa_sinks[l], slopes_a),
            mla_mixer(zb, mla_q_norm_g[l], mla_kv_norm_g[l], mla_w_uq[l], mla_w_ukv[l]),
            nsa_mixer(zc, slopes_c, nsa_cmp_pos_k[l], nsa_cmp_pos_v[l],
                      nsa_cmp_k_w1[l], nsa_cmp_k_w2[l], nsa_cmp_v_w1[l], nsa_cmp_v_w2[l]),
            moba_mixer(zd, slopes_d),
        ], axis=-1)
        x = x + g1 * (o @ w_out[l])
        h = rmsnorm(x, norm_mlp_g[l]) * (1.0 + sc2) + sh2
        x = x + g2 * (jnp.square(jax.nn.relu(h @ w_up[l])) @ w_down[l])
    return rmsnorm(x, final_norm_g)
```

```cpp
#include <hip/hip_runtime.h>
#include <math.h>
#include <stdint.h>

namespace nv {
constexpr int D = 1024, NB = 4, T = 8192, DEPTH = 2, DIN = 2284, DFF = 4096;
constexpr int ZA = 0, ZB = 512, ZC = 864, ZD = 1516;
constexpr int NCMP = 511;
constexpr float NEGF = -1e30f, TINYF = 1e-30f, EPS = 1e-6f;

__device__ __forceinline__ float slope_of(int i) { return exp2f(-8.0f * (float)(i + 1) / 12.0f); }

__global__ void k_mod(const float* c, const float* w_ada, const float* b_ada, float* mod) {
    int idx = blockIdx.x * 256 + threadIdx.x;
    if (idx >= DEPTH * NB * 6 * D) return;
    int j = idx % (6 * D), b = (idx / (6 * D)) % NB, l = idx / (6 * D * NB);
    float acc = b_ada[l * 6 * D + j];
    const float* w = w_ada + (size_t)l * D * 6 * D + j;
    for (int k = 0; k < D; ++k) { float cv = c[b * D + k]; float s = cv / (1.f + expf(-cv)); acc += s * w[(size_t)k * 6 * D]; }
    mod[idx] = acc;
}

__device__ __forceinline__ float block_sum256(float v, float* red) {
    for (int o = 32; o > 0; o >>= 1) v += __shfl_xor(v, o);
    __syncthreads();
    if ((threadIdx.x & 63) == 0) red[threadIdx.x >> 6] = v;
    __syncthreads();
    return red[0] + red[1] + red[2] + red[3];
}

__global__ void k_norm(const float* x, const float* g, const float* sc, const float* sh, float* h) {
    __shared__ float red[4];
    int t = blockIdx.x;
    const float* xr = x + (size_t)t * D;
    float v[4]; float s = 0.f;
#pragma unroll
    for (int i = 0; i < 4; ++i) { v[i] = xr[threadIdx.x + 256 * i]; s += v[i] * v[i]; }
    s = block_sum256(s, red);
    float r = rsqrtf(s / D + EPS);
#pragma unroll
    for (int i = 0; i < 4; ++i) { int j = threadIdx.x + 256 * i; float y = v[i] * r * g[j]; if (sc) y = y * (1.f + sc[j]) + sh[j]; h[(size_t)t * D + j] = y; }
}

template <int EP>
__global__ void __launch_bounds__(256) k_sgemm(const float* __restrict__ A, int lda, const float* __restrict__ W, int ldw, float* C, int ldc, int M, int N, int K, const float* gate) {
    __shared__ float As[16][68];
    __shared__ float Ws[16][68];
    const int tx = threadIdx.x % 16, ty = threadIdx.x / 16;
    const int m0 = blockIdx.y * 64, n0 = blockIdx.x * 64;
    float acc[4][4];
#pragma unroll
    for (int i = 0; i < 4; ++i)
#pragma unroll
        for (int j = 0; j < 4; ++j) acc[i][j] = 0.f;
    for (int k0 = 0; k0 < K; k0 += 16) {
        { int r = threadIdx.x / 4, kq = (threadIdx.x % 4) * 4; float4 v = *(const float4*)(A + (size_t)(m0 + r) * lda + k0 + kq);
          As[kq + 0][r] = v.x; As[kq + 1][r] = v.y; As[kq + 2][r] = v.z; As[kq + 3][r] = v.w; }
        { int k = threadIdx.x / 16, nq = (threadIdx.x % 16) * 4;
#pragma unroll
          for (int j = 0; j < 4; ++j) { int n = n0 + nq + j; Ws[k][nq + j] = n < N ? W[(size_t)(k0 + k) * ldw + n] : 0.f; } }
        __syncthreads();
#pragma unroll
        for (int kk = 0; kk < 16; ++kk) {
            float a[4], b[4];
#pragma unroll
            for (int i = 0; i < 4; ++i) { a[i] = As[kk][ty * 4 + i]; b[i] = Ws[kk][tx * 4 + i]; }
#pragma unroll
            for (int i = 0; i < 4; ++i)
#pragma unroll
                for (int j = 0; j < 4; ++j) acc[i][j] += a[i] * b[j];
        }
        __syncthreads();
    }
#pragma unroll
    for (int i = 0; i < 4; ++i)
#pragma unroll
        for (int j = 0; j < 4; ++j) {
            int m = m0 + ty * 4 + i, n = n0 + tx * 4 + j;
            if (n < N) {
                float* p = C + (size_t)m * ldc + n;
                if (EP == 0) *p = acc[i][j];
                else if (EP == 1) *p = *p + gate[n] * acc[i][j];
                else { float r = fmaxf(acc[i][j], 0.f); *p = r * r; }
            }
        }
}

struct OS {
    float m, l, o[64];
    __device__ __forceinline__ void init() { m = NEGF; l = 0.f;
#pragma unroll
        for (int d = 0; d < 64; ++d) o[d] = 0.f; }
    __device__ __forceinline__ void upd(float s, const float* vrow) {
        if (s > m) { float sc = expf(m - s); l *= sc;
#pragma unroll
            for (int d = 0; d < 64; ++d) o[d] *= sc;
            m = s; }
        float p = expf(s - m); l += p;
#pragma unroll
        for (int d4 = 0; d4 < 16; ++d4) { float4 v = ((const float4*)vrow)[d4]; o[4 * d4] += p * v.x; o[4 * d4 + 1] += p * v.y; o[4 * d4 + 2] += p * v.z; o[4 * d4 + 3] += p * v.w; }
    }
    __device__ __forceinline__ void store(float* out) {
        float inv = 1.f / fmaxf(l, TINYF);
#pragma unroll
        for (int d = 0; d < 64; ++d) out[d] = o[d] * inv;
    }
};
__device__ __forceinline__ float dot64(const float* q, const float* krow) {
    float s = 0.f;
#pragma unroll
    for (int d4 = 0; d4 < 16; ++d4) { float4 v = ((const float4*)krow)[d4]; s += q[4 * d4] * v.x + q[4 * d4 + 1] * v.y + q[4 * d4 + 2] * v.z + q[4 * d4 + 3] * v.w; }
    return s;
}
__device__ __forceinline__ void load64(float* q, const float* src) {
#pragma unroll
    for (int d4 = 0; d4 < 16; ++d4) { float4 v = ((const float4*)src)[d4]; q[4 * d4] = v.x; q[4 * d4 + 1] = v.y; q[4 * d4 + 2] = v.z; q[4 * d4 + 3] = v.w; }
}

__global__ void __launch_bounds__(256) k_banded(const float* z, int qoff, int koff, int voff, int gshift, int window, int slope_base, const float* sinks, float* out, int ostride, int ooff) {
    int idx = blockIdx.x * 256 + threadIdx.x; int t = idx >> 2, h = idx & 3;
    float q[64]; load64(q, z + (size_t)t * DIN + qoff + h * 64);
    const int kvh = h >> gshift;
    const float slope = slope_of(slope_base + 3 * h);
    OS st; st.init();
    int s0 = t - window + 1; if (s0 < 0) s0 = 0;
    for (int s = s0; s <= t; ++s) {
        float sc = dot64(q, z + (size_t)s * DIN + koff + kvh * 64) * 0.125f - slope * (float)(t - s);
        st.upd(sc, z + (size_t)s * DIN + voff + kvh * 64);
    }
    if (sinks) { float sk = sinks[h]; float mf = fmaxf(st.m, sk); float a = expf(st.m - mf); st.l = st.l * a + expf(sk - mf);
#pragma unroll
        for (int d = 0; d < 64; ++d) st.o[d] *= a; }
    st.store(out + (size_t)t * ostride + ooff + h * 64);
}

__global__ void k_mla_prep(const float* z, const float* gq, const float* gkv, float* cqn, float* ckvn, float* kper) {
    int t = blockIdx.x, l = threadIdx.x;
    const float* zr = z + (size_t)t * DIN + ZB;
    float a0 = zr[l], a1 = zr[64 + l], a2 = zr[128 + l];
    float s = a0 * a0 + a1 * a1 + a2 * a2;
    for (int o = 32; o > 0; o >>= 1) s += __shfl_xor(s, o);
    float r = rsqrtf(s / 192.f + EPS);
    cqn[(size_t)t * 192 + l] = a0 * r * gq[l]; cqn[(size_t)t * 192 + 64 + l] = a1 * r * gq[64 + l]; cqn[(size_t)t * 192 + 128 + l] = a2 * r * gq[128 + l];
    float b0 = zr[192 + l], b1 = zr[256 + l];
    float s2 = b0 * b0 + b1 * b1;
    for (int o = 32; o > 0; o >>= 1) s2 += __shfl_xor(s2, o);
    float r2 = rsqrtf(s2 / 128.f + EPS);
    ckvn[(size_t)t * 128 + l] = b0 * r2 * gkv[l]; ckvn[(size_t)t * 128 + 64 + l] = b1 * r2 * gkv[64 + l];
    if (l < 16) {
        float freq = powf(10000.f, -(float)l / 16.f); float ang = (float)t * freq; float cs = cosf(ang), sn = sinf(ang);
        float x1 = zr[320 + l], x2 = zr[336 + l];
        kper[(size_t)t * 32 + l] = x1 * cs - x2 * sn; kper[(size_t)t * 32 + 16 + l] = x1 * sn + x2 * cs;
    }
}
__global__ void k_rope_q(float* qm) {
    int idx = blockIdx.x * 256 + threadIdx.x; int i = idx & 15, h = (idx >> 4) & 3, t = idx >> 6;
    float freq = powf(10000.f, -(float)i / 16.f); float ang = (float)t * freq; float cs = cosf(ang), sn = sinf(ang);
    float* p = qm + (size_t)t * 384 + h * 96 + 64;
    float x1 = p[i], x2 = p[16 + i];
    p[i] = x1 * cs - x2 * sn; p[16 + i] = x1 * sn + x2 * cs;
}
__global__ void __launch_bounds__(256) k_mla_attn(const float* qm, const float* kvm, const float* kper, float* out) {
    int idx = blockIdx.x * 256 + threadIdx.x; int t = idx >> 2, h = idx & 3;
    float q[64], qr[32];
    load64(q, qm + (size_t)t * 384 + h * 96);
#pragma unroll
    for (int d4 = 0; d4 < 8; ++d4) { float4 v = ((const float4*)(qm + (size_t)t * 384 + h * 96 + 64))[d4]; qr[4 * d4] = v.x; qr[4 * d4 + 1] = v.y; qr[4 * d4 + 2] = v.z; qr[4 * d4 + 3] = v.w; }
    const float scale = 0.10206207261596577f;
    OS st; st.init();
    for (int s = 0; s <= t; ++s) {
        float sc = dot64(q, kvm + (size_t)s * 512 + h * 128);
#pragma unroll
        for (int d4 = 0; d4 < 8; ++d4) { float4 v = ((const float4*)(kper + (size_t)s * 32))[d4]; sc += qr[4 * d4] * v.x + qr[4 * d4 + 1] * v.y + qr[4 * d4 + 2] * v.z + qr[4 * d4 + 3] * v.w; }
        st.upd(sc * scale, kvm + (size_t)s * 512 + h * 128 + 64);
    }
    st.store(out + (size_t)t * D + 256 + h * 64);
}

__device__ __forceinline__ float gelu_tanh(float x) { return 0.5f * x * (1.f + tanhf(0.7978845608028654f * (x + 0.044715f * x * x * x))); }
__global__ void k_nsa_hidden(const float* z, int coff, const float* pos, const float* w1, float* hid) {
    int idx = blockIdx.x * 128 + threadIdx.x; int j = idx & 127, i = idx >> 7;
    if (i >= NCMP) return;
    float acc = 0.f;
    for (int tt = 0; tt < 32; ++tt) {
        const float* zr = z + (size_t)(16 * i + tt) * DIN + coff;
        for (int d = 0; d < 64; ++d) acc += (zr[d] + pos[tt * 64 + d]) * w1[(size_t)(tt * 64 + d) * 128 + j];
    }
    hid[i * 128 + j] = gelu_tanh(acc);
}
__global__ void k_nsa_cmp2(const float* hid, const float* w2, float* outc) {
    int idx = blockIdx.x * 64 + threadIdx.x; int d = idx & 63, i = idx >> 6;
    if (i >= NCMP) return;
    float acc = 0.f;
    for (int j = 0; j < 128; ++j) acc += hid[i * 128 + j] * w2[j * 64 + d];
    outc[i * 64 + d] = acc;
}
__global__ void __launch_bounds__(256) k_nsa_cmp_attn(const float* z, const float* kcmp, const float* vcmp, float* pc, float* oc) {
    int idx = blockIdx.x * 256 + threadIdx.x; int h = idx / T, t = idx % T;
    float q[64]; load64(q, z + (size_t)t * DIN + ZC + h * 64);
    const float slope = slope_of(1 + 3 * h);
    int nc = (t >= 31) ? ((t - 31) / 16 + 1) : 0; if (nc > NCMP) nc = NCMP;
    float* pcol = pc + (size_t)h * 512 * T + t;
    float m = NEGF;
    for (int c = 0; c < nc; ++c) { float s = dot64(q, kcmp + c * 64) * 0.125f - slope * (float)(t - (16 * c + 31)); pcol[(size_t)c * T] = s; m = fmaxf(m, s); }
    float den = 0.f;
    for (int c = 0; c < nc; ++c) { float e = expf(pcol[(size_t)c * T] - m); pcol[(size_t)c * T] = e; den += e; }
    float inv = 1.f / fmaxf(den, TINYF);
    float o[64];
#pragma unroll
    for (int d = 0; d < 64; ++d) o[d] = 0.f;
    for (int c = 0; c < nc; ++c) { float p = pcol[(size_t)c * T] * inv; pcol[(size_t)c * T] = p;
#pragma unroll
        for (int d = 0; d < 64; ++d) o[d] += p * vcmp[c * 64 + d]; }
    for (int c = nc; c < 512; ++c) pcol[(size_t)c * T] = 0.f;
#pragma unroll
    for (int d = 0; d < 64; ++d) oc[(size_t)t * 256 + h * 64 + d] = o[d];
}
__global__ void k_nsa_select(const float* pc, int* idxo) {
    __shared__ float imp[64][129];
    int t = blockIdx.x * 64 + threadIdx.x; int cur = t >> 6; int tid = threadIdx.x;
    for (int j = 0; j < 128; ++j) {
        float v = 0.f;
        for (int o = 0; o < 5; ++o) { int c = 4 * j + o - 1; if (c >= 0 && c < NCMP) { float ps = 0.f; for (int h = 0; h < 4; ++h) ps += pc[((size_t)h * 512 + c) * T + t]; v += ps; } }
        bool cand = j <= cur; bool forced = (j == 0) || (j == cur) || (j == cur - 1);
        imp[tid][j] = cand ? (forced ? 1e9f : v) : NEGF;
    }
    for (int k = 0; k < 16; ++k) {
        float best = -INFINITY; int bi = 0;
        for (int j = 0; j < 128; ++j) { float v = imp[tid][j]; if (v > best) { best = v; bi = j; } }
        imp[tid][bi] = -INFINITY;
        idxo[t * 16 + k] = (bi <= cur) ? bi : -1;
    }
}
__global__ void __launch_bounds__(256) k_nsa_sel_attn(const float* z, const int* idxs, float* os) {
    int idx = blockIdx.x * 256 + threadIdx.x; int t = idx >> 2, h = idx & 3;
    float q[64]; load64(q, z + (size_t)t * DIN + ZC + h * 64);
    const float slope = slope_of(1 + 3 * h);
    OS st; st.init();
    for (int k = 0; k < 16; ++k) {
        int j = idxs[t * 16 + k]; if (j < 0) continue;
        for (int kk = 0; kk < 64; ++kk) { int p = j * 64 + kk; if (p > t) break;
            float sc = dot64(q, z + (size_t)p * DIN + ZC + 384) * 0.125f - slope * (float)(t - p);
            st.upd(sc, z + (size_t)p * DIN + ZC + 448); }
    }
    st.store(os + (size_t)t * 256 + h * 64);
}
__global__ void k_nsa_combine(const float* z, const float* oc, const float* os, const float* ow, float* out) {
    int idx = blockIdx.x * 256 + threadIdx.x; int d = idx & 63, h = (idx >> 6) & 3, t = idx >> 8;
    const float* gl = z + (size_t)t * DIN + ZC + 640;
    float g0 = 1.f / (1.f + expf(-gl[h])), g1 = 1.f / (1.f + expf(-gl[4 + h])), g2 = 1.f / (1.f + expf(-gl[8 + h]));
    size_t i = (size_t)t * 256 + h * 64 + d;
    out[(size_t)t * D + 512 + h * 64 + d] = g0 * oc[i] + g1 * os[i] + g2 * ow[i];
}
__global__ void k_moba_kmean(const float* z, float* km) {
    int idx = blockIdx.x * 256 + threadIdx.x; int d = idx & 63, j = (idx >> 6) & 31, h = idx >> 11;
    float s = 0.f;
    for (int i = 0; i < 256; ++i) s += z[(size_t)(j * 256 + i) * DIN + ZD + 256 + h * 64 + d];
    km[idx] = s * (1.f / 256.f);
}
__global__ void __launch_bounds__(256) k_moba_attn(const float* z, const float* km, float* out) {
    int idx = blockIdx.x * 256 + threadIdx.x; int t = idx >> 2, h = idx & 3;
    float q[64]; load64(q, z + (size_t)t * DIN + ZD + h * 64);
    const float slope = slope_of(2 + 3 * h);
    const int cur = t >> 8;
    float v0 = -INFINITY, v1 = -INFINITY, v2 = -INFINITY; int i0 = -1, i1 = -1, i2 = -1;
    for (int j = 0; j < cur; ++j) {
        float g = dot64(q, km + (h * 32 + j) * 64);
        if (g > v0) { v2 = v1; i2 = i1; v1 = v0; i1 = i0; v0 = g; i0 = j; }
        else if (g > v1) { v2 = v1; i2 = i1; v1 = g; i1 = j; }
        else if (g > v2) { v2 = g; i2 = j; }
    }
    OS st; st.init();
    for (int k = 0; k < 4; ++k) {
        int j = (k == 0) ? i0 : (k == 1) ? i1 : (k == 2) ? i2 : cur;
        if (j < 0) continue;
        for (int kk = 0; kk < 256; ++kk) { int p = j * 256 + kk; if (p > t) break;
            float sc = dot64(q, z + (size_t)p * DIN + ZD + 256 + h * 64) * 0.125f - slope * (float)(t - p);
            st.upd(sc, z + (size_t)p * DIN + ZD + 512 + h * 64); }
    }
    st.store(out + (size_t)t * D + 768 + h * 64);
}
}

extern "C" void kernel_launch(void* const* d_in, const int* in_sizes, int n_in, void* d_out, int out_size, void* d_ws, size_t ws_size, hipStream_t stream) {
    using namespace nv;
    const float* x = (const float*)d_in[0]; const float* c = (const float*)d_in[1];
    const float* norm_mix_g = (const float*)d_in[2]; const float* norm_mlp_g = (const float*)d_in[3];
    const float* w_ada = (const float*)d_in[4]; const float* b_ada = (const float*)d_in[5];
    const float* w_in = (const float*)d_in[6]; const float* w_out = (const float*)d_in[7];
    const float* swa_sinks = (const float*)d_in[8]; const float* mla_qg = (const float*)d_in[9]; const float* mla_kvg = (const float*)d_in[10];
    const float* mla_w_uq = (const float*)d_in[11]; const float* mla_w_ukv = (const float*)d_in[12];
    const float* pos_k = (const float*)d_in[13]; const float* pos_v = (const float*)d_in[14];
    const float* ck_w1 = (const float*)d_in[15]; const float* ck_w2 = (const float*)d_in[16];
    const float* cv_w1 = (const float*)d_in[17]; const float* cv_w2 = (const float*)d_in[18];
    const float* w_up = (const float*)d_in[19]; const float* w_down = (const float*)d_in[20]; const float* final_g = (const float*)d_in[21];
    float* X = (float*)d_out;
    char* ws = (char*)d_ws; size_t off = 0;
    auto alloc = [&](size_t bytes) { char* p = ws + off; off += (bytes + 255) & ~(size_t)255; return (float*)p; };
    float* mod = alloc((size_t)DEPTH * NB * 6 * D * 4);
    float* h = alloc((size_t)T * D * 4);
    float* z = alloc((size_t)T * DIN * 4);
    float* cqn = alloc((size_t)T * 192 * 4); float* ckvn = alloc((size_t)T * 128 * 4); float* kper = alloc((size_t)T * 32 * 4);
    float* qm = alloc((size_t)T * 384 * 4); float* kvm = alloc((size_t)T * 512 * 4);
    float* hidk = alloc(512 * 128 * 4); float* hidv = alloc(512 * 128 * 4); float* kcmp = alloc(512 * 64 * 4); float* vcmp = alloc(512 * 64 * 4);
    float* pc = alloc((size_t)4 * 512 * T * 4);
    float* oc = alloc((size_t)T * 256 * 4); float* os = alloc((size_t)T * 256 * 4); float* ow = alloc((size_t)T * 256 * 4);
    int* idxs = (int*)alloc((size_t)T * 16 * 4);
    float* km = alloc(4 * 32 * 64 * 4);
    float* o = alloc((size_t)T * D * 4);
    float* u = alloc((size_t)T * DFF * 4);
    (void)ws_size; (void)in_sizes; (void)n_in; (void)out_size;

    (void)hipMemcpyAsync(X, x, (size_t)NB * T * D * 4, hipMemcpyDeviceToDevice, stream);
    k_mod<<<(DEPTH * NB * 6 * D + 255) / 256, 256, 0, stream>>>(c, w_ada, b_ada, mod);
    for (int l = 0; l < DEPTH; ++l) {
        for (int b = 0; b < NB; ++b) {
            float* Xb = X + (size_t)b * T * D;
            const float* md = mod + ((size_t)l * NB + b) * 6 * D;
            const float *sh1 = md, *sc1 = md + D, *g1 = md + 2 * D, *sh2 = md + 3 * D, *sc2 = md + 4 * D, *g2 = md + 5 * D;
            k_norm<<<T, 256, 0, stream>>>(Xb, norm_mix_g + l * D, sc1, sh1, h);
            k_sgemm<0><<<dim3((DIN + 63) / 64, T / 64), 256, 0, stream>>>(h, D, w_in + (size_t)l * D * DIN, DIN, z, DIN, T, DIN, D, nullptr);
            k_banded<<<T * 4 / 256, 256, 0, stream>>>(z, ZA, ZA + 256, ZA + 384, 1, 128, 0, swa_sinks + l * 4, o, D, 0);
            k_mla_prep<<<T, 64, 0, stream>>>(z, mla_qg + l * 192, mla_kvg + l * 128, cqn, ckvn, kper);
            k_sgemm<0><<<dim3(384 / 64, T / 64), 256, 0, stream>>>(cqn, 192, mla_w_uq + (size_t)l * 192 * 384, 384, qm, 384, T, 384, 192, nullptr);
            k_sgemm<0><<<dim3(512 / 64, T / 64), 256, 0, stream>>>(ckvn, 128, mla_w_ukv + (size_t)l * 128 * 512, 512, kvm, 512, T, 512, 128, nullptr);
            k_rope_q<<<T * 64 / 256, 256, 0, stream>>>(qm);
            k_mla_attn<<<T * 4 / 256, 256, 0, stream>>>(qm, kvm, kper, o);
            k_nsa_hidden<<<512, 128, 0, stream>>>(z, ZC + 256, pos_k + l * 2048, ck_w1 + (size_t)l * 2048 * 128, hidk);
            k_nsa_hidden<<<512, 128, 0, stream>>>(z, ZC + 320, pos_v + l * 2048, cv_w1 + (size_t)l * 2048 * 128, hidv);
            k_nsa_cmp2<<<512, 64, 0, stream>>>(hidk, ck_w2 + (size_t)l * 128 * 64, kcmp);
            k_nsa_cmp2<<<512, 64, 0, stream>>>(hidv, cv_w2 + (size_t)l * 128 * 64, vcmp);
            k_nsa_cmp_attn<<<T * 4 / 256, 256, 0, stream>>>(z, kcmp, vcmp, pc, oc);
            k_nsa_select<<<T / 64, 64, 0, stream>>>(pc, idxs);
            k_nsa_sel_attn<<<T * 4 / 256, 256, 0, stream>>>(z, idxs, os);
            k_banded<<<T * 4 / 256, 256, 0, stream>>>(z, ZC, ZC + 512, ZC + 576, 2, 512, 1, nullptr, ow, 256, 0);
            k_nsa_combine<<<T * 256 / 256, 256, 0, stream>>>(z, oc, os, ow, o);
            k_moba_kmean<<<4 * 32 * 64 / 256, 256, 0, stream>>>(z, km);
            k_moba_attn<<<T * 4 / 256, 256, 0, stream>>>(z, km, o);
            k_sgemm<1><<<dim3(D / 64, T / 64), 256, 0, stream>>>(o, D, w_out + (size_t)l * D * D, D, Xb, D, T, D, D, g1);
            k_norm<<<T, 256, 0, stream>>>(Xb, norm_mlp_g + l * D, sc2, sh2, h);
            k_sgemm<2><<<dim3(DFF / 64, T / 64), 256, 0, stream>>>(h, D, w_up + (size_t)l * D * DFF, DFF, u, DFF, T, DFF, D, nullptr);
            k_sgemm<1><<<dim3(D / 64, T / 64), 256, 0, stream>>>(u, DFF, w_down + (size_t)l * DFF * D, D, Xb, D, T, D, DFF, g2);
        }
    }
    k_norm<<<NB * T, 256, 0, stream>>>(X, final_g, nullptr, nullptr, X);
}
```

```cpp
#include <hip/hip_runtime.h>
#include <cstdio>
#include <cstdint>
#include <math.h>
#define FA_EXP 0
#define FA_PROBE 0
#define MK_PROBE_IDX 0
#define MK_MODE 0
#define MK_NAIVE_MASK 0
#define MK_SKIP 0
#define MK_SPLIT 0
#define MK_DBG_PHASE 0
#define MK_DBG_TEST 0
#define MK_REP 0
namespace pg8 {
#define PG8_LAS __attribute__((address_space(3)))
typedef unsigned short bf16_t;
typedef short bf16x8 __attribute__((ext_vector_type(8)));
typedef float f32x4 __attribute__((ext_vector_type(4)));
typedef unsigned u32x4 __attribute__((ext_vector_type(4)));
constexpr int BM = 256, BK = 64, HALF = 128, HTB = HALF * BK * 2  , STAGE_BYTES = 8 * HTB, NXCD = 8, WGM = 8;

__host__ __device__ __forceinline__ int lds_byte(int r, int c) { const int st = (r >> 4) * 2 + (c >> 5), rr = r & 15, cc = c & 31, ob = rr * 64 + cc * 2; return st * 1024 + (ob ^ (((ob >> 9) & 1) << 5)); }
__host__ __device__ __forceinline__ void stage_rc(int b, int& R, int& C) { const int st = b / 1024, sb = b % 1024, swz = sb ^ (((sb >> 9) & 1) << 5); R = (st >> 1) * 16 + swz / 64; C = (st & 1) * 32 + (swz % 64) / 2; }
__host__ __device__ __forceinline__ int perm32(int rho) { const int n = rho >> 4, i = rho & 15; return 8 * (i >> 2) + 4 * n + (i & 3); }

struct Unit { int pm, pn; };
struct Gemm { const bf16_t* A; const bf16_t* Bt; int M, N, K, lda; };

struct StaticOrder {
    int nM, nN, nwg, G, c;
    __host__ __device__ void init(int M, int N, int G_, int c_) { nM = M / BM; nN = N / BM; nwg = nM * nN; G = G_; c = c_; }
    __host__ __device__ bool next(int i, Unit& u) const {
        const long L = (long)i * G + c; if (L >= nwg) return false;
        int wgid = (int)L; { const int q = nwg / NXCD, r = nwg % NXCD, xcd = wgid % NXCD, off = wgid / NXCD; wgid = (xcd < r ? xcd * (q + 1) : r * (q + 1) + (xcd - r) * q) + off; }
        const int nig = WGM * nN, gid = wgid / nig, fm = gid * WGM, gsz = (nM - fm) < WGM ? (nM - fm) : WGM;
        u.pm = fm + ((wgid % nig) % gsz); u.pn = (wgid % nig) / gsz; return true;
    }
    __device__ __forceinline__ void a_ready(const Unit&) const {}
    __device__ __forceinline__ void done(const Unit&) const {}
};
__device__ __forceinline__ unsigned cvt_pk_bf16(float lo, float hi) { unsigned r; asm volatile("v_cvt_pk_bf16_f32 %0, %1, %2" : "=v"(r) : "v"(lo), "v"(hi)); return r; }
typedef float f32x2 __attribute__((ext_vector_type(2)));
__device__ __forceinline__ f32x2 gelu_pk(f32x2 v) {
    const f32x2 av = __builtin_elementwise_abs(v), d = av * 0.2316418882f + 1.0f;
    f32x2 t; t.x = __builtin_amdgcn_rcpf(d.x); t.y = __builtin_amdgcn_rcpf(d.y);
    f32x2 q = t * 0.5307027145f + (-0.7265760135f); q = q * t + 0.7107068705f; q = q * t + (-0.142248368f); q = q * t + 0.127414796f; q = q * t;
    const f32x2 s = (v * v) * (-0.72134752044f);
    f32x2 e; e.x = __builtin_amdgcn_exp2f(s.x); e.y = __builtin_amdgcn_exp2f(s.y);
    const f32x2 m = v * (q * e), r = v - m;
    f32x2 o; o.x = v.x < 0.f ? m.x : r.x; o.y = v.y < 0.f ? m.y : r.y; return o;
}

template <int ACT  > struct EpiBf16 {
    static constexpr bool PERM = true, AFTER_DRAIN = false; static_assert(ACT == 0 || ACT == 1, "EpiBf16: ACT is 0 (none) or 1 (gelu_pk)");
    bf16_t* O; int ldc; const float* bias; int split_cols; size_t split_stride; float scale0;
    __device__ __forceinline__ void operator()(const f32x4 (&acc)[2][2][4][2], const Unit& u, int wr, int wc, int fr, int fq) const {
        const int row0 = u.pm * BM + wr * 64 + fr; int colt = u.pn * BM; bf16_t* base = O;
        float sc = 1.f; if (split_cols) { const int t = colt / split_cols; base += (size_t)t * split_stride; colt -= t * split_cols; if (t == 0) sc = scale0; }
        const int col0 = colt + wc * 32 + 8 * fq, bcol0 = u.pn * BM + wc * 32 + 8 * fq;
        f32x4 bv[2][2];
#pragma unroll
        for (int bj = 0; bj < 2; ++bj)
#pragma unroll
            for (int n = 0; n < 2; ++n) bv[bj][n] = bias ? *(const f32x4*)(bias + bcol0 + bj * HALF + 4 * n) : (f32x4){0.f, 0.f, 0.f, 0.f};
#pragma unroll
        for (int ai = 0; ai < 2; ++ai)
#pragma unroll
            for (int m = 0; m < 4; ++m) { bf16_t* rowp = base + (size_t)(row0 + ai * HALF + m * 16) * ldc + col0;
#pragma unroll
                for (int bj = 0; bj < 2; ++bj) { f32x4 v0 = acc[ai][bj][m][0] + bv[bj][0], v1 = acc[ai][bj][m][1] + bv[bj][1];
                    if (ACT == 1) { f32x2 a = gelu_pk((f32x2){v0[0], v0[1]}), b = gelu_pk((f32x2){v0[2], v0[3]}), c = gelu_pk((f32x2){v1[0], v1[1]}), d = gelu_pk((f32x2){v1[2], v1[3]});
                        v0 = (f32x4){a.x, a.y, b.x, b.y}; v1 = (f32x4){c.x, c.y, d.x, d.y}; }
                    v0 = v0 * sc; v1 = v1 * sc; u32x4 w; w.x = cvt_pk_bf16(v0[0], v0[1]); w.y = cvt_pk_bf16(v0[2], v0[3]); w.z = cvt_pk_bf16(v1[0], v1[1]); w.w = cvt_pk_bf16(v1[2], v1[3]);
                    *(u32x4*)(rowp + bj * HALF) = w; } }
    }
};
template <class Epi, class Sched, bool ALIGN_EPI = false, bool SP2 = false>
__device__ __forceinline__ void gemm_phase(PG8_LAS unsigned char* lds, const Gemm g, const Sched& S, const Epi& E, int tid_in) {
    int tid_ = tid_in; asm volatile("" : "+v"(tid_));
    const int tid = tid_, wid = __builtin_amdgcn_readfirstlane(tid >> 6), lane = tid & 63, wr = wid >> 2, wc = wid & 3, fr = lane & 15, fq = lane >> 4;
    const int K = g.K, nt = K / BK;
    unsigned voffA[2], voffB[2];
#pragma unroll
    for (int i = 0; i < 2; ++i) { int R, C; stage_rc(tid * 16 + i * 8192, R, C); const int Rb = Epi::PERM ? ((R & ~31) + perm32(R & 31)) : R;
        voffA[i] = (unsigned)(R * g.lda + C) * 2u; voffB[i] = (unsigned)(Rb * K + C) * 2u; }
    const size_t kstep = (size_t)(BK * 2);
    const size_t hstep = (size_t)HALF * K * 2;
    const size_t tstep = 2 * hstep; const size_t hstepA = (size_t)HALF * g.lda * 2, tstepA = 2 * hstepA;
    const unsigned ldsw = (unsigned)wid * 1024u;
    const int aoff = lds_byte(wr * 64 + fr, fq * 8), boff = lds_byte(wc * 32 + fr, fq * 8);
#define PG8_SA(b, h) (((b) * 2 + (h)) * HTB)
#define PG8_SB(b, h) ((4 + (b) * 2 + (h)) * HTB)
#define PG8_STAGE(bufoff, gbase, voff) do { _Pragma("unroll") for (int _i = 0; _i < 2; ++_i) \
        __builtin_amdgcn_global_load_lds((const unsigned*)((const char*)(gbase) + (voff)[_i]), (PG8_LAS unsigned*)(lds + (bufoff) + ldsw + _i * 8192), 16, 0, 0); } while (0)
#define PG8_LDA(dst, b, h) do { _Pragma("unroll") for (int m = 0; m < 4; ++m) _Pragma("unroll") for (int k = 0; k < 2; ++k) dst[m][k] = *(const PG8_LAS bf16x8*)(lds + PG8_SA(b, h) + aoff + m * 2048 + k * 1024); } while (0)
#define PG8_LDB(dst, b, h) do { _Pragma("unroll") for (int n = 0; n < 2; ++n) _Pragma("unroll") for (int k = 0; k < 2; ++k) dst[n][k] = *(const PG8_LAS bf16x8*)(lds + PG8_SB(b, h) + boff + n * 2048 + k * 1024); } while (0)
#define PG8_MMA(ai, bj, At, Bt) do { __builtin_amdgcn_s_setprio(1); _Pragma("unroll") for (int m = 0; m < 4; ++m) _Pragma("unroll") for (int n = 0; n < 2; ++n) _Pragma("unroll") for (int k = 0; k < 2; ++k) \
        acc[ai][bj][m][n] = __builtin_amdgcn_mfma_f32_16x16x32_bf16(Bt[n][k], At[m][k], acc[ai][bj][m][n], 0, 0, 0); __builtin_amdgcn_s_setprio(0); } while (0)
#define PG8_WAIT_V(n) asm volatile("s_waitcnt vmcnt(" #n ")" ::: "memory")
#define PG8_WAIT_L(n) asm volatile("s_waitcnt lgkmcnt(" #n ")" ::: "memory")
#define PG8_BAR __builtin_amdgcn_s_barrier()
#define PG8_SCHED __builtin_amdgcn_sched_barrier(0)
    Unit cur, nxt; int ui = 0;
    if (!S.next(0, cur)) return;
    f32x4 acc[2][2][4][2];
#pragma unroll
    for (int a = 0; a < 2; ++a)
#pragma unroll
        for (int b = 0; b < 2; ++b)
#pragma unroll
            for (int m = 0; m < 4; ++m)
#pragma unroll
                for (int n = 0; n < 2; ++n) acc[a][b][m][n] = (f32x4){0.f, 0.f, 0.f, 0.f};
    bf16x8 At[4][2], B0[2][2], B1[2][2];
    const char* cA = (const char*)g.A + (size_t)cur.pm * tstepA; const char* cB = (const char*)g.Bt + (size_t)cur.pn * tstep;
    S.a_ready(cur);
    if constexpr (SP2) {
        PG8_STAGE(PG8_SB(0, 0), cB, voffB); PG8_STAGE(PG8_SB(0, 1), cB + hstep, voffB); PG8_STAGE(PG8_SA(0, 0), cA, voffA); PG8_STAGE(PG8_SA(0, 1), cA + hstepA, voffA);
        if (wr == 1) PG8_BAR;
        PG8_WAIT_V(2); PG8_BAR;
        PG8_STAGE(PG8_SB(1, 0), cB + kstep, voffB); PG8_STAGE(PG8_SA(1, 0), cA + kstep, voffA); PG8_STAGE(PG8_SB(1, 1), cB + hstep + kstep, voffB);
        PG8_WAIT_V(6); PG8_BAR;
    } else {
        PG8_STAGE(PG8_SB(0, 0), cB, voffB); PG8_STAGE(PG8_SA(0, 0), cA, voffA); PG8_STAGE(PG8_SB(0, 1), cB + hstep, voffB); PG8_STAGE(PG8_SA(0, 1), cA + hstepA, voffA);
        if (wr == 1) PG8_BAR;
        PG8_WAIT_V(4); PG8_BAR;
        PG8_STAGE(PG8_SB(1, 0), cB + kstep, voffB); PG8_STAGE(PG8_SA(1, 0), cA + kstep, voffA); PG8_STAGE(PG8_SB(1, 1), cB + hstep + kstep, voffB);
        PG8_WAIT_V(6); PG8_BAR;
    }
    for (;;) {
        const bool has_next = S.next(ui + 1, nxt);
        const char* nA = has_next ? (const char*)g.A + (size_t)nxt.pm * tstepA : cA; const char* nB = has_next ? (const char*)g.Bt + (size_t)nxt.pn * tstep : cB;
        for (int t = 0; t < nt; t += 2) {
            const bool last = (t == nt - 2);
            const char* a1 = cA + (size_t)(t + 1) * kstep;
            const char* a2 = last ? nA : cA + (size_t)(t + 2) * kstep; const char* b2 = last ? nB : cB + (size_t)(t + 2) * kstep;
            const char* a3 = a2 + kstep; const char* b3 = b2 + kstep;
            if (last && has_next) S.a_ready(nxt);
            if constexpr (SP2) {
            PG8_LDB(B0, 0, 0); PG8_LDB(B1, 0, 1); PG8_SCHED; PG8_LDA(At, 0, 0); PG8_STAGE(PG8_SA(1, 1), a1 + hstepA, voffA);
            PG8_WAIT_V(8); PG8_WAIT_L(0); PG8_BAR; PG8_MMA(0, 0, At, B0); PG8_MMA(0, 1, At, B1); PG8_BAR; PG8_SCHED;
            PG8_LDA(At, 0, 1); PG8_STAGE(PG8_SB(0, 0), b2, voffB); PG8_STAGE(PG8_SB(0, 1), b2 + hstep, voffB); PG8_STAGE(PG8_SA(0, 0), a2, voffA);
            PG8_WAIT_V(8); PG8_WAIT_L(0); PG8_BAR; PG8_MMA(1, 0, At, B0); PG8_MMA(1, 1, At, B1); PG8_BAR; PG8_SCHED;
            PG8_LDB(B0, 1, 0); PG8_LDB(B1, 1, 1); PG8_SCHED; PG8_LDA(At, 1, 0); PG8_STAGE(PG8_SA(0, 1), a2 + hstepA, voffA);
            PG8_WAIT_V(8); PG8_WAIT_L(0); PG8_BAR; PG8_MMA(0, 0, At, B0); PG8_MMA(0, 1, At, B1); PG8_BAR; PG8_SCHED;
            PG8_LDA(At, 1, 1); PG8_STAGE(PG8_SB(1, 0), b3, voffB); PG8_STAGE(PG8_SB(1, 1), b3 + hstep, voffB); PG8_STAGE(PG8_SA(1, 0), a3, voffA);
            PG8_WAIT_V(8); PG8_WAIT_L(0); PG8_BAR; PG8_MMA(1, 0, At, B0); PG8_MMA(1, 1, At, B1); PG8_BAR; PG8_SCHED;
            } else {
            PG8_LDB(B0, 0, 0); PG8_SCHED; PG8_LDA(At, 0, 0); PG8_STAGE(PG8_SA(1, 1), a1 + hstepA, voffA);
            PG8_WAIT_L(8); PG8_BAR; PG8_WAIT_L(0); PG8_MMA(0, 0, At, B0); PG8_BAR; PG8_SCHED;
            PG8_LDB(B1, 0, 1); PG8_STAGE(PG8_SB(0, 0), b2, voffB);
            PG8_BAR; PG8_WAIT_L(0); PG8_MMA(0, 1, At, B1); PG8_BAR;
            PG8_LDA(At, 0, 1); PG8_STAGE(PG8_SA(0, 0), a2, voffA);
            PG8_BAR; PG8_WAIT_L(0); PG8_MMA(1, 0, At, B0); PG8_BAR; PG8_SCHED;
            PG8_STAGE(PG8_SB(0, 1), b2 + hstep, voffB);
            PG8_WAIT_V(6); PG8_BAR; PG8_MMA(1, 1, At, B1); PG8_BAR;
            PG8_LDB(B0, 1, 0); PG8_SCHED; PG8_LDA(At, 1, 0); PG8_STAGE(PG8_SA(0, 1), a2 + hstepA, voffA);
            PG8_WAIT_L(8); PG8_BAR; PG8_WAIT_L(0); PG8_MMA(0, 0, At, B0); PG8_BAR; PG8_SCHED;
            PG8_LDB(B1, 1, 1); PG8_STAGE(PG8_SB(1, 0), b3, voffB);
            PG8_BAR; PG8_WAIT_L(0); PG8_MMA(0, 1, At, B1); PG8_BAR;
            PG8_LDA(At, 1, 1); PG8_STAGE(PG8_SA(1, 0), a3, voffA);
            PG8_BAR; PG8_WAIT_L(0); PG8_MMA(1, 0, At, B0); PG8_BAR; PG8_SCHED;
            PG8_STAGE(PG8_SB(1, 1), b3 + hstep, voffB);
            PG8_WAIT_V(6); PG8_BAR; PG8_MMA(1, 1, At, B1); PG8_BAR;
            }
        }
        if constexpr (ALIGN_EPI) { if (wr == 0) PG8_BAR; }
        if constexpr (!Epi::AFTER_DRAIN) { E(acc, cur, wr, wc, fr, fq); S.done(cur); }
        if (!has_next) break;
#pragma unroll
        for (int a = 0; a < 2; ++a)
#pragma unroll
            for (int b = 0; b < 2; ++b)
#pragma unroll
                for (int m = 0; m < 4; ++m)
#pragma unroll
                    for (int n = 0; n < 2; ++n) acc[a][b][m][n] = (f32x4){0.f, 0.f, 0.f, 0.f};
        cur = nxt; cA = nA; cB = nB; ++ui;
        if constexpr (ALIGN_EPI) { if (wr == 1) PG8_BAR; }
    }
    PG8_WAIT_V(0);
    if constexpr (!ALIGN_EPI) { if (wr == 0) PG8_BAR; }
    PG8_BAR;
    if constexpr (Epi::AFTER_DRAIN) { E.fused(acc, cur, wr, wc, fr, fq, lds, wid, lane); S.done(cur); }
#undef PG8_SA
#undef PG8_SB
#undef PG8_STAGE
#undef PG8_LDA
#undef PG8_LDB
#undef PG8_MMA
#undef PG8_WAIT_V
#undef PG8_WAIT_L
#undef PG8_BAR
#undef PG8_SCHED
}
}
namespace pg8 {
template <class T> __device__ __forceinline__ T* uni_ptr(T* p) {
    const unsigned long long v = (unsigned long long)p; unsigned lo = __builtin_amdgcn_readfirstlane((unsigned)v), hi = __builtin_amdgcn_readfirstlane((unsigned)(v >> 32)); asm volatile("" : "+s"(lo), "+s"(hi)); return (T*)(((unsigned long long)hi << 32) | lo); }
struct EpiResid {
    static constexpr bool PERM = true, AFTER_DRAIN = false;
    const float* xin_; float* out_; const float* gate_;
    __device__ __forceinline__ void operator()(const f32x4 (&acc)[2][2][4][2], const Unit& u, int wr, int wc, int fr, int fq) const {
        const float* xin = uni_ptr(xin_); float* out = uni_ptr(out_); const float* gate = uni_ptr(gate_);
        const int row0 = u.pm * BM + wr * 64 + fr, col0 = u.pn * BM + wc * 32 + 8 * fq;
        const float* gp = gate + (size_t)(u.pm >> 5) * 6144 + col0;
        f32x4 gv[2][2];
#pragma unroll
        for (int bj = 0; bj < 2; ++bj)
#pragma unroll
            for (int n = 0; n < 2; ++n) gv[bj][n] = *(const f32x4*)(gp + bj * HALF + 4 * n);
#pragma unroll
        for (int ai = 0; ai < 2; ++ai)
#pragma unroll
            for (int m = 0; m < 4; ++m) { const size_t off = (size_t)(row0 + ai * HALF + m * 16) * 1024 + col0;
#pragma unroll
                for (int bj = 0; bj < 2; ++bj) { const f32x4 x0 = *(const f32x4*)(xin + off + bj * HALF), x1 = *(const f32x4*)(xin + off + bj * HALF + 4);
                    *(f32x4*)(out + off + bj * HALF) = x0 + gv[bj][0] * acc[ai][bj][m][0]; *(f32x4*)(out + off + bj * HALF + 4) = x1 + gv[bj][1] * acc[ai][bj][m][1]; }
                if (m & 1) asm volatile("" ::: "memory"); }
    }
};
struct EpiRelu2 {
    static constexpr bool PERM = true, AFTER_DRAIN = false;
    bf16_t* O_; int ldc;
    __device__ __forceinline__ void operator()(const f32x4 (&acc)[2][2][4][2], const Unit& u, int wr, int wc, int fr, int fq) const {
        bf16_t* O = uni_ptr(O_);
        const int row0 = u.pm * BM + wr * 64 + fr, col0 = u.pn * BM + wc * 32 + 8 * fq;
#pragma unroll
        for (int ai = 0; ai < 2; ++ai)
#pragma unroll
            for (int m = 0; m < 4; ++m) { bf16_t* rowp = O + (size_t)(row0 + ai * HALF + m * 16) * ldc + col0;
#pragma unroll
                for (int bj = 0; bj < 2; ++bj) { f32x4 v0 = acc[ai][bj][m][0], v1 = acc[ai][bj][m][1];
                    v0 = __builtin_elementwise_max(v0, (f32x4){0.f, 0.f, 0.f, 0.f}); v1 = __builtin_elementwise_max(v1, (f32x4){0.f, 0.f, 0.f, 0.f}); v0 = v0 * v0; v1 = v1 * v1;
                    u32x4 w; w.x = cvt_pk_bf16(v0[0], v0[1]); w.y = cvt_pk_bf16(v0[2], v0[3]); w.z = cvt_pk_bf16(v1[0], v1[1]); w.w = cvt_pk_bf16(v1[2], v1[3]);
                    *(u32x4*)(rowp + bj * HALF) = w; } }
    }
};
struct EpiMlaQ {
    static constexpr bool PERM = true, AFTER_DRAIN = false;
    bf16_t* QM_;
    __device__ __forceinline__ void operator()(const f32x4 (&acc)[2][2][4][2], const Unit& u, int wr, int wc, int fr, int fq) const {
        bf16_t* QM = uni_ptr(QM_);
        const int row0 = u.pm * BM + wr * 64 + fr, cw = wc * 32 + 8 * fq;
        const int nbj = (u.pn != 0) ? 1 : 2;
#pragma unroll
        for (int ai = 0; ai < 2; ++ai)
#pragma unroll
            for (int m = 0; m < 4; ++m) { bf16_t* qr = QM + (size_t)(row0 + ai * HALF + m * 16) * 384 + u.pn * 256 + cw;
#pragma unroll
                for (int bj = 0; bj < 2; ++bj) if (bj < nbj) { const f32x4 v0 = acc[ai][bj][m][0], v1 = acc[ai][bj][m][1];
                    u32x4 o; o.x = cvt_pk_bf16(v0[0], v0[1]); o.y = cvt_pk_bf16(v0[2], v0[3]); o.z = cvt_pk_bf16(v1[0], v1[1]); o.w = cvt_pk_bf16(v1[2], v1[3]);
                    *(u32x4*)(qr + bj * HALF) = o; } }
    }
};
struct EpiMlaKV {
    static constexpr bool PERM = true, AFTER_DRAIN = false;
    bf16_t* KM_; bf16_t* VM_; const float* rskv_;
    __device__ __forceinline__ void operator()(const f32x4 (&acc)[2][2][4][2], const Unit& u, int wr, int wc, int fr, int fq) const {
        bf16_t* KM = uni_ptr(KM_); bf16_t* VM = uni_ptr(VM_); const float* rskv = uni_ptr(rskv_);
        const int row0 = u.pm * BM + wr * 64 + fr, w = wc * 32 + 8 * fq;
        const bool isk = wc < 2;
#pragma unroll
        for (int ai = 0; ai < 2; ++ai)
#pragma unroll
            for (int m = 0; m < 4; ++m) { const int row = row0 + ai * HALF + m * 16; const float rs = rskv[row];
#pragma unroll
                for (int bj = 0; bj < 2; ++bj) { const int head = u.pn * 2 + bj;
                    const f32x4 v0 = acc[ai][bj][m][0] * rs, v1 = acc[ai][bj][m][1] * rs;
                    u32x4 o; o.x = cvt_pk_bf16(v0[0], v0[1]); o.y = cvt_pk_bf16(v0[2], v0[3]); o.z = cvt_pk_bf16(v1[0], v1[1]); o.w = cvt_pk_bf16(v1[2], v1[3]);
                    if (isk) *(u32x4*)(KM + (size_t)row * 384 + head * 96 + w) = o; else *(u32x4*)(VM + (size_t)row * 256 + head * 64 + (w - 64)) = o; }
                asm volatile("" ::: "memory"); }
    }
};
}
#define GAS __attribute__((address_space(1)))
#define LAS __attribute__((address_space(3)))
typedef unsigned short bf16;
typedef unsigned v4u __attribute__((ext_vector_type(4)));
typedef float f32x4 __attribute__((ext_vector_type(4)));
typedef short bf16x8 __attribute__((ext_vector_type(8)));
typedef GAS unsigned gu32;
typedef GAS unsigned long long gu64;
#define RLX_AGENT __ATOMIC_RELAXED, __HIP_MEMORY_SCOPE_AGENT
#define LDS_WAIT() asm volatile("s_waitcnt lgkmcnt(0)" ::: "memory")
#define VM_WAIT() asm volatile("s_waitcnt vmcnt(0)" ::: "memory")
__device__ __forceinline__ unsigned long long rt() { return __builtin_amdgcn_s_memrealtime(); }
__device__ __forceinline__ unsigned f2bf(float f) { unsigned u = __builtin_bit_cast(unsigned, f); return (u + 0x7fffu + ((u >> 16) & 1u)) >> 16; }
__device__ __forceinline__ unsigned pk2(float lo, float hi) { return f2bf(lo) | (f2bf(hi) << 16); }

#define XB_TMO      128
#define XB_XCNT(j)  (256  + 64 * (j))
#define XB_XSUB(j)  (1280 + 64 * (j))
#define XB_XGEN(j)  (2304 + 64 * (j))
#define XB_TOP      3328
#define XB_TOPGEN   3392
#define XCD_BAR_WORDS 3456
#define XB_SPIN_CAP (1u << 18)

__device__ __forceinline__ unsigned xb_ld(unsigned* p)              { return __hip_atomic_load(p, __ATOMIC_RELAXED, __HIP_MEMORY_SCOPE_AGENT); }
__device__ __forceinline__ unsigned xb_add(unsigned* p, unsigned v) { return __hip_atomic_fetch_add(p, v, __ATOMIC_RELAXED, __HIP_MEMORY_SCOPE_AGENT); }
__device__ __forceinline__ unsigned xb_xcc_id() { return (unsigned)__builtin_amdgcn_s_getreg((3 << 11) | 20) & 0xFu; }
#define XB_SPIN(cond, bar) do { unsigned _sp = 0; while (cond) { __builtin_amdgcn_s_sleep(1); \
    if ((++_sp & 255u) == 0u) { if (xb_ld(&(bar)[XB_TMO])) break; if (_sp > XB_SPIN_CAP) { atomicAdd(&(bar)[XB_TMO], 1u); break; } } } } while (0)

struct XcdBarrier {
    unsigned* bar; unsigned x;
    volatile LAS unsigned* st;
};

__device__ __forceinline__ XcdBarrier xcd_barrier_post(unsigned* bar, volatile LAS unsigned* st) {
    XcdBarrier b; b.bar = bar; b.x = xb_xcc_id(); b.st = st;
    if (threadIdx.x == 0) (void)xb_add(&bar[XB_XCNT(b.x)], 1u);
    return b;
}
__device__ __forceinline__ void xcd_barrier_complete(unsigned* bar, unsigned x, unsigned& nloc, unsigned& nx) {
    const unsigned G = gridDim.x * gridDim.y * gridDim.z;
    unsigned sum, cnt, mine, sp = 0u;
    for (;;) {
        sum = 0u; cnt = 0u; mine = 0u;
#pragma unroll
        for (unsigned j = 0; j < 16; ++j) { const unsigned c = xb_ld(&bar[XB_XCNT(j)]); sum += c; cnt += (c > 0u) ? 1u : 0u; mine = (j == x) ? c : mine; }
        if (sum == G) break;
        __builtin_amdgcn_s_sleep(1);
        if ((++sp & 255u) == 0u) { if (xb_ld(&bar[XB_TMO])) break; if (sp > XB_SPIN_CAP) { atomicAdd(&bar[XB_TMO], 1u); break; } }
    }
    nloc = mine > 0u ? mine : 1u; nx = cnt > 0u ? cnt : 1u;
}

__device__ __forceinline__ void xcd_barrier(const XcdBarrier& b) {
    asm volatile("s_waitcnt vmcnt(0)" ::: "memory");
    __syncthreads();
    if (threadIdx.x == 0) {
        unsigned* bar = b.bar;
        __builtin_amdgcn_s_waitcnt(0);
        unsigned nloc = b.st[0], nx = b.st[1];
        if (nloc == 0u) { xcd_barrier_complete(bar, b.x, nloc, nx); b.st[0] = nloc; b.st[1] = nx; }
        const unsigned old = xb_add(&bar[XB_XSUB(b.x)], 1u);
        const unsigned gen = old / nloc;
        if (old + 1u == (gen + 1u) * nloc) {
            __builtin_amdgcn_fence(__ATOMIC_RELEASE, "agent");
            asm volatile("s_waitcnt vmcnt(0)" ::: "memory");
            const unsigned og = xb_add(&bar[XB_TOP], 1u);
            const unsigned tg = og / nx;
            if (og + 1u == (tg + 1u) * nx) xb_add(&bar[XB_TOPGEN], 1u);
            else XB_SPIN(xb_ld(&bar[XB_TOPGEN]) == tg, bar);
            __builtin_amdgcn_fence(__ATOMIC_ACQUIRE, "agent");
            xb_add(&bar[XB_XGEN(b.x)], 1u);
            asm volatile("s_waitcnt vmcnt(0)" ::: "memory");
        } else {
            XB_SPIN(xb_ld(&bar[XB_XGEN(b.x)]) == gen, bar);
            __builtin_amdgcn_fence(__ATOMIC_ACQUIRE, "agent");
            asm volatile("s_waitcnt vmcnt(0)" ::: "memory");
        }
    }
    __syncthreads();
}
#ifndef FA_PROBE
#define FA_PROBE 0
#endif
namespace fa {
typedef unsigned short bf16;
typedef short bf16x8 __attribute__((ext_vector_type(8)));
typedef short s16x4 __attribute__((ext_vector_type(4)));
typedef float f32x16 __attribute__((ext_vector_type(16)));
typedef float f32x4v __attribute__((ext_vector_type(4)));
typedef unsigned u32x4 __attribute__((ext_vector_type(4)));
typedef unsigned u32x2 __attribute__((ext_vector_type(2)));
typedef float f32x2_t __attribute__((ext_vector_type(2)));
typedef __bf16 bf16x2_t __attribute__((ext_vector_type(2)));
#define FLAS __attribute__((address_space(3)))
#define FGAS __attribute__((address_space(1)))
constexpr float MASKV = -1e30f, MINIT = -5e29f, TINYF = 1e-30f, LOG2E = 1.4426950408889634f;
constexpr int OSTR = 144;

__device__ __forceinline__ float ex2(float x) { return __builtin_amdgcn_exp2f(x); }
__device__ __forceinline__ unsigned cvtpk(float lo, float hi) { f32x2_t v = {lo, hi}; bf16x2_t b = __builtin_convertvector(v, bf16x2_t); return __builtin_bit_cast(unsigned, b); }
__device__ __forceinline__ float xhalf_max(float m) { auto rr = __builtin_amdgcn_permlane32_swap(__float_as_uint(m), __float_as_uint(m), false, false); return fmaxf(__uint_as_float(rr[0]), __uint_as_float(rr[1])); }
__device__ __forceinline__ float xhalf_sum(float m) { auto rr = __builtin_amdgcn_permlane32_swap(__float_as_uint(m), __float_as_uint(m), false, false); return __uint_as_float(rr[0]) + __uint_as_float(rr[1]); }
__device__ __forceinline__ float bf2f(unsigned short b) { return __uint_as_float((unsigned)b << 16); }

struct SM { float m, l; f32x16 o[2]; };
__device__ __forceinline__ void sm_init(SM& s) { s.m = MINIT; s.l = 0.f; s.o[0] = f32x16{}; s.o[1] = f32x16{}; }

template <int DQ> struct Stg { u32x4 k0, k1, v; };
template <int DQ> __device__ __forceinline__ void stg_load(Stg<DQ>& s, const FGAS char* ws, unsigned koff, unsigned ksb, unsigned voff, unsigned vsb, int key0, int kmax, int tid) {
    const int row = tid >> 3, ch = tid & 7; int kr = key0 + row; kr = kr < kmax ? kr : kmax;
    s.k0 = *(const FGAS u32x4*)(ws + (koff + (unsigned)kr * ksb + (unsigned)ch * 16u));
    s.v = *(const FGAS u32x4*)(ws + (voff + (unsigned)kr * vsb + (unsigned)ch * 16u));
    if (DQ == 96) { if (tid < 256) { const int r2 = tid >> 2, c2 = tid & 3; int k2 = key0 + r2; k2 = k2 < kmax ? k2 : kmax; s.k1 = *(const FGAS u32x4*)(ws + (koff + (unsigned)k2 * ksb + 128u + (unsigned)c2 * 16u)); } }
}
template <int DQ> __device__ __forceinline__ void stg_store(const Stg<DQ>& s, FLAS char* buf, int tid) {
    const int row = tid >> 3, ch = tid & 7, p = ch >> 2, c = ch & 3;
    *(FLAS u32x4*)(buf + p * 4096 + row * 64 + ((c ^ ((row >> 2) & 3)) << 4)) = s.k0;
    *(FLAS u32x4*)(buf + (DQ / 32) * 4096 + row * 128 + ((p ^ ((row >> 1) & 1)) << 6) + (c << 4)) = s.v;
    if (DQ == 96) { if (tid < 256) { const int r2 = tid >> 2, c2 = tid & 3; *(FLAS u32x4*)(buf + 2 * 4096 + r2 * 64 + ((c2 ^ ((r2 >> 2) & 3)) << 4)) = s.k1; } }
}
template <int DQ> constexpr int stage_bytes() { return (DQ / 32) * 4096 + 8192; }

template <int DQ> __device__ __forceinline__ void compute_S(f32x16& p0, f32x16& p1, const FLAS char* buf, const bf16x8 (&qf)[DQ / 16], int lane) {
    const int r = lane & 31, h = lane >> 5, sw = (r >> 2) & 3;
#pragma unroll
    for (int d0 = 0; d0 < DQ / 16; ++d0) {
        const int p = d0 >> 1, c = 2 * (d0 & 1) + h;
        const FLAS char* a = buf + p * 4096 + r * 64 + ((c ^ sw) << 4);
        const bf16x8 a0 = *(const FLAS bf16x8*)a, a1 = *(const FLAS bf16x8*)(a + 2048);
        p0 = __builtin_amdgcn_mfma_f32_32x32x16_bf16(a0, qf[d0], p0, 0, 0, 0);
        p1 = __builtin_amdgcn_mfma_f32_32x32x16_bf16(a1, qf[d0], p1, 0, 0, 0);
    }
}
__device__ __forceinline__ s16x4 vtr(const FLAS char* p) { typedef short v4i16_t __attribute__((ext_vector_type(4))); return __builtin_bit_cast(s16x4, __builtin_amdgcn_ds_read_tr16_b64_v4i16((FLAS v4i16_t*)p)); }
__device__ __forceinline__ void pv(f32x16 (&o)[2], const FLAS char* vbuf, const bf16x8 (&pf)[4], int lane) {
    const int g = lane >> 4, i = lane & 15, q4 = i >> 2, pp = i & 3, h = lane >> 5;
    const int sw = (q4 >> 1) & 1;
#pragma unroll
    for (int db = 0; db < 2; ++db) {
        const FLAS char* base = vbuf + (4 * h + q4) * 128 + ((db ^ sw) << 6) + (16 * (g & 1) + 4 * pp) * 2;
#pragma unroll
        for (int ks = 0; ks < 4; ++ks) {
            const s16x4 lo = vtr(base + ks * 2048), hi = vtr(base + ks * 2048 + 1024);
            const bf16x8 a = (bf16x8){lo[0], lo[1], lo[2], lo[3], hi[0], hi[1], hi[2], hi[3]};
            o[db] = __builtin_amdgcn_mfma_f32_32x32x16_bf16(a, pf[ks], o[db], 0, 0, 0);
        }
    }
}
__device__ __forceinline__ void mask_ew(f32x16& p0, f32x16& p1, int lo, int hi, int h) {
    const int lo2 = lo - 4 * h, hi2 = hi - 4 * h;
#pragma unroll
    for (int v = 0; v < 16; ++v) { const int k0 = (v & 3) + 8 * (v >> 2);
        if (k0 < lo2 || k0 > hi2) p0[v] = MASKV;
        if (k0 + 32 < lo2 || k0 + 32 > hi2) p1[v] = MASKV; }
}
__device__ __forceinline__ void sm_step(SM& st, f32x16& p0, f32x16& p1, bf16x8 (&pf)[4]) {
#define FA_MX3(a, b, c) __builtin_fmaxf(__builtin_fmaxf((a), (b)), (c))
    float ma = FA_MX3(p0[0], p0[1], p1[0]), mb = FA_MX3(p0[2], p0[3], p1[1]); ma = FA_MX3(ma, p1[2], p1[3]);
#pragma unroll
    for (int v = 4; v < 16; v += 4) { ma = FA_MX3(ma, p0[v], p0[v + 1]); mb = FA_MX3(mb, p0[v + 2], p0[v + 3]); ma = FA_MX3(ma, p1[v], p1[v + 1]); mb = FA_MX3(mb, p1[v + 2], p1[v + 3]); }
#undef FA_MX3
    const float mx = xhalf_max(__builtin_fmaxf(ma, mb));
    if (__any(mx > st.m)) {
        const float mn2 = fmaxf(st.m, mx), alpha = ex2(st.m - mn2);
        st.m = mn2; st.l *= alpha; st.o[0] *= alpha; st.o[1] *= alpha;
    }
    const float mn = st.m;
    float s0 = 0.f, s1 = 0.f;
#pragma unroll
    for (int v = 0; v < 16; ++v) { p0[v] = ex2(p0[v] - mn); p1[v] = ex2(p1[v] - mn); s0 += p0[v]; s1 += p1[v]; }
    st.l += s0 + s1;
    u32x4 w;
    w.x = cvtpk(p0[0], p0[1]); w.y = cvtpk(p0[2], p0[3]); w.z = cvtpk(p0[4], p0[5]); w.w = cvtpk(p0[6], p0[7]); pf[0] = __builtin_bit_cast(bf16x8, w);
    w.x = cvtpk(p0[8], p0[9]); w.y = cvtpk(p0[10], p0[11]); w.z = cvtpk(p0[12], p0[13]); w.w = cvtpk(p0[14], p0[15]); pf[1] = __builtin_bit_cast(bf16x8, w);
    w.x = cvtpk(p1[0], p1[1]); w.y = cvtpk(p1[2], p1[3]); w.z = cvtpk(p1[4], p1[5]); w.w = cvtpk(p1[6], p1[7]); pf[2] = __builtin_bit_cast(bf16x8, w);
    w.x = cvtpk(p1[8], p1[9]); w.y = cvtpk(p1[10], p1[11]); w.z = cvtpk(p1[12], p1[13]); w.w = cvtpk(p1[14], p1[15]); pf[3] = __builtin_bit_cast(bf16x8, w);
}
template <int DQ, bool ALIBI> __device__ __forceinline__ void score_tile(f32x16& p0, f32x16& p1, const FLAS char* buf, const bf16x8 (&qf)[DQ / 16], float cb, float sl, int lane) {
    if (ALIBI) {
#pragma unroll
        for (int v = 0; v < 16; ++v) { const float c = (float)((v & 3) + 8 * (v >> 2)); p0[v] = fmaf(sl, c, cb); p1[v] = fmaf(sl, c + 32.f, cb); }
    } else { p0 = f32x16{}; p1 = f32x16{}; }
    compute_S<DQ>(p0, p1, buf, qf, lane);
}
template <int DQ, bool ALIBI> __device__ __forceinline__ void tile_compute(SM& st, const FLAS char* buf, const bf16x8 (&qf)[DQ / 16], float cb, float sl, bool ew, int lo, int hi, int lane) {
    f32x16 p0, p1; bf16x8 pf[4];
    score_tile<DQ, ALIBI>(p0, p1, buf, qf, cb, sl, lane);
    if (ew) mask_ew(p0, p1, lo, hi, lane >> 5);
    sm_step(st, p0, p1, pf);
    pv(st.o, buf + (DQ / 32) * 4096, pf, lane);
}
template <int DQ, bool ALIBI, class K0, class PAR>
__device__ __forceinline__ void fa_loop(SM& st, const bf16x8 (&qf)[DQ / 16], const FGAS char* ws, unsigned koff, unsigned ksb, unsigned voff, unsigned vsb, int kmax, int ntile, K0 k0f, PAR parf, float sl, FLAS char* lds, int tid, int lane) {
    constexpr int STG = stage_bytes<DQ>();
    Stg<DQ> sgA, sgB;
    stg_load<DQ>(sgB, ws, koff, ksb, voff, vsb, k0f(0), kmax, tid); stg_store<DQ>(sgB, lds, tid);
    if (ntile > 1) stg_load<DQ>(sgA, ws, koff, ksb, voff, vsb, k0f(1), kmax, tid);
    if (ntile > 2) stg_load<DQ>(sgB, ws, koff, ksb, voff, vsb, k0f(2), kmax, tid);
    __syncthreads();
#if FA_PROBE
    unsigned long long pr_c = 0, pr_w = 0, pr_b = 0, pr_t = 0; const unsigned long long pr_start = __builtin_amdgcn_s_memtime();
#define FA_P0 const unsigned long long q0_ = __builtin_amdgcn_s_memtime();
#define FA_P1 asm volatile("s_waitcnt vmcnt(0)" ::: "memory"); const unsigned long long q1_ = __builtin_amdgcn_s_memtime();
#define FA_P2 asm volatile("s_waitcnt lgkmcnt(0)" ::: "memory"); asm volatile("" : "+v"(st.o[0]), "+v"(st.o[1])); const unsigned long long q2_ = __builtin_amdgcn_s_memtime();
#define FA_P3 const unsigned long long q3_ = __builtin_amdgcn_s_memtime(); pr_w += q1_ - q0_; pr_c += q2_ - q1_; pr_b += q3_ - q2_; pr_t += 1;
#else
#define FA_P0
#define FA_P1
#define FA_P2
#define FA_P3
#endif
#define FA_ITER(SG) { \
        FA_P0 \
        if (t + 1 < ntile) stg_store<DQ>(SG, lds + ((t + 1) & 1) * STG, tid); \
        if (t + 3 < ntile) stg_load<DQ>(SG, ws, koff, ksb, voff, vsb, k0f(t + 3), kmax, tid); \
        FA_P1 \
        bool act, ew; float cb; int lo, hi; \
        parf(t, act, ew, cb, lo, hi); \
        if (act) tile_compute<DQ, ALIBI>(st, lds + (t & 1) * STG, qf, cb, sl, ew, lo, hi, lane); \
        FA_P2 \
        __syncthreads(); \
        FA_P3 }
    int t = 0;
    for (; t + 1 < ntile; t += 2) { FA_ITER(sgA) ++t; FA_ITER(sgB) --t; }
    if (t < ntile) FA_ITER(sgA)
#undef FA_ITER
#if FA_PROBE
    if (DQ == 96 && lane == 0) { unsigned long long* pp = (unsigned long long*)((FGAS char*)ws + 32768);
        atomicAdd(pp + 0, pr_c); atomicAdd(pp + 1, pr_w); atomicAdd(pp + 2, pr_b); atomicAdd(pp + 3, pr_t); atomicAdd(pp + 4, __builtin_amdgcn_s_memtime() - pr_start); }
#endif
}
__device__ __forceinline__ void sm_finish(const SM& st, float gate, f32x16 (&acc)[2]) {
    const float inv = gate / fmaxf(xhalf_sum(st.l), TINYF);
    acc[0] += st.o[0] * inv; acc[1] += st.o[1] * inv;
}
template <class DST> __device__ __forceinline__ void store_out(const f32x16 (&acc)[2], FLAS char* ost, FGAS char* ws, DST dstf, int lane) {
    const int r = lane & 31, h = lane >> 5;
#pragma unroll
    for (int db = 0; db < 2; ++db)
#pragma unroll
        for (int g = 0; g < 4; ++g) { u32x2 w; w.x = cvtpk(acc[db][4 * g], acc[db][4 * g + 1]); w.y = cvtpk(acc[db][4 * g + 2], acc[db][4 * g + 3]);
            *(FLAS u32x2*)(ost + r * OSTR + (32 * db + 8 * g + 4 * h) * 2) = w; }
    asm volatile("s_waitcnt lgkmcnt(0)" ::: "memory");
#pragma unroll
    for (int i = 0; i < 4; ++i) { const int idx = i * 64 + lane, col = idx >> 3, ch = idx & 7;
        const u32x4 v = *(const FLAS u32x4*)(ost + col * OSTR + ch * 16);
        *(FGAS u32x4*)(ws + (dstf(col) + (unsigned)ch * 16u)) = v; }
    asm volatile("s_waitcnt lgkmcnt(0)" ::: "memory");
}
template <int DQ> __device__ __forceinline__ void load_q(bf16x8 (&qf)[DQ / 16], const FGAS char* ws, unsigned qoff, int h) {
#pragma unroll
    for (int d0 = 0; d0 < DQ / 16; ++d0) qf[d0] = *(const FGAS bf16x8*)(ws + (qoff + (unsigned)(d0 * 32 + 16 * h)));
}
}
namespace mk {
typedef unsigned short bf16;
typedef float f32x4 __attribute__((ext_vector_type(4)));
typedef unsigned v4u __attribute__((ext_vector_type(4)));
typedef unsigned v2u __attribute__((ext_vector_type(2)));
typedef short bf16x8 __attribute__((ext_vector_type(8)));
typedef float f32x16 __attribute__((ext_vector_type(16)));
using fa::SM;

constexpr int D = 1024, NB = 4, SEQ = 8192, M = NB * SEQ, DEPTH = 2, DFF = 4096, ZLD = 2304, DIN = 2284;
constexpr int ZA_Q = 0, ZA_K = 256, ZA_V = 384, ZB_CQ = 512, ZB_CKV = 704, ZB_PE = 832, ZC_Q = 864, ZC_KC = 1120, ZC_VC = 1184, ZC_KS = 1248, ZC_VS = 1312, ZC_KW = 1376, ZC_VW = 1440, ZC_GL = 1504, ZD_Q = 1520, ZD_K = 1776, ZD_V = 2032;
constexpr float LOG2E = 1.4426950408889634f;
constexpr float QS = 0.125f * LOG2E;
constexpr float C_MLA = 0.10206207261596577f * LOG2E;
constexpr float RMS_EPS = 1e-6f;
constexpr int NWAVES = 8, NTHR = 512;

constexpr size_t MiB = 1u << 20;
constexpr size_t WS_CTL = 0, CTL_ZERO_BYTES = 64 * 1024;
constexpr size_t WS_MOD = 1 * MiB;
constexpr size_t WS_ROPE = WS_MOD + 256 * 1024;
constexpr size_t WS_POSP = WS_ROPE + 1 * MiB;
constexpr size_t WS_POSB = WS_POSP + 64 * 1024;
constexpr size_t WS_RSQ = WS_POSB + 64 * 1024;
constexpr size_t WS_RSKV = WS_RSQ + 128 * 1024;
constexpr size_t WS_KMH = WS_RSKV + 128 * 1024;
constexpr size_t WS_KML = WS_KMH + 64 * 1024;
constexpr size_t WS_KCMP = WS_KML + 64 * 1024;
constexpr size_t WS_VCMP = WS_KCMP + 256 * 1024;
constexpr size_t WS_PARK = 401 * MiB;
constexpr size_t WS_W = 4 * MiB, WS_WL = 26 * MiB;
constexpr size_t W_IN = 0, W_OUT = 4608 * 1024, W_UP = W_OUT + 2 * MiB, W_DN = W_UP + 8 * MiB, W_UQ = W_DN + 8 * MiB, W_UKV = W_UQ + 256 * 1024, W_1K = W_UKV + 256 * 1024, W_1V = W_1K + 512 * 1024, W_2K = W_1V + 512 * 1024, W_2V = W_2K + 16 * 1024;
static_assert(W_2V + 16 * 1024 <= WS_WL && WS_VCMP + 256 * 1024 <= WS_W, "ws map");
constexpr size_t WS_H = 56 * MiB;
constexpr size_t WS_Z = 120 * MiB;
constexpr size_t WS_QM = 265 * MiB, WS_KM = 297 * MiB, WS_VM = 321 * MiB, WS_O = 337 * MiB, WS_U = 120 * MiB, WS_END = 401 * MiB;
static_assert(WS_Z + (size_t)(M + 64) * ZLD * 2 <= WS_QM && WS_U + (size_t)M * DFF * 2 <= WS_END, "ws map 2");

constexpr int LDS_RING = 131072, LDS_BYTES = 163840, LDS_MISC = LDS_BYTES - 256;
constexpr int FA_STAGES = 0, FA_OST = 61440, FA_IMP = FA_OST + 8 * 32 * fa::OSTR  , FA_SELM = FA_IMP + 32768, FA_UM = FA_SELM + 1024, FA_VALS = FA_UM + 64;
static_assert(FA_VALS + 8 * 512 <= LDS_MISC, "fa lds map");
constexpr int MB_Q = 49152, MB_O = MB_Q + 32768, MB_ML = MB_O + 65536, MB_CNT = MB_ML + 2048, MB_LST = MB_CNT + 128;
static_assert(MB_LST + 8192 <= LDS_MISC, "moba lds map");

#define GAS __attribute__((address_space(1)))
#define LAS __attribute__((address_space(3)))
#define LDS_WAIT() asm volatile("s_waitcnt lgkmcnt(0)" ::: "memory")
__device__ __forceinline__ unsigned f2bf(float f) { unsigned u = __builtin_bit_cast(unsigned, f); return (u + 0x7fffu + ((u >> 16) & 1u)) >> 16; }
__device__ __forceinline__ unsigned pk2(float lo, float hi) { return f2bf(lo) | (f2bf(hi) << 16); }
__device__ __forceinline__ float bf2f(unsigned short b) { return __uint_as_float((unsigned)b << 16); }
__device__ __forceinline__ float wave_sum(float v) {
#pragma unroll
    for (int o = 1; o < 64; o <<= 1) v += __shfl_xor(v, o);
    return v;
}
__device__ __forceinline__ float slope2_of(int i) { return exp2f(-8.0f * (float)(i + 1) / 12.0f) * LOG2E; }

struct Args { const float* in[22]; float* out; unsigned char* ws; int ph_lo, ph_hi, skip, rep; };
typedef const __attribute__((address_space(4))) Args* KArgsP;
struct Frame {
    LAS unsigned char* lds;
    int tid, lane, wave, vcu, G, bx;
    unsigned char* ws;
};

template <int MODE> __device__ __forceinline__ int dmap(int n) {
    if (MODE == 1) { if (n < 832) return n; if (n < 848) return 832 + 2 * (n - 832); if (n < 864) return 832 + 2 * (n - 848) + 1; if (n < 1516) return n; return n + 4; }
    if (MODE == 2) { const int hd = n / 96, w = n - hd * 96; if (w < 64) return hd * 64 + w; if (w < 80) return 256 + hd * 32 + 2 * (w - 64); return 256 + hd * 32 + 2 * (w - 80) + 1; }
    return n;
}
template <int MODE> __device__ __forceinline__ float cscale(int n) {
    if (MODE == 1) { return (n < 256 || (n >= 864 && n < 1120) || (n >= 1516 && n < 1772)) ? QS : 1.f; }
    if (MODE == 2) return C_MLA;
    return 1.f;
}
template <int MODE> __device__ __forceinline__ void transpose_item(const float* W, int N, bf16* WT, int KT, const float* kscale, LAS float* scr, int item, int lane) {
    const int nblk = (N + 31) / 32, kb = item / nblk, nb = item % nblk, k0 = 64 * kb, n0 = 32 * nb;
    const int nl = lane & 31, n = n0 + nl;
#pragma unroll 8
    for (int i = 0; i < 32; ++i) { const int kk = 2 * i + (lane >> 5); float v = (n < N) ? W[(size_t)(k0 + kk) * N + n] : 0.f; if (kscale) v *= kscale[k0 + kk]; scr[kk * 33 + nl] = v; }
    LDS_WAIT(); asm volatile("" ::: "memory");
    const int c = lane & 7;
#pragma unroll
    for (int j = 0; j < 4; ++j) { const int nn = (lane >> 3) + 8 * j, ng = n0 + nn;
        if (ng < N) { const float cs = cscale<MODE>(ng); const LAS float* s = scr + (8 * c) * 33 + nn;
            v4u o; o.x = pk2(s[0 * 33] * cs, s[1 * 33] * cs); o.y = pk2(s[2 * 33] * cs, s[3 * 33] * cs); o.z = pk2(s[4 * 33] * cs, s[5 * 33] * cs); o.w = pk2(s[6 * 33] * cs, s[7 * 33] * cs);
            *(GAS v4u*)(WT + (size_t)dmap<MODE>(ng) * KT + k0 + 8 * c) = o; } }
    LDS_WAIT(); asm volatile("" ::: "memory");
}
__device__ __forceinline__ void zero_fill16(bf16* p, size_t n16, int gtid, int gthreads) {
    for (size_t i = gtid; i < n16; i += gthreads) ((GAS v4u*)p)[i] = (v4u){0u, 0u, 0u, 0u};
}

__device__ __forceinline__ void p_prologue(Frame& F, KArgsP ap_) {
#define a (*ap_)
    LAS float* scr = (LAS float*)(F.lds + F.wave * 16384);
    const int gw = F.vcu * NWAVES + F.wave, NGW = F.G * NWAVES;
    const int gtid = F.vcu * NTHR + F.tid, GT = F.G * NTHR;
    constexpr int I_IN = 16 * 72, I_OUT = 16 * 32, I_UP = 16 * 128, I_DN = 64 * 32, I_UQ = 3 * 12, I_UKV = 2 * 16, I_W1 = 32 * 4, I_W2 = 2 * 2;
    constexpr int PER_L = I_IN + I_OUT + I_UP + I_DN + I_UQ + I_UKV + 2 * I_W1 + 2 * I_W2;
    for (int it = gw; it < DEPTH * PER_L; it += NGW) {
        const int l = it / PER_L; int r = it - l * PER_L;
        unsigned char* wb = F.ws + WS_W + (size_t)l * WS_WL;
        if (r < I_IN) { transpose_item<1>(a.in[6] + (size_t)l * D * DIN, DIN, (bf16*)(wb + W_IN), D, nullptr, scr, r, F.lane); continue; } r -= I_IN;
        if (r < I_OUT) { transpose_item<0>(a.in[7] + (size_t)l * D * D, D, (bf16*)(wb + W_OUT), D, nullptr, scr, r, F.lane); continue; } r -= I_OUT;
        if (r < I_UP) { transpose_item<0>(a.in[19] + (size_t)l * D * DFF, DFF, (bf16*)(wb + W_UP), D, nullptr, scr, r, F.lane); continue; } r -= I_UP;
        if (r < I_DN) { transpose_item<0>(a.in[20] + (size_t)l * DFF * D, D, (bf16*)(wb + W_DN), DFF, nullptr, scr, r, F.lane); continue; } r -= I_DN;
        if (r < I_UQ) { transpose_item<2>(a.in[11] + (size_t)l * 192 * 384, 384, (bf16*)(wb + W_UQ), 256, a.in[9] + l * 192, scr, r, F.lane); continue; } r -= I_UQ;
        if (r < I_UKV) { transpose_item<0>(a.in[12] + (size_t)l * 128 * 512, 512, (bf16*)(wb + W_UKV), 256, a.in[10] + l * 128, scr, r, F.lane); continue; } r -= I_UKV;
        if (r < I_W1) { transpose_item<0>(a.in[15] + (size_t)l * 2048 * 128, 128, (bf16*)(wb + W_1K), 2048, nullptr, scr, r, F.lane); continue; } r -= I_W1;
        if (r < I_W1) { transpose_item<0>(a.in[17] + (size_t)l * 2048 * 128, 128, (bf16*)(wb + W_1V), 2048, nullptr, scr, r, F.lane); continue; } r -= I_W1;
        if (r < I_W2) { transpose_item<0>(a.in[16] + (size_t)l * 128 * 64, 64, (bf16*)(wb + W_2K), 128, nullptr, scr, r, F.lane); continue; } r -= I_W2;
        transpose_item<0>(a.in[18] + (size_t)l * 128 * 64, 64, (bf16*)(wb + W_2V), 128, nullptr, scr, r, F.lane);
    }
    for (int l = 0; l < DEPTH; ++l) {
        unsigned char* wb = F.ws + WS_W + (size_t)l * WS_WL;
        zero_fill16((bf16*)(wb + W_IN) + (size_t)1516 * D, 4 * D / 8, gtid, GT);
        zero_fill16((bf16*)(wb + W_IN) + (size_t)2288 * D, 16 * D / 8, gtid, GT);
        zero_fill16((bf16*)(wb + W_UQ) + (size_t)384 * 256, 128 * 256 / 8, gtid, GT);
        for (int i = gtid; i < 384 * 8; i += GT) ((GAS v4u*)((bf16*)(wb + W_UQ) + (size_t)(i >> 3) * 256 + 192))[i & 7] = (v4u){0u, 0u, 0u, 0u};
        for (int i = gtid; i < 512 * 16; i += GT) ((GAS v4u*)((bf16*)(wb + W_UKV) + (size_t)(i >> 4) * 256 + 128))[i & 15] = (v4u){0u, 0u, 0u, 0u};
    }
    { float* rt = (float*)(F.ws + WS_ROPE);
      for (int i = gtid; i < SEQ * 16; i += GT) { const int ii = i & 15, t = i >> 4; const float freq = powf(10000.f, -(float)ii / 16.f), ang = (float)t * freq; rt[2 * i] = cosf(ang); rt[2 * i + 1] = sinf(ang); } }
    { float* pp = (float*)(F.ws + WS_POSP);
      for (int i = gtid; i < DEPTH * 2 * 32 * 128; i += GT) { const int j = i & 127, kr = (i >> 7) & 31, wh = (i >> 12) & 1, l = i >> 13;
          const float* pos = a.in[wh ? 14 : 13] + l * 2048 + kr * 64; const float* w1 = a.in[wh ? 17 : 15] + (size_t)l * 2048 * 128 + (size_t)kr * 64 * 128 + j;
          float s = 0.f;
#pragma unroll 8
          for (int k = 0; k < 64; ++k) s += pos[k] * w1[(size_t)k * 128];
          pp[i] = s; } }
    { LAS float* sc = (LAS float*)(F.lds);
      LAS float* part = (LAS float*)(F.lds + 16384);
      __syncthreads();
      bool have = false;
      for (int it = F.vcu; it < DEPTH * 96; it += F.G) {
          if (!have) { for (int i = F.tid; i < NB * D; i += NTHR) { const float cv = a.in[1][i]; sc[i] = cv / (1.f + expf(-cv)); } have = true; __syncthreads(); }
          const int l = it / 96, ch = it % 96; const int j = ch * 64 + F.lane;
          const float* w = a.in[4] + (size_t)l * D * 6 * D + j;
          float acc[4] = {0.f, 0.f, 0.f, 0.f};
#pragma unroll 8
          for (int k = 128 * F.wave; k < 128 * F.wave + 128; ++k) { const float wv = w[(size_t)k * 6 * D]; acc[0] += sc[k] * wv; acc[1] += sc[D + k] * wv; acc[2] += sc[2 * D + k] * wv; acc[3] += sc[3 * D + k] * wv; }
#pragma unroll
          for (int b = 0; b < 4; ++b) part[(F.wave * 4 + b) * 64 + F.lane] = acc[b];
          __syncthreads();
          if (F.tid < 256) { const int b = F.tid >> 6, ln = F.tid & 63; float s = a.in[5][l * 6 * D + ch * 64 + ln];
#pragma unroll
              for (int w8 = 0; w8 < 8; ++w8) s += part[(w8 * 4 + b) * 64 + ln];
              ((float*)(F.ws + WS_MOD))[((size_t)l * NB + b) * 6 * D + ch * 64 + ln] = s; }
          __syncthreads();
      } }
}

#undef a
template <int MODE> __device__ __forceinline__ void p_norm(Frame& F, const float* x, const float* g, const float* modsh, const float* modsc, bf16* hout, float* fout) {
    const int gw = F.vcu * NWAVES + F.wave, NGW = F.G * NWAVES;
    for (int blk = gw; blk < M / 16; blk += NGW) {
        const int row0 = blk * 16, b = row0 >> 13;
        f32x4 ga[4], sh[4];
#pragma unroll
        for (int j = 0; j < 4; ++j) { const int c = 4 * F.lane + 256 * j; ga[j] = *(const f32x4*)(g + c);
            if (MODE == 0) { const f32x4 s = *(const f32x4*)(modsc + (size_t)b * 6 * D + c); ga[j] = ga[j] * (s + 1.0f); sh[j] = *(const f32x4*)(modsh + (size_t)b * 6 * D + c); } }
        for (int rr = 0; rr < 16; ++rr) {
            const int row = row0 + rr;
            const GAS f32x4* xr = (const GAS f32x4*)(x + (size_t)row * D) + F.lane;
            f32x4 v[4]; float s = 0.f;
#pragma unroll
            for (int j = 0; j < 4; ++j) { v[j] = xr[64 * j]; s += (v[j].x * v[j].x + v[j].y * v[j].y) + (v[j].z * v[j].z + v[j].w * v[j].w); }
            const float r = rsqrtf(wave_sum(s) * (1.f / D) + RMS_EPS);
            if (MODE == 0) { GAS unsigned long long* o8 = (GAS unsigned long long*)(hout + (size_t)row * D) + F.lane;
#pragma unroll
                for (int j = 0; j < 4; ++j) { const f32x4 y = v[j] * r * ga[j] + sh[j]; o8[64 * j] = (unsigned long long)pk2(y.x, y.y) | ((unsigned long long)pk2(y.z, y.w) << 32); } }
            else { GAS f32x4* o = (GAS f32x4*)(fout + (size_t)row * D) + F.lane;
#pragma unroll
                for (int j = 0; j < 4; ++j) o[64 * j] = v[j] * r * ga[j]; }
        }
    }
}

__device__ __forceinline__ void p_prep(Frame& F, int l) {
    const int gw = F.vcu * NWAVES + F.wave, NGW = F.G * NWAVES;
    const bf16* Z = (const bf16*)(F.ws + WS_Z); bf16* KM = (bf16*)(F.ws + WS_KM);
    float* rsq = (float*)(F.ws + WS_RSQ); float* rskv = (float*)(F.ws + WS_RSKV); const float* rope = (const float*)(F.ws + WS_ROPE);
    for (int row = gw; row < M; row += NGW) {
        const bf16* zr = Z + (size_t)row * ZLD;
        const float a0 = bf2f(zr[ZB_CQ + F.lane]), a1 = bf2f(zr[ZB_CQ + 64 + F.lane]), a2 = bf2f(zr[ZB_CQ + 128 + F.lane]);
        const float b0 = bf2f(zr[ZB_CKV + F.lane]), b1 = bf2f(zr[ZB_CKV + 64 + F.lane]);
        const float sq = wave_sum(a0 * a0 + a1 * a1 + a2 * a2), skv = wave_sum(b0 * b0 + b1 * b1);
        if (F.lane == 0) { rsq[row] = rsqrtf(sq * (1.f / 192.f) + RMS_EPS); rskv[row] = rsqrtf(skv * (1.f / 128.f) + RMS_EPS); }
        if (F.lane < 16) { const unsigned pr = *(const unsigned*)(zr + ZB_PE + 2 * F.lane); const float x1 = bf2f((unsigned short)(pr & 0xffffu)), x2 = bf2f((unsigned short)(pr >> 16));
            const float cs = rope[((size_t)(row & 8191) * 16 + F.lane) * 2], sn = rope[((size_t)(row & 8191) * 16 + F.lane) * 2 + 1];
            const unsigned o = pk2(x1 * cs - x2 * sn, x1 * sn + x2 * cs);
#pragma unroll
            for (int hd = 0; hd < 4; ++hd) *(unsigned*)(KM + (size_t)row * 384 + hd * 96 + 64 + 2 * F.lane) = o; }
    }
    { bf16* KMH = (bf16*)(F.ws + WS_KMH); bf16* KML = (bf16*)(F.ws + WS_KML);
      for (int it = gw; it < NB * 4 * 32; it += NGW) { const int j = it & 31, hd = (it >> 5) & 3, b = it >> 7; const int ts = F.lane >> 3, ch = F.lane & 7;
          float acc[8] = {0.f, 0.f, 0.f, 0.f, 0.f, 0.f, 0.f, 0.f};
          for (int i = 0; i < 32; ++i) { const v4u w = *(const v4u*)(Z + (size_t)(b * SEQ + j * 256 + 8 * i + ts) * ZLD + ZD_K + hd * 64 + ch * 8);
#pragma unroll
              for (int e = 0; e < 4; ++e) { acc[2 * e] += __uint_as_float(w[e] << 16); acc[2 * e + 1] += __uint_as_float(w[e] & 0xffff0000u); } }
#pragma unroll
          for (int e = 0; e < 8; ++e) { acc[e] += __shfl_xor(acc[e], 8); acc[e] += __shfl_xor(acc[e], 16); acc[e] += __shfl_xor(acc[e], 32); }
          if (F.lane < 8) { unsigned hi[4], lo[4];
#pragma unroll
              for (int e = 0; e < 4; ++e) { const float m0 = acc[2 * e] * (1.f / 256.f), m1 = acc[2 * e + 1] * (1.f / 256.f); const unsigned h0 = f2bf(m0), h1 = f2bf(m1);
                  hi[e] = h0 | (h1 << 16); lo[e] = pk2(m0 - __uint_as_float(h0 << 16), m1 - __uint_as_float(h1 << 16)); }
              *(v4u*)(KMH + (size_t)it * 64 + ch * 8) = (v4u){hi[0], hi[1], hi[2], hi[3]}; *(v4u*)(KML + (size_t)it * 64 + ch * 8) = (v4u){lo[0], lo[1], lo[2], lo[3]}; } } }
    if (gw == 0) { const float* pp = (const float*)(F.ws + WS_POSP) + (size_t)l * 2 * 32 * 128; float* pb = (float*)(F.ws + WS_POSB) + l * 256;
        for (int i = F.lane; i < 256; i += 64) { const int j = i & 127, wh = i >> 7; float s = 0.f; for (int kr = 0; kr < 32; ++kr) s += pp[(wh * 32 + kr) * 128 + j]; pb[i] = s; } }
}

__device__ __forceinline__ float gelu_tanh(float x) { const float u = 0.7978845608028654f * (x + 0.044715f * x * x * x); const float e = __expf(2.f * u); return x * (1.f - 1.f / (e + 1.f)); }
__device__ __forceinline__ void p_compress(Frame& F, int l) {
    const bf16* Z = (const bf16*)(F.ws + WS_Z);
    unsigned char* wb = F.ws + WS_W + (size_t)l * WS_WL;
    LAS float* red = (LAS float*)F.lds;
    const int r = F.lane & 31, h = F.lane >> 5;
    for (int it = F.vcu; it < NB * 16 * 2; it += F.G) {
        const int which = it & 1, itile = (it >> 1) & 15, b = it >> 5;
        const bf16* W1T = (const bf16*)(wb + (which ? W_1V : W_1K)); const bf16* W2T = (const bf16*)(wb + (which ? W_2V : W_2K));
        const int coff = which ? ZC_VC : ZC_KC;
        f32x16 acc[4] = {f32x16{}, f32x16{}, f32x16{}, f32x16{}};
        const bf16* brow = Z + (size_t)(b * SEQ + 16 * (32 * itile + r)) * ZLD + coff + 8 * h;
#pragma unroll 2
        for (int ks = 0; ks < 16; ++ks) { const int tt = 4 * F.wave + (ks >> 2), d0 = ks & 3;
            const bf16x8 bf = *(const bf16x8*)(brow + (size_t)tt * ZLD + d0 * 16);
#pragma unroll
            for (int hb = 0; hb < 4; ++hb) { const bf16x8 af = *(const bf16x8*)(W1T + (size_t)(hb * 32 + r) * 2048 + tt * 64 + d0 * 16 + 8 * h);
                acc[hb] = __builtin_amdgcn_mfma_f32_32x32x16_bf16(af, bf, acc[hb], 0, 0, 0); } }
#pragma unroll
        for (int hb = 0; hb < 4; ++hb)
#pragma unroll
            for (int v = 0; v < 16; ++v) red[((F.wave * 4 + hb) * 16 + v) * 64 + F.lane] = acc[hb][v];
        __syncthreads();
        if (F.wave < 2) {
            const float* pb = (const float*)(F.ws + WS_POSB) + l * 256 + which * 128;
            f32x16 o = f32x16{};
#pragma unroll
            for (int hb = 0; hb < 4; ++hb) { float x[16];
#pragma unroll
                for (int v = 0; v < 16; ++v) { float s = pb[hb * 32 + (v & 3) + 8 * (v >> 2) + 4 * h];
#pragma unroll
                    for (int w8 = 0; w8 < 8; ++w8) s += red[((w8 * 4 + hb) * 16 + v) * 64 + F.lane];
                    x[v] = gelu_tanh(s); }
#pragma unroll
                for (int s2 = 0; s2 < 2; ++s2) {
                    v4u pw; pw.x = fa::cvtpk(x[8 * s2], x[8 * s2 + 1]); pw.y = fa::cvtpk(x[8 * s2 + 2], x[8 * s2 + 3]); pw.z = fa::cvtpk(x[8 * s2 + 4], x[8 * s2 + 5]); pw.w = fa::cvtpk(x[8 * s2 + 6], x[8 * s2 + 7]);
                    const bf16* wr = W2T + (size_t)(F.wave * 32 + r) * 128 + hb * 32 + 16 * s2 + 4 * h;
                    const v2u a0 = *(const v2u*)wr, a1 = *(const v2u*)(wr + 8);
                    const v4u aw = (v4u){a0.x, a0.y, a1.x, a1.y};
                    o = __builtin_amdgcn_mfma_f32_32x32x16_bf16(__builtin_bit_cast(bf16x8, aw), __builtin_bit_cast(bf16x8, pw), o, 0, 0, 0); } }
            bf16* dst = (bf16*)(F.ws + (which ? WS_VCMP : WS_KCMP)) + (size_t)(b * 512 + 32 * itile + r) * 64 + F.wave * 32 + 4 * h;
#pragma unroll
            for (int g = 0; g < 4; ++g) { v2u w; w.x = fa::cvtpk(o[4 * g], o[4 * g + 1]); w.y = fa::cvtpk(o[4 * g + 2], o[4 * g + 3]); *(v2u*)(dst + 8 * g) = w; }
        }
        __syncthreads();
    }
}
using fa::bf16x8;
__device__ __forceinline__ unsigned char* launder_ptr(unsigned char* p) { const unsigned long long v = (unsigned long long)p; unsigned lo = __builtin_amdgcn_readfirstlane((unsigned)v), hi = __builtin_amdgcn_readfirstlane((unsigned)(v >> 32)); asm volatile("" : "+s"(lo), "+s"(hi)); return (unsigned char*)(((unsigned long long)hi << 32) | lo); }
#define UNIT_BEGIN() Frame F = F0; { int tid_ = F0.tid; asm volatile("" : "+v"(tid_)); int bx_ = __builtin_amdgcn_readfirstlane(F0.bx); asm volatile("" : "+s"(bx_)); \
    F.ws = launder_ptr(F0.ws); F.tid = tid_; F.lane = tid_ & 63; F.wave = __builtin_amdgcn_readfirstlane(tid_ >> 6); F.bx = bx_; }
__device__ __forceinline__ void u_mla(const Frame& F0, int b, int hd, int u) {
    UNIT_BEGIN();
    GAS char* ws = (GAS char*)F.ws;
    const int r = F.lane & 31, h = F.lane >> 5, q0 = 256 * u, wq0 = q0 + 32 * F.wave, tq = wq0 + r;
    bf16x8 qf[6]; { const unsigned qrow = (unsigned)WS_QM + (unsigned)(b * SEQ + tq) * 1024u;
      const float rs = *(const GAS float*)(ws + ((unsigned)WS_RSQ + (unsigned)(b * SEQ + tq) * 4u));
#pragma unroll
      for (int d0 = 0; d0 < 4; ++d0) { const fa::u32x4 raw = *(const GAS fa::u32x4*)(ws + (qrow + (unsigned)(hd * 128 + d0 * 32 + 16 * h))); fa::u32x4 o;
          o.x = fa::cvtpk(__uint_as_float(raw.x << 16) * rs, __uint_as_float(raw.x & 0xffff0000u) * rs); o.y = fa::cvtpk(__uint_as_float(raw.y << 16) * rs, __uint_as_float(raw.y & 0xffff0000u) * rs);
          o.z = fa::cvtpk(__uint_as_float(raw.z << 16) * rs, __uint_as_float(raw.z & 0xffff0000u) * rs); o.w = fa::cvtpk(__uint_as_float(raw.w << 16) * rs, __uint_as_float(raw.w & 0xffff0000u) * rs);
          qf[d0] = __builtin_bit_cast(bf16x8, o); }
#pragma unroll
      for (int d0 = 0; d0 < 2; ++d0) {
          const fa::u32x4 raw = *(const GAS fa::u32x4*)(ws + (qrow + (unsigned)(512 + hd * 64 + d0 * 32 + 16 * h)));
          const GAS float* rp = (const GAS float*)(ws + ((unsigned)WS_ROPE + (unsigned)((tq * 16 + d0 * 8 + 4 * h) * 8)));
          const fa::f32x4v r0 = *(const GAS fa::f32x4v*)rp * rs, r1 = *(const GAS fa::f32x4v*)(rp + 4) * rs;
          fa::u32x4 o;
          { const float x1 = __uint_as_float(raw.x << 16), x2 = __uint_as_float(raw.x & 0xffff0000u); o.x = fa::cvtpk(x1 * r0[0] - x2 * r0[1], x1 * r0[1] + x2 * r0[0]); }
          { const float x1 = __uint_as_float(raw.y << 16), x2 = __uint_as_float(raw.y & 0xffff0000u); o.y = fa::cvtpk(x1 * r0[2] - x2 * r0[3], x1 * r0[3] + x2 * r0[2]); }
          { const float x1 = __uint_as_float(raw.z << 16), x2 = __uint_as_float(raw.z & 0xffff0000u); o.z = fa::cvtpk(x1 * r1[0] - x2 * r1[1], x1 * r1[1] + x2 * r1[0]); }
          { const float x1 = __uint_as_float(raw.w << 16), x2 = __uint_as_float(raw.w & 0xffff0000u); o.w = fa::cvtpk(x1 * r1[2] - x2 * r1[3], x1 * r1[3] + x2 * r1[2]); }
          qf[4 + d0] = __builtin_bit_cast(bf16x8, o); } }
    SM st; fa::sm_init(st);
    LAS char* lds = (LAS char*)F.lds;
    fa::fa_loop<96, false>(st, qf, ws, (unsigned)WS_KM + (unsigned)b * (SEQ * 768u) + (unsigned)hd * 192u, 768u, (unsigned)WS_VM + (unsigned)b * (SEQ * 512u) + (unsigned)hd * 128u, 512u, SEQ - 1, 4 * u + 4,
        [](int t) { return 64 * t; },
        [=](int t, bool& act, bool& ew, float& cb, int& lo, int& hi) { const int key0 = 64 * t; act = key0 <= wq0 + 31; ew = key0 + 63 > wq0; cb = 0.f; lo = -100000; hi = tq - key0; },
        0.f, lds + FA_STAGES, F.tid, F.lane);
    f32x16 acc[2] = {f32x16{}, f32x16{}}; fa::sm_finish(st, 1.f, acc);
    fa::store_out(acc, lds + FA_OST + F.wave * 32 * fa::OSTR, ws, [=](int col) { return (unsigned)WS_O + (unsigned)(b * SEQ + wq0 + col) * 2048u + (unsigned)(256 + hd * 64) * 2u; }, F.lane);
}
__device__ __forceinline__ void u_moba(const Frame& F0, int b, int hd, int i) {
    UNIT_BEGIN();
    GAS char* ws = (GAS char*)F.ws;
    const int r = F.lane & 31, h = F.lane >> 5, q0 = 256 * i, wq0 = q0 + 32 * F.wave, tq = wq0 + r;
    bf16x8 qf[4]; fa::load_q<64>(qf, ws, (unsigned)WS_Z + (unsigned)(b * SEQ + tq) * (ZLD * 2u) + (unsigned)(ZD_Q + hd * 64) * 2u, h);
    unsigned bits = 0u;
    if (i > 0) {
        const GAS bf16* KMH = (const GAS bf16*)(ws + ((unsigned)WS_KMH + (unsigned)(((b * 4 + hd) * 32 + r) * 64 + 8 * h) * 2u)); const GAS bf16* KML = (const GAS bf16*)(ws + ((unsigned)WS_KML + (unsigned)(((b * 4 + hd) * 32 + r) * 64 + 8 * h) * 2u));
        f32x16 g = f32x16{};
#pragma unroll
        for (int d0 = 0; d0 < 4; ++d0) { const bf16x8 ah = *(const GAS bf16x8*)(KMH + d0 * 16), al = *(const GAS bf16x8*)(KML + d0 * 16);
            g = __builtin_amdgcn_mfma_f32_32x32x16_bf16(ah, qf[d0], g, 0, 0, 0); g = __builtin_amdgcn_mfma_f32_32x32x16_bf16(al, qf[d0], g, 0, 0, 0); }
        float og[16];
#pragma unroll
        for (int v = 0; v < 16; ++v) { const int j = (v & 3) + 8 * (v >> 2) + 4 * h; if (j >= i) g[v] = -INFINITY; og[v] = __shfl_xor(g[v], 32); }
#pragma unroll
        for (int v = 0; v < 16; ++v) { const int j = (v & 3) + 8 * (v >> 2) + 4 * h; int rank = 0;
#pragma unroll
            for (int w = 0; w < 16; ++w) { const int jm = (w & 3) + 8 * (w >> 2) + 4 * h, jo = (w & 3) + 8 * (w >> 2) + 4 * (1 - h);
                rank += (g[w] > g[v] || (g[w] == g[v] && jm < j)) ? 1 : 0; rank += (og[w] > g[v] || (og[w] == g[v] && jo < j)) ? 1 : 0; }
            if (rank < 3 && j < i) bits |= 1u << j; }
        bits |= __shfl_xor(bits, 32);
    }
    const float sl = slope2_of(2 + 3 * hd);
    LAS char* lds = (LAS char*)F.lds;
    LAS char* Qimg = lds + MB_Q;
    LAS float* Ost = (LAS float*)(lds + MB_O);
    LAS float* MLst = (LAS float*)(lds + MB_ML);
    LAS unsigned* cnt = (LAS unsigned*)(lds + MB_CNT);
    LAS unsigned char* lst = (LAS unsigned char*)(lds + MB_LST);
    const unsigned koff = (unsigned)WS_Z + (unsigned)b * (SEQ * ZLD * 2u) + (unsigned)(ZD_K + hd * 64) * 2u, voff = (unsigned)WS_Z + (unsigned)b * (SEQ * ZLD * 2u) + (unsigned)(ZD_V + hd * 64) * 2u;
    if (F.tid < 32) cnt[F.tid] = 0u;
#pragma unroll
    for (int d0 = 0; d0 < 4; ++d0) *(LAS bf16x8*)(Qimg + (32 * F.wave + r) * 128 + d0 * 32 + h * 16) = qf[d0];
    {
        SM st; fa::sm_init(st);
        fa::fa_loop<64, true>(st, qf, ws, koff, ZLD * 2u, voff, ZLD * 2u, SEQ - 1, 4,
            [=](int t) { return q0 + 64 * t; },
            [=](int t, bool& act, bool& ew, float& cb, int& lo, int& hi) { const int key0 = q0 + 64 * t; act = key0 <= wq0 + 31; ew = key0 + 63 > wq0; cb = sl * (float)(64 * t + 4 * h); lo = -100000; hi = tq - key0; },
            sl, lds + FA_STAGES, F.tid, F.lane);
        const float lt = fa::xhalf_sum(st.l);
        LAS float* orow = Ost + (32 * F.wave + r) * 64;
#pragma unroll
        for (int db = 0; db < 2; ++db)
#pragma unroll
            for (int g = 0; g < 4; ++g) *(LAS fa::f32x4v*)(orow + 32 * db + 8 * g + 4 * h) = (fa::f32x4v){st.o[db][4 * g], st.o[db][4 * g + 1], st.o[db][4 * g + 2], st.o[db][4 * g + 3]};
        if (h == 0) { MLst[(32 * F.wave + r) * 2] = st.m; MLst[(32 * F.wave + r) * 2 + 1] = lt; }
    }
    if (h == 0) { unsigned bb = bits;
        while (bb) { const int j = __ffs(bb) - 1; bb &= bb - 1u; const unsigned slot = __hip_atomic_fetch_add(&cnt[j], 1u, __ATOMIC_RELAXED, __HIP_MEMORY_SCOPE_WORKGROUP); lst[j * 256 + slot] = (unsigned char)(32 * F.wave + r); } }
    LDS_WAIT(); __syncthreads();
    const int ntile = 4 * i;
    if (ntile > 0) {
        fa::Stg<64> sg;
        fa::stg_load<64>(sg, ws, koff, ZLD * 2u, voff, ZLD * 2u, 0, SEQ - 1, F.tid); fa::stg_store<64>(sg, lds + FA_STAGES, F.tid); __syncthreads();
        SM st; fa::sm_init(st); bf16x8 qfb[4] = {qf[0], qf[1], qf[2], qf[3]}; bool myact = false, colv = false; int qsel = 0;
        for (int t = 0; t < ntile; ++t) {
            const LAS char* buf = lds + FA_STAGES + (t & 1) * 16384;
            if (t + 1 < ntile) fa::stg_load<64>(sg, ws, koff, ZLD * 2u, voff, ZLD * 2u, 64 * (t + 1), SEQ - 1, F.tid);
            if ((t & 3) == 0) { const int j = t >> 2; const int n = (int)cnt[j]; myact = 32 * F.wave < n; colv = (32 * F.wave + r) < n; qsel = colv ? (int)lst[j * 256 + 32 * F.wave + r] : 0;
                if (myact) { fa::sm_init(st);
#pragma unroll
                    for (int d0 = 0; d0 < 4; ++d0) qfb[d0] = *(const LAS bf16x8*)(Qimg + qsel * 128 + d0 * 32 + h * 16); } }
            if (myact) { fa::f32x16 p0, p1; bf16x8 pf[4];
                fa::score_tile<64, true>(p0, p1, buf, qfb, colv ? sl * (float)(64 * t - q0 + 4 * h) : fa::MASKV, sl, F.lane);
                fa::sm_step(st, p0, p1, pf);
                fa::pv(st.o, buf + 8192, pf, F.lane);
                if ((t & 3) == 3) {
                    const float lp = fa::xhalf_sum(st.l);
                    if (colv) { const float ms = MLst[qsel * 2], ls = MLst[qsel * 2 + 1]; const float mn = fmaxf(ms, st.m), ea = fa::ex2(ms - mn), eb = fa::ex2(st.m - mn);
                        LAS float* orow = Ost + qsel * 64;
#pragma unroll
                        for (int db = 0; db < 2; ++db)
#pragma unroll
                            for (int g = 0; g < 4; ++g) { LAS fa::f32x4v* p = (LAS fa::f32x4v*)(orow + 32 * db + 8 * g + 4 * h); const fa::f32x4v o4 = *p;
                                *p = (fa::f32x4v){o4[0] * ea + st.o[db][4 * g] * eb, o4[1] * ea + st.o[db][4 * g + 1] * eb, o4[2] * ea + st.o[db][4 * g + 2] * eb, o4[3] * ea + st.o[db][4 * g + 3] * eb}; }
                        asm volatile("s_waitcnt lgkmcnt(0)" ::: "memory");
                        if (h == 0) { MLst[qsel * 2] = mn; MLst[qsel * 2 + 1] = ls * ea + lp * eb; } } } }
            if (t + 1 < ntile) fa::stg_store<64>(sg, lds + FA_STAGES + ((t + 1) & 1) * 16384, F.tid);
            __syncthreads();
        }
    }
    { const int q = 32 * F.wave + (F.lane >> 1), hf = F.lane & 1; const float inv = 1.f / fmaxf(MLst[q * 2 + 1], fa::TINYF);
      const LAS float* orow = Ost + q * 64 + 32 * hf;
      GAS char* dst = ws + ((unsigned)WS_O + (unsigned)(b * SEQ + q0 + q) * 2048u + (unsigned)(768 + hd * 64 + 32 * hf) * 2u);
#pragma unroll
      for (int c = 0; c < 4; ++c) { const fa::f32x4v x0 = *(const LAS fa::f32x4v*)(orow + 8 * c), x1 = *(const LAS fa::f32x4v*)(orow + 8 * c + 4);
          fa::u32x4 w; w.x = fa::cvtpk(x0[0] * inv, x0[1] * inv); w.y = fa::cvtpk(x0[2] * inv, x0[3] * inv); w.z = fa::cvtpk(x1[0] * inv, x1[1] * inv); w.w = fa::cvtpk(x1[2] * inv, x1[3] * inv);
          *(GAS fa::u32x4*)(dst + 16 * c) = w; } }
    LDS_WAIT(); __syncthreads();
}
__device__ __forceinline__ void u_swa(const Frame& F0, int b, int kvh, int u, const float* sinks) {
    UNIT_BEGIN();
    GAS char* ws = (GAS char*)F.ws;
    const int r = F.lane & 31, h = F.lane >> 5, q0 = 128 * u, wq0 = q0 + 16 * F.wave, tq = wq0 + (r >> 1), hd = kvh * 2 + (r & 1);
    bf16x8 qf[4]; fa::load_q<64>(qf, ws, (unsigned)WS_Z + (unsigned)(b * SEQ + tq) * (ZLD * 2u) + (unsigned)(ZA_Q + hd * 64) * 2u, h);
    const float sl = slope2_of(3 * hd);
    const int t0 = (2 * u - 2) > 0 ? (2 * u - 2) : 0, nt = 2 * u + 2 - t0;
    SM st; fa::sm_init(st);
    LAS char* lds = (LAS char*)F.lds;
    fa::fa_loop<64, true>(st, qf, ws, (unsigned)WS_Z + (unsigned)b * (SEQ * ZLD * 2u) + (unsigned)(ZA_K + kvh * 64) * 2u, ZLD * 2u, (unsigned)WS_Z + (unsigned)b * (SEQ * ZLD * 2u) + (unsigned)(ZA_V + kvh * 64) * 2u, ZLD * 2u, SEQ - 1, nt,
        [=](int t) { return 64 * (t0 + t); },
        [=](int t, bool& act, bool& ew, float& cb, int& lo, int& hi) { const int key0 = 64 * (t0 + t); act = (key0 <= wq0 + 15) && (key0 + 63 >= wq0 - 127); ew = true;
            cb = sl * (float)(key0 - q0 + 4 * h); lo = tq - 127 - key0; hi = tq - key0; },
        sl, lds + FA_STAGES, F.tid, F.lane);
    const float sk = sinks[hd] * LOG2E + sl * (float)(tq - q0), mf = fmaxf(st.m, sk), a = fa::ex2(st.m - mf);
    const float ltot = fa::xhalf_sum(st.l) * a + fa::ex2(sk - mf), inv = a / fmaxf(ltot, fa::TINYF);
    f32x16 acc[2]; acc[0] = st.o[0] * inv; acc[1] = st.o[1] * inv;
    fa::store_out(acc, lds + FA_OST + F.wave * 32 * fa::OSTR, ws, [=](int col) { return (unsigned)WS_O + (unsigned)(b * SEQ + wq0 + (col >> 1)) * 2048u + (unsigned)((kvh * 2 + (col & 1)) * 64) * 2u; }, F.lane);
}
__device__ __forceinline__ void u_nsa(const Frame& F0, int b, int qi) {
    UNIT_BEGIN();
    GAS char* ws = (GAS char*)F.ws;
    const unsigned KC = (unsigned)WS_KCMP + (unsigned)b * (512u * 128u), VC = (unsigned)WS_VCMP + (unsigned)b * (512u * 128u), ZB = (unsigned)WS_Z + (unsigned)b * (SEQ * ZLD * 2u);
    const int r = F.lane & 31, h = F.lane >> 5, q0 = 64 * qi, wq0 = q0 + 8 * F.wave, qloc = 8 * F.wave + (r >> 2), tq = q0 + qloc, hd = r & 3;
    const unsigned zrow_off = ZB + (unsigned)tq * (ZLD * 2u); const GAS bf16* zrow = (const GAS bf16*)(ws + zrow_off);
    bf16x8 qf[4]; fa::load_q<64>(qf, ws, zrow_off + (unsigned)(ZC_Q + hd * 64) * 2u, h);
    const float sl = slope2_of(1 + 3 * hd);
    const float g0 = 1.f / (1.f + __expf(-bf2f(zrow[ZC_GL + hd]))), g1 = 1.f / (1.f + __expf(-bf2f(zrow[ZC_GL + 4 + hd]))), g2 = 1.f / (1.f + __expf(-bf2f(zrow[ZC_GL + 8 + hd])));
    LAS char* lds = (LAS char*)F.lds;
    LAS float* impA = (LAS float*)(lds + FA_IMP) + F.wave * 1024;
    LAS float* impB = (LAS float*)(lds + FA_OST) + F.wave * 1024;
    LAS unsigned* selm = (LAS unsigned*)(lds + FA_SELM);
    LAS unsigned* um = (LAS unsigned*)(lds + FA_UM);
    LAS float* vals = (LAS float*)(lds + FA_VALS) + F.wave * 128;
    if (F.tid < 4) um[F.tid] = 0u;
    GAS fa::f32x4v* park = (GAS fa::f32x4v*)(ws + ((unsigned)WS_PARK + (unsigned)(((F.bx * NWAVES + F.wave) * 64 + F.lane) * 256)));
    const int ntc = ((4 * qi + 3) >> 6) + 1;
    const int cvis = (tq - 31) >> 4;
    const int cvis_min = (q0 - 31) >> 4;
    const float slc = 16.f * sl;
    SM st; fa::sm_init(st);
    fa::fa_loop<64, true>(st, qf, ws, KC, 128u, VC, 128u, 510, ntc,
        [](int t) { return 64 * t; },
        [=](int t, bool& act, bool& ew, float& cb, int& lo, int& hi) { const int c0 = 64 * t; act = true; ew = c0 + 63 > cvis_min; cb = slc * (float)(c0 - 4 * qi + 4 * h); lo = -100000; hi = cvis - c0; },
        slc, lds + FA_STAGES, F.tid, F.lane);
    { f32x16 t2[2] = {f32x16{}, f32x16{}}; fa::sm_finish(st, g0, t2);
#pragma unroll
      for (int v = 0; v < 4; ++v) { park[v] = (fa::f32x4v){t2[0][4 * v], t2[0][4 * v + 1], t2[0][4 * v + 2], t2[0][4 * v + 3]}; park[4 + v] = (fa::f32x4v){t2[1][4 * v], t2[1][4 * v + 1], t2[1][4 * v + 2], t2[1][4 * v + 3]}; } }
    {
        const float mfin = st.m, invl = 1.f / fmaxf(fa::xhalf_sum(st.l), fa::TINYF);
        constexpr int STG = fa::stage_bytes<64>();
        fa::Stg<64> sg;
        fa::stg_load<64>(sg, ws, KC, 128u, VC, 128u, 0, 510, F.tid); fa::stg_store<64>(sg, lds + FA_STAGES, F.tid); __syncthreads();
        for (int t = 0; t < ntc; ++t) {
            const LAS char* buf = lds + FA_STAGES + (t & 1) * STG;
            if (t + 1 < ntc) fa::stg_load<64>(sg, ws, KC, 128u, VC, 128u, 64 * (t + 1), 510, F.tid);
            const int c0 = 64 * t;
            f32x16 p0, p1; fa::score_tile<64, true>(p0, p1, buf, qf, slc * (float)(c0 - 4 * qi + 4 * h), slc, F.lane);
            if (c0 + 63 > cvis_min) fa::mask_ew(p0, p1, -100000, cvis - c0, h);
#pragma unroll
            for (int kh = 0; kh < 2; ++kh)
#pragma unroll
                for (int g = 0; g < 4; ++g) {
                    float e0, e1, e2, e3;
                    if (kh == 0) { e0 = fa::ex2(p0[4 * g] - mfin); e1 = fa::ex2(p0[4 * g + 1] - mfin); e2 = fa::ex2(p0[4 * g + 2] - mfin); e3 = fa::ex2(p0[4 * g + 3] - mfin); }
                    else { e0 = fa::ex2(p1[4 * g] - mfin); e1 = fa::ex2(p1[4 * g + 1] - mfin); e2 = fa::ex2(p1[4 * g + 2] - mfin); e3 = fa::ex2(p1[4 * g + 3] - mfin); }
                    e0 *= invl; e1 *= invl; e2 *= invl; e3 *= invl;
                    float s4 = ((e0 + e1) + e2) + e3;
                    s4 += __shfl_xor(s4, 1); s4 += __shfl_xor(s4, 2); e3 += __shfl_xor(e3, 1); e3 += __shfl_xor(e3, 2);
                    const int j = 16 * t + 8 * kh + 2 * g + h;
                    if (hd == 0) { impA[(r >> 2) * 128 + j] = s4; impB[(r >> 2) * 128 + j] = e3; }
                }
            if (t + 1 < ntc) fa::stg_store<64>(sg, lds + FA_STAGES + ((t + 1) & 1) * STG, F.tid);
            __syncthreads();
        }
    }
    {
        const int cur = qi;
        for (int qq = 0; qq < 8; ++qq) {
            unsigned long long m0, m1;
            if (cur < 16) { m0 = (cur >= 63) ? ~0ull : ((1ull << (cur + 1)) - 1ull); m1 = 0ull; }
            else {
                const int ja = F.lane, jb2 = F.lane + 64;
                const bool fca = (ja == 0 || ja == cur || ja == cur - 1), fcb = (jb2 == cur || jb2 == cur - 1);
                const float va = impA[qq * 128 + ja] + (ja > 0 ? impB[qq * 128 + ja - 1] : 0.f), vb = impA[qq * 128 + jb2] + impB[qq * 128 + jb2 - 1];
                const unsigned ka = (ja <= cur && !fca) ? (__float_as_uint(va) + 1u) : 0u, kb = (jb2 <= cur && !fcb) ? (__float_as_uint(vb) + 1u) : 0u;
                unsigned T = 0u;
                for (int bit = 31; bit >= 0; --bit) { const unsigned cand = T | (1u << bit); const int c = __popcll(__ballot(ka >= cand)) + __popcll(__ballot(kb >= cand)); if (c >= 13) T = cand; }
                if (T == 0u) T = 1u;
                const unsigned long long ga = __ballot(ka > T), gb = __ballot(kb > T), ea = __ballot(ka == T), eb = __ballot(kb == T);
                const int R = 13 - (__popcll(ga) + __popcll(gb)), na = __popcll(ea);
                const int pa = (int)__builtin_amdgcn_mbcnt_hi((unsigned)(ea >> 32), __builtin_amdgcn_mbcnt_lo((unsigned)ea, 0u)), pb = (int)__builtin_amdgcn_mbcnt_hi((unsigned)(eb >> 32), __builtin_amdgcn_mbcnt_lo((unsigned)eb, 0u));
                m0 = ga | __ballot(ka == T && pa < R) | 1ull; m1 = gb | __ballot(kb == T && (na + pb) < R);
                if (cur < 64) m0 |= 1ull << cur; else m1 |= 1ull << (cur - 64);
                if (cur - 1 < 64) m0 |= 1ull << (cur - 1); else m1 |= 1ull << (cur - 65);
            }
            if (F.lane == 0) { LAS unsigned* sp = selm + (8 * F.wave + qq) * 4; sp[0] = (unsigned)m0; sp[1] = (unsigned)(m0 >> 32); sp[2] = (unsigned)m1; sp[3] = (unsigned)(m1 >> 32);
                __hip_atomic_fetch_or(&um[0], (unsigned)m0, __ATOMIC_RELAXED, __HIP_MEMORY_SCOPE_WORKGROUP); __hip_atomic_fetch_or(&um[1], (unsigned)(m0 >> 32), __ATOMIC_RELAXED, __HIP_MEMORY_SCOPE_WORKGROUP); __hip_atomic_fetch_or(&um[2], (unsigned)m1, __ATOMIC_RELAXED, __HIP_MEMORY_SCOPE_WORKGROUP); __hip_atomic_fetch_or(&um[3], (unsigned)(m1 >> 32), __ATOMIC_RELAXED, __HIP_MEMORY_SCOPE_WORKGROUP); }
        }
        LDS_WAIT(); __syncthreads();
    }
    {
        const unsigned uw0 = um[0], uw1 = um[1], uw2 = um[2], uw3 = um[3];
        const LAS unsigned* selq = selm + qloc * 4;
        const int nsel = __builtin_amdgcn_readfirstlane(__popc(uw0) + __popc(uw1) + __popc(uw2) + __popc(uw3));
        LAS unsigned char* slist = (LAS unsigned char*)(lds + FA_VALS);
        if (F.tid < 128) { const int j = F.tid; const unsigned w = (j < 32) ? uw0 : (j < 64) ? uw1 : (j < 96) ? uw2 : uw3;
            if ((w >> (j & 31)) & 1u) { int pos = __popc(w & ((1u << (j & 31)) - 1u)); if (j >= 32) pos += __popc(uw0); if (j >= 64) pos += __popc(uw1); if (j >= 96) pos += __popc(uw2); slist[pos] = (unsigned char)j; } }
        LDS_WAIT(); __syncthreads();
        fa::sm_init(st);
        fa::fa_loop<64, true>(st, qf, ws, ZB + ZC_KS * 2u, ZLD * 2u, ZB + ZC_VS * 2u, ZLD * 2u, SEQ - 1, nsel,
            [=](int t) { return 64 * (int)slist[t]; },
            [=](int t, bool& act, bool& ew, float& cb, int& lo, int& hi) { const int j = (int)slist[t], key0 = 64 * j; const unsigned mw = selq[j >> 5];
                const bool on = (mw >> (j & 31)) & 1u; act = __any(on) != 0; ew = (j == qi); cb = on ? sl * (float)(key0 - q0 + 4 * h) : fa::MASKV; lo = -100000; hi = tq - key0; },
            sl, lds + FA_STAGES, F.tid, F.lane);
        { f32x16 t2[2] = {f32x16{}, f32x16{}}; fa::sm_finish(st, g1, t2);
#pragma unroll
          for (int v = 0; v < 4; ++v) { park[8 + v] = (fa::f32x4v){t2[0][4 * v], t2[0][4 * v + 1], t2[0][4 * v + 2], t2[0][4 * v + 3]}; park[12 + v] = (fa::f32x4v){t2[1][4 * v], t2[1][4 * v + 1], t2[1][4 * v + 2], t2[1][4 * v + 3]}; } }
    }
    {
        const int t0 = (qi - 8) > 0 ? (qi - 8) : 0, nt = qi + 1 - t0;
        fa::sm_init(st);
        fa::fa_loop<64, true>(st, qf, ws, ZB + ZC_KW * 2u, ZLD * 2u, ZB + ZC_VW * 2u, ZLD * 2u, SEQ - 1, nt,
            [=](int t) { return 64 * (t0 + t); },
            [=](int t, bool& act, bool& ew, float& cb, int& lo, int& hi) { const int j = t0 + t, key0 = 64 * j; act = true; ew = (j == qi) || (j == qi - 8);
                cb = sl * (float)(key0 - q0 + 4 * h); lo = tq - 511 - key0; hi = tq - key0; },
            sl, lds + FA_STAGES, F.tid, F.lane);
    }
    f32x16 acc[2] = {f32x16{}, f32x16{}}; fa::sm_finish(st, g2, acc);
#pragma unroll
    for (int v = 0; v < 4; ++v) { const fa::f32x4v a0 = park[v], a1 = park[8 + v], b0 = park[4 + v], b1 = park[12 + v];
#pragma unroll
        for (int e2 = 0; e2 < 4; ++e2) { acc[0][4 * v + e2] += a0[e2] + a1[e2]; acc[1][4 * v + e2] += b0[e2] + b1[e2]; } }
    fa::store_out(acc, lds + FA_OST + F.wave * 32 * fa::OSTR, ws, [=](int col) { return (unsigned)WS_O + (unsigned)(b * SEQ + wq0 + (col >> 2)) * 2048u + (unsigned)(512 + (col & 3) * 64) * 2u; }, F.lane);
}

__device__ __forceinline__ void p_attn(Frame& F, const float* sinks, int mskip) {
    const int id = F.vcu;
    if (F.G != 256) return;
    { const int bh = id >> 4, s = id & 15;
#pragma unroll 1
      for (int k = 0; k < (((mskip >> 9) & 1) ? 4 : 2); ++k) u_mla(F, bh >> 2, bh & 3, (k & 1) ? s : 31 - s); }
    { const int bh = id >> 4, s = id & 15;
#pragma unroll 1
      for (int k = 0; k < (((mskip >> 11) & 1) ? 4 : 2); ++k) u_moba(F, bh >> 2, bh & 3, (k & 1) ? s : 31 - s); }
    if (!(mskip & 4)) { const int b = id >> 6, s = id & 63;
#pragma unroll 1
      for (int k = 0; k < (((mskip >> 10) & 1) ? 4 : 2); ++k) u_nsa(F, b, (k & 1) ? s : 127 - s); }
    {
#pragma unroll 1
      for (int k = 0; k < (((mskip >> 8) & 1) ? 4 : 2); ++k) { const int u0 = 2 * id + (k & 1); u_swa(F, u0 >> 7, (u0 >> 6) & 1, u0 & 63, sinks); } }
}
constexpr int PH_PRO = 0, PH_L0 = 1, PH_PER_L = 9, PH_FIN = 19, PH_END = 20;
constexpr int PO_NORM1 = 0, PO_ZG = 1, PO_PREP = 2, PO_UP = 3, PO_ATTN = 4, PO_OG = 5, PO_NORM2 = 6, PO_UPG = 7, PO_DNG = 8;
#ifndef MK_PHASE_MASK
#define MK_PHASE_MASK 0xFFFFFu
#endif

__global__ void __launch_bounds__(NTHR, 2) mega(Args args) {
    extern __shared__ __attribute__((aligned(16))) unsigned char lds_raw[];
    Frame F;
    F.lds = (LAS unsigned char*)lds_raw;
    int wave_s = __builtin_amdgcn_readfirstlane((int)threadIdx.x >> 6); asm volatile("" : "+s"(wave_s));
    F.tid = threadIdx.x; F.lane = F.tid & 63; F.wave = wave_s;
    F.G = gridDim.x; { const int bx = blockIdx.x; F.vcu = (F.G % 8 == 0) ? (bx % 8) * (F.G / 8) + bx / 8 : bx; }
    volatile LAS unsigned* misc = (volatile LAS unsigned*)(F.lds + LDS_MISC);
    if (F.tid < 64) misc[F.tid] = 0u;
    __syncthreads();
    (void)xcd_barrier_post((unsigned*)(args.ws + WS_CTL), misc + 8);
    float* fo; KArgsP ap;
#define KARGS() ({ KArgsP q_ = (KArgsP)__builtin_amdgcn_kernarg_segment_ptr(); asm volatile("" : "+s"(q_)); q_; })
#define IN(k) ({ KArgsP q2_ = KARGS(); q2_->ph_lo <= (k) && (k) < q2_->ph_hi; })
#define PHASE_BEGIN() do { asm volatile("; PHASE_MARK %0" :: "i"(__LINE__)); ap = KARGS(); F.G = gridDim.x; \
        { int w_ = wave_s; asm volatile("" : "+s"(w_)); int t_ = (w_ << 6) | (int)__builtin_amdgcn_mbcnt_hi(~0u, __builtin_amdgcn_mbcnt_lo(~0u, 0u)); asm volatile("" : "+v"(t_)); F.tid = t_; F.lane = t_ & 63; F.wave = w_; } F.ws = ap->ws; int bx_ = (int)blockIdx.x; asm volatile("" : "+s"(bx_)); F.bx = bx_; F.vcu = (F.G % 8 == 0) ? (bx_ % 8) * (F.G / 8) + bx_ / 8 : bx_; fo = ap->out; } while (0)
#define INP(i) (ap->in[i])
#define SEAM(k) do { if (IN(k) && IN((k) + 1)) { XcdBarrier b_; b_.bar = (unsigned*)(KARGS()->ws + WS_CTL); b_.x = xb_xcc_id(); b_.st = (volatile LAS unsigned*)(F.lds + LDS_MISC) + 8; xcd_barrier(b_); } } while (0)

    if (IN(PH_PRO)) { PHASE_BEGIN(); p_prologue(F, ap); }
#ifdef MK_PRO_TWICE
    if (IN(PH_PRO)) { PHASE_BEGIN(); p_prologue(F, ap); }
#endif
    SEAM(PH_PRO);

    { constexpr int l = 0;
        const int pb = PH_L0 + PH_PER_L * l;
#define WB (F.ws + WS_W + (size_t)l * WS_WL)
#define MOD ((const float*)(F.ws + WS_MOD) + (size_t)l * NB * 6 * D)
#define XIN ((l == 0) ? INP(0) : (const float*)fo)
#define H ((bf16*)(F.ws + WS_H))
#define Z ((bf16*)(F.ws + WS_Z))
#define OB ((bf16*)(F.ws + WS_O))
#define U ((bf16*)(F.ws + WS_U))

        if (IN(pb + PO_NORM1) && !((KARGS()->skip >> PO_NORM1) & 1)) { PHASE_BEGIN(); p_norm<0>(F, XIN, INP(2) + l * D, MOD, MOD + D, H, nullptr); }
        SEAM(pb + PO_NORM1);

        if (IN(pb + PO_ZG) && !((KARGS()->skip >> PO_ZG) & 1)) { PHASE_BEGIN();
            pg8::Gemm g{H, (const bf16*)(WB + W_IN), M, ZLD, D, D}; pg8::StaticOrder S; S.init(M, ZLD, F.G, F.bx);
            pg8::EpiBf16<0> E{Z, ZLD, nullptr, 0, 0, 1.f};
            pg8::gemm_phase<pg8::EpiBf16<0>, pg8::StaticOrder, true, true>(F.lds, g, S, E, F.tid);
        }
        SEAM(pb + PO_ZG);

        if (IN(pb + PO_PREP) && !((KARGS()->skip >> PO_PREP) & 1)) { PHASE_BEGIN(); p_prep(F, l); }
        SEAM(pb + PO_PREP);

        if (IN(pb + PO_UP) && !((KARGS()->skip >> PO_UP) & 1)) { PHASE_BEGIN();
            { pg8::Gemm g{Z + ZB_CQ, (const bf16*)(WB + W_UQ), M, 512, 256, ZLD}; pg8::StaticOrder S; S.init(M, 512, F.G, F.bx);
              pg8::EpiBf16<0> E{(bf16*)(F.ws + WS_QM), 512, nullptr, 0, 0, 1.f};
              pg8::gemm_phase<pg8::EpiBf16<0>, pg8::StaticOrder, true, true>(F.lds, g, S, E, F.tid); }
            PHASE_BEGIN();
            { pg8::Gemm g{Z + ZB_CKV, (const bf16*)(WB + W_UKV), M, 512, 256, ZLD}; pg8::StaticOrder S; S.init(M, 512, F.G, F.bx);
              pg8::EpiMlaKV E{(bf16*)(F.ws + WS_KM), (bf16*)(F.ws + WS_VM), (const float*)(F.ws + WS_RSKV)};
              pg8::gemm_phase<pg8::EpiMlaKV, pg8::StaticOrder, true, false>(F.lds, g, S, E, F.tid); }
            PHASE_BEGIN();
            p_compress(F, l);
        }
        SEAM(pb + PO_UP);

        if (IN(pb + PO_ATTN) && !((KARGS()->skip >> PO_ATTN) & 1)) { PHASE_BEGIN(); p_attn(F, INP(8) + l * 4, (ap->skip >> 16) | ((ap->rep >> 20) << 8)); }
        SEAM(pb + PO_ATTN);

        if (IN(pb + PO_OG) && !((KARGS()->skip >> PO_OG) & 1)) { PHASE_BEGIN();
            pg8::Gemm g{OB, (const bf16*)(WB + W_OUT), M, D, D, D}; pg8::StaticOrder S; S.init(M, D, F.G, F.bx);
            pg8::EpiResid E{XIN, fo, MOD + 2 * D};
            pg8::gemm_phase<pg8::EpiResid, pg8::StaticOrder, true, true>(F.lds, g, S, E, F.tid);
        }
        SEAM(pb + PO_OG);

        if (IN(pb + PO_NORM2) && !((KARGS()->skip >> PO_NORM2) & 1)) { PHASE_BEGIN(); p_norm<0>(F, fo, INP(3) + l * D, MOD + 3 * D, MOD + 4 * D, H, nullptr); }
        SEAM(pb + PO_NORM2);

        if (IN(pb + PO_UPG) && !((KARGS()->skip >> PO_UPG) & 1)) { PHASE_BEGIN();
            pg8::Gemm g{H, (const bf16*)(WB + W_UP), M, DFF, D, D}; pg8::StaticOrder S; S.init(M, DFF, F.G, F.bx);
            pg8::EpiRelu2 E{U, DFF};
            pg8::gemm_phase<pg8::EpiRelu2, pg8::StaticOrder, true, true>(F.lds, g, S, E, F.tid);
        }
        SEAM(pb + PO_UPG);

        if (IN(pb + PO_DNG) && !((KARGS()->skip >> PO_DNG) & 1)) { PHASE_BEGIN();
            pg8::Gemm g{U, (const bf16*)(WB + W_DN), M, D, DFF, DFF}; pg8::StaticOrder S; S.init(M, D, F.G, F.bx);
            pg8::EpiResid E{fo, fo, MOD + 5 * D};
            pg8::gemm_phase<pg8::EpiResid, pg8::StaticOrder, true, true>(F.lds, g, S, E, F.tid);
        }
        SEAM(pb + PO_DNG);
    }
    { constexpr int l = 1;
        const int pb = PH_L0 + PH_PER_L * l;
#define WB (F.ws + WS_W + (size_t)l * WS_WL)
#define MOD ((const float*)(F.ws + WS_MOD) + (size_t)l * NB * 6 * D)
#define XIN ((l == 0) ? INP(0) : (const float*)fo)
#define H ((bf16*)(F.ws + WS_H))
#define Z ((bf16*)(F.ws + WS_Z))
#define OB ((bf16*)(F.ws + WS_O))
#define U ((bf16*)(F.ws + WS_U))

        if (IN(pb + PO_NORM1) && !((KARGS()->skip >> PO_NORM1) & 1)) { PHASE_BEGIN(); p_norm<0>(F, XIN, INP(2) + l * D, MOD, MOD + D, H, nullptr); }
        SEAM(pb + PO_NORM1);

        if (IN(pb + PO_ZG) && !((KARGS()->skip >> PO_ZG) & 1)) { PHASE_BEGIN();
            pg8::Gemm g{H, (const bf16*)(WB + W_IN), M, ZLD, D, D}; pg8::StaticOrder S; S.init(M, ZLD, F.G, F.bx);
            pg8::EpiBf16<0> E{Z, ZLD, nullptr, 0, 0, 1.f};
            pg8::gemm_phase<pg8::EpiBf16<0>, pg8::StaticOrder, true, true>(F.lds, g, S, E, F.tid);
        }
        SEAM(pb + PO_ZG);

        if (IN(pb + PO_PREP) && !((KARGS()->skip >> PO_PREP) & 1)) { PHASE_BEGIN(); p_prep(F, l); }
        SEAM(pb + PO_PREP);

        if (IN(pb + PO_UP) && !((KARGS()->skip >> PO_UP) & 1)) { PHASE_BEGIN();
            { pg8::Gemm g{Z + ZB_CQ, (const bf16*)(WB + W_UQ), M, 512, 256, ZLD}; pg8::StaticOrder S; S.init(M, 512, F.G, F.bx);
              pg8::EpiBf16<0> E{(bf16*)(F.ws + WS_QM), 512, nullptr, 0, 0, 1.f};
              pg8::gemm_phase<pg8::EpiBf16<0>, pg8::StaticOrder, true, true>(F.lds, g, S, E, F.tid); }
            PHASE_BEGIN();
            { pg8::Gemm g{Z + ZB_CKV, (const bf16*)(WB + W_UKV), M, 512, 256, ZLD}; pg8::StaticOrder S; S.init(M, 512, F.G, F.bx);
              pg8::EpiMlaKV E{(bf16*)(F.ws + WS_KM), (bf16*)(F.ws + WS_VM), (const float*)(F.ws + WS_RSKV)};
              pg8::gemm_phase<pg8::EpiMlaKV, pg8::StaticOrder, true, false>(F.lds, g, S, E, F.tid); }
            PHASE_BEGIN();
            p_compress(F, l);
        }
        SEAM(pb + PO_UP);

        if (IN(pb + PO_ATTN) && !((KARGS()->skip >> PO_ATTN) & 1)) { PHASE_BEGIN(); p_attn(F, INP(8) + l * 4, (ap->skip >> 16) | ((ap->rep >> 20) << 8)); }
        SEAM(pb + PO_ATTN);

        if (IN(pb + PO_OG) && !((KARGS()->skip >> PO_OG) & 1)) { PHASE_BEGIN();
            pg8::Gemm g{OB, (const bf16*)(WB + W_OUT), M, D, D, D}; pg8::StaticOrder S; S.init(M, D, F.G, F.bx);
            pg8::EpiResid E{XIN, fo, MOD + 2 * D};
            pg8::gemm_phase<pg8::EpiResid, pg8::StaticOrder, true, true>(F.lds, g, S, E, F.tid);
        }
        SEAM(pb + PO_OG);

        if (IN(pb + PO_NORM2) && !((KARGS()->skip >> PO_NORM2) & 1)) { PHASE_BEGIN(); p_norm<0>(F, fo, INP(3) + l * D, MOD + 3 * D, MOD + 4 * D, H, nullptr); }
        SEAM(pb + PO_NORM2);

        if (IN(pb + PO_UPG) && !((KARGS()->skip >> PO_UPG) & 1)) { PHASE_BEGIN();
            pg8::Gemm g{H, (const bf16*)(WB + W_UP), M, DFF, D, D}; pg8::StaticOrder S; S.init(M, DFF, F.G, F.bx);
            pg8::EpiRelu2 E{U, DFF};
            pg8::gemm_phase<pg8::EpiRelu2, pg8::StaticOrder, true, true>(F.lds, g, S, E, F.tid);
        }
        SEAM(pb + PO_UPG);

        if (IN(pb + PO_DNG) && !((KARGS()->skip >> PO_DNG) & 1)) { PHASE_BEGIN();
            pg8::Gemm g{U, (const bf16*)(WB + W_DN), M, D, DFF, DFF}; pg8::StaticOrder S; S.init(M, D, F.G, F.bx);
            pg8::EpiResid E{fo, fo, MOD + 5 * D};
            pg8::gemm_phase<pg8::EpiResid, pg8::StaticOrder, true, true>(F.lds, g, S, E, F.tid);
        }
        SEAM(pb + PO_DNG);
    }
    if (IN(PH_FIN)) { PHASE_BEGIN(); p_norm<1>(F, fo, INP(21), nullptr, nullptr, nullptr, fo); }
#undef IN
#undef SEAM
}
}
extern "C" void kernel_launch(void* const* d_in, const int* in_sizes, int n_in, void* d_out, int out_size, void* d_ws, size_t ws_size, hipStream_t stream) {
    using namespace mk;
    static int grid = 0;
    if (grid == 0) {
        int dev = 0, cus = 0;
        if (hipGetDevice(&dev) != hipSuccess || hipDeviceGetAttribute(&cus, hipDeviceAttributeMultiprocessorCount, dev) != hipSuccess) { grid = -1; return; }
        if (hipFuncSetAttribute((const void*)mega, hipFuncAttributeMaxDynamicSharedMemorySize, LDS_BYTES) != hipSuccess) { grid = -1; return; }
        (void)hipGetLastError();
        grid = cus;
    }
    if (grid < 0) return;
    (void)in_sizes; (void)n_in; (void)out_size; (void)ws_size;
    Args a{};
    for (int i = 0; i < 22; ++i) a.in[i] = (const float*)d_in[i];
    a.out = (float*)d_out; a.ws = (unsigned char*)d_ws; a.skip = 0; a.rep = MK_REP;
    auto launch = [&](int lo, int hi) {
        (void)hipMemsetAsync((char*)d_ws + WS_CTL, 0, CTL_ZERO_BYTES, stream);
        a.ph_lo = lo; a.ph_hi = hi;
        hipLaunchKernelGGL(mega, dim3(grid), dim3(NTHR), LDS_BYTES, stream, a);
    };
    launch(0, PH_END);
}
```

```cpp
#include <hip/hip_runtime.h>
#include <cstdio>
#include <cstdint>
#include <math.h>
#define FA_EXP 0
#define FA_PROBE 0
#define MK_PROBE_IDX 0
#define MK_MODE 0
#define MK_NAIVE_MASK 0
#define MK_SKIP 0
#define MK_SPLIT 0
#define MK_DBG_PHASE 0
#define MK_DBG_TEST 0
#define MK_REP 0
namespace pg8 {
#define PG8_LAS __attribute__((address_space(3)))
typedef unsigned short bf16_t;
typedef short bf16x8 __attribute__((ext_vector_type(8)));
typedef float f32x4 __attribute__((ext_vector_type(4)));
typedef unsigned u32x4 __attribute__((ext_vector_type(4)));
constexpr int BM = 256, BK = 64, HALF = 128, HTB = HALF * BK * 2  , STAGE_BYTES = 8 * HTB, NXCD = 8, WGM = 8;

__host__ __device__ __forceinline__ int lds_byte(int r, int c) { const int st = (r >> 4) * 2 + (c >> 5), rr = r & 15, cc = c & 31, ob = rr * 64 + cc * 2; return st * 1024 + (ob ^ (((ob >> 9) & 1) << 5)); }
__host__ __device__ __forceinline__ void stage_rc(int b, int& R, int& C) { const int st = b / 1024, sb = b % 1024, swz = sb ^ (((sb >> 9) & 1) << 5); R = (st >> 1) * 16 + swz / 64; C = (st & 1) * 32 + (swz % 64) / 2; }
__host__ __device__ __forceinline__ int perm32(int rho) { const int n = rho >> 4, i = rho & 15; return 8 * (i >> 2) + 4 * n + (i & 3); }

struct Unit { int pm, pn; };
struct Gemm { const bf16_t* A; const bf16_t* Bt; int M, N, K, lda; };

struct StaticOrder {
    int nM, nN, nwg, G, c;
    __host__ __device__ void init(int M, int N, int G_, int c_) { nM = M / BM; nN = N / BM; nwg = nM * nN; G = G_; c = c_; }
    __host__ __device__ bool next(int i, Unit& u) const {
        const long L = (long)i * G + c; if (L >= nwg) return false;
        int wgid = (int)L; { const int q = nwg / NXCD, r = nwg % NXCD, xcd = wgid % NXCD, off = wgid / NXCD; wgid = (xcd < r ? xcd * (q + 1) : r * (q + 1) + (xcd - r) * q) + off; }
        const int nig = WGM * nN, gid = wgid / nig, fm = gid * WGM, gsz = (nM - fm) < WGM ? (nM - fm) : WGM;
        u.pm = fm + ((wgid % nig) % gsz); u.pn = (wgid % nig) / gsz; return true;
    }
    __device__ __forceinline__ void a_ready(const Unit&) const {}
    __device__ __forceinline__ void done(const Unit&) const {}
};
__device__ __forceinline__ unsigned cvt_pk_bf16(float lo, float hi) { unsigned r; asm volatile("v_cvt_pk_bf16_f32 %0, %1, %2" : "=v"(r) : "v"(lo), "v"(hi)); return r; }
typedef float f32x2 __attribute__((ext_vector_type(2)));
__device__ __forceinline__ f32x2 gelu_pk(f32x2 v) {
    const f32x2 av = __builtin_elementwise_abs(v), d = av * 0.2316418882f + 1.0f;
    f32x2 t; t.x = __builtin_amdgcn_rcpf(d.x); t.y = __builtin_amdgcn_rcpf(d.y);
    f32x2 q = t * 0.5307027145f + (-0.7265760135f); q = q * t + 0.7107068705f; q = q * t + (-0.142248368f); q = q * t + 0.127414796f; q = q * t;
    const f32x2 s = (v * v) * (-0.72134752044f);
    f32x2 e; e.x = __builtin_amdgcn_exp2f(s.x); e.y = __builtin_amdgcn_exp2f(s.y);
    const f32x2 m = v * (q * e), r = v - m;
    f32x2 o; o.x = v.x < 0.f ? m.x : r.x; o.y = v.y < 0.f ? m.y : r.y; return o;
}

template <int ACT  > struct EpiBf16 {
    static constexpr bool PERM = true, AFTER_DRAIN = false; static_assert(ACT == 0 || ACT == 1, "EpiBf16: ACT is 0 (none) or 1 (gelu_pk)");
    bf16_t* O; int ldc; const float* bias; int split_cols; size_t split_stride; float scale0;
    __device__ __forceinline__ void operator()(const f32x4 (&acc)[2][2][4][2], const Unit& u, int wr, int wc, int fr, int fq) const {
        const int row0 = u.pm * BM + wr * 64 + fr; int colt = u.pn * BM; bf16_t* base = O;
        float sc = 1.f; if (split_cols) { const int t = colt / split_cols; base += (size_t)t * split_stride; colt -= t * split_cols; if (t == 0) sc = scale0; }
        const int col0 = colt + wc * 32 + 8 * fq, bcol0 = u.pn * BM + wc * 32 + 8 * fq;
        f32x4 bv[2][2];
#pragma unroll
        for (int bj = 0; bj < 2; ++bj)
#pragma unroll
            for (int n = 0; n < 2; ++n) bv[bj][n] = bias ? *(const f32x4*)(bias + bcol0 + bj * HALF + 4 * n) : (f32x4){0.f, 0.f, 0.f, 0.f};
#pragma unroll
        for (int ai = 0; ai < 2; ++ai)
#pragma unroll
            for (int m = 0; m < 4; ++m) { bf16_t* rowp = base + (size_t)(row0 + ai * HALF + m * 16) * ldc + col0;
#pragma unroll
                for (int bj = 0; bj < 2; ++bj) { f32x4 v0 = acc[ai][bj][m][0] + bv[bj][0], v1 = acc[ai][bj][m][1] + bv[bj][1];
                    if (ACT == 1) { f32x2 a = gelu_pk((f32x2){v0[0], v0[1]}), b = gelu_pk((f32x2){v0[2], v0[3]}), c = gelu_pk((f32x2){v1[0], v1[1]}), d = gelu_pk((f32x2){v1[2], v1[3]});
                        v0 = (f32x4){a.x, a.y, b.x, b.y}; v1 = (f32x4){c.x, c.y, d.x, d.y}; }
                    v0 = v0 * sc; v1 = v1 * sc; u32x4 w; w.x = cvt_pk_bf16(v0[0], v0[1]); w.y = cvt_pk_bf16(v0[2], v0[3]); w.z = cvt_pk_bf16(v1[0], v1[1]); w.w = cvt_pk_bf16(v1[2], v1[3]);
                    *(u32x4*)(rowp + bj * HALF) = w; } }
    }
};
template <class Epi, class Sched, bool ALIGN_EPI = false, bool SP2 = false>
__device__ __forceinline__ void gemm_phase(PG8_LAS unsigned char* lds, const Gemm g, const Sched& S, const Epi& E, int tid_in) {
    int tid_ = tid_in; asm volatile("" : "+v"(tid_));
    const int tid = tid_, wid = __builtin_amdgcn_readfirstlane(tid >> 6), lane = tid & 63, wr = wid >> 2, wc = wid & 3, fr = lane & 15, fq = lane >> 4;
    const int K = g.K, nt = K / BK;
    unsigned voffA[2], voffB[2];
#pragma unroll
    for (int i = 0; i < 2; ++i) { int R, C; stage_rc(tid * 16 + i * 8192, R, C); const int Rb = Epi::PERM ? ((R & ~31) + perm32(R & 31)) : R;
        voffA[i] = (unsigned)(R * g.lda + C) * 2u; voffB[i] = (unsigned)(Rb * K + C) * 2u; }
    const size_t kstep = (size_t)(BK * 2);
    const size_t hstep = (size_t)HALF * K * 2;
    const size_t tstep = 2 * hstep; const size_t hstepA = (size_t)HALF * g.lda * 2, tstepA = 2 * hstepA;
    const unsigned ldsw = (unsigned)wid * 1024u;
    const int aoff = lds_byte(wr * 64 + fr, fq * 8), boff = lds_byte(wc * 32 + fr, fq * 8);
#define PG8_SA(b, h) (((b) * 2 + (h)) * HTB)
#define PG8_SB(b, h) ((4 + (b) * 2 + (h)) * HTB)
#define PG8_STAGE(bufoff, gbase, voff) do { _Pragma("unroll") for (int _i = 0; _i < 2; ++_i) \
        __builtin_amdgcn_global_load_lds((const unsigned*)((const char*)(gbase) + (voff)[_i]), (PG8_LAS unsigned*)(lds + (bufoff) + ldsw + _i * 8192), 16, 0, 0); } while (0)
#define PG8_LDA(dst, b, h) do { _Pragma("unroll") for (int m = 0; m < 4; ++m) _Pragma("unroll") for (int k = 0; k < 2; ++k) dst[m][k] = *(const PG8_LAS bf16x8*)(lds + PG8_SA(b, h) + aoff + m * 2048 + k * 1024); } while (0)
#define PG8_LDB(dst, b, h) do { _Pragma("unroll") for (int n = 0; n < 2; ++n) _Pragma("unroll") for (int k = 0; k < 2; ++k) dst[n][k] = *(const PG8_LAS bf16x8*)(lds + PG8_SB(b, h) + boff + n * 2048 + k * 1024); } while (0)
#define PG8_MMA(ai, bj, At, Bt) do { __builtin_amdgcn_s_setprio(1); _Pragma("unroll") for (int m = 0; m < 4; ++m) _Pragma("unroll") for (int n = 0; n < 2; ++n) _Pragma("unroll") for (int k = 0; k < 2; ++k) \
        acc[ai][bj][m][n] = __builtin_amdgcn_mfma_f32_16x16x32_bf16(Bt[n][k], At[m][k], acc[ai][bj][m][n], 0, 0, 0); __builtin_amdgcn_s_setprio(0); } while (0)
#define PG8_WAIT_V(n) asm volatile("s_waitcnt vmcnt(" #n ")" ::: "memory")
#define PG8_WAIT_L(n) asm volatile("s_waitcnt lgkmcnt(" #n ")" ::: "memory")
#define PG8_BAR __builtin_amdgcn_s_barrier()
#define PG8_SCHED __builtin_amdgcn_sched_barrier(0)
    Unit cur, nxt; int ui = 0;
    if (!S.next(0, cur)) return;
    f32x4 acc[2][2][4][2];
#pragma unroll
    for (int a = 0; a < 2; ++a)
#pragma unroll
        for (int b = 0; b < 2; ++b)
#pragma unroll
            for (int m = 0; m < 4; ++m)
#pragma unroll
                for (int n = 0; n < 2; ++n) acc[a][b][m][n] = (f32x4){0.f, 0.f, 0.f, 0.f};
    bf16x8 At[4][2], B0[2][2], B1[2][2];
    const char* cA = (const char*)g.A + (size_t)cur.pm * tstepA; const char* cB = (const char*)g.Bt + (size_t)cur.pn * tstep;
    S.a_ready(cur);
    if constexpr (SP2) {
        PG8_STAGE(PG8_SB(0, 0), cB, voffB); PG8_STAGE(PG8_SB(0, 1), cB + hstep, voffB); PG8_STAGE(PG8_SA(0, 0), cA, voffA); PG8_STAGE(PG8_SA(0, 1), cA + hstepA, voffA);
        if (wr == 1) PG8_BAR;
        PG8_WAIT_V(2); PG8_BAR;
        PG8_STAGE(PG8_SB(1, 0), cB + kstep, voffB); PG8_STAGE(PG8_SA(1, 0), cA + kstep, voffA); PG8_STAGE(PG8_SB(1, 1), cB + hstep + kstep, voffB);
        PG8_WAIT_V(6); PG8_BAR;
    } else {
        PG8_STAGE(PG8_SB(0, 0), cB, voffB); PG8_STAGE(PG8_SA(0, 0), cA, voffA); PG8_STAGE(PG8_SB(0, 1), cB + hstep, voffB); PG8_STAGE(PG8_SA(0, 1), cA + hstepA, voffA);
        if (wr == 1) PG8_BAR;
        PG8_WAIT_V(4); PG8_BAR;
        PG8_STAGE(PG8_SB(1, 0), cB + kstep, voffB); PG8_STAGE(PG8_SA(1, 0), cA + kstep, voffA); PG8_STAGE(PG8_SB(1, 1), cB + hstep + kstep, voffB);
        PG8_WAIT_V(6); PG8_BAR;
    }
    for (;;) {
        const bool has_next = S.next(ui + 1, nxt);
        const char* nA = has_next ? (const char*)g.A + (size_t)nxt.pm * tstepA : cA; const char* nB = has_next ? (const char*)g.Bt + (size_t)nxt.pn * tstep : cB;
        for (int t = 0; t < nt; t += 2) {
            const bool last = (t == nt - 2);
            const char* a1 = cA + (size_t)(t + 1) * kstep;
            const char* a2 = last ? nA : cA + (size_t)(t + 2) * kstep; const char* b2 = last ? nB : cB + (size_t)(t + 2) * kstep;
            const char* a3 = a2 + kstep; const char* b3 = b2 + kstep;
            if (last && has_next) S.a_ready(nxt);
            if constexpr (SP2) {
            PG8_LDB(B0, 0, 0); PG8_LDB(B1, 0, 1); PG8_SCHED; PG8_LDA(At, 0, 0); PG8_STAGE(PG8_SA(1, 1), a1 + hstepA, voffA);
            PG8_WAIT_V(8); PG8_WAIT_L(0); PG8_BAR; PG8_MMA(0, 0, At, B0); PG8_MMA(0, 1, At, B1); PG8_BAR; PG8_SCHED;
            PG8_LDA(At, 0, 1); PG8_STAGE(PG8_SB(0, 0), b2, voffB); PG8_STAGE(PG8_SB(0, 1), b2 + hstep, voffB); PG8_STAGE(PG8_SA(0, 0), a2, voffA);
            PG8_WAIT_V(8); PG8_WAIT_L(0); PG8_BAR; PG8_MMA(1, 0, At, B0); PG8_MMA(1, 1, At, B1); PG8_BAR; PG8_SCHED;
            PG8_LDB(B0, 1, 0); PG8_LDB(B1, 1, 1); PG8_SCHED; PG8_LDA(At, 1, 0); PG8_STAGE(PG8_SA(0, 1), a2 + hstepA, voffA);
            PG8_WAIT_V(8); PG8_WAIT_L(0); PG8_BAR; PG8_MMA(0, 0, At, B0); PG8_MMA(0, 1, At, B1); PG8_BAR; PG8_SCHED;
            PG8_LDA(At, 1, 1); PG8_STAGE(PG8_SB(1, 0), b3, voffB); PG8_STAGE(PG8_SB(1, 1), b3 + hstep, voffB); PG8_STAGE(PG8_SA(1, 0), a3, voffA);
            PG8_WAIT_V(8); PG8_WAIT_L(0); PG8_BAR; PG8_MMA(1, 0, At, B0); PG8_MMA(1, 1, At, B1); PG8_BAR; PG8_SCHED;
            } else {
            PG8_LDB(B0, 0, 0); PG8_SCHED; PG8_LDA(At, 0, 0); PG8_STAGE(PG8_SA(1, 1), a1 + hstepA, voffA);
            PG8_WAIT_L(8); PG8_BAR; PG8_WAIT_L(0); PG8_MMA(0, 0, At, B0); PG8_BAR; PG8_SCHED;
            PG8_LDB(B1, 0, 1); PG8_STAGE(PG8_SB(0, 0), b2, voffB);
            PG8_BAR; PG8_WAIT_L(0); PG8_MMA(0, 1, At, B1); PG8_BAR;
            PG8_LDA(At, 0, 1); PG8_STAGE(PG8_SA(0, 0), a2, voffA);
            PG8_BAR; PG8_WAIT_L(0); PG8_MMA(1, 0, At, B0); PG8_BAR; PG8_SCHED;
            PG8_STAGE(PG8_SB(0, 1), b2 + hstep, voffB);
            PG8_WAIT_V(6); PG8_BAR; PG8_MMA(1, 1, At, B1); PG8_BAR;
            PG8_LDB(B0, 1, 0); PG8_SCHED; PG8_LDA(At, 1, 0); PG8_STAGE(PG8_SA(0, 1), a2 + hstepA, voffA);
            PG8_WAIT_L(8); PG8_BAR; PG8_WAIT_L(0); PG8_MMA(0, 0, At, B0); PG8_BAR; PG8_SCHED;
            PG8_LDB(B1, 1, 1); PG8_STAGE(PG8_SB(1, 0), b3, voffB);
            PG8_BAR; PG8_WAIT_L(0); PG8_MMA(0, 1, At, B1); PG8_BAR;
            PG8_LDA(At, 1, 1); PG8_STAGE(PG8_SA(1, 0), a3, voffA);
            PG8_BAR; PG8_WAIT_L(0); PG8_MMA(1, 0, At, B0); PG8_BAR; PG8_SCHED;
            PG8_STAGE(PG8_SB(1, 1), b3 + hstep, voffB);
            PG8_WAIT_V(6); PG8_BAR; PG8_MMA(1, 1, At, B1); PG8_BAR;
            }
        }
        if constexpr (ALIGN_EPI) { if (wr == 0) PG8_BAR; }
        if constexpr (!Epi::AFTER_DRAIN) { E(acc, cur, wr, wc, fr, fq); S.done(cur); }
        if (!has_next) break;
#pragma unroll
        for (int a = 0; a < 2; ++a)
#pragma unroll
            for (int b = 0; b < 2; ++b)
#pragma unroll
                for (int m = 0; m < 4; ++m)
#pragma unroll
                    for (int n = 0; n < 2; ++n) acc[a][b][m][n] = (f32x4){0.f, 0.f, 0.f, 0.f};
        cur = nxt; cA = nA; cB = nB; ++ui;
        if constexpr (ALIGN_EPI) { if (wr == 1) PG8_BAR; }
    }
    PG8_WAIT_V(0);
    if constexpr (!ALIGN_EPI) { if (wr == 0) PG8_BAR; }
    PG8_BAR;
    if constexpr (Epi::AFTER_DRAIN) { E.fused(acc, cur, wr, wc, fr, fq, lds, wid, lane); S.done(cur); }
#undef PG8_SA
#undef PG8_SB
#undef PG8_STAGE
#undef PG8_LDA
#undef PG8_LDB
#undef PG8_MMA
#undef PG8_WAIT_V
#undef PG8_WAIT_L
#undef PG8_BAR
#undef PG8_SCHED
}
}
namespace pg8 {
template <class T> __device__ __forceinline__ T* uni_ptr(T* p) {
    const unsigned long long v = (unsigned long long)p; unsigned lo = __builtin_amdgcn_readfirstlane((unsigned)v), hi = __builtin_amdgcn_readfirstlane((unsigned)(v >> 32)); asm volatile("" : "+s"(lo), "+s"(hi)); return (T*)(((unsigned long long)hi << 32) | lo); }
struct EpiResid {
    static constexpr bool PERM = true, AFTER_DRAIN = false;
    const float* xin_; float* out_; const float* gate_;
    __device__ __forceinline__ void operator()(const f32x4 (&acc)[2][2][4][2], const Unit& u, int wr, int wc, int fr, int fq) const {
        const float* xin = uni_ptr(xin_); float* out = uni_ptr(out_); const float* gate = uni_ptr(gate_);
        const int row0 = u.pm * BM + wr * 64 + fr, col0 = u.pn * BM + wc * 32 + 8 * fq;
        const float* gp = gate + (size_t)(u.pm >> 5) * 6144 + col0;
        f32x4 gv[2][2];
#pragma unroll
        for (int bj = 0; bj < 2; ++bj)
#pragma unroll
            for (int n = 0; n < 2; ++n) gv[bj][n] = *(const f32x4*)(gp + bj * HALF + 4 * n);
#pragma unroll
        for (int ai = 0; ai < 2; ++ai) {
            f32x4 xr[4][2][2];
#pragma unroll
            for (int m = 0; m < 4; ++m) { const size_t off = (size_t)(row0 + ai * HALF + m * 16) * 1024 + col0;
#pragma unroll
                for (int bj = 0; bj < 2; ++bj) { xr[m][bj][0] = *(const f32x4*)(xin + off + bj * HALF); xr[m][bj][1] = *(const f32x4*)(xin + off + bj * HALF + 4); } }
#pragma unroll
            for (int m = 0; m < 4; ++m) { const size_t off = (size_t)(row0 + ai * HALF + m * 16) * 1024 + col0;
#pragma unroll
                for (int bj = 0; bj < 2; ++bj) { *(f32x4*)(out + off + bj * HALF) = xr[m][bj][0] + gv[bj][0] * acc[ai][bj][m][0]; *(f32x4*)(out + off + bj * HALF + 4) = xr[m][bj][1] + gv[bj][1] * acc[ai][bj][m][1]; } }
            asm volatile("" ::: "memory");
        }
    }
};
struct EpiRelu2 {
    static constexpr bool PERM = true, AFTER_DRAIN = false;
    bf16_t* O_; int ldc;
    __device__ __forceinline__ void operator()(const f32x4 (&acc)[2][2][4][2], const Unit& u, int wr, int wc, int fr, int fq) const {
        bf16_t* O = uni_ptr(O_);
        const int row0 = u.pm * BM + wr * 64 + fr, col0 = u.pn * BM + wc * 32 + 8 * fq;
#pragma unroll
        for (int ai = 0; ai < 2; ++ai)
#pragma unroll
            for (int m = 0; m < 4; ++m) { bf16_t* rowp = O + (size_t)(row0 + ai * HALF + m * 16) * ldc + col0;
#pragma unroll
                for (int bj = 0; bj < 2; ++bj) { f32x4 v0 = acc[ai][bj][m][0], v1 = acc[ai][bj][m][1];
                    v0 = __builtin_elementwise_max(v0, (f32x4){0.f, 0.f, 0.f, 0.f}); v1 = __builtin_elementwise_max(v1, (f32x4){0.f, 0.f, 0.f, 0.f}); v0 = v0 * v0; v1 = v1 * v1;
                    u32x4 w; w.x = cvt_pk_bf16(v0[0], v0[1]); w.y = cvt_pk_bf16(v0[2], v0[3]); w.z = cvt_pk_bf16(v1[0], v1[1]); w.w = cvt_pk_bf16(v1[2], v1[3]);
                    *(u32x4*)(rowp + bj * HALF) = w; } }
    }
};
struct EpiMlaQ {
    static constexpr bool PERM = true, AFTER_DRAIN = false;
    bf16_t* QM_;
    __device__ __forceinline__ void operator()(const f32x4 (&acc)[2][2][4][2], const Unit& u, int wr, int wc, int fr, int fq) const {
        bf16_t* QM = uni_ptr(QM_);
        const int row0 = u.pm * BM + wr * 64 + fr, cw = wc * 32 + 8 * fq;
        const int nbj = (u.pn != 0) ? 1 : 2;
#pragma unroll
        for (int ai = 0; ai < 2; ++ai)
#pragma unroll
            for (int m = 0; m < 4; ++m) { bf16_t* qr = QM + (size_t)(row0 + ai * HALF + m * 16) * 384 + u.pn * 256 + cw;
#pragma unroll
                for (int bj = 0; bj < 2; ++bj) if (bj < nbj) { const f32x4 v0 = acc[ai][bj][m][0], v1 = acc[ai][bj][m][1];
                    u32x4 o; o.x = cvt_pk_bf16(v0[0], v0[1]); o.y = cvt_pk_bf16(v0[2], v0[3]); o.z = cvt_pk_bf16(v1[0], v1[1]); o.w = cvt_pk_bf16(v1[2], v1[3]);
                    *(u32x4*)(qr + bj * HALF) = o; } }
    }
};
struct EpiMlaKV {
    static constexpr bool PERM = true, AFTER_DRAIN = false;
    bf16_t* KM_; bf16_t* VM_; const float* rskv_;
    __device__ __forceinline__ void operator()(const f32x4 (&acc)[2][2][4][2], const Unit& u, int wr, int wc, int fr, int fq) const {
        bf16_t* KM = uni_ptr(KM_); bf16_t* VM = uni_ptr(VM_); const float* rskv = uni_ptr(rskv_);
        const int row0 = u.pm * BM + wr * 64 + fr, w = wc * 32 + 8 * fq;
        const bool isk = wc < 2;
#pragma unroll
        for (int ai = 0; ai < 2; ++ai)
#pragma unroll
            for (int m = 0; m < 4; ++m) { const int row = row0 + ai * HALF + m * 16; const float rs = rskv[row];
#pragma unroll
                for (int bj = 0; bj < 2; ++bj) { const int head = u.pn * 2 + bj;
                    const f32x4 v0 = acc[ai][bj][m][0] * rs, v1 = acc[ai][bj][m][1] * rs;
                    u32x4 o; o.x = cvt_pk_bf16(v0[0], v0[1]); o.y = cvt_pk_bf16(v0[2], v0[3]); o.z = cvt_pk_bf16(v1[0], v1[1]); o.w = cvt_pk_bf16(v1[2], v1[3]);
                    if (isk) *(u32x4*)(KM + (size_t)row * 384 + head * 96 + w) = o; else *(u32x4*)(VM + (size_t)row * 256 + head * 64 + (w - 64)) = o; }
                asm volatile("" ::: "memory"); }
    }
};
}
#define GAS __attribute__((address_space(1)))
#define LAS __attribute__((address_space(3)))
typedef unsigned short bf16;
typedef unsigned v4u __attribute__((ext_vector_type(4)));
typedef float f32x4 __attribute__((ext_vector_type(4)));
typedef short bf16x8 __attribute__((ext_vector_type(8)));
typedef GAS unsigned gu32;
typedef GAS unsigned long long gu64;
#define RLX_AGENT __ATOMIC_RELAXED, __HIP_MEMORY_SCOPE_AGENT
#define LDS_WAIT() asm volatile("s_waitcnt lgkmcnt(0)" ::: "memory")
#define VM_WAIT() asm volatile("s_waitcnt vmcnt(0)" ::: "memory")
__device__ __forceinline__ unsigned long long rt() { return __builtin_amdgcn_s_memrealtime(); }
__device__ __forceinline__ unsigned f2bf(float f) { unsigned u = __builtin_bit_cast(unsigned, f); return (u + 0x7fffu + ((u >> 16) & 1u)) >> 16; }
__device__ __forceinline__ unsigned pk2(float lo, float hi) { return f2bf(lo) | (f2bf(hi) << 16); }

#define XB_TMO      128
#define XB_XCNT(j)  (256  + 64 * (j))
#define XB_XSUB(j)  (1280 + 64 * (j))
#define XB_XGEN(j)  (2304 + 64 * (j))
#define XB_TOP      3328
#define XB_TOPGEN   3392
#define XCD_BAR_WORDS 3456
#define XB_SPIN_CAP (1u << 18)

__device__ __forceinline__ unsigned xb_ld(unsigned* p)              { return __hip_atomic_load(p, __ATOMIC_RELAXED, __HIP_MEMORY_SCOPE_AGENT); }
__device__ __forceinline__ unsigned xb_add(unsigned* p, unsigned v) { return __hip_atomic_fetch_add(p, v, __ATOMIC_RELAXED, __HIP_MEMORY_SCOPE_AGENT); }
__device__ __forceinline__ unsigned xb_xcc_id() { return (unsigned)__builtin_amdgcn_s_getreg((3 << 11) | 20) & 0xFu; }
#define XB_SPIN(cond, bar) do { unsigned _sp = 0; while (cond) { __builtin_amdgcn_s_sleep(1); \
    if ((++_sp & 255u) == 0u) { if (xb_ld(&(bar)[XB_TMO])) break; if (_sp > XB_SPIN_CAP) { atomicAdd(&(bar)[XB_TMO], 1u); break; } } } } while (0)

struct XcdBarrier {
    unsigned* bar; unsigned x;
    volatile LAS unsigned* st;
};

__device__ __forceinline__ XcdBarrier xcd_barrier_post(unsigned* bar, volatile LAS unsigned* st) {
    XcdBarrier b; b.bar = bar; b.x = xb_xcc_id(); b.st = st;
    if (threadIdx.x == 0) (void)xb_add(&bar[XB_XCNT(b.x)], 1u);
    return b;
}
__device__ __forceinline__ void xcd_barrier_complete(unsigned* bar, unsigned x, unsigned& nloc, unsigned& nx) {
    const unsigned G = gridDim.x * gridDim.y * gridDim.z;
    unsigned sum, cnt, mine, sp = 0u;
    for (;;) {
        sum = 0u; cnt = 0u; mine = 0u;
#pragma unroll
        for (unsigned j = 0; j < 16; ++j) { const unsigned c = xb_ld(&bar[XB_XCNT(j)]); sum += c; cnt += (c > 0u) ? 1u : 0u; mine = (j == x) ? c : mine; }
        if (sum == G) break;
        __builtin_amdgcn_s_sleep(1);
        if ((++sp & 255u) == 0u) { if (xb_ld(&bar[XB_TMO])) break; if (sp > XB_SPIN_CAP) { atomicAdd(&bar[XB_TMO], 1u); break; } }
    }
    nloc = mine > 0u ? mine : 1u; nx = cnt > 0u ? cnt : 1u;
}

__device__ __forceinline__ void xcd_barrier(const XcdBarrier& b) {
    asm volatile("s_waitcnt vmcnt(0)" ::: "memory");
    __syncthreads();
    if (threadIdx.x == 0) {
        unsigned* bar = b.bar;
        __builtin_amdgcn_s_waitcnt(0);
        unsigned nloc = b.st[0], nx = b.st[1];
        if (nloc == 0u) { xcd_barrier_complete(bar, b.x, nloc, nx); b.st[0] = nloc; b.st[1] = nx; }
        const unsigned old = xb_add(&bar[XB_XSUB(b.x)], 1u);
        const unsigned gen = old / nloc;
        if (old + 1u == (gen + 1u) * nloc) {
            __builtin_amdgcn_fence(__ATOMIC_RELEASE, "agent");
            asm volatile("s_waitcnt vmcnt(0)" ::: "memory");
            const unsigned og = xb_add(&bar[XB_TOP], 1u);
            const unsigned tg = og / nx;
            if (og + 1u == (tg + 1u) * nx) xb_add(&bar[XB_TOPGEN], 1u);
            else XB_SPIN(xb_ld(&bar[XB_TOPGEN]) == tg, bar);
            __builtin_amdgcn_fence(__ATOMIC_ACQUIRE, "agent");
            xb_add(&bar[XB_XGEN(b.x)], 1u);
            asm volatile("s_waitcnt vmcnt(0)" ::: "memory");
        } else {
            XB_SPIN(xb_ld(&bar[XB_XGEN(b.x)]) == gen, bar);
            __builtin_amdgcn_fence(__ATOMIC_ACQUIRE, "agent");
            asm volatile("s_waitcnt vmcnt(0)" ::: "memory");
        }
    }
    __syncthreads();
}
#ifndef FA_PROBE
#define FA_PROBE 0
#endif
namespace fa {
typedef unsigned short bf16;
typedef short bf16x8 __attribute__((ext_vector_type(8)));
typedef short s16x4 __attribute__((ext_vector_type(4)));
typedef float f32x16 __attribute__((ext_vector_type(16)));
typedef float f32x4v __attribute__((ext_vector_type(4)));
typedef unsigned u32x4 __attribute__((ext_vector_type(4)));
typedef unsigned u32x2 __attribute__((ext_vector_type(2)));
typedef float f32x2_t __attribute__((ext_vector_type(2)));
typedef __bf16 bf16x2_t __attribute__((ext_vector_type(2)));
#define FLAS __attribute__((address_space(3)))
#define FGAS __attribute__((address_space(1)))
constexpr float MASKV = -1e30f, MINIT = -5e29f, TINYF = 1e-30f, LOG2E = 1.4426950408889634f;
constexpr int OSTR = 144;

__device__ __forceinline__ float ex2(float x) { return __builtin_amdgcn_exp2f(x); }
__device__ __forceinline__ unsigned cvtpk(float lo, float hi) { f32x2_t v = {lo, hi}; bf16x2_t b = __builtin_convertvector(v, bf16x2_t); return __builtin_bit_cast(unsigned, b); }
__device__ __forceinline__ float xhalf_max(float m) { auto rr = __builtin_amdgcn_permlane32_swap(__float_as_uint(m), __float_as_uint(m), false, false); return fmaxf(__uint_as_float(rr[0]), __uint_as_float(rr[1])); }
__device__ __forceinline__ float xhalf_sum(float m) { auto rr = __builtin_amdgcn_permlane32_swap(__float_as_uint(m), __float_as_uint(m), false, false); return __uint_as_float(rr[0]) + __uint_as_float(rr[1]); }
__device__ __forceinline__ float bf2f(unsigned short b) { return __uint_as_float((unsigned)b << 16); }

struct SM { float m, l; f32x16 o[2]; };
__device__ __forceinline__ void sm_init(SM& s) { s.m = MINIT; s.l = 0.f; s.o[0] = f32x16{}; s.o[1] = f32x16{}; }

template <int DQ> struct Stg { u32x4 k0, k1, v; };
template <int DQ> __device__ __forceinline__ void stg_load(Stg<DQ>& s, const FGAS char* ws, unsigned koff, unsigned ksb, unsigned voff, unsigned vsb, int key0, int kmax, int tid) {
    const int row = tid >> 3, ch = tid & 7; int kr = key0 + row; kr = kr < kmax ? kr : kmax;
    s.k0 = *(const FGAS u32x4*)(ws + (koff + (unsigned)kr * ksb + (unsigned)ch * 16u));
    s.v = *(const FGAS u32x4*)(ws + (voff + (unsigned)kr * vsb + (unsigned)ch * 16u));
    if (DQ == 96) { if (tid < 256) { const int r2 = tid >> 2, c2 = tid & 3; int k2 = key0 + r2; k2 = k2 < kmax ? k2 : kmax; s.k1 = *(const FGAS u32x4*)(ws + (koff + (unsigned)k2 * ksb + 128u + (unsigned)c2 * 16u)); } }
}
template <int DQ> __device__ __forceinline__ void stg_store(const Stg<DQ>& s, FLAS char* buf, int tid) {
    const int row = tid >> 3, ch = tid & 7, p = ch >> 2, c = ch & 3;
    *(FLAS u32x4*)(buf + p * 4096 + row * 64 + ((c ^ ((row >> 2) & 3)) << 4)) = s.k0;
    *(FLAS u32x4*)(buf + (DQ / 32) * 4096 + row * 128 + ((p ^ ((row >> 1) & 1)) << 6) + (c << 4)) = s.v;
    if (DQ == 96) { if (tid < 256) { const int r2 = tid >> 2, c2 = tid & 3; *(FLAS u32x4*)(buf + 2 * 4096 + r2 * 64 + ((c2 ^ ((r2 >> 2) & 3)) << 4)) = s.k1; } }
}
template <int DQ> constexpr int stage_bytes() { return (DQ / 32) * 4096 + 8192; }

template <int DQ> __device__ __forceinline__ void compute_S(f32x16& p0, f32x16& p1, const FLAS char* buf, const bf16x8 (&qf)[DQ / 16], int lane) {
    const int r = lane & 31, h = lane >> 5, sw = (r >> 2) & 3;
#pragma unroll
    for (int d0 = 0; d0 < DQ / 16; ++d0) {
        const int p = d0 >> 1, c = 2 * (d0 & 1) + h;
        const FLAS char* a = buf + p * 4096 + r * 64 + ((c ^ sw) << 4);
        const bf16x8 a0 = *(const FLAS bf16x8*)a, a1 = *(const FLAS bf16x8*)(a + 2048);
        p0 = __builtin_amdgcn_mfma_f32_32x32x16_bf16(a0, qf[d0], p0, 0, 0, 0);
        p1 = __builtin_amdgcn_mfma_f32_32x32x16_bf16(a1, qf[d0], p1, 0, 0, 0);
    }
}
__device__ __forceinline__ s16x4 vtr(const FLAS char* p) { typedef short v4i16_t __attribute__((ext_vector_type(4))); return __builtin_bit_cast(s16x4, __builtin_amdgcn_ds_read_tr16_b64_v4i16((FLAS v4i16_t*)p)); }
__device__ __forceinline__ void pv(f32x16 (&o)[2], const FLAS char* vbuf, const bf16x8 (&pf)[4], int lane) {
    const int g = lane >> 4, i = lane & 15, q4 = i >> 2, pp = i & 3, h = lane >> 5;
    const int sw = (q4 >> 1) & 1;
#pragma unroll
    for (int db = 0; db < 2; ++db) {
        const FLAS char* base = vbuf + (4 * h + q4) * 128 + ((db ^ sw) << 6) + (16 * (g & 1) + 4 * pp) * 2;
#pragma unroll
        for (int ks = 0; ks < 4; ++ks) {
            const s16x4 lo = vtr(base + ks * 2048), hi = vtr(base + ks * 2048 + 1024);
            const bf16x8 a = (bf16x8){lo[0], lo[1], lo[2], lo[3], hi[0], hi[1], hi[2], hi[3]};
            o[db] = __builtin_amdgcn_mfma_f32_32x32x16_bf16(a, pf[ks], o[db], 0, 0, 0);
        }
    }
}
__device__ __forceinline__ void mask_ew(f32x16& p0, f32x16& p1, int lo, int hi, int h) {
    const int lo2 = lo - 4 * h, hi2 = hi - 4 * h;
#pragma unroll
    for (int v = 0; v < 16; ++v) { const int k0 = (v & 3) + 8 * (v >> 2);
        if (k0 < lo2 || k0 > hi2) p0[v] = MASKV;
        if (k0 + 32 < lo2 || k0 + 32 > hi2) p1[v] = MASKV; }
}
__device__ __forceinline__ void sm_step(SM& st, f32x16& p0, f32x16& p1, bf16x8 (&pf)[4]) {
#define FA_MX3(a, b, c) __builtin_fmaxf(__builtin_fmaxf((a), (b)), (c))
    float ma = FA_MX3(p0[0], p0[1], p1[0]), mb = FA_MX3(p0[2], p0[3], p1[1]); ma = FA_MX3(ma, p1[2], p1[3]);
#pragma unroll
    for (int v = 4; v < 16; v += 4) { ma = FA_MX3(ma, p0[v], p0[v + 1]); mb = FA_MX3(mb, p0[v + 2], p0[v + 3]); ma = FA_MX3(ma, p1[v], p1[v + 1]); mb = FA_MX3(mb, p1[v + 2], p1[v + 3]); }
#undef FA_MX3
    const float mx = xhalf_max(__builtin_fmaxf(ma, mb));
    if (__any(mx > st.m)) {
        const float mn2 = fmaxf(st.m, mx), alpha = ex2(st.m - mn2);
        st.m = mn2; st.l *= alpha; st.o[0] *= alpha; st.o[1] *= alpha;
    }
    const float mn = st.m;
    float s0 = 0.f, s1 = 0.f;
#pragma unroll
    for (int v = 0; v < 16; ++v) { p0[v] = ex2(p0[v] - mn); p1[v] = ex2(p1[v] - mn); s0 += p0[v]; s1 += p1[v]; }
    st.l += s0 + s1;
    u32x4 w;
    w.x = cvtpk(p0[0], p0[1]); w.y = cvtpk(p0[2], p0[3]); w.z = cvtpk(p0[4], p0[5]); w.w = cvtpk(p0[6], p0[7]); pf[0] = __builtin_bit_cast(bf16x8, w);
    w.x = cvtpk(p0[8], p0[9]); w.y = cvtpk(p0[10], p0[11]); w.z = cvtpk(p0[12], p0[13]); w.w = cvtpk(p0[14], p0[15]); pf[1] = __builtin_bit_cast(bf16x8, w);
    w.x = cvtpk(p1[0], p1[1]); w.y = cvtpk(p1[2], p1[3]); w.z = cvtpk(p1[4], p1[5]); w.w = cvtpk(p1[6], p1[7]); pf[2] = __builtin_bit_cast(bf16x8, w);
    w.x = cvtpk(p1[8], p1[9]); w.y = cvtpk(p1[10], p1[11]); w.z = cvtpk(p1[12], p1[13]); w.w = cvtpk(p1[14], p1[15]); pf[3] = __builtin_bit_cast(bf16x8, w);
}
template <int DQ, bool ALIBI> __device__ __forceinline__ void score_tile(f32x16& p0, f32x16& p1, const FLAS char* buf, const bf16x8 (&qf)[DQ / 16], float cb, float sl, int lane) {
    if (ALIBI) {
#pragma unroll
        for (int v = 0; v < 16; ++v) { const float c = (float)((v & 3) + 8 * (v >> 2)); p0[v] = fmaf(sl, c, cb); p1[v] = fmaf(sl, c + 32.f, cb); }
    } else { p0 = f32x16{}; p1 = f32x16{}; }
    compute_S<DQ>(p0, p1, buf, qf, lane);
}
template <int DQ, bool ALIBI> __device__ __forceinline__ void tile_compute(SM& st, const FLAS char* buf, const bf16x8 (&qf)[DQ / 16], float cb, float sl, bool ew, int lo, int hi, int lane) {
    f32x16 p0, p1; bf16x8 pf[4];
    score_tile<DQ, ALIBI>(p0, p1, buf, qf, cb, sl, lane);
    if (ew) mask_ew(p0, p1, lo, hi, lane >> 5);
    sm_step(st, p0, p1, pf);
    pv(st.o, buf + (DQ / 32) * 4096, pf, lane);
}
template <int DQ, bool ALIBI, class K0, class PAR>
__device__ __forceinline__ void fa_loop(SM& st, const bf16x8 (&qf)[DQ / 16], const FGAS char* ws, unsigned koff, unsigned ksb, unsigned voff, unsigned vsb, int kmax, int ntile, K0 k0f, PAR parf, float sl, FLAS char* lds, int tid, int lane) {
    constexpr int STG = stage_bytes<DQ>();
    Stg<DQ> sgA, sgB;
    stg_load<DQ>(sgB, ws, koff, ksb, voff, vsb, k0f(0), kmax, tid); stg_store<DQ>(sgB, lds, tid);
    if (ntile > 1) stg_load<DQ>(sgA, ws, koff, ksb, voff, vsb, k0f(1), kmax, tid);
    if (ntile > 2) stg_load<DQ>(sgB, ws, koff, ksb, voff, vsb, k0f(2), kmax, tid);
    __syncthreads();
#if FA_PROBE
    unsigned long long pr_c = 0, pr_w = 0, pr_b = 0, pr_t = 0; const unsigned long long pr_start = __builtin_amdgcn_s_memtime();
#define FA_P0 const unsigned long long q0_ = __builtin_amdgcn_s_memtime();
#define FA_P1 asm volatile("s_waitcnt vmcnt(0)" ::: "memory"); const unsigned long long q1_ = __builtin_amdgcn_s_memtime();
#define FA_P2 asm volatile("s_waitcnt lgkmcnt(0)" ::: "memory"); asm volatile("" : "+v"(st.o[0]), "+v"(st.o[1])); const unsigned long long q2_ = __builtin_amdgcn_s_memtime();
#define FA_P3 const unsigned long long q3_ = __builtin_amdgcn_s_memtime(); pr_w += q1_ - q0_; pr_c += q2_ - q1_; pr_b += q3_ - q2_; pr_t += 1;
#else
#define FA_P0
#define FA_P1
#define FA_P2
#define FA_P3
#endif
#define FA_ITER(SG) { \
        FA_P0 \
        if (t + 1 < ntile) stg_store<DQ>(SG, lds + ((t + 1) & 1) * STG, tid); \
        if (t + 3 < ntile) stg_load<DQ>(SG, ws, koff, ksb, voff, vsb, k0f(t + 3), kmax, tid); \
        FA_P1 \
        bool act, ew; float cb; int lo, hi; \
        parf(t, act, ew, cb, lo, hi); \
        if (act) tile_compute<DQ, ALIBI>(st, lds + (t & 1) * STG, qf, cb, sl, ew, lo, hi, lane); \
        FA_P2 \
        __syncthreads(); \
        FA_P3 }
    int t = 0;
    for (; t + 1 < ntile; t += 2) { FA_ITER(sgA) ++t; FA_ITER(sgB) --t; }
    if (t < ntile) FA_ITER(sgA)
#undef FA_ITER
#if FA_PROBE
    if (DQ == 96 && lane == 0) { unsigned long long* pp = (unsigned long long*)((FGAS char*)ws + 32768);
        atomicAdd(pp + 0, pr_c); atomicAdd(pp + 1, pr_w); atomicAdd(pp + 2, pr_b); atomicAdd(pp + 3, pr_t); atomicAdd(pp + 4, __builtin_amdgcn_s_memtime() - pr_start); }
#endif
}
__device__ __forceinline__ void sm_finish(const SM& st, float gate, f32x16 (&acc)[2]) {
    const float inv = gate / fmaxf(xhalf_sum(st.l), TINYF);
    acc[0] += st.o[0] * inv; acc[1] += st.o[1] * inv;
}
template <class DST> __device__ __forceinline__ void store_out(const f32x16 (&acc)[2], FLAS char* ost, FGAS char* ws, DST dstf, int lane) {
    const int r = lane & 31, h = lane >> 5;
#pragma unroll
    for (int db = 0; db < 2; ++db)
#pragma unroll
        for (int g = 0; g < 4; ++g) { u32x2 w; w.x = cvtpk(acc[db][4 * g], acc[db][4 * g + 1]); w.y = cvtpk(acc[db][4 * g + 2], acc[db][4 * g + 3]);
            *(FLAS u32x2*)(ost + r * OSTR + (32 * db + 8 * g + 4 * h) * 2) = w; }
    asm volatile("s_waitcnt lgkmcnt(0)" ::: "memory");
#pragma unroll
    for (int i = 0; i < 4; ++i) { const int idx = i * 64 + lane, col = idx >> 3, ch = idx & 7;
        const u32x4 v = *(const FLAS u32x4*)(ost + col * OSTR + ch * 16);
        *(FGAS u32x4*)(ws + (dstf(col) + (unsigned)ch * 16u)) = v; }
    asm volatile("s_waitcnt lgkmcnt(0)" ::: "memory");
}
template <int DQ> __device__ __forceinline__ void load_q(bf16x8 (&qf)[DQ / 16], const FGAS char* ws, unsigned qoff, int h) {
#pragma unroll
    for (int d0 = 0; d0 < DQ / 16; ++d0) qf[d0] = *(const FGAS bf16x8*)(ws + (qoff + (unsigned)(d0 * 32 + 16 * h)));
}
}
namespace mk {
typedef unsigned short bf16;
typedef float f32x4 __attribute__((ext_vector_type(4)));
typedef unsigned v4u __attribute__((ext_vector_type(4)));
typedef unsigned v2u __attribute__((ext_vector_type(2)));
typedef short bf16x8 __attribute__((ext_vector_type(8)));
typedef float f32x16 __attribute__((ext_vector_type(16)));
using fa::SM;

constexpr int D = 1024, NB = 4, SEQ = 8192, M = NB * SEQ, DEPTH = 2, DFF = 4096, ZLD = 2304, DIN = 2284;
constexpr int ZA_Q = 0, ZA_K = 256, ZA_V = 384, ZB_CQ = 512, ZB_CKV = 704, ZB_PE = 832, ZC_Q = 864, ZC_KC = 1120, ZC_VC = 1184, ZC_KS = 1248, ZC_VS = 1312, ZC_KW = 1376, ZC_VW = 1440, ZC_GL = 1504, ZD_Q = 1520, ZD_K = 1776, ZD_V = 2032;
constexpr float LOG2E = 1.4426950408889634f;
constexpr float QS = 0.125f * LOG2E;
constexpr float C_MLA = 0.10206207261596577f * LOG2E;
constexpr float RMS_EPS = 1e-6f;
constexpr int NWAVES = 8, NTHR = 512;

constexpr size_t MiB = 1u << 20;
constexpr size_t WS_CTL = 0, CTL_ZERO_BYTES = 64 * 1024;
constexpr size_t WS_MOD = 1 * MiB;
constexpr size_t WS_ROPE = WS_MOD + 256 * 1024;
constexpr size_t WS_POSP = WS_ROPE + 1 * MiB;
constexpr size_t WS_POSB = WS_POSP + 64 * 1024;
constexpr size_t WS_RSQ = WS_POSB + 64 * 1024;
constexpr size_t WS_RSKV = WS_RSQ + 128 * 1024;
constexpr size_t WS_KMH = WS_RSKV + 128 * 1024;
constexpr size_t WS_KML = WS_KMH + 64 * 1024;
constexpr size_t WS_KCMP = WS_KML + 64 * 1024;
constexpr size_t WS_VCMP = WS_KCMP + 256 * 1024;
constexpr size_t WS_PARK = 401 * MiB;
constexpr size_t WS_W = 4 * MiB, WS_WL = 26 * MiB;
constexpr size_t W_IN = 0, W_OUT = 4608 * 1024, W_UP = W_OUT + 2 * MiB, W_DN = W_UP + 8 * MiB, W_UQ = W_DN + 8 * MiB, W_UKV = W_UQ + 256 * 1024, W_1K = W_UKV + 256 * 1024, W_1V = W_1K + 512 * 1024, W_2K = W_1V + 512 * 1024, W_2V = W_2K + 16 * 1024;
static_assert(W_2V + 16 * 1024 <= WS_WL && WS_VCMP + 256 * 1024 <= WS_W, "ws map");
constexpr size_t WS_H = 56 * MiB;
constexpr size_t WS_Z = 120 * MiB;
constexpr size_t WS_QM = 265 * MiB, WS_KM = 297 * MiB, WS_VM = 321 * MiB, WS_O = 337 * MiB, WS_U = 120 * MiB, WS_END = 401 * MiB;
static_assert(WS_Z + (size_t)(M + 64) * ZLD * 2 <= WS_QM && WS_U + (size_t)M * DFF * 2 <= WS_END, "ws map 2");

constexpr int LDS_RING = 131072, LDS_BYTES = 163840, LDS_MISC = LDS_BYTES - 256;
constexpr int FA_STAGES = 0, FA_OST = 61440, FA_IMP = FA_OST + 8 * 32 * fa::OSTR  , FA_SELM = FA_IMP + 32768, FA_UM = FA_SELM + 1024, FA_VALS = FA_UM + 64;
static_assert(FA_VALS + 8 * 512 <= LDS_MISC, "fa lds map");
constexpr int MB_Q = 49152, MB_O = MB_Q + 32768, MB_ML = MB_O + 65536, MB_CNT = MB_ML + 2048, MB_LST = MB_CNT + 128;
static_assert(MB_LST + 8192 <= LDS_MISC, "moba lds map");

#define GAS __attribute__((address_space(1)))
#define LAS __attribute__((address_space(3)))
#define LDS_WAIT() asm volatile("s_waitcnt lgkmcnt(0)" ::: "memory")
__device__ __forceinline__ unsigned f2bf(float f) { unsigned u = __builtin_bit_cast(unsigned, f); return (u + 0x7fffu + ((u >> 16) & 1u)) >> 16; }
__device__ __forceinline__ unsigned pk2(float lo, float hi) { return f2bf(lo) | (f2bf(hi) << 16); }
__device__ __forceinline__ float bf2f(unsigned short b) { return __uint_as_float((unsigned)b << 16); }
__device__ __forceinline__ float wave_sum(float v) {
#pragma unroll
    for (int o = 1; o < 64; o <<= 1) v += __shfl_xor(v, o);
    return v;
}
__device__ __forceinline__ float slope2_of(int i) { return exp2f(-8.0f * (float)(i + 1) / 12.0f) * LOG2E; }

struct Args { const float* in[22]; float* out; unsigned char* ws; int ph_lo, ph_hi, skip, rep; };
typedef const __attribute__((address_space(4))) Args* KArgsP;
struct Frame {
    LAS unsigned char* lds;
    int tid, lane, wave, vcu, G, bx;
    unsigned char* ws;
};

template <int MODE> __device__ __forceinline__ int dmap(int n) {
    if (MODE == 1) { if (n < 832) return n; if (n < 848) return 832 + 2 * (n - 832); if (n < 864) return 832 + 2 * (n - 848) + 1; if (n < 1516) return n; return n + 4; }
    if (MODE == 2) { const int hd = n / 96, w = n - hd * 96; if (w < 64) return hd * 64 + w; if (w < 80) return 256 + hd * 32 + 2 * (w - 64); return 256 + hd * 32 + 2 * (w - 80) + 1; }
    return n;
}
template <int MODE> __device__ __forceinline__ float cscale(int n) {
    if (MODE == 1) { return (n < 256 || (n >= 864 && n < 1120) || (n >= 1516 && n < 1772)) ? QS : 1.f; }
    if (MODE == 2) return C_MLA;
    return 1.f;
}
template <int MODE> __device__ __forceinline__ void transpose_item(const float* W, int N, bf16* WT, int KT, const float* kscale, LAS float* scr, int item, int lane) {
    const int nblk = (N + 31) / 32, kb = item / nblk, nb = item % nblk, k0 = 64 * kb, n0 = 32 * nb;
    const int nl = lane & 31, n = n0 + nl;
#pragma unroll 8
    for (int i = 0; i < 32; ++i) { const int kk = 2 * i + (lane >> 5); float v = (n < N) ? W[(size_t)(k0 + kk) * N + n] : 0.f; if (kscale) v *= kscale[k0 + kk]; scr[kk * 33 + nl] = v; }
    LDS_WAIT(); asm volatile("" ::: "memory");
    const int c = lane & 7;
#pragma unroll
    for (int j = 0; j < 4; ++j) { const int nn = (lane >> 3) + 8 * j, ng = n0 + nn;
        if (ng < N) { const float cs = cscale<MODE>(ng); const LAS float* s = scr + (8 * c) * 33 + nn;
            v4u o; o.x = pk2(s[0 * 33] * cs, s[1 * 33] * cs); o.y = pk2(s[2 * 33] * cs, s[3 * 33] * cs); o.z = pk2(s[4 * 33] * cs, s[5 * 33] * cs); o.w = pk2(s[6 * 33] * cs, s[7 * 33] * cs);
            *(GAS v4u*)(WT + (size_t)dmap<MODE>(ng) * KT + k0 + 8 * c) = o; } }
    LDS_WAIT(); asm volatile("" ::: "memory");
}
__device__ __forceinline__ void zero_fill16(bf16* p, size_t n16, int gtid, int gthreads) {
    for (size_t i = gtid; i < n16; i += gthreads) ((GAS v4u*)p)[i] = (v4u){0u, 0u, 0u, 0u};
}

__device__ __forceinline__ void p_prologue(Frame& F, KArgsP ap_) {
#define a (*ap_)
    LAS float* scr = (LAS float*)(F.lds + F.wave * 16384);
    const int gw = F.vcu * NWAVES + F.wave, NGW = F.G * NWAVES;
    const int gtid = F.vcu * NTHR + F.tid, GT = F.G * NTHR;
    constexpr int I_IN = 16 * 72, I_OUT = 16 * 32, I_UP = 16 * 128, I_DN = 64 * 32, I_UQ = 3 * 12, I_UKV = 2 * 16, I_W1 = 32 * 4, I_W2 = 2 * 2;
    constexpr int PER_L = I_IN + I_OUT + I_UP + I_DN + I_UQ + I_UKV + 2 * I_W1 + 2 * I_W2;
    for (int it = gw; it < DEPTH * PER_L; it += NGW) {
        const int l = it / PER_L; int r = it - l * PER_L;
        unsigned char* wb = F.ws + WS_W + (size_t)l * WS_WL;
        if (r < I_IN) { transpose_item<1>(a.in[6] + (size_t)l * D * DIN, DIN, (bf16*)(wb + W_IN), D, nullptr, scr, r, F.lane); continue; } r -= I_IN;
        if (r < I_OUT) { transpose_item<0>(a.in[7] + (size_t)l * D * D, D, (bf16*)(wb + W_OUT), D, nullptr, scr, r, F.lane); continue; } r -= I_OUT;
        if (r < I_UP) { transpose_item<0>(a.in[19] + (size_t)l * D * DFF, DFF, (bf16*)(wb + W_UP), D, nullptr, scr, r, F.lane); continue; } r -= I_UP;
        if (r < I_DN) { transpose_item<0>(a.in[20] + (size_t)l * DFF * D, D, (bf16*)(wb + W_DN), DFF, nullptr, scr, r, F.lane); continue; } r -= I_DN;
        if (r < I_UQ) { transpose_item<2>(a.in[11] + (size_t)l * 192 * 384, 384, (bf16*)(wb + W_UQ), 256, a.in[9] + l * 192, scr, r, F.lane); continue; } r -= I_UQ;
        if (r < I_UKV) { transpose_item<0>(a.in[12] + (size_t)l * 128 * 512, 512, (bf16*)(wb + W_UKV), 256, a.in[10] + l * 128, scr, r, F.lane); continue; } r -= I_UKV;
        if (r < I_W1) { transpose_item<0>(a.in[15] + (size_t)l * 2048 * 128, 128, (bf16*)(wb + W_1K), 2048, nullptr, scr, r, F.lane); continue; } r -= I_W1;
        if (r < I_W1) { transpose_item<0>(a.in[17] + (size_t)l * 2048 * 128, 128, (bf16*)(wb + W_1V), 2048, nullptr, scr, r, F.lane); continue; } r -= I_W1;
        if (r < I_W2) { transpose_item<0>(a.in[16] + (size_t)l * 128 * 64, 64, (bf16*)(wb + W_2K), 128, nullptr, scr, r, F.lane); continue; } r -= I_W2;
        transpose_item<0>(a.in[18] + (size_t)l * 128 * 64, 64, (bf16*)(wb + W_2V), 128, nullptr, scr, r, F.lane);
    }
    for (int l = 0; l < DEPTH; ++l) {
        unsigned char* wb = F.ws + WS_W + (size_t)l * WS_WL;
        zero_fill16((bf16*)(wb + W_IN) + (size_t)1516 * D, 4 * D / 8, gtid, GT);
        zero_fill16((bf16*)(wb + W_IN) + (size_t)2288 * D, 16 * D / 8, gtid, GT);
        zero_fill16((bf16*)(wb + W_UQ) + (size_t)384 * 256, 128 * 256 / 8, gtid, GT);
        for (int i = gtid; i < 384 * 8; i += GT) ((GAS v4u*)((bf16*)(wb + W_UQ) + (size_t)(i >> 3) * 256 + 192))[i & 7] = (v4u){0u, 0u, 0u, 0u};
        for (int i = gtid; i < 512 * 16; i += GT) ((GAS v4u*)((bf16*)(wb + W_UKV) + (size_t)(i >> 4) * 256 + 128))[i & 15] = (v4u){0u, 0u, 0u, 0u};
    }
    { float* rt = (float*)(F.ws + WS_ROPE);
      for (int i = gtid; i < SEQ * 16; i += GT) { const int ii = i & 15, t = i >> 4; const float freq = powf(10000.f, -(float)ii / 16.f), ang = (float)t * freq; rt[2 * i] = cosf(ang); rt[2 * i + 1] = sinf(ang); } }
    { float* pp = (float*)(F.ws + WS_POSP);
      for (int i = gtid; i < DEPTH * 2 * 32 * 128; i += GT) { const int j = i & 127, kr = (i >> 7) & 31, wh = (i >> 12) & 1, l = i >> 13;
          const float* pos = a.in[wh ? 14 : 13] + l * 2048 + kr * 64; const float* w1 = a.in[wh ? 17 : 15] + (size_t)l * 2048 * 128 + (size_t)kr * 64 * 128 + j;
          float s = 0.f;
#pragma unroll 8
          for (int k = 0; k < 64; ++k) s += pos[k] * w1[(size_t)k * 128];
          pp[i] = s; } }
    { LAS float* sc = (LAS float*)(F.lds);
      LAS float* part = (LAS float*)(F.lds + 16384);
      __syncthreads();
      bool have = false;
      for (int it = F.vcu; it < DEPTH * 96; it += F.G) {
          if (!have) { for (int i = F.tid; i < NB * D; i += NTHR) { const float cv = a.in[1][i]; sc[i] = cv / (1.f + expf(-cv)); } have = true; __syncthreads(); }
          const int l = it / 96, ch = it % 96; const int j = ch * 64 + F.lane;
          const float* w = a.in[4] + (size_t)l * D * 6 * D + j;
          float acc[4] = {0.f, 0.f, 0.f, 0.f};
#pragma unroll 8
          for (int k = 128 * F.wave; k < 128 * F.wave + 128; ++k) { const float wv = w[(size_t)k * 6 * D]; acc[0] += sc[k] * wv; acc[1] += sc[D + k] * wv; acc[2] += sc[2 * D + k] * wv; acc[3] += sc[3 * D + k] * wv; }
#pragma unroll
          for (int b = 0; b < 4; ++b) part[(F.wave * 4 + b) * 64 + F.lane] = acc[b];
          __syncthreads();
          if (F.tid < 256) { const int b = F.tid >> 6, ln = F.tid & 63; float s = a.in[5][l * 6 * D + ch * 64 + ln];
#pragma unroll
              for (int w8 = 0; w8 < 8; ++w8) s += part[(w8 * 4 + b) * 64 + ln];
              ((float*)(F.ws + WS_MOD))[((size_t)l * NB + b) * 6 * D + ch * 64 + ln] = s; }
          __syncthreads();
      } }
}

#undef a
template <int MODE> __device__ __forceinline__ void p_norm(Frame& F, const float* x, const float* g, const float* modsh, const float* modsc, bf16* hout, float* fout) {
    const int gw = F.vcu * NWAVES + F.wave, NGW = F.G * NWAVES;
    for (int blk = gw; blk < M / 16; blk += NGW) {
        const int row0 = blk * 16, b = row0 >> 13;
        f32x4 ga[4], sh[4];
#pragma unroll
        for (int j = 0; j < 4; ++j) { const int c = 4 * F.lane + 256 * j; ga[j] = *(const f32x4*)(g + c);
            if (MODE == 0) { const f32x4 s = *(const f32x4*)(modsc + (size_t)b * 6 * D + c); ga[j] = ga[j] * (s + 1.0f); sh[j] = *(const f32x4*)(modsh + (size_t)b * 6 * D + c); } }
        for (int rr = 0; rr < 16; ++rr) {
            const int row = row0 + rr;
            const GAS f32x4* xr = (const GAS f32x4*)(x + (size_t)row * D) + F.lane;
            f32x4 v[4]; float s = 0.f;
#pragma unroll
            for (int j = 0; j < 4; ++j) { v[j] = xr[64 * j]; s += (v[j].x * v[j].x + v[j].y * v[j].y) + (v[j].z * v[j].z + v[j].w * v[j].w); }
            const float r = rsqrtf(wave_sum(s) * (1.f / D) + RMS_EPS);
            if (MODE == 0) { GAS unsigned long long* o8 = (GAS unsigned long long*)(hout + (size_t)row * D) + F.lane;
#pragma unroll
                for (int j = 0; j < 4; ++j) { const f32x4 y = v[j] * r * ga[j] + sh[j]; o8[64 * j] = (unsigned long long)pk2(y.x, y.y) | ((unsigned long long)pk2(y.z, y.w) << 32); } }
            else { GAS f32x4* o = (GAS f32x4*)(fout + (size_t)row * D) + F.lane;
#pragma unroll
                for (int j = 0; j < 4; ++j) o[64 * j] = v[j] * r * ga[j]; }
        }
    }
}

__device__ __forceinline__ void p_prep(Frame& F, int l) {
    const int gw = F.vcu * NWAVES + F.wave, NGW = F.G * NWAVES;
    const bf16* Z = (const bf16*)(F.ws + WS_Z); bf16* KM = (bf16*)(F.ws + WS_KM);
    float* rsq = (float*)(F.ws + WS_RSQ); float* rskv = (float*)(F.ws + WS_RSKV); const float* rope = (const float*)(F.ws + WS_ROPE);
    for (int row = gw; row < M; row += NGW) {
        const bf16* zr = Z + (size_t)row * ZLD;
        const float a0 = bf2f(zr[ZB_CQ + F.lane]), a1 = bf2f(zr[ZB_CQ + 64 + F.lane]), a2 = bf2f(zr[ZB_CQ + 128 + F.lane]);
        const float b0 = bf2f(zr[ZB_CKV + F.lane]), b1 = bf2f(zr[ZB_CKV + 64 + F.lane]);
        const float sq = wave_sum(a0 * a0 + a1 * a1 + a2 * a2), skv = wave_sum(b0 * b0 + b1 * b1);
        if (F.lane == 0) { rsq[row] = rsqrtf(sq * (1.f / 192.f) + RMS_EPS); rskv[row] = rsqrtf(skv * (1.f / 128.f) + RMS_EPS); }
        if (F.lane < 16) { const unsigned pr = *(const unsigned*)(zr + ZB_PE + 2 * F.lane); const float x1 = bf2f((unsigned short)(pr & 0xffffu)), x2 = bf2f((unsigned short)(pr >> 16));
            const float cs = rope[((size_t)(row & 8191) * 16 + F.lane) * 2], sn = rope[((size_t)(row & 8191) * 16 + F.lane) * 2 + 1];
            const unsigned o = pk2(x1 * cs - x2 * sn, x1 * sn + x2 * cs);
#pragma unroll
            for (int hd = 0; hd < 4; ++hd) *(unsigned*)(KM + (size_t)row * 384 + hd * 96 + 64 + 2 * F.lane) = o; }
    }
    { bf16* KMH = (bf16*)(F.ws + WS_KMH); bf16* KML = (bf16*)(F.ws + WS_KML);
      for (int it = gw; it < NB * 4 * 32; it += NGW) { const int j = it & 31, hd = (it >> 5) & 3, b = it >> 7; const int ts = F.lane >> 3, ch = F.lane & 7;
          float acc[8] = {0.f, 0.f, 0.f, 0.f, 0.f, 0.f, 0.f, 0.f};
          for (int i = 0; i < 32; ++i) { const v4u w = *(const v4u*)(Z + (size_t)(b * SEQ + j * 256 + 8 * i + ts) * ZLD + ZD_K + hd * 64 + ch * 8);
#pragma unroll
              for (int e = 0; e < 4; ++e) { acc[2 * e] += __uint_as_float(w[e] << 16); acc[2 * e + 1] += __uint_as_float(w[e] & 0xffff0000u); } }
#pragma unroll
          for (int e = 0; e < 8; ++e) { acc[e] += __shfl_xor(acc[e], 8); acc[e] += __shfl_xor(acc[e], 16); acc[e] += __shfl_xor(acc[e], 32); }
          if (F.lane < 8) { unsigned hi[4], lo[4];
#pragma unroll
              for (int e = 0; e < 4; ++e) { const float m0 = acc[2 * e] * (1.f / 256.f), m1 = acc[2 * e + 1] * (1.f / 256.f); const unsigned h0 = f2bf(m0), h1 = f2bf(m1);
                  hi[e] = h0 | (h1 << 16); lo[e] = pk2(m0 - __uint_as_float(h0 << 16), m1 - __uint_as_float(h1 << 16)); }
              *(v4u*)(KMH + (size_t)it * 64 + ch * 8) = (v4u){hi[0], hi[1], hi[2], hi[3]}; *(v4u*)(KML + (size_t)it * 64 + ch * 8) = (v4u){lo[0], lo[1], lo[2], lo[3]}; } } }
    if (gw == 0) { const float* pp = (const float*)(F.ws + WS_POSP) + (size_t)l * 2 * 32 * 128; float* pb = (float*)(F.ws + WS_POSB) + l * 256;
        for (int i = F.lane; i < 256; i += 64) { const int j = i & 127, wh = i >> 7; float s = 0.f; for (int kr = 0; kr < 32; ++kr) s += pp[(wh * 32 + kr) * 128 + j]; pb[i] = s; } }
}

__device__ __forceinline__ float gelu_tanh(float x) { const float u = 0.7978845608028654f * (x + 0.044715f * x * x * x); const float e = __expf(2.f * u); return x * (1.f - 1.f / (e + 1.f)); }
__device__ __forceinline__ void p_compress(Frame& F, int l) {
    const bf16* Z = (const bf16*)(F.ws + WS_Z);
    unsigned char* wb = F.ws + WS_W + (size_t)l * WS_WL;
    LAS float* red = (LAS float*)F.lds;
    const int r = F.lane & 31, h = F.lane >> 5;
    for (int it = F.vcu; it < NB * 16 * 2; it += F.G) {
        const int which = it & 1, itile = (it >> 1) & 15, b = it >> 5;
        const bf16* W1T = (const bf16*)(wb + (which ? W_1V : W_1K)); const bf16* W2T = (const bf16*)(wb + (which ? W_2V : W_2K));
        const int coff = which ? ZC_VC : ZC_KC;
        f32x16 acc[4] = {f32x16{}, f32x16{}, f32x16{}, f32x16{}};
        const bf16* brow = Z + (size_t)(b * SEQ + 16 * (32 * itile + r)) * ZLD + coff + 8 * h;
#pragma unroll 2
        for (int ks = 0; ks < 16; ++ks) { const int tt = 4 * F.wave + (ks >> 2), d0 = ks & 3;
            const bf16x8 bf = *(const bf16x8*)(brow + (size_t)tt * ZLD + d0 * 16);
#pragma unroll
            for (int hb = 0; hb < 4; ++hb) { const bf16x8 af = *(const bf16x8*)(W1T + (size_t)(hb * 32 + r) * 2048 + tt * 64 + d0 * 16 + 8 * h);
                acc[hb] = __builtin_amdgcn_mfma_f32_32x32x16_bf16(af, bf, acc[hb], 0, 0, 0); } }
#pragma unroll
        for (int hb = 0; hb < 4; ++hb)
#pragma unroll
            for (int v = 0; v < 16; ++v) red[((F.wave * 4 + hb) * 16 + v) * 64 + F.lane] = acc[hb][v];
        __syncthreads();
        if (F.wave < 2) {
            const float* pb = (const float*)(F.ws + WS_POSB) + l * 256 + which * 128;
            f32x16 o = f32x16{};
#pragma unroll
            for (int hb = 0; hb < 4; ++hb) { float x[16];
#pragma unroll
                for (int v = 0; v < 16; ++v) { float s = pb[hb * 32 + (v & 3) + 8 * (v >> 2) + 4 * h];
#pragma unroll
                    for (int w8 = 0; w8 < 8; ++w8) s += red[((w8 * 4 + hb) * 16 + v) * 64 + F.lane];
                    x[v] = gelu_tanh(s); }
#pragma unroll
                for (int s2 = 0; s2 < 2; ++s2) {
                    v4u pw; pw.x = fa::cvtpk(x[8 * s2], x[8 * s2 + 1]); pw.y = fa::cvtpk(x[8 * s2 + 2], x[8 * s2 + 3]); pw.z = fa::cvtpk(x[8 * s2 + 4], x[8 * s2 + 5]); pw.w = fa::cvtpk(x[8 * s2 + 6], x[8 * s2 + 7]);
                    const bf16* wr = W2T + (size_t)(F.wave * 32 + r) * 128 + hb * 32 + 16 * s2 + 4 * h;
                    const v2u a0 = *(const v2u*)wr, a1 = *(const v2u*)(wr + 8);
                    const v4u aw = (v4u){a0.x, a0.y, a1.x, a1.y};
                    o = __builtin_amdgcn_mfma_f32_32x32x16_bf16(__builtin_bit_cast(bf16x8, aw), __builtin_bit_cast(bf16x8, pw), o, 0, 0, 0); } }
            bf16* dst = (bf16*)(F.ws + (which ? WS_VCMP : WS_KCMP)) + (size_t)(b * 512 + 32 * itile + r) * 64 + F.wave * 32 + 4 * h;
#pragma unroll
            for (int g = 0; g < 4; ++g) { v2u w; w.x = fa::cvtpk(o[4 * g], o[4 * g + 1]); w.y = fa::cvtpk(o[4 * g + 2], o[4 * g + 3]); *(v2u*)(dst + 8 * g) = w; }
        }
        __syncthreads();
    }
}
using fa::bf16x8;
__device__ __forceinline__ unsigned char* launder_ptr(unsigned char* p) { const unsigned long long v = (unsigned long long)p; unsigned lo = __builtin_amdgcn_readfirstlane((unsigned)v), hi = __builtin_amdgcn_readfirstlane((unsigned)(v >> 32)); asm volatile("" : "+s"(lo), "+s"(hi)); return (unsigned char*)(((unsigned long long)hi << 32) | lo); }
#define UNIT_BEGIN() Frame F = F0; { int tid_ = F0.tid; asm volatile("" : "+v"(tid_)); int bx_ = __builtin_amdgcn_readfirstlane(F0.bx); asm volatile("" : "+s"(bx_)); \
    F.ws = launder_ptr(F0.ws); F.tid = tid_; F.lane = tid_ & 63; F.wave = __builtin_amdgcn_readfirstlane(tid_ >> 6); F.bx = bx_; }
__device__ __forceinline__ void u_mla(const Frame& F0, int b, int hd, int u) {
    UNIT_BEGIN();
    GAS char* ws = (GAS char*)F.ws;
    const int r = F.lane & 31, h = F.lane >> 5, q0 = 256 * u, wq0 = q0 + 32 * F.wave, tq = wq0 + r;
    bf16x8 qf[6]; { const unsigned qrow = (unsigned)WS_QM + (unsigned)(b * SEQ + tq) * 1024u;
      const float rs = *(const GAS float*)(ws + ((unsigned)WS_RSQ + (unsigned)(b * SEQ + tq) * 4u));
#pragma unroll
      for (int d0 = 0; d0 < 4; ++d0) { const fa::u32x4 raw = *(const GAS fa::u32x4*)(ws + (qrow + (unsigned)(hd * 128 + d0 * 32 + 16 * h))); fa::u32x4 o;
          o.x = fa::cvtpk(__uint_as_float(raw.x << 16) * rs, __uint_as_float(raw.x & 0xffff0000u) * rs); o.y = fa::cvtpk(__uint_as_float(raw.y << 16) * rs, __uint_as_float(raw.y & 0xffff0000u) * rs);
          o.z = fa::cvtpk(__uint_as_float(raw.z << 16) * rs, __uint_as_float(raw.z & 0xffff0000u) * rs); o.w = fa::cvtpk(__uint_as_float(raw.w << 16) * rs, __uint_as_float(raw.w & 0xffff0000u) * rs);
          qf[d0] = __builtin_bit_cast(bf16x8, o); }
#pragma unroll
      for (int d0 = 0; d0 < 2; ++d0) {
          const fa::u32x4 raw = *(const GAS fa::u32x4*)(ws + (qrow + (unsigned)(512 + hd * 64 + d0 * 32 + 16 * h)));
          const GAS float* rp = (const GAS float*)(ws + ((unsigned)WS_ROPE + (unsigned)((tq * 16 + d0 * 8 + 4 * h) * 8)));
          const fa::f32x4v r0 = *(const GAS fa::f32x4v*)rp * rs, r1 = *(const GAS fa::f32x4v*)(rp + 4) * rs;
          fa::u32x4 o;
          { const float x1 = __uint_as_float(raw.x << 16), x2 = __uint_as_float(raw.x & 0xffff0000u); o.x = fa::cvtpk(x1 * r0[0] - x2 * r0[1], x1 * r0[1] + x2 * r0[0]); }
          { const float x1 = __uint_as_float(raw.y << 16), x2 = __uint_as_float(raw.y & 0xffff0000u); o.y = fa::cvtpk(x1 * r0[2] - x2 * r0[3], x1 * r0[3] + x2 * r0[2]); }
          { const float x1 = __uint_as_float(raw.z << 16), x2 = __uint_as_float(raw.z & 0xffff0000u); o.z = fa::cvtpk(x1 * r1[0] - x2 * r1[1], x1 * r1[1] + x2 * r1[0]); }
          { const float x1 = __uint_as_float(raw.w << 16), x2 = __uint_as_float(raw.w & 0xffff0000u); o.w = fa::cvtpk(x1 * r1[2] - x2 * r1[3], x1 * r1[3] + x2 * r1[2]); }
          qf[4 + d0] = __builtin_bit_cast(bf16x8, o); } }
    SM st; fa::sm_init(st);
    LAS char* lds = (LAS char*)F.lds;
    fa::fa_loop<96, false>(st, qf, ws, (unsigned)WS_KM + (unsigned)b * (SEQ * 768u) + (unsigned)hd * 192u, 768u, (unsigned)WS_VM + (unsigned)b * (SEQ * 512u) + (unsigned)hd * 128u, 512u, SEQ - 1, 4 * u + 4,
        [](int t) { return 64 * t; },
        [=](int t, bool& act, bool& ew, float& cb, int& lo, int& hi) { const int key0 = 64 * t; act = key0 <= wq0 + 31; ew = key0 + 63 > wq0; cb = 0.f; lo = -100000; hi = tq - key0; },
        0.f, lds + FA_STAGES, F.tid, F.lane);
    f32x16 acc[2] = {f32x16{}, f32x16{}}; fa::sm_finish(st, 1.f, acc);
    fa::store_out(acc, lds + FA_OST + F.wave * 32 * fa::OSTR, ws, [=](int col) { return (unsigned)WS_O + (unsigned)(b * SEQ + wq0 + col) * 2048u + (unsigned)(256 + hd * 64) * 2u; }, F.lane);
}
__device__ __forceinline__ void u_moba(const Frame& F0, int b, int hd, int i) {
    UNIT_BEGIN();
    GAS char* ws = (GAS char*)F.ws;
    const int r = F.lane & 31, h = F.lane >> 5, q0 = 256 * i, wq0 = q0 + 32 * F.wave, tq = wq0 + r;
    bf16x8 qf[4]; fa::load_q<64>(qf, ws, (unsigned)WS_Z + (unsigned)(b * SEQ + tq) * (ZLD * 2u) + (unsigned)(ZD_Q + hd * 64) * 2u, h);
    unsigned bits = 0u;
    if (i > 0) {
        const GAS bf16* KMH = (const GAS bf16*)(ws + ((unsigned)WS_KMH + (unsigned)(((b * 4 + hd) * 32 + r) * 64 + 8 * h) * 2u)); const GAS bf16* KML = (const GAS bf16*)(ws + ((unsigned)WS_KML + (unsigned)(((b * 4 + hd) * 32 + r) * 64 + 8 * h) * 2u));
        f32x16 g = f32x16{};
#pragma unroll
        for (int d0 = 0; d0 < 4; ++d0) { const bf16x8 ah = *(const GAS bf16x8*)(KMH + d0 * 16), al = *(const GAS bf16x8*)(KML + d0 * 16);
            g = __builtin_amdgcn_mfma_f32_32x32x16_bf16(ah, qf[d0], g, 0, 0, 0); g = __builtin_amdgcn_mfma_f32_32x32x16_bf16(al, qf[d0], g, 0, 0, 0); }
        float og[16];
#pragma unroll
        for (int v = 0; v < 16; ++v) { const int j = (v & 3) + 8 * (v >> 2) + 4 * h; if (j >= i) g[v] = -INFINITY; og[v] = __shfl_xor(g[v], 32); }
#pragma unroll
        for (int v = 0; v < 16; ++v) { const int j = (v & 3) + 8 * (v >> 2) + 4 * h; int rank = 0;
#pragma unroll
            for (int w = 0; w < 16; ++w) { const int jm = (w & 3) + 8 * (w >> 2) + 4 * h, jo = (w & 3) + 8 * (w >> 2) + 4 * (1 - h);
                rank += (g[w] > g[v] || (g[w] == g[v] && jm < j)) ? 1 : 0; rank += (og[w] > g[v] || (og[w] == g[v] && jo < j)) ? 1 : 0; }
            if (rank < 3 && j < i) bits |= 1u << j; }
        bits |= __shfl_xor(bits, 32);
    }
    const float sl = slope2_of(2 + 3 * hd);
    LAS char* lds = (LAS char*)F.lds;
    LAS char* Qimg = lds + MB_Q;
    LAS float* Ost = (LAS float*)(lds + MB_O);
    LAS float* MLst = (LAS float*)(lds + MB_ML);
    LAS unsigned* cnt = (LAS unsigned*)(lds + MB_CNT);
    LAS unsigned char* lst = (LAS unsigned char*)(lds + MB_LST);
    const unsigned koff = (unsigned)WS_Z + (unsigned)b * (SEQ * ZLD * 2u) + (unsigned)(ZD_K + hd * 64) * 2u, voff = (unsigned)WS_Z + (unsigned)b * (SEQ * ZLD * 2u) + (unsigned)(ZD_V + hd * 64) * 2u;
    if (F.tid < 32) cnt[F.tid] = 0u;
#pragma unroll
    for (int d0 = 0; d0 < 4; ++d0) *(LAS bf16x8*)(Qimg + (32 * F.wave + r) * 128 + d0 * 32 + h * 16) = qf[d0];
    {
        SM st; fa::sm_init(st);
        fa::fa_loop<64, true>(st, qf, ws, koff, ZLD * 2u, voff, ZLD * 2u, SEQ - 1, 4,
            [=](int t) { return q0 + 64 * t; },
            [=](int t, bool& act, bool& ew, float& cb, int& lo, int& hi) { const int key0 = q0 + 64 * t; act = key0 <= wq0 + 31; ew = key0 + 63 > wq0; cb = sl * (float)(64 * t + 4 * h); lo = -100000; hi = tq - key0; },
            sl, lds + FA_STAGES, F.tid, F.lane);
        const float lt = fa::xhalf_sum(st.l);
        LAS float* orow = Ost + (32 * F.wave + r) * 64;
#pragma unroll
        for (int db = 0; db < 2; ++db)
#pragma unroll
            for (int g = 0; g < 4; ++g) *(LAS fa::f32x4v*)(orow + 32 * db + 8 * g + 4 * h) = (fa::f32x4v){st.o[db][4 * g], st.o[db][4 * g + 1], st.o[db][4 * g + 2], st.o[db][4 * g + 3]};
        if (h == 0) { MLst[(32 * F.wave + r) * 2] = st.m; MLst[(32 * F.wave + r) * 2 + 1] = lt; }
    }
    if (h == 0) { unsigned bb = bits;
        while (bb) { const int j = __ffs(bb) - 1; bb &= bb - 1u; const unsigned slot = __hip_atomic_fetch_add(&cnt[j], 1u, __ATOMIC_RELAXED, __HIP_MEMORY_SCOPE_WORKGROUP); lst[j * 256 + slot] = (unsigned char)(32 * F.wave + r); } }
    LDS_WAIT(); __syncthreads();
    const int ntile = 4 * i;
    if (ntile > 0) {
        fa::Stg<64> sg;
        fa::stg_load<64>(sg, ws, koff, ZLD * 2u, voff, ZLD * 2u, 0, SEQ - 1, F.tid); fa::stg_store<64>(sg, lds + FA_STAGES, F.tid); __syncthreads();
        SM st; fa::sm_init(st); bf16x8 qfb[4] = {qf[0], qf[1], qf[2], qf[3]}; bool myact = false, colv = false; int qsel = 0;
        for (int t = 0; t < ntile; ++t) {
            const LAS char* buf = lds + FA_STAGES + (t & 1) * 16384;
            if (t + 1 < ntile) fa::stg_load<64>(sg, ws, koff, ZLD * 2u, voff, ZLD * 2u, 64 * (t + 1), SEQ - 1, F.tid);
            if ((t & 3) == 0) { const int j = t >> 2; const int n = (int)cnt[j]; myact = 32 * F.wave < n; colv = (32 * F.wave + r) < n; qsel = colv ? (int)lst[j * 256 + 32 * F.wave + r] : 0;
                if (myact) { fa::sm_init(st);
#pragma unroll
                    for (int d0 = 0; d0 < 4; ++d0) qfb[d0] = *(const LAS bf16x8*)(Qimg + qsel * 128 + d0 * 32 + h * 16); } }
            if (myact) { fa::f32x16 p0, p1; bf16x8 pf[4];
                fa::score_tile<64, true>(p0, p1, buf, qfb, colv ? sl * (float)(64 * t - q0 + 4 * h) : fa::MASKV, sl, F.lane);
                fa::sm_step(st, p0, p1, pf);
                fa::pv(st.o, buf + 8192, pf, F.lane);
                if ((t & 3) == 3) {
                    const float lp = fa::xhalf_sum(st.l);
                    if (colv) { const float ms = MLst[qsel * 2], ls = MLst[qsel * 2 + 1]; const float mn = fmaxf(ms, st.m), ea = fa::ex2(ms - mn), eb = fa::ex2(st.m - mn);
                        LAS float* orow = Ost + qsel * 64;
#pragma unroll
                        for (int db = 0; db < 2; ++db)
#pragma unroll
                            for (int g = 0; g < 4; ++g) { LAS fa::f32x4v* p = (LAS fa::f32x4v*)(orow + 32 * db + 8 * g + 4 * h); const fa::f32x4v o4 = *p;
                                *p = (fa::f32x4v){o4[0] * ea + st.o[db][4 * g] * eb, o4[1] * ea + st.o[db][4 * g + 1] * eb, o4[2] * ea + st.o[db][4 * g + 2] * eb, o4[3] * ea + st.o[db][4 * g + 3] * eb}; }
                        asm volatile("s_waitcnt lgkmcnt(0)" ::: "memory");
                        if (h == 0) { MLst[qsel * 2] = mn; MLst[qsel * 2 + 1] = ls * ea + lp * eb; } } } }
            if (t + 1 < ntile) fa::stg_store<64>(sg, lds + FA_STAGES + ((t + 1) & 1) * 16384, F.tid);
            __syncthreads();
        }
    }
    { const int q = 32 * F.wave + (F.lane >> 1), hf = F.lane & 1; const float inv = 1.f / fmaxf(MLst[q * 2 + 1], fa::TINYF);
      const LAS float* orow = Ost + q * 64 + 32 * hf;
      GAS char* dst = ws + ((unsigned)WS_O + (unsigned)(b * SEQ + q0 + q) * 2048u + (unsigned)(768 + hd * 64 + 32 * hf) * 2u);
#pragma unroll
      for (int c = 0; c < 4; ++c) { const fa::f32x4v x0 = *(const LAS fa::f32x4v*)(orow + 8 * c), x1 = *(const LAS fa::f32x4v*)(orow + 8 * c + 4);
          fa::u32x4 w; w.x = fa::cvtpk(x0[0] * inv, x0[1] * inv); w.y = fa::cvtpk(x0[2] * inv, x0[3] * inv); w.z = fa::cvtpk(x1[0] * inv, x1[1] * inv); w.w = fa::cvtpk(x1[2] * inv, x1[3] * inv);
          *(GAS fa::u32x4*)(dst + 16 * c) = w; } }
    LDS_WAIT(); __syncthreads();
}
__device__ __forceinline__ void u_swa(const Frame& F0, int b, int kvh, int u, const float* sinks) {
    UNIT_BEGIN();
    GAS char* ws = (GAS char*)F.ws;
    const int r = F.lane & 31, h = F.lane >> 5, q0 = 128 * u, wq0 = q0 + 16 * F.wave, tq = wq0 + (r >> 1), hd = kvh * 2 + (r & 1);
    bf16x8 qf[4]; fa::load_q<64>(qf, ws, (unsigned)WS_Z + (unsigned)(b * SEQ + tq) * (ZLD * 2u) + (unsigned)(ZA_Q + hd * 64) * 2u, h);
    const float sl = slope2_of(3 * hd);
    const int t0 = (2 * u - 2) > 0 ? (2 * u - 2) : 0, nt = 2 * u + 2 - t0;
    SM st; fa::sm_init(st);
    LAS char* lds = (LAS char*)F.lds;
    fa::fa_loop<64, true>(st, qf, ws, (unsigned)WS_Z + (unsigned)b * (SEQ * ZLD * 2u) + (unsigned)(ZA_K + kvh * 64) * 2u, ZLD * 2u, (unsigned)WS_Z + (unsigned)b * (SEQ * ZLD * 2u) + (unsigned)(ZA_V + kvh * 64) * 2u, ZLD * 2u, SEQ - 1, nt,
        [=](int t) { return 64 * (t0 + t); },
        [=](int t, bool& act, bool& ew, float& cb, int& lo, int& hi) { const int key0 = 64 * (t0 + t); act = (key0 <= wq0 + 15) && (key0 + 63 >= wq0 - 127); ew = true;
            cb = sl * (float)(key0 - q0 + 4 * h); lo = tq - 127 - key0; hi = tq - key0; },
        sl, lds + FA_STAGES, F.tid, F.lane);
    const float sk = sinks[hd] * LOG2E + sl * (float)(tq - q0), mf = fmaxf(st.m, sk), a = fa::ex2(st.m - mf);
    const float ltot = fa::xhalf_sum(st.l) * a + fa::ex2(sk - mf), inv = a / fmaxf(ltot, fa::TINYF);
    f32x16 acc[2]; acc[0] = st.o[0] * inv; acc[1] = st.o[1] * inv;
    fa::store_out(acc, lds + FA_OST + F.wave * 32 * fa::OSTR, ws, [=](int col) { return (unsigned)WS_O + (unsigned)(b * SEQ + wq0 + (col >> 1)) * 2048u + (unsigned)((kvh * 2 + (col & 1)) * 64) * 2u; }, F.lane);
}
__device__ __forceinline__ void u_nsa(const Frame& F0, int b, int qi) {
    UNIT_BEGIN();
    GAS char* ws = (GAS char*)F.ws;
    const unsigned KC = (unsigned)WS_KCMP + (unsigned)b * (512u * 128u), VC = (unsigned)WS_VCMP + (unsigned)b * (512u * 128u), ZB = (unsigned)WS_Z + (unsigned)b * (SEQ * ZLD * 2u);
    const int r = F.lane & 31, h = F.lane >> 5, q0 = 64 * qi, wq0 = q0 + 8 * F.wave, qloc = 8 * F.wave + (r >> 2), tq = q0 + qloc, hd = r & 3;
    const unsigned zrow_off = ZB + (unsigned)tq * (ZLD * 2u); const GAS bf16* zrow = (const GAS bf16*)(ws + zrow_off);
    bf16x8 qf[4]; fa::load_q<64>(qf, ws, zrow_off + (unsigned)(ZC_Q + hd * 64) * 2u, h);
    const float sl = slope2_of(1 + 3 * hd);
    const float g0 = 1.f / (1.f + __expf(-bf2f(zrow[ZC_GL + hd]))), g1 = 1.f / (1.f + __expf(-bf2f(zrow[ZC_GL + 4 + hd]))), g2 = 1.f / (1.f + __expf(-bf2f(zrow[ZC_GL + 8 + hd])));
    LAS char* lds = (LAS char*)F.lds;
    LAS float* impA = (LAS float*)(lds + FA_IMP) + F.wave * 1024;
    LAS float* impB = (LAS float*)(lds + FA_OST) + F.wave * 1024;
    LAS unsigned* selm = (LAS unsigned*)(lds + FA_SELM);
    LAS unsigned* um = (LAS unsigned*)(lds + FA_UM);
    LAS float* vals = (LAS float*)(lds + FA_VALS) + F.wave * 128;
    if (F.tid < 4) um[F.tid] = 0u;
    GAS float* park = (GAS float*)(ws + ((unsigned)WS_PARK + (unsigned)((F.bx * NWAVES + F.wave) * 2 * 32 * 64 + F.lane) * 4u));
    const int ntc = ((4 * qi + 3) >> 6) + 1;
    const int cvis = (tq - 31) >> 4;
    const int cvis_min = (q0 - 31) >> 4;
    const float slc = 16.f * sl;
    SM st; fa::sm_init(st);
    fa::fa_loop<64, true>(st, qf, ws, KC, 128u, VC, 128u, 510, ntc,
        [](int t) { return 64 * t; },
        [=](int t, bool& act, bool& ew, float& cb, int& lo, int& hi) { const int c0 = 64 * t; act = true; ew = c0 + 63 > cvis_min; cb = slc * (float)(c0 - 4 * qi + 4 * h); lo = -100000; hi = cvis - c0; },
        slc, lds + FA_STAGES, F.tid, F.lane);
    { f32x16 t2[2] = {f32x16{}, f32x16{}}; fa::sm_finish(st, g0, t2);
#pragma unroll
      for (int v = 0; v < 16; ++v) { park[v * 64] = t2[0][v]; park[(16 + v) * 64] = t2[1][v]; } }
    {
        const float mfin = st.m, invl = 1.f / fmaxf(fa::xhalf_sum(st.l), fa::TINYF);
        constexpr int STG = fa::stage_bytes<64>();
        fa::Stg<64> sg;
        fa::stg_load<64>(sg, ws, KC, 128u, VC, 128u, 0, 510, F.tid); fa::stg_store<64>(sg, lds + FA_STAGES, F.tid); __syncthreads();
        for (int t = 0; t < ntc; ++t) {
            const LAS char* buf = lds + FA_STAGES + (t & 1) * STG;
            if (t + 1 < ntc) fa::stg_load<64>(sg, ws, KC, 128u, VC, 128u, 64 * (t + 1), 510, F.tid);
            const int c0 = 64 * t;
            f32x16 p0, p1; fa::score_tile<64, true>(p0, p1, buf, qf, slc * (float)(c0 - 4 * qi + 4 * h), slc, F.lane);
            if (c0 + 63 > cvis_min) fa::mask_ew(p0, p1, -100000, cvis - c0, h);
#pragma unroll
            for (int kh = 0; kh < 2; ++kh)
#pragma unroll
                for (int g = 0; g < 4; ++g) {
                    float e0, e1, e2, e3;
                    if (kh == 0) { e0 = fa::ex2(p0[4 * g] - mfin); e1 = fa::ex2(p0[4 * g + 1] - mfin); e2 = fa::ex2(p0[4 * g + 2] - mfin); e3 = fa::ex2(p0[4 * g + 3] - mfin); }
                    else { e0 = fa::ex2(p1[4 * g] - mfin); e1 = fa::ex2(p1[4 * g + 1] - mfin); e2 = fa::ex2(p1[4 * g + 2] - mfin); e3 = fa::ex2(p1[4 * g + 3] - mfin); }
                    e0 *= invl; e1 *= invl; e2 *= invl; e3 *= invl;
                    float s4 = ((e0 + e1) + e2) + e3;
                    s4 += __shfl_xor(s4, 1); s4 += __shfl_xor(s4, 2); e3 += __shfl_xor(e3, 1); e3 += __shfl_xor(e3, 2);
                    const int j = 16 * t + 8 * kh + 2 * g + h;
                    if (hd == 0) { impA[(r >> 2) * 128 + j] = s4; impB[(r >> 2) * 128 + j] = e3; }
                }
            if (t + 1 < ntc) fa::stg_store<64>(sg, lds + FA_STAGES + ((t + 1) & 1) * STG, F.tid);
            __syncthreads();
        }
    }
    {
        const int cur = qi;
        for (int qq = 0; qq < 8; ++qq) {
            unsigned long long m0, m1;
            if (cur < 16) { m0 = (cur >= 63) ? ~0ull : ((1ull << (cur + 1)) - 1ull); m1 = 0ull; }
            else {
                const int ja = F.lane, jb2 = F.lane + 64;
                const bool fca = (ja == 0 || ja == cur || ja == cur - 1), fcb = (jb2 == cur || jb2 == cur - 1);
                const float va = impA[qq * 128 + ja] + (ja > 0 ? impB[qq * 128 + ja - 1] : 0.f), vb = impA[qq * 128 + jb2] + impB[qq * 128 + jb2 - 1];
                const unsigned ka = (ja <= cur && !fca) ? (__float_as_uint(va) + 1u) : 0u, kb = (jb2 <= cur && !fcb) ? (__float_as_uint(vb) + 1u) : 0u;
                unsigned T = 0u;
                for (int bit = 31; bit >= 0; --bit) { const unsigned cand = T | (1u << bit); const int c = __popcll(__ballot(ka >= cand)) + __popcll(__ballot(kb >= cand)); if (c >= 13) T = cand; }
                if (T == 0u) T = 1u;
                const unsigned long long ga = __ballot(ka > T), gb = __ballot(kb > T), ea = __ballot(ka == T), eb = __ballot(kb == T);
                const int R = 13 - (__popcll(ga) + __popcll(gb)), na = __popcll(ea);
                const int pa = (int)__builtin_amdgcn_mbcnt_hi((unsigned)(ea >> 32), __builtin_amdgcn_mbcnt_lo((unsigned)ea, 0u)), pb = (int)__builtin_amdgcn_mbcnt_hi((unsigned)(eb >> 32), __builtin_amdgcn_mbcnt_lo((unsigned)eb, 0u));
                m0 = ga | __ballot(ka == T && pa < R) | 1ull; m1 = gb | __ballot(kb == T && (na + pb) < R);
                if (cur < 64) m0 |= 1ull << cur; else m1 |= 1ull << (cur - 64);
                if (cur - 1 < 64) m0 |= 1ull << (cur - 1); else m1 |= 1ull << (cur - 65);
            }
            if (F.lane == 0) { LAS unsigned* sp = selm + (8 * F.wave + qq) * 4; sp[0] = (unsigned)m0; sp[1] = (unsigned)(m0 >> 32); sp[2] = (unsigned)m1; sp[3] = (unsigned)(m1 >> 32);
                __hip_atomic_fetch_or(&um[0], (unsigned)m0, __ATOMIC_RELAXED, __HIP_MEMORY_SCOPE_WORKGROUP); __hip_atomic_fetch_or(&um[1], (unsigned)(m0 >> 32), __ATOMIC_RELAXED, __HIP_MEMORY_SCOPE_WORKGROUP); __hip_atomic_fetch_or(&um[2], (unsigned)m1, __ATOMIC_RELAXED, __HIP_MEMORY_SCOPE_WORKGROUP); __hip_atomic_fetch_or(&um[3], (unsigned)(m1 >> 32), __ATOMIC_RELAXED, __HIP_MEMORY_SCOPE_WORKGROUP); }
        }
        LDS_WAIT(); __syncthreads();
    }
    {
        const unsigned uw0 = um[0], uw1 = um[1], uw2 = um[2], uw3 = um[3];
        const LAS unsigned* selq = selm + qloc * 4;
        const int nsel = __builtin_amdgcn_readfirstlane(__popc(uw0) + __popc(uw1) + __popc(uw2) + __popc(uw3));
        LAS unsigned char* slist = (LAS unsigned char*)(lds + FA_VALS);
        if (F.tid < 128) { const int j = F.tid; const unsigned w = (j < 32) ? uw0 : (j < 64) ? uw1 : (j < 96) ? uw2 : uw3;
            if ((w >> (j & 31)) & 1u) { int pos = __popc(w & ((1u << (j & 31)) - 1u)); if (j >= 32) pos += __popc(uw0); if (j >= 64) pos += __popc(uw1); if (j >= 96) pos += __popc(uw2); slist[pos] = (unsigned char)j; } }
        LDS_WAIT(); __syncthreads();
        fa::sm_init(st);
        fa::fa_loop<64, true>(st, qf, ws, ZB + ZC_KS * 2u, ZLD * 2u, ZB + ZC_VS * 2u, ZLD * 2u, SEQ - 1, nsel,
            [=](int t) { return 64 * (int)slist[t]; },
            [=](int t, bool& act, bool& ew, float& cb, int& lo, int& hi) { const int j = (int)slist[t], key0 = 64 * j; const unsigned mw = selq[j >> 5];
                const bool on = (mw >> (j & 31)) & 1u; act = __any(on) != 0; ew = (j == qi); cb = on ? sl * (float)(key0 - q0 + 4 * h) : fa::MASKV; lo = -100000; hi = tq - key0; },
            sl, lds + FA_STAGES, F.tid, F.lane);
        { f32x16 t2[2] = {f32x16{}, f32x16{}}; fa::sm_finish(st, g1, t2);
#pragma unroll
          for (int v = 0; v < 16; ++v) { park[(32 + v) * 64] = t2[0][v]; park[(48 + v) * 64] = t2[1][v]; } }
    }
    {
        const int t0 = (qi - 8) > 0 ? (qi - 8) : 0, nt = qi + 1 - t0;
        fa::sm_init(st);
        fa::fa_loop<64, true>(st, qf, ws, ZB + ZC_KW * 2u, ZLD * 2u, ZB + ZC_VW * 2u, ZLD * 2u, SEQ - 1, nt,
            [=](int t) { return 64 * (t0 + t); },
            [=](int t, bool& act, bool& ew, float& cb, int& lo, int& hi) { const int j = t0 + t, key0 = 64 * j; act = true; ew = (j == qi) || (j == qi - 8);
                cb = sl * (float)(key0 - q0 + 4 * h); lo = tq - 511 - key0; hi = tq - key0; },
            sl, lds + FA_STAGES, F.tid, F.lane);
    }
    f32x16 acc[2] = {f32x16{}, f32x16{}}; fa::sm_finish(st, g2, acc);
#pragma unroll
    for (int v = 0; v < 16; ++v) { acc[0][v] += park[v * 64] + park[(32 + v) * 64]; acc[1][v] += park[(16 + v) * 64] + park[(48 + v) * 64]; }
    fa::store_out(acc, lds + FA_OST + F.wave * 32 * fa::OSTR, ws, [=](int col) { return (unsigned)WS_O + (unsigned)(b * SEQ + wq0 + (col >> 2)) * 2048u + (unsigned)(512 + (col & 3) * 64) * 2u; }, F.lane);
}

__device__ __forceinline__ void p_attn(Frame& F, const float* sinks, int mskip) {
    const int id = F.vcu;
    if (F.G != 256) return;
    { const int bh = id >> 4, s = id & 15;
#pragma unroll 1
      for (int k = 0; k < (((mskip >> 9) & 1) ? 4 : 2); ++k) u_mla(F, bh >> 2, bh & 3, (k & 1) ? s : 31 - s); }
    { const int bh = id >> 4, s = id & 15;
#pragma unroll 1
      for (int k = 0; k < (((mskip >> 11) & 1) ? 4 : 2); ++k) u_moba(F, bh >> 2, bh & 3, (k & 1) ? s : 31 - s); }
    if (!(mskip & 4)) { const int b = id >> 6, s = id & 63;
#pragma unroll 1
      for (int k = 0; k < (((mskip >> 10) & 1) ? 4 : 2); ++k) u_nsa(F, b, (k & 1) ? s : 127 - s); }
    {
#pragma unroll 1
      for (int k = 0; k < (((mskip >> 8) & 1) ? 4 : 2); ++k) { const int u0 = 2 * id + (k & 1); u_swa(F, u0 >> 7, (u0 >> 6) & 1, u0 & 63, sinks); } }
}
constexpr int PH_PRO = 0, PH_L0 = 1, PH_PER_L = 9, PH_FIN = 19, PH_END = 20;
constexpr int PO_NORM1 = 0, PO_ZG = 1, PO_PREP = 2, PO_UP = 3, PO_ATTN = 4, PO_OG = 5, PO_NORM2 = 6, PO_UPG = 7, PO_DNG = 8;
#ifndef MK_PHASE_MASK
#define MK_PHASE_MASK 0xFFFFFu
#endif

__global__ void __launch_bounds__(NTHR, 2) mega(Args args) {
    extern __shared__ __attribute__((aligned(16))) unsigned char lds_raw[];
    Frame F;
    F.lds = (LAS unsigned char*)lds_raw;
    int wave_s = __builtin_amdgcn_readfirstlane((int)threadIdx.x >> 6); asm volatile("" : "+s"(wave_s));
    F.tid = threadIdx.x; F.lane = F.tid & 63; F.wave = wave_s;
    F.G = gridDim.x; { const int bx = blockIdx.x; F.vcu = (F.G % 8 == 0) ? (bx % 8) * (F.G / 8) + bx / 8 : bx; }
    volatile LAS unsigned* misc = (volatile LAS unsigned*)(F.lds + LDS_MISC);
    if (F.tid < 64) misc[F.tid] = 0u;
    __syncthreads();
    (void)xcd_barrier_post((unsigned*)(args.ws + WS_CTL), misc + 8);
    float* fo; KArgsP ap;
#define KARGS() ({ KArgsP q_ = (KArgsP)__builtin_amdgcn_kernarg_segment_ptr(); asm volatile("" : "+s"(q_)); q_; })
#define IN(k) ({ KArgsP q2_ = KARGS(); q2_->ph_lo <= (k) && (k) < q2_->ph_hi; })
#define PHASE_BEGIN() do { asm volatile("; PHASE_MARK %0" :: "i"(__LINE__)); ap = KARGS(); F.G = gridDim.x; \
        { int w_ = wave_s; asm volatile("" : "+s"(w_)); int t_ = (w_ << 6) | (int)__builtin_amdgcn_mbcnt_hi(~0u, __builtin_amdgcn_mbcnt_lo(~0u, 0u)); asm volatile("" : "+v"(t_)); F.tid = t_; F.lane = t_ & 63; F.wave = w_; } F.ws = ap->ws; int bx_ = (int)blockIdx.x; asm volatile("" : "+s"(bx_)); F.bx = bx_; F.vcu = (F.G % 8 == 0) ? (bx_ % 8) * (F.G / 8) + bx_ / 8 : bx_; fo = ap->out; } while (0)
#define INP(i) (ap->in[i])
#define SEAM(k) do { if (IN(k) && IN((k) + 1)) { XcdBarrier b_; b_.bar = (unsigned*)(KARGS()->ws + WS_CTL); b_.x = xb_xcc_id(); b_.st = (volatile LAS unsigned*)(F.lds + LDS_MISC) + 8; xcd_barrier(b_); } } while (0)

    if (IN(PH_PRO)) { PHASE_BEGIN(); p_prologue(F, ap); }
#ifdef MK_PRO_TWICE
    if (IN(PH_PRO)) { PHASE_BEGIN(); p_prologue(F, ap); }
#endif
    SEAM(PH_PRO);

    { constexpr int l = 0;
        const int pb = PH_L0 + PH_PER_L * l;
#define WB (F.ws + WS_W + (size_t)l * WS_WL)
#define MOD ((const float*)(F.ws + WS_MOD) + (size_t)l * NB * 6 * D)
#define XIN ((l == 0) ? INP(0) : (const float*)fo)
#define H ((bf16*)(F.ws + WS_H))
#define Z ((bf16*)(F.ws + WS_Z))
#define OB ((bf16*)(F.ws + WS_O))
#define U ((bf16*)(F.ws + WS_U))

        if (IN(pb + PO_NORM1) && !((KARGS()->skip >> PO_NORM1) & 1)) { PHASE_BEGIN(); p_norm<0>(F, XIN, INP(2) + l * D, MOD, MOD + D, H, nullptr); }
        SEAM(pb + PO_NORM1);

        if (IN(pb + PO_ZG) && !((KARGS()->skip >> PO_ZG) & 1)) { PHASE_BEGIN();
            pg8::Gemm g{H, (const bf16*)(WB + W_IN), M, ZLD, D, D}; pg8::StaticOrder S; S.init(M, ZLD, F.G, F.bx);
            pg8::EpiBf16<0> E{Z, ZLD, nullptr, 0, 0, 1.f};
            pg8::gemm_phase<pg8::EpiBf16<0>, pg8::StaticOrder, true, true>(F.lds, g, S, E, F.tid);
        }
        SEAM(pb + PO_ZG);

        if (IN(pb + PO_PREP) && !((KARGS()->skip >> PO_PREP) & 1)) { PHASE_BEGIN(); p_prep(F, l); }
        SEAM(pb + PO_PREP);

        if (IN(pb + PO_UP) && !((KARGS()->skip >> PO_UP) & 1)) { PHASE_BEGIN();
            { pg8::Gemm g{Z + ZB_CQ, (const bf16*)(WB + W_UQ), M, 512, 256, ZLD}; pg8::StaticOrder S; S.init(M, 512, F.G, F.bx);
              pg8::EpiBf16<0> E{(bf16*)(F.ws + WS_QM), 512, nullptr, 0, 0, 1.f};
              pg8::gemm_phase<pg8::EpiBf16<0>, pg8::StaticOrder, true, true>(F.lds, g, S, E, F.tid); }
            PHASE_BEGIN();
            { pg8::Gemm g{Z + ZB_CKV, (const bf16*)(WB + W_UKV), M, 512, 256, ZLD}; pg8::StaticOrder S; S.init(M, 512, F.G, F.bx);
              pg8::EpiMlaKV E{(bf16*)(F.ws + WS_KM), (bf16*)(F.ws + WS_VM), (const float*)(F.ws + WS_RSKV)};
              pg8::gemm_phase<pg8::EpiMlaKV, pg8::StaticOrder, true, false>(F.lds, g, S, E, F.tid); }
            PHASE_BEGIN();
            p_compress(F, l);
        }
        SEAM(pb + PO_UP);

        if (IN(pb + PO_ATTN) && !((KARGS()->skip >> PO_ATTN) & 1)) { PHASE_BEGIN(); p_attn(F, INP(8) + l * 4, (ap->skip >> 16) | ((ap->rep >> 20) << 8)); }
        SEAM(pb + PO_ATTN);

        if (IN(pb + PO_OG) && !((KARGS()->skip >> PO_OG) & 1)) { PHASE_BEGIN();
            pg8::Gemm g{OB, (const bf16*)(WB + W_OUT), M, D, D, D}; pg8::StaticOrder S; S.init(M, D, F.G, F.bx);
            pg8::EpiResid E{XIN, fo, MOD + 2 * D};
            pg8::gemm_phase<pg8::EpiResid, pg8::StaticOrder, true, true>(F.lds, g, S, E, F.tid);
        }
        SEAM(pb + PO_OG);

        if (IN(pb + PO_NORM2) && !((KARGS()->skip >> PO_NORM2) & 1)) { PHASE_BEGIN(); p_norm<0>(F, fo, INP(3) + l * D, MOD + 3 * D, MOD + 4 * D, H, nullptr); }
        SEAM(pb + PO_NORM2);

        if (IN(pb + PO_UPG) && !((KARGS()->skip >> PO_UPG) & 1)) { PHASE_BEGIN();
            pg8::Gemm g{H, (const bf16*)(WB + W_UP), M, DFF, D, D}; pg8::StaticOrder S; S.init(M, DFF, F.G, F.bx);
            pg8::EpiRelu2 E{U, DFF};
            pg8::gemm_phase<pg8::EpiRelu2, pg8::StaticOrder, true, true>(F.lds, g, S, E, F.tid);
        }
        SEAM(pb + PO_UPG);

        if (IN(pb + PO_DNG) && !((KARGS()->skip >> PO_DNG) & 1)) { PHASE_BEGIN();
            pg8::Gemm g{U, (const bf16*)(WB + W_DN), M, D, DFF, DFF}; pg8::StaticOrder S; S.init(M, D, F.G, F.bx);
            pg8::EpiResid E{fo, fo, MOD + 5 * D};
            pg8::gemm_phase<pg8::EpiResid, pg8::StaticOrder, true, true>(F.lds, g, S, E, F.tid);
        }
        SEAM(pb + PO_DNG);
    }
    { constexpr int l = 1;
        const int pb = PH_L0 + PH_PER_L * l;
#define WB (F.ws + WS_W + (size_t)l * WS_WL)
#define MOD ((const float*)(F.ws + WS_MOD) + (size_t)l * NB * 6 * D)
#define XIN ((l == 0) ? INP(0) : (const float*)fo)
#define H ((bf16*)(F.ws + WS_H))
#define Z ((bf16*)(F.ws + WS_Z))
#define OB ((bf16*)(F.ws + WS_O))
#define U ((bf16*)(F.ws + WS_U))

        if (IN(pb + PO_NORM1) && !((KARGS()->skip >> PO_NORM1) & 1)) { PHASE_BEGIN(); p_norm<0>(F, XIN, INP(2) + l * D, MOD, MOD + D, H, nullptr); }
        SEAM(pb + PO_NORM1);

        if (IN(pb + PO_ZG) && !((KARGS()->skip >> PO_ZG) & 1)) { PHASE_BEGIN();
            pg8::Gemm g{H, (const bf16*)(WB + W_IN), M, ZLD, D, D}; pg8::StaticOrder S; S.init(M, ZLD, F.G, F.bx);
            pg8::EpiBf16<0> E{Z, ZLD, nullptr, 0, 0, 1.f};
            pg8::gemm_phase<pg8::EpiBf16<0>, pg8::StaticOrder, true, true>(F.lds, g, S, E, F.tid);
        }
        SEAM(pb + PO_ZG);

        if (IN(pb + PO_PREP) && !((KARGS()->skip >> PO_PREP) & 1)) { PHASE_BEGIN(); p_prep(F, l); }
        SEAM(pb + PO_PREP);

        if (IN(pb + PO_UP) && !((KARGS()->skip >> PO_UP) & 1)) { PHASE_BEGIN();
            { pg8::Gemm g{Z + ZB_CQ, (const bf16*)(WB + W_UQ), M, 512, 256, ZLD}; pg8::StaticOrder S; S.init(M, 512, F.G, F.bx);
              pg8::EpiBf16<0> E{(bf16*)(F.ws + WS_QM), 512, nullptr, 0, 0, 1.f};
              pg8::gemm_phase<pg8::EpiBf16<0>, pg8::StaticOrder, true, true>(F.lds, g, S, E, F.tid); }
            PHASE_BEGIN();
            { pg8::Gemm g{Z + ZB_CKV, (const bf16*)(WB + W_UKV), M, 512, 256, ZLD}; pg8::StaticOrder S; S.init(M, 512, F.G, F.bx);
              pg8::EpiMlaKV E{(bf16*)(F.ws + WS_KM), (bf16*)(F.ws + WS_VM), (const float*)(F.ws + WS_RSKV)};
              pg8::gemm_phase<pg8::EpiMlaKV, pg8::StaticOrder, true, false>(F.lds, g, S, E, F.tid); }
            PHASE_BEGIN();
            p_compress(F, l);
        }
        SEAM(pb + PO_UP);

        if (IN(pb + PO_ATTN) && !((KARGS()->skip >> PO_ATTN) & 1)) { PHASE_BEGIN(); p_attn(F, INP(8) + l * 4, (ap->skip >> 16) | ((ap->rep >> 20) << 8)); }
        SEAM(pb + PO_ATTN);

        if (IN(pb + PO_OG) && !((KARGS()->skip >> PO_OG) & 1)) { PHASE_BEGIN();
            pg8::Gemm g{OB, (const bf16*)(WB + W_OUT), M, D, D, D}; pg8::StaticOrder S; S.init(M, D, F.G, F.bx);
            pg8::EpiResid E{XIN, fo, MOD + 2 * D};
            pg8::gemm_phase<pg8::EpiResid, pg8::StaticOrder, true, true>(F.lds, g, S, E, F.tid);
        }
        SEAM(pb + PO_OG);

        if (IN(pb + PO_NORM2) && !((KARGS()->skip >> PO_NORM2) & 1)) { PHASE_BEGIN(); p_norm<0>(F, fo, INP(3) + l * D, MOD + 3 * D, MOD + 4 * D, H, nullptr); }
        SEAM(pb + PO_NORM2);

        if (IN(pb + PO_UPG) && !((KARGS()->skip >> PO_UPG) & 1)) { PHASE_BEGIN();
            pg8::Gemm g{H, (const bf16*)(WB + W_UP), M, DFF, D, D}; pg8::StaticOrder S; S.init(M, DFF, F.G, F.bx);
            pg8::EpiRelu2 E{U, DFF};
            pg8::gemm_phase<pg8::EpiRelu2, pg8::StaticOrder, true, true>(F.lds, g, S, E, F.tid);
        }
        SEAM(pb + PO_UPG);

        if (IN(pb + PO_DNG) && !((KARGS()->skip >> PO_DNG) & 1)) { PHASE_BEGIN();
            pg8::Gemm g{U, (const bf16*)(WB + W_DN), M, D, DFF, DFF}; pg8::StaticOrder S; S.init(M, D, F.G, F.bx);
            pg8::EpiResid E{fo, fo, MOD + 5 * D};
            pg8::gemm_phase<pg8::EpiResid, pg8::StaticOrder, true, true>(F.lds, g, S, E, F.tid);
        }
        SEAM(pb + PO_DNG);
    }
    if (IN(PH_FIN)) { PHASE_BEGIN(); p_norm<1>(F, fo, INP(21), nullptr, nullptr, nullptr, fo); }
#undef IN
#undef SEAM
}
}
extern "C" void kernel_launch(void* const* d_in, const int* in_sizes, int n_in, void* d_out, int out_size, void* d_ws, size_t ws_size, hipStream_t stream) {
    using namespace mk;
    static int grid = 0;
    if (grid == 0) {
        int dev = 0, cus = 0;
        if (hipGetDevice(&dev) != hipSuccess || hipDeviceGetAttribute(&cus, hipDeviceAttributeMultiprocessorCount, dev) != hipSuccess) { grid = -1; return; }
        if (hipFuncSetAttribute((const void*)mega, hipFuncAttributeMaxDynamicSharedMemorySize, LDS_BYTES) != hipSuccess) { grid = -1; return; }
        (void)hipGetLastError();
        grid = cus;
    }
    if (grid < 0) return;
    (void)in_sizes; (void)n_in; (void)out_size; (void)ws_size;
    Args a{};
    for (int i = 0; i < 22; ++i) a.in[i] = (const float*)d_in[i];
    a.out = (float*)d_out; a.ws = (unsigned char*)d_ws; a.skip = 0; a.rep = MK_REP;
    auto launch = [&](int lo, int hi) {
        (void)hipMemsetAsync((char*)d_ws + WS_CTL, 0, CTL_ZERO_BYTES, stream);
        a.ph_lo = lo; a.ph_hi = hi;
        hipLaunchKernelGGL(mega, dim3(grid), dim3(NTHR), LDS_BYTES, stream, a);
    };
    launch(0, PH_END);
}
```

```cpp
#include <hip/hip_runtime.h>
#include <cstdio>
#include <cstdint>
#include <math.h>
#define FA_EXP 0
#define FA_PROBE 0
#define MK_PROBE_IDX 0
#define FA_KO 0
#define MK_MODE 0
#define MK_NAIVE_MASK 0
#define MK_SKIP 0
#define MK_SPLIT 0
#define MK_DBG_PHASE 0
#define MK_DBG_TEST 0
#define MK_REP 0
namespace pg8 {
#define PG8_LAS __attribute__((address_space(3)))
typedef unsigned short bf16_t;
typedef short bf16x8 __attribute__((ext_vector_type(8)));
typedef float f32x4 __attribute__((ext_vector_type(4)));
typedef unsigned u32x4 __attribute__((ext_vector_type(4)));
constexpr int BM = 256, BK = 64, HALF = 128, HTB = HALF * BK * 2  , STAGE_BYTES = 8 * HTB, NXCD = 8, WGM = 8;

__host__ __device__ __forceinline__ int lds_byte(int r, int c) { const int st = (r >> 4) * 2 + (c >> 5), rr = r & 15, cc = c & 31, ob = rr * 64 + cc * 2; return st * 1024 + (ob ^ (((ob >> 9) & 1) << 5)); }
__host__ __device__ __forceinline__ void stage_rc(int b, int& R, int& C) { const int st = b / 1024, sb = b % 1024, swz = sb ^ (((sb >> 9) & 1) << 5); R = (st >> 1) * 16 + swz / 64; C = (st & 1) * 32 + (swz % 64) / 2; }
__host__ __device__ __forceinline__ int perm32(int rho) { const int n = rho >> 4, i = rho & 15; return 8 * (i >> 2) + 4 * n + (i & 3); }

struct Unit { int pm, pn; };
struct Gemm { const bf16_t* A; const bf16_t* Bt; int M, N, K, lda; };

struct StaticOrder {
    int nM, nN, nwg, G, c;
    __host__ __device__ void init(int M, int N, int G_, int c_) { nM = M / BM; nN = N / BM; nwg = nM * nN; G = G_; c = c_; }
    __host__ __device__ bool next(int i, Unit& u) const {
        const long L = (long)i * G + c; if (L >= nwg) return false;
        int wgid = (int)L; { const int q = nwg / NXCD, r = nwg % NXCD, xcd = wgid % NXCD, off = wgid / NXCD; wgid = (xcd < r ? xcd * (q + 1) : r * (q + 1) + (xcd - r) * q) + off; }
        const int nig = WGM * nN, gid = wgid / nig, fm = gid * WGM, gsz = (nM - fm) < WGM ? (nM - fm) : WGM;
        u.pm = fm + ((wgid % nig) % gsz); u.pn = (wgid % nig) / gsz; return true;
    }
    __device__ __forceinline__ void a_ready(const Unit&) const {}
    __device__ __forceinline__ void done(const Unit&) const {}
};
__device__ __forceinline__ unsigned cvt_pk_bf16(float lo, float hi) { unsigned r; asm volatile("v_cvt_pk_bf16_f32 %0, %1, %2" : "=v"(r) : "v"(lo), "v"(hi)); return r; }
typedef float f32x2 __attribute__((ext_vector_type(2)));
__device__ __forceinline__ f32x2 gelu_pk(f32x2 v) {
    const f32x2 av = __builtin_elementwise_abs(v), d = av * 0.2316418882f + 1.0f;
    f32x2 t; t.x = __builtin_amdgcn_rcpf(d.x); t.y = __builtin_amdgcn_rcpf(d.y);
    f32x2 q = t * 0.5307027145f + (-0.7265760135f); q = q * t + 0.7107068705f; q = q * t + (-0.142248368f); q = q * t + 0.127414796f; q = q * t;
    const f32x2 s = (v * v) * (-0.72134752044f);
    f32x2 e; e.x = __builtin_amdgcn_exp2f(s.x); e.y = __builtin_amdgcn_exp2f(s.y);
    const f32x2 m = v * (q * e), r = v - m;
    f32x2 o; o.x = v.x < 0.f ? m.x : r.x; o.y = v.y < 0.f ? m.y : r.y; return o;
}

template <int ACT  > struct EpiBf16 {
    static constexpr bool PERM = true, AFTER_DRAIN = false; static_assert(ACT == 0 || ACT == 1, "EpiBf16: ACT is 0 (none) or 1 (gelu_pk)");
    bf16_t* O; int ldc; const float* bias; int split_cols; size_t split_stride; float scale0;
    __device__ __forceinline__ void operator()(const f32x4 (&acc)[2][2][4][2], const Unit& u, int wr, int wc, int fr, int fq) const {
        const int row0 = u.pm * BM + wr * 64 + fr; int colt = u.pn * BM; bf16_t* base = O;
        float sc = 1.f; if (split_cols) { const int t = colt / split_cols; base += (size_t)t * split_stride; colt -= t * split_cols; if (t == 0) sc = scale0; }
        const int col0 = colt + wc * 32 + 8 * fq, bcol0 = u.pn * BM + wc * 32 + 8 * fq;
        f32x4 bv[2][2];
#pragma unroll
        for (int bj = 0; bj < 2; ++bj)
#pragma unroll
            for (int n = 0; n < 2; ++n) bv[bj][n] = bias ? *(const f32x4*)(bias + bcol0 + bj * HALF + 4 * n) : (f32x4){0.f, 0.f, 0.f, 0.f};
#pragma unroll
        for (int ai = 0; ai < 2; ++ai)
#pragma unroll
            for (int m = 0; m < 4; ++m) { bf16_t* rowp = base + (size_t)(row0 + ai * HALF + m * 16) * ldc + col0;
#pragma unroll
                for (int bj = 0; bj < 2; ++bj) { f32x4 v0 = acc[ai][bj][m][0] + bv[bj][0], v1 = acc[ai][bj][m][1] + bv[bj][1];
                    if (ACT == 1) { f32x2 a = gelu_pk((f32x2){v0[0], v0[1]}), b = gelu_pk((f32x2){v0[2], v0[3]}), c = gelu_pk((f32x2){v1[0], v1[1]}), d = gelu_pk((f32x2){v1[2], v1[3]});
                        v0 = (f32x4){a.x, a.y, b.x, b.y}; v1 = (f32x4){c.x, c.y, d.x, d.y}; }
                    v0 = v0 * sc; v1 = v1 * sc; u32x4 w; w.x = cvt_pk_bf16(v0[0], v0[1]); w.y = cvt_pk_bf16(v0[2], v0[3]); w.z = cvt_pk_bf16(v1[0], v1[1]); w.w = cvt_pk_bf16(v1[2], v1[3]);
                    *(u32x4*)(rowp + bj * HALF) = w; } }
    }
};
template <class Epi, class Sched, bool ALIGN_EPI = false, bool SP2 = false>
__device__ __forceinline__ void gemm_phase(PG8_LAS unsigned char* lds, const Gemm g, const Sched& S, const Epi& E, int tid_in) {
    int tid_ = tid_in; asm volatile("" : "+v"(tid_));
    const int tid = tid_, wid = __builtin_amdgcn_readfirstlane(tid >> 6), lane = tid & 63, wr = wid >> 2, wc = wid & 3, fr = lane & 15, fq = lane >> 4;
    const int K = g.K, nt = K / BK;
    unsigned voffA[2], voffB[2];
#pragma unroll
    for (int i = 0; i < 2; ++i) { int R, C; stage_rc(tid * 16 + i * 8192, R, C); const int Rb = Epi::PERM ? ((R & ~31) + perm32(R & 31)) : R;
        voffA[i] = (unsigned)(R * g.lda + C) * 2u; voffB[i] = (unsigned)(Rb * K + C) * 2u; }
    const size_t kstep = (size_t)(BK * 2);
    const size_t hstep = (size_t)HALF * K * 2;
    const size_t tstep = 2 * hstep; const size_t hstepA = (size_t)HALF * g.lda * 2, tstepA = 2 * hstepA;
    const unsigned ldsw = (unsigned)wid * 1024u;
    const int aoff = lds_byte(wr * 64 + fr, fq * 8), boff = lds_byte(wc * 32 + fr, fq * 8);
#define PG8_SA(b, h) (((b) * 2 + (h)) * HTB)
#define PG8_SB(b, h) ((4 + (b) * 2 + (h)) * HTB)
#define PG8_STAGE(bufoff, gbase, voff) do { _Pragma("unroll") for (int _i = 0; _i < 2; ++_i) \
        __builtin_amdgcn_global_load_lds((const unsigned*)((const char*)(gbase) + (voff)[_i]), (PG8_LAS unsigned*)(lds + (bufoff) + ldsw + _i * 8192), 16, 0, 0); } while (0)
#define PG8_LDA(dst, b, h) do { _Pragma("unroll") for (int m = 0; m < 4; ++m) _Pragma("unroll") for (int k = 0; k < 2; ++k) dst[m][k] = *(const PG8_LAS bf16x8*)(lds + PG8_SA(b, h) + aoff + m * 2048 + k * 1024); } while (0)
#define PG8_LDB(dst, b, h) do { _Pragma("unroll") for (int n = 0; n < 2; ++n) _Pragma("unroll") for (int k = 0; k < 2; ++k) dst[n][k] = *(const PG8_LAS bf16x8*)(lds + PG8_SB(b, h) + boff + n * 2048 + k * 1024); } while (0)
#define PG8_MMA(ai, bj, At, Bt) do { __builtin_amdgcn_s_setprio(1); _Pragma("unroll") for (int m = 0; m < 4; ++m) _Pragma("unroll") for (int n = 0; n < 2; ++n) _Pragma("unroll") for (int k = 0; k < 2; ++k) \
        acc[ai][bj][m][n] = __builtin_amdgcn_mfma_f32_16x16x32_bf16(Bt[n][k], At[m][k], acc[ai][bj][m][n], 0, 0, 0); __builtin_amdgcn_s_setprio(0); } while (0)
#define PG8_WAIT_V(n) asm volatile("s_waitcnt vmcnt(" #n ")" ::: "memory")
#define PG8_WAIT_L(n) asm volatile("s_waitcnt lgkmcnt(" #n ")" ::: "memory")
#define PG8_BAR __builtin_amdgcn_s_barrier()
#define PG8_SCHED __builtin_amdgcn_sched_barrier(0)
    Unit cur, nxt; int ui = 0;
    if (!S.next(0, cur)) return;
    f32x4 acc[2][2][4][2];
#pragma unroll
    for (int a = 0; a < 2; ++a)
#pragma unroll
        for (int b = 0; b < 2; ++b)
#pragma unroll
            for (int m = 0; m < 4; ++m)
#pragma unroll
                for (int n = 0; n < 2; ++n) acc[a][b][m][n] = (f32x4){0.f, 0.f, 0.f, 0.f};
    bf16x8 At[4][2], B0[2][2], B1[2][2];
    const char* cA = (const char*)g.A + (size_t)cur.pm * tstepA; const char* cB = (const char*)g.Bt + (size_t)cur.pn * tstep;
    S.a_ready(cur);
    if constexpr (SP2) {
        PG8_STAGE(PG8_SB(0, 0), cB, voffB); PG8_STAGE(PG8_SB(0, 1), cB + hstep, voffB); PG8_STAGE(PG8_SA(0, 0), cA, voffA); PG8_STAGE(PG8_SA(0, 1), cA + hstepA, voffA);
        if (wr == 1) PG8_BAR;
        PG8_WAIT_V(2); PG8_BAR;
        PG8_STAGE(PG8_SB(1, 0), cB + kstep, voffB); PG8_STAGE(PG8_SA(1, 0), cA + kstep, voffA); PG8_STAGE(PG8_SB(1, 1), cB + hstep + kstep, voffB);
        PG8_WAIT_V(6); PG8_BAR;
    } else {
        PG8_STAGE(PG8_SB(0, 0), cB, voffB); PG8_STAGE(PG8_SA(0, 0), cA, voffA); PG8_STAGE(PG8_SB(0, 1), cB + hstep, voffB); PG8_STAGE(PG8_SA(0, 1), cA + hstepA, voffA);
        if (wr == 1) PG8_BAR;
        PG8_WAIT_V(4); PG8_BAR;
        PG8_STAGE(PG8_SB(1, 0), cB + kstep, voffB); PG8_STAGE(PG8_SA(1, 0), cA + kstep, voffA); PG8_STAGE(PG8_SB(1, 1), cB + hstep + kstep, voffB);
        PG8_WAIT_V(6); PG8_BAR;
    }
    for (;;) {
        const bool has_next = S.next(ui + 1, nxt);
        const char* nA = has_next ? (const char*)g.A + (size_t)nxt.pm * tstepA : cA; const char* nB = has_next ? (const char*)g.Bt + (size_t)nxt.pn * tstep : cB;
        for (int t = 0; t < nt; t += 2) {
            const bool last = (t == nt - 2);
            const char* a1 = cA + (size_t)(t + 1) * kstep;
            const char* a2 = last ? nA : cA + (size_t)(t + 2) * kstep; const char* b2 = last ? nB : cB + (size_t)(t + 2) * kstep;
            const char* a3 = a2 + kstep; const char* b3 = b2 + kstep;
            if (last && has_next) S.a_ready(nxt);
            if constexpr (SP2) {
            PG8_LDB(B0, 0, 0); PG8_LDB(B1, 0, 1); PG8_SCHED; PG8_LDA(At, 0, 0); PG8_STAGE(PG8_SA(1, 1), a1 + hstepA, voffA);
            PG8_WAIT_V(8); PG8_WAIT_L(0); PG8_BAR; PG8_MMA(0, 0, At, B0); PG8_MMA(0, 1, At, B1); PG8_BAR; PG8_SCHED;
            PG8_LDA(At, 0, 1); PG8_STAGE(PG8_SB(0, 0), b2, voffB); PG8_STAGE(PG8_SB(0, 1), b2 + hstep, voffB); PG8_STAGE(PG8_SA(0, 0), a2, voffA);
            PG8_WAIT_V(8); PG8_WAIT_L(0); PG8_BAR; PG8_MMA(1, 0, At, B0); PG8_MMA(1, 1, At, B1); PG8_BAR; PG8_SCHED;
            PG8_LDB(B0, 1, 0); PG8_LDB(B1, 1, 1); PG8_SCHED; PG8_LDA(At, 1, 0); PG8_STAGE(PG8_SA(0, 1), a2 + hstepA, voffA);
            PG8_WAIT_V(8); PG8_WAIT_L(0); PG8_BAR; PG8_MMA(0, 0, At, B0); PG8_MMA(0, 1, At, B1); PG8_BAR; PG8_SCHED;
            PG8_LDA(At, 1, 1); PG8_STAGE(PG8_SB(1, 0), b3, voffB); PG8_STAGE(PG8_SB(1, 1), b3 + hstep, voffB); PG8_STAGE(PG8_SA(1, 0), a3, voffA);
            PG8_WAIT_V(8); PG8_WAIT_L(0); PG8_BAR; PG8_MMA(1, 0, At, B0); PG8_MMA(1, 1, At, B1); PG8_BAR; PG8_SCHED;
            } else {
            PG8_LDB(B0, 0, 0); PG8_SCHED; PG8_LDA(At, 0, 0); PG8_STAGE(PG8_SA(1, 1), a1 + hstepA, voffA);
            PG8_WAIT_L(8); PG8_BAR; PG8_WAIT_L(0); PG8_MMA(0, 0, At, B0); PG8_BAR; PG8_SCHED;
            PG8_LDB(B1, 0, 1); PG8_STAGE(PG8_SB(0, 0), b2, voffB);
            PG8_BAR; PG8_WAIT_L(0); PG8_MMA(0, 1, At, B1); PG8_BAR;
            PG8_LDA(At, 0, 1); PG8_STAGE(PG8_SA(0, 0), a2, voffA);
            PG8_BAR; PG8_WAIT_L(0); PG8_MMA(1, 0, At, B0); PG8_BAR; PG8_SCHED;
            PG8_STAGE(PG8_SB(0, 1), b2 + hstep, voffB);
            PG8_WAIT_V(6); PG8_BAR; PG8_MMA(1, 1, At, B1); PG8_BAR;
            PG8_LDB(B0, 1, 0); PG8_SCHED; PG8_LDA(At, 1, 0); PG8_STAGE(PG8_SA(0, 1), a2 + hstepA, voffA);
            PG8_WAIT_L(8); PG8_BAR; PG8_WAIT_L(0); PG8_MMA(0, 0, At, B0); PG8_BAR; PG8_SCHED;
            PG8_LDB(B1, 1, 1); PG8_STAGE(PG8_SB(1, 0), b3, voffB);
            PG8_BAR; PG8_WAIT_L(0); PG8_MMA(0, 1, At, B1); PG8_BAR;
            PG8_LDA(At, 1, 1); PG8_STAGE(PG8_SA(1, 0), a3, voffA);
            PG8_BAR; PG8_WAIT_L(0); PG8_MMA(1, 0, At, B0); PG8_BAR; PG8_SCHED;
            PG8_STAGE(PG8_SB(1, 1), b3 + hstep, voffB);
            PG8_WAIT_V(6); PG8_BAR; PG8_MMA(1, 1, At, B1); PG8_BAR;
            }
        }
        if constexpr (ALIGN_EPI) { if (wr == 0) PG8_BAR; }
        if constexpr (!Epi::AFTER_DRAIN) { E(acc, cur, wr, wc, fr, fq); S.done(cur); }
        if (!has_next) break;
#pragma unroll
        for (int a = 0; a < 2; ++a)
#pragma unroll
            for (int b = 0; b < 2; ++b)
#pragma unroll
                for (int m = 0; m < 4; ++m)
#pragma unroll
                    for (int n = 0; n < 2; ++n) acc[a][b][m][n] = (f32x4){0.f, 0.f, 0.f, 0.f};
        cur = nxt; cA = nA; cB = nB; ++ui;
        if constexpr (ALIGN_EPI) { if (wr == 1) PG8_BAR; }
    }
    PG8_WAIT_V(0);
    if constexpr (!ALIGN_EPI) { if (wr == 0) PG8_BAR; }
    PG8_BAR;
    if constexpr (Epi::AFTER_DRAIN) { E.fused(acc, cur, wr, wc, fr, fq, lds, wid, lane); S.done(cur); }
#undef PG8_SA
#undef PG8_SB
#undef PG8_STAGE
#undef PG8_LDA
#undef PG8_LDB
#undef PG8_MMA
#undef PG8_WAIT_V
#undef PG8_WAIT_L
#undef PG8_BAR
#undef PG8_SCHED
}
}
namespace pg8 {
template <class T> __device__ __forceinline__ T* uni_ptr(T* p) {
    const unsigned long long v = (unsigned long long)p; unsigned lo = __builtin_amdgcn_readfirstlane((unsigned)v), hi = __builtin_amdgcn_readfirstlane((unsigned)(v >> 32)); asm volatile("" : "+s"(lo), "+s"(hi)); return (T*)(((unsigned long long)hi << 32) | lo); }
template <bool XB16> struct EpiResid {
    static constexpr bool PERM = true, AFTER_DRAIN = false;
    const void* xin_; bf16_t* out_; const float* gate_;
    __device__ __forceinline__ void operator()(const f32x4 (&acc)[2][2][4][2], const Unit& u, int wr, int wc, int fr, int fq) const {
        const void* xin = uni_ptr(xin_); bf16_t* out = uni_ptr(out_); const float* gate = uni_ptr(gate_);
        const int row0 = u.pm * BM + wr * 64 + fr, col0 = u.pn * BM + wc * 32 + 8 * fq;
        const float* gp = gate + (size_t)(u.pm >> 5) * 6144 + col0;
        f32x4 gv[2][2];
#pragma unroll
        for (int bj = 0; bj < 2; ++bj)
#pragma unroll
            for (int n = 0; n < 2; ++n) gv[bj][n] = *(const f32x4*)(gp + bj * HALF + 4 * n);
#pragma unroll
        for (int ai = 0; ai < 2; ++ai)
#pragma unroll
            for (int m = 0; m < 4; ++m) { const size_t off = (size_t)(row0 + ai * HALF + m * 16) * 1024 + col0;
#pragma unroll
                for (int bj = 0; bj < 2; ++bj) { f32x4 x0, x1;
                    if (XB16) { const u32x4 xr = *(const u32x4*)((const bf16_t*)xin + off + bj * HALF);
                        x0 = (f32x4){__uint_as_float(xr.x << 16), __uint_as_float(xr.x & 0xffff0000u), __uint_as_float(xr.y << 16), __uint_as_float(xr.y & 0xffff0000u)};
                        x1 = (f32x4){__uint_as_float(xr.z << 16), __uint_as_float(xr.z & 0xffff0000u), __uint_as_float(xr.w << 16), __uint_as_float(xr.w & 0xffff0000u)}; }
                    else { x0 = *(const f32x4*)((const float*)xin + off + bj * HALF); x1 = *(const f32x4*)((const float*)xin + off + bj * HALF + 4); }
                    const f32x4 y0 = x0 + gv[bj][0] * acc[ai][bj][m][0], y1 = x1 + gv[bj][1] * acc[ai][bj][m][1];
                    u32x4 w; w.x = cvt_pk_bf16(y0[0], y0[1]); w.y = cvt_pk_bf16(y0[2], y0[3]); w.z = cvt_pk_bf16(y1[0], y1[1]); w.w = cvt_pk_bf16(y1[2], y1[3]);
                    *(u32x4*)(out + off + bj * HALF) = w; }
                if (m & 1) asm volatile("" ::: "memory"); }
    }
};
struct EpiRelu2 {
    static constexpr bool PERM = true, AFTER_DRAIN = false;
    bf16_t* O_; int ldc;
    __device__ __forceinline__ void operator()(const f32x4 (&acc)[2][2][4][2], const Unit& u, int wr, int wc, int fr, int fq) const {
        bf16_t* O = uni_ptr(O_);
        const int row0 = u.pm * BM + wr * 64 + fr, col0 = u.pn * BM + wc * 32 + 8 * fq;
#pragma unroll
        for (int ai = 0; ai < 2; ++ai)
#pragma unroll
            for (int m = 0; m < 4; ++m) { bf16_t* rowp = O + (size_t)(row0 + ai * HALF + m * 16) * ldc + col0;
#pragma unroll
                for (int bj = 0; bj < 2; ++bj) { f32x4 v0 = acc[ai][bj][m][0], v1 = acc[ai][bj][m][1];
                    v0 = __builtin_elementwise_max(v0, (f32x4){0.f, 0.f, 0.f, 0.f}); v1 = __builtin_elementwise_max(v1, (f32x4){0.f, 0.f, 0.f, 0.f}); v0 = v0 * v0; v1 = v1 * v1;
                    u32x4 w; w.x = cvt_pk_bf16(v0[0], v0[1]); w.y = cvt_pk_bf16(v0[2], v0[3]); w.z = cvt_pk_bf16(v1[0], v1[1]); w.w = cvt_pk_bf16(v1[2], v1[3]);
                    *(u32x4*)(rowp + bj * HALF) = w; } }
    }
};
struct EpiMlaQ {
    static constexpr bool PERM = true, AFTER_DRAIN = false;
    bf16_t* QM_;
    __device__ __forceinline__ void operator()(const f32x4 (&acc)[2][2][4][2], const Unit& u, int wr, int wc, int fr, int fq) const {
        bf16_t* QM = uni_ptr(QM_);
        const int row0 = u.pm * BM + wr * 64 + fr, cw = wc * 32 + 8 * fq;
        const int nbj = (u.pn != 0) ? 1 : 2;
#pragma unroll
        for (int ai = 0; ai < 2; ++ai)
#pragma unroll
            for (int m = 0; m < 4; ++m) { bf16_t* qr = QM + (size_t)(row0 + ai * HALF + m * 16) * 384 + u.pn * 256 + cw;
#pragma unroll
                for (int bj = 0; bj < 2; ++bj) if (bj < nbj) { const f32x4 v0 = acc[ai][bj][m][0], v1 = acc[ai][bj][m][1];
                    u32x4 o; o.x = cvt_pk_bf16(v0[0], v0[1]); o.y = cvt_pk_bf16(v0[2], v0[3]); o.z = cvt_pk_bf16(v1[0], v1[1]); o.w = cvt_pk_bf16(v1[2], v1[3]);
                    *(u32x4*)(qr + bj * HALF) = o; } }
    }
};
struct EpiMlaKV {
    static constexpr bool PERM = true, AFTER_DRAIN = false;
    bf16_t* KM_; bf16_t* VM_; const float* rskv_;
    __device__ __forceinline__ void operator()(const f32x4 (&acc)[2][2][4][2], const Unit& u, int wr, int wc, int fr, int fq) const {
        bf16_t* KM = uni_ptr(KM_); bf16_t* VM = uni_ptr(VM_); const float* rskv = uni_ptr(rskv_);
        const int row0 = u.pm * BM + wr * 64 + fr, w = wc * 32 + 8 * fq;
        const bool isk = wc < 2;
#pragma unroll
        for (int ai = 0; ai < 2; ++ai)
#pragma unroll
            for (int m = 0; m < 4; ++m) { const int row = row0 + ai * HALF + m * 16; const float rs = rskv[row];
#pragma unroll
                for (int bj = 0; bj < 2; ++bj) { const int head = u.pn * 2 + bj;
                    const f32x4 v0 = acc[ai][bj][m][0] * rs, v1 = acc[ai][bj][m][1] * rs;
                    u32x4 o; o.x = cvt_pk_bf16(v0[0], v0[1]); o.y = cvt_pk_bf16(v0[2], v0[3]); o.z = cvt_pk_bf16(v1[0], v1[1]); o.w = cvt_pk_bf16(v1[2], v1[3]);
                    if (isk) *(u32x4*)(KM + (size_t)row * 384 + head * 96 + w) = o; else *(u32x4*)(VM + (size_t)row * 256 + head * 64 + (w - 64)) = o; }
                asm volatile("" ::: "memory"); }
    }
};
}
#define GAS __attribute__((address_space(1)))
#define LAS __attribute__((address_space(3)))
typedef unsigned short bf16;
typedef unsigned v4u __attribute__((ext_vector_type(4)));
typedef float f32x4 __attribute__((ext_vector_type(4)));
typedef short bf16x8 __attribute__((ext_vector_type(8)));
typedef GAS unsigned gu32;
typedef GAS unsigned long long gu64;
#define RLX_AGENT __ATOMIC_RELAXED, __HIP_MEMORY_SCOPE_AGENT
#define LDS_WAIT() asm volatile("s_waitcnt lgkmcnt(0)" ::: "memory")
#define VM_WAIT() asm volatile("s_waitcnt vmcnt(0)" ::: "memory")
__device__ __forceinline__ unsigned long long rt() { return __builtin_amdgcn_s_memrealtime(); }
__device__ __forceinline__ unsigned f2bf(float f) { unsigned u = __builtin_bit_cast(unsigned, f); return (u + 0x7fffu + ((u >> 16) & 1u)) >> 16; }
__device__ __forceinline__ unsigned pk2(float lo, float hi) { return f2bf(lo) | (f2bf(hi) << 16); }

#define XB_TMO      128
#define XB_XCNT(j)  (256  + 64 * (j))
#define XB_XSUB(j)  (1280 + 64 * (j))
#define XB_XGEN(j)  (2304 + 64 * (j))
#define XB_TOP      3328
#define XB_TOPGEN   3392
#define XCD_BAR_WORDS 3456
#define XB_SPIN_CAP (1u << 18)

__device__ __forceinline__ unsigned xb_ld(unsigned* p)              { return __hip_atomic_load(p, __ATOMIC_RELAXED, __HIP_MEMORY_SCOPE_AGENT); }
__device__ __forceinline__ unsigned xb_add(unsigned* p, unsigned v) { return __hip_atomic_fetch_add(p, v, __ATOMIC_RELAXED, __HIP_MEMORY_SCOPE_AGENT); }
__device__ __forceinline__ unsigned xb_xcc_id() { return (unsigned)__builtin_amdgcn_s_getreg((3 << 11) | 20) & 0xFu; }
#define XB_SPIN(cond, bar) do { unsigned _sp = 0; while (cond) { __builtin_amdgcn_s_sleep(1); \
    if ((++_sp & 255u) == 0u) { if (xb_ld(&(bar)[XB_TMO])) break; if (_sp > XB_SPIN_CAP) { atomicAdd(&(bar)[XB_TMO], 1u); break; } } } } while (0)

struct XcdBarrier {
    unsigned* bar; unsigned x;
    volatile LAS unsigned* st;
};

__device__ __forceinline__ XcdBarrier xcd_barrier_post(unsigned* bar, volatile LAS unsigned* st) {
    XcdBarrier b; b.bar = bar; b.x = xb_xcc_id(); b.st = st;
    if (threadIdx.x == 0) (void)xb_add(&bar[XB_XCNT(b.x)], 1u);
    return b;
}
__device__ __forceinline__ void xcd_barrier_complete(unsigned* bar, unsigned x, unsigned& nloc, unsigned& nx) {
    const unsigned G = gridDim.x * gridDim.y * gridDim.z;
    unsigned sum, cnt, mine, sp = 0u;
    for (;;) {
        sum = 0u; cnt = 0u; mine = 0u;
#pragma unroll
        for (unsigned j = 0; j < 16; ++j) { const unsigned c = xb_ld(&bar[XB_XCNT(j)]); sum += c; cnt += (c > 0u) ? 1u : 0u; mine = (j == x) ? c : mine; }
        if (sum == G) break;
        __builtin_amdgcn_s_sleep(1);
        if ((++sp & 255u) == 0u) { if (xb_ld(&bar[XB_TMO])) break; if (sp > XB_SPIN_CAP) { atomicAdd(&bar[XB_TMO], 1u); break; } }
    }
    nloc = mine > 0u ? mine : 1u; nx = cnt > 0u ? cnt : 1u;
}

__device__ __forceinline__ void xcd_barrier(const XcdBarrier& b) {
    asm volatile("s_waitcnt vmcnt(0)" ::: "memory");
    __syncthreads();
    if (threadIdx.x == 0) {
        unsigned* bar = b.bar;
        __builtin_amdgcn_s_waitcnt(0);
        unsigned nloc = b.st[0], nx = b.st[1];
        if (nloc == 0u) { xcd_barrier_complete(bar, b.x, nloc, nx); b.st[0] = nloc; b.st[1] = nx; }
        const unsigned old = xb_add(&bar[XB_XSUB(b.x)], 1u);
        const unsigned gen = old / nloc;
        if (old + 1u == (gen + 1u) * nloc) {
            __builtin_amdgcn_fence(__ATOMIC_RELEASE, "agent");
            asm volatile("s_waitcnt vmcnt(0)" ::: "memory");
            const unsigned og = xb_add(&bar[XB_TOP], 1u);
            const unsigned tg = og / nx;
            if (og + 1u == (tg + 1u) * nx) xb_add(&bar[XB_TOPGEN], 1u);
            else XB_SPIN(xb_ld(&bar[XB_TOPGEN]) == tg, bar);
            __builtin_amdgcn_fence(__ATOMIC_ACQUIRE, "agent");
            xb_add(&bar[XB_XGEN(b.x)], 1u);
            asm volatile("s_waitcnt vmcnt(0)" ::: "memory");
        } else {
            XB_SPIN(xb_ld(&bar[XB_XGEN(b.x)]) == gen, bar);
            __builtin_amdgcn_fence(__ATOMIC_ACQUIRE, "agent");
            asm volatile("s_waitcnt vmcnt(0)" ::: "memory");
        }
    }
    __syncthreads();
}
#ifndef FA_PROBE
#define FA_PROBE 0
#endif
namespace fa {
typedef unsigned short bf16;
typedef short bf16x8 __attribute__((ext_vector_type(8)));
typedef short s16x4 __attribute__((ext_vector_type(4)));
typedef float f32x16 __attribute__((ext_vector_type(16)));
typedef float f32x4v __attribute__((ext_vector_type(4)));
typedef unsigned u32x4 __attribute__((ext_vector_type(4)));
typedef unsigned u32x2 __attribute__((ext_vector_type(2)));
typedef float f32x2_t __attribute__((ext_vector_type(2)));
typedef __bf16 bf16x2_t __attribute__((ext_vector_type(2)));
#define FLAS __attribute__((address_space(3)))
#define FGAS __attribute__((address_space(1)))
constexpr float MASKV = -1e30f, MINIT = -5e29f, TINYF = 1e-30f, LOG2E = 1.4426950408889634f;
constexpr int OSTR = 144;

__device__ __forceinline__ float ex2(float x) { return __builtin_amdgcn_exp2f(x); }
__device__ __forceinline__ unsigned cvtpk(float lo, float hi) { f32x2_t v = {lo, hi}; bf16x2_t b = __builtin_convertvector(v, bf16x2_t); return __builtin_bit_cast(unsigned, b); }
__device__ __forceinline__ float xhalf_max(float m) { auto rr = __builtin_amdgcn_permlane32_swap(__float_as_uint(m), __float_as_uint(m), false, false); return fmaxf(__uint_as_float(rr[0]), __uint_as_float(rr[1])); }
__device__ __forceinline__ float xhalf_sum(float m) { auto rr = __builtin_amdgcn_permlane32_swap(__float_as_uint(m), __float_as_uint(m), false, false); return __uint_as_float(rr[0]) + __uint_as_float(rr[1]); }
__device__ __forceinline__ float bf2f(unsigned short b) { return __uint_as_float((unsigned)b << 16); }

struct SM { float m, l; f32x16 o[2]; };
__device__ __forceinline__ void sm_init(SM& s) { s.m = MINIT; s.l = 0.f; s.o[0] = f32x16{}; s.o[1] = f32x16{}; }

template <int DQ> struct Stg { u32x4 k0, k1, v; };
template <int DQ> __device__ __forceinline__ void stg_load(Stg<DQ>& s, const FGAS char* ws, unsigned koff, unsigned ksb, unsigned voff, unsigned vsb, int key0, int kmax, int tid) {
    const int row = tid >> 3, ch = tid & 7; int kr = key0 + row; kr = kr < kmax ? kr : kmax;
    s.k0 = *(const FGAS u32x4*)(ws + (koff + (unsigned)kr * ksb + (unsigned)ch * 16u));
    s.v = *(const FGAS u32x4*)(ws + (voff + (unsigned)kr * vsb + (unsigned)ch * 16u));
    if (DQ == 96) { if (tid < 256) { const int r2 = tid >> 2, c2 = tid & 3; int k2 = key0 + r2; k2 = k2 < kmax ? k2 : kmax; s.k1 = *(const FGAS u32x4*)(ws + (koff + (unsigned)k2 * ksb + 128u + (unsigned)c2 * 16u)); } }
}
template <int DQ> __device__ __forceinline__ void stg_store(const Stg<DQ>& s, FLAS char* buf, int tid) {
    const int row = tid >> 3, ch = tid & 7, p = ch >> 2, c = ch & 3;
    *(FLAS u32x4*)(buf + p * 4096 + row * 64 + ((c ^ ((row >> 2) & 3)) << 4)) = s.k0;
    *(FLAS u32x4*)(buf + (DQ / 32) * 4096 + row * 128 + ((p ^ ((row >> 1) & 1)) << 6) + (c << 4)) = s.v;
    if (DQ == 96) { if (tid < 256) { const int r2 = tid >> 2, c2 = tid & 3; *(FLAS u32x4*)(buf + 2 * 4096 + r2 * 64 + ((c2 ^ ((r2 >> 2) & 3)) << 4)) = s.k1; } }
}
template <int DQ> constexpr int stage_bytes() { return (DQ / 32) * 4096 + 8192; }

template <int DQ> __device__ __forceinline__ void compute_S(f32x16& p0, f32x16& p1, const FLAS char* buf, const bf16x8 (&qf)[DQ / 16], int lane) {
    const int r = lane & 31, h = lane >> 5, sw = (r >> 2) & 3;
#pragma unroll
    for (int d0 = 0; d0 < DQ / 16; ++d0) {
        const int p = d0 >> 1, c = 2 * (d0 & 1) + h;
        const FLAS char* a = buf + p * 4096 + r * 64 + ((c ^ sw) << 4);
        const bf16x8 a0 = *(const FLAS bf16x8*)a, a1 = *(const FLAS bf16x8*)(a + 2048);
        p0 = __builtin_amdgcn_mfma_f32_32x32x16_bf16(a0, qf[d0], p0, 0, 0, 0);
        p1 = __builtin_amdgcn_mfma_f32_32x32x16_bf16(a1, qf[d0], p1, 0, 0, 0);
    }
}
__device__ __forceinline__ s16x4 vtr(const FLAS char* p) { typedef short v4i16_t __attribute__((ext_vector_type(4))); return __builtin_bit_cast(s16x4, __builtin_amdgcn_ds_read_tr16_b64_v4i16((FLAS v4i16_t*)p)); }
__device__ __forceinline__ void pv(f32x16 (&o)[2], const FLAS char* vbuf, const bf16x8 (&pf)[4], int lane) {
    const int g = lane >> 4, i = lane & 15, q4 = i >> 2, pp = i & 3, h = lane >> 5;
    const int sw = (q4 >> 1) & 1;
#pragma unroll
    for (int db = 0; db < 2; ++db) {
        const FLAS char* base = vbuf + (4 * h + q4) * 128 + ((db ^ sw) << 6) + (16 * (g & 1) + 4 * pp) * 2;
#pragma unroll
        for (int ks = 0; ks < 4; ++ks) {
            const s16x4 lo = vtr(base + ks * 2048), hi = vtr(base + ks * 2048 + 1024);
            const bf16x8 a = (bf16x8){lo[0], lo[1], lo[2], lo[3], hi[0], hi[1], hi[2], hi[3]};
            o[db] = __builtin_amdgcn_mfma_f32_32x32x16_bf16(a, pf[ks], o[db], 0, 0, 0);
        }
    }
}
__device__ __forceinline__ void mask_ew(f32x16& p0, f32x16& p1, int lo, int hi, int h) {
    const int lo2 = lo - 4 * h, hi2 = hi - 4 * h;
#pragma unroll
    for (int v = 0; v < 16; ++v) { const int k0 = (v & 3) + 8 * (v >> 2);
        if (k0 < lo2 || k0 > hi2) p0[v] = MASKV;
        if (k0 + 32 < lo2 || k0 + 32 > hi2) p1[v] = MASKV; }
}
__device__ __forceinline__ void sm_step(SM& st, f32x16& p0, f32x16& p1, bf16x8 (&pf)[4]) {
#define FA_MX3(a, b, c) __builtin_fmaxf(__builtin_fmaxf((a), (b)), (c))
    float ma = FA_MX3(p0[0], p0[1], p1[0]), mb = FA_MX3(p0[2], p0[3], p1[1]); ma = FA_MX3(ma, p1[2], p1[3]);
#pragma unroll
    for (int v = 4; v < 16; v += 4) { ma = FA_MX3(ma, p0[v], p0[v + 1]); mb = FA_MX3(mb, p0[v + 2], p0[v + 3]); ma = FA_MX3(ma, p1[v], p1[v + 1]); mb = FA_MX3(mb, p1[v + 2], p1[v + 3]); }
#undef FA_MX3
    const float mx = xhalf_max(__builtin_fmaxf(ma, mb));
    if (__any(mx > st.m)) {
        const float mn2 = fmaxf(st.m, mx), alpha = ex2(st.m - mn2);
        st.m = mn2; st.l *= alpha; st.o[0] *= alpha; st.o[1] *= alpha;
    }
    const float mn = st.m;
    float s0 = 0.f, s1 = 0.f;
#pragma unroll
    for (int v = 0; v < 16; ++v) { p0[v] = ex2(p0[v] - mn); p1[v] = ex2(p1[v] - mn); s0 += p0[v]; s1 += p1[v]; }
    st.l += s0 + s1;
    u32x4 w;
    w.x = cvtpk(p0[0], p0[1]); w.y = cvtpk(p0[2], p0[3]); w.z = cvtpk(p0[4], p0[5]); w.w = cvtpk(p0[6], p0[7]); pf[0] = __builtin_bit_cast(bf16x8, w);
    w.x = cvtpk(p0[8], p0[9]); w.y = cvtpk(p0[10], p0[11]); w.z = cvtpk(p0[12], p0[13]); w.w = cvtpk(p0[14], p0[15]); pf[1] = __builtin_bit_cast(bf16x8, w);
    w.x = cvtpk(p1[0], p1[1]); w.y = cvtpk(p1[2], p1[3]); w.z = cvtpk(p1[4], p1[5]); w.w = cvtpk(p1[6], p1[7]); pf[2] = __builtin_bit_cast(bf16x8, w);
    w.x = cvtpk(p1[8], p1[9]); w.y = cvtpk(p1[10], p1[11]); w.z = cvtpk(p1[12], p1[13]); w.w = cvtpk(p1[14], p1[15]); pf[3] = __builtin_bit_cast(bf16x8, w);
}
template <int DQ, bool ALIBI> __device__ __forceinline__ void score_tile(f32x16& p0, f32x16& p1, const FLAS char* buf, const bf16x8 (&qf)[DQ / 16], float cb, float sl, int lane) {
    if (ALIBI) {
#pragma unroll
        for (int v = 0; v < 16; ++v) { const float c = (float)((v & 3) + 8 * (v >> 2)); p0[v] = fmaf(sl, c, cb); p1[v] = fmaf(sl, c + 32.f, cb); }
    } else { p0 = f32x16{}; p1 = f32x16{}; }
    compute_S<DQ>(p0, p1, buf, qf, lane);
}
template <int DQ, bool ALIBI> __device__ __forceinline__ void tile_compute(SM& st, const FLAS char* buf, const bf16x8 (&qf)[DQ / 16], float cb, float sl, bool ew, int lo, int hi, int lane) {
    f32x16 p0, p1; bf16x8 pf[4];
    score_tile<DQ, ALIBI>(p0, p1, buf, qf, cb, sl, lane);
    if (ew) mask_ew(p0, p1, lo, hi, lane >> 5);
    sm_step(st, p0, p1, pf);
    pv(st.o, buf + (DQ / 32) * 4096, pf, lane);
}
template <int DQ, bool ALIBI, class K0, class PAR>
__device__ __forceinline__ void fa_loop(SM& st, const bf16x8 (&qf)[DQ / 16], const FGAS char* ws, unsigned koff, unsigned ksb, unsigned voff, unsigned vsb, int kmax, int ntile, K0 k0f, PAR parf, float sl, FLAS char* lds, int tid, int lane) {
    constexpr int STG = stage_bytes<DQ>();
    Stg<DQ> sgA, sgB;
    stg_load<DQ>(sgB, ws, koff, ksb, voff, vsb, k0f(0), kmax, tid); stg_store<DQ>(sgB, lds, tid);
    if (ntile > 1) stg_load<DQ>(sgA, ws, koff, ksb, voff, vsb, k0f(1), kmax, tid);
    if (ntile > 2) stg_load<DQ>(sgB, ws, koff, ksb, voff, vsb, k0f(2), kmax, tid);
    __syncthreads();
#if FA_PROBE
    unsigned long long pr_c = 0, pr_w = 0, pr_b = 0, pr_t = 0; const unsigned long long pr_start = __builtin_amdgcn_s_memtime();
#define FA_P0 const unsigned long long q0_ = __builtin_amdgcn_s_memtime();
#define FA_P1 asm volatile("s_waitcnt vmcnt(0)" ::: "memory"); const unsigned long long q1_ = __builtin_amdgcn_s_memtime();
#define FA_P2 asm volatile("s_waitcnt lgkmcnt(0)" ::: "memory"); asm volatile("" : "+v"(st.o[0]), "+v"(st.o[1])); const unsigned long long q2_ = __builtin_amdgcn_s_memtime();
#define FA_P3 const unsigned long long q3_ = __builtin_amdgcn_s_memtime(); pr_w += q1_ - q0_; pr_c += q2_ - q1_; pr_b += q3_ - q2_; pr_t += 1;
#else
#define FA_P0
#define FA_P1
#define FA_P2
#define FA_P3
#endif
#define FA_ITER(SG) { \
        FA_P0 \
        if (t + 1 < ntile) stg_store<DQ>(SG, lds + ((t + 1) & 1) * STG, tid); \
        if (t + 3 < ntile) stg_load<DQ>(SG, ws, koff, ksb, voff, vsb, k0f(t + 3), kmax, tid); \
        FA_P1 \
        bool act, ew; float cb; int lo, hi; \
        parf(t, act, ew, cb, lo, hi); \
        if (act) tile_compute<DQ, ALIBI>(st, lds + (t & 1) * STG, qf, cb, sl, ew, lo, hi, lane); \
        FA_P2 \
        __syncthreads(); \
        FA_P3 }
    int t = 0;
    for (; t + 1 < ntile; t += 2) { FA_ITER(sgA) ++t; FA_ITER(sgB) --t; }
    if (t < ntile) FA_ITER(sgA)
#undef FA_ITER
#if FA_PROBE
    if (DQ == 96 && lane == 0) { unsigned long long* pp = (unsigned long long*)((FGAS char*)ws + 32768);
        atomicAdd(pp + 0, pr_c); atomicAdd(pp + 1, pr_w); atomicAdd(pp + 2, pr_b); atomicAdd(pp + 3, pr_t); atomicAdd(pp + 4, __builtin_amdgcn_s_memtime() - pr_start); }
#endif
}
__device__ __forceinline__ void sm_finish(const SM& st, float gate, f32x16 (&acc)[2]) {
    const float inv = gate / fmaxf(xhalf_sum(st.l), TINYF);
    acc[0] += st.o[0] * inv; acc[1] += st.o[1] * inv;
}
template <class DST> __device__ __forceinline__ void store_out(const f32x16 (&acc)[2], FLAS char* ost, FGAS char* ws, DST dstf, int lane) {
    const int r = lane & 31, h = lane >> 5;
#pragma unroll
    for (int db = 0; db < 2; ++db)
#pragma unroll
        for (int g = 0; g < 4; ++g) { u32x2 w; w.x = cvtpk(acc[db][4 * g], acc[db][4 * g + 1]); w.y = cvtpk(acc[db][4 * g + 2], acc[db][4 * g + 3]);
            *(FLAS u32x2*)(ost + r * OSTR + (32 * db + 8 * g + 4 * h) * 2) = w; }
    asm volatile("s_waitcnt lgkmcnt(0)" ::: "memory");
#pragma unroll
    for (int i = 0; i < 4; ++i) { const int idx = i * 64 + lane, col = idx >> 3, ch = idx & 7;
        const u32x4 v = *(const FLAS u32x4*)(ost + col * OSTR + ch * 16);
        *(FGAS u32x4*)(ws + (dstf(col) + (unsigned)ch * 16u)) = v; }
    asm volatile("s_waitcnt lgkmcnt(0)" ::: "memory");
}
template <int DQ> __device__ __forceinline__ void load_q(bf16x8 (&qf)[DQ / 16], const FGAS char* ws, unsigned qoff, int h) {
#pragma unroll
    for (int d0 = 0; d0 < DQ / 16; ++d0) qf[d0] = *(const FGAS bf16x8*)(ws + (qoff + (unsigned)(d0 * 32 + 16 * h)));
}
}
namespace mk {
typedef unsigned short bf16;
typedef float f32x4 __attribute__((ext_vector_type(4)));
typedef unsigned v4u __attribute__((ext_vector_type(4)));
typedef unsigned v2u __attribute__((ext_vector_type(2)));
typedef short bf16x8 __attribute__((ext_vector_type(8)));
typedef float f32x16 __attribute__((ext_vector_type(16)));
using fa::SM;

constexpr int D = 1024, NB = 4, SEQ = 8192, M = NB * SEQ, DEPTH = 2, DFF = 4096, ZLD = 2304, DIN = 2284;
constexpr int ZA_Q = 0, ZA_K = 256, ZA_V = 384, ZB_CQ = 512, ZB_CKV = 704, ZB_PE = 832, ZC_Q = 864, ZC_KC = 1120, ZC_VC = 1184, ZC_KS = 1248, ZC_VS = 1312, ZC_KW = 1376, ZC_VW = 1440, ZC_GL = 1504, ZD_Q = 1520, ZD_K = 1776, ZD_V = 2032;
constexpr float LOG2E = 1.4426950408889634f;
constexpr float QS = 0.125f * LOG2E;
constexpr float C_MLA = 0.10206207261596577f * LOG2E;
constexpr float RMS_EPS = 1e-6f;
constexpr int NWAVES = 8, NTHR = 512;

constexpr size_t MiB = 1u << 20;
constexpr size_t WS_CTL = 0, CTL_ZERO_BYTES = 64 * 1024;
constexpr size_t WS_MOD = 1 * MiB;
constexpr size_t WS_ROPE = WS_MOD + 256 * 1024;
constexpr size_t WS_POSP = WS_ROPE + 1 * MiB;
constexpr size_t WS_POSB = WS_POSP + 64 * 1024;
constexpr size_t WS_RSQ = WS_POSB + 64 * 1024;
constexpr size_t WS_RSKV = WS_RSQ + 128 * 1024;
constexpr size_t WS_KMH = WS_RSKV + 128 * 1024;
constexpr size_t WS_KML = WS_KMH + 64 * 1024;
constexpr size_t WS_KCMP = WS_KML + 64 * 1024;
constexpr size_t WS_VCMP = WS_KCMP + 256 * 1024;
constexpr size_t WS_XB = 436 * MiB;
constexpr size_t WS_PARK = 401 * MiB;
constexpr size_t WS_W = 4 * MiB, WS_WL = 26 * MiB;
constexpr size_t W_IN = 0, W_OUT = 4608 * 1024, W_UP = W_OUT + 2 * MiB, W_DN = W_UP + 8 * MiB, W_UQ = W_DN + 8 * MiB, W_UKV = W_UQ + 256 * 1024, W_1K = W_UKV + 256 * 1024, W_1V = W_1K + 512 * 1024, W_2K = W_1V + 512 * 1024, W_2V = W_2K + 16 * 1024;
static_assert(W_2V + 16 * 1024 <= WS_WL && WS_VCMP + 256 * 1024 <= WS_W, "ws map");
constexpr size_t WS_H = 56 * MiB;
constexpr size_t WS_Z = 120 * MiB;
constexpr size_t WS_QM = 265 * MiB, WS_KM = 297 * MiB, WS_VM = 321 * MiB, WS_O = 337 * MiB, WS_U = 120 * MiB, WS_END = 401 * MiB;
static_assert(WS_Z + (size_t)(M + 64) * ZLD * 2 <= WS_QM && WS_U + (size_t)M * DFF * 2 <= WS_END, "ws map 2");

constexpr int LDS_RING = 131072, LDS_BYTES = 163840, LDS_MISC = LDS_BYTES - 256;
constexpr int FA_STAGES = 0, FA_OST = 61440, FA_IMP = FA_OST + 8 * 32 * fa::OSTR  , FA_SELM = FA_IMP + 32768, FA_UM = FA_SELM + 1024, FA_VALS = FA_UM + 64;
static_assert(FA_VALS + 8 * 512 <= LDS_MISC, "fa lds map");
constexpr int MB_Q = 49152, MB_O = MB_Q + 32768, MB_ML = MB_O + 65536, MB_CNT = MB_ML + 2048, MB_LST = MB_CNT + 128;
static_assert(MB_LST + 8192 <= LDS_MISC, "moba lds map");

#define GAS __attribute__((address_space(1)))
#define LAS __attribute__((address_space(3)))
#define LDS_WAIT() asm volatile("s_waitcnt lgkmcnt(0)" ::: "memory")
__device__ __forceinline__ unsigned f2bf(float f) { unsigned u = __builtin_bit_cast(unsigned, f); return (u + 0x7fffu + ((u >> 16) & 1u)) >> 16; }
__device__ __forceinline__ unsigned pk2(float lo, float hi) { return f2bf(lo) | (f2bf(hi) << 16); }
__device__ __forceinline__ float bf2f(unsigned short b) { return __uint_as_float((unsigned)b << 16); }
__device__ __forceinline__ float wave_sum(float v) {
#pragma unroll
    for (int o = 1; o < 64; o <<= 1) v += __shfl_xor(v, o);
    return v;
}
__device__ __forceinline__ float slope2_of(int i) { return exp2f(-8.0f * (float)(i + 1) / 12.0f) * LOG2E; }

struct Args { const float* in[22]; float* out; unsigned char* ws; int ph_lo, ph_hi, skip, rep; };
typedef const __attribute__((address_space(4))) Args* KArgsP;
struct Frame {
    LAS unsigned char* lds;
    int tid, lane, wave, vcu, G, bx;
    unsigned char* ws;
};

template <int MODE> __device__ __forceinline__ int dmap(int n) {
    if (MODE == 1) { if (n < 832) return n; if (n < 848) return 832 + 2 * (n - 832); if (n < 864) return 832 + 2 * (n - 848) + 1; if (n < 1516) return n; return n + 4; }
    if (MODE == 2) { const int hd = n / 96, w = n - hd * 96; if (w < 64) return hd * 64 + w; if (w < 80) return 256 + hd * 32 + 2 * (w - 64); return 256 + hd * 32 + 2 * (w - 80) + 1; }
    return n;
}
template <int MODE> __device__ __forceinline__ float cscale(int n) {
    if (MODE == 1) { return (n < 256 || (n >= 864 && n < 1120) || (n >= 1516 && n < 1772)) ? QS : 1.f; }
    if (MODE == 2) return C_MLA;
    return 1.f;
}
template <int MODE> __device__ __forceinline__ void transpose_item(const float* W, int N, bf16* WT, int KT, const float* kscale, LAS float* scr, int item, int lane) {
    const int nblk = (N + 31) / 32, kb = item / nblk, nb = item % nblk, k0 = 64 * kb, n0 = 32 * nb;
    const int nl = lane & 31, n = n0 + nl;
#pragma unroll 8
    for (int i = 0; i < 32; ++i) { const int kk = 2 * i + (lane >> 5); float v = (n < N) ? W[(size_t)(k0 + kk) * N + n] : 0.f; if (kscale) v *= kscale[k0 + kk]; scr[kk * 33 + nl] = v; }
    LDS_WAIT(); asm volatile("" ::: "memory");
    const int c = lane & 7;
#pragma unroll
    for (int j = 0; j < 4; ++j) { const int nn = (lane >> 3) + 8 * j, ng = n0 + nn;
        if (ng < N) { const float cs = cscale<MODE>(ng); const LAS float* s = scr + (8 * c) * 33 + nn;
            v4u o; o.x = pk2(s[0 * 33] * cs, s[1 * 33] * cs); o.y = pk2(s[2 * 33] * cs, s[3 * 33] * cs); o.z = pk2(s[4 * 33] * cs, s[5 * 33] * cs); o.w = pk2(s[6 * 33] * cs, s[7 * 33] * cs);
            *(GAS v4u*)(WT + (size_t)dmap<MODE>(ng) * KT + k0 + 8 * c) = o; } }
    LDS_WAIT(); asm volatile("" ::: "memory");
}
__device__ __forceinline__ void zero_fill16(bf16* p, size_t n16, int gtid, int gthreads) {
    for (size_t i = gtid; i < n16; i += gthreads) ((GAS v4u*)p)[i] = (v4u){0u, 0u, 0u, 0u};
}

__device__ __forceinline__ void p_prologue(Frame& F, KArgsP ap_) {
#define a (*ap_)
    LAS float* scr = (LAS float*)(F.lds + F.wave * 16384);
    const int gw = F.vcu * NWAVES + F.wave, NGW = F.G * NWAVES;
    const int gtid = F.vcu * NTHR + F.tid, GT = F.G * NTHR;
    constexpr int I_IN = 16 * 72, I_OUT = 16 * 32, I_UP = 16 * 128, I_DN = 64 * 32, I_UQ = 3 * 12, I_UKV = 2 * 16, I_W1 = 32 * 4, I_W2 = 2 * 2;
    constexpr int PER_L = I_IN + I_OUT + I_UP + I_DN + I_UQ + I_UKV + 2 * I_W1 + 2 * I_W2;
    for (int it = gw; it < DEPTH * PER_L; it += NGW) {
        const int l = it / PER_L; int r = it - l * PER_L;
        unsigned char* wb = F.ws + WS_W + (size_t)l * WS_WL;
        if (r < I_IN) { transpose_item<1>(a.in[6] + (size_t)l * D * DIN, DIN, (bf16*)(wb + W_IN), D, nullptr, scr, r, F.lane); continue; } r -= I_IN;
        if (r < I_OUT) { transpose_item<0>(a.in[7] + (size_t)l * D * D, D, (bf16*)(wb + W_OUT), D, nullptr, scr, r, F.lane); continue; } r -= I_OUT;
        if (r < I_UP) { transpose_item<0>(a.in[19] + (size_t)l * D * DFF, DFF, (bf16*)(wb + W_UP), D, nullptr, scr, r, F.lane); continue; } r -= I_UP;
        if (r < I_DN) { transpose_item<0>(a.in[20] + (size_t)l * DFF * D, D, (bf16*)(wb + W_DN), DFF, nullptr, scr, r, F.lane); continue; } r -= I_DN;
        if (r < I_UQ) { transpose_item<2>(a.in[11] + (size_t)l * 192 * 384, 384, (bf16*)(wb + W_UQ), 256, a.in[9] + l * 192, scr, r, F.lane); continue; } r -= I_UQ;
        if (r < I_UKV) { transpose_item<0>(a.in[12] + (size_t)l * 128 * 512, 512, (bf16*)(wb + W_UKV), 256, a.in[10] + l * 128, scr, r, F.lane); continue; } r -= I_UKV;
        if (r < I_W1) { transpose_item<0>(a.in[15] + (size_t)l * 2048 * 128, 128, (bf16*)(wb + W_1K), 2048, nullptr, scr, r, F.lane); continue; } r -= I_W1;
        if (r < I_W1) { transpose_item<0>(a.in[17] + (size_t)l * 2048 * 128, 128, (bf16*)(wb + W_1V), 2048, nullptr, scr, r, F.lane); continue; } r -= I_W1;
        if (r < I_W2) { transpose_item<0>(a.in[16] + (size_t)l * 128 * 64, 64, (bf16*)(wb + W_2K), 128, nullptr, scr, r, F.lane); continue; } r -= I_W2;
        transpose_item<0>(a.in[18] + (size_t)l * 128 * 64, 64, (bf16*)(wb + W_2V), 128, nullptr, scr, r, F.lane);
    }
    for (int l = 0; l < DEPTH; ++l) {
        unsigned char* wb = F.ws + WS_W + (size_t)l * WS_WL;
        zero_fill16((bf16*)(wb + W_IN) + (size_t)1516 * D, 4 * D / 8, gtid, GT);
        zero_fill16((bf16*)(wb + W_IN) + (size_t)2288 * D, 16 * D / 8, gtid, GT);
        zero_fill16((bf16*)(wb + W_UQ) + (size_t)384 * 256, 128 * 256 / 8, gtid, GT);
        for (int i = gtid; i < 384 * 8; i += GT) ((GAS v4u*)((bf16*)(wb + W_UQ) + (size_t)(i >> 3) * 256 + 192))[i & 7] = (v4u){0u, 0u, 0u, 0u};
        for (int i = gtid; i < 512 * 16; i += GT) ((GAS v4u*)((bf16*)(wb + W_UKV) + (size_t)(i >> 4) * 256 + 128))[i & 15] = (v4u){0u, 0u, 0u, 0u};
    }
    { float* rt = (float*)(F.ws + WS_ROPE);
      for (int i = gtid; i < SEQ * 16; i += GT) { const int ii = i & 15, t = i >> 4; const float freq = powf(10000.f, -(float)ii / 16.f), ang = (float)t * freq; rt[2 * i] = cosf(ang); rt[2 * i + 1] = sinf(ang); } }
    { float* pp = (float*)(F.ws + WS_POSP);
      for (int i = gtid; i < DEPTH * 2 * 32 * 128; i += GT) { const int j = i & 127, kr = (i >> 7) & 31, wh = (i >> 12) & 1, l = i >> 13;
          const float* pos = a.in[wh ? 14 : 13] + l * 2048 + kr * 64; const float* w1 = a.in[wh ? 17 : 15] + (size_t)l * 2048 * 128 + (size_t)kr * 64 * 128 + j;
          float s = 0.f;
#pragma unroll 8
          for (int k = 0; k < 64; ++k) s += pos[k] * w1[(size_t)k * 128];
          pp[i] = s; } }
    { LAS float* sc = (LAS float*)(F.lds);
      LAS float* part = (LAS float*)(F.lds + 16384);
      __syncthreads();
      bool have = false;
      for (int it = F.vcu; it < DEPTH * 96; it += F.G) {
          if (!have) { for (int i = F.tid; i < NB * D; i += NTHR) { const float cv = a.in[1][i]; sc[i] = cv / (1.f + expf(-cv)); } have = true; __syncthreads(); }
          const int l = it / 96, ch = it % 96; const int j = ch * 64 + F.lane;
          const float* w = a.in[4] + (size_t)l * D * 6 * D + j;
          float acc[4] = {0.f, 0.f, 0.f, 0.f};
#pragma unroll 8
          for (int k = 128 * F.wave; k < 128 * F.wave + 128; ++k) { const float wv = w[(size_t)k * 6 * D]; acc[0] += sc[k] * wv; acc[1] += sc[D + k] * wv; acc[2] += sc[2 * D + k] * wv; acc[3] += sc[3 * D + k] * wv; }
#pragma unroll
          for (int b = 0; b < 4; ++b) part[(F.wave * 4 + b) * 64 + F.lane] = acc[b];
          __syncthreads();
          if (F.tid < 256) { const int b = F.tid >> 6, ln = F.tid & 63; float s = a.in[5][l * 6 * D + ch * 64 + ln];
#pragma unroll
              for (int w8 = 0; w8 < 8; ++w8) s += part[(w8 * 4 + b) * 64 + ln];
              ((float*)(F.ws + WS_MOD))[((size_t)l * NB + b) * 6 * D + ch * 64 + ln] = s; }
          __syncthreads();
      } }
}

#undef a
template <int MODE, bool XB16> __device__ __forceinline__ void p_norm(Frame& F, const void* x, const float* g, const float* modsh, const float* modsc, bf16* hout, float* fout) {
    const int gw = F.vcu * NWAVES + F.wave, NGW = F.G * NWAVES;
    for (int blk = gw; blk < M / 16; blk += NGW) {
        const int row0 = blk * 16, b = row0 >> 13;
        f32x4 ga[4], sh[4];
#pragma unroll
        for (int j = 0; j < 4; ++j) { const int c = 4 * F.lane + 256 * j; ga[j] = *(const f32x4*)(g + c);
            if (MODE == 0) { const f32x4 s = *(const f32x4*)(modsc + (size_t)b * 6 * D + c); ga[j] = ga[j] * (s + 1.0f); sh[j] = *(const f32x4*)(modsh + (size_t)b * 6 * D + c); } }
        for (int rr = 0; rr < 16; ++rr) {
            const int row = row0 + rr;
            f32x4 v[4]; float s = 0.f;
            if (XB16) { const GAS unsigned long long* xr = (const GAS unsigned long long*)((const bf16*)x + (size_t)row * D) + F.lane;
#pragma unroll
                for (int j = 0; j < 4; ++j) { const unsigned long long q = xr[64 * j]; const unsigned lo = (unsigned)q, hi = (unsigned)(q >> 32);
                    v[j] = (f32x4){__uint_as_float(lo << 16), __uint_as_float(lo & 0xffff0000u), __uint_as_float(hi << 16), __uint_as_float(hi & 0xffff0000u)}; } }
            else { const GAS f32x4* xr = (const GAS f32x4*)((const float*)x + (size_t)row * D) + F.lane;
#pragma unroll
                for (int j = 0; j < 4; ++j) v[j] = xr[64 * j]; }
#pragma unroll
            for (int j = 0; j < 4; ++j) s += (v[j].x * v[j].x + v[j].y * v[j].y) + (v[j].z * v[j].z + v[j].w * v[j].w);
            const float r = rsqrtf(wave_sum(s) * (1.f / D) + RMS_EPS);
            if (MODE == 0) { GAS unsigned long long* o8 = (GAS unsigned long long*)(hout + (size_t)row * D) + F.lane;
#pragma unroll
                for (int j = 0; j < 4; ++j) { const f32x4 y = v[j] * r * ga[j] + sh[j]; o8[64 * j] = (unsigned long long)pk2(y.x, y.y) | ((unsigned long long)pk2(y.z, y.w) << 32); } }
            else { GAS f32x4* o = (GAS f32x4*)(fout + (size_t)row * D) + F.lane;
#pragma unroll
                for (int j = 0; j < 4; ++j) o[64 * j] = v[j] * r * ga[j]; }
        }
    }
}

__device__ __forceinline__ void p_prep(Frame& F, int l) {
    const int gw = F.vcu * NWAVES + F.wave, NGW = F.G * NWAVES;
    const bf16* Z = (const bf16*)(F.ws + WS_Z); bf16* KM = (bf16*)(F.ws + WS_KM);
    float* rsq = (float*)(F.ws + WS_RSQ); float* rskv = (float*)(F.ws + WS_RSKV); const float* rope = (const float*)(F.ws + WS_ROPE);
    for (int row = gw; row < M; row += NGW) {
        const bf16* zr = Z + (size_t)row * ZLD;
        const float a0 = bf2f(zr[ZB_CQ + F.lane]), a1 = bf2f(zr[ZB_CQ + 64 + F.lane]), a2 = bf2f(zr[ZB_CQ + 128 + F.lane]);
        const float b0 = bf2f(zr[ZB_CKV + F.lane]), b1 = bf2f(zr[ZB_CKV + 64 + F.lane]);
        const float sq = wave_sum(a0 * a0 + a1 * a1 + a2 * a2), skv = wave_sum(b0 * b0 + b1 * b1);
        if (F.lane == 0) { rsq[row] = rsqrtf(sq * (1.f / 192.f) + RMS_EPS); rskv[row] = rsqrtf(skv * (1.f / 128.f) + RMS_EPS); }
        if (F.lane < 16) { const unsigned pr = *(const unsigned*)(zr + ZB_PE + 2 * F.lane); const float x1 = bf2f((unsigned short)(pr & 0xffffu)), x2 = bf2f((unsigned short)(pr >> 16));
            const float cs = rope[((size_t)(row & 8191) * 16 + F.lane) * 2], sn = rope[((size_t)(row & 8191) * 16 + F.lane) * 2 + 1];
            const unsigned o = pk2(x1 * cs - x2 * sn, x1 * sn + x2 * cs);
#pragma unroll
            for (int hd = 0; hd < 4; ++hd) *(unsigned*)(KM + (size_t)row * 384 + hd * 96 + 64 + 2 * F.lane) = o; }
    }
    { bf16* KMH = (bf16*)(F.ws + WS_KMH); bf16* KML = (bf16*)(F.ws + WS_KML);
      for (int it = gw; it < NB * 4 * 32; it += NGW) { const int j = it & 31, hd = (it >> 5) & 3, b = it >> 7; const int ts = F.lane >> 3, ch = F.lane & 7;
          float acc[8] = {0.f, 0.f, 0.f, 0.f, 0.f, 0.f, 0.f, 0.f};
          for (int i = 0; i < 32; ++i) { const v4u w = *(const v4u*)(Z + (size_t)(b * SEQ + j * 256 + 8 * i + ts) * ZLD + ZD_K + hd * 64 + ch * 8);
#pragma unroll
              for (int e = 0; e < 4; ++e) { acc[2 * e] += __uint_as_float(w[e] << 16); acc[2 * e + 1] += __uint_as_float(w[e] & 0xffff0000u); } }
#pragma unroll
          for (int e = 0; e < 8; ++e) { acc[e] += __shfl_xor(acc[e], 8); acc[e] += __shfl_xor(acc[e], 16); acc[e] += __shfl_xor(acc[e], 32); }
          if (F.lane < 8) { unsigned hi[4], lo[4];
#pragma unroll
              for (int e = 0; e < 4; ++e) { const float m0 = acc[2 * e] * (1.f / 256.f), m1 = acc[2 * e + 1] * (1.f / 256.f); const unsigned h0 = f2bf(m0), h1 = f2bf(m1);
                  hi[e] = h0 | (h1 << 16); lo[e] = pk2(m0 - __uint_as_float(h0 << 16), m1 - __uint_as_float(h1 << 16)); }
              *(v4u*)(KMH + (size_t)it * 64 + ch * 8) = (v4u){hi[0], hi[1], hi[2], hi[3]}; *(v4u*)(KML + (size_t)it * 64 + ch * 8) = (v4u){lo[0], lo[1], lo[2], lo[3]}; } } }
    if (gw == 0) { const float* pp = (const float*)(F.ws + WS_POSP) + (size_t)l * 2 * 32 * 128; float* pb = (float*)(F.ws + WS_POSB) + l * 256;
        for (int i = F.lane; i < 256; i += 64) { const int j = i & 127, wh = i >> 7; float s = 0.f; for (int kr = 0; kr < 32; ++kr) s += pp[(wh * 32 + kr) * 128 + j]; pb[i] = s; } }
}

__device__ __forceinline__ float gelu_tanh(float x) { const float u = 0.7978845608028654f * (x + 0.044715f * x * x * x); const float e = __expf(2.f * u); return x * (1.f - 1.f / (e + 1.f)); }
__device__ __forceinline__ void p_compress(Frame& F, int l) {
    const bf16* Z = (const bf16*)(F.ws + WS_Z);
    unsigned char* wb = F.ws + WS_W + (size_t)l * WS_WL;
    LAS float* red = (LAS float*)F.lds;
    const int r = F.lane & 31, h = F.lane >> 5;
    for (int it = F.vcu; it < NB * 16 * 2; it += F.G) {
        const int which = it & 1, itile = (it >> 1) & 15, b = it >> 5;
        const bf16* W1T = (const bf16*)(wb + (which ? W_1V : W_1K)); const bf16* W2T = (const bf16*)(wb + (which ? W_2V : W_2K));
        const int coff = which ? ZC_VC : ZC_KC;
        f32x16 acc[4] = {f32x16{}, f32x16{}, f32x16{}, f32x16{}};
        const bf16* brow = Z + (size_t)(b * SEQ + 16 * (32 * itile + r)) * ZLD + coff + 8 * h;
#pragma unroll 2
        for (int ks = 0; ks < 16; ++ks) { const int tt = 4 * F.wave + (ks >> 2), d0 = ks & 3;
            const bf16x8 bf = *(const bf16x8*)(brow + (size_t)tt * ZLD + d0 * 16);
#pragma unroll
            for (int hb = 0; hb < 4; ++hb) { const bf16x8 af = *(const bf16x8*)(W1T + (size_t)(hb * 32 + r) * 2048 + tt * 64 + d0 * 16 + 8 * h);
                acc[hb] = __builtin_amdgcn_mfma_f32_32x32x16_bf16(af, bf, acc[hb], 0, 0, 0); } }
#pragma unroll
        for (int hb = 0; hb < 4; ++hb)
#pragma unroll
            for (int v = 0; v < 16; ++v) red[((F.wave * 4 + hb) * 16 + v) * 64 + F.lane] = acc[hb][v];
        __syncthreads();
        if (F.wave < 2) {
            const float* pb = (const float*)(F.ws + WS_POSB) + l * 256 + which * 128;
            f32x16 o = f32x16{};
#pragma unroll
            for (int hb = 0; hb < 4; ++hb) { float x[16];
#pragma unroll
                for (int v = 0; v < 16; ++v) { float s = pb[hb * 32 + (v & 3) + 8 * (v >> 2) + 4 * h];
#pragma unroll
                    for (int w8 = 0; w8 < 8; ++w8) s += red[((w8 * 4 + hb) * 16 + v) * 64 + F.lane];
                    x[v] = gelu_tanh(s); }
#pragma unroll
                for (int s2 = 0; s2 < 2; ++s2) {
                    v4u pw; pw.x = fa::cvtpk(x[8 * s2], x[8 * s2 + 1]); pw.y = fa::cvtpk(x[8 * s2 + 2], x[8 * s2 + 3]); pw.z = fa::cvtpk(x[8 * s2 + 4], x[8 * s2 + 5]); pw.w = fa::cvtpk(x[8 * s2 + 6], x[8 * s2 + 7]);
                    const bf16* wr = W2T + (size_t)(F.wave * 32 + r) * 128 + hb * 32 + 16 * s2 + 4 * h;
                    const v2u a0 = *(const v2u*)wr, a1 = *(const v2u*)(wr + 8);
                    const v4u aw = (v4u){a0.x, a0.y, a1.x, a1.y};
                    o = __builtin_amdgcn_mfma_f32_32x32x16_bf16(__builtin_bit_cast(bf16x8, aw), __builtin_bit_cast(bf16x8, pw), o, 0, 0, 0); } }
            bf16* dst = (bf16*)(F.ws + (which ? WS_VCMP : WS_KCMP)) + (size_t)(b * 512 + 32 * itile + r) * 64 + F.wave * 32 + 4 * h;
#pragma unroll
            for (int g = 0; g < 4; ++g) { v2u w; w.x = fa::cvtpk(o[4 * g], o[4 * g + 1]); w.y = fa::cvtpk(o[4 * g + 2], o[4 * g + 3]); *(v2u*)(dst + 8 * g) = w; }
        }
        __syncthreads();
    }
}
using fa::bf16x8;
__device__ __forceinline__ unsigned char* launder_ptr(unsigned char* p) { const unsigned long long v = (unsigned long long)p; unsigned lo = __builtin_amdgcn_readfirstlane((unsigned)v), hi = __builtin_amdgcn_readfirstlane((unsigned)(v >> 32)); asm volatile("" : "+s"(lo), "+s"(hi)); return (unsigned char*)(((unsigned long long)hi << 32) | lo); }
#define UNIT_BEGIN() Frame F = F0; { int tid_ = F0.tid; asm volatile("" : "+v"(tid_)); int bx_ = __builtin_amdgcn_readfirstlane(F0.bx); asm volatile("" : "+s"(bx_)); \
    F.ws = launder_ptr(F0.ws); F.tid = tid_; F.lane = tid_ & 63; F.wave = __builtin_amdgcn_readfirstlane(tid_ >> 6); F.bx = bx_; }
__device__ __forceinline__ void u_mla(const Frame& F0, int b, int hd, int u) {
    UNIT_BEGIN();
    GAS char* ws = (GAS char*)F.ws;
    const int r = F.lane & 31, h = F.lane >> 5, q0 = 256 * u, wq0 = q0 + 32 * F.wave, tq = wq0 + r;
    bf16x8 qf[6]; { const unsigned qrow = (unsigned)WS_QM + (unsigned)(b * SEQ + tq) * 1024u;
      const float rs = *(const GAS float*)(ws + ((unsigned)WS_RSQ + (unsigned)(b * SEQ + tq) * 4u));
#pragma unroll
      for (int d0 = 0; d0 < 4; ++d0) { const fa::u32x4 raw = *(const GAS fa::u32x4*)(ws + (qrow + (unsigned)(hd * 128 + d0 * 32 + 16 * h))); fa::u32x4 o;
          o.x = fa::cvtpk(__uint_as_float(raw.x << 16) * rs, __uint_as_float(raw.x & 0xffff0000u) * rs); o.y = fa::cvtpk(__uint_as_float(raw.y << 16) * rs, __uint_as_float(raw.y & 0xffff0000u) * rs);
          o.z = fa::cvtpk(__uint_as_float(raw.z << 16) * rs, __uint_as_float(raw.z & 0xffff0000u) * rs); o.w = fa::cvtpk(__uint_as_float(raw.w << 16) * rs, __uint_as_float(raw.w & 0xffff0000u) * rs);
          qf[d0] = __builtin_bit_cast(bf16x8, o); }
#pragma unroll
      for (int d0 = 0; d0 < 2; ++d0) {
          const fa::u32x4 raw = *(const GAS fa::u32x4*)(ws + (qrow + (unsigned)(512 + hd * 64 + d0 * 32 + 16 * h)));
          const GAS float* rp = (const GAS float*)(ws + ((unsigned)WS_ROPE + (unsigned)((tq * 16 + d0 * 8 + 4 * h) * 8)));
          const fa::f32x4v r0 = *(const GAS fa::f32x4v*)rp * rs, r1 = *(const GAS fa::f32x4v*)(rp + 4) * rs;
          fa::u32x4 o;
          { const float x1 = __uint_as_float(raw.x << 16), x2 = __uint_as_float(raw.x & 0xffff0000u); o.x = fa::cvtpk(x1 * r0[0] - x2 * r0[1], x1 * r0[1] + x2 * r0[0]); }
          { const float x1 = __uint_as_float(raw.y << 16), x2 = __uint_as_float(raw.y & 0xffff0000u); o.y = fa::cvtpk(x1 * r0[2] - x2 * r0[3], x1 * r0[3] + x2 * r0[2]); }
          { const float x1 = __uint_as_float(raw.z << 16), x2 = __uint_as_float(raw.z & 0xffff0000u); o.z = fa::cvtpk(x1 * r1[0] - x2 * r1[1], x1 * r1[1] + x2 * r1[0]); }
          { const float x1 = __uint_as_float(raw.w << 16), x2 = __uint_as_float(raw.w & 0xffff0000u); o.w = fa::cvtpk(x1 * r1[2] - x2 * r1[3], x1 * r1[3] + x2 * r1[2]); }
          qf[4 + d0] = __builtin_bit_cast(bf16x8, o); } }
    SM st; fa::sm_init(st);
    LAS char* lds = (LAS char*)F.lds;
    fa::fa_loop<96, false>(st, qf, ws, (unsigned)WS_KM + (unsigned)b * (SEQ * 768u) + (unsigned)hd * 192u, 768u, (unsigned)WS_VM + (unsigned)b * (SEQ * 512u) + (unsigned)hd * 128u, 512u, SEQ - 1, 4 * u + 4,
        [](int t) { return 64 * t; },
        [=](int t, bool& act, bool& ew, float& cb, int& lo, int& hi) { const int key0 = 64 * t; act = key0 <= wq0 + 31; ew = key0 + 63 > wq0; cb = 0.f; lo = -100000; hi = tq - key0; },
        0.f, lds + FA_STAGES, F.tid, F.lane);
    f32x16 acc[2] = {f32x16{}, f32x16{}}; fa::sm_finish(st, 1.f, acc);
    fa::store_out(acc, lds + FA_OST + F.wave * 32 * fa::OSTR, ws, [=](int col) { return (unsigned)WS_O + (unsigned)(b * SEQ + wq0 + col) * 2048u + (unsigned)(256 + hd * 64) * 2u; }, F.lane);
}
__device__ __forceinline__ void u_moba(const Frame& F0, int b, int hd, int i) {
    UNIT_BEGIN();
    GAS char* ws = (GAS char*)F.ws;
    const int r = F.lane & 31, h = F.lane >> 5, q0 = 256 * i, wq0 = q0 + 32 * F.wave, tq = wq0 + r;
    bf16x8 qf[4]; fa::load_q<64>(qf, ws, (unsigned)WS_Z + (unsigned)(b * SEQ + tq) * (ZLD * 2u) + (unsigned)(ZD_Q + hd * 64) * 2u, h);
    unsigned bits = 0u;
    if (i > 0) {
        const GAS bf16* KMH = (const GAS bf16*)(ws + ((unsigned)WS_KMH + (unsigned)(((b * 4 + hd) * 32 + r) * 64 + 8 * h) * 2u)); const GAS bf16* KML = (const GAS bf16*)(ws + ((unsigned)WS_KML + (unsigned)(((b * 4 + hd) * 32 + r) * 64 + 8 * h) * 2u));
        f32x16 g = f32x16{};
#pragma unroll
        for (int d0 = 0; d0 < 4; ++d0) { const bf16x8 ah = *(const GAS bf16x8*)(KMH + d0 * 16), al = *(const GAS bf16x8*)(KML + d0 * 16);
            g = __builtin_amdgcn_mfma_f32_32x32x16_bf16(ah, qf[d0], g, 0, 0, 0); g = __builtin_amdgcn_mfma_f32_32x32x16_bf16(al, qf[d0], g, 0, 0, 0); }
        float og[16];
#pragma unroll
        for (int v = 0; v < 16; ++v) { const int j = (v & 3) + 8 * (v >> 2) + 4 * h; if (j >= i) g[v] = -INFINITY; og[v] = __shfl_xor(g[v], 32); }
#pragma unroll
        for (int v = 0; v < 16; ++v) { const int j = (v & 3) + 8 * (v >> 2) + 4 * h; int rank = 0;
#pragma unroll
            for (int w = 0; w < 16; ++w) { const int jm = (w & 3) + 8 * (w >> 2) + 4 * h, jo = (w & 3) + 8 * (w >> 2) + 4 * (1 - h);
                rank += (g[w] > g[v] || (g[w] == g[v] && jm < j)) ? 1 : 0; rank += (og[w] > g[v] || (og[w] == g[v] && jo < j)) ? 1 : 0; }
            if (rank < 3 && j < i) bits |= 1u << j; }
        bits |= __shfl_xor(bits, 32);
    }
    const float sl = slope2_of(2 + 3 * hd);
    LAS char* lds = (LAS char*)F.lds;
    LAS char* Qimg = lds + MB_Q;
    LAS float* Ost = (LAS float*)(lds + MB_O);
    LAS float* MLst = (LAS float*)(lds + MB_ML);
    LAS unsigned* cnt = (LAS unsigned*)(lds + MB_CNT);
    LAS unsigned char* lst = (LAS unsigned char*)(lds + MB_LST);
    const unsigned koff = (unsigned)WS_Z + (unsigned)b * (SEQ * ZLD * 2u) + (unsigned)(ZD_K + hd * 64) * 2u, voff = (unsigned)WS_Z + (unsigned)b * (SEQ * ZLD * 2u) + (unsigned)(ZD_V + hd * 64) * 2u;
    if (F.tid < 32) cnt[F.tid] = 0u;
#pragma unroll
    for (int d0 = 0; d0 < 4; ++d0) *(LAS bf16x8*)(Qimg + (32 * F.wave + r) * 128 + d0 * 32 + h * 16) = qf[d0];
    {
        SM st; fa::sm_init(st);
        fa::fa_loop<64, true>(st, qf, ws, koff, ZLD * 2u, voff, ZLD * 2u, SEQ - 1, 4,
            [=](int t) { return q0 + 64 * t; },
            [=](int t, bool& act, bool& ew, float& cb, int& lo, int& hi) { const int key0 = q0 + 64 * t; act = key0 <= wq0 + 31; ew = key0 + 63 > wq0; cb = sl * (float)(64 * t + 4 * h); lo = -100000; hi = tq - key0; },
            sl, lds + FA_STAGES, F.tid, F.lane);
        const float lt = fa::xhalf_sum(st.l);
        LAS float* orow = Ost + (32 * F.wave + r) * 64;
#pragma unroll
        for (int db = 0; db < 2; ++db)
#pragma unroll
            for (int g = 0; g < 4; ++g) *(LAS fa::f32x4v*)(orow + 32 * db + 8 * g + 4 * h) = (fa::f32x4v){st.o[db][4 * g], st.o[db][4 * g + 1], st.o[db][4 * g + 2], st.o[db][4 * g + 3]};
        if (h == 0) { MLst[(32 * F.wave + r) * 2] = st.m; MLst[(32 * F.wave + r) * 2 + 1] = lt; }
    }
    if (h == 0) { unsigned bb = bits;
        while (bb) { const int j = __ffs(bb) - 1; bb &= bb - 1u; const unsigned slot = __hip_atomic_fetch_add(&cnt[j], 1u, __ATOMIC_RELAXED, __HIP_MEMORY_SCOPE_WORKGROUP); lst[j * 256 + slot] = (unsigned char)(32 * F.wave + r); } }
    LDS_WAIT(); __syncthreads();
    const int ntile = 4 * i;
    if (ntile > 0) {
        fa::Stg<64> sg;
        fa::stg_load<64>(sg, ws, koff, ZLD * 2u, voff, ZLD * 2u, 0, SEQ - 1, F.tid); fa::stg_store<64>(sg, lds + FA_STAGES, F.tid); __syncthreads();
        SM st; fa::sm_init(st); bf16x8 qfb[4] = {qf[0], qf[1], qf[2], qf[3]}; bool myact = false, colv = false; int qsel = 0;
        for (int t = 0; t < ntile; ++t) {
            const LAS char* buf = lds + FA_STAGES + (t & 1) * 16384;
            if (t + 1 < ntile) fa::stg_load<64>(sg, ws, koff, ZLD * 2u, voff, ZLD * 2u, 64 * (t + 1), SEQ - 1, F.tid);
            if ((t & 3) == 0) { const int j = t >> 2; const int n = (int)cnt[j]; myact = 32 * F.wave < n; colv = (32 * F.wave + r) < n; qsel = colv ? (int)lst[j * 256 + 32 * F.wave + r] : 0;
                if (myact) { fa::sm_init(st);
#pragma unroll
                    for (int d0 = 0; d0 < 4; ++d0) qfb[d0] = *(const LAS bf16x8*)(Qimg + qsel * 128 + d0 * 32 + h * 16); } }
            if (myact) { fa::f32x16 p0, p1; bf16x8 pf[4];
                fa::score_tile<64, true>(p0, p1, buf, qfb, colv ? sl * (float)(64 * t - q0 + 4 * h) : fa::MASKV, sl, F.lane);
                fa::sm_step(st, p0, p1, pf);
                fa::pv(st.o, buf + 8192, pf, F.lane);
                if ((t & 3) == 3) {
                    const float lp = fa::xhalf_sum(st.l);
                    if (colv) { const float ms = MLst[qsel * 2], ls = MLst[qsel * 2 + 1]; const float mn = fmaxf(ms, st.m), ea = fa::ex2(ms - mn), eb = fa::ex2(st.m - mn);
                        LAS float* orow = Ost + qsel * 64;
#pragma unroll
                        for (int db = 0; db < 2; ++db)
#pragma unroll
                            for (int g = 0; g < 4; ++g) { LAS fa::f32x4v* p = (LAS fa::f32x4v*)(orow + 32 * db + 8 * g + 4 * h); const fa::f32x4v o4 = *p;
                                *p = (fa::f32x4v){o4[0] * ea + st.o[db][4 * g] * eb, o4[1] * ea + st.o[db][4 * g + 1] * eb, o4[2] * ea + st.o[db][4 * g + 2] * eb, o4[3] * ea + st.o[db][4 * g + 3] * eb}; }
                        asm volatile("s_waitcnt lgkmcnt(0)" ::: "memory");
                        if (h == 0) { MLst[qsel * 2] = mn; MLst[qsel * 2 + 1] = ls * ea + lp * eb; } } } }
            if (t + 1 < ntile) fa::stg_store<64>(sg, lds + FA_STAGES + ((t + 1) & 1) * 16384, F.tid);
            __syncthreads();
        }
    }
    { const int q = 32 * F.wave + (F.lane >> 1), hf = F.lane & 1; const float inv = 1.f / fmaxf(MLst[q * 2 + 1], fa::TINYF);
      const LAS float* orow = Ost + q * 64 + 32 * hf;
      GAS char* dst = ws + ((unsigned)WS_O + (unsigned)(b * SEQ + q0 + q) * 2048u + (unsigned)(768 + hd * 64 + 32 * hf) * 2u);
#pragma unroll
      for (int c = 0; c < 4; ++c) { const fa::f32x4v x0 = *(const LAS fa::f32x4v*)(orow + 8 * c), x1 = *(const LAS fa::f32x4v*)(orow + 8 * c + 4);
          fa::u32x4 w; w.x = fa::cvtpk(x0[0] * inv, x0[1] * inv); w.y = fa::cvtpk(x0[2] * inv, x0[3] * inv); w.z = fa::cvtpk(x1[0] * inv, x1[1] * inv); w.w = fa::cvtpk(x1[2] * inv, x1[3] * inv);
          *(GAS fa::u32x4*)(dst + 16 * c) = w; } }
    LDS_WAIT(); __syncthreads();
}
__device__ __forceinline__ void u_swa(const Frame& F0, int b, int kvh, int u, const float* sinks) {
    UNIT_BEGIN();
    GAS char* ws = (GAS char*)F.ws;
    const int r = F.lane & 31, h = F.lane >> 5, q0 = 128 * u, wq0 = q0 + 16 * F.wave, tq = wq0 + (r >> 1), hd = kvh * 2 + (r & 1);
    bf16x8 qf[4]; fa::load_q<64>(qf, ws, (unsigned)WS_Z + (unsigned)(b * SEQ + tq) * (ZLD * 2u) + (unsigned)(ZA_Q + hd * 64) * 2u, h);
    const float sl = slope2_of(3 * hd);
    const int t0 = (2 * u - 2) > 0 ? (2 * u - 2) : 0, nt = 2 * u + 2 - t0;
    SM st; fa::sm_init(st);
    LAS char* lds = (LAS char*)F.lds;
    fa::fa_loop<64, true>(st, qf, ws, (unsigned)WS_Z + (unsigned)b * (SEQ * ZLD * 2u) + (unsigned)(ZA_K + kvh * 64) * 2u, ZLD * 2u, (unsigned)WS_Z + (unsigned)b * (SEQ * ZLD * 2u) + (unsigned)(ZA_V + kvh * 64) * 2u, ZLD * 2u, SEQ - 1, nt,
        [=](int t) { return 64 * (t0 + t); },
        [=](int t, bool& act, bool& ew, float& cb, int& lo, int& hi) { const int key0 = 64 * (t0 + t); act = (key0 <= wq0 + 15) && (key0 + 63 >= wq0 - 127); ew = true;
            cb = sl * (float)(key0 - q0 + 4 * h); lo = tq - 127 - key0; hi = tq - key0; },
        sl, lds + FA_STAGES, F.tid, F.lane);
    const float sk = sinks[hd] * LOG2E + sl * (float)(tq - q0), mf = fmaxf(st.m, sk), a = fa::ex2(st.m - mf);
    const float ltot = fa::xhalf_sum(st.l) * a + fa::ex2(sk - mf), inv = a / fmaxf(ltot, fa::TINYF);
    f32x16 acc[2]; acc[0] = st.o[0] * inv; acc[1] = st.o[1] * inv;
    fa::store_out(acc, lds + FA_OST + F.wave * 32 * fa::OSTR, ws, [=](int col) { return (unsigned)WS_O + (unsigned)(b * SEQ + wq0 + (col >> 1)) * 2048u + (unsigned)((kvh * 2 + (col & 1)) * 64) * 2u; }, F.lane);
}
__device__ __forceinline__ void u_nsa(const Frame& F0, int b, int qi) {
    UNIT_BEGIN();
    GAS char* ws = (GAS char*)F.ws;
    const unsigned KC = (unsigned)WS_KCMP + (unsigned)b * (512u * 128u), VC = (unsigned)WS_VCMP + (unsigned)b * (512u * 128u), ZB = (unsigned)WS_Z + (unsigned)b * (SEQ * ZLD * 2u);
    const int r = F.lane & 31, h = F.lane >> 5, q0 = 64 * qi, wq0 = q0 + 8 * F.wave, qloc = 8 * F.wave + (r >> 2), tq = q0 + qloc, hd = r & 3;
    const unsigned zrow_off = ZB + (unsigned)tq * (ZLD * 2u); const GAS bf16* zrow = (const GAS bf16*)(ws + zrow_off);
    bf16x8 qf[4]; fa::load_q<64>(qf, ws, zrow_off + (unsigned)(ZC_Q + hd * 64) * 2u, h);
    const float sl = slope2_of(1 + 3 * hd);
    const float g0 = 1.f / (1.f + __expf(-bf2f(zrow[ZC_GL + hd]))), g1 = 1.f / (1.f + __expf(-bf2f(zrow[ZC_GL + 4 + hd]))), g2 = 1.f / (1.f + __expf(-bf2f(zrow[ZC_GL + 8 + hd])));
    LAS char* lds = (LAS char*)F.lds;
    LAS float* impA = (LAS float*)(lds + FA_IMP) + F.wave * 1024;
    LAS float* impB = (LAS float*)(lds + FA_OST) + F.wave * 1024;
    LAS unsigned* selm = (LAS unsigned*)(lds + FA_SELM);
    LAS unsigned* um = (LAS unsigned*)(lds + FA_UM);
    LAS float* vals = (LAS float*)(lds + FA_VALS) + F.wave * 128;
    if (F.tid < 4) um[F.tid] = 0u;
    const unsigned parko = (unsigned)WS_PARK + (unsigned)((F.bx * NWAVES + F.wave) * 2 * 32 * 64 + F.lane) * 4u;
#define PARK(i) (*(GAS float*)(ws + (parkl + (unsigned)((i) * 256))))
    const int ntc = ((4 * qi + 3) >> 6) + 1;
    const int cvis = (tq - 31) >> 4;
    const int cvis_min = (q0 - 31) >> 4;
    const float slc = 16.f * sl;
    SM st; fa::sm_init(st);
    fa::fa_loop<64, true>(st, qf, ws, KC, 128u, VC, 128u, 510, ntc,
        [](int t) { return 64 * t; },
        [=](int t, bool& act, bool& ew, float& cb, int& lo, int& hi) { const int c0 = 64 * t; act = true; ew = c0 + 63 > cvis_min; cb = slc * (float)(c0 - 4 * qi + 4 * h); lo = -100000; hi = cvis - c0; },
        slc, lds + FA_STAGES, F.tid, F.lane);
    { f32x16 t2[2] = {f32x16{}, f32x16{}}; fa::sm_finish(st, g0, t2); unsigned parkl = parko; asm volatile("" : "+v"(parkl));
#pragma unroll
      for (int v = 0; v < 16; ++v) { PARK(v) = t2[0][v]; PARK(16 + v) = t2[1][v]; } }
    {
        const float mfin = st.m, invl = 1.f / fmaxf(fa::xhalf_sum(st.l), fa::TINYF);
        constexpr int STG = fa::stage_bytes<64>();
        fa::Stg<64> sg;
        fa::stg_load<64>(sg, ws, KC, 128u, VC, 128u, 0, 510, F.tid); fa::stg_store<64>(sg, lds + FA_STAGES, F.tid); __syncthreads();
        for (int t = 0; t < ntc; ++t) {
            const LAS char* buf = lds + FA_STAGES + (t & 1) * STG;
            if (t + 1 < ntc) fa::stg_load<64>(sg, ws, KC, 128u, VC, 128u, 64 * (t + 1), 510, F.tid);
            const int c0 = 64 * t;
            f32x16 p0, p1; fa::score_tile<64, true>(p0, p1, buf, qf, slc * (float)(c0 - 4 * qi + 4 * h), slc, F.lane);
            if (c0 + 63 > cvis_min) fa::mask_ew(p0, p1, -100000, cvis - c0, h);
#pragma unroll
            for (int kh = 0; kh < 2; ++kh)
#pragma unroll
                for (int g = 0; g < 4; ++g) {
                    float e0, e1, e2, e3;
                    if (kh == 0) { e0 = fa::ex2(p0[4 * g] - mfin); e1 = fa::ex2(p0[4 * g + 1] - mfin); e2 = fa::ex2(p0[4 * g + 2] - mfin); e3 = fa::ex2(p0[4 * g + 3] - mfin); }
                    else { e0 = fa::ex2(p1[4 * g] - mfin); e1 = fa::ex2(p1[4 * g + 1] - mfin); e2 = fa::ex2(p1[4 * g + 2] - mfin); e3 = fa::ex2(p1[4 * g + 3] - mfin); }
                    e0 *= invl; e1 *= invl; e2 *= invl; e3 *= invl;
                    float s4 = ((e0 + e1) + e2) + e3;
                    s4 += __shfl_xor(s4, 1); s4 += __shfl_xor(s4, 2); e3 += __shfl_xor(e3, 1); e3 += __shfl_xor(e3, 2);
                    const int j = 16 * t + 8 * kh + 2 * g + h;
                    if (hd == 0) { impA[(r >> 2) * 128 + j] = s4; impB[(r >> 2) * 128 + j] = e3; }
                }
            if (t + 1 < ntc) fa::stg_store<64>(sg, lds + FA_STAGES + ((t + 1) & 1) * STG, F.tid);
            __syncthreads();
        }
    }
    {
        const int cur = qi;
        for (int qq = 0; qq < 8; ++qq) {
            unsigned long long m0, m1;
            if (cur < 16) { m0 = (cur >= 63) ? ~0ull : ((1ull << (cur + 1)) - 1ull); m1 = 0ull; }
            else {
                const int ja = F.lane, jb2 = F.lane + 64;
                const bool fca = (ja == 0 || ja == cur || ja == cur - 1), fcb = (jb2 == cur || jb2 == cur - 1);
                const float va = impA[qq * 128 + ja] + (ja > 0 ? impB[qq * 128 + ja - 1] : 0.f), vb = impA[qq * 128 + jb2] + impB[qq * 128 + jb2 - 1];
                const unsigned ka = (ja <= cur && !fca) ? (__float_as_uint(va) + 1u) : 0u, kb = (jb2 <= cur && !fcb) ? (__float_as_uint(vb) + 1u) : 0u;
                unsigned T = 0u;
                for (int bit = 31; bit >= 0; --bit) { const unsigned cand = T | (1u << bit); const int c = __popcll(__ballot(ka >= cand)) + __popcll(__ballot(kb >= cand)); if (c >= 13) T = cand; }
                if (T == 0u) T = 1u;
                const unsigned long long ga = __ballot(ka > T), gb = __ballot(kb > T), ea = __ballot(ka == T), eb = __ballot(kb == T);
                const int R = 13 - (__popcll(ga) + __popcll(gb)), na = __popcll(ea);
                const int pa = (int)__builtin_amdgcn_mbcnt_hi((unsigned)(ea >> 32), __builtin_amdgcn_mbcnt_lo((unsigned)ea, 0u)), pb = (int)__builtin_amdgcn_mbcnt_hi((unsigned)(eb >> 32), __builtin_amdgcn_mbcnt_lo((unsigned)eb, 0u));
                m0 = ga | __ballot(ka == T && pa < R) | 1ull; m1 = gb | __ballot(kb == T && (na + pb) < R);
                if (cur < 64) m0 |= 1ull << cur; else m1 |= 1ull << (cur - 64);
                if (cur - 1 < 64) m0 |= 1ull << (cur - 1); else m1 |= 1ull << (cur - 65);
            }
            if (F.lane == 0) { LAS unsigned* sp = selm + (8 * F.wave + qq) * 4; sp[0] = (unsigned)m0; sp[1] = (unsigned)(m0 >> 32); sp[2] = (unsigned)m1; sp[3] = (unsigned)(m1 >> 32);
                __hip_atomic_fetch_or(&um[0], (unsigned)m0, __ATOMIC_RELAXED, __HIP_MEMORY_SCOPE_WORKGROUP); __hip_atomic_fetch_or(&um[1], (unsigned)(m0 >> 32), __ATOMIC_RELAXED, __HIP_MEMORY_SCOPE_WORKGROUP); __hip_atomic_fetch_or(&um[2], (unsigned)m1, __ATOMIC_RELAXED, __HIP_MEMORY_SCOPE_WORKGROUP); __hip_atomic_fetch_or(&um[3], (unsigned)(m1 >> 32), __ATOMIC_RELAXED, __HIP_MEMORY_SCOPE_WORKGROUP); }
        }
        LDS_WAIT(); __syncthreads();
    }
    {
        const unsigned uw0 = um[0], uw1 = um[1], uw2 = um[2], uw3 = um[3];
        const LAS unsigned* selq = selm + qloc * 4;
        const int nsel = __builtin_amdgcn_readfirstlane(__popc(uw0) + __popc(uw1) + __popc(uw2) + __popc(uw3));
        LAS unsigned char* slist = (LAS unsigned char*)(lds + FA_VALS);
        if (F.tid < 128) { const int j = F.tid; const unsigned w = (j < 32) ? uw0 : (j < 64) ? uw1 : (j < 96) ? uw2 : uw3;
            if ((w >> (j & 31)) & 1u) { int pos = __popc(w & ((1u << (j & 31)) - 1u)); if (j >= 32) pos += __popc(uw0); if (j >= 64) pos += __popc(uw1); if (j >= 96) pos += __popc(uw2); slist[pos] = (unsigned char)j; } }
        LDS_WAIT(); __syncthreads();
        fa::sm_init(st);
        fa::fa_loop<64, true>(st, qf, ws, ZB + ZC_KS * 2u, ZLD * 2u, ZB + ZC_VS * 2u, ZLD * 2u, SEQ - 1, nsel,
            [=](int t) { return 64 * (int)slist[t]; },
            [=](int t, bool& act, bool& ew, float& cb, int& lo, int& hi) { const int j = (int)slist[t], key0 = 64 * j; const unsigned mw = selq[j >> 5];
                const bool on = (mw >> (j & 31)) & 1u; act = __any(on) != 0; ew = (j == qi); cb = on ? sl * (float)(key0 - q0 + 4 * h) : fa::MASKV; lo = -100000; hi = tq - key0; },
            sl, lds + FA_STAGES, F.tid, F.lane);
        { f32x16 t2[2] = {f32x16{}, f32x16{}}; fa::sm_finish(st, g1, t2); unsigned parkl = parko; asm volatile("" : "+v"(parkl));
#pragma unroll
          for (int v = 0; v < 16; ++v) { PARK(32 + v) = t2[0][v]; PARK(48 + v) = t2[1][v]; } }
    }
    {
        const int t0 = (qi - 8) > 0 ? (qi - 8) : 0, nt = qi + 1 - t0;
        fa::sm_init(st);
        fa::fa_loop<64, true>(st, qf, ws, ZB + ZC_KW * 2u, ZLD * 2u, ZB + ZC_VW * 2u, ZLD * 2u, SEQ - 1, nt,
            [=](int t) { return 64 * (t0 + t); },
            [=](int t, bool& act, bool& ew, float& cb, int& lo, int& hi) { const int j = t0 + t, key0 = 64 * j; act = true; ew = (j == qi) || (j == qi - 8);
                cb = sl * (float)(key0 - q0 + 4 * h); lo = tq - 511 - key0; hi = tq - key0; },
            sl, lds + FA_STAGES, F.tid, F.lane);
    }
    f32x16 acc[2] = {f32x16{}, f32x16{}}; fa::sm_finish(st, g2, acc); unsigned parkl = parko; asm volatile("" : "+v"(parkl));
#pragma unroll
    for (int v = 0; v < 16; ++v) { acc[0][v] += PARK(v) + PARK(32 + v); acc[1][v] += PARK(16 + v) + PARK(48 + v); }
#undef PARK
    fa::store_out(acc, lds + FA_OST + F.wave * 32 * fa::OSTR, ws, [=](int col) { return (unsigned)WS_O + (unsigned)(b * SEQ + wq0 + (col >> 2)) * 2048u + (unsigned)(512 + (col & 3) * 64) * 2u; }, F.lane);
}

__device__ __forceinline__ void p_attn(Frame& F, const float* sinks, int mskip) {
    const int id = F.vcu;
    if (F.G != 256) return;
    { const int bh = id >> 4, s = id & 15;
#pragma unroll 1
      for (int k = 0; k < (((mskip >> 9) & 1) ? 4 : 2); ++k) u_mla(F, bh >> 2, bh & 3, (k & 1) ? s : 31 - s); }
    { const int bh = id >> 4, s = id & 15;
#pragma unroll 1
      for (int k = 0; k < (((mskip >> 11) & 1) ? 4 : 2); ++k) u_moba(F, bh >> 2, bh & 3, (k & 1) ? s : 31 - s); }
    if (!(mskip & 4)) { const int b = id >> 6, s = id & 63;
#pragma unroll 1
      for (int k = 0; k < (((mskip >> 10) & 1) ? 4 : 2); ++k) u_nsa(F, b, (k & 1) ? s : 127 - s); }
    {
#pragma unroll 1
      for (int k = 0; k < (((mskip >> 8) & 1) ? 4 : 2); ++k) { const int u0 = 2 * id + (k & 1); u_swa(F, u0 >> 7, (u0 >> 6) & 1, u0 & 63, sinks); } }
}
constexpr int PH_PRO = 0, PH_L0 = 1, PH_PER_L = 9, PH_FIN = 19, PH_END = 20;
constexpr int PO_NORM1 = 0, PO_ZG = 1, PO_PREP = 2, PO_UP = 3, PO_ATTN = 4, PO_OG = 5, PO_NORM2 = 6, PO_UPG = 7, PO_DNG = 8;
#ifndef MK_PHASE_MASK
#define MK_PHASE_MASK 0xFFFFFu
#endif

__global__ void __launch_bounds__(NTHR, 2) mega(Args args) {
    extern __shared__ __attribute__((aligned(16))) unsigned char lds_raw[];
    Frame F;
    F.lds = (LAS unsigned char*)lds_raw;
    int wave_s = __builtin_amdgcn_readfirstlane((int)threadIdx.x >> 6); asm volatile("" : "+s"(wave_s));
    F.tid = threadIdx.x; F.lane = F.tid & 63; F.wave = wave_s;
    F.G = gridDim.x; { const int bx = blockIdx.x; F.vcu = (F.G % 8 == 0) ? (bx % 8) * (F.G / 8) + bx / 8 : bx; }
    volatile LAS unsigned* misc = (volatile LAS unsigned*)(F.lds + LDS_MISC);
    if (F.tid < 64) misc[F.tid] = 0u;
    __syncthreads();
    (void)xcd_barrier_post((unsigned*)(args.ws + WS_CTL), misc + 8);
    float* fo; KArgsP ap;
#define KARGS() ({ KArgsP q_ = (KArgsP)__builtin_amdgcn_kernarg_segment_ptr(); asm volatile("" : "+s"(q_)); q_; })
#define IN(k) ({ KArgsP q2_ = KARGS(); q2_->ph_lo <= (k) && (k) < q2_->ph_hi; })
#define PHASE_BEGIN() do { asm volatile("; PHASE_MARK %0" :: "i"(__LINE__)); ap = KARGS(); F.G = gridDim.x; \
        { int w_ = wave_s; asm volatile("" : "+s"(w_)); int t_ = (w_ << 6) | (int)__builtin_amdgcn_mbcnt_hi(~0u, __builtin_amdgcn_mbcnt_lo(~0u, 0u)); asm volatile("" : "+v"(t_)); F.tid = t_; F.lane = t_ & 63; F.wave = w_; } F.ws = ap->ws; int bx_ = (int)blockIdx.x; asm volatile("" : "+s"(bx_)); F.bx = bx_; F.vcu = (F.G % 8 == 0) ? (bx_ % 8) * (F.G / 8) + bx_ / 8 : bx_; fo = ap->out; } while (0)
#define INP(i) (ap->in[i])
#define SEAM(k) do { if (IN(k) && IN((k) + 1)) { XcdBarrier b_; b_.bar = (unsigned*)(KARGS()->ws + WS_CTL); b_.x = xb_xcc_id(); b_.st = (volatile LAS unsigned*)(F.lds + LDS_MISC) + 8; xcd_barrier(b_); } } while (0)

    if (IN(PH_PRO)) { PHASE_BEGIN(); p_prologue(F, ap); }
#ifdef MK_PRO_TWICE
    if (IN(PH_PRO)) { PHASE_BEGIN(); p_prologue(F, ap); }
#endif
    SEAM(PH_PRO);

    { constexpr int l = 0;
        const int pb = PH_L0 + PH_PER_L * l;
#define WB (F.ws + WS_W + (size_t)l * WS_WL)
#define MOD ((const float*)(F.ws + WS_MOD) + (size_t)l * NB * 6 * D)
#define XB ((bf16*)(F.ws + WS_XB))
#define XIN ((l == 0) ? (const void*)INP(0) : (const void*)XB)
#define H ((bf16*)(F.ws + WS_H))
#define Z ((bf16*)(F.ws + WS_Z))
#define OB ((bf16*)(F.ws + WS_O))
#define U ((bf16*)(F.ws + WS_U))

        if (IN(pb + PO_NORM1) && !((KARGS()->skip >> PO_NORM1) & 1)) { PHASE_BEGIN(); p_norm<0, (l != 0)>(F, XIN, INP(2) + l * D, MOD, MOD + D, H, nullptr); }
        SEAM(pb + PO_NORM1);

        if (IN(pb + PO_ZG) && !((KARGS()->skip >> PO_ZG) & 1)) { PHASE_BEGIN();
            pg8::Gemm g{H, (const bf16*)(WB + W_IN), M, ZLD, D, D}; pg8::StaticOrder S; S.init(M, ZLD, F.G, F.bx);
            pg8::EpiBf16<0> E{Z, ZLD, nullptr, 0, 0, 1.f};
            pg8::gemm_phase<pg8::EpiBf16<0>, pg8::StaticOrder, true, true>(F.lds, g, S, E, F.tid);
        }
        SEAM(pb + PO_ZG);

        if (IN(pb + PO_PREP) && !((KARGS()->skip >> PO_PREP) & 1)) { PHASE_BEGIN(); p_prep(F, l); }
        SEAM(pb + PO_PREP);

        if (IN(pb + PO_UP) && !((KARGS()->skip >> PO_UP) & 1)) { PHASE_BEGIN();
            { pg8::Gemm g{Z + ZB_CQ, (const bf16*)(WB + W_UQ), M, 512, 256, ZLD}; pg8::StaticOrder S; S.init(M, 512, F.G, F.bx);
              pg8::EpiBf16<0> E{(bf16*)(F.ws + WS_QM), 512, nullptr, 0, 0, 1.f};
              pg8::gemm_phase<pg8::EpiBf16<0>, pg8::StaticOrder, true, true>(F.lds, g, S, E, F.tid); }
            PHASE_BEGIN();
            { pg8::Gemm g{Z + ZB_CKV, (const bf16*)(WB + W_UKV), M, 512, 256, ZLD}; pg8::StaticOrder S; S.init(M, 512, F.G, F.bx);
              pg8::EpiMlaKV E{(bf16*)(F.ws + WS_KM), (bf16*)(F.ws + WS_VM), (const float*)(F.ws + WS_RSKV)};
              pg8::gemm_phase<pg8::EpiMlaKV, pg8::StaticOrder, true, false>(F.lds, g, S, E, F.tid); }
            PHASE_BEGIN();
            p_compress(F, l);
        }
        SEAM(pb + PO_UP);

        if (IN(pb + PO_ATTN) && !((KARGS()->skip >> PO_ATTN) & 1)) { PHASE_BEGIN(); p_attn(F, INP(8) + l * 4, (ap->skip >> 16) | ((ap->rep >> 20) << 8)); }
        SEAM(pb + PO_ATTN);

        if (IN(pb + PO_OG) && !((KARGS()->skip >> PO_OG) & 1)) { PHASE_BEGIN();
            pg8::Gemm g{OB, (const bf16*)(WB + W_OUT), M, D, D, D}; pg8::StaticOrder S; S.init(M, D, F.G, F.bx);
            pg8::EpiResid<(l != 0)> E{XIN, XB, MOD + 2 * D};
            pg8::gemm_phase<pg8::EpiResid<(l != 0)>, pg8::StaticOrder, true, true>(F.lds, g, S, E, F.tid);
        }
        SEAM(pb + PO_OG);

        if (IN(pb + PO_NORM2) && !((KARGS()->skip >> PO_NORM2) & 1)) { PHASE_BEGIN(); p_norm<0, true>(F, XB, INP(3) + l * D, MOD + 3 * D, MOD + 4 * D, H, nullptr); }
        SEAM(pb + PO_NORM2);

        if (IN(pb + PO_UPG) && !((KARGS()->skip >> PO_UPG) & 1)) { PHASE_BEGIN();
            pg8::Gemm g{H, (const bf16*)(WB + W_UP), M, DFF, D, D}; pg8::StaticOrder S; S.init(M, DFF, F.G, F.bx);
            pg8::EpiRelu2 E{U, DFF};
            pg8::gemm_phase<pg8::EpiRelu2, pg8::StaticOrder, true, true>(F.lds, g, S, E, F.tid);
        }
        SEAM(pb + PO_UPG);

        if (IN(pb + PO_DNG) && !((KARGS()->skip >> PO_DNG) & 1)) { PHASE_BEGIN();
            pg8::Gemm g{U, (const bf16*)(WB + W_DN), M, D, DFF, DFF}; pg8::StaticOrder S; S.init(M, D, F.G, F.bx);
            pg8::EpiResid<true> E{XB, XB, MOD + 5 * D};
            pg8::gemm_phase<pg8::EpiResid<true>, pg8::StaticOrder, true, true>(F.lds, g, S, E, F.tid);
        }
        SEAM(pb + PO_DNG);
    }
    { constexpr int l = 1;
        const int pb = PH_L0 + PH_PER_L * l;
#define WB (F.ws + WS_W + (size_t)l * WS_WL)
#define MOD ((const float*)(F.ws + WS_MOD) + (size_t)l * NB * 6 * D)
#define XB ((bf16*)(F.ws + WS_XB))
#define XIN ((l == 0) ? (const void*)INP(0) : (const void*)XB)
#define H ((bf16*)(F.ws + WS_H))
#define Z ((bf16*)(F.ws + WS_Z))
#define OB ((bf16*)(F.ws + WS_O))
#define U ((bf16*)(F.ws + WS_U))

        if (IN(pb + PO_NORM1) && !((KARGS()->skip >> PO_NORM1) & 1)) { PHASE_BEGIN(); p_norm<0, (l != 0)>(F, XIN, INP(2) + l * D, MOD, MOD + D, H, nullptr); }
        SEAM(pb + PO_NORM1);

        if (IN(pb + PO_ZG) && !((KARGS()->skip >> PO_ZG) & 1)) { PHASE_BEGIN();
            pg8::Gemm g{H, (const bf16*)(WB + W_IN), M, ZLD, D, D}; pg8::StaticOrder S; S.init(M, ZLD, F.G, F.bx);
            pg8::EpiBf16<0> E{Z, ZLD, nullptr, 0, 0, 1.f};
            pg8::gemm_phase<pg8::EpiBf16<0>, pg8::StaticOrder, true, true>(F.lds, g, S, E, F.tid);
        }
        SEAM(pb + PO_ZG);

        if (IN(pb + PO_PREP) && !((KARGS()->skip >> PO_PREP) & 1)) { PHASE_BEGIN(); p_prep(F, l); }
        SEAM(pb + PO_PREP);

        if (IN(pb + PO_UP) && !((KARGS()->skip >> PO_UP) & 1)) { PHASE_BEGIN();
            { pg8::Gemm g{Z + ZB_CQ, (const bf16*)(WB + W_UQ), M, 512, 256, ZLD}; pg8::StaticOrder S; S.init(M, 512, F.G, F.bx);
              pg8::EpiBf16<0> E{(bf16*)(F.ws + WS_QM), 512, nullptr, 0, 0, 1.f};
              pg8::gemm_phase<pg8::EpiBf16<0>, pg8::StaticOrder, true, true>(F.lds, g, S, E, F.tid); }
            PHASE_BEGIN();
            { pg8::Gemm g{Z + ZB_CKV, (const bf16*)(WB + W_UKV), M, 512, 256, ZLD}; pg8::StaticOrder S; S.init(M, 512, F.G, F.bx);
              pg8::EpiMlaKV E{(bf16*)(F.ws + WS_KM), (bf16*)(F.ws + WS_VM), (const float*)(F.ws + WS_RSKV)};
              pg8::gemm_phase<pg8::EpiMlaKV, pg8::StaticOrder, true, false>(F.lds, g, S, E, F.tid); }
            PHASE_BEGIN();
            p_compress(F, l);
        }
        SEAM(pb + PO_UP);

        if (IN(pb + PO_ATTN) && !((KARGS()->skip >> PO_ATTN) & 1)) { PHASE_BEGIN(); p_attn(F, INP(8) + l * 4, (ap->skip >> 16) | ((ap->rep >> 20) << 8)); }
        SEAM(pb + PO_ATTN);

        if (IN(pb + PO_OG) && !((KARGS()->skip >> PO_OG) & 1)) { PHASE_BEGIN();
            pg8::Gemm g{OB, (const bf16*)(WB + W_OUT), M, D, D, D}; pg8::StaticOrder S; S.init(M, D, F.G, F.bx);
            pg8::EpiResid<(l != 0)> E{XIN, XB, MOD + 2 * D};
            pg8::gemm_phase<pg8::EpiResid<(l != 0)>, pg8::StaticOrder, true, true>(F.lds, g, S, E, F.tid);
        }
        SEAM(pb + PO_OG);

        if (IN(pb + PO_NORM2) && !((KARGS()->skip >> PO_NORM2) & 1)) { PHASE_BEGIN(); p_norm<0, true>(F, XB, INP(3) + l * D, MOD + 3 * D, MOD + 4 * D, H, nullptr); }
        SEAM(pb + PO_NORM2);

        if (IN(pb + PO_UPG) && !((KARGS()->skip >> PO_UPG) & 1)) { PHASE_BEGIN();
            pg8::Gemm g{H, (const bf16*)(WB + W_UP), M, DFF, D, D}; pg8::StaticOrder S; S.init(M, DFF, F.G, F.bx);
            pg8::EpiRelu2 E{U, DFF};
            pg8::gemm_phase<pg8::EpiRelu2, pg8::StaticOrder, true, true>(F.lds, g, S, E, F.tid);
        }
        SEAM(pb + PO_UPG);

        if (IN(pb + PO_DNG) && !((KARGS()->skip >> PO_DNG) & 1)) { PHASE_BEGIN();
            pg8::Gemm g{U, (const bf16*)(WB + W_DN), M, D, DFF, DFF}; pg8::StaticOrder S; S.init(M, D, F.G, F.bx);
            pg8::EpiResid<true> E{XB, XB, MOD + 5 * D};
            pg8::gemm_phase<pg8::EpiResid<true>, pg8::StaticOrder, true, true>(F.lds, g, S, E, F.tid);
        }
        SEAM(pb + PO_DNG);
    }
    if (IN(PH_FIN)) { PHASE_BEGIN(); p_norm<1, true>(F, (const void*)(F.ws + WS_XB), INP(21), nullptr, nullptr, nullptr, fo); }
#undef IN
#undef SEAM
}
}
extern "C" void kernel_launch(void* const* d_in, const int* in_sizes, int n_in, void* d_out, int out_size, void* d_ws, size_t ws_size, hipStream_t stream) {
    using namespace mk;
    static int grid = 0;
    if (grid == 0) {
        int dev = 0, cus = 0;
        if (hipGetDevice(&dev) != hipSuccess || hipDeviceGetAttribute(&cus, hipDeviceAttributeMultiprocessorCount, dev) != hipSuccess) { grid = -1; return; }
        if (hipFuncSetAttribute((const void*)mega, hipFuncAttributeMaxDynamicSharedMemorySize, LDS_BYTES) != hipSuccess) { grid = -1; return; }
        (void)hipGetLastError();
        grid = cus;
    }
    if (grid < 0) return;
    (void)in_sizes; (void)n_in; (void)out_size; (void)ws_size;
    Args a{};
    for (int i = 0; i < 22; ++i) a.in[i] = (const float*)d_in[i];
    a.out = (float*)d_out; a.ws = (unsigned char*)d_ws; a.skip = 0; a.rep = MK_REP;
    auto launch = [&](int lo, int hi) {
        (void)hipMemsetAsync((char*)d_ws + WS_CTL, 0, CTL_ZERO_BYTES, stream);
        a.ph_lo = lo; a.ph_hi = hi;
        hipLaunchKernelGGL(mega, dim3(grid), dim3(NTHR), LDS_BYTES, stream, a);
    };
    launch(0, PH_END);
}
```

```cpp
#include <hip/hip_runtime.h>
#include <cstdio>
#include <cstdint>
#include <math.h>
#define MK_PQ 500.0
#define FA_EXP 2
#define FA_PROBE 0
#define MK_PROBE_IDX 0
#define FA_KO 0
#define MK_MODE 0
#define MK_NAIVE_MASK 0
#define MK_SKIP 0
#define MK_SPLIT 0
#define MK_DBG_PHASE 0
#define MK_DBG_TEST 0
#define MK_REP 0
namespace pg8 {
#define PG8_LAS __attribute__((address_space(3)))
typedef unsigned short bf16_t;
typedef short bf16x8 __attribute__((ext_vector_type(8)));
typedef float f32x4 __attribute__((ext_vector_type(4)));
typedef unsigned u32x4 __attribute__((ext_vector_type(4)));
constexpr int BM = 256, BK = 64, HALF = 128, HTB = HALF * BK * 2  , STAGE_BYTES = 8 * HTB, NXCD = 8, WGM = 8;

__host__ __device__ __forceinline__ int lds_byte(int r, int c) { const int st = (r >> 4) * 2 + (c >> 5), rr = r & 15, cc = c & 31, ob = rr * 64 + cc * 2; return st * 1024 + (ob ^ (((ob >> 9) & 1) << 5)); }
__host__ __device__ __forceinline__ void stage_rc(int b, int& R, int& C) { const int st = b / 1024, sb = b % 1024, swz = sb ^ (((sb >> 9) & 1) << 5); R = (st >> 1) * 16 + swz / 64; C = (st & 1) * 32 + (swz % 64) / 2; }
__host__ __device__ __forceinline__ int perm32(int rho) { const int n = rho >> 4, i = rho & 15; return 8 * (i >> 2) + 4 * n + (i & 3); }

struct Unit { int pm, pn; };
struct Gemm { const bf16_t* A; const bf16_t* Bt; int M, N, K, lda; };

struct StaticOrder {
    int nM, nN, nwg, G, c;
    __host__ __device__ void init(int M, int N, int G_, int c_) { nM = M / BM; nN = N / BM; nwg = nM * nN; G = G_; c = c_; }
    __host__ __device__ bool next(int i, Unit& u) const {
        const long L = (long)i * G + c; if (L >= nwg) return false;
        int wgid = (int)L; { const int q = nwg / NXCD, r = nwg % NXCD, xcd = wgid % NXCD, off = wgid / NXCD; wgid = (xcd < r ? xcd * (q + 1) : r * (q + 1) + (xcd - r) * q) + off; }
        const int nig = WGM * nN, gid = wgid / nig, fm = gid * WGM, gsz = (nM - fm) < WGM ? (nM - fm) : WGM;
        u.pm = fm + ((wgid % nig) % gsz); u.pn = (wgid % nig) / gsz; return true;
    }
    __device__ __forceinline__ void a_ready(const Unit&) const {}
    __device__ __forceinline__ void done(const Unit&) const {}
};
__device__ __forceinline__ unsigned cvt_pk_bf16(float lo, float hi) { unsigned r; asm volatile("v_cvt_pk_bf16_f32 %0, %1, %2" : "=v"(r) : "v"(lo), "v"(hi)); return r; }
typedef float f32x2 __attribute__((ext_vector_type(2)));
__device__ __forceinline__ f32x2 gelu_pk(f32x2 v) {
    const f32x2 av = __builtin_elementwise_abs(v), d = av * 0.2316418882f + 1.0f;
    f32x2 t; t.x = __builtin_amdgcn_rcpf(d.x); t.y = __builtin_amdgcn_rcpf(d.y);
    f32x2 q = t * 0.5307027145f + (-0.7265760135f); q = q * t + 0.7107068705f; q = q * t + (-0.142248368f); q = q * t + 0.127414796f; q = q * t;
    const f32x2 s = (v * v) * (-0.72134752044f);
    f32x2 e; e.x = __builtin_amdgcn_exp2f(s.x); e.y = __builtin_amdgcn_exp2f(s.y);
    const f32x2 m = v * (q * e), r = v - m;
    f32x2 o; o.x = v.x < 0.f ? m.x : r.x; o.y = v.y < 0.f ? m.y : r.y; return o;
}

template <int ACT  > struct EpiBf16 {
    static constexpr bool PERM = true, AFTER_DRAIN = false; static_assert(ACT == 0 || ACT == 1, "EpiBf16: ACT is 0 (none) or 1 (gelu_pk)");
    bf16_t* O; int ldc; const float* bias; int split_cols; size_t split_stride; float scale0;
    __device__ __forceinline__ void operator()(const f32x4 (&acc)[2][2][4][2], const Unit& u, int wr, int wc, int fr, int fq) const {
        const int row0 = u.pm * BM + wr * 64 + fr; int colt = u.pn * BM; bf16_t* base = O;
        float sc = 1.f; if (split_cols) { const int t = colt / split_cols; base += (size_t)t * split_stride; colt -= t * split_cols; if (t == 0) sc = scale0; }
        const int col0 = colt + wc * 32 + 8 * fq, bcol0 = u.pn * BM + wc * 32 + 8 * fq;
        f32x4 bv[2][2];
#pragma unroll
        for (int bj = 0; bj < 2; ++bj)
#pragma unroll
            for (int n = 0; n < 2; ++n) bv[bj][n] = bias ? *(const f32x4*)(bias + bcol0 + bj * HALF + 4 * n) : (f32x4){0.f, 0.f, 0.f, 0.f};
#pragma unroll
        for (int ai = 0; ai < 2; ++ai)
#pragma unroll
            for (int m = 0; m < 4; ++m) { bf16_t* rowp = base + (size_t)(row0 + ai * HALF + m * 16) * ldc + col0;
#pragma unroll
                for (int bj = 0; bj < 2; ++bj) { f32x4 v0 = acc[ai][bj][m][0] + bv[bj][0], v1 = acc[ai][bj][m][1] + bv[bj][1];
                    if (ACT == 1) { f32x2 a = gelu_pk((f32x2){v0[0], v0[1]}), b = gelu_pk((f32x2){v0[2], v0[3]}), c = gelu_pk((f32x2){v1[0], v1[1]}), d = gelu_pk((f32x2){v1[2], v1[3]});
                        v0 = (f32x4){a.x, a.y, b.x, b.y}; v1 = (f32x4){c.x, c.y, d.x, d.y}; }
                    v0 = v0 * sc; v1 = v1 * sc; u32x4 w; w.x = cvt_pk_bf16(v0[0], v0[1]); w.y = cvt_pk_bf16(v0[2], v0[3]); w.z = cvt_pk_bf16(v1[0], v1[1]); w.w = cvt_pk_bf16(v1[2], v1[3]);
                    *(u32x4*)(rowp + bj * HALF) = w; } }
    }
};
template <class Epi, class Sched, bool ALIGN_EPI = false, bool SP2 = false>
__device__ __forceinline__ void gemm_phase(PG8_LAS unsigned char* lds, const Gemm g, const Sched& S, const Epi& E, int tid_in) {
    int tid_ = tid_in; asm volatile("" : "+v"(tid_));
    const int tid = tid_, wid = __builtin_amdgcn_readfirstlane(tid >> 6), lane = tid & 63, wr = wid >> 2, wc = wid & 3, fr = lane & 15, fq = lane >> 4;
    const int K = g.K, nt = K / BK;
    unsigned voffA[2], voffB[2];
#pragma unroll
    for (int i = 0; i < 2; ++i) { int R, C; stage_rc(tid * 16 + i * 8192, R, C); const int Rb = Epi::PERM ? ((R & ~31) + perm32(R & 31)) : R;
        voffA[i] = (unsigned)(R * g.lda + C) * 2u; voffB[i] = (unsigned)(Rb * K + C) * 2u; }
    const size_t kstep = (size_t)(BK * 2);
    const size_t hstep = (size_t)HALF * K * 2;
    const size_t tstep = 2 * hstep; const size_t hstepA = (size_t)HALF * g.lda * 2, tstepA = 2 * hstepA;
    const unsigned ldsw = (unsigned)wid * 1024u;
    const int aoff = lds_byte(wr * 64 + fr, fq * 8), boff = lds_byte(wc * 32 + fr, fq * 8);
#define PG8_SA(b, h) (((b) * 2 + (h)) * HTB)
#define PG8_SB(b, h) ((4 + (b) * 2 + (h)) * HTB)
#define PG8_STAGE(bufoff, gbase, voff) do { _Pragma("unroll") for (int _i = 0; _i < 2; ++_i) \
        __builtin_amdgcn_global_load_lds((const unsigned*)((const char*)(gbase) + (voff)[_i]), (PG8_LAS unsigned*)(lds + (bufoff) + ldsw + _i * 8192), 16, 0, 0); } while (0)
#define PG8_LDA(dst, b, h) do { _Pragma("unroll") for (int m = 0; m < 4; ++m) _Pragma("unroll") for (int k = 0; k < 2; ++k) dst[m][k] = *(const PG8_LAS bf16x8*)(lds + PG8_SA(b, h) + aoff + m * 2048 + k * 1024); } while (0)
#define PG8_LDB(dst, b, h) do { _Pragma("unroll") for (int n = 0; n < 2; ++n) _Pragma("unroll") for (int k = 0; k < 2; ++k) dst[n][k] = *(const PG8_LAS bf16x8*)(lds + PG8_SB(b, h) + boff + n * 2048 + k * 1024); } while (0)
#define PG8_MMA(ai, bj, At, Bt) do { __builtin_amdgcn_s_setprio(1); _Pragma("unroll") for (int m = 0; m < 4; ++m) _Pragma("unroll") for (int n = 0; n < 2; ++n) _Pragma("unroll") for (int k = 0; k < 2; ++k) \
        acc[ai][bj][m][n] = __builtin_amdgcn_mfma_f32_16x16x32_bf16(Bt[n][k], At[m][k], acc[ai][bj][m][n], 0, 0, 0); __builtin_amdgcn_s_setprio(0); } while (0)
#define PG8_WAIT_V(n) asm volatile("s_waitcnt vmcnt(" #n ")" ::: "memory")
#define PG8_WAIT_L(n) asm volatile("s_waitcnt lgkmcnt(" #n ")" ::: "memory")
#define PG8_BAR __builtin_amdgcn_s_barrier()
#define PG8_SCHED __builtin_amdgcn_sched_barrier(0)
    Unit cur, nxt; int ui = 0;
    if (!S.next(0, cur)) return;
    f32x4 acc[2][2][4][2];
#pragma unroll
    for (int a = 0; a < 2; ++a)
#pragma unroll
        for (int b = 0; b < 2; ++b)
#pragma unroll
            for (int m = 0; m < 4; ++m)
#pragma unroll
                for (int n = 0; n < 2; ++n) acc[a][b][m][n] = (f32x4){0.f, 0.f, 0.f, 0.f};
    bf16x8 At[4][2], B0[2][2], B1[2][2];
    const char* cA = (const char*)g.A + (size_t)cur.pm * tstepA; const char* cB = (const char*)g.Bt + (size_t)cur.pn * tstep;
    S.a_ready(cur);
    if constexpr (SP2) {
        PG8_STAGE(PG8_SB(0, 0), cB, voffB); PG8_STAGE(PG8_SB(0, 1), cB + hstep, voffB); PG8_STAGE(PG8_SA(0, 0), cA, voffA); PG8_STAGE(PG8_SA(0, 1), cA + hstepA, voffA);
        if (wr == 1) PG8_BAR;
        PG8_WAIT_V(2); PG8_BAR;
        PG8_STAGE(PG8_SB(1, 0), cB + kstep, voffB); PG8_STAGE(PG8_SA(1, 0), cA + kstep, voffA); PG8_STAGE(PG8_SB(1, 1), cB + hstep + kstep, voffB);
        PG8_WAIT_V(6); PG8_BAR;
    } else {
        PG8_STAGE(PG8_SB(0, 0), cB, voffB); PG8_STAGE(PG8_SA(0, 0), cA, voffA); PG8_STAGE(PG8_SB(0, 1), cB + hstep, voffB); PG8_STAGE(PG8_SA(0, 1), cA + hstepA, voffA);
        if (wr == 1) PG8_BAR;
        PG8_WAIT_V(4); PG8_BAR;
        PG8_STAGE(PG8_SB(1, 0), cB + kstep, voffB); PG8_STAGE(PG8_SA(1, 0), cA + kstep, voffA); PG8_STAGE(PG8_SB(1, 1), cB + hstep + kstep, voffB);
        PG8_WAIT_V(6); PG8_BAR;
    }
    for (;;) {
        const bool has_next = S.next(ui + 1, nxt);
        const char* nA = has_next ? (const char*)g.A + (size_t)nxt.pm * tstepA : cA; const char* nB = has_next ? (const char*)g.Bt + (size_t)nxt.pn * tstep : cB;
        for (int t = 0; t < nt; t += 2) {
            const bool last = (t == nt - 2);
            const char* a1 = cA + (size_t)(t + 1) * kstep;
            const char* a2 = last ? nA : cA + (size_t)(t + 2) * kstep; const char* b2 = last ? nB : cB + (size_t)(t + 2) * kstep;
            const char* a3 = a2 + kstep; const char* b3 = b2 + kstep;
            if (last && has_next) S.a_ready(nxt);
            if constexpr (SP2) {
            PG8_LDB(B0, 0, 0); PG8_LDB(B1, 0, 1); PG8_SCHED; PG8_LDA(At, 0, 0); PG8_STAGE(PG8_SA(1, 1), a1 + hstepA, voffA);
            PG8_WAIT_V(8); PG8_WAIT_L(0); PG8_BAR; PG8_MMA(0, 0, At, B0); PG8_MMA(0, 1, At, B1); PG8_BAR; PG8_SCHED;
            PG8_LDA(At, 0, 1); PG8_STAGE(PG8_SB(0, 0), b2, voffB); PG8_STAGE(PG8_SB(0, 1), b2 + hstep, voffB); PG8_STAGE(PG8_SA(0, 0), a2, voffA);
            PG8_WAIT_V(8); PG8_WAIT_L(0); PG8_BAR; PG8_MMA(1, 0, At, B0); PG8_MMA(1, 1, At, B1); PG8_BAR; PG8_SCHED;
            PG8_LDB(B0, 1, 0); PG8_LDB(B1, 1, 1); PG8_SCHED; PG8_LDA(At, 1, 0); PG8_STAGE(PG8_SA(0, 1), a2 + hstepA, voffA);
            PG8_WAIT_V(8); PG8_WAIT_L(0); PG8_BAR; PG8_MMA(0, 0, At, B0); PG8_MMA(0, 1, At, B1); PG8_BAR; PG8_SCHED;
            PG8_LDA(At, 1, 1); PG8_STAGE(PG8_SB(1, 0), b3, voffB); PG8_STAGE(PG8_SB(1, 1), b3 + hstep, voffB); PG8_STAGE(PG8_SA(1, 0), a3, voffA);
            PG8_WAIT_V(8); PG8_WAIT_L(0); PG8_BAR; PG8_MMA(1, 0, At, B0); PG8_MMA(1, 1, At, B1); PG8_BAR; PG8_SCHED;
            } else {
            PG8_LDB(B0, 0, 0); PG8_SCHED; PG8_LDA(At, 0, 0); PG8_STAGE(PG8_SA(1, 1), a1 + hstepA, voffA);
            PG8_WAIT_L(8); PG8_BAR; PG8_WAIT_L(0); PG8_MMA(0, 0, At, B0); PG8_BAR; PG8_SCHED;
            PG8_LDB(B1, 0, 1); PG8_STAGE(PG8_SB(0, 0), b2, voffB);
            PG8_BAR; PG8_WAIT_L(0); PG8_MMA(0, 1, At, B1); PG8_BAR;
            PG8_LDA(At, 0, 1); PG8_STAGE(PG8_SA(0, 0), a2, voffA);
            PG8_BAR; PG8_WAIT_L(0); PG8_MMA(1, 0, At, B0); PG8_BAR; PG8_SCHED;
            PG8_STAGE(PG8_SB(0, 1), b2 + hstep, voffB);
            PG8_WAIT_V(6); PG8_BAR; PG8_MMA(1, 1, At, B1); PG8_BAR;
            PG8_LDB(B0, 1, 0); PG8_SCHED; PG8_LDA(At, 1, 0); PG8_STAGE(PG8_SA(0, 1), a2 + hstepA, voffA);
            PG8_WAIT_L(8); PG8_BAR; PG8_WAIT_L(0); PG8_MMA(0, 0, At, B0); PG8_BAR; PG8_SCHED;
            PG8_LDB(B1, 1, 1); PG8_STAGE(PG8_SB(1, 0), b3, voffB);
            PG8_BAR; PG8_WAIT_L(0); PG8_MMA(0, 1, At, B1); PG8_BAR;
            PG8_LDA(At, 1, 1); PG8_STAGE(PG8_SA(1, 0), a3, voffA);
            PG8_BAR; PG8_WAIT_L(0); PG8_MMA(1, 0, At, B0); PG8_BAR; PG8_SCHED;
            PG8_STAGE(PG8_SB(1, 1), b3 + hstep, voffB);
            PG8_WAIT_V(6); PG8_BAR; PG8_MMA(1, 1, At, B1); PG8_BAR;
            }
        }
        if constexpr (ALIGN_EPI) { if (wr == 0) PG8_BAR; }
        if constexpr (!Epi::AFTER_DRAIN) { E(acc, cur, wr, wc, fr, fq); S.done(cur); }
        if (!has_next) break;
#pragma unroll
        for (int a = 0; a < 2; ++a)
#pragma unroll
            for (int b = 0; b < 2; ++b)
#pragma unroll
                for (int m = 0; m < 4; ++m)
#pragma unroll
                    for (int n = 0; n < 2; ++n) acc[a][b][m][n] = (f32x4){0.f, 0.f, 0.f, 0.f};
        cur = nxt; cA = nA; cB = nB; ++ui;
        if constexpr (ALIGN_EPI) { if (wr == 1) PG8_BAR; }
    }
    PG8_WAIT_V(0);
    if constexpr (!ALIGN_EPI) { if (wr == 0) PG8_BAR; }
    PG8_BAR;
    if constexpr (Epi::AFTER_DRAIN) { E.fused(acc, cur, wr, wc, fr, fq, lds, wid, lane); S.done(cur); }
#undef PG8_SA
#undef PG8_SB
#undef PG8_STAGE
#undef PG8_LDA
#undef PG8_LDB
#undef PG8_MMA
#undef PG8_WAIT_V
#undef PG8_WAIT_L
#undef PG8_BAR
#undef PG8_SCHED
}
}
namespace pg8 {
template <class T> __device__ __forceinline__ T* uni_ptr(T* p) {
    const unsigned long long v = (unsigned long long)p; unsigned lo = __builtin_amdgcn_readfirstlane((unsigned)v), hi = __builtin_amdgcn_readfirstlane((unsigned)(v >> 32)); asm volatile("" : "+s"(lo), "+s"(hi)); return (T*)(((unsigned long long)hi << 32) | lo); }
template <bool XB16> struct EpiResid {
    static constexpr bool PERM = true, AFTER_DRAIN = false;
    const void* xin_; bf16_t* out_; const float* gate_;
    __device__ __forceinline__ void operator()(const f32x4 (&acc)[2][2][4][2], const Unit& u, int wr, int wc, int fr, int fq) const {
        const void* xin = uni_ptr(xin_); bf16_t* out = uni_ptr(out_); const float* gate = uni_ptr(gate_);
        const int row0 = u.pm * BM + wr * 64 + fr, col0 = u.pn * BM + wc * 32 + 8 * fq;
        const float* gp = gate + (size_t)(u.pm >> 5) * 6144 + col0;
        f32x4 gv[2][2];
#pragma unroll
        for (int bj = 0; bj < 2; ++bj)
#pragma unroll
            for (int n = 0; n < 2; ++n) gv[bj][n] = *(const f32x4*)(gp + bj * HALF + 4 * n);
#pragma unroll
        for (int ai = 0; ai < 2; ++ai)
#pragma unroll
            for (int m = 0; m < 4; ++m) { const size_t off = (size_t)(row0 + ai * HALF + m * 16) * 1024 + col0;
#pragma unroll
                for (int bj = 0; bj < 2; ++bj) { f32x4 x0, x1;
                    if (XB16) { const u32x4 xr = *(const u32x4*)((const bf16_t*)xin + off + bj * HALF);
                        x0 = (f32x4){__uint_as_float(xr.x << 16), __uint_as_float(xr.x & 0xffff0000u), __uint_as_float(xr.y << 16), __uint_as_float(xr.y & 0xffff0000u)};
                        x1 = (f32x4){__uint_as_float(xr.z << 16), __uint_as_float(xr.z & 0xffff0000u), __uint_as_float(xr.w << 16), __uint_as_float(xr.w & 0xffff0000u)}; }
                    else { x0 = *(const f32x4*)((const float*)xin + off + bj * HALF); x1 = *(const f32x4*)((const float*)xin + off + bj * HALF + 4); }
                    const f32x4 y0 = x0 + gv[bj][0] * acc[ai][bj][m][0], y1 = x1 + gv[bj][1] * acc[ai][bj][m][1];
                    u32x4 w; w.x = cvt_pk_bf16(y0[0], y0[1]); w.y = cvt_pk_bf16(y0[2], y0[3]); w.z = cvt_pk_bf16(y1[0], y1[1]); w.w = cvt_pk_bf16(y1[2], y1[3]);
                    *(u32x4*)(out + off + bj * HALF) = w; }
                if (m & 1) asm volatile("" ::: "memory"); }
    }
};
struct EpiRelu2 {
    static constexpr bool PERM = true, AFTER_DRAIN = false;
    bf16_t* O_; int ldc;
    __device__ __forceinline__ void operator()(const f32x4 (&acc)[2][2][4][2], const Unit& u, int wr, int wc, int fr, int fq) const {
        bf16_t* O = uni_ptr(O_);
        const int row0 = u.pm * BM + wr * 64 + fr, col0 = u.pn * BM + wc * 32 + 8 * fq;
#pragma unroll
        for (int ai = 0; ai < 2; ++ai)
#pragma unroll
            for (int m = 0; m < 4; ++m) { bf16_t* rowp = O + (size_t)(row0 + ai * HALF + m * 16) * ldc + col0;
#pragma unroll
                for (int bj = 0; bj < 2; ++bj) { f32x4 v0 = acc[ai][bj][m][0], v1 = acc[ai][bj][m][1];
                    v0 = __builtin_elementwise_max(v0, (f32x4){0.f, 0.f, 0.f, 0.f}); v1 = __builtin_elementwise_max(v1, (f32x4){0.f, 0.f, 0.f, 0.f}); v0 = v0 * v0; v1 = v1 * v1;
                    u32x4 w; w.x = cvt_pk_bf16(v0[0], v0[1]); w.y = cvt_pk_bf16(v0[2], v0[3]); w.z = cvt_pk_bf16(v1[0], v1[1]); w.w = cvt_pk_bf16(v1[2], v1[3]);
                    *(u32x4*)(rowp + bj * HALF) = w; } }
    }
};
struct EpiMlaQ {
    static constexpr bool PERM = true, AFTER_DRAIN = false;
    bf16_t* QM_;
    __device__ __forceinline__ void operator()(const f32x4 (&acc)[2][2][4][2], const Unit& u, int wr, int wc, int fr, int fq) const {
        bf16_t* QM = uni_ptr(QM_);
        const int row0 = u.pm * BM + wr * 64 + fr, cw = wc * 32 + 8 * fq;
        const int nbj = (u.pn != 0) ? 1 : 2;
#pragma unroll
        for (int ai = 0; ai < 2; ++ai)
#pragma unroll
            for (int m = 0; m < 4; ++m) { bf16_t* qr = QM + (size_t)(row0 + ai * HALF + m * 16) * 384 + u.pn * 256 + cw;
#pragma unroll
                for (int bj = 0; bj < 2; ++bj) if (bj < nbj) { const f32x4 v0 = acc[ai][bj][m][0], v1 = acc[ai][bj][m][1];
                    u32x4 o; o.x = cvt_pk_bf16(v0[0], v0[1]); o.y = cvt_pk_bf16(v0[2], v0[3]); o.z = cvt_pk_bf16(v1[0], v1[1]); o.w = cvt_pk_bf16(v1[2], v1[3]);
                    *(u32x4*)(qr + bj * HALF) = o; } }
    }
};
struct EpiMlaKV {
    static constexpr bool PERM = true, AFTER_DRAIN = false;
    bf16_t* KM_; bf16_t* VM_; const float* rskv_;
    __device__ __forceinline__ void operator()(const f32x4 (&acc)[2][2][4][2], const Unit& u, int wr, int wc, int fr, int fq) const {
        bf16_t* KM = uni_ptr(KM_); bf16_t* VM = uni_ptr(VM_); const float* rskv = uni_ptr(rskv_);
        const int row0 = u.pm * BM + wr * 64 + fr, w = wc * 32 + 8 * fq;
        const bool isk = wc < 2;
#pragma unroll
        for (int ai = 0; ai < 2; ++ai)
#pragma unroll
            for (int m = 0; m < 4; ++m) { const int row = row0 + ai * HALF + m * 16; const float rs = rskv[row];
#pragma unroll
                for (int bj = 0; bj < 2; ++bj) { const int head = u.pn * 2 + bj;
                    const f32x4 v0 = acc[ai][bj][m][0] * rs, v1 = acc[ai][bj][m][1] * rs;
                    u32x4 o; o.x = cvt_pk_bf16(v0[0], v0[1]); o.y = cvt_pk_bf16(v0[2], v0[3]); o.z = cvt_pk_bf16(v1[0], v1[1]); o.w = cvt_pk_bf16(v1[2], v1[3]);
                    if (isk) *(u32x4*)(KM + (size_t)row * 384 + head * 96 + w) = o; else *(u32x4*)(VM + (size_t)row * 256 + head * 64 + (w - 64)) = o; }
                asm volatile("" ::: "memory"); }
    }
};
}
#define GAS __attribute__((address_space(1)))
#define LAS __attribute__((address_space(3)))
typedef unsigned short bf16;
typedef unsigned v4u __attribute__((ext_vector_type(4)));
typedef float f32x4 __attribute__((ext_vector_type(4)));
typedef short bf16x8 __attribute__((ext_vector_type(8)));
typedef GAS unsigned gu32;
typedef GAS unsigned long long gu64;
#define RLX_AGENT __ATOMIC_RELAXED, __HIP_MEMORY_SCOPE_AGENT
#define LDS_WAIT() asm volatile("s_waitcnt lgkmcnt(0)" ::: "memory")
#define VM_WAIT() asm volatile("s_waitcnt vmcnt(0)" ::: "memory")
__device__ __forceinline__ unsigned long long rt() { return __builtin_amdgcn_s_memrealtime(); }
__device__ __forceinline__ unsigned f2bf(float f) { unsigned u = __builtin_bit_cast(unsigned, f); return (u + 0x7fffu + ((u >> 16) & 1u)) >> 16; }
__device__ __forceinline__ unsigned pk2(float lo, float hi) { return f2bf(lo) | (f2bf(hi) << 16); }

#define XB_TMO      128
#define XB_XCNT(j)  (256  + 64 * (j))
#define XB_XSUB(j)  (1280 + 64 * (j))
#define XB_XGEN(j)  (2304 + 64 * (j))
#define XB_TOP      3328
#define XB_TOPGEN   3392
#define XCD_BAR_WORDS 3456
#define XB_SPIN_CAP (1u << 18)

__device__ __forceinline__ unsigned xb_ld(unsigned* p)              { return __hip_atomic_load(p, __ATOMIC_RELAXED, __HIP_MEMORY_SCOPE_AGENT); }
__device__ __forceinline__ unsigned xb_add(unsigned* p, unsigned v) { return __hip_atomic_fetch_add(p, v, __ATOMIC_RELAXED, __HIP_MEMORY_SCOPE_AGENT); }
__device__ __forceinline__ unsigned xb_xcc_id() { return (unsigned)__builtin_amdgcn_s_getreg((3 << 11) | 20) & 0xFu; }
#define XB_SPIN(cond, bar) do { unsigned _sp = 0; while (cond) { __builtin_amdgcn_s_sleep(1); \
    if ((++_sp & 255u) == 0u) { if (xb_ld(&(bar)[XB_TMO])) break; if (_sp > XB_SPIN_CAP) { atomicAdd(&(bar)[XB_TMO], 1u); break; } } } } while (0)

struct XcdBarrier {
    unsigned* bar; unsigned x;
    volatile LAS unsigned* st;
};

__device__ __forceinline__ XcdBarrier xcd_barrier_post(unsigned* bar, volatile LAS unsigned* st) {
    XcdBarrier b; b.bar = bar; b.x = xb_xcc_id(); b.st = st;
    if (threadIdx.x == 0) (void)xb_add(&bar[XB_XCNT(b.x)], 1u);
    return b;
}
__device__ __forceinline__ void xcd_barrier_complete(unsigned* bar, unsigned x, unsigned& nloc, unsigned& nx) {
    const unsigned G = gridDim.x * gridDim.y * gridDim.z;
    unsigned sum, cnt, mine, sp = 0u;
    for (;;) {
        sum = 0u; cnt = 0u; mine = 0u;
#pragma unroll
        for (unsigned j = 0; j < 16; ++j) { const unsigned c = xb_ld(&bar[XB_XCNT(j)]); sum += c; cnt += (c > 0u) ? 1u : 0u; mine = (j == x) ? c : mine; }
        if (sum == G) break;
        __builtin_amdgcn_s_sleep(1);
        if ((++sp & 255u) == 0u) { if (xb_ld(&bar[XB_TMO])) break; if (sp > XB_SPIN_CAP) { atomicAdd(&bar[XB_TMO], 1u); break; } }
    }
    nloc = mine > 0u ? mine : 1u; nx = cnt > 0u ? cnt : 1u;
}

__device__ __forceinline__ void xcd_barrier(const XcdBarrier& b) {
    asm volatile("s_waitcnt vmcnt(0)" ::: "memory");
    __syncthreads();
    if (threadIdx.x == 0) {
        unsigned* bar = b.bar;
        __builtin_amdgcn_s_waitcnt(0);
        unsigned nloc = b.st[0], nx = b.st[1];
        if (nloc == 0u) { xcd_barrier_complete(bar, b.x, nloc, nx); b.st[0] = nloc; b.st[1] = nx; }
        const unsigned old = xb_add(&bar[XB_XSUB(b.x)], 1u);
        const unsigned gen = old / nloc;
        if (old + 1u == (gen + 1u) * nloc) {
            __builtin_amdgcn_fence(__ATOMIC_RELEASE, "agent");
            asm volatile("s_waitcnt vmcnt(0)" ::: "memory");
            const unsigned og = xb_add(&bar[XB_TOP], 1u);
            const unsigned tg = og / nx;
            if (og + 1u == (tg + 1u) * nx) xb_add(&bar[XB_TOPGEN], 1u);
            else XB_SPIN(xb_ld(&bar[XB_TOPGEN]) == tg, bar);
            __builtin_amdgcn_fence(__ATOMIC_ACQUIRE, "agent");
            xb_add(&bar[XB_XGEN(b.x)], 1u);
            asm volatile("s_waitcnt vmcnt(0)" ::: "memory");
        } else {
            XB_SPIN(xb_ld(&bar[XB_XGEN(b.x)]) == gen, bar);
            __builtin_amdgcn_fence(__ATOMIC_ACQUIRE, "agent");
            asm volatile("s_waitcnt vmcnt(0)" ::: "memory");
        }
    }
    __syncthreads();
}
#ifndef FA_PROBE
#define FA_PROBE 0
#endif
#ifndef FA_EXP
#define FA_EXP 0
#endif
namespace fa {
typedef unsigned short bf16;
typedef short bf16x8 __attribute__((ext_vector_type(8)));
typedef short s16x4 __attribute__((ext_vector_type(4)));
typedef float f32x16 __attribute__((ext_vector_type(16)));
typedef float f32x4v __attribute__((ext_vector_type(4)));
typedef unsigned u32x4 __attribute__((ext_vector_type(4)));
typedef unsigned u32x2 __attribute__((ext_vector_type(2)));
typedef float f32x2_t __attribute__((ext_vector_type(2)));
typedef __bf16 bf16x2_t __attribute__((ext_vector_type(2)));
#define FLAS __attribute__((address_space(3)))
#define FGAS __attribute__((address_space(1)))
constexpr float MASKV = -1e30f, MINIT = -5e29f, TINYF = 1e-30f, LOG2E = 1.4426950408889634f;
constexpr int OSTR = 144;

__device__ __forceinline__ float ex2(float x) { return __builtin_amdgcn_exp2f(x); }
__device__ __forceinline__ unsigned cvtpk(float lo, float hi) { f32x2_t v = {lo, hi}; bf16x2_t b = __builtin_convertvector(v, bf16x2_t); return __builtin_bit_cast(unsigned, b); }
__device__ __forceinline__ float xhalf_max(float m) { auto rr = __builtin_amdgcn_permlane32_swap(__float_as_uint(m), __float_as_uint(m), false, false); return fmaxf(__uint_as_float(rr[0]), __uint_as_float(rr[1])); }
__device__ __forceinline__ float xhalf_sum(float m) { auto rr = __builtin_amdgcn_permlane32_swap(__float_as_uint(m), __float_as_uint(m), false, false); return __uint_as_float(rr[0]) + __uint_as_float(rr[1]); }
__device__ __forceinline__ float bf2f(unsigned short b) { return __uint_as_float((unsigned)b << 16); }

struct SM { float m, l; f32x16 o[2]; };
__device__ __forceinline__ void sm_init(SM& s) { s.m = MINIT; s.l = 0.f; s.o[0] = f32x16{}; s.o[1] = f32x16{}; }

template <int DQ> struct Stg { u32x4 k0, k1, v; };
template <int DQ> __device__ __forceinline__ void stg_load(Stg<DQ>& s, const FGAS char* ws, unsigned koff, unsigned ksb, unsigned voff, unsigned vsb, int key0, int kmax, int tid) {
    const int row = tid >> 3, ch = tid & 7; int kr = key0 + row; kr = kr < kmax ? kr : kmax;
    s.k0 = *(const FGAS u32x4*)(ws + (koff + (unsigned)kr * ksb + (unsigned)ch * 16u));
    s.v = *(const FGAS u32x4*)(ws + (voff + (unsigned)kr * vsb + (unsigned)ch * 16u));
    if (DQ == 96) { if (tid < 256) { const int r2 = tid >> 2, c2 = tid & 3; int k2 = key0 + r2; k2 = k2 < kmax ? k2 : kmax; s.k1 = *(const FGAS u32x4*)(ws + (koff + (unsigned)k2 * ksb + 128u + (unsigned)c2 * 16u)); } }
}
template <int DQ> __device__ __forceinline__ void stg_store(const Stg<DQ>& s, FLAS char* buf, int tid) {
    const int row = tid >> 3, ch = tid & 7, p = ch >> 2, c = ch & 3;
    *(FLAS u32x4*)(buf + p * 4096 + row * 64 + ((c ^ ((row >> 2) & 3)) << 4)) = s.k0;
    *(FLAS u32x4*)(buf + (DQ / 32) * 4096 + row * 128 + ((p ^ ((row >> 1) & 1)) << 6) + (c << 4)) = s.v;
    if (DQ == 96) { if (tid < 256) { const int r2 = tid >> 2, c2 = tid & 3; *(FLAS u32x4*)(buf + 2 * 4096 + r2 * 64 + ((c2 ^ ((r2 >> 2) & 3)) << 4)) = s.k1; } }
}
template <int DQ> constexpr int stage_bytes() { return (DQ / 32) * 4096 + 8192; }

template <int DQ> __device__ __forceinline__ void compute_S(f32x16& p0, f32x16& p1, const FLAS char* buf, const bf16x8 (&qf)[DQ / 16], int lane) {
    const int r = lane & 31, h = lane >> 5, sw = (r >> 2) & 3;
#pragma unroll
    for (int d0 = 0; d0 < DQ / 16; ++d0) {
        const int p = d0 >> 1, c = 2 * (d0 & 1) + h;
        const FLAS char* a = buf + p * 4096 + r * 64 + ((c ^ sw) << 4);
        const bf16x8 a0 = *(const FLAS bf16x8*)a, a1 = *(const FLAS bf16x8*)(a + 2048);
        p0 = __builtin_amdgcn_mfma_f32_32x32x16_bf16(a0, qf[d0], p0, 0, 0, 0);
        p1 = __builtin_amdgcn_mfma_f32_32x32x16_bf16(a1, qf[d0], p1, 0, 0, 0);
    }
#if FA_EXP & 2
    __builtin_amdgcn_sched_group_barrier(0x100, 4, 0);
#pragma unroll
    for (int i = 0; i < DQ / 16 - 2; ++i) { __builtin_amdgcn_sched_group_barrier(0x008, 2, 0); __builtin_amdgcn_sched_group_barrier(0x100, 2, 0); }
    __builtin_amdgcn_sched_group_barrier(0x008, 4, 0);
#endif
}
__device__ __forceinline__ s16x4 vtr(const FLAS char* p) { typedef short v4i16_t __attribute__((ext_vector_type(4))); return __builtin_bit_cast(s16x4, __builtin_amdgcn_ds_read_tr16_b64_v4i16((FLAS v4i16_t*)p)); }
__device__ __forceinline__ void pv(f32x16 (&o)[2], const FLAS char* vbuf, const bf16x8 (&pf)[4], int lane) {
    const int g = lane >> 4, i = lane & 15, q4 = i >> 2, pp = i & 3, h = lane >> 5;
    const int sw = (q4 >> 1) & 1;
#pragma unroll
    for (int db = 0; db < 2; ++db) {
        const FLAS char* base = vbuf + (4 * h + q4) * 128 + ((db ^ sw) << 6) + (16 * (g & 1) + 4 * pp) * 2;
#pragma unroll
        for (int ks = 0; ks < 4; ++ks) {
            const s16x4 lo = vtr(base + ks * 2048), hi = vtr(base + ks * 2048 + 1024);
            const bf16x8 a = (bf16x8){lo[0], lo[1], lo[2], lo[3], hi[0], hi[1], hi[2], hi[3]};
            o[db] = __builtin_amdgcn_mfma_f32_32x32x16_bf16(a, pf[ks], o[db], 0, 0, 0);
        }
    }
#if FA_EXP & 2
    __builtin_amdgcn_sched_group_barrier(0x100, 8, 0);
    __builtin_amdgcn_sched_group_barrier(0x008, 2, 0); __builtin_amdgcn_sched_group_barrier(0x100, 4, 0);
    __builtin_amdgcn_sched_group_barrier(0x008, 2, 0); __builtin_amdgcn_sched_group_barrier(0x100, 4, 0);
    __builtin_amdgcn_sched_group_barrier(0x008, 4, 0);
#endif
}
__device__ __forceinline__ void mask_ew(f32x16& p0, f32x16& p1, int lo, int hi, int h) {
    const int lo2 = lo - 4 * h, hi2 = hi - 4 * h;
#pragma unroll
    for (int v = 0; v < 16; ++v) { const int k0 = (v & 3) + 8 * (v >> 2);
        if (k0 < lo2 || k0 > hi2) p0[v] = MASKV;
        if (k0 + 32 < lo2 || k0 + 32 > hi2) p1[v] = MASKV; }
}
__device__ __forceinline__ void sm_step(SM& st, f32x16& p0, f32x16& p1, bf16x8 (&pf)[4]) {
#define FA_MX3(a, b, c) __builtin_fmaxf(__builtin_fmaxf((a), (b)), (c))
    float ma = FA_MX3(p0[0], p0[1], p1[0]), mb = FA_MX3(p0[2], p0[3], p1[1]); ma = FA_MX3(ma, p1[2], p1[3]);
#pragma unroll
    for (int v = 4; v < 16; v += 4) { ma = FA_MX3(ma, p0[v], p0[v + 1]); mb = FA_MX3(mb, p0[v + 2], p0[v + 3]); ma = FA_MX3(ma, p1[v], p1[v + 1]); mb = FA_MX3(mb, p1[v + 2], p1[v + 3]); }
#undef FA_MX3
    const float mx = xhalf_max(__builtin_fmaxf(ma, mb));
    if (__any(mx > st.m)) {
        const float mn2 = fmaxf(st.m, mx), alpha = ex2(st.m - mn2);
        st.m = mn2; st.l *= alpha; st.o[0] *= alpha; st.o[1] *= alpha;
    }
    const float mn = st.m;
    float s0 = 0.f, s1 = 0.f;
#pragma unroll
    for (int v = 0; v < 16; ++v) { p0[v] = ex2(p0[v] - mn); p1[v] = ex2(p1[v] - mn); s0 += p0[v]; s1 += p1[v]; }
    st.l += s0 + s1;
    u32x4 w;
    w.x = cvtpk(p0[0], p0[1]); w.y = cvtpk(p0[2], p0[3]); w.z = cvtpk(p0[4], p0[5]); w.w = cvtpk(p0[6], p0[7]); pf[0] = __builtin_bit_cast(bf16x8, w);
    w.x = cvtpk(p0[8], p0[9]); w.y = cvtpk(p0[10], p0[11]); w.z = cvtpk(p0[12], p0[13]); w.w = cvtpk(p0[14], p0[15]); pf[1] = __builtin_bit_cast(bf16x8, w);
    w.x = cvtpk(p1[0], p1[1]); w.y = cvtpk(p1[2], p1[3]); w.z = cvtpk(p1[4], p1[5]); w.w = cvtpk(p1[6], p1[7]); pf[2] = __builtin_bit_cast(bf16x8, w);
    w.x = cvtpk(p1[8], p1[9]); w.y = cvtpk(p1[10], p1[11]); w.z = cvtpk(p1[12], p1[13]); w.w = cvtpk(p1[14], p1[15]); pf[3] = __builtin_bit_cast(bf16x8, w);
}
template <int DQ, bool ALIBI> __device__ __forceinline__ void score_tile(f32x16& p0, f32x16& p1, const FLAS char* buf, const bf16x8 (&qf)[DQ / 16], float cb, float sl, int lane) {
    if (ALIBI) {
#pragma unroll
        for (int v = 0; v < 16; ++v) { const float c = (float)((v & 3) + 8 * (v >> 2)); p0[v] = fmaf(sl, c, cb); p1[v] = fmaf(sl, c + 32.f, cb); }
    } else { p0 = f32x16{}; p1 = f32x16{}; }
    compute_S<DQ>(p0, p1, buf, qf, lane);
}
template <int DQ, bool ALIBI> __device__ __forceinline__ void tile_compute(SM& st, const FLAS char* buf, const bf16x8 (&qf)[DQ / 16], float cb, float sl, bool ew, int lo, int hi, int lane) {
    f32x16 p0, p1; bf16x8 pf[4];
    score_tile<DQ, ALIBI>(p0, p1, buf, qf, cb, sl, lane);
    if (ew) mask_ew(p0, p1, lo, hi, lane >> 5);
    sm_step(st, p0, p1, pf);
    pv(st.o, buf + (DQ / 32) * 4096, pf, lane);
}
template <int DQ, bool ALIBI, class K0, class PAR>
__device__ __forceinline__ void fa_loop(SM& st, const bf16x8 (&qf)[DQ / 16], const FGAS char* ws, unsigned koff, unsigned ksb, unsigned voff, unsigned vsb, int kmax, int ntile, K0 k0f, PAR parf, float sl, FLAS char* lds, int tid, int lane) {
    constexpr int STG = stage_bytes<DQ>();
    Stg<DQ> sgA, sgB;
    stg_load<DQ>(sgB, ws, koff, ksb, voff, vsb, k0f(0), kmax, tid); stg_store<DQ>(sgB, lds, tid);
    if (ntile > 1) stg_load<DQ>(sgA, ws, koff, ksb, voff, vsb, k0f(1), kmax, tid);
    if (ntile > 2) stg_load<DQ>(sgB, ws, koff, ksb, voff, vsb, k0f(2), kmax, tid);
    __syncthreads();
#if FA_PROBE && FA_PROBE < 9
    unsigned long long pr_c = 0, pr_w = 0, pr_b = 0, pr_t = 0; const unsigned long long pr_start = __builtin_amdgcn_s_memtime();
#define FA_P0 const unsigned long long q0_ = __builtin_amdgcn_s_memtime();
#define FA_P1 asm volatile("s_waitcnt vmcnt(0)" ::: "memory"); const unsigned long long q1_ = __builtin_amdgcn_s_memtime();
#define FA_P2 asm volatile("s_waitcnt lgkmcnt(0)" ::: "memory"); asm volatile("" : "+v"(st.o[0]), "+v"(st.o[1])); const unsigned long long q2_ = __builtin_amdgcn_s_memtime();
#define FA_P3 const unsigned long long q3_ = __builtin_amdgcn_s_memtime(); pr_w += q1_ - q0_; pr_c += q2_ - q1_; pr_b += q3_ - q2_; pr_t += 1;
#else
#define FA_P0
#define FA_P1
#define FA_P2
#define FA_P3
#endif
#define FA_ITER(SG) { \
        FA_P0 \
        if (t + 1 < ntile) stg_store<DQ>(SG, lds + ((t + 1) & 1) * STG, tid); \
        if (t + 3 < ntile) stg_load<DQ>(SG, ws, koff, ksb, voff, vsb, k0f(t + 3), kmax, tid); \
        FA_P1 \
        bool act, ew; float cb; int lo, hi; \
        parf(t, act, ew, cb, lo, hi); \
        if (act) tile_compute<DQ, ALIBI>(st, lds + (t & 1) * STG, qf, cb, sl, ew, lo, hi, lane); \
        FA_P2 \
        __syncthreads(); \
        FA_P3 }
    int t = 0;
    for (; t + 1 < ntile; t += 2) { FA_ITER(sgA) ++t; FA_ITER(sgB) --t; }
    if (t < ntile) FA_ITER(sgA)
#undef FA_ITER
#if FA_PROBE && FA_PROBE < 9
    if (DQ == 96 && lane == 0) { unsigned long long* pp = (unsigned long long*)((FGAS char*)ws + 32768);
        atomicAdd(pp + 0, pr_c); atomicAdd(pp + 1, pr_w); atomicAdd(pp + 2, pr_b); atomicAdd(pp + 3, pr_t); atomicAdd(pp + 4, __builtin_amdgcn_s_memtime() - pr_start); }
#endif
}
__device__ __forceinline__ void sm_finish(const SM& st, float gate, f32x16 (&acc)[2]) {
    const float inv = gate / fmaxf(xhalf_sum(st.l), TINYF);
    acc[0] += st.o[0] * inv; acc[1] += st.o[1] * inv;
}
template <class DST> __device__ __forceinline__ void store_out(const f32x16 (&acc)[2], FLAS char* ost, FGAS char* ws, DST dstf, int lane) {
    const int r = lane & 31, h = lane >> 5;
#pragma unroll
    for (int db = 0; db < 2; ++db)
#pragma unroll
        for (int g = 0; g < 4; ++g) { u32x2 w; w.x = cvtpk(acc[db][4 * g], acc[db][4 * g + 1]); w.y = cvtpk(acc[db][4 * g + 2], acc[db][4 * g + 3]);
            *(FLAS u32x2*)(ost + r * OSTR + (32 * db + 8 * g + 4 * h) * 2) = w; }
    asm volatile("s_waitcnt lgkmcnt(0)" ::: "memory");
#pragma unroll
    for (int i = 0; i < 4; ++i) { const int idx = i * 64 + lane, col = idx >> 3, ch = idx & 7;
        const u32x4 v = *(const FLAS u32x4*)(ost + col * OSTR + ch * 16);
        *(FGAS u32x4*)(ws + (dstf(col) + (unsigned)ch * 16u)) = v; }
    asm volatile("s_waitcnt lgkmcnt(0)" ::: "memory");
}
template <int DQ> __device__ __forceinline__ void load_q(bf16x8 (&qf)[DQ / 16], const FGAS char* ws, unsigned qoff, int h) {
#pragma unroll
    for (int d0 = 0; d0 < DQ / 16; ++d0) qf[d0] = *(const FGAS bf16x8*)(ws + (qoff + (unsigned)(d0 * 32 + 16 * h)));
}
}
namespace mk {
typedef unsigned short bf16;
typedef float f32x4 __attribute__((ext_vector_type(4)));
typedef unsigned v4u __attribute__((ext_vector_type(4)));
typedef unsigned v2u __attribute__((ext_vector_type(2)));
typedef short bf16x8 __attribute__((ext_vector_type(8)));
typedef float f32x16 __attribute__((ext_vector_type(16)));
using fa::SM;

constexpr int D = 1024, NB = 4, SEQ = 8192, M = NB * SEQ, DEPTH = 2, DFF = 4096, ZLD = 2304, DIN = 2284;
constexpr int ZA_Q = 0, ZA_K = 256, ZA_V = 384, ZB_CQ = 512, ZB_CKV = 704, ZB_PE = 832, ZC_Q = 864, ZC_KC = 1120, ZC_VC = 1184, ZC_KS = 1248, ZC_VS = 1312, ZC_KW = 1376, ZC_VW = 1440, ZC_GL = 1504, ZD_Q = 1520, ZD_K = 1776, ZD_V = 2032;
constexpr float LOG2E = 1.4426950408889634f;
constexpr float QS = 0.125f * LOG2E;
constexpr float C_MLA = 0.10206207261596577f * LOG2E;
constexpr float RMS_EPS = 1e-6f;
constexpr int NWAVES = 8, NTHR = 512;

constexpr size_t MiB = 1u << 20;
constexpr size_t WS_CTL = 0, CTL_ZERO_BYTES = 64 * 1024;
constexpr size_t WS_MOD = 1 * MiB;
constexpr size_t WS_ROPE = WS_MOD + 256 * 1024;
constexpr size_t WS_POSP = WS_ROPE + 1 * MiB;
constexpr size_t WS_POSB = WS_POSP + 64 * 1024;
constexpr size_t WS_RSQ = WS_POSB + 64 * 1024;
constexpr size_t WS_RSKV = WS_RSQ + 128 * 1024;
constexpr size_t WS_KMH = WS_RSKV + 128 * 1024;
constexpr size_t WS_KML = WS_KMH + 64 * 1024;
constexpr size_t WS_KCMP = WS_KML + 64 * 1024;
constexpr size_t WS_VCMP = WS_KCMP + 256 * 1024;
constexpr size_t WS_XB = 436 * MiB;
constexpr size_t WS_PARK = 401 * MiB;
constexpr size_t WS_W = 4 * MiB, WS_WL = 26 * MiB;
constexpr size_t W_IN = 0, W_OUT = 4608 * 1024, W_UP = W_OUT + 2 * MiB, W_DN = W_UP + 8 * MiB, W_UQ = W_DN + 8 * MiB, W_UKV = W_UQ + 256 * 1024, W_1K = W_UKV + 256 * 1024, W_1V = W_1K + 512 * 1024, W_2K = W_1V + 512 * 1024, W_2V = W_2K + 16 * 1024;
static_assert(W_2V + 16 * 1024 <= WS_WL && WS_VCMP + 256 * 1024 <= WS_W, "ws map");
constexpr size_t WS_H = 56 * MiB;
constexpr size_t WS_Z = 120 * MiB;
constexpr size_t WS_QM = 265 * MiB, WS_KM = 297 * MiB, WS_VM = 321 * MiB, WS_O = 337 * MiB, WS_U = 120 * MiB, WS_END = 401 * MiB;
static_assert(WS_Z + (size_t)(M + 64) * ZLD * 2 <= WS_QM && WS_U + (size_t)M * DFF * 2 <= WS_END, "ws map 2");

constexpr int LDS_RING = 131072, LDS_BYTES = 163840, LDS_MISC = LDS_BYTES - 256;
constexpr int FA_STAGES = 0, FA_OST = 61440, FA_IMP = FA_OST + 8 * 32 * fa::OSTR  , FA_SELM = FA_IMP + 32768, FA_UM = FA_SELM + 1024, FA_VALS = FA_UM + 64;
static_assert(FA_VALS + 8 * 512 <= LDS_MISC, "fa lds map");
constexpr int MB_OS = 65;
constexpr int MB_T = 0, MB_O = 65536, MB_ML = MB_O + 256 * MB_OS * 4, MB_CNT = MB_ML + 2048, MB_LST = MB_CNT + 128, MB_PS = MB_LST + 8192, MB_PM = MB_PS + 4 * 32 * 33 * 4;
static_assert(MB_PM + 1024 <= LDS_MISC, "moba lds map");

#define GAS __attribute__((address_space(1)))
#define LAS __attribute__((address_space(3)))
#define LDS_WAIT() asm volatile("s_waitcnt lgkmcnt(0)" ::: "memory")
__device__ __forceinline__ unsigned f2bf(float f) { unsigned u = __builtin_bit_cast(unsigned, f); return (u + 0x7fffu + ((u >> 16) & 1u)) >> 16; }
__device__ __forceinline__ unsigned pk2(float lo, float hi) { return f2bf(lo) | (f2bf(hi) << 16); }
__device__ __forceinline__ float bf2f(unsigned short b) { return __uint_as_float((unsigned)b << 16); }
__device__ __forceinline__ float wave_sum(float v) {
#pragma unroll
    for (int o = 1; o < 64; o <<= 1) v += __shfl_xor(v, o);
    return v;
}
__device__ __forceinline__ float slope2_of(int i) { return exp2f(-8.0f * (float)(i + 1) / 12.0f) * LOG2E; }

struct Args { const float* in[22]; float* out; unsigned char* ws; int ph_lo, ph_hi, skip, rep; };
typedef const __attribute__((address_space(4))) Args* KArgsP;
struct Frame {
    LAS unsigned char* lds;
    int tid, lane, wave, vcu, G, bx;
    unsigned char* ws;
};

template <int MODE> __device__ __forceinline__ int dmap(int n) {
    if (MODE == 1) { if (n < 832) return n; if (n < 848) return 832 + 2 * (n - 832); if (n < 864) return 832 + 2 * (n - 848) + 1; if (n < 1516) return n; return n + 4; }
    if (MODE == 2) { const int hd = n / 96, w = n - hd * 96; if (w < 64) return hd * 64 + w; if (w < 80) return 256 + hd * 32 + 2 * (w - 64); return 256 + hd * 32 + 2 * (w - 80) + 1; }
    return n;
}
template <int MODE> __device__ __forceinline__ float cscale(int n) {
    if (MODE == 1) { return (n < 256 || (n >= 864 && n < 1120) || (n >= 1516 && n < 1772)) ? QS : 1.f; }
    if (MODE == 2) return C_MLA;
    return 1.f;
}
template <int MODE> __device__ __forceinline__ void transpose_item(const float* W, int N, bf16* WT, int KT, const float* kscale, LAS float* scr, int item, int lane) {
    const int nblk = (N + 31) / 32, kb = item / nblk, nb = item % nblk, k0 = 64 * kb, n0 = 32 * nb;
    const int nl = lane & 31, n = n0 + nl;
#pragma unroll 8
    for (int i = 0; i < 32; ++i) { const int kk = 2 * i + (lane >> 5); float v = (n < N) ? W[(size_t)(k0 + kk) * N + n] : 0.f; if (kscale) v *= kscale[k0 + kk]; scr[kk * 33 + nl] = v; }
    LDS_WAIT(); asm volatile("" ::: "memory");
    const int c = lane & 7;
#pragma unroll
    for (int j = 0; j < 4; ++j) { const int nn = (lane >> 3) + 8 * j, ng = n0 + nn;
        if (ng < N) { const float cs = cscale<MODE>(ng); const LAS float* s = scr + (8 * c) * 33 + nn;
            v4u o; o.x = pk2(s[0 * 33] * cs, s[1 * 33] * cs); o.y = pk2(s[2 * 33] * cs, s[3 * 33] * cs); o.z = pk2(s[4 * 33] * cs, s[5 * 33] * cs); o.w = pk2(s[6 * 33] * cs, s[7 * 33] * cs);
            *(GAS v4u*)(WT + (size_t)dmap<MODE>(ng) * KT + k0 + 8 * c) = o; } }
    LDS_WAIT(); asm volatile("" ::: "memory");
}
__device__ __forceinline__ void zero_fill16(bf16* p, size_t n16, int gtid, int gthreads) {
    for (size_t i = gtid; i < n16; i += gthreads) ((GAS v4u*)p)[i] = (v4u){0u, 0u, 0u, 0u};
}

__device__ __forceinline__ void p_prologue(Frame& F, KArgsP ap_) {
#define a (*ap_)
    LAS float* scr = (LAS float*)(F.lds + F.wave * 16384);
    const int gw = F.vcu * NWAVES + F.wave, NGW = F.G * NWAVES;
    const int gtid = F.vcu * NTHR + F.tid, GT = F.G * NTHR;
    constexpr int I_IN = 16 * 72, I_OUT = 16 * 32, I_UP = 16 * 128, I_DN = 64 * 32, I_UQ = 3 * 12, I_UKV = 2 * 16, I_W1 = 32 * 4, I_W2 = 2 * 2;
    constexpr int PER_L = I_IN + I_OUT + I_UP + I_DN + I_UQ + I_UKV + 2 * I_W1 + 2 * I_W2;
    for (int it = gw; it < DEPTH * PER_L; it += NGW) {
        const int l = it / PER_L; int r = it - l * PER_L;
        unsigned char* wb = F.ws + WS_W + (size_t)l * WS_WL;
        if (r < I_IN) { transpose_item<1>(a.in[6] + (size_t)l * D * DIN, DIN, (bf16*)(wb + W_IN), D, nullptr, scr, r, F.lane); continue; } r -= I_IN;
        if (r < I_OUT) { transpose_item<0>(a.in[7] + (size_t)l * D * D, D, (bf16*)(wb + W_OUT), D, nullptr, scr, r, F.lane); continue; } r -= I_OUT;
        if (r < I_UP) { transpose_item<0>(a.in[19] + (size_t)l * D * DFF, DFF, (bf16*)(wb + W_UP), D, nullptr, scr, r, F.lane); continue; } r -= I_UP;
        if (r < I_DN) { transpose_item<0>(a.in[20] + (size_t)l * DFF * D, D, (bf16*)(wb + W_DN), DFF, nullptr, scr, r, F.lane); continue; } r -= I_DN;
        if (r < I_UQ) { transpose_item<2>(a.in[11] + (size_t)l * 192 * 384, 384, (bf16*)(wb + W_UQ), 256, a.in[9] + l * 192, scr, r, F.lane); continue; } r -= I_UQ;
        if (r < I_UKV) { transpose_item<0>(a.in[12] + (size_t)l * 128 * 512, 512, (bf16*)(wb + W_UKV), 256, a.in[10] + l * 128, scr, r, F.lane); continue; } r -= I_UKV;
        if (r < I_W1) { transpose_item<0>(a.in[15] + (size_t)l * 2048 * 128, 128, (bf16*)(wb + W_1K), 2048, nullptr, scr, r, F.lane); continue; } r -= I_W1;
        if (r < I_W1) { transpose_item<0>(a.in[17] + (size_t)l * 2048 * 128, 128, (bf16*)(wb + W_1V), 2048, nullptr, scr, r, F.lane); continue; } r -= I_W1;
        if (r < I_W2) { transpose_item<0>(a.in[16] + (size_t)l * 128 * 64, 64, (bf16*)(wb + W_2K), 128, nullptr, scr, r, F.lane); continue; } r -= I_W2;
        transpose_item<0>(a.in[18] + (size_t)l * 128 * 64, 64, (bf16*)(wb + W_2V), 128, nullptr, scr, r, F.lane);
    }
    for (int l = 0; l < DEPTH; ++l) {
        unsigned char* wb = F.ws + WS_W + (size_t)l * WS_WL;
        zero_fill16((bf16*)(wb + W_IN) + (size_t)1516 * D, 4 * D / 8, gtid, GT);
        zero_fill16((bf16*)(wb + W_IN) + (size_t)2288 * D, 16 * D / 8, gtid, GT);
        zero_fill16((bf16*)(wb + W_UQ) + (size_t)384 * 256, 128 * 256 / 8, gtid, GT);
        for (int i = gtid; i < 384 * 8; i += GT) ((GAS v4u*)((bf16*)(wb + W_UQ) + (size_t)(i >> 3) * 256 + 192))[i & 7] = (v4u){0u, 0u, 0u, 0u};
        for (int i = gtid; i < 512 * 16; i += GT) ((GAS v4u*)((bf16*)(wb + W_UKV) + (size_t)(i >> 4) * 256 + 128))[i & 15] = (v4u){0u, 0u, 0u, 0u};
    }
    { float* rt = (float*)(F.ws + WS_ROPE);
      for (int i = gtid; i < SEQ * 16; i += GT) { const int ii = i & 15, t = i >> 4; const float freq = powf(10000.f, -(float)ii / 16.f), ang = (float)t * freq; rt[2 * i] = cosf(ang); rt[2 * i + 1] = sinf(ang); } }
    { float* pp = (float*)(F.ws + WS_POSP);
      for (int i = gtid; i < DEPTH * 2 * 32 * 128; i += GT) { const int j = i & 127, kr = (i >> 7) & 31, wh = (i >> 12) & 1, l = i >> 13;
          const float* pos = a.in[wh ? 14 : 13] + l * 2048 + kr * 64; const float* w1 = a.in[wh ? 17 : 15] + (size_t)l * 2048 * 128 + (size_t)kr * 64 * 128 + j;
          float s = 0.f;
#pragma unroll 8
          for (int k = 0; k < 64; ++k) s += pos[k] * w1[(size_t)k * 128];
          pp[i] = s; } }
    { LAS float* sc = (LAS float*)(F.lds);
      LAS float* part = (LAS float*)(F.lds + 16384);
      __syncthreads();
      bool have = false;
      for (int it = F.vcu; it < DEPTH * 96; it += F.G) {
          if (!have) { for (int i = F.tid; i < NB * D; i += NTHR) { const float cv = a.in[1][i]; sc[i] = cv / (1.f + expf(-cv)); } have = true; __syncthreads(); }
          const int l = it / 96, ch = it % 96; const int j = ch * 64 + F.lane;
          const float* w = a.in[4] + (size_t)l * D * 6 * D + j;
          float acc[4] = {0.f, 0.f, 0.f, 0.f};
#pragma unroll 8
          for (int k = 128 * F.wave; k < 128 * F.wave + 128; ++k) { const float wv = w[(size_t)k * 6 * D]; acc[0] += sc[k] * wv; acc[1] += sc[D + k] * wv; acc[2] += sc[2 * D + k] * wv; acc[3] += sc[3 * D + k] * wv; }
#pragma unroll
          for (int b = 0; b < 4; ++b) part[(F.wave * 4 + b) * 64 + F.lane] = acc[b];
          __syncthreads();
          if (F.tid < 256) { const int b = F.tid >> 6, ln = F.tid & 63; float s = a.in[5][l * 6 * D + ch * 64 + ln];
#pragma unroll
              for (int w8 = 0; w8 < 8; ++w8) s += part[(w8 * 4 + b) * 64 + ln];
              ((float*)(F.ws + WS_MOD))[((size_t)l * NB + b) * 6 * D + ch * 64 + ln] = s; }
          __syncthreads();
      } }
}

#undef a
template <int MODE, bool XB16> __device__ __forceinline__ void p_norm(Frame& F, const void* x, const float* g, const float* modsh, const float* modsc, bf16* hout, float* fout) {
    const int gw = F.vcu * NWAVES + F.wave, NGW = F.G * NWAVES;
    for (int blk = gw; blk < M / 16; blk += NGW) {
        const int row0 = blk * 16, b = row0 >> 13;
        f32x4 ga[4], sh[4];
#pragma unroll
        for (int j = 0; j < 4; ++j) { const int c = 4 * F.lane + 256 * j; ga[j] = *(const f32x4*)(g + c);
            if (MODE == 0) { const f32x4 s = *(const f32x4*)(modsc + (size_t)b * 6 * D + c); ga[j] = ga[j] * (s + 1.0f); sh[j] = *(const f32x4*)(modsh + (size_t)b * 6 * D + c); } }
        for (int rr = 0; rr < 16; ++rr) {
            const int row = row0 + rr;
            f32x4 v[4]; float s = 0.f;
            if (XB16) { const GAS unsigned long long* xr = (const GAS unsigned long long*)((const bf16*)x + (size_t)row * D) + F.lane;
#pragma unroll
                for (int j = 0; j < 4; ++j) { const unsigned long long q = xr[64 * j]; const unsigned lo = (unsigned)q, hi = (unsigned)(q >> 32);
                    v[j] = (f32x4){__uint_as_float(lo << 16), __uint_as_float(lo & 0xffff0000u), __uint_as_float(hi << 16), __uint_as_float(hi & 0xffff0000u)}; } }
            else { const GAS f32x4* xr = (const GAS f32x4*)((const float*)x + (size_t)row * D) + F.lane;
#pragma unroll
                for (int j = 0; j < 4; ++j) v[j] = xr[64 * j]; }
#pragma unroll
            for (int j = 0; j < 4; ++j) s += (v[j].x * v[j].x + v[j].y * v[j].y) + (v[j].z * v[j].z + v[j].w * v[j].w);
            const float r = rsqrtf(wave_sum(s) * (1.f / D) + RMS_EPS);
            if (MODE == 0) { GAS unsigned long long* o8 = (GAS unsigned long long*)(hout + (size_t)row * D) + F.lane;
#pragma unroll
                for (int j = 0; j < 4; ++j) { const f32x4 y = v[j] * r * ga[j] + sh[j]; o8[64 * j] = (unsigned long long)pk2(y.x, y.y) | ((unsigned long long)pk2(y.z, y.w) << 32); } }
            else { GAS f32x4* o = (GAS f32x4*)(fout + (size_t)row * D) + F.lane;
#pragma unroll
                for (int j = 0; j < 4; ++j) o[64 * j] = v[j] * r * ga[j]; }
        }
    }
}

__device__ __forceinline__ void p_prep(Frame& F, int l) {
    const int gw = F.vcu * NWAVES + F.wave, NGW = F.G * NWAVES;
    const bf16* Z = (const bf16*)(F.ws + WS_Z); bf16* KM = (bf16*)(F.ws + WS_KM);
    float* rsq = (float*)(F.ws + WS_RSQ); float* rskv = (float*)(F.ws + WS_RSKV); const float* rope = (const float*)(F.ws + WS_ROPE);
    for (int row = gw; row < M; row += NGW) {
        const bf16* zr = Z + (size_t)row * ZLD;
        const float a0 = bf2f(zr[ZB_CQ + F.lane]), a1 = bf2f(zr[ZB_CQ + 64 + F.lane]), a2 = bf2f(zr[ZB_CQ + 128 + F.lane]);
        const float b0 = bf2f(zr[ZB_CKV + F.lane]), b1 = bf2f(zr[ZB_CKV + 64 + F.lane]);
        const float sq = wave_sum(a0 * a0 + a1 * a1 + a2 * a2), skv = wave_sum(b0 * b0 + b1 * b1);
        if (F.lane == 0) { rsq[row] = rsqrtf(sq * (1.f / 192.f) + RMS_EPS); rskv[row] = rsqrtf(skv * (1.f / 128.f) + RMS_EPS); }
        if (F.lane < 16) { const unsigned pr = *(const unsigned*)(zr + ZB_PE + 2 * F.lane); const float x1 = bf2f((unsigned short)(pr & 0xffffu)), x2 = bf2f((unsigned short)(pr >> 16));
            const float cs = rope[((size_t)(row & 8191) * 16 + F.lane) * 2], sn = rope[((size_t)(row & 8191) * 16 + F.lane) * 2 + 1];
            const unsigned o = pk2(x1 * cs - x2 * sn, x1 * sn + x2 * cs);
#pragma unroll
            for (int hd = 0; hd < 4; ++hd) *(unsigned*)(KM + (size_t)row * 384 + hd * 96 + 64 + 2 * F.lane) = o; }
    }
    { bf16* KMH = (bf16*)(F.ws + WS_KMH); bf16* KML = (bf16*)(F.ws + WS_KML);
      for (int it = gw; it < NB * 4 * 32; it += NGW) { const int j = it & 31, hd = (it >> 5) & 3, b = it >> 7; const int ts = F.lane >> 3, ch = F.lane & 7;
          float acc[8] = {0.f, 0.f, 0.f, 0.f, 0.f, 0.f, 0.f, 0.f};
          for (int i = 0; i < 32; ++i) { const v4u w = *(const v4u*)(Z + (size_t)(b * SEQ + j * 256 + 8 * i + ts) * ZLD + ZD_K + hd * 64 + ch * 8);
#pragma unroll
              for (int e = 0; e < 4; ++e) { acc[2 * e] += __uint_as_float(w[e] << 16); acc[2 * e + 1] += __uint_as_float(w[e] & 0xffff0000u); } }
#pragma unroll
          for (int e = 0; e < 8; ++e) { acc[e] += __shfl_xor(acc[e], 8); acc[e] += __shfl_xor(acc[e], 16); acc[e] += __shfl_xor(acc[e], 32); }
          if (F.lane < 8) { unsigned hi[4], lo[4];
#pragma unroll
              for (int e = 0; e < 4; ++e) { const float m0 = acc[2 * e] * (1.f / 256.f), m1 = acc[2 * e + 1] * (1.f / 256.f); const unsigned h0 = f2bf(m0), h1 = f2bf(m1);
                  hi[e] = h0 | (h1 << 16); lo[e] = pk2(m0 - __uint_as_float(h0 << 16), m1 - __uint_as_float(h1 << 16)); }
              *(v4u*)(KMH + (size_t)it * 64 + ch * 8) = (v4u){hi[0], hi[1], hi[2], hi[3]}; *(v4u*)(KML + (size_t)it * 64 + ch * 8) = (v4u){lo[0], lo[1], lo[2], lo[3]}; } } }
    if (gw == 0) { const float* pp = (const float*)(F.ws + WS_POSP) + (size_t)l * 2 * 32 * 128; float* pb = (float*)(F.ws + WS_POSB) + l * 256;
        for (int i = F.lane; i < 256; i += 64) { const int j = i & 127, wh = i >> 7; float s = 0.f; for (int kr = 0; kr < 32; ++kr) s += pp[(wh * 32 + kr) * 128 + j]; pb[i] = s; } }
}

__device__ __forceinline__ float gelu_tanh(float x) { const float u = 0.7978845608028654f * (x + 0.044715f * x * x * x); const float e = __expf(2.f * u); return x * (1.f - 1.f / (e + 1.f)); }
__device__ __forceinline__ void p_compress(Frame& F, int l) {
    const bf16* Z = (const bf16*)(F.ws + WS_Z);
    unsigned char* wb = F.ws + WS_W + (size_t)l * WS_WL;
    LAS float* red = (LAS float*)F.lds;
    const int r = F.lane & 31, h = F.lane >> 5;
    for (int it = F.vcu; it < NB * 16 * 2; it += F.G) {
        const int which = it & 1, itile = (it >> 1) & 15, b = it >> 5;
        const bf16* W1T = (const bf16*)(wb + (which ? W_1V : W_1K)); const bf16* W2T = (const bf16*)(wb + (which ? W_2V : W_2K));
        const int coff = which ? ZC_VC : ZC_KC;
        f32x16 acc[4] = {f32x16{}, f32x16{}, f32x16{}, f32x16{}};
        const bf16* brow = Z + (size_t)(b * SEQ + 16 * (32 * itile + r)) * ZLD + coff + 8 * h;
#pragma unroll 2
        for (int ks = 0; ks < 16; ++ks) { const int tt = 4 * F.wave + (ks >> 2), d0 = ks & 3;
            const bf16x8 bf = *(const bf16x8*)(brow + (size_t)tt * ZLD + d0 * 16);
#pragma unroll
            for (int hb = 0; hb < 4; ++hb) { const bf16x8 af = *(const bf16x8*)(W1T + (size_t)(hb * 32 + r) * 2048 + tt * 64 + d0 * 16 + 8 * h);
                acc[hb] = __builtin_amdgcn_mfma_f32_32x32x16_bf16(af, bf, acc[hb], 0, 0, 0); } }
#pragma unroll
        for (int hb = 0; hb < 4; ++hb)
#pragma unroll
            for (int v = 0; v < 16; ++v) red[((F.wave * 4 + hb) * 16 + v) * 64 + F.lane] = acc[hb][v];
        __syncthreads();
        if (F.wave < 2) {
            const float* pb = (const float*)(F.ws + WS_POSB) + l * 256 + which * 128;
            f32x16 o = f32x16{};
#pragma unroll
            for (int hb = 0; hb < 4; ++hb) { float x[16];
#pragma unroll
                for (int v = 0; v < 16; ++v) { float s = pb[hb * 32 + (v & 3) + 8 * (v >> 2) + 4 * h];
#pragma unroll
                    for (int w8 = 0; w8 < 8; ++w8) s += red[((w8 * 4 + hb) * 16 + v) * 64 + F.lane];
                    x[v] = gelu_tanh(s); }
#pragma unroll
                for (int s2 = 0; s2 < 2; ++s2) {
                    v4u pw; pw.x = fa::cvtpk(x[8 * s2], x[8 * s2 + 1]); pw.y = fa::cvtpk(x[8 * s2 + 2], x[8 * s2 + 3]); pw.z = fa::cvtpk(x[8 * s2 + 4], x[8 * s2 + 5]); pw.w = fa::cvtpk(x[8 * s2 + 6], x[8 * s2 + 7]);
                    const bf16* wr = W2T + (size_t)(F.wave * 32 + r) * 128 + hb * 32 + 16 * s2 + 4 * h;
                    const v2u a0 = *(const v2u*)wr, a1 = *(const v2u*)(wr + 8);
                    const v4u aw = (v4u){a0.x, a0.y, a1.x, a1.y};
                    o = __builtin_amdgcn_mfma_f32_32x32x16_bf16(__builtin_bit_cast(bf16x8, aw), __builtin_bit_cast(bf16x8, pw), o, 0, 0, 0); } }
            bf16* dst = (bf16*)(F.ws + (which ? WS_VCMP : WS_KCMP)) + (size_t)(b * 512 + 32 * itile + r) * 64 + F.wave * 32 + 4 * h;
#pragma unroll
            for (int g = 0; g < 4; ++g) { v2u w; w.x = fa::cvtpk(o[4 * g], o[4 * g + 1]); w.y = fa::cvtpk(o[4 * g + 2], o[4 * g + 3]); *(v2u*)(dst + 8 * g) = w; }
        }
        __syncthreads();
    }
}
using fa::bf16x8;
__device__ __forceinline__ unsigned char* launder_ptr(unsigned char* p) { const unsigned long long v = (unsigned long long)p; unsigned lo = __builtin_amdgcn_readfirstlane((unsigned)v), hi = __builtin_amdgcn_readfirstlane((unsigned)(v >> 32)); asm volatile("" : "+s"(lo), "+s"(hi)); return (unsigned char*)(((unsigned long long)hi << 32) | lo); }
#define UNIT_BEGIN() Frame F = F0; { int tid_ = F0.tid; asm volatile("" : "+v"(tid_)); int bx_ = __builtin_amdgcn_readfirstlane(F0.bx); asm volatile("" : "+s"(bx_)); \
    F.ws = launder_ptr(F0.ws); F.tid = tid_; F.lane = tid_ & 63; F.wave = __builtin_amdgcn_readfirstlane(tid_ >> 6); F.bx = bx_; }
__device__ __forceinline__ void u_mla(const Frame& F0, int b, int hd, int u) {
    UNIT_BEGIN();
    GAS char* ws = (GAS char*)F.ws;
    const int r = F.lane & 31, h = F.lane >> 5, q0 = 256 * u, wq0 = q0 + 32 * F.wave, tq = wq0 + r;
    bf16x8 qf[6]; { const unsigned qrow = (unsigned)WS_QM + (unsigned)(b * SEQ + tq) * 1024u;
      const float rs = *(const GAS float*)(ws + ((unsigned)WS_RSQ + (unsigned)(b * SEQ + tq) * 4u));
#pragma unroll
      for (int d0 = 0; d0 < 4; ++d0) { const fa::u32x4 raw = *(const GAS fa::u32x4*)(ws + (qrow + (unsigned)(hd * 128 + d0 * 32 + 16 * h))); fa::u32x4 o;
          o.x = fa::cvtpk(__uint_as_float(raw.x << 16) * rs, __uint_as_float(raw.x & 0xffff0000u) * rs); o.y = fa::cvtpk(__uint_as_float(raw.y << 16) * rs, __uint_as_float(raw.y & 0xffff0000u) * rs);
          o.z = fa::cvtpk(__uint_as_float(raw.z << 16) * rs, __uint_as_float(raw.z & 0xffff0000u) * rs); o.w = fa::cvtpk(__uint_as_float(raw.w << 16) * rs, __uint_as_float(raw.w & 0xffff0000u) * rs);
          qf[d0] = __builtin_bit_cast(bf16x8, o); }
#pragma unroll
      for (int d0 = 0; d0 < 2; ++d0) {
          const fa::u32x4 raw = *(const GAS fa::u32x4*)(ws + (qrow + (unsigned)(512 + hd * 64 + d0 * 32 + 16 * h)));
          const GAS float* rp = (const GAS float*)(ws + ((unsigned)WS_ROPE + (unsigned)((tq * 16 + d0 * 8 + 4 * h) * 8)));
          const fa::f32x4v r0 = *(const GAS fa::f32x4v*)rp * rs, r1 = *(const GAS fa::f32x4v*)(rp + 4) * rs;
          fa::u32x4 o;
          { const float x1 = __uint_as_float(raw.x << 16), x2 = __uint_as_float(raw.x & 0xffff0000u); o.x = fa::cvtpk(x1 * r0[0] - x2 * r0[1], x1 * r0[1] + x2 * r0[0]); }
          { const float x1 = __uint_as_float(raw.y << 16), x2 = __uint_as_float(raw.y & 0xffff0000u); o.y = fa::cvtpk(x1 * r0[2] - x2 * r0[3], x1 * r0[3] + x2 * r0[2]); }
          { const float x1 = __uint_as_float(raw.z << 16), x2 = __uint_as_float(raw.z & 0xffff0000u); o.z = fa::cvtpk(x1 * r1[0] - x2 * r1[1], x1 * r1[1] + x2 * r1[0]); }
          { const float x1 = __uint_as_float(raw.w << 16), x2 = __uint_as_float(raw.w & 0xffff0000u); o.w = fa::cvtpk(x1 * r1[2] - x2 * r1[3], x1 * r1[3] + x2 * r1[2]); }
          qf[4 + d0] = __builtin_bit_cast(bf16x8, o); } }
    SM st; fa::sm_init(st);
    LAS char* lds = (LAS char*)F.lds;
    fa::fa_loop<96, false>(st, qf, ws, (unsigned)WS_KM + (unsigned)b * (SEQ * 768u) + (unsigned)hd * 192u, 768u, (unsigned)WS_VM + (unsigned)b * (SEQ * 512u) + (unsigned)hd * 128u, 512u, SEQ - 1, 4 * u + 4,
        [](int t) { return 64 * t; },
        [=](int t, bool& act, bool& ew, float& cb, int& lo, int& hi) { const int key0 = 64 * t; act = key0 <= wq0 + 31; ew = key0 + 63 > wq0; cb = 0.f; lo = -100000; hi = tq - key0; },
        0.f, lds + FA_STAGES, F.tid, F.lane);
    f32x16 acc[2] = {f32x16{}, f32x16{}}; fa::sm_finish(st, 1.f, acc);
    fa::store_out(acc, lds + FA_OST + F.wave * 32 * fa::OSTR, ws, [=](int col) { return (unsigned)WS_O + (unsigned)(b * SEQ + wq0 + col) * 2048u + (unsigned)(256 + hd * 64) * 2u; }, F.lane);
}
__device__ __forceinline__ void u_moba(const Frame& F0, int b, int hd, int i) {
    UNIT_BEGIN();
    GAS char* ws = (GAS char*)F.ws;
    const int r = F.lane & 31, h = F.lane >> 5, q0 = 256 * i, wq0 = q0 + 32 * F.wave, tq = wq0 + r;
    bf16x8 qf[4]; fa::load_q<64>(qf, ws, (unsigned)WS_Z + (unsigned)(b * SEQ + tq) * (ZLD * 2u) + (unsigned)(ZD_Q + hd * 64) * 2u, h);
    unsigned bits = 0u;
    if (i > 0) {
        const GAS bf16* KMH = (const GAS bf16*)(ws + ((unsigned)WS_KMH + (unsigned)(((b * 4 + hd) * 32 + r) * 64 + 8 * h) * 2u)); const GAS bf16* KML = (const GAS bf16*)(ws + ((unsigned)WS_KML + (unsigned)(((b * 4 + hd) * 32 + r) * 64 + 8 * h) * 2u));
        f32x16 g = f32x16{};
#pragma unroll
        for (int d0 = 0; d0 < 4; ++d0) { const bf16x8 ah = *(const GAS bf16x8*)(KMH + d0 * 16), al = *(const GAS bf16x8*)(KML + d0 * 16);
            g = __builtin_amdgcn_mfma_f32_32x32x16_bf16(ah, qf[d0], g, 0, 0, 0); g = __builtin_amdgcn_mfma_f32_32x32x16_bf16(al, qf[d0], g, 0, 0, 0); }
        float og[16];
#pragma unroll
        for (int v = 0; v < 16; ++v) { const int j = (v & 3) + 8 * (v >> 2) + 4 * h; if (j >= i) g[v] = -INFINITY; og[v] = __shfl_xor(g[v], 32); }
#pragma unroll
        for (int v = 0; v < 16; ++v) { const int j = (v & 3) + 8 * (v >> 2) + 4 * h; int rank = 0;
#pragma unroll
            for (int w = 0; w < 16; ++w) { const int jm = (w & 3) + 8 * (w >> 2) + 4 * h, jo = (w & 3) + 8 * (w >> 2) + 4 * (1 - h);
                rank += (g[w] > g[v] || (g[w] == g[v] && jm < j)) ? 1 : 0; rank += (og[w] > g[v] || (og[w] == g[v] && jo < j)) ? 1 : 0; }
            if (rank < 3 && j < i) bits |= 1u << j; }
        bits |= __shfl_xor(bits, 32);
    }
    const float sl = slope2_of(2 + 3 * hd);
    LAS char* lds = (LAS char*)F.lds;
    LAS float* Ost = (LAS float*)(lds + MB_O);
    LAS float* MLst = (LAS float*)(lds + MB_ML);
    LAS unsigned* cnt = (LAS unsigned*)(lds + MB_CNT);
    LAS unsigned char* lst = (LAS unsigned char*)(lds + MB_LST);
    const unsigned koff = (unsigned)WS_Z + (unsigned)b * (SEQ * ZLD * 2u) + (unsigned)(ZD_K + hd * 64) * 2u, voff = (unsigned)WS_Z + (unsigned)b * (SEQ * ZLD * 2u) + (unsigned)(ZD_V + hd * 64) * 2u;
    if (F.tid < 32) cnt[F.tid] = 0u;
    {
        SM st; fa::sm_init(st);
        fa::fa_loop<64, true>(st, qf, ws, koff, ZLD * 2u, voff, ZLD * 2u, SEQ - 1, 4,
            [=](int t) { return q0 + 64 * t; },
            [=](int t, bool& act, bool& ew, float& cb, int& lo, int& hi) { const int key0 = q0 + 64 * t; act = key0 <= wq0 + 31; ew = key0 + 63 > wq0; cb = sl * (float)(64 * t + 4 * h); lo = -100000; hi = tq - key0; },
            sl, lds + FA_STAGES, F.tid, F.lane);
        const float lt = fa::xhalf_sum(st.l);
        LAS float* orow = Ost + (32 * F.wave + r) * MB_OS;
#pragma unroll
        for (int db = 0; db < 2; ++db)
#pragma unroll
            for (int g = 0; g < 4; ++g)
#pragma unroll
                for (int e = 0; e < 4; ++e) orow[32 * db + 8 * g + 4 * h + e] = st.o[db][4 * g + e];
        if (h == 0) { MLst[(32 * F.wave + r) * 2] = st.m; MLst[(32 * F.wave + r) * 2 + 1] = lt; }
    }
    if (h == 0) { unsigned bb = bits;
        while (bb) { const int j = __ffs(bb) - 1; bb &= bb - 1u; const unsigned slot = __hip_atomic_fetch_add(&cnt[j], 1u, __ATOMIC_RELAXED, __HIP_MEMORY_SCOPE_WORKGROUP); lst[j * 256 + slot] = (unsigned char)(32 * F.wave + r); } }
    LDS_WAIT(); __syncthreads();
    if (i > 0) {
        LAS unsigned* PS = (LAS unsigned*)(lds + MB_PS);
        LAS float* PM = (LAS float*)(lds + MB_PM);
        const unsigned qbase = (unsigned)WS_Z + (unsigned)(b * SEQ + q0) * (ZLD * 2u) + (unsigned)(ZD_Q + hd * 64) * 2u;
        const int tt = F.wave & 3; const bool cw = F.wave < 4;
        fa::Stg<64> s0, s1, s2, s3;
#define MB_LOADBLK(J) { fa::stg_load<64>(s0, ws, koff, ZLD * 2u, voff, ZLD * 2u, 256 * (J), SEQ - 1, F.tid); fa::stg_load<64>(s1, ws, koff, ZLD * 2u, voff, ZLD * 2u, 256 * (J) + 64, SEQ - 1, F.tid); \
                        fa::stg_load<64>(s2, ws, koff, ZLD * 2u, voff, ZLD * 2u, 256 * (J) + 128, SEQ - 1, F.tid); fa::stg_load<64>(s3, ws, koff, ZLD * 2u, voff, ZLD * 2u, 256 * (J) + 192, SEQ - 1, F.tid); }
        MB_LOADBLK(0)
#if FA_PROBE == 9
        unsigned long long pq0 = 0, pq1 = 0, pq2 = 0, pq3 = 0, pqn = 0, tprev_ = 0;
#define MBT(n_) asm volatile("s_waitcnt lgkmcnt(0)" ::: "memory"); const unsigned long long n_ = __builtin_amdgcn_s_memtime();
#else
#define MBT(n_)
#endif
        for (int j = 0; j < i; ++j) {
            MBT(t0_)
            const int n = (int)cnt[j];
            bool colv = cw && r < n; int qsel = colv ? (int)lst[j * 256 + r] : 0;
            bf16x8 qfb[4] = {qf[0], qf[1], qf[2], qf[3]};
            if (cw && n > 0) fa::load_q<64>(qfb, ws, qbase + (unsigned)qsel * (ZLD * 2u), h);
            fa::stg_store<64>(s0, lds + MB_T, F.tid); fa::stg_store<64>(s1, lds + MB_T + 16384, F.tid); fa::stg_store<64>(s2, lds + MB_T + 32768, F.tid); fa::stg_store<64>(s3, lds + MB_T + 49152, F.tid);
#if !(FA_EXP & 4)
            if (j + 1 < i) MB_LOADBLK(j + 1)
#endif
            MBT(t1_)
            LDS_WAIT(); __syncthreads();
            MBT(t2_)
#if FA_PROBE == 9
            if (j > 0) pq0 += t0_ - tprev_; tprev_ = t0_; pqn += 1; pq1 += t1_ - t0_; pq3 += t2_ - t1_;
#endif
            for (int rd = 0; 32 * rd < n; ++rd) {
                MBT(t3_)
                if (rd > 0) { LDS_WAIT(); __syncthreads();
                    colv = cw && (32 * rd + r) < n; qsel = colv ? (int)lst[j * 256 + 32 * rd + r] : 0;
                    if (cw) fa::load_q<64>(qfb, ws, qbase + (unsigned)qsel * (ZLD * 2u), h); }
                if (cw) {
                    SM st; fa::sm_init(st);
                    const LAS char* buf = lds + MB_T + tt * 16384;
                    fa::f32x16 p0, p1; bf16x8 pf[4];
                    fa::score_tile<64, true>(p0, p1, buf, qfb, colv ? sl * (float)(256 * j + 64 * tt - q0 + 4 * h) : fa::MASKV, sl, F.lane);
                    fa::sm_step(st, p0, p1, pf);
                    fa::pv(st.o, buf + 8192, pf, F.lane);
                    const float lp = fa::xhalf_sum(st.l);
                    LAS unsigned* ps = PS + (tt * 32 + r) * 33 + 2 * h;
#pragma unroll
                    for (int db = 0; db < 2; ++db)
#pragma unroll
                        for (int g = 0; g < 4; ++g) { ps[16 * db + 4 * g] = fa::cvtpk(st.o[db][4 * g], st.o[db][4 * g + 1]); ps[16 * db + 4 * g + 1] = fa::cvtpk(st.o[db][4 * g + 2], st.o[db][4 * g + 3]); }
                    if (h == 0) { PM[(tt * 32 + r) * 2] = st.m; PM[(tt * 32 + r) * 2 + 1] = lp; }
                }
                MBT(t4_)
                LDS_WAIT(); __syncthreads();
                MBT(t5_)
#if FA_PROBE == 9
                if (rd == 0) { pq2 += t4_ - t2_; }
#endif
                if (cw) {
                    const int ql = 8 * tt + (F.lane >> 3), l7 = F.lane & 7;
                    if (32 * rd + ql < n) {
                        const int qs = (int)lst[j * 256 + 32 * rd + ql];
                        const float m0 = PM[ql * 2], l0 = PM[ql * 2 + 1], m1 = PM[(32 + ql) * 2], l1 = PM[(32 + ql) * 2 + 1], m2 = PM[(64 + ql) * 2], l2 = PM[(64 + ql) * 2 + 1], m3 = PM[(96 + ql) * 2], l3 = PM[(96 + ql) * 2 + 1];
                        const float ms = MLst[qs * 2], ls = MLst[qs * 2 + 1];
                        const float mn = fmaxf(fmaxf(fmaxf(m0, m1), fmaxf(m2, m3)), ms);
                        const float ea = fa::ex2(ms - mn), e0 = fa::ex2(m0 - mn), e1 = fa::ex2(m1 - mn), e2 = fa::ex2(m2 - mn), e3 = fa::ex2(m3 - mn);
                        LAS float* orow = Ost + qs * MB_OS + 8 * l7;
                        const LAS unsigned* pr = PS + ql * 33 + 4 * l7;
                        float acc8[8];
#pragma unroll
                        for (int x = 0; x < 8; ++x) acc8[x] = orow[x] * ea;
#pragma unroll
                        for (int x = 0; x < 4; ++x) { const unsigned w0 = pr[x], w1 = pr[32 * 33 + x], w2 = pr[64 * 33 + x], w3 = pr[96 * 33 + x];
                            acc8[2 * x] += (__uint_as_float(w0 << 16) * e0 + __uint_as_float(w1 << 16) * e1) + (__uint_as_float(w2 << 16) * e2 + __uint_as_float(w3 << 16) * e3);
                            acc8[2 * x + 1] += (__uint_as_float(w0 & 0xffff0000u) * e0 + __uint_as_float(w1 & 0xffff0000u) * e1) + (__uint_as_float(w2 & 0xffff0000u) * e2 + __uint_as_float(w3 & 0xffff0000u) * e3); }
#pragma unroll
                        for (int x = 0; x < 8; ++x) orow[x] = acc8[x];
                        if (l7 == 0) { MLst[qs * 2] = mn; MLst[qs * 2 + 1] = ls * ea + ((l0 * e0 + l1 * e1) + (l2 * e2 + l3 * e3)); }
                    }
                }
            }
        }
#undef MB_LOADBLK
        LDS_WAIT(); __syncthreads();
#if FA_PROBE == 9
        if (F.lane == 0 && F.wave == FA_KO) { unsigned long long* pp = (unsigned long long*)((GAS char*)ws + 32768);
            atomicAdd(pp + 0, pq0); atomicAdd(pp + 1, pq1); atomicAdd(pp + 2, pq2); atomicAdd(pp + 3, pqn); atomicAdd(pp + 4, pq3); }
#endif
    }
    { const int q = 32 * F.wave + (F.lane >> 1), hf = F.lane & 1; const float inv = 1.f / fmaxf(MLst[q * 2 + 1], fa::TINYF);
      const LAS float* orow = Ost + q * MB_OS + 32 * hf;
      GAS char* dst = ws + ((unsigned)WS_O + (unsigned)(b * SEQ + q0 + q) * 2048u + (unsigned)(768 + hd * 64 + 32 * hf) * 2u);
#pragma unroll
      for (int c = 0; c < 4; ++c) { float x[8];
#pragma unroll
          for (int e = 0; e < 8; ++e) x[e] = orow[8 * c + e] * inv;
          fa::u32x4 w; w.x = fa::cvtpk(x[0], x[1]); w.y = fa::cvtpk(x[2], x[3]); w.z = fa::cvtpk(x[4], x[5]); w.w = fa::cvtpk(x[6], x[7]);
          *(GAS fa::u32x4*)(dst + 16 * c) = w; } }
    LDS_WAIT(); __syncthreads();
}
__device__ __forceinline__ void u_swa(const Frame& F0, int b, int kvh, int u, const float* sinks) {
    UNIT_BEGIN();
    GAS char* ws = (GAS char*)F.ws;
    const int r = F.lane & 31, h = F.lane >> 5, q0 = 128 * u, wq0 = q0 + 16 * F.wave, tq = wq0 + (r >> 1), hd = kvh * 2 + (r & 1);
    bf16x8 qf[4]; fa::load_q<64>(qf, ws, (unsigned)WS_Z + (unsigned)(b * SEQ + tq) * (ZLD * 2u) + (unsigned)(ZA_Q + hd * 64) * 2u, h);
    const float sl = slope2_of(3 * hd);
    const int t0 = (2 * u - 2) > 0 ? (2 * u - 2) : 0, nt = 2 * u + 2 - t0;
    SM st; fa::sm_init(st);
    LAS char* lds = (LAS char*)F.lds;
    fa::fa_loop<64, true>(st, qf, ws, (unsigned)WS_Z + (unsigned)b * (SEQ * ZLD * 2u) + (unsigned)(ZA_K + kvh * 64) * 2u, ZLD * 2u, (unsigned)WS_Z + (unsigned)b * (SEQ * ZLD * 2u) + (unsigned)(ZA_V + kvh * 64) * 2u, ZLD * 2u, SEQ - 1, nt,
        [=](int t) { return 64 * (t0 + t); },
        [=](int t, bool& act, bool& ew, float& cb, int& lo, int& hi) { const int key0 = 64 * (t0 + t); act = (key0 <= wq0 + 15) && (key0 + 63 >= wq0 - 127); ew = true;
            cb = sl * (float)(key0 - q0 + 4 * h); lo = tq - 127 - key0; hi = tq - key0; },
        sl, lds + FA_STAGES, F.tid, F.lane);
    const float sk = sinks[hd] * LOG2E + sl * (float)(tq - q0), mf = fmaxf(st.m, sk), a = fa::ex2(st.m - mf);
    const float ltot = fa::xhalf_sum(st.l) * a + fa::ex2(sk - mf), inv = a / fmaxf(ltot, fa::TINYF);
    f32x16 acc[2]; acc[0] = st.o[0] * inv; acc[1] = st.o[1] * inv;
    fa::store_out(acc, lds + FA_OST + F.wave * 32 * fa::OSTR, ws, [=](int col) { return (unsigned)WS_O + (unsigned)(b * SEQ + wq0 + (col >> 1)) * 2048u + (unsigned)((kvh * 2 + (col & 1)) * 64) * 2u; }, F.lane);
}
__device__ __forceinline__ void u_nsa(const Frame& F0, int b, int qi) {
    UNIT_BEGIN();
    GAS char* ws = (GAS char*)F.ws;
    const unsigned KC = (unsigned)WS_KCMP + (unsigned)b * (512u * 128u), VC = (unsigned)WS_VCMP + (unsigned)b * (512u * 128u), ZB = (unsigned)WS_Z + (unsigned)b * (SEQ * ZLD * 2u);
    const int r = F.lane & 31, h = F.lane >> 5, q0 = 64 * qi, wq0 = q0 + 8 * F.wave, qloc = 8 * F.wave + (r >> 2), tq = q0 + qloc, hd = r & 3;
    const unsigned zrow_off = ZB + (unsigned)tq * (ZLD * 2u); const GAS bf16* zrow = (const GAS bf16*)(ws + zrow_off);
    bf16x8 qf[4]; fa::load_q<64>(qf, ws, zrow_off + (unsigned)(ZC_Q + hd * 64) * 2u, h);
    const float sl = slope2_of(1 + 3 * hd);
    const float g0 = 1.f / (1.f + __expf(-bf2f(zrow[ZC_GL + hd]))), g1 = 1.f / (1.f + __expf(-bf2f(zrow[ZC_GL + 4 + hd]))), g2 = 1.f / (1.f + __expf(-bf2f(zrow[ZC_GL + 8 + hd])));
    LAS char* lds = (LAS char*)F.lds;
    LAS float* impA = (LAS float*)(lds + FA_IMP) + F.wave * 1024;
    LAS float* impB = (LAS float*)(lds + FA_OST) + F.wave * 1024;
    LAS unsigned* selm = (LAS unsigned*)(lds + FA_SELM);
    LAS unsigned* um = (LAS unsigned*)(lds + FA_UM);
    LAS float* vals = (LAS float*)(lds + FA_VALS) + F.wave * 128;
    if (F.tid < 4) um[F.tid] = 0u;
    const unsigned parko = (unsigned)WS_PARK + (unsigned)((F.bx * NWAVES + F.wave) * 2 * 32 * 64 + F.lane) * 4u;
#define PARK(i) (*(GAS float*)(ws + (parkl + (unsigned)((i) * 256))))
    const int ntc = ((4 * qi + 3) >> 6) + 1;
    const int cvis = (tq - 31) >> 4;
    const int cvis_min = (q0 - 31) >> 4;
    const float slc = 16.f * sl;
    SM st; fa::sm_init(st);
    fa::fa_loop<64, true>(st, qf, ws, KC, 128u, VC, 128u, 510, ntc,
        [](int t) { return 64 * t; },
        [=](int t, bool& act, bool& ew, float& cb, int& lo, int& hi) { const int c0 = 64 * t; act = true; ew = c0 + 63 > cvis_min; cb = slc * (float)(c0 - 4 * qi + 4 * h); lo = -100000; hi = cvis - c0; },
        slc, lds + FA_STAGES, F.tid, F.lane);
    { f32x16 t2[2] = {f32x16{}, f32x16{}}; fa::sm_finish(st, g0, t2); unsigned parkl = parko; asm volatile("" : "+v"(parkl));
#pragma unroll
      for (int v = 0; v < 16; ++v) { PARK(v) = t2[0][v]; PARK(16 + v) = t2[1][v]; } }
    {
        const float mfin = st.m, invl = 1.f / fmaxf(fa::xhalf_sum(st.l), fa::TINYF);
        constexpr int STG = fa::stage_bytes<64>();
        fa::Stg<64> sg;
        fa::stg_load<64>(sg, ws, KC, 128u, VC, 128u, 0, 510, F.tid); fa::stg_store<64>(sg, lds + FA_STAGES, F.tid); __syncthreads();
        for (int t = 0; t < ntc; ++t) {
            const LAS char* buf = lds + FA_STAGES + (t & 1) * STG;
            if (t + 1 < ntc) fa::stg_load<64>(sg, ws, KC, 128u, VC, 128u, 64 * (t + 1), 510, F.tid);
            const int c0 = 64 * t;
            f32x16 p0, p1; fa::score_tile<64, true>(p0, p1, buf, qf, slc * (float)(c0 - 4 * qi + 4 * h), slc, F.lane);
            if (c0 + 63 > cvis_min) fa::mask_ew(p0, p1, -100000, cvis - c0, h);
#pragma unroll
            for (int kh = 0; kh < 2; ++kh)
#pragma unroll
                for (int g = 0; g < 4; ++g) {
                    float e0, e1, e2, e3;
                    if (kh == 0) { e0 = fa::ex2(p0[4 * g] - mfin); e1 = fa::ex2(p0[4 * g + 1] - mfin); e2 = fa::ex2(p0[4 * g + 2] - mfin); e3 = fa::ex2(p0[4 * g + 3] - mfin); }
                    else { e0 = fa::ex2(p1[4 * g] - mfin); e1 = fa::ex2(p1[4 * g + 1] - mfin); e2 = fa::ex2(p1[4 * g + 2] - mfin); e3 = fa::ex2(p1[4 * g + 3] - mfin); }
                    e0 *= invl; e1 *= invl; e2 *= invl; e3 *= invl;
                    float s4 = ((e0 + e1) + e2) + e3;
                    s4 += __shfl_xor(s4, 1); s4 += __shfl_xor(s4, 2); e3 += __shfl_xor(e3, 1); e3 += __shfl_xor(e3, 2);
                    const int j = 16 * t + 8 * kh + 2 * g + h;
                    if (hd == 0) { impA[(r >> 2) * 128 + j] = s4; impB[(r >> 2) * 128 + j] = e3; }
                }
            if (t + 1 < ntc) fa::stg_store<64>(sg, lds + FA_STAGES + ((t + 1) & 1) * STG, F.tid);
            __syncthreads();
        }
    }
    {
        const int cur = qi;
        for (int qq = 0; qq < 8; ++qq) {
            unsigned long long m0, m1;
            if (cur < 16) { m0 = (cur >= 63) ? ~0ull : ((1ull << (cur + 1)) - 1ull); m1 = 0ull; }
            else {
                const int ja = F.lane, jb2 = F.lane + 64;
                const bool fca = (ja == 0 || ja == cur || ja == cur - 1), fcb = (jb2 == cur || jb2 == cur - 1);
                const float va = impA[qq * 128 + ja] + (ja > 0 ? impB[qq * 128 + ja - 1] : 0.f), vb = impA[qq * 128 + jb2] + impB[qq * 128 + jb2 - 1];
                const unsigned ka = (ja <= cur && !fca) ? (__float_as_uint(va) + 1u) : 0u, kb = (jb2 <= cur && !fcb) ? (__float_as_uint(vb) + 1u) : 0u;
                unsigned T = 0u;
                for (int bit = 31; bit >= 0; --bit) { const unsigned cand = T | (1u << bit); const int c = __popcll(__ballot(ka >= cand)) + __popcll(__ballot(kb >= cand)); if (c >= 13) T = cand; }
                if (T == 0u) T = 1u;
                const unsigned long long ga = __ballot(ka > T), gb = __ballot(kb > T), ea = __ballot(ka == T), eb = __ballot(kb == T);
                const int R = 13 - (__popcll(ga) + __popcll(gb)), na = __popcll(ea);
                const int pa = (int)__builtin_amdgcn_mbcnt_hi((unsigned)(ea >> 32), __builtin_amdgcn_mbcnt_lo((unsigned)ea, 0u)), pb = (int)__builtin_amdgcn_mbcnt_hi((unsigned)(eb >> 32), __builtin_amdgcn_mbcnt_lo((unsigned)eb, 0u));
                m0 = ga | __ballot(ka == T && pa < R) | 1ull; m1 = gb | __ballot(kb == T && (na + pb) < R);
                if (cur < 64) m0 |= 1ull << cur; else m1 |= 1ull << (cur - 64);
                if (cur - 1 < 64) m0 |= 1ull << (cur - 1); else m1 |= 1ull << (cur - 65);
            }
            if (F.lane == 0) { LAS unsigned* sp = selm + (8 * F.wave + qq) * 4; sp[0] = (unsigned)m0; sp[1] = (unsigned)(m0 >> 32); sp[2] = (unsigned)m1; sp[3] = (unsigned)(m1 >> 32);
                __hip_atomic_fetch_or(&um[0], (unsigned)m0, __ATOMIC_RELAXED, __HIP_MEMORY_SCOPE_WORKGROUP); __hip_atomic_fetch_or(&um[1], (unsigned)(m0 >> 32), __ATOMIC_RELAXED, __HIP_MEMORY_SCOPE_WORKGROUP); __hip_atomic_fetch_or(&um[2], (unsigned)m1, __ATOMIC_RELAXED, __HIP_MEMORY_SCOPE_WORKGROUP); __hip_atomic_fetch_or(&um[3], (unsigned)(m1 >> 32), __ATOMIC_RELAXED, __HIP_MEMORY_SCOPE_WORKGROUP); }
        }
        LDS_WAIT(); __syncthreads();
    }
    {
        const unsigned uw0 = um[0], uw1 = um[1], uw2 = um[2], uw3 = um[3];
        const LAS unsigned* selq = selm + qloc * 4;
        const int nsel = __builtin_amdgcn_readfirstlane(__popc(uw0) + __popc(uw1) + __popc(uw2) + __popc(uw3));
        LAS unsigned char* slist = (LAS unsigned char*)(lds + FA_VALS);
        if (F.tid < 128) { const int j = F.tid; const unsigned w = (j < 32) ? uw0 : (j < 64) ? uw1 : (j < 96) ? uw2 : uw3;
            if ((w >> (j & 31)) & 1u) { int pos = __popc(w & ((1u << (j & 31)) - 1u)); if (j >= 32) pos += __popc(uw0); if (j >= 64) pos += __popc(uw1); if (j >= 96) pos += __popc(uw2); slist[pos] = (unsigned char)j; } }
        LDS_WAIT(); __syncthreads();
        fa::sm_init(st);
        fa::fa_loop<64, true>(st, qf, ws, ZB + ZC_KS * 2u, ZLD * 2u, ZB + ZC_VS * 2u, ZLD * 2u, SEQ - 1, nsel,
            [=](int t) { return 64 * (int)slist[t]; },
            [=](int t, bool& act, bool& ew, float& cb, int& lo, int& hi) { const int j = (int)slist[t], key0 = 64 * j; const unsigned mw = selq[j >> 5];
                const bool on = (mw >> (j & 31)) & 1u; act = __any(on) != 0; ew = (j == qi); cb = on ? sl * (float)(key0 - q0 + 4 * h) : fa::MASKV; lo = -100000; hi = tq - key0; },
            sl, lds + FA_STAGES, F.tid, F.lane);
        { f32x16 t2[2] = {f32x16{}, f32x16{}}; fa::sm_finish(st, g1, t2); unsigned parkl = parko; asm volatile("" : "+v"(parkl));
#pragma unroll
          for (int v = 0; v < 16; ++v) { PARK(32 + v) = t2[0][v]; PARK(48 + v) = t2[1][v]; } }
    }
    {
        const int t0 = (qi - 8) > 0 ? (qi - 8) : 0, nt = qi + 1 - t0;
        fa::sm_init(st);
        fa::fa_loop<64, true>(st, qf, ws, ZB + ZC_KW * 2u, ZLD * 2u, ZB + ZC_VW * 2u, ZLD * 2u, SEQ - 1, nt,
            [=](int t) { return 64 * (t0 + t); },
            [=](int t, bool& act, bool& ew, float& cb, int& lo, int& hi) { const int j = t0 + t, key0 = 64 * j; act = true; ew = (j == qi) || (j == qi - 8);
                cb = sl * (float)(key0 - q0 + 4 * h); lo = tq - 511 - key0; hi = tq - key0; },
            sl, lds + FA_STAGES, F.tid, F.lane);
    }
    f32x16 acc[2] = {f32x16{}, f32x16{}}; fa::sm_finish(st, g2, acc); unsigned parkl = parko; asm volatile("" : "+v"(parkl));
#pragma unroll
    for (int v = 0; v < 16; ++v) { acc[0][v] += PARK(v) + PARK(32 + v); acc[1][v] += PARK(16 + v) + PARK(48 + v); }
#undef PARK
    fa::store_out(acc, lds + FA_OST + F.wave * 32 * fa::OSTR, ws, [=](int col) { return (unsigned)WS_O + (unsigned)(b * SEQ + wq0 + (col >> 2)) * 2048u + (unsigned)(512 + (col & 3) * 64) * 2u; }, F.lane);
}

__device__ __forceinline__ void p_attn(Frame& F, const float* sinks, int mskip) {
    const int id = F.vcu;
    if (F.G != 256) return;
    { const int bh = id >> 4, s = id & 15;
#pragma unroll 1
      for (int k = 0; k < (((mskip >> 9) & 1) ? 4 : 2); ++k) u_mla(F, bh >> 2, bh & 3, (k & 1) ? s : 31 - s); }
    { const int bh = id >> 4, s = id & 15;
#pragma unroll 1
      for (int k = 0; k < (((mskip >> 11) & 1) ? 4 : 2); ++k) u_moba(F, bh >> 2, bh & 3, (k & 1) ? s : 31 - s); }
    if (!(mskip & 4)) { const int b = id >> 6, s = id & 63;
#pragma unroll 1
      for (int k = 0; k < (((mskip >> 10) & 1) ? 4 : 2); ++k) u_nsa(F, b, (k & 1) ? s : 127 - s); }
    {
#pragma unroll 1
      for (int k = 0; k < (((mskip >> 8) & 1) ? 4 : 2); ++k) { const int u0 = 2 * id + (k & 1); u_swa(F, u0 >> 7, (u0 >> 6) & 1, u0 & 63, sinks); } }
}
constexpr int PH_PRO = 0, PH_L0 = 1, PH_PER_L = 9, PH_FIN = 19, PH_END = 20;
constexpr int PO_NORM1 = 0, PO_ZG = 1, PO_PREP = 2, PO_UP = 3, PO_ATTN = 4, PO_OG = 5, PO_NORM2 = 6, PO_UPG = 7, PO_DNG = 8;
#ifndef MK_PHASE_MASK
#define MK_PHASE_MASK 0xFFFFFu
#endif

__global__ void __launch_bounds__(NTHR, 2) mega(Args args) {
    extern __shared__ __attribute__((aligned(16))) unsigned char lds_raw[];
    Frame F;
    F.lds = (LAS unsigned char*)lds_raw;
    int wave_s = __builtin_amdgcn_readfirstlane((int)threadIdx.x >> 6); asm volatile("" : "+s"(wave_s));
    F.tid = threadIdx.x; F.lane = F.tid & 63; F.wave = wave_s;
    F.G = gridDim.x; { const int bx = blockIdx.x; F.vcu = (F.G % 8 == 0) ? (bx % 8) * (F.G / 8) + bx / 8 : bx; }
    volatile LAS unsigned* misc = (volatile LAS unsigned*)(F.lds + LDS_MISC);
    if (F.tid < 64) misc[F.tid] = 0u;
    __syncthreads();
    (void)xcd_barrier_post((unsigned*)(args.ws + WS_CTL), misc + 8);
    float* fo; KArgsP ap;
#define KARGS() ({ KArgsP q_ = (KArgsP)__builtin_amdgcn_kernarg_segment_ptr(); asm volatile("" : "+s"(q_)); q_; })
#define IN(k) ({ KArgsP q2_ = KARGS(); q2_->ph_lo <= (k) && (k) < q2_->ph_hi; })
#define PHASE_BEGIN() do { asm volatile("; PHASE_MARK %0" :: "i"(__LINE__)); ap = KARGS(); F.G = gridDim.x; \
        { int w_ = wave_s; asm volatile("" : "+s"(w_)); int t_ = (w_ << 6) | (int)__builtin_amdgcn_mbcnt_hi(~0u, __builtin_amdgcn_mbcnt_lo(~0u, 0u)); asm volatile("" : "+v"(t_)); F.tid = t_; F.lane = t_ & 63; F.wave = w_; } F.ws = ap->ws; int bx_ = (int)blockIdx.x; asm volatile("" : "+s"(bx_)); F.bx = bx_; F.vcu = (F.G % 8 == 0) ? (bx_ % 8) * (F.G / 8) + bx_ / 8 : bx_; fo = ap->out; } while (0)
#define INP(i) (ap->in[i])
#define SEAM(k) do { if (IN(k) && IN((k) + 1)) { XcdBarrier b_; b_.bar = (unsigned*)(KARGS()->ws + WS_CTL); b_.x = xb_xcc_id(); b_.st = (volatile LAS unsigned*)(F.lds + LDS_MISC) + 8; xcd_barrier(b_); } } while (0)

    if (IN(PH_PRO)) { PHASE_BEGIN(); p_prologue(F, ap); }
#ifdef MK_PRO_TWICE
    if (IN(PH_PRO)) { PHASE_BEGIN(); p_prologue(F, ap); }
#endif
    SEAM(PH_PRO);

    { constexpr int l = 0;
        const int pb = PH_L0 + PH_PER_L * l;
#define WB (F.ws + WS_W + (size_t)l * WS_WL)
#define MOD ((const float*)(F.ws + WS_MOD) + (size_t)l * NB * 6 * D)
#define XB ((bf16*)(F.ws + WS_XB))
#define XIN ((l == 0) ? (const void*)INP(0) : (const void*)XB)
#define H ((bf16*)(F.ws + WS_H))
#define Z ((bf16*)(F.ws + WS_Z))
#define OB ((bf16*)(F.ws + WS_O))
#define U ((bf16*)(F.ws + WS_U))

        if (IN(pb + PO_NORM1) && !((KARGS()->skip >> PO_NORM1) & 1)) { PHASE_BEGIN(); p_norm<0, (l != 0)>(F, XIN, INP(2) + l * D, MOD, MOD + D, H, nullptr); }
        SEAM(pb + PO_NORM1);

        if (IN(pb + PO_ZG) && !((KARGS()->skip >> PO_ZG) & 1)) { PHASE_BEGIN();
            pg8::Gemm g{H, (const bf16*)(WB + W_IN), M, ZLD, D, D}; pg8::StaticOrder S; S.init(M, ZLD, F.G, F.bx);
            pg8::EpiBf16<0> E{Z, ZLD, nullptr, 0, 0, 1.f};
            pg8::gemm_phase<pg8::EpiBf16<0>, pg8::StaticOrder, true, true>(F.lds, g, S, E, F.tid);
        }
        SEAM(pb + PO_ZG);

        if (IN(pb + PO_PREP) && !((KARGS()->skip >> PO_PREP) & 1)) { PHASE_BEGIN(); p_prep(F, l); }
        SEAM(pb + PO_PREP);

        if (IN(pb + PO_UP) && !((KARGS()->skip >> PO_UP) & 1)) { PHASE_BEGIN();
            { pg8::Gemm g{Z + ZB_CQ, (const bf16*)(WB + W_UQ), M, 512, 256, ZLD}; pg8::StaticOrder S; S.init(M, 512, F.G, F.bx);
              pg8::EpiBf16<0> E{(bf16*)(F.ws + WS_QM), 512, nullptr, 0, 0, 1.f};
              pg8::gemm_phase<pg8::EpiBf16<0>, pg8::StaticOrder, true, true>(F.lds, g, S, E, F.tid); }
            PHASE_BEGIN();
            { pg8::Gemm g{Z + ZB_CKV, (const bf16*)(WB + W_UKV), M, 512, 256, ZLD}; pg8::StaticOrder S; S.init(M, 512, F.G, F.bx);
              pg8::EpiMlaKV E{(bf16*)(F.ws + WS_KM), (bf16*)(F.ws + WS_VM), (const float*)(F.ws + WS_RSKV)};
              pg8::gemm_phase<pg8::EpiMlaKV, pg8::StaticOrder, true, false>(F.lds, g, S, E, F.tid); }
            PHASE_BEGIN();
            p_compress(F, l);
        }
        SEAM(pb + PO_UP);

        if (IN(pb + PO_ATTN) && !((KARGS()->skip >> PO_ATTN) & 1)) { PHASE_BEGIN(); p_attn(F, INP(8) + l * 4, (ap->skip >> 16) | ((ap->rep >> 20) << 8)); }
        SEAM(pb + PO_ATTN);

        if (IN(pb + PO_OG) && !((KARGS()->skip >> PO_OG) & 1)) { PHASE_BEGIN();
            pg8::Gemm g{OB, (const bf16*)(WB + W_OUT), M, D, D, D}; pg8::StaticOrder S; S.init(M, D, F.G, F.bx);
            pg8::EpiResid<(l != 0)> E{XIN, XB, MOD + 2 * D};
            pg8::gemm_phase<pg8::EpiResid<(l != 0)>, pg8::StaticOrder, true, true>(F.lds, g, S, E, F.tid);
        }
        SEAM(pb + PO_OG);

        if (IN(pb + PO_NORM2) && !((KARGS()->skip >> PO_NORM2) & 1)) { PHASE_BEGIN(); p_norm<0, true>(F, XB, INP(3) + l * D, MOD + 3 * D, MOD + 4 * D, H, nullptr); }
        SEAM(pb + PO_NORM2);

        if (IN(pb + PO_UPG) && !((KARGS()->skip >> PO_UPG) & 1)) { PHASE_BEGIN();
            pg8::Gemm g{H, (const bf16*)(WB + W_UP), M, DFF, D, D}; pg8::StaticOrder S; S.init(M, DFF, F.G, F.bx);
            pg8::EpiRelu2 E{U, DFF};
            pg8::gemm_phase<pg8::EpiRelu2, pg8::StaticOrder, true, true>(F.lds, g, S, E, F.tid);
        }
        SEAM(pb + PO_UPG);

        if (IN(pb + PO_DNG) && !((KARGS()->skip >> PO_DNG) & 1)) { PHASE_BEGIN();
            pg8::Gemm g{U, (const bf16*)(WB + W_DN), M, D, DFF, DFF}; pg8::StaticOrder S; S.init(M, D, F.G, F.bx);
            pg8::EpiResid<true> E{XB, XB, MOD + 5 * D};
            pg8::gemm_phase<pg8::EpiResid<true>, pg8::StaticOrder, true, true>(F.lds, g, S, E, F.tid);
        }
        SEAM(pb + PO_DNG);
    }
    { constexpr int l = 1;
        const int pb = PH_L0 + PH_PER_L * l;
#define WB (F.ws + WS_W + (size_t)l * WS_WL)
#define MOD ((const float*)(F.ws + WS_MOD) + (size_t)l * NB * 6 * D)
#define XB ((bf16*)(F.ws + WS_XB))
#define XIN ((l == 0) ? (const void*)INP(0) : (const void*)XB)
#define H ((bf16*)(F.ws + WS_H))
#define Z ((bf16*)(F.ws + WS_Z))
#define OB ((bf16*)(F.ws + WS_O))
#define U ((bf16*)(F.ws + WS_U))

        if (IN(pb + PO_NORM1) && !((KARGS()->skip >> PO_NORM1) & 1)) { PHASE_BEGIN(); p_norm<0, (l != 0)>(F, XIN, INP(2) + l * D, MOD, MOD + D, H, nullptr); }
        SEAM(pb + PO_NORM1);

        if (IN(pb + PO_ZG) && !((KARGS()->skip >> PO_ZG) & 1)) { PHASE_BEGIN();
            pg8::Gemm g{H, (const bf16*)(WB + W_IN), M, ZLD, D, D}; pg8::StaticOrder S; S.init(M, ZLD, F.G, F.bx);
            pg8::EpiBf16<0> E{Z, ZLD, nullptr, 0, 0, 1.f};
            pg8::gemm_phase<pg8::EpiBf16<0>, pg8::StaticOrder, true, true>(F.lds, g, S, E, F.tid);
        }
        SEAM(pb + PO_ZG);

        if (IN(pb + PO_PREP) && !((KARGS()->skip >> PO_PREP) & 1)) { PHASE_BEGIN(); p_prep(F, l); }
        SEAM(pb + PO_PREP);

        if (IN(pb + PO_UP) && !((KARGS()->skip >> PO_UP) & 1)) { PHASE_BEGIN();
            { pg8::Gemm g{Z + ZB_CQ, (const bf16*)(WB + W_UQ), M, 512, 256, ZLD}; pg8::StaticOrder S; S.init(M, 512, F.G, F.bx);
              pg8::EpiBf16<0> E{(bf16*)(F.ws + WS_QM), 512, nullptr, 0, 0, 1.f};
              pg8::gemm_phase<pg8::EpiBf16<0>, pg8::StaticOrder, true, true>(F.lds, g, S, E, F.tid); }
            PHASE_BEGIN();
            { pg8::Gemm g{Z + ZB_CKV, (const bf16*)(WB + W_UKV), M, 512, 256, ZLD}; pg8::StaticOrder S; S.init(M, 512, F.G, F.bx);
              pg8::EpiMlaKV E{(bf16*)(F.ws + WS_KM), (bf16*)(F.ws + WS_VM), (const float*)(F.ws + WS_RSKV)};
              pg8::gemm_phase<pg8::EpiMlaKV, pg8::StaticOrder, true, false>(F.lds, g, S, E, F.tid); }
            PHASE_BEGIN();
            p_compress(F, l);
        }
        SEAM(pb + PO_UP);

        if (IN(pb + PO_ATTN) && !((KARGS()->skip >> PO_ATTN) & 1)) { PHASE_BEGIN(); p_attn(F, INP(8) + l * 4, (ap->skip >> 16) | ((ap->rep >> 20) << 8)); }
        SEAM(pb + PO_ATTN);

        if (IN(pb + PO_OG) && !((KARGS()->skip >> PO_OG) & 1)) { PHASE_BEGIN();
            pg8::Gemm g{OB, (const bf16*)(WB + W_OUT), M, D, D, D}; pg8::StaticOrder S; S.init(M, D, F.G, F.bx);
            pg8::EpiResid<(l != 0)> E{XIN, XB, MOD + 2 * D};
            pg8::gemm_phase<pg8::EpiResid<(l != 0)>, pg8::StaticOrder, true, true>(F.lds, g, S, E, F.tid);
        }
        SEAM(pb + PO_OG);

        if (IN(pb + PO_NORM2) && !((KARGS()->skip >> PO_NORM2) & 1)) { PHASE_BEGIN(); p_norm<0, true>(F, XB, INP(3) + l * D, MOD + 3 * D, MOD + 4 * D, H, nullptr); }
        SEAM(pb + PO_NORM2);

        if (IN(pb + PO_UPG) && !((KARGS()->skip >> PO_UPG) & 1)) { PHASE_BEGIN();
            pg8::Gemm g{H, (const bf16*)(WB + W_UP), M, DFF, D, D}; pg8::StaticOrder S; S.init(M, DFF, F.G, F.bx);
            pg8::EpiRelu2 E{U, DFF};
            pg8::gemm_phase<pg8::EpiRelu2, pg8::StaticOrder, true, true>(F.lds, g, S, E, F.tid);
        }
        SEAM(pb + PO_UPG);

        if (IN(pb + PO_DNG) && !((KARGS()->skip >> PO_DNG) & 1)) { PHASE_BEGIN();
            pg8::Gemm g{U, (const bf16*)(WB + W_DN), M, D, DFF, DFF}; pg8::StaticOrder S; S.init(M, D, F.G, F.bx);
            pg8::EpiResid<true> E{XB, XB, MOD + 5 * D};
            pg8::gemm_phase<pg8::EpiResid<true>, pg8::StaticOrder, true, true>(F.lds, g, S, E, F.tid);
        }
        SEAM(pb + PO_DNG);
    }
    if (IN(PH_FIN)) { PHASE_BEGIN(); p_norm<1, true>(F, (const void*)(F.ws + WS_XB), INP(21), nullptr, nullptr, nullptr, fo); }
#undef IN
#undef SEAM
}
}
extern "C" void kernel_launch(void* const* d_in, const int* in_sizes, int n_in, void* d_out, int out_size, void* d_ws, size_t ws_size, hipStream_t stream) {
    using namespace mk;
    static int grid = 0;
    if (grid == 0) {
        int dev = 0, cus = 0;
        if (hipGetDevice(&dev) != hipSuccess || hipDeviceGetAttribute(&cus, hipDeviceAttributeMultiprocessorCount, dev) != hipSuccess) { grid = -1; return; }
        if (hipFuncSetAttribute((const void*)mega, hipFuncAttributeMaxDynamicSharedMemorySize, LDS_BYTES) != hipSuccess) { grid = -1; return; }
        (void)hipGetLastError();
        grid = cus;
    }
    if (grid < 0) return;
    (void)in_sizes; (void)n_in; (void)out_size; (void)ws_size;
    Args a{};
    for (int i = 0; i < 22; ++i) a.in[i] = (const float*)d_in[i];
    a.out = (float*)d_out; a.ws = (unsigned char*)d_ws; a.skip = 0; a.rep = MK_REP;
    auto launch = [&](int lo, int hi) {
        (void)hipMemsetAsync((char*)d_ws + WS_CTL, 0, CTL_ZERO_BYTES, stream);
        a.ph_lo = lo; a.ph_hi = hi;
        hipLaunchKernelGGL(mega, dim3(grid), dim3(NTHR), LDS_BYTES, stream, a);
    };
    launch(0, PH_END);
}
```

```cpp
#include <hip/hip_runtime.h>
#include <cstdio>
#include <cstdint>
#include <math.h>
#define MK_PQ 500.0
#define FA_EXP 2
#define FA_PROBE 0
#define MK_PROBE_IDX 0
#define FA_KO 0
#define MK_MODE 0
#define MK_NAIVE_MASK 0
#define MK_SKIP 0
#define MK_SPLIT 0
#define MK_DBG_PHASE 0
#define MK_DBG_TEST 0
#define MK_REP 0
namespace pg8 {
#define PG8_LAS __attribute__((address_space(3)))
typedef unsigned short bf16_t;
typedef short bf16x8 __attribute__((ext_vector_type(8)));
typedef float f32x4 __attribute__((ext_vector_type(4)));
typedef unsigned u32x4 __attribute__((ext_vector_type(4)));
constexpr int BM = 256, BK = 64, HALF = 128, HTB = HALF * BK * 2  , STAGE_BYTES = 8 * HTB, NXCD = 8, WGM = 8;

__host__ __device__ __forceinline__ int lds_byte(int r, int c) { const int st = (r >> 4) * 2 + (c >> 5), rr = r & 15, cc = c & 31, ob = rr * 64 + cc * 2; return st * 1024 + (ob ^ (((ob >> 9) & 1) << 5)); }
__host__ __device__ __forceinline__ void stage_rc(int b, int& R, int& C) { const int st = b / 1024, sb = b % 1024, swz = sb ^ (((sb >> 9) & 1) << 5); R = (st >> 1) * 16 + swz / 64; C = (st & 1) * 32 + (swz % 64) / 2; }
__host__ __device__ __forceinline__ int perm32(int rho) { const int n = rho >> 4, i = rho & 15; return 8 * (i >> 2) + 4 * n + (i & 3); }

struct Unit { int pm, pn; };
struct Gemm { const bf16_t* A; const bf16_t* Bt; int M, N, K, lda; };

struct StaticOrder {
    int nM, nN, nwg, G, c;
    __host__ __device__ void init(int M, int N, int G_, int c_) { nM = M / BM; nN = N / BM; nwg = nM * nN; G = G_; c = c_; }
    __host__ __device__ bool next(int i, Unit& u) const {
        const long L = (long)i * G + c; if (L >= nwg) return false;
        int wgid = (int)L; { const int q = nwg / NXCD, r = nwg % NXCD, xcd = wgid % NXCD, off = wgid / NXCD; wgid = (xcd < r ? xcd * (q + 1) : r * (q + 1) + (xcd - r) * q) + off; }
        const int nig = WGM * nN, gid = wgid / nig, fm = gid * WGM, gsz = (nM - fm) < WGM ? (nM - fm) : WGM;
        u.pm = fm + ((wgid % nig) % gsz); u.pn = (wgid % nig) / gsz; return true;
    }
    __device__ __forceinline__ void a_ready(const Unit&) const {}
    __device__ __forceinline__ void done(const Unit&) const {}
};
__device__ __forceinline__ unsigned cvt_pk_bf16(float lo, float hi) { unsigned r; asm volatile("v_cvt_pk_bf16_f32 %0, %1, %2" : "=v"(r) : "v"(lo), "v"(hi)); return r; }
typedef float f32x2 __attribute__((ext_vector_type(2)));
__device__ __forceinline__ f32x2 gelu_pk(f32x2 v) {
    const f32x2 av = __builtin_elementwise_abs(v), d = av * 0.2316418882f + 1.0f;
    f32x2 t; t.x = __builtin_amdgcn_rcpf(d.x); t.y = __builtin_amdgcn_rcpf(d.y);
    f32x2 q = t * 0.5307027145f + (-0.7265760135f); q = q * t + 0.7107068705f; q = q * t + (-0.142248368f); q = q * t + 0.127414796f; q = q * t;
    const f32x2 s = (v * v) * (-0.72134752044f);
    f32x2 e; e.x = __builtin_amdgcn_exp2f(s.x); e.y = __builtin_amdgcn_exp2f(s.y);
    const f32x2 m = v * (q * e), r = v - m;
    f32x2 o; o.x = v.x < 0.f ? m.x : r.x; o.y = v.y < 0.f ? m.y : r.y; return o;
}

template <int ACT  > struct EpiBf16 {
    static constexpr bool PERM = true, AFTER_DRAIN = false; static_assert(ACT == 0 || ACT == 1, "EpiBf16: ACT is 0 (none) or 1 (gelu_pk)");
    bf16_t* O; int ldc; const float* bias; int split_cols; size_t split_stride; float scale0;
    __device__ __forceinline__ void operator()(const f32x4 (&acc)[2][2][4][2], const Unit& u, int wr, int wc, int fr, int fq) const {
        const int row0 = u.pm * BM + wr * 64 + fr; int colt = u.pn * BM; bf16_t* base = O;
        float sc = 1.f; if (split_cols) { const int t = colt / split_cols; base += (size_t)t * split_stride; colt -= t * split_cols; if (t == 0) sc = scale0; }
        const int col0 = colt + wc * 32 + 8 * fq, bcol0 = u.pn * BM + wc * 32 + 8 * fq;
        f32x4 bv[2][2];
#pragma unroll
        for (int bj = 0; bj < 2; ++bj)
#pragma unroll
            for (int n = 0; n < 2; ++n) bv[bj][n] = bias ? *(const f32x4*)(bias + bcol0 + bj * HALF + 4 * n) : (f32x4){0.f, 0.f, 0.f, 0.f};
#pragma unroll
        for (int ai = 0; ai < 2; ++ai)
#pragma unroll
            for (int m = 0; m < 4; ++m) { bf16_t* rowp = base + (size_t)(row0 + ai * HALF + m * 16) * ldc + col0;
#pragma unroll
                for (int bj = 0; bj < 2; ++bj) { f32x4 v0 = acc[ai][bj][m][0] + bv[bj][0], v1 = acc[ai][bj][m][1] + bv[bj][1];
                    if (ACT == 1) { f32x2 a = gelu_pk((f32x2){v0[0], v0[1]}), b = gelu_pk((f32x2){v0[2], v0[3]}), c = gelu_pk((f32x2){v1[0], v1[1]}), d = gelu_pk((f32x2){v1[2], v1[3]});
                        v0 = (f32x4){a.x, a.y, b.x, b.y}; v1 = (f32x4){c.x, c.y, d.x, d.y}; }
                    v0 = v0 * sc; v1 = v1 * sc; u32x4 w; w.x = cvt_pk_bf16(v0[0], v0[1]); w.y = cvt_pk_bf16(v0[2], v0[3]); w.z = cvt_pk_bf16(v1[0], v1[1]); w.w = cvt_pk_bf16(v1[2], v1[3]);
                    *(u32x4*)(rowp + bj * HALF) = w; } }
    }
};
template <class Epi, class Sched, bool ALIGN_EPI = false, bool SP2 = false>
__device__ __forceinline__ void gemm_phase(PG8_LAS unsigned char* lds, const Gemm g, const Sched& S, const Epi& E, int tid_in) {
    int tid_ = tid_in; asm volatile("" : "+v"(tid_));
    const int tid = tid_, wid = __builtin_amdgcn_readfirstlane(tid >> 6), lane = tid & 63, wr = wid >> 2, wc = wid & 3, fr = lane & 15, fq = lane >> 4;
    const int K = g.K, nt = K / BK;
    unsigned voffA[2], voffB[2];
#pragma unroll
    for (int i = 0; i < 2; ++i) { int R, C; stage_rc(tid * 16 + i * 8192, R, C); const int Rb = Epi::PERM ? ((R & ~31) + perm32(R & 31)) : R;
        voffA[i] = (unsigned)(R * g.lda + C) * 2u; voffB[i] = (unsigned)(Rb * K + C) * 2u; }
    const size_t kstep = (size_t)(BK * 2);
    const size_t hstep = (size_t)HALF * K * 2;
    const size_t tstep = 2 * hstep; const size_t hstepA = (size_t)HALF * g.lda * 2, tstepA = 2 * hstepA;
    const unsigned ldsw = (unsigned)wid * 1024u;
    const int aoff = lds_byte(wr * 64 + fr, fq * 8), boff = lds_byte(wc * 32 + fr, fq * 8);
#define PG8_SA(b, h) (((b) * 2 + (h)) * HTB)
#define PG8_SB(b, h) ((4 + (b) * 2 + (h)) * HTB)
#define PG8_STAGE(bufoff, gbase, voff) do { _Pragma("unroll") for (int _i = 0; _i < 2; ++_i) \
        __builtin_amdgcn_global_load_lds((const unsigned*)((const char*)(gbase) + (voff)[_i]), (PG8_LAS unsigned*)(lds + (bufoff) + ldsw + _i * 8192), 16, 0, 0); } while (0)
#define PG8_LDA(dst, b, h) do { _Pragma("unroll") for (int m = 0; m < 4; ++m) _Pragma("unroll") for (int k = 0; k < 2; ++k) dst[m][k] = *(const PG8_LAS bf16x8*)(lds + PG8_SA(b, h) + aoff + m * 2048 + k * 1024); } while (0)
#define PG8_LDB(dst, b, h) do { _Pragma("unroll") for (int n = 0; n < 2; ++n) _Pragma("unroll") for (int k = 0; k < 2; ++k) dst[n][k] = *(const PG8_LAS bf16x8*)(lds + PG8_SB(b, h) + boff + n * 2048 + k * 1024); } while (0)
#define PG8_MMA(ai, bj, At, Bt) do { __builtin_amdgcn_s_setprio(1); _Pragma("unroll") for (int m = 0; m < 4; ++m) _Pragma("unroll") for (int n = 0; n < 2; ++n) _Pragma("unroll") for (int k = 0; k < 2; ++k) \
        acc[ai][bj][m][n] = __builtin_amdgcn_mfma_f32_16x16x32_bf16(Bt[n][k], At[m][k], acc[ai][bj][m][n], 0, 0, 0); __builtin_amdgcn_s_setprio(0); } while (0)
#define PG8_WAIT_V(n) asm volatile("s_waitcnt vmcnt(" #n ")" ::: "memory")
#define PG8_WAIT_L(n) asm volatile("s_waitcnt lgkmcnt(" #n ")" ::: "memory")
#define PG8_BAR __builtin_amdgcn_s_barrier()
#define PG8_SCHED __builtin_amdgcn_sched_barrier(0)
    Unit cur, nxt; int ui = 0;
    if (!S.next(0, cur)) return;
    f32x4 acc[2][2][4][2];
#pragma unroll
    for (int a = 0; a < 2; ++a)
#pragma unroll
        for (int b = 0; b < 2; ++b)
#pragma unroll
            for (int m = 0; m < 4; ++m)
#pragma unroll
                for (int n = 0; n < 2; ++n) acc[a][b][m][n] = (f32x4){0.f, 0.f, 0.f, 0.f};
    bf16x8 At[4][2], B0[2][2], B1[2][2];
    const char* cA = (const char*)g.A + (size_t)cur.pm * tstepA; const char* cB = (const char*)g.Bt + (size_t)cur.pn * tstep;
    S.a_ready(cur);
    if constexpr (SP2) {
        PG8_STAGE(PG8_SB(0, 0), cB, voffB); PG8_STAGE(PG8_SB(0, 1), cB + hstep, voffB); PG8_STAGE(PG8_SA(0, 0), cA, voffA); PG8_STAGE(PG8_SA(0, 1), cA + hstepA, voffA);
        if (wr == 1) PG8_BAR;
        PG8_WAIT_V(2); PG8_BAR;
        PG8_STAGE(PG8_SB(1, 0), cB + kstep, voffB); PG8_STAGE(PG8_SA(1, 0), cA + kstep, voffA); PG8_STAGE(PG8_SB(1, 1), cB + hstep + kstep, voffB);
        PG8_WAIT_V(6); PG8_BAR;
    } else {
        PG8_STAGE(PG8_SB(0, 0), cB, voffB); PG8_STAGE(PG8_SA(0, 0), cA, voffA); PG8_STAGE(PG8_SB(0, 1), cB + hstep, voffB); PG8_STAGE(PG8_SA(0, 1), cA + hstepA, voffA);
        if (wr == 1) PG8_BAR;
        PG8_WAIT_V(4); PG8_BAR;
        PG8_STAGE(PG8_SB(1, 0), cB + kstep, voffB); PG8_STAGE(PG8_SA(1, 0), cA + kstep, voffA); PG8_STAGE(PG8_SB(1, 1), cB + hstep + kstep, voffB);
        PG8_WAIT_V(6); PG8_BAR;
    }
    for (;;) {
        const bool has_next = S.next(ui + 1, nxt);
        const char* nA = has_next ? (const char*)g.A + (size_t)nxt.pm * tstepA : cA; const char* nB = has_next ? (const char*)g.Bt + (size_t)nxt.pn * tstep : cB;
        for (int t = 0; t < nt; t += 2) {
            const bool last = (t == nt - 2);
            const char* a1 = cA + (size_t)(t + 1) * kstep;
            const char* a2 = last ? nA : cA + (size_t)(t + 2) * kstep; const char* b2 = last ? nB : cB + (size_t)(t + 2) * kstep;
            const char* a3 = a2 + kstep; const char* b3 = b2 + kstep;
            if (last && has_next) S.a_ready(nxt);
            if constexpr (SP2) {
            PG8_LDB(B0, 0, 0); PG8_LDB(B1, 0, 1); PG8_SCHED; PG8_LDA(At, 0, 0); PG8_STAGE(PG8_SA(1, 1), a1 + hstepA, voffA);
            PG8_WAIT_V(8); PG8_WAIT_L(0); PG8_BAR; PG8_MMA(0, 0, At, B0); PG8_MMA(0, 1, At, B1); PG8_BAR; PG8_SCHED;
            PG8_LDA(At, 0, 1); PG8_STAGE(PG8_SB(0, 0), b2, voffB); PG8_STAGE(PG8_SB(0, 1), b2 + hstep, voffB); PG8_STAGE(PG8_SA(0, 0), a2, voffA);
            PG8_WAIT_V(8); PG8_WAIT_L(0); PG8_BAR; PG8_MMA(1, 0, At, B0); PG8_MMA(1, 1, At, B1); PG8_BAR; PG8_SCHED;
            PG8_LDB(B0, 1, 0); PG8_LDB(B1, 1, 1); PG8_SCHED; PG8_LDA(At, 1, 0); PG8_STAGE(PG8_SA(0, 1), a2 + hstepA, voffA);
            PG8_WAIT_V(8); PG8_WAIT_L(0); PG8_BAR; PG8_MMA(0, 0, At, B0); PG8_MMA(0, 1, At, B1); PG8_BAR; PG8_SCHED;
            PG8_LDA(At, 1, 1); PG8_STAGE(PG8_SB(1, 0), b3, voffB); PG8_STAGE(PG8_SB(1, 1), b3 + hstep, voffB); PG8_STAGE(PG8_SA(1, 0), a3, voffA);
            PG8_WAIT_V(8); PG8_WAIT_L(0); PG8_BAR; PG8_MMA(1, 0, At, B0); PG8_MMA(1, 1, At, B1); PG8_BAR; PG8_SCHED;
            } else {
            PG8_LDB(B0, 0, 0); PG8_SCHED; PG8_LDA(At, 0, 0); PG8_STAGE(PG8_SA(1, 1), a1 + hstepA, voffA);
            PG8_WAIT_L(8); PG8_BAR; PG8_WAIT_L(0); PG8_MMA(0, 0, At, B0); PG8_BAR; PG8_SCHED;
            PG8_LDB(B1, 0, 1); PG8_STAGE(PG8_SB(0, 0), b2, voffB);
            PG8_BAR; PG8_WAIT_L(0); PG8_MMA(0, 1, At, B1); PG8_BAR;
            PG8_LDA(At, 0, 1); PG8_STAGE(PG8_SA(0, 0), a2, voffA);
            PG8_BAR; PG8_WAIT_L(0); PG8_MMA(1, 0, At, B0); PG8_BAR; PG8_SCHED;
            PG8_STAGE(PG8_SB(0, 1), b2 + hstep, voffB);
            PG8_WAIT_V(6); PG8_BAR; PG8_MMA(1, 1, At, B1); PG8_BAR;
            PG8_LDB(B0, 1, 0); PG8_SCHED; PG8_LDA(At, 1, 0); PG8_STAGE(PG8_SA(0, 1), a2 + hstepA, voffA);
            PG8_WAIT_L(8); PG8_BAR; PG8_WAIT_L(0); PG8_MMA(0, 0, At, B0); PG8_BAR; PG8_SCHED;
            PG8_LDB(B1, 1, 1); PG8_STAGE(PG8_SB(1, 0), b3, voffB);
            PG8_BAR; PG8_WAIT_L(0); PG8_MMA(0, 1, At, B1); PG8_BAR;
            PG8_LDA(At, 1, 1); PG8_STAGE(PG8_SA(1, 0), a3, voffA);
            PG8_BAR; PG8_WAIT_L(0); PG8_MMA(1, 0, At, B0); PG8_BAR; PG8_SCHED;
            PG8_STAGE(PG8_SB(1, 1), b3 + hstep, voffB);
            PG8_WAIT_V(6); PG8_BAR; PG8_MMA(1, 1, At, B1); PG8_BAR;
            }
        }
        if constexpr (ALIGN_EPI) { if (wr == 0) PG8_BAR; }
        if constexpr (!Epi::AFTER_DRAIN) { E(acc, cur, wr, wc, fr, fq); S.done(cur); }
        if (!has_next) break;
#pragma unroll
        for (int a = 0; a < 2; ++a)
#pragma unroll
            for (int b = 0; b < 2; ++b)
#pragma unroll
                for (int m = 0; m < 4; ++m)
#pragma unroll
                    for (int n = 0; n < 2; ++n) acc[a][b][m][n] = (f32x4){0.f, 0.f, 0.f, 0.f};
        cur = nxt; cA = nA; cB = nB; ++ui;
        if constexpr (ALIGN_EPI) { if (wr == 1) PG8_BAR; }
    }
    PG8_WAIT_V(0);
    if constexpr (!ALIGN_EPI) { if (wr == 0) PG8_BAR; }
    PG8_BAR;
    if constexpr (Epi::AFTER_DRAIN) { E.fused(acc, cur, wr, wc, fr, fq, lds, wid, lane); S.done(cur); }
#undef PG8_SA
#undef PG8_SB
#undef PG8_STAGE
#undef PG8_LDA
#undef PG8_LDB
#undef PG8_MMA
#undef PG8_WAIT_V
#undef PG8_WAIT_L
#undef PG8_BAR
#undef PG8_SCHED
}
}
namespace pg8 {
template <class T> __device__ __forceinline__ T* uni_ptr(T* p) {
    const unsigned long long v = (unsigned long long)p; unsigned lo = __builtin_amdgcn_readfirstlane((unsigned)v), hi = __builtin_amdgcn_readfirstlane((unsigned)(v >> 32)); asm volatile("" : "+s"(lo), "+s"(hi)); return (T*)(((unsigned long long)hi << 32) | lo); }
template <bool XB16> struct EpiResid {
    static constexpr bool PERM = true, AFTER_DRAIN = false;
    const void* xin_; bf16_t* out_; const float* gate_;
    __device__ __forceinline__ void operator()(const f32x4 (&acc)[2][2][4][2], const Unit& u, int wr, int wc, int fr, int fq) const {
        const void* xin = uni_ptr(xin_); bf16_t* out = uni_ptr(out_); const float* gate = uni_ptr(gate_);
        const int row0 = u.pm * BM + wr * 64 + fr, col0 = u.pn * BM + wc * 32 + 8 * fq;
        const float* gp = gate + (size_t)(u.pm >> 5) * 6144 + col0;
        f32x4 gv[2][2];
#pragma unroll
        for (int bj = 0; bj < 2; ++bj)
#pragma unroll
            for (int n = 0; n < 2; ++n) gv[bj][n] = *(const f32x4*)(gp + bj * HALF + 4 * n);
#pragma unroll
        for (int ai = 0; ai < 2; ++ai)
#pragma unroll
            for (int m = 0; m < 4; ++m) { const size_t off = (size_t)(row0 + ai * HALF + m * 16) * 1024 + col0;
#pragma unroll
                for (int bj = 0; bj < 2; ++bj) { f32x4 x0, x1;
                    if (XB16) { const u32x4 xr = *(const u32x4*)((const bf16_t*)xin + off + bj * HALF);
                        x0 = (f32x4){__uint_as_float(xr.x << 16), __uint_as_float(xr.x & 0xffff0000u), __uint_as_float(xr.y << 16), __uint_as_float(xr.y & 0xffff0000u)};
                        x1 = (f32x4){__uint_as_float(xr.z << 16), __uint_as_float(xr.z & 0xffff0000u), __uint_as_float(xr.w << 16), __uint_as_float(xr.w & 0xffff0000u)}; }
                    else { x0 = *(const f32x4*)((const float*)xin + off + bj * HALF); x1 = *(const f32x4*)((const float*)xin + off + bj * HALF + 4); }
                    const f32x4 y0 = x0 + gv[bj][0] * acc[ai][bj][m][0], y1 = x1 + gv[bj][1] * acc[ai][bj][m][1];
                    u32x4 w; w.x = cvt_pk_bf16(y0[0], y0[1]); w.y = cvt_pk_bf16(y0[2], y0[3]); w.z = cvt_pk_bf16(y1[0], y1[1]); w.w = cvt_pk_bf16(y1[2], y1[3]);
                    *(u32x4*)(out + off + bj * HALF) = w; }
                if (m & 1) asm volatile("" ::: "memory"); }
    }
};
struct EpiRelu2 {
    static constexpr bool PERM = true, AFTER_DRAIN = false;
    bf16_t* O_; int ldc;
    __device__ __forceinline__ void operator()(const f32x4 (&acc)[2][2][4][2], const Unit& u, int wr, int wc, int fr, int fq) const {
        bf16_t* O = uni_ptr(O_);
        const int row0 = u.pm * BM + wr * 64 + fr, col0 = u.pn * BM + wc * 32 + 8 * fq;
#pragma unroll
        for (int ai = 0; ai < 2; ++ai)
#pragma unroll
            for (int m = 0; m < 4; ++m) { bf16_t* rowp = O + (size_t)(row0 + ai * HALF + m * 16) * ldc + col0;
#pragma unroll
                for (int bj = 0; bj < 2; ++bj) { f32x4 v0 = acc[ai][bj][m][0], v1 = acc[ai][bj][m][1];
                    v0 = __builtin_elementwise_max(v0, (f32x4){0.f, 0.f, 0.f, 0.f}); v1 = __builtin_elementwise_max(v1, (f32x4){0.f, 0.f, 0.f, 0.f}); v0 = v0 * v0; v1 = v1 * v1;
                    u32x4 w; w.x = cvt_pk_bf16(v0[0], v0[1]); w.y = cvt_pk_bf16(v0[2], v0[3]); w.z = cvt_pk_bf16(v1[0], v1[1]); w.w = cvt_pk_bf16(v1[2], v1[3]);
                    *(u32x4*)(rowp + bj * HALF) = w; } }
    }
};
struct EpiMlaQ {
    static constexpr bool PERM = true, AFTER_DRAIN = false;
    bf16_t* QM_;
    __device__ __forceinline__ void operator()(const f32x4 (&acc)[2][2][4][2], const Unit& u, int wr, int wc, int fr, int fq) const {
        bf16_t* QM = uni_ptr(QM_);
        const int row0 = u.pm * BM + wr * 64 + fr, cw = wc * 32 + 8 * fq;
        const int nbj = (u.pn != 0) ? 1 : 2;
#pragma unroll
        for (int ai = 0; ai < 2; ++ai)
#pragma unroll
            for (int m = 0; m < 4; ++m) { bf16_t* qr = QM + (size_t)(row0 + ai * HALF + m * 16) * 384 + u.pn * 256 + cw;
#pragma unroll
                for (int bj = 0; bj < 2; ++bj) if (bj < nbj) { const f32x4 v0 = acc[ai][bj][m][0], v1 = acc[ai][bj][m][1];
                    u32x4 o; o.x = cvt_pk_bf16(v0[0], v0[1]); o.y = cvt_pk_bf16(v0[2], v0[3]); o.z = cvt_pk_bf16(v1[0], v1[1]); o.w = cvt_pk_bf16(v1[2], v1[3]);
                    *(u32x4*)(qr + bj * HALF) = o; } }
    }
};
struct EpiMlaKV {
    static constexpr bool PERM = true, AFTER_DRAIN = false;
    bf16_t* KM_; bf16_t* VM_; const float* rskv_;
    __device__ __forceinline__ void operator()(const f32x4 (&acc)[2][2][4][2], const Unit& u, int wr, int wc, int fr, int fq) const {
        bf16_t* KM = uni_ptr(KM_); bf16_t* VM = uni_ptr(VM_); const float* rskv = uni_ptr(rskv_);
        const int row0 = u.pm * BM + wr * 64 + fr, w = wc * 32 + 8 * fq;
        const bool isk = wc < 2;
#pragma unroll
        for (int ai = 0; ai < 2; ++ai)
#pragma unroll
            for (int m = 0; m < 4; ++m) { const int row = row0 + ai * HALF + m * 16; const float rs = rskv[row];
#pragma unroll
                for (int bj = 0; bj < 2; ++bj) { const int head = u.pn * 2 + bj;
                    const f32x4 v0 = acc[ai][bj][m][0] * rs, v1 = acc[ai][bj][m][1] * rs;
                    u32x4 o; o.x = cvt_pk_bf16(v0[0], v0[1]); o.y = cvt_pk_bf16(v0[2], v0[3]); o.z = cvt_pk_bf16(v1[0], v1[1]); o.w = cvt_pk_bf16(v1[2], v1[3]);
                    if (isk) *(u32x4*)(KM + (size_t)row * 384 + head * 96 + w) = o; else *(u32x4*)(VM + (size_t)row * 256 + head * 64 + (w - 64)) = o; }
                asm volatile("" ::: "memory"); }
    }
};
}
#define GAS __attribute__((address_space(1)))
#define LAS __attribute__((address_space(3)))
typedef unsigned short bf16;
typedef unsigned v4u __attribute__((ext_vector_type(4)));
typedef float f32x4 __attribute__((ext_vector_type(4)));
typedef short bf16x8 __attribute__((ext_vector_type(8)));
typedef GAS unsigned gu32;
typedef GAS unsigned long long gu64;
#define RLX_AGENT __ATOMIC_RELAXED, __HIP_MEMORY_SCOPE_AGENT
#define LDS_WAIT() asm volatile("s_waitcnt lgkmcnt(0)" ::: "memory")
#define VM_WAIT() asm volatile("s_waitcnt vmcnt(0)" ::: "memory")
__device__ __forceinline__ unsigned long long rt() { return __builtin_amdgcn_s_memrealtime(); }
__device__ __forceinline__ unsigned f2bf(float f) { unsigned u = __builtin_bit_cast(unsigned, f); return (u + 0x7fffu + ((u >> 16) & 1u)) >> 16; }
__device__ __forceinline__ unsigned pk2(float lo, float hi) { return f2bf(lo) | (f2bf(hi) << 16); }

#define XB_TMO      128
#define XB_XCNT(j)  (256  + 64 * (j))
#define XB_XSUB(j)  (1280 + 64 * (j))
#define XB_XGEN(j)  (2304 + 64 * (j))
#define XB_TOP      3328
#define XB_TOPGEN   3392
#define XCD_BAR_WORDS 3456
#define XB_SPIN_CAP (1u << 18)

__device__ __forceinline__ unsigned xb_ld(unsigned* p)              { return __hip_atomic_load(p, __ATOMIC_RELAXED, __HIP_MEMORY_SCOPE_AGENT); }
__device__ __forceinline__ unsigned xb_add(unsigned* p, unsigned v) { return __hip_atomic_fetch_add(p, v, __ATOMIC_RELAXED, __HIP_MEMORY_SCOPE_AGENT); }
__device__ __forceinline__ unsigned xb_xcc_id() { return (unsigned)__builtin_amdgcn_s_getreg((3 << 11) | 20) & 0xFu; }
#define XB_SPIN(cond, bar) do { unsigned _sp = 0; while (cond) { __builtin_amdgcn_s_sleep(1); \
    if ((++_sp & 255u) == 0u) { if (xb_ld(&(bar)[XB_TMO])) break; if (_sp > XB_SPIN_CAP) { atomicAdd(&(bar)[XB_TMO], 1u); break; } } } } while (0)

struct XcdBarrier {
    unsigned* bar; unsigned x;
    volatile LAS unsigned* st;
};

__device__ __forceinline__ XcdBarrier xcd_barrier_post(unsigned* bar, volatile LAS unsigned* st) {
    XcdBarrier b; b.bar = bar; b.x = xb_xcc_id(); b.st = st;
    if (threadIdx.x == 0) (void)xb_add(&bar[XB_XCNT(b.x)], 1u);
    return b;
}
__device__ __forceinline__ void xcd_barrier_complete(unsigned* bar, unsigned x, unsigned& nloc, unsigned& nx) {
    const unsigned G = gridDim.x * gridDim.y * gridDim.z;
    unsigned sum, cnt, mine, sp = 0u;
    for (;;) {
        sum = 0u; cnt = 0u; mine = 0u;
#pragma unroll
        for (unsigned j = 0; j < 16; ++j) { const unsigned c = xb_ld(&bar[XB_XCNT(j)]); sum += c; cnt += (c > 0u) ? 1u : 0u; mine = (j == x) ? c : mine; }
        if (sum == G) break;
        __builtin_amdgcn_s_sleep(1);
        if ((++sp & 255u) == 0u) { if (xb_ld(&bar[XB_TMO])) break; if (sp > XB_SPIN_CAP) { atomicAdd(&bar[XB_TMO], 1u); break; } }
    }
    nloc = mine > 0u ? mine : 1u; nx = cnt > 0u ? cnt : 1u;
}

__device__ __forceinline__ void xcd_barrier(const XcdBarrier& b) {
    asm volatile("s_waitcnt vmcnt(0)" ::: "memory");
    __syncthreads();
    if (threadIdx.x == 0) {
        unsigned* bar = b.bar;
        __builtin_amdgcn_s_waitcnt(0);
        unsigned nloc = b.st[0], nx = b.st[1];
        if (nloc == 0u) { xcd_barrier_complete(bar, b.x, nloc, nx); b.st[0] = nloc; b.st[1] = nx; }
        const unsigned old = xb_add(&bar[XB_XSUB(b.x)], 1u);
        const unsigned gen = old / nloc;
        if (old + 1u == (gen + 1u) * nloc) {
            __builtin_amdgcn_fence(__ATOMIC_RELEASE, "agent");
            asm volatile("s_waitcnt vmcnt(0)" ::: "memory");
            const unsigned og = xb_add(&bar[XB_TOP], 1u);
            const unsigned tg = og / nx;
            if (og + 1u == (tg + 1u) * nx) xb_add(&bar[XB_TOPGEN], 1u);
            else XB_SPIN(xb_ld(&bar[XB_TOPGEN]) == tg, bar);
            __builtin_amdgcn_fence(__ATOMIC_ACQUIRE, "agent");
            xb_add(&bar[XB_XGEN(b.x)], 1u);
            asm volatile("s_waitcnt vmcnt(0)" ::: "memory");
        } else {
            XB_SPIN(xb_ld(&bar[XB_XGEN(b.x)]) == gen, bar);
            __builtin_amdgcn_fence(__ATOMIC_ACQUIRE, "agent");
            asm volatile("s_waitcnt vmcnt(0)" ::: "memory");
        }
    }
    __syncthreads();
}
#ifndef FA_PROBE
#define FA_PROBE 0
#endif
#ifndef FA_EXP
#define FA_EXP 0
#endif
namespace fa {
typedef unsigned short bf16;
typedef short bf16x8 __attribute__((ext_vector_type(8)));
typedef short s16x4 __attribute__((ext_vector_type(4)));
typedef float f32x16 __attribute__((ext_vector_type(16)));
typedef float f32x4v __attribute__((ext_vector_type(4)));
typedef unsigned u32x4 __attribute__((ext_vector_type(4)));
typedef unsigned u32x2 __attribute__((ext_vector_type(2)));
typedef float f32x2_t __attribute__((ext_vector_type(2)));
typedef __bf16 bf16x2_t __attribute__((ext_vector_type(2)));
#define FLAS __attribute__((address_space(3)))
#define FGAS __attribute__((address_space(1)))
constexpr float MASKV = -1e30f, MINIT = -5e29f, TINYF = 1e-30f, LOG2E = 1.4426950408889634f;
constexpr int OSTR = 144;

__device__ __forceinline__ float ex2(float x) { return __builtin_amdgcn_exp2f(x); }
__device__ __forceinline__ unsigned cvtpk(float lo, float hi) { f32x2_t v = {lo, hi}; bf16x2_t b = __builtin_convertvector(v, bf16x2_t); return __builtin_bit_cast(unsigned, b); }
__device__ __forceinline__ float xhalf_max(float m) { auto rr = __builtin_amdgcn_permlane32_swap(__float_as_uint(m), __float_as_uint(m), false, false); return fmaxf(__uint_as_float(rr[0]), __uint_as_float(rr[1])); }
__device__ __forceinline__ float xhalf_sum(float m) { auto rr = __builtin_amdgcn_permlane32_swap(__float_as_uint(m), __float_as_uint(m), false, false); return __uint_as_float(rr[0]) + __uint_as_float(rr[1]); }
__device__ __forceinline__ float bf2f(unsigned short b) { return __uint_as_float((unsigned)b << 16); }

struct SM { float m, l; f32x16 o[2]; };
__device__ __forceinline__ void sm_init(SM& s) { s.m = MINIT; s.l = 0.f; s.o[0] = f32x16{}; s.o[1] = f32x16{}; }

template <int DQ> struct Stg { u32x4 k0, k1, v; };
template <int DQ> __device__ __forceinline__ void stg_load(Stg<DQ>& s, const FGAS char* ws, unsigned koff, unsigned ksb, unsigned voff, unsigned vsb, int key0, int kmax, int tid) {
    const int row = tid >> 3, ch = tid & 7; int kr = key0 + row; kr = kr < kmax ? kr : kmax;
    s.k0 = *(const FGAS u32x4*)(ws + (koff + (unsigned)kr * ksb + (unsigned)ch * 16u));
    s.v = *(const FGAS u32x4*)(ws + (voff + (unsigned)kr * vsb + (unsigned)ch * 16u));
    if (DQ == 96) { if (tid < 256) { const int r2 = tid >> 2, c2 = tid & 3; int k2 = key0 + r2; k2 = k2 < kmax ? k2 : kmax; s.k1 = *(const FGAS u32x4*)(ws + (koff + (unsigned)k2 * ksb + 128u + (unsigned)c2 * 16u)); } }
}
template <int DQ> __device__ __forceinline__ void stg_store(const Stg<DQ>& s, FLAS char* buf, int tid) {
    const int row = tid >> 3, ch = tid & 7, p = ch >> 2, c = ch & 3;
    *(FLAS u32x4*)(buf + p * 4096 + row * 64 + ((c ^ ((row >> 2) & 3)) << 4)) = s.k0;
    *(FLAS u32x4*)(buf + (DQ / 32) * 4096 + row * 128 + ((p ^ ((row >> 1) & 1)) << 6) + (c << 4)) = s.v;
    if (DQ == 96) { if (tid < 256) { const int r2 = tid >> 2, c2 = tid & 3; *(FLAS u32x4*)(buf + 2 * 4096 + r2 * 64 + ((c2 ^ ((r2 >> 2) & 3)) << 4)) = s.k1; } }
}
template <int DQ> constexpr int stage_bytes() { return (DQ / 32) * 4096 + 8192; }

template <int DQ> __device__ __forceinline__ void compute_S(f32x16& p0, f32x16& p1, const FLAS char* buf, const bf16x8 (&qf)[DQ / 16], int lane) {
    const int r = lane & 31, h = lane >> 5, sw = (r >> 2) & 3;
#pragma unroll
    for (int d0 = 0; d0 < DQ / 16; ++d0) {
        const int p = d0 >> 1, c = 2 * (d0 & 1) + h;
        const FLAS char* a = buf + p * 4096 + r * 64 + ((c ^ sw) << 4);
        const bf16x8 a0 = *(const FLAS bf16x8*)a, a1 = *(const FLAS bf16x8*)(a + 2048);
        p0 = __builtin_amdgcn_mfma_f32_32x32x16_bf16(a0, qf[d0], p0, 0, 0, 0);
        p1 = __builtin_amdgcn_mfma_f32_32x32x16_bf16(a1, qf[d0], p1, 0, 0, 0);
    }
#if FA_EXP & 2
    __builtin_amdgcn_sched_group_barrier(0x100, 4, 0);
#pragma unroll
    for (int i = 0; i < DQ / 16 - 2; ++i) { __builtin_amdgcn_sched_group_barrier(0x008, 2, 0); __builtin_amdgcn_sched_group_barrier(0x100, 2, 0); }
    __builtin_amdgcn_sched_group_barrier(0x008, 4, 0);
#endif
}
__device__ __forceinline__ s16x4 vtr(const FLAS char* p) { typedef short v4i16_t __attribute__((ext_vector_type(4))); return __builtin_bit_cast(s16x4, __builtin_amdgcn_ds_read_tr16_b64_v4i16((FLAS v4i16_t*)p)); }
__device__ __forceinline__ void pv(f32x16 (&o)[2], const FLAS char* vbuf, const bf16x8 (&pf)[4], int lane) {
    const int g = lane >> 4, i = lane & 15, q4 = i >> 2, pp = i & 3, h = lane >> 5;
    const int sw = (q4 >> 1) & 1;
#pragma unroll
    for (int db = 0; db < 2; ++db) {
        const FLAS char* base = vbuf + (4 * h + q4) * 128 + ((db ^ sw) << 6) + (16 * (g & 1) + 4 * pp) * 2;
#pragma unroll
        for (int ks = 0; ks < 4; ++ks) {
            const s16x4 lo = vtr(base + ks * 2048), hi = vtr(base + ks * 2048 + 1024);
            const bf16x8 a = (bf16x8){lo[0], lo[1], lo[2], lo[3], hi[0], hi[1], hi[2], hi[3]};
            o[db] = __builtin_amdgcn_mfma_f32_32x32x16_bf16(a, pf[ks], o[db], 0, 0, 0);
        }
    }
#if FA_EXP & 2
    __builtin_amdgcn_sched_group_barrier(0x100, 8, 0);
    __builtin_amdgcn_sched_group_barrier(0x008, 2, 0); __builtin_amdgcn_sched_group_barrier(0x100, 4, 0);
    __builtin_amdgcn_sched_group_barrier(0x008, 2, 0); __builtin_amdgcn_sched_group_barrier(0x100, 4, 0);
    __builtin_amdgcn_sched_group_barrier(0x008, 4, 0);
#endif
}
__device__ __forceinline__ void mask_ew(f32x16& p0, f32x16& p1, int lo, int hi, int h) {
    const int lo2 = lo - 4 * h, hi2 = hi - 4 * h;
#pragma unroll
    for (int v = 0; v < 16; ++v) { const int k0 = (v & 3) + 8 * (v >> 2);
        if (k0 < lo2 || k0 > hi2) p0[v] = MASKV;
        if (k0 + 32 < lo2 || k0 + 32 > hi2) p1[v] = MASKV; }
}
__device__ __forceinline__ void sm_step(SM& st, f32x16& p0, f32x16& p1, bf16x8 (&pf)[4]) {
#define FA_MX3(a, b, c) __builtin_fmaxf(__builtin_fmaxf((a), (b)), (c))
    float ma = FA_MX3(p0[0], p0[1], p1[0]), mb = FA_MX3(p0[2], p0[3], p1[1]); ma = FA_MX3(ma, p1[2], p1[3]);
#pragma unroll
    for (int v = 4; v < 16; v += 4) { ma = FA_MX3(ma, p0[v], p0[v + 1]); mb = FA_MX3(mb, p0[v + 2], p0[v + 3]); ma = FA_MX3(ma, p1[v], p1[v + 1]); mb = FA_MX3(mb, p1[v + 2], p1[v + 3]); }
#undef FA_MX3
    const float mx = xhalf_max(__builtin_fmaxf(ma, mb));
    if (__any(mx > st.m)) {
        const float mn2 = fmaxf(st.m, mx), alpha = ex2(st.m - mn2);
        st.m = mn2; st.l *= alpha; st.o[0] *= alpha; st.o[1] *= alpha;
    }
    const float mn = st.m;
    float s0 = 0.f, s1 = 0.f;
#pragma unroll
    for (int v = 0; v < 16; ++v) { p0[v] = ex2(p0[v] - mn); p1[v] = ex2(p1[v] - mn); s0 += p0[v]; s1 += p1[v]; }
    st.l += s0 + s1;
    u32x4 w;
    w.x = cvtpk(p0[0], p0[1]); w.y = cvtpk(p0[2], p0[3]); w.z = cvtpk(p0[4], p0[5]); w.w = cvtpk(p0[6], p0[7]); pf[0] = __builtin_bit_cast(bf16x8, w);
    w.x = cvtpk(p0[8], p0[9]); w.y = cvtpk(p0[10], p0[11]); w.z = cvtpk(p0[12], p0[13]); w.w = cvtpk(p0[14], p0[15]); pf[1] = __builtin_bit_cast(bf16x8, w);
    w.x = cvtpk(p1[0], p1[1]); w.y = cvtpk(p1[2], p1[3]); w.z = cvtpk(p1[4], p1[5]); w.w = cvtpk(p1[6], p1[7]); pf[2] = __builtin_bit_cast(bf16x8, w);
    w.x = cvtpk(p1[8], p1[9]); w.y = cvtpk(p1[10], p1[11]); w.z = cvtpk(p1[12], p1[13]); w.w = cvtpk(p1[14], p1[15]); pf[3] = __builtin_bit_cast(bf16x8, w);
}
template <int DQ, bool ALIBI> __device__ __forceinline__ void score_tile(f32x16& p0, f32x16& p1, const FLAS char* buf, const bf16x8 (&qf)[DQ / 16], float cb, float sl, int lane) {
    if (ALIBI) {
#pragma unroll
        for (int v = 0; v < 16; ++v) { const float c = (float)((v & 3) + 8 * (v >> 2)); p0[v] = fmaf(sl, c, cb); p1[v] = fmaf(sl, c + 32.f, cb); }
    } else { p0 = f32x16{}; p1 = f32x16{}; }
    compute_S<DQ>(p0, p1, buf, qf, lane);
}
template <int DQ, bool ALIBI> __device__ __forceinline__ void tile_compute(SM& st, const FLAS char* buf, const bf16x8 (&qf)[DQ / 16], float cb, float sl, bool ew, int lo, int hi, int lane) {
    f32x16 p0, p1; bf16x8 pf[4];
    score_tile<DQ, ALIBI>(p0, p1, buf, qf, cb, sl, lane);
    if (ew) mask_ew(p0, p1, lo, hi, lane >> 5);
    sm_step(st, p0, p1, pf);
    pv(st.o, buf + (DQ / 32) * 4096, pf, lane);
}
template <int DQ, bool ALIBI, class K0, class PAR>
__device__ __forceinline__ void fa_loop(SM& st, const bf16x8 (&qf)[DQ / 16], const FGAS char* ws, unsigned koff, unsigned ksb, unsigned voff, unsigned vsb, int kmax, int ntile, K0 k0f, PAR parf, float sl, FLAS char* lds, int tid, int lane) {
    constexpr int STG = stage_bytes<DQ>();
    Stg<DQ> sgA, sgB;
    stg_load<DQ>(sgB, ws, koff, ksb, voff, vsb, k0f(0), kmax, tid); stg_store<DQ>(sgB, lds, tid);
    if (ntile > 1) stg_load<DQ>(sgA, ws, koff, ksb, voff, vsb, k0f(1), kmax, tid);
    if (ntile > 2) stg_load<DQ>(sgB, ws, koff, ksb, voff, vsb, k0f(2), kmax, tid);
    __syncthreads();
#if FA_PROBE && FA_PROBE < 9
    unsigned long long pr_c = 0, pr_w = 0, pr_b = 0, pr_t = 0; const unsigned long long pr_start = __builtin_amdgcn_s_memtime();
#define FA_P0 const unsigned long long q0_ = __builtin_amdgcn_s_memtime();
#define FA_P1 asm volatile("s_waitcnt vmcnt(0)" ::: "memory"); const unsigned long long q1_ = __builtin_amdgcn_s_memtime();
#define FA_P2 asm volatile("s_waitcnt lgkmcnt(0)" ::: "memory"); asm volatile("" : "+v"(st.o[0]), "+v"(st.o[1])); const unsigned long long q2_ = __builtin_amdgcn_s_memtime();
#define FA_P3 const unsigned long long q3_ = __builtin_amdgcn_s_memtime(); pr_w += q1_ - q0_; pr_c += q2_ - q1_; pr_b += q3_ - q2_; pr_t += 1;
#else
#define FA_P0
#define FA_P1
#define FA_P2
#define FA_P3
#endif
#define FA_ITER(SG) { \
        FA_P0 \
        if (t + 1 < ntile) stg_store<DQ>(SG, lds + ((t + 1) & 1) * STG, tid); \
        if (t + 3 < ntile) stg_load<DQ>(SG, ws, koff, ksb, voff, vsb, k0f(t + 3), kmax, tid); \
        FA_P1 \
        bool act, ew; float cb; int lo, hi; \
        parf(t, act, ew, cb, lo, hi); \
        if (act) tile_compute<DQ, ALIBI>(st, lds + (t & 1) * STG, qf, cb, sl, ew, lo, hi, lane); \
        FA_P2 \
        __syncthreads(); \
        FA_P3 }
    int t = 0;
    for (; t + 1 < ntile; t += 2) { FA_ITER(sgA) ++t; FA_ITER(sgB) --t; }
    if (t < ntile) FA_ITER(sgA)
#undef FA_ITER
#if FA_PROBE && FA_PROBE < 9
    if (DQ == 96 && lane == 0) { unsigned long long* pp = (unsigned long long*)((FGAS char*)ws + 32768);
        atomicAdd(pp + 0, pr_c); atomicAdd(pp + 1, pr_w); atomicAdd(pp + 2, pr_b); atomicAdd(pp + 3, pr_t); atomicAdd(pp + 4, __builtin_amdgcn_s_memtime() - pr_start); }
#endif
}
__device__ __forceinline__ void sm_finish(const SM& st, float gate, f32x16 (&acc)[2]) {
    const float inv = gate / fmaxf(xhalf_sum(st.l), TINYF);
    acc[0] += st.o[0] * inv; acc[1] += st.o[1] * inv;
}
template <class DST> __device__ __forceinline__ void store_out(const f32x16 (&acc)[2], FLAS char* ost, FGAS char* ws, DST dstf, int lane) {
    const int r = lane & 31, h = lane >> 5;
#pragma unroll
    for (int db = 0; db < 2; ++db)
#pragma unroll
        for (int g = 0; g < 4; ++g) { u32x2 w; w.x = cvtpk(acc[db][4 * g], acc[db][4 * g + 1]); w.y = cvtpk(acc[db][4 * g + 2], acc[db][4 * g + 3]);
            *(FLAS u32x2*)(ost + r * OSTR + (32 * db + 8 * g + 4 * h) * 2) = w; }
    asm volatile("s_waitcnt lgkmcnt(0)" ::: "memory");
#pragma unroll
    for (int i = 0; i < 4; ++i) { const int idx = i * 64 + lane, col = idx >> 3, ch = idx & 7;
        const u32x4 v = *(const FLAS u32x4*)(ost + col * OSTR + ch * 16);
        *(FGAS u32x4*)(ws + (dstf(col) + (unsigned)ch * 16u)) = v; }
    asm volatile("s_waitcnt lgkmcnt(0)" ::: "memory");
}
template <int DQ> __device__ __forceinline__ void load_q(bf16x8 (&qf)[DQ / 16], const FGAS char* ws, unsigned qoff, int h) {
#pragma unroll
    for (int d0 = 0; d0 < DQ / 16; ++d0) qf[d0] = *(const FGAS bf16x8*)(ws + (qoff + (unsigned)(d0 * 32 + 16 * h)));
}
}
namespace mk {
typedef unsigned short bf16;
typedef float f32x4 __attribute__((ext_vector_type(4)));
typedef unsigned v4u __attribute__((ext_vector_type(4)));
typedef unsigned v2u __attribute__((ext_vector_type(2)));
typedef short bf16x8 __attribute__((ext_vector_type(8)));
typedef float f32x16 __attribute__((ext_vector_type(16)));
using fa::SM;

constexpr int D = 1024, NB = 4, SEQ = 8192, M = NB * SEQ, DEPTH = 2, DFF = 4096, ZLD = 2304, DIN = 2284;
constexpr int ZA_Q = 0, ZA_K = 256, ZA_V = 384, ZB_CQ = 512, ZB_CKV = 704, ZB_PE = 832, ZC_Q = 864, ZC_KC = 1120, ZC_VC = 1184, ZC_KS = 1248, ZC_VS = 1312, ZC_KW = 1376, ZC_VW = 1440, ZC_GL = 1504, ZD_Q = 1520, ZD_K = 1776, ZD_V = 2032;
constexpr float LOG2E = 1.4426950408889634f;
constexpr float QS = 0.125f * LOG2E;
constexpr float C_MLA = 0.10206207261596577f * LOG2E;
constexpr float RMS_EPS = 1e-6f;
constexpr int NWAVES = 8, NTHR = 512;

constexpr size_t MiB = 1u << 20;
constexpr size_t WS_CTL = 0, CTL_ZERO_BYTES = 64 * 1024;
constexpr size_t WS_MOD = 1 * MiB;
constexpr size_t WS_ROPE = WS_MOD + 256 * 1024;
constexpr size_t WS_POSP = WS_ROPE + 1 * MiB;
constexpr size_t WS_POSB = WS_POSP + 64 * 1024;
constexpr size_t WS_RSQ = WS_POSB + 64 * 1024;
constexpr size_t WS_RSKV = WS_RSQ + 128 * 1024;
constexpr size_t WS_KMH = WS_RSKV + 128 * 1024;
constexpr size_t WS_KML = WS_KMH + 64 * 1024;
constexpr size_t WS_KCMP = WS_KML + 64 * 1024;
constexpr size_t WS_VCMP = WS_KCMP + 256 * 1024;
constexpr size_t WS_XB = 436 * MiB;
constexpr size_t WS_PARK = 401 * MiB;
constexpr size_t WS_W = 4 * MiB, WS_WL = 26 * MiB;
constexpr size_t W_IN = 0, W_OUT = 4608 * 1024, W_UP = W_OUT + 2 * MiB, W_DN = W_UP + 8 * MiB, W_UQ = W_DN + 8 * MiB, W_UKV = W_UQ + 256 * 1024, W_1K = W_UKV + 256 * 1024, W_1V = W_1K + 512 * 1024, W_2K = W_1V + 512 * 1024, W_2V = W_2K + 16 * 1024;
static_assert(W_2V + 16 * 1024 <= WS_WL && WS_VCMP + 256 * 1024 <= WS_W, "ws map");
constexpr size_t WS_H = 56 * MiB;
constexpr size_t WS_Z = 120 * MiB;
constexpr size_t WS_QM = 265 * MiB, WS_KM = 297 * MiB, WS_VM = 321 * MiB, WS_O = 337 * MiB, WS_U = 120 * MiB, WS_END = 401 * MiB;
static_assert(WS_Z + (size_t)(M + 64) * ZLD * 2 <= WS_QM && WS_U + (size_t)M * DFF * 2 <= WS_END, "ws map 2");

constexpr int LDS_RING = 131072, LDS_BYTES = 163840, LDS_MISC = LDS_BYTES - 256;
constexpr int FA_STAGES = 0, FA_OST = 61440, FA_IMP = FA_OST + 8 * 32 * fa::OSTR  , FA_SELM = FA_IMP + 32768, FA_UM = FA_SELM + 1024, FA_VALS = FA_UM + 64;
static_assert(FA_VALS + 8 * 512 <= LDS_MISC, "fa lds map");
constexpr int MB_OS = 65;
constexpr int MB_T = 0, MB_O = 65536, MB_ML = MB_O + 256 * MB_OS * 4, MB_CNT = MB_ML + 2048, MB_LST = MB_CNT + 128, MB_PS = MB_LST + 8192, MB_PM = MB_PS + 4 * 32 * 33 * 4;
static_assert(MB_PM + 1024 <= LDS_MISC, "moba lds map");

#define GAS __attribute__((address_space(1)))
#define LAS __attribute__((address_space(3)))
#define LDS_WAIT() asm volatile("s_waitcnt lgkmcnt(0)" ::: "memory")
__device__ __forceinline__ unsigned f2bf(float f) { unsigned u = __builtin_bit_cast(unsigned, f); return (u + 0x7fffu + ((u >> 16) & 1u)) >> 16; }
__device__ __forceinline__ unsigned pk2(float lo, float hi) { return f2bf(lo) | (f2bf(hi) << 16); }
__device__ __forceinline__ float bf2f(unsigned short b) { return __uint_as_float((unsigned)b << 16); }
__device__ __forceinline__ float wave_sum(float v) {
#pragma unroll
    for (int o = 1; o < 64; o <<= 1) v += __shfl_xor(v, o);
    return v;
}
__device__ __forceinline__ float slope2_of(int i) { return exp2f(-8.0f * (float)(i + 1) / 12.0f) * LOG2E; }

struct Args { const float* in[22]; float* out; unsigned char* ws; int ph_lo, ph_hi, skip, rep; };
typedef const __attribute__((address_space(4))) Args* KArgsP;
struct Frame {
    LAS unsigned char* lds;
    int tid, lane, wave, vcu, G, bx;
    unsigned char* ws;
};

template <int MODE> __device__ __forceinline__ int dmap(int n) {
    if (MODE == 1) { if (n < 832) return n; if (n < 848) return 832 + 2 * (n - 832); if (n < 864) return 832 + 2 * (n - 848) + 1; if (n < 1516) return n; return n + 4; }
    if (MODE == 2) { const int hd = n / 96, w = n - hd * 96; if (w < 64) return hd * 64 + w; if (w < 80) return 256 + hd * 32 + 2 * (w - 64); return 256 + hd * 32 + 2 * (w - 80) + 1; }
    return n;
}
template <int MODE> __device__ __forceinline__ float cscale(int n) {
    if (MODE == 1) { return (n < 256 || (n >= 864 && n < 1120) || (n >= 1516 && n < 1772)) ? QS : 1.f; }
    if (MODE == 2) return C_MLA;
    return 1.f;
}
template <int MODE> __device__ __forceinline__ void transpose_item(const float* W, int N, bf16* WT, int KT, const float* kscale, LAS float* scr, int item, int lane) {
    const int nblk = (N + 31) / 32, kb = item / nblk, nb = item % nblk, k0 = 64 * kb, n0 = 32 * nb;
    const int nl = lane & 31, n = n0 + nl;
#pragma unroll 8
    for (int i = 0; i < 32; ++i) { const int kk = 2 * i + (lane >> 5); float v = (n < N) ? W[(size_t)(k0 + kk) * N + n] : 0.f; if (kscale) v *= kscale[k0 + kk]; scr[kk * 33 + nl] = v; }
    LDS_WAIT(); asm volatile("" ::: "memory");
    const int c = lane & 7;
#pragma unroll
    for (int j = 0; j < 4; ++j) { const int nn = (lane >> 3) + 8 * j, ng = n0 + nn;
        if (ng < N) { const float cs = cscale<MODE>(ng); const LAS float* s = scr + (8 * c) * 33 + nn;
            v4u o; o.x = pk2(s[0 * 33] * cs, s[1 * 33] * cs); o.y = pk2(s[2 * 33] * cs, s[3 * 33] * cs); o.z = pk2(s[4 * 33] * cs, s[5 * 33] * cs); o.w = pk2(s[6 * 33] * cs, s[7 * 33] * cs);
            *(GAS v4u*)(WT + (size_t)dmap<MODE>(ng) * KT + k0 + 8 * c) = o; } }
    LDS_WAIT(); asm volatile("" ::: "memory");
}
__device__ __forceinline__ void zero_fill16(bf16* p, size_t n16, int gtid, int gthreads) {
    for (size_t i = gtid; i < n16; i += gthreads) ((GAS v4u*)p)[i] = (v4u){0u, 0u, 0u, 0u};
}

__device__ __forceinline__ void p_prologue(Frame& F, KArgsP ap_) {
#define a (*ap_)
    LAS float* scr = (LAS float*)(F.lds + F.wave * 16384);
    const int gw = F.vcu * NWAVES + F.wave, NGW = F.G * NWAVES;
    const int gtid = F.vcu * NTHR + F.tid, GT = F.G * NTHR;
    constexpr int I_IN = 16 * 72, I_OUT = 16 * 32, I_UP = 16 * 128, I_DN = 64 * 32, I_UQ = 3 * 12, I_UKV = 2 * 16, I_W1 = 32 * 4, I_W2 = 2 * 2;
    constexpr int PER_L = I_IN + I_OUT + I_UP + I_DN + I_UQ + I_UKV + 2 * I_W1 + 2 * I_W2;
    for (int it = gw; it < DEPTH * PER_L; it += NGW) {
        const int l = it / PER_L; int r = it - l * PER_L;
        unsigned char* wb = F.ws + WS_W + (size_t)l * WS_WL;
        if (r < I_IN) { transpose_item<1>(a.in[6] + (size_t)l * D * DIN, DIN, (bf16*)(wb + W_IN), D, nullptr, scr, r, F.lane); continue; } r -= I_IN;
        if (r < I_OUT) { transpose_item<0>(a.in[7] + (size_t)l * D * D, D, (bf16*)(wb + W_OUT), D, nullptr, scr, r, F.lane); continue; } r -= I_OUT;
        if (r < I_UP) { transpose_item<0>(a.in[19] + (size_t)l * D * DFF, DFF, (bf16*)(wb + W_UP), D, nullptr, scr, r, F.lane); continue; } r -= I_UP;
        if (r < I_DN) { transpose_item<0>(a.in[20] + (size_t)l * DFF * D, D, (bf16*)(wb + W_DN), DFF, nullptr, scr, r, F.lane); continue; } r -= I_DN;
        if (r < I_UQ) { transpose_item<2>(a.in[11] + (size_t)l * 192 * 384, 384, (bf16*)(wb + W_UQ), 256, a.in[9] + l * 192, scr, r, F.lane); continue; } r -= I_UQ;
        if (r < I_UKV) { transpose_item<0>(a.in[12] + (size_t)l * 128 * 512, 512, (bf16*)(wb + W_UKV), 256, a.in[10] + l * 128, scr, r, F.lane); continue; } r -= I_UKV;
        if (r < I_W1) { transpose_item<0>(a.in[15] + (size_t)l * 2048 * 128, 128, (bf16*)(wb + W_1K), 2048, nullptr, scr, r, F.lane); continue; } r -= I_W1;
        if (r < I_W1) { transpose_item<0>(a.in[17] + (size_t)l * 2048 * 128, 128, (bf16*)(wb + W_1V), 2048, nullptr, scr, r, F.lane); continue; } r -= I_W1;
        if (r < I_W2) { transpose_item<0>(a.in[16] + (size_t)l * 128 * 64, 64, (bf16*)(wb + W_2K), 128, nullptr, scr, r, F.lane); continue; } r -= I_W2;
        transpose_item<0>(a.in[18] + (size_t)l * 128 * 64, 64, (bf16*)(wb + W_2V), 128, nullptr, scr, r, F.lane);
    }
    for (int l = 0; l < DEPTH; ++l) {
        unsigned char* wb = F.ws + WS_W + (size_t)l * WS_WL;
        zero_fill16((bf16*)(wb + W_IN) + (size_t)1516 * D, 4 * D / 8, gtid, GT);
        zero_fill16((bf16*)(wb + W_IN) + (size_t)2288 * D, 16 * D / 8, gtid, GT);
        zero_fill16((bf16*)(wb + W_UQ) + (size_t)384 * 256, 128 * 256 / 8, gtid, GT);
        for (int i = gtid; i < 384 * 8; i += GT) ((GAS v4u*)((bf16*)(wb + W_UQ) + (size_t)(i >> 3) * 256 + 192))[i & 7] = (v4u){0u, 0u, 0u, 0u};
        for (int i = gtid; i < 512 * 16; i += GT) ((GAS v4u*)((bf16*)(wb + W_UKV) + (size_t)(i >> 4) * 256 + 128))[i & 15] = (v4u){0u, 0u, 0u, 0u};
    }
    { float* rt = (float*)(F.ws + WS_ROPE);
      for (int i = gtid; i < SEQ * 16; i += GT) { const int ii = i & 15, t = i >> 4; const float freq = powf(10000.f, -(float)ii / 16.f), ang = (float)t * freq; rt[2 * i] = cosf(ang); rt[2 * i + 1] = sinf(ang); } }
    { float* pp = (float*)(F.ws + WS_POSP);
      for (int i = gtid; i < DEPTH * 2 * 32 * 128; i += GT) { const int j = i & 127, kr = (i >> 7) & 31, wh = (i >> 12) & 1, l = i >> 13;
          const float* pos = a.in[wh ? 14 : 13] + l * 2048 + kr * 64; const float* w1 = a.in[wh ? 17 : 15] + (size_t)l * 2048 * 128 + (size_t)kr * 64 * 128 + j;
          float s = 0.f;
#pragma unroll 8
          for (int k = 0; k < 64; ++k) s += pos[k] * w1[(size_t)k * 128];
          pp[i] = s; } }
    { LAS float* sc = (LAS float*)(F.lds);
      LAS float* part = (LAS float*)(F.lds + 16384);
      __syncthreads();
      bool have = false;
      for (int it = F.vcu; it < DEPTH * 96; it += F.G) {
          if (!have) { for (int i = F.tid; i < NB * D; i += NTHR) { const float cv = a.in[1][i]; sc[i] = cv / (1.f + expf(-cv)); } have = true; __syncthreads(); }
          const int l = it / 96, ch = it % 96; const int j = ch * 64 + F.lane;
          const float* w = a.in[4] + (size_t)l * D * 6 * D + j;
          float acc[4] = {0.f, 0.f, 0.f, 0.f};
#pragma unroll 8
          for (int k = 128 * F.wave; k < 128 * F.wave + 128; ++k) { const float wv = w[(size_t)k * 6 * D]; acc[0] += sc[k] * wv; acc[1] += sc[D + k] * wv; acc[2] += sc[2 * D + k] * wv; acc[3] += sc[3 * D + k] * wv; }
#pragma unroll
          for (int b = 0; b < 4; ++b) part[(F.wave * 4 + b) * 64 + F.lane] = acc[b];
          __syncthreads();
          if (F.tid < 256) { const int b = F.tid >> 6, ln = F.tid & 63; float s = a.in[5][l * 6 * D + ch * 64 + ln];
#pragma unroll
              for (int w8 = 0; w8 < 8; ++w8) s += part[(w8 * 4 + b) * 64 + ln];
              ((float*)(F.ws + WS_MOD))[((size_t)l * NB + b) * 6 * D + ch * 64 + ln] = s; }
          __syncthreads();
      } }
}

#undef a
template <int MODE, bool XB16> __device__ __forceinline__ void p_norm(Frame& F, const void* x, const float* g, const float* modsh, const float* modsc, bf16* hout, float* fout) {
    const int gw = F.vcu * NWAVES + F.wave, NGW = F.G * NWAVES;
    for (int blk = gw; blk < M / 16; blk += NGW) {
        const int row0 = blk * 16, b = row0 >> 13;
        f32x4 ga[4], sh[4];
#pragma unroll
        for (int j = 0; j < 4; ++j) { const int c = 4 * F.lane + 256 * j; ga[j] = *(const f32x4*)(g + c);
            if (MODE == 0) { const f32x4 s = *(const f32x4*)(modsc + (size_t)b * 6 * D + c); ga[j] = ga[j] * (s + 1.0f); sh[j] = *(const f32x4*)(modsh + (size_t)b * 6 * D + c); } }
        for (int rr = 0; rr < 16; ++rr) {
            const int row = row0 + rr;
            f32x4 v[4]; float s = 0.f;
            if (XB16) { const GAS unsigned long long* xr = (const GAS unsigned long long*)((const bf16*)x + (size_t)row * D) + F.lane;
#pragma unroll
                for (int j = 0; j < 4; ++j) { const unsigned long long q = xr[64 * j]; const unsigned lo = (unsigned)q, hi = (unsigned)(q >> 32);
                    v[j] = (f32x4){__uint_as_float(lo << 16), __uint_as_float(lo & 0xffff0000u), __uint_as_float(hi << 16), __uint_as_float(hi & 0xffff0000u)}; } }
            else { const GAS f32x4* xr = (const GAS f32x4*)((const float*)x + (size_t)row * D) + F.lane;
#pragma unroll
                for (int j = 0; j < 4; ++j) v[j] = xr[64 * j]; }
#pragma unroll
            for (int j = 0; j < 4; ++j) s += (v[j].x * v[j].x + v[j].y * v[j].y) + (v[j].z * v[j].z + v[j].w * v[j].w);
            const float r = rsqrtf(wave_sum(s) * (1.f / D) + RMS_EPS);
            if (MODE == 0) { GAS unsigned long long* o8 = (GAS unsigned long long*)(hout + (size_t)row * D) + F.lane;
#pragma unroll
                for (int j = 0; j < 4; ++j) { const f32x4 y = v[j] * r * ga[j] + sh[j]; o8[64 * j] = (unsigned long long)pk2(y.x, y.y) | ((unsigned long long)pk2(y.z, y.w) << 32); } }
            else { GAS f32x4* o = (GAS f32x4*)(fout + (size_t)row * D) + F.lane;
#pragma unroll
                for (int j = 0; j < 4; ++j) o[64 * j] = v[j] * r * ga[j]; }
        }
    }
}

__device__ __forceinline__ void p_prep(Frame& F, int l) {
    const int gw = F.vcu * NWAVES + F.wave, NGW = F.G * NWAVES;
    const bf16* Z = (const bf16*)(F.ws + WS_Z); bf16* KM = (bf16*)(F.ws + WS_KM);
    float* rsq = (float*)(F.ws + WS_RSQ); float* rskv = (float*)(F.ws + WS_RSKV); const float* rope = (const float*)(F.ws + WS_ROPE);
    for (int row = gw; row < M; row += NGW) {
        const bf16* zr = Z + (size_t)row * ZLD;
        const float a0 = bf2f(zr[ZB_CQ + F.lane]), a1 = bf2f(zr[ZB_CQ + 64 + F.lane]), a2 = bf2f(zr[ZB_CQ + 128 + F.lane]);
        const float b0 = bf2f(zr[ZB_CKV + F.lane]), b1 = bf2f(zr[ZB_CKV + 64 + F.lane]);
        const float sq = wave_sum(a0 * a0 + a1 * a1 + a2 * a2), skv = wave_sum(b0 * b0 + b1 * b1);
        if (F.lane == 0) { rsq[row] = rsqrtf(sq * (1.f / 192.f) + RMS_EPS); rskv[row] = rsqrtf(skv * (1.f / 128.f) + RMS_EPS); }
        if (F.lane < 16) { const unsigned pr = *(const unsigned*)(zr + ZB_PE + 2 * F.lane); const float x1 = bf2f((unsigned short)(pr & 0xffffu)), x2 = bf2f((unsigned short)(pr >> 16));
            const float cs = rope[((size_t)(row & 8191) * 16 + F.lane) * 2], sn = rope[((size_t)(row & 8191) * 16 + F.lane) * 2 + 1];
            const unsigned o = pk2(x1 * cs - x2 * sn, x1 * sn + x2 * cs);
#pragma unroll
            for (int hd = 0; hd < 4; ++hd) *(unsigned*)(KM + (size_t)row * 384 + hd * 96 + 64 + 2 * F.lane) = o; }
    }
    { bf16* KMH = (bf16*)(F.ws + WS_KMH); bf16* KML = (bf16*)(F.ws + WS_KML);
      for (int it = gw; it < NB * 4 * 32; it += NGW) { const int j = it & 31, hd = (it >> 5) & 3, b = it >> 7; const int ts = F.lane >> 3, ch = F.lane & 7;
          float acc[8] = {0.f, 0.f, 0.f, 0.f, 0.f, 0.f, 0.f, 0.f};
          for (int i = 0; i < 32; ++i) { const v4u w = *(const v4u*)(Z + (size_t)(b * SEQ + j * 256 + 8 * i + ts) * ZLD + ZD_K + hd * 64 + ch * 8);
#pragma unroll
              for (int e = 0; e < 4; ++e) { acc[2 * e] += __uint_as_float(w[e] << 16); acc[2 * e + 1] += __uint_as_float(w[e] & 0xffff0000u); } }
#pragma unroll
          for (int e = 0; e < 8; ++e) { acc[e] += __shfl_xor(acc[e], 8); acc[e] += __shfl_xor(acc[e], 16); acc[e] += __shfl_xor(acc[e], 32); }
          if (F.lane < 8) { unsigned hi[4], lo[4];
#pragma unroll
              for (int e = 0; e < 4; ++e) { const float m0 = acc[2 * e] * (1.f / 256.f), m1 = acc[2 * e + 1] * (1.f / 256.f); const unsigned h0 = f2bf(m0), h1 = f2bf(m1);
                  hi[e] = h0 | (h1 << 16); lo[e] = pk2(m0 - __uint_as_float(h0 << 16), m1 - __uint_as_float(h1 << 16)); }
              *(v4u*)(KMH + (size_t)it * 64 + ch * 8) = (v4u){hi[0], hi[1], hi[2], hi[3]}; *(v4u*)(KML + (size_t)it * 64 + ch * 8) = (v4u){lo[0], lo[1], lo[2], lo[3]}; } } }
    if (gw == 0) { const float* pp = (const float*)(F.ws + WS_POSP) + (size_t)l * 2 * 32 * 128; float* pb = (float*)(F.ws + WS_POSB) + l * 256;
        for (int i = F.lane; i < 256; i += 64) { const int j = i & 127, wh = i >> 7; float s = 0.f; for (int kr = 0; kr < 32; ++kr) s += pp[(wh * 32 + kr) * 128 + j]; pb[i] = s; } }
}

__device__ __forceinline__ float gelu_tanh(float x) { const float u = 0.7978845608028654f * (x + 0.044715f * x * x * x); const float e = __expf(2.f * u); return x * (1.f - 1.f / (e + 1.f)); }
__device__ __forceinline__ void p_compress(Frame& F, int l) {
    const bf16* Z = (const bf16*)(F.ws + WS_Z);
    unsigned char* wb = F.ws + WS_W + (size_t)l * WS_WL;
    LAS float* red = (LAS float*)F.lds;
    const int r = F.lane & 31, h = F.lane >> 5;
    for (int it = F.vcu; it < NB * 16 * 2; it += F.G) {
        const int which = it & 1, itile = (it >> 1) & 15, b = it >> 5;
        const bf16* W1T = (const bf16*)(wb + (which ? W_1V : W_1K)); const bf16* W2T = (const bf16*)(wb + (which ? W_2V : W_2K));
        const int coff = which ? ZC_VC : ZC_KC;
        f32x16 acc[4] = {f32x16{}, f32x16{}, f32x16{}, f32x16{}};
        const bf16* brow = Z + (size_t)(b * SEQ + 16 * (32 * itile + r)) * ZLD + coff + 8 * h;
#pragma unroll 2
        for (int ks = 0; ks < 16; ++ks) { const int tt = 4 * F.wave + (ks >> 2), d0 = ks & 3;
            const bf16x8 bf = *(const bf16x8*)(brow + (size_t)tt * ZLD + d0 * 16);
#pragma unroll
            for (int hb = 0; hb < 4; ++hb) { const bf16x8 af = *(const bf16x8*)(W1T + (size_t)(hb * 32 + r) * 2048 + tt * 64 + d0 * 16 + 8 * h);
                acc[hb] = __builtin_amdgcn_mfma_f32_32x32x16_bf16(af, bf, acc[hb], 0, 0, 0); } }
#pragma unroll
        for (int hb = 0; hb < 4; ++hb)
#pragma unroll
            for (int v = 0; v < 16; ++v) red[((F.wave * 4 + hb) * 16 + v) * 64 + F.lane] = acc[hb][v];
        __syncthreads();
        if (F.wave < 2) {
            const float* pb = (const float*)(F.ws + WS_POSB) + l * 256 + which * 128;
            f32x16 o = f32x16{};
#pragma unroll
            for (int hb = 0; hb < 4; ++hb) { float x[16];
#pragma unroll
                for (int v = 0; v < 16; ++v) { float s = pb[hb * 32 + (v & 3) + 8 * (v >> 2) + 4 * h];
#pragma unroll
                    for (int w8 = 0; w8 < 8; ++w8) s += red[((w8 * 4 + hb) * 16 + v) * 64 + F.lane];
                    x[v] = gelu_tanh(s); }
#pragma unroll
                for (int s2 = 0; s2 < 2; ++s2) {
                    v4u pw; pw.x = fa::cvtpk(x[8 * s2], x[8 * s2 + 1]); pw.y = fa::cvtpk(x[8 * s2 + 2], x[8 * s2 + 3]); pw.z = fa::cvtpk(x[8 * s2 + 4], x[8 * s2 + 5]); pw.w = fa::cvtpk(x[8 * s2 + 6], x[8 * s2 + 7]);
                    const bf16* wr = W2T + (size_t)(F.wave * 32 + r) * 128 + hb * 32 + 16 * s2 + 4 * h;
                    const v2u a0 = *(const v2u*)wr, a1 = *(const v2u*)(wr + 8);
                    const v4u aw = (v4u){a0.x, a0.y, a1.x, a1.y};
                    o = __builtin_amdgcn_mfma_f32_32x32x16_bf16(__builtin_bit_cast(bf16x8, aw), __builtin_bit_cast(bf16x8, pw), o, 0, 0, 0); } }
            bf16* dst = (bf16*)(F.ws + (which ? WS_VCMP : WS_KCMP)) + (size_t)(b * 512 + 32 * itile + r) * 64 + F.wave * 32 + 4 * h;
#pragma unroll
            for (int g = 0; g < 4; ++g) { v2u w; w.x = fa::cvtpk(o[4 * g], o[4 * g + 1]); w.y = fa::cvtpk(o[4 * g + 2], o[4 * g + 3]); *(v2u*)(dst + 8 * g) = w; }
        }
        __syncthreads();
    }
}
using fa::bf16x8;
__device__ __forceinline__ unsigned char* launder_ptr(unsigned char* p) { const unsigned long long v = (unsigned long long)p; unsigned lo = __builtin_amdgcn_readfirstlane((unsigned)v), hi = __builtin_amdgcn_readfirstlane((unsigned)(v >> 32)); asm volatile("" : "+s"(lo), "+s"(hi)); return (unsigned char*)(((unsigned long long)hi << 32) | lo); }
#define UNIT_BEGIN() Frame F = F0; { int tid_ = F0.tid; asm volatile("" : "+v"(tid_)); int bx_ = __builtin_amdgcn_readfirstlane(F0.bx); asm volatile("" : "+s"(bx_)); \
    F.ws = launder_ptr(F0.ws); F.tid = tid_; F.lane = tid_ & 63; F.wave = __builtin_amdgcn_readfirstlane(tid_ >> 6); F.bx = bx_; }
__device__ __forceinline__ void u_mla(const Frame& F0, int b, int hd, int u) {
    UNIT_BEGIN();
    GAS char* ws = (GAS char*)F.ws;
    const int r = F.lane & 31, h = F.lane >> 5, q0 = 256 * u, wq0 = q0 + 32 * F.wave, tq = wq0 + r;
    bf16x8 qf[6]; { const unsigned qrow = (unsigned)WS_QM + (unsigned)(b * SEQ + tq) * 1024u;
      const float rs = *(const GAS float*)(ws + ((unsigned)WS_RSQ + (unsigned)(b * SEQ + tq) * 4u));
#pragma unroll
      for (int d0 = 0; d0 < 4; ++d0) { const fa::u32x4 raw = *(const GAS fa::u32x4*)(ws + (qrow + (unsigned)(hd * 128 + d0 * 32 + 16 * h))); fa::u32x4 o;
          o.x = fa::cvtpk(__uint_as_float(raw.x << 16) * rs, __uint_as_float(raw.x & 0xffff0000u) * rs); o.y = fa::cvtpk(__uint_as_float(raw.y << 16) * rs, __uint_as_float(raw.y & 0xffff0000u) * rs);
          o.z = fa::cvtpk(__uint_as_float(raw.z << 16) * rs, __uint_as_float(raw.z & 0xffff0000u) * rs); o.w = fa::cvtpk(__uint_as_float(raw.w << 16) * rs, __uint_as_float(raw.w & 0xffff0000u) * rs);
          qf[d0] = __builtin_bit_cast(bf16x8, o); }
#pragma unroll
      for (int d0 = 0; d0 < 2; ++d0) {
          const fa::u32x4 raw = *(const GAS fa::u32x4*)(ws + (qrow + (unsigned)(512 + hd * 64 + d0 * 32 + 16 * h)));
          const GAS float* rp = (const GAS float*)(ws + ((unsigned)WS_ROPE + (unsigned)((tq * 16 + d0 * 8 + 4 * h) * 8)));
          const fa::f32x4v r0 = *(const GAS fa::f32x4v*)rp * rs, r1 = *(const GAS fa::f32x4v*)(rp + 4) * rs;
          fa::u32x4 o;
          { const float x1 = __uint_as_float(raw.x << 16), x2 = __uint_as_float(raw.x & 0xffff0000u); o.x = fa::cvtpk(x1 * r0[0] - x2 * r0[1], x1 * r0[1] + x2 * r0[0]); }
          { const float x1 = __uint_as_float(raw.y << 16), x2 = __uint_as_float(raw.y & 0xffff0000u); o.y = fa::cvtpk(x1 * r0[2] - x2 * r0[3], x1 * r0[3] + x2 * r0[2]); }
          { const float x1 = __uint_as_float(raw.z << 16), x2 = __uint_as_float(raw.z & 0xffff0000u); o.z = fa::cvtpk(x1 * r1[0] - x2 * r1[1], x1 * r1[1] + x2 * r1[0]); }
          { const float x1 = __uint_as_float(raw.w << 16), x2 = __uint_as_float(raw.w & 0xffff0000u); o.w = fa::cvtpk(x1 * r1[2] - x2 * r1[3], x1 * r1[3] + x2 * r1[2]); }
          qf[4 + d0] = __builtin_bit_cast(bf16x8, o); } }
    SM st; fa::sm_init(st);
    LAS char* lds = (LAS char*)F.lds;
    fa::fa_loop<96, false>(st, qf, ws, (unsigned)WS_KM + (unsigned)b * (SEQ * 768u) + (unsigned)hd * 192u, 768u, (unsigned)WS_VM + (unsigned)b * (SEQ * 512u) + (unsigned)hd * 128u, 512u, SEQ - 1, 4 * u + 4,
        [](int t) { return 64 * t; },
        [=](int t, bool& act, bool& ew, float& cb, int& lo, int& hi) { const int key0 = 64 * t; act = key0 <= wq0 + 31; ew = key0 + 63 > wq0; cb = 0.f; lo = -100000; hi = tq - key0; },
        0.f, lds + FA_STAGES, F.tid, F.lane);
    f32x16 acc[2] = {f32x16{}, f32x16{}}; fa::sm_finish(st, 1.f, acc);
    fa::store_out(acc, lds + FA_OST + F.wave * 32 * fa::OSTR, ws, [=](int col) { return (unsigned)WS_O + (unsigned)(b * SEQ + wq0 + col) * 2048u + (unsigned)(256 + hd * 64) * 2u; }, F.lane);
}
__device__ __forceinline__ void u_moba(const Frame& F0, int b, int hd, int i) {
    UNIT_BEGIN();
    GAS char* ws = (GAS char*)F.ws;
    const int r = F.lane & 31, h = F.lane >> 5, q0 = 256 * i, wq0 = q0 + 32 * F.wave, tq = wq0 + r;
    bf16x8 qf[4]; fa::load_q<64>(qf, ws, (unsigned)WS_Z + (unsigned)(b * SEQ + tq) * (ZLD * 2u) + (unsigned)(ZD_Q + hd * 64) * 2u, h);
    unsigned bits = 0u;
    if (i > 0) {
        const GAS bf16* KMH = (const GAS bf16*)(ws + ((unsigned)WS_KMH + (unsigned)(((b * 4 + hd) * 32 + r) * 64 + 8 * h) * 2u)); const GAS bf16* KML = (const GAS bf16*)(ws + ((unsigned)WS_KML + (unsigned)(((b * 4 + hd) * 32 + r) * 64 + 8 * h) * 2u));
        f32x16 g = f32x16{};
#pragma unroll
        for (int d0 = 0; d0 < 4; ++d0) { const bf16x8 ah = *(const GAS bf16x8*)(KMH + d0 * 16), al = *(const GAS bf16x8*)(KML + d0 * 16);
            g = __builtin_amdgcn_mfma_f32_32x32x16_bf16(ah, qf[d0], g, 0, 0, 0); g = __builtin_amdgcn_mfma_f32_32x32x16_bf16(al, qf[d0], g, 0, 0, 0); }
        float og[16];
#pragma unroll
        for (int v = 0; v < 16; ++v) { const int j = (v & 3) + 8 * (v >> 2) + 4 * h; if (j >= i) g[v] = -INFINITY; og[v] = __shfl_xor(g[v], 32); }
#pragma unroll
        for (int v = 0; v < 16; ++v) { const int j = (v & 3) + 8 * (v >> 2) + 4 * h; int rank = 0;
#pragma unroll
            for (int w = 0; w < 16; ++w) { const int jm = (w & 3) + 8 * (w >> 2) + 4 * h, jo = (w & 3) + 8 * (w >> 2) + 4 * (1 - h);
                rank += (g[w] > g[v] || (g[w] == g[v] && jm < j)) ? 1 : 0; rank += (og[w] > g[v] || (og[w] == g[v] && jo < j)) ? 1 : 0; }
            if (rank < 3 && j < i) bits |= 1u << j; }
        bits |= __shfl_xor(bits, 32);
    }
    const float sl = slope2_of(2 + 3 * hd);
    LAS char* lds = (LAS char*)F.lds;
    LAS float* Ost = (LAS float*)(lds + MB_O);
    LAS float* MLst = (LAS float*)(lds + MB_ML);
    LAS unsigned* cnt = (LAS unsigned*)(lds + MB_CNT);
    LAS unsigned char* lst = (LAS unsigned char*)(lds + MB_LST);
    const unsigned koff = (unsigned)WS_Z + (unsigned)b * (SEQ * ZLD * 2u) + (unsigned)(ZD_K + hd * 64) * 2u, voff = (unsigned)WS_Z + (unsigned)b * (SEQ * ZLD * 2u) + (unsigned)(ZD_V + hd * 64) * 2u;
    if (F.tid < 32) cnt[F.tid] = 0u;
    {
        SM st; fa::sm_init(st);
        fa::fa_loop<64, true>(st, qf, ws, koff, ZLD * 2u, voff, ZLD * 2u, SEQ - 1, 4,
            [=](int t) { return q0 + 64 * t; },
            [=](int t, bool& act, bool& ew, float& cb, int& lo, int& hi) { const int key0 = q0 + 64 * t; act = key0 <= wq0 + 31; ew = key0 + 63 > wq0; cb = sl * (float)(64 * t + 4 * h); lo = -100000; hi = tq - key0; },
            sl, lds + FA_STAGES, F.tid, F.lane);
        const float lt = fa::xhalf_sum(st.l);
        LAS float* orow = Ost + (32 * F.wave + r) * MB_OS;
#pragma unroll
        for (int db = 0; db < 2; ++db)
#pragma unroll
            for (int g = 0; g < 4; ++g)
#pragma unroll
                for (int e = 0; e < 4; ++e) orow[32 * db + 8 * g + 4 * h + e] = st.o[db][4 * g + e];
        if (h == 0) { MLst[(32 * F.wave + r) * 2] = st.m; MLst[(32 * F.wave + r) * 2 + 1] = lt; }
    }
    if (h == 0) { unsigned bb = bits;
        while (bb) { const int j = __ffs(bb) - 1; bb &= bb - 1u; const unsigned slot = __hip_atomic_fetch_add(&cnt[j], 1u, __ATOMIC_RELAXED, __HIP_MEMORY_SCOPE_WORKGROUP); lst[j * 256 + slot] = (unsigned char)(32 * F.wave + r); } }
    LDS_WAIT(); __syncthreads();
    if (i > 0) {
        LAS unsigned* PS = (LAS unsigned*)(lds + MB_PS);
        LAS float* PM = (LAS float*)(lds + MB_PM);
        const unsigned qbase = (unsigned)WS_Z + (unsigned)(b * SEQ + q0) * (ZLD * 2u) + (unsigned)(ZD_Q + hd * 64) * 2u;
        const int tt = F.wave & 3, g4 = F.wave >> 2;
        fa::Stg<64> s0, s1, s2, s3;
#define MB_LOADBLK(J) { fa::stg_load<64>(s0, ws, koff, ZLD * 2u, voff, ZLD * 2u, 256 * (J), SEQ - 1, F.tid); fa::stg_load<64>(s1, ws, koff, ZLD * 2u, voff, ZLD * 2u, 256 * (J) + 64, SEQ - 1, F.tid); \
                        fa::stg_load<64>(s2, ws, koff, ZLD * 2u, voff, ZLD * 2u, 256 * (J) + 128, SEQ - 1, F.tid); fa::stg_load<64>(s3, ws, koff, ZLD * 2u, voff, ZLD * 2u, 256 * (J) + 192, SEQ - 1, F.tid); }
        MB_LOADBLK(0)
        const int ql = 8 * tt + (F.lane >> 3), l7 = F.lane & 7;
        for (int j = 0; j < i; ++j) {
            const int n = (int)cnt[j];
            bool myact = 32 * g4 < n, colv = (32 * g4 + r) < n; int qsel = colv ? (int)lst[j * 256 + 32 * g4 + r] : 0;
            bf16x8 qfb[4] = {qf[0], qf[1], qf[2], qf[3]};
            if (myact) fa::load_q<64>(qfb, ws, qbase + (unsigned)qsel * (ZLD * 2u), h);
            fa::stg_store<64>(s0, lds + MB_T, F.tid); fa::stg_store<64>(s1, lds + MB_T + 16384, F.tid); fa::stg_store<64>(s2, lds + MB_T + 32768, F.tid); fa::stg_store<64>(s3, lds + MB_T + 49152, F.tid);
            if (j + 1 < i) MB_LOADBLK(j + 1)
            LDS_WAIT(); __syncthreads();
            for (int rd = 0; 64 * rd < n; ++rd) {
                const int grp = 2 * rd + g4;
                if (rd > 0) { LDS_WAIT(); __syncthreads();
                    myact = 32 * grp < n; colv = (32 * grp + r) < n; qsel = colv ? (int)lst[j * 256 + 32 * grp + r] : 0;
                    if (myact) fa::load_q<64>(qfb, ws, qbase + (unsigned)qsel * (ZLD * 2u), h); }
                const bool two = 32 * (2 * rd + 1) < n;
                const bool fv = (32 * grp + ql) < n; const int qs = fv ? (int)lst[j * 256 + 32 * grp + ql] : 0;
                const float ms = MLst[qs * 2], ls = MLst[qs * 2 + 1];
                LAS float* orow = Ost + qs * MB_OS + 8 * l7;
                float acc8[8];
#pragma unroll
                for (int x = 0; x < 8; ++x) acc8[x] = orow[x];
                SM st; fa::sm_init(st); float lp = 0.f;
                if (myact) {
                    const LAS char* buf = lds + MB_T + tt * 16384;
                    fa::f32x16 p0, p1; bf16x8 pf[4];
                    fa::score_tile<64, true>(p0, p1, buf, qfb, colv ? sl * (float)(256 * j + 64 * tt - q0 + 4 * h) : fa::MASKV, sl, F.lane);
                    fa::sm_step(st, p0, p1, pf);
                    fa::pv(st.o, buf + 8192, pf, F.lane);
                    lp = fa::xhalf_sum(st.l);
                }
#pragma unroll 1
                for (int ph = 0; ph < 2; ++ph) {
                    if (ph == 1 && !two) break;
                    if (ph == 1) { LDS_WAIT(); __syncthreads(); }
                    if (g4 == ph && myact) {
                        LAS unsigned* ps = PS + (tt * 32 + r) * 33 + 2 * h;
#pragma unroll
                        for (int db = 0; db < 2; ++db)
#pragma unroll
                            for (int g = 0; g < 4; ++g) { ps[16 * db + 4 * g] = fa::cvtpk(st.o[db][4 * g], st.o[db][4 * g + 1]); ps[16 * db + 4 * g + 1] = fa::cvtpk(st.o[db][4 * g + 2], st.o[db][4 * g + 3]); }
                        if (h == 0) { PM[(tt * 32 + r) * 2] = st.m; PM[(tt * 32 + r) * 2 + 1] = lp; }
                    }
                    LDS_WAIT(); __syncthreads();
                    if (g4 == ph && fv) {
                        const float m0 = PM[ql * 2], l0 = PM[ql * 2 + 1], m1 = PM[(32 + ql) * 2], l1 = PM[(32 + ql) * 2 + 1], m2 = PM[(64 + ql) * 2], l2 = PM[(64 + ql) * 2 + 1], m3 = PM[(96 + ql) * 2], l3 = PM[(96 + ql) * 2 + 1];
                        const float mn = fmaxf(fmaxf(fmaxf(m0, m1), fmaxf(m2, m3)), ms);
                        const float ea = fa::ex2(ms - mn), e0 = fa::ex2(m0 - mn), e1 = fa::ex2(m1 - mn), e2 = fa::ex2(m2 - mn), e3 = fa::ex2(m3 - mn);
                        const LAS unsigned* pr = PS + ql * 33 + 4 * l7;
#pragma unroll
                        for (int x = 0; x < 4; ++x) { const unsigned w0 = pr[x], w1 = pr[32 * 33 + x], w2 = pr[64 * 33 + x], w3 = pr[96 * 33 + x];
                            orow[2 * x] = acc8[2 * x] * ea + ((__uint_as_float(w0 << 16) * e0 + __uint_as_float(w1 << 16) * e1) + (__uint_as_float(w2 << 16) * e2 + __uint_as_float(w3 << 16) * e3));
                            orow[2 * x + 1] = acc8[2 * x + 1] * ea + ((__uint_as_float(w0 & 0xffff0000u) * e0 + __uint_as_float(w1 & 0xffff0000u) * e1) + (__uint_as_float(w2 & 0xffff0000u) * e2 + __uint_as_float(w3 & 0xffff0000u) * e3)); }
                        if (l7 == 0) { MLst[qs * 2] = mn; MLst[qs * 2 + 1] = ls * ea + ((l0 * e0 + l1 * e1) + (l2 * e2 + l3 * e3)); }
                    }
                }
            }
        }
#undef MB_LOADBLK
        LDS_WAIT(); __syncthreads();
#if FA_PROBE == 9
        if (F.lane == 0 && F.wave == FA_KO) { unsigned long long* pp = (unsigned long long*)((GAS char*)ws + 32768);
            atomicAdd(pp + 0, pq0); atomicAdd(pp + 1, pq1); atomicAdd(pp + 2, pq2); atomicAdd(pp + 3, pqn); atomicAdd(pp + 4, pq3); }
#endif
    }
    { const int q = 32 * F.wave + (F.lane >> 1), hf = F.lane & 1; const float inv = 1.f / fmaxf(MLst[q * 2 + 1], fa::TINYF);
      const LAS float* orow = Ost + q * MB_OS + 32 * hf;
      GAS char* dst = ws + ((unsigned)WS_O + (unsigned)(b * SEQ + q0 + q) * 2048u + (unsigned)(768 + hd * 64 + 32 * hf) * 2u);
#pragma unroll
      for (int c = 0; c < 4; ++c) { float x[8];
#pragma unroll
          for (int e = 0; e < 8; ++e) x[e] = orow[8 * c + e] * inv;
          fa::u32x4 w; w.x = fa::cvtpk(x[0], x[1]); w.y = fa::cvtpk(x[2], x[3]); w.z = fa::cvtpk(x[4], x[5]); w.w = fa::cvtpk(x[6], x[7]);
          *(GAS fa::u32x4*)(dst + 16 * c) = w; } }
    LDS_WAIT(); __syncthreads();
}
__device__ __forceinline__ void u_swa(const Frame& F0, int b, int kvh, int u, const float* sinks) {
    UNIT_BEGIN();
    GAS char* ws = (GAS char*)F.ws;
    const int r = F.lane & 31, h = F.lane >> 5, q0 = 128 * u, wq0 = q0 + 16 * F.wave, tq = wq0 + (r >> 1), hd = kvh * 2 + (r & 1);
    bf16x8 qf[4]; fa::load_q<64>(qf, ws, (unsigned)WS_Z + (unsigned)(b * SEQ + tq) * (ZLD * 2u) + (unsigned)(ZA_Q + hd * 64) * 2u, h);
    const float sl = slope2_of(3 * hd);
    const int t0 = (2 * u - 2) > 0 ? (2 * u - 2) : 0, nt = 2 * u + 2 - t0;
    SM st; fa::sm_init(st);
    LAS char* lds = (LAS char*)F.lds;
    fa::fa_loop<64, true>(st, qf, ws, (unsigned)WS_Z + (unsigned)b * (SEQ * ZLD * 2u) + (unsigned)(ZA_K + kvh * 64) * 2u, ZLD * 2u, (unsigned)WS_Z + (unsigned)b * (SEQ * ZLD * 2u) + (unsigned)(ZA_V + kvh * 64) * 2u, ZLD * 2u, SEQ - 1, nt,
        [=](int t) { return 64 * (t0 + t); },
        [=](int t, bool& act, bool& ew, float& cb, int& lo, int& hi) { const int key0 = 64 * (t0 + t); act = (key0 <= wq0 + 15) && (key0 + 63 >= wq0 - 127); ew = true;
            cb = sl * (float)(key0 - q0 + 4 * h); lo = tq - 127 - key0; hi = tq - key0; },
        sl, lds + FA_STAGES, F.tid, F.lane);
    const float sk = sinks[hd] * LOG2E + sl * (float)(tq - q0), mf = fmaxf(st.m, sk), a = fa::ex2(st.m - mf);
    const float ltot = fa::xhalf_sum(st.l) * a + fa::ex2(sk - mf), inv = a / fmaxf(ltot, fa::TINYF);
    f32x16 acc[2]; acc[0] = st.o[0] * inv; acc[1] = st.o[1] * inv;
    fa::store_out(acc, lds + FA_OST + F.wave * 32 * fa::OSTR, ws, [=](int col) { return (unsigned)WS_O + (unsigned)(b * SEQ + wq0 + (col >> 1)) * 2048u + (unsigned)((kvh * 2 + (col & 1)) * 64) * 2u; }, F.lane);
}
__device__ __forceinline__ void u_nsa(const Frame& F0, int b, int qi) {
    UNIT_BEGIN();
    GAS char* ws = (GAS char*)F.ws;
    const unsigned KC = (unsigned)WS_KCMP + (unsigned)b * (512u * 128u), VC = (unsigned)WS_VCMP + (unsigned)b * (512u * 128u), ZB = (unsigned)WS_Z + (unsigned)b * (SEQ * ZLD * 2u);
    const int r = F.lane & 31, h = F.lane >> 5, q0 = 64 * qi, wq0 = q0 + 8 * F.wave, qloc = 8 * F.wave + (r >> 2), tq = q0 + qloc, hd = r & 3;
    const unsigned zrow_off = ZB + (unsigned)tq * (ZLD * 2u); const GAS bf16* zrow = (const GAS bf16*)(ws + zrow_off);
    bf16x8 qf[4]; fa::load_q<64>(qf, ws, zrow_off + (unsigned)(ZC_Q + hd * 64) * 2u, h);
    const float sl = slope2_of(1 + 3 * hd);
    const float g0 = 1.f / (1.f + __expf(-bf2f(zrow[ZC_GL + hd]))), g1 = 1.f / (1.f + __expf(-bf2f(zrow[ZC_GL + 4 + hd]))), g2 = 1.f / (1.f + __expf(-bf2f(zrow[ZC_GL + 8 + hd])));
    LAS char* lds = (LAS char*)F.lds;
    LAS float* impA = (LAS float*)(lds + FA_IMP) + F.wave * 1024;
    LAS float* impB = (LAS float*)(lds + FA_OST) + F.wave * 1024;
    LAS unsigned* selm = (LAS unsigned*)(lds + FA_SELM);
    LAS unsigned* um = (LAS unsigned*)(lds + FA_UM);
    LAS float* vals = (LAS float*)(lds + FA_VALS) + F.wave * 128;
    if (F.tid < 4) um[F.tid] = 0u;
    const unsigned parko = (unsigned)WS_PARK + (unsigned)((F.bx * NWAVES + F.wave) * 2 * 32 * 64 + F.lane) * 4u;
#define PARK(i) (*(GAS float*)(ws + (parkl + (unsigned)((i) * 256))))
    const int ntc = ((4 * qi + 3) >> 6) + 1;
    const int cvis = (tq - 31) >> 4;
    const int cvis_min = (q0 - 31) >> 4;
    const float slc = 16.f * sl;
    SM st; fa::sm_init(st);
    fa::fa_loop<64, true>(st, qf, ws, KC, 128u, VC, 128u, 510, ntc,
        [](int t) { return 64 * t; },
        [=](int t, bool& act, bool& ew, float& cb, int& lo, int& hi) { const int c0 = 64 * t; act = true; ew = c0 + 63 > cvis_min; cb = slc * (float)(c0 - 4 * qi + 4 * h); lo = -100000; hi = cvis - c0; },
        slc, lds + FA_STAGES, F.tid, F.lane);
    { f32x16 t2[2] = {f32x16{}, f32x16{}}; fa::sm_finish(st, g0, t2); unsigned parkl = parko; asm volatile("" : "+v"(parkl));
#pragma unroll
      for (int v = 0; v < 16; ++v) { PARK(v) = t2[0][v]; PARK(16 + v) = t2[1][v]; } }
    {
        const float mfin = st.m, invl = 1.f / fmaxf(fa::xhalf_sum(st.l), fa::TINYF);
        constexpr int STG = fa::stage_bytes<64>();
        fa::Stg<64> sg;
        fa::stg_load<64>(sg, ws, KC, 128u, VC, 128u, 0, 510, F.tid); fa::stg_store<64>(sg, lds + FA_STAGES, F.tid); __syncthreads();
        for (int t = 0; t < ntc; ++t) {
            const LAS char* buf = lds + FA_STAGES + (t & 1) * STG;
            if (t + 1 < ntc) fa::stg_load<64>(sg, ws, KC, 128u, VC, 128u, 64 * (t + 1), 510, F.tid);
            const int c0 = 64 * t;
            f32x16 p0, p1; fa::score_tile<64, true>(p0, p1, buf, qf, slc * (float)(c0 - 4 * qi + 4 * h), slc, F.lane);
            if (c0 + 63 > cvis_min) fa::mask_ew(p0, p1, -100000, cvis - c0, h);
#pragma unroll
            for (int kh = 0; kh < 2; ++kh)
#pragma unroll
                for (int g = 0; g < 4; ++g) {
                    float e0, e1, e2, e3;
                    if (kh == 0) { e0 = fa::ex2(p0[4 * g] - mfin); e1 = fa::ex2(p0[4 * g + 1] - mfin); e2 = fa::ex2(p0[4 * g + 2] - mfin); e3 = fa::ex2(p0[4 * g + 3] - mfin); }
                    else { e0 = fa::ex2(p1[4 * g] - mfin); e1 = fa::ex2(p1[4 * g + 1] - mfin); e2 = fa::ex2(p1[4 * g + 2] - mfin); e3 = fa::ex2(p1[4 * g + 3] - mfin); }
                    e0 *= invl; e1 *= invl; e2 *= invl; e3 *= invl;
                    float s4 = ((e0 + e1) + e2) + e3;
                    s4 += __shfl_xor(s4, 1); s4 += __shfl_xor(s4, 2); e3 += __shfl_xor(e3, 1); e3 += __shfl_xor(e3, 2);
                    const int j = 16 * t + 8 * kh + 2 * g + h;
                    if (hd == 0) { impA[(r >> 2) * 128 + j] = s4; impB[(r >> 2) * 128 + j] = e3; }
                }
            if (t + 1 < ntc) fa::stg_store<64>(sg, lds + FA_STAGES + ((t + 1) & 1) * STG, F.tid);
            __syncthreads();
        }
    }
    {
        const int cur = qi;
        for (int qq = 0; qq < 8; ++qq) {
            unsigned long long m0, m1;
            if (cur < 16) { m0 = (cur >= 63) ? ~0ull : ((1ull << (cur + 1)) - 1ull); m1 = 0ull; }
            else {
                const int ja = F.lane, jb2 = F.lane + 64;
                const bool fca = (ja == 0 || ja == cur || ja == cur - 1), fcb = (jb2 == cur || jb2 == cur - 1);
                const float va = impA[qq * 128 + ja] + (ja > 0 ? impB[qq * 128 + ja - 1] : 0.f), vb = impA[qq * 128 + jb2] + impB[qq * 128 + jb2 - 1];
                const unsigned ka = (ja <= cur && !fca) ? (__float_as_uint(va) + 1u) : 0u, kb = (jb2 <= cur && !fcb) ? (__float_as_uint(vb) + 1u) : 0u;
                unsigned T = 0u;
                for (int bit = 31; bit >= 0; --bit) { const unsigned cand = T | (1u << bit); const int c = __popcll(__ballot(ka >= cand)) + __popcll(__ballot(kb >= cand)); if (c >= 13) T = cand; }
                if (T == 0u) T = 1u;
                const unsigned long long ga = __ballot(ka > T), gb = __ballot(kb > T), ea = __ballot(ka == T), eb = __ballot(kb == T);
                const int R = 13 - (__popcll(ga) + __popcll(gb)), na = __popcll(ea);
                const int pa = (int)__builtin_amdgcn_mbcnt_hi((unsigned)(ea >> 32), __builtin_amdgcn_mbcnt_lo((unsigned)ea, 0u)), pb = (int)__builtin_amdgcn_mbcnt_hi((unsigned)(eb >> 32), __builtin_amdgcn_mbcnt_lo((unsigned)eb, 0u));
                m0 = ga | __ballot(ka == T && pa < R) | 1ull; m1 = gb | __ballot(kb == T && (na + pb) < R);
                if (cur < 64) m0 |= 1ull << cur; else m1 |= 1ull << (cur - 64);
                if (cur - 1 < 64) m0 |= 1ull << (cur - 1); else m1 |= 1ull << (cur - 65);
            }
            if (F.lane == 0) { LAS unsigned* sp = selm + (8 * F.wave + qq) * 4; sp[0] = (unsigned)m0; sp[1] = (unsigned)(m0 >> 32); sp[2] = (unsigned)m1; sp[3] = (unsigned)(m1 >> 32);
                __hip_atomic_fetch_or(&um[0], (unsigned)m0, __ATOMIC_RELAXED, __HIP_MEMORY_SCOPE_WORKGROUP); __hip_atomic_fetch_or(&um[1], (unsigned)(m0 >> 32), __ATOMIC_RELAXED, __HIP_MEMORY_SCOPE_WORKGROUP); __hip_atomic_fetch_or(&um[2], (unsigned)m1, __ATOMIC_RELAXED, __HIP_MEMORY_SCOPE_WORKGROUP); __hip_atomic_fetch_or(&um[3], (unsigned)(m1 >> 32), __ATOMIC_RELAXED, __HIP_MEMORY_SCOPE_WORKGROUP); }
        }
        LDS_WAIT(); __syncthreads();
    }
    {
        const unsigned uw0 = um[0], uw1 = um[1], uw2 = um[2], uw3 = um[3];
        const LAS unsigned* selq = selm + qloc * 4;
        const int nsel = __builtin_amdgcn_readfirstlane(__popc(uw0) + __popc(uw1) + __popc(uw2) + __popc(uw3));
        LAS unsigned char* slist = (LAS unsigned char*)(lds + FA_VALS);
        if (F.tid < 128) { const int j = F.tid; const unsigned w = (j < 32) ? uw0 : (j < 64) ? uw1 : (j < 96) ? uw2 : uw3;
            if ((w >> (j & 31)) & 1u) { int pos = __popc(w & ((1u << (j & 31)) - 1u)); if (j >= 32) pos += __popc(uw0); if (j >= 64) pos += __popc(uw1); if (j >= 96) pos += __popc(uw2); slist[pos] = (unsigned char)j; } }
        LDS_WAIT(); __syncthreads();
        fa::sm_init(st);
        fa::fa_loop<64, true>(st, qf, ws, ZB + ZC_KS * 2u, ZLD * 2u, ZB + ZC_VS * 2u, ZLD * 2u, SEQ - 1, nsel,
            [=](int t) { return 64 * (int)slist[t]; },
            [=](int t, bool& act, bool& ew, float& cb, int& lo, int& hi) { const int j = (int)slist[t], key0 = 64 * j; const unsigned mw = selq[j >> 5];
                const bool on = (mw >> (j & 31)) & 1u; act = __any(on) != 0; ew = (j == qi); cb = on ? sl * (float)(key0 - q0 + 4 * h) : fa::MASKV; lo = -100000; hi = tq - key0; },
            sl, lds + FA_STAGES, F.tid, F.lane);
        { f32x16 t2[2] = {f32x16{}, f32x16{}}; fa::sm_finish(st, g1, t2); unsigned parkl = parko; asm volatile("" : "+v"(parkl));
#pragma unroll
          for (int v = 0; v < 16; ++v) { PARK(32 + v) = t2[0][v]; PARK(48 + v) = t2[1][v]; } }
    }
    {
        const int t0 = (qi - 8) > 0 ? (qi - 8) : 0, nt = qi + 1 - t0;
        fa::sm_init(st);
        fa::fa_loop<64, true>(st, qf, ws, ZB + ZC_KW * 2u, ZLD * 2u, ZB + ZC_VW * 2u, ZLD * 2u, SEQ - 1, nt,
            [=](int t) { return 64 * (t0 + t); },
            [=](int t, bool& act, bool& ew, float& cb, int& lo, int& hi) { const int j = t0 + t, key0 = 64 * j; act = true; ew = (j == qi) || (j == qi - 8);
                cb = sl * (float)(key0 - q0 + 4 * h); lo = tq - 511 - key0; hi = tq - key0; },
            sl, lds + FA_STAGES, F.tid, F.lane);
    }
    f32x16 acc[2] = {f32x16{}, f32x16{}}; fa::sm_finish(st, g2, acc); unsigned parkl = parko; asm volatile("" : "+v"(parkl));
#pragma unroll
    for (int v = 0; v < 16; ++v) { acc[0][v] += PARK(v) + PARK(32 + v); acc[1][v] += PARK(16 + v) + PARK(48 + v); }
#undef PARK
    fa::store_out(acc, lds + FA_OST + F.wave * 32 * fa::OSTR, ws, [=](int col) { return (unsigned)WS_O + (unsigned)(b * SEQ + wq0 + (col >> 2)) * 2048u + (unsigned)(512 + (col & 3) * 64) * 2u; }, F.lane);
}

__device__ __forceinline__ void p_attn(Frame& F, const float* sinks, int mskip) {
    const int id = F.vcu;
    if (F.G != 256) return;
    { const int bh = id >> 4, s = id & 15;
#pragma unroll 1
      for (int k = 0; k < (((mskip >> 9) & 1) ? 4 : 2); ++k) u_mla(F, bh >> 2, bh & 3, (k & 1) ? s : 31 - s); }
    { const int bh = id >> 4, s = id & 15;
#pragma unroll 1
      for (int k = 0; k < (((mskip >> 11) & 1) ? 4 : 2); ++k) u_moba(F, bh >> 2, bh & 3, (k & 1) ? s : 31 - s); }
    if (!(mskip & 4)) { const int b = id >> 6, s = id & 63;
#pragma unroll 1
      for (int k = 0; k < (((mskip >> 10) & 1) ? 4 : 2); ++k) u_nsa(F, b, (k & 1) ? s : 127 - s); }
    {
#pragma unroll 1
      for (int k = 0; k < (((mskip >> 8) & 1) ? 4 : 2); ++k) { const int u0 = 2 * id + (k & 1); u_swa(F, u0 >> 7, (u0 >> 6) & 1, u0 & 63, sinks); } }
}
constexpr int PH_PRO = 0, PH_L0 = 1, PH_PER_L = 9, PH_FIN = 19, PH_END = 20;
constexpr int PO_NORM1 = 0, PO_ZG = 1, PO_PREP = 2, PO_UP = 3, PO_ATTN = 4, PO_OG = 5, PO_NORM2 = 6, PO_UPG = 7, PO_DNG = 8;
#ifndef MK_PHASE_MASK
#define MK_PHASE_MASK 0xFFFFFu
#endif

__global__ void __launch_bounds__(NTHR, 2) mega(Args args) {
    extern __shared__ __attribute__((aligned(16))) unsigned char lds_raw[];
    Frame F;
    F.lds = (LAS unsigned char*)lds_raw;
    int wave_s = __builtin_amdgcn_readfirstlane((int)threadIdx.x >> 6); asm volatile("" : "+s"(wave_s));
    F.tid = threadIdx.x; F.lane = F.tid & 63; F.wave = wave_s;
    F.G = gridDim.x; { const int bx = blockIdx.x; F.vcu = (F.G % 8 == 0) ? (bx % 8) * (F.G / 8) + bx / 8 : bx; }
    volatile LAS unsigned* misc = (volatile LAS unsigned*)(F.lds + LDS_MISC);
    if (F.tid < 64) misc[F.tid] = 0u;
    __syncthreads();
    (void)xcd_barrier_post((unsigned*)(args.ws + WS_CTL), misc + 8);
    float* fo; KArgsP ap;
#define KARGS() ({ KArgsP q_ = (KArgsP)__builtin_amdgcn_kernarg_segment_ptr(); asm volatile("" : "+s"(q_)); q_; })
#define IN(k) ({ KArgsP q2_ = KARGS(); q2_->ph_lo <= (k) && (k) < q2_->ph_hi; })
#define PHASE_BEGIN() do { asm volatile("; PHASE_MARK %0" :: "i"(__LINE__)); ap = KARGS(); F.G = gridDim.x; \
        { int w_ = wave_s; asm volatile("" : "+s"(w_)); int t_ = (w_ << 6) | (int)__builtin_amdgcn_mbcnt_hi(~0u, __builtin_amdgcn_mbcnt_lo(~0u, 0u)); asm volatile("" : "+v"(t_)); F.tid = t_; F.lane = t_ & 63; F.wave = w_; } F.ws = ap->ws; int bx_ = (int)blockIdx.x; asm volatile("" : "+s"(bx_)); F.bx = bx_; F.vcu = (F.G % 8 == 0) ? (bx_ % 8) * (F.G / 8) + bx_ / 8 : bx_; fo = ap->out; } while (0)
#define INP(i) (ap->in[i])
#define SEAM(k) do { if (IN(k) && IN((k) + 1)) { XcdBarrier b_; b_.bar = (unsigned*)(KARGS()->ws + WS_CTL); b_.x = xb_xcc_id(); b_.st = (volatile LAS unsigned*)(F.lds + LDS_MISC) + 8; xcd_barrier(b_); } } while (0)

    if (IN(PH_PRO)) { PHASE_BEGIN(); p_prologue(F, ap); }
#ifdef MK_PRO_TWICE
    if (IN(PH_PRO)) { PHASE_BEGIN(); p_prologue(F, ap); }
#endif
    SEAM(PH_PRO);

    { constexpr int l = 0;
        const int pb = PH_L0 + PH_PER_L * l;
#define WB (F.ws + WS_W + (size_t)l * WS_WL)
#define MOD ((const float*)(F.ws + WS_MOD) + (size_t)l * NB * 6 * D)
#define XB ((bf16*)(F.ws + WS_XB))
#define XIN ((l == 0) ? (const void*)INP(0) : (const void*)XB)
#define H ((bf16*)(F.ws + WS_H))
#define Z ((bf16*)(F.ws + WS_Z))
#define OB ((bf16*)(F.ws + WS_O))
#define U ((bf16*)(F.ws + WS_U))

        if (IN(pb + PO_NORM1) && !((KARGS()->skip >> PO_NORM1) & 1)) { PHASE_BEGIN(); p_norm<0, (l != 0)>(F, XIN, INP(2) + l * D, MOD, MOD + D, H, nullptr); }
        SEAM(pb + PO_NORM1);

        if (IN(pb + PO_ZG) && !((KARGS()->skip >> PO_ZG) & 1)) { PHASE_BEGIN();
            pg8::Gemm g{H, (const bf16*)(WB + W_IN), M, ZLD, D, D}; pg8::StaticOrder S; S.init(M, ZLD, F.G, F.bx);
            pg8::EpiBf16<0> E{Z, ZLD, nullptr, 0, 0, 1.f};
            pg8::gemm_phase<pg8::EpiBf16<0>, pg8::StaticOrder, true, true>(F.lds, g, S, E, F.tid);
        }
        SEAM(pb + PO_ZG);

        if (IN(pb + PO_PREP) && !((KARGS()->skip >> PO_PREP) & 1)) { PHASE_BEGIN(); p_prep(F, l); }
        SEAM(pb + PO_PREP);

        if (IN(pb + PO_UP) && !((KARGS()->skip >> PO_UP) & 1)) { PHASE_BEGIN();
            { pg8::Gemm g{Z + ZB_CQ, (const bf16*)(WB + W_UQ), M, 512, 256, ZLD}; pg8::StaticOrder S; S.init(M, 512, F.G, F.bx);
              pg8::EpiBf16<0> E{(bf16*)(F.ws + WS_QM), 512, nullptr, 0, 0, 1.f};
              pg8::gemm_phase<pg8::EpiBf16<0>, pg8::StaticOrder, true, true>(F.lds, g, S, E, F.tid); }
            PHASE_BEGIN();
            { pg8::Gemm g{Z + ZB_CKV, (const bf16*)(WB + W_UKV), M, 512, 256, ZLD}; pg8::StaticOrder S; S.init(M, 512, F.G, F.bx);
              pg8::EpiMlaKV E{(bf16*)(F.ws + WS_KM), (bf16*)(F.ws + WS_VM), (const float*)(F.ws + WS_RSKV)};
              pg8::gemm_phase<pg8::EpiMlaKV, pg8::StaticOrder, true, false>(F.lds, g, S, E, F.tid); }
            PHASE_BEGIN();
            p_compress(F, l);
        }
        SEAM(pb + PO_UP);

        if (IN(pb + PO_ATTN) && !((KARGS()->skip >> PO_ATTN) & 1)) { PHASE_BEGIN(); p_attn(F, INP(8) + l * 4, (ap->skip >> 16) | ((ap->rep >> 20) << 8)); }
        SEAM(pb + PO_ATTN);

        if (IN(pb + PO_OG) && !((KARGS()->skip >> PO_OG) & 1)) { PHASE_BEGIN();
            pg8::Gemm g{OB, (const bf16*)(WB + W_OUT), M, D, D, D}; pg8::StaticOrder S; S.init(M, D, F.G, F.bx);
            pg8::EpiResid<(l != 0)> E{XIN, XB, MOD + 2 * D};
            pg8::gemm_phase<pg8::EpiResid<(l != 0)>, pg8::StaticOrder, true, true>(F.lds, g, S, E, F.tid);
        }
        SEAM(pb + PO_OG);

        if (IN(pb + PO_NORM2) && !((KARGS()->skip >> PO_NORM2) & 1)) { PHASE_BEGIN(); p_norm<0, true>(F, XB, INP(3) + l * D, MOD + 3 * D, MOD + 4 * D, H, nullptr); }
        SEAM(pb + PO_NORM2);

        if (IN(pb + PO_UPG) && !((KARGS()->skip >> PO_UPG) & 1)) { PHASE_BEGIN();
            pg8::Gemm g{H, (const bf16*)(WB + W_UP), M, DFF, D, D}; pg8::StaticOrder S; S.init(M, DFF, F.G, F.bx);
            pg8::EpiRelu2 E{U, DFF};
            pg8::gemm_phase<pg8::EpiRelu2, pg8::StaticOrder, true, true>(F.lds, g, S, E, F.tid);
        }
        SEAM(pb + PO_UPG);

        if (IN(pb + PO_DNG) && !((KARGS()->skip >> PO_DNG) & 1)) { PHASE_BEGIN();
            pg8::Gemm g{U, (const bf16*)(WB + W_DN), M, D, DFF, DFF}; pg8::StaticOrder S; S.init(M, D, F.G, F.bx);
            pg8::EpiResid<true> E{XB, XB, MOD + 5 * D};
            pg8::gemm_phase<pg8::EpiResid<true>, pg8::StaticOrder, true, true>(F.lds, g, S, E, F.tid);
        }
        SEAM(pb + PO_DNG);
    }
    { constexpr int l = 1;
        const int pb = PH_L0 + PH_PER_L * l;
#define WB (F.ws + WS_W + (size_t)l * WS_WL)
#define MOD ((const float*)(F.ws + WS_MOD) + (size_t)l * NB * 6 * D)
#define XB ((bf16*)(F.ws + WS_XB))
#define XIN ((l == 0) ? (const void*)INP(0) : (const void*)XB)
#define H ((bf16*)(F.ws + WS_H))
#define Z ((bf16*)(F.ws + WS_Z))
#define OB ((bf16*)(F.ws + WS_O))
#define U ((bf16*)(F.ws + WS_U))

        if (IN(pb + PO_NORM1) && !((KARGS()->skip >> PO_NORM1) & 1)) { PHASE_BEGIN(); p_norm<0, (l != 0)>(F, XIN, INP(2) + l * D, MOD, MOD + D, H, nullptr); }
        SEAM(pb + PO_NORM1);

        if (IN(pb + PO_ZG) && !((KARGS()->skip >> PO_ZG) & 1)) { PHASE_BEGIN();
            pg8::Gemm g{H, (const bf16*)(WB + W_IN), M, ZLD, D, D}; pg8::StaticOrder S; S.init(M, ZLD, F.G, F.bx);
            pg8::EpiBf16<0> E{Z, ZLD, nullptr, 0, 0, 1.f};
            pg8::gemm_phase<pg8::EpiBf16<0>, pg8::StaticOrder, true, true>(F.lds, g, S, E, F.tid);
        }
        SEAM(pb + PO_ZG);

        if (IN(pb + PO_PREP) && !((KARGS()->skip >> PO_PREP) & 1)) { PHASE_BEGIN(); p_prep(F, l); }
        SEAM(pb + PO_PREP);

        if (IN(pb + PO_UP) && !((KARGS()->skip >> PO_UP) & 1)) { PHASE_BEGIN();
            { pg8::Gemm g{Z + ZB_CQ, (const bf16*)(WB + W_UQ), M, 512, 256, ZLD}; pg8::StaticOrder S; S.init(M, 512, F.G, F.bx);
              pg8::EpiBf16<0> E{(bf16*)(F.ws + WS_QM), 512, nullptr, 0, 0, 1.f};
              pg8::gemm_phase<pg8::EpiBf16<0>, pg8::StaticOrder, true, true>(F.lds, g, S, E, F.tid); }
            PHASE_BEGIN();
            { pg8::Gemm g{Z + ZB_CKV, (const bf16*)(WB + W_UKV), M, 512, 256, ZLD}; pg8::StaticOrder S; S.init(M, 512, F.G, F.bx);
              pg8::EpiMlaKV E{(bf16*)(F.ws + WS_KM), (bf16*)(F.ws + WS_VM), (const float*)(F.ws + WS_RSKV)};
              pg8::gemm_phase<pg8::EpiMlaKV, pg8::StaticOrder, true, false>(F.lds, g, S, E, F.tid); }
            PHASE_BEGIN();
            p_compress(F, l);
        }
        SEAM(pb + PO_UP);

        if (IN(pb + PO_ATTN) && !((KARGS()->skip >> PO_ATTN) & 1)) { PHASE_BEGIN(); p_attn(F, INP(8) + l * 4, (ap->skip >> 16) | ((ap->rep >> 20) << 8)); }
        SEAM(pb + PO_ATTN);

        if (IN(pb + PO_OG) && !((KARGS()->skip >> PO_OG) & 1)) { PHASE_BEGIN();
            pg8::Gemm g{OB, (const bf16*)(WB + W_OUT), M, D, D, D}; pg8::StaticOrder S; S.init(M, D, F.G, F.bx);
            pg8::EpiResid<(l != 0)> E{XIN, XB, MOD + 2 * D};
            pg8::gemm_phase<pg8::EpiResid<(l != 0)>, pg8::StaticOrder, true, true>(F.lds, g, S, E, F.tid);
        }
        SEAM(pb + PO_OG);

        if (IN(pb + PO_NORM2) && !((KARGS()->skip >> PO_NORM2) & 1)) { PHASE_BEGIN(); p_norm<0, true>(F, XB, INP(3) + l * D, MOD + 3 * D, MOD + 4 * D, H, nullptr); }
        SEAM(pb + PO_NORM2);

        if (IN(pb + PO_UPG) && !((KARGS()->skip >> PO_UPG) & 1)) { PHASE_BEGIN();
            pg8::Gemm g{H, (const bf16*)(WB + W_UP), M, DFF, D, D}; pg8::StaticOrder S; S.init(M, DFF, F.G, F.bx);
            pg8::EpiRelu2 E{U, DFF};
            pg8::gemm_phase<pg8::EpiRelu2, pg8::StaticOrder, true, true>(F.lds, g, S, E, F.tid);
        }
        SEAM(pb + PO_UPG);

        if (IN(pb + PO_DNG) && !((KARGS()->skip >> PO_DNG) & 1)) { PHASE_BEGIN();
            pg8::Gemm g{U, (const bf16*)(WB + W_DN), M, D, DFF, DFF}; pg8::StaticOrder S; S.init(M, D, F.G, F.bx);
            pg8::EpiResid<true> E{XB, XB, MOD + 5 * D};
            pg8::gemm_phase<pg8::EpiResid<true>, pg8::StaticOrder, true, true>(F.lds, g, S, E, F.tid);
        }
        SEAM(pb + PO_DNG);
    }
    if (IN(PH_FIN)) { PHASE_BEGIN(); p_norm<1, true>(F, (const void*)(F.ws + WS_XB), INP(21), nullptr, nullptr, nullptr, fo); }
#undef IN
#undef SEAM
}
}
extern "C" void kernel_launch(void* const* d_in, const int* in_sizes, int n_in, void* d_out, int out_size, void* d_ws, size_t ws_size, hipStream_t stream) {
    using namespace mk;
    static int grid = 0;
    if (grid == 0) {
        int dev = 0, cus = 0;
        if (hipGetDevice(&dev) != hipSuccess || hipDeviceGetAttribute(&cus, hipDeviceAttributeMultiprocessorCount, dev) != hipSuccess) { grid = -1; return; }
        if (hipFuncSetAttribute((const void*)mega, hipFuncAttributeMaxDynamicSharedMemorySize, LDS_BYTES) != hipSuccess) { grid = -1; return; }
        (void)hipGetLastError();
        grid = cus;
    }
    if (grid < 0) return;
    (void)in_sizes; (void)n_in; (void)out_size; (void)ws_size;
    Args a{};
    for (int i = 0; i < 22; ++i) a.in[i] = (const float*)d_in[i];
    a.out = (float*)d_out; a.ws = (unsigned char*)d_ws; a.skip = 0; a.rep = MK_REP;
    auto launch = [&](int lo, int hi) {
        (void)hipMemsetAsync((char*)d_ws + WS_CTL, 0, CTL_ZERO_BYTES, stream);
        a.ph_lo = lo; a.ph_hi = hi;
        hipLaunchKernelGGL(mega, dim3(grid), dim3(NTHR), LDS_BYTES, stream, a);
    };
    launch(0, PH_END);
}
```

```cpp
#include <hip/hip_runtime.h>
#include <cstdio>
#include <cstdint>
#include <math.h>
#define MK_PQ 500.0
#define FA_EXP 2
#define FA_PROBE 0
#define MK_PROBE_IDX 0
#define FA_KO 0
#define MK_MODE 0
#define MK_NAIVE_MASK 0
#define MK_SKIP 0
#define MK_SPLIT 0
#define MK_DBG_PHASE 0
#define MK_DBG_TEST 0
#define MK_REP 0
namespace pg8 {
#define PG8_LAS __attribute__((address_space(3)))
typedef unsigned short bf16_t;
typedef short bf16x8 __attribute__((ext_vector_type(8)));
typedef float f32x4 __attribute__((ext_vector_type(4)));
typedef unsigned u32x4 __attribute__((ext_vector_type(4)));
constexpr int BM = 256, BK = 64, HALF = 128, HTB = HALF * BK * 2  , STAGE_BYTES = 8 * HTB, NXCD = 8, WGM = 8;

__host__ __device__ __forceinline__ int lds_byte(int r, int c) { const int st = (r >> 4) * 2 + (c >> 5), rr = r & 15, cc = c & 31, ob = rr * 64 + cc * 2; return st * 1024 + (ob ^ (((ob >> 9) & 1) << 5)); }
__host__ __device__ __forceinline__ void stage_rc(int b, int& R, int& C) { const int st = b / 1024, sb = b % 1024, swz = sb ^ (((sb >> 9) & 1) << 5); R = (st >> 1) * 16 + swz / 64; C = (st & 1) * 32 + (swz % 64) / 2; }
__host__ __device__ __forceinline__ int perm32(int rho) { const int n = rho >> 4, i = rho & 15; return 8 * (i >> 2) + 4 * n + (i & 3); }

struct Unit { int pm, pn; };
struct Gemm { const bf16_t* A; const bf16_t* Bt; int M, N, K, lda; };

struct StaticOrder {
    int nM, nN, nwg, G, c;
    __host__ __device__ void init(int M, int N, int G_, int c_) { nM = M / BM; nN = N / BM; nwg = nM * nN; G = G_; c = c_; }
    __host__ __device__ bool next(int i, Unit& u) const {
        const long L = (long)i * G + c; if (L >= nwg) return false;
        int wgid = (int)L; { const int q = nwg / NXCD, r = nwg % NXCD, xcd = wgid % NXCD, off = wgid / NXCD; wgid = (xcd < r ? xcd * (q + 1) : r * (q + 1) + (xcd - r) * q) + off; }
        const int nig = WGM * nN, gid = wgid / nig, fm = gid * WGM, gsz = (nM - fm) < WGM ? (nM - fm) : WGM;
        u.pm = fm + ((wgid % nig) % gsz); u.pn = (wgid % nig) / gsz; return true;
    }
    __device__ __forceinline__ void a_ready(const Unit&) const {}
    __device__ __forceinline__ void done(const Unit&) const {}
};
__device__ __forceinline__ unsigned cvt_pk_bf16(float lo, float hi) { unsigned r; asm volatile("v_cvt_pk_bf16_f32 %0, %1, %2" : "=v"(r) : "v"(lo), "v"(hi)); return r; }
typedef float f32x2 __attribute__((ext_vector_type(2)));
__device__ __forceinline__ f32x2 gelu_pk(f32x2 v) {
    const f32x2 av = __builtin_elementwise_abs(v), d = av * 0.2316418882f + 1.0f;
    f32x2 t; t.x = __builtin_amdgcn_rcpf(d.x); t.y = __builtin_amdgcn_rcpf(d.y);
    f32x2 q = t * 0.5307027145f + (-0.7265760135f); q = q * t + 0.7107068705f; q = q * t + (-0.142248368f); q = q * t + 0.127414796f; q = q * t;
    const f32x2 s = (v * v) * (-0.72134752044f);
    f32x2 e; e.x = __builtin_amdgcn_exp2f(s.x); e.y = __builtin_amdgcn_exp2f(s.y);
    const f32x2 m = v * (q * e), r = v - m;
    f32x2 o; o.x = v.x < 0.f ? m.x : r.x; o.y = v.y < 0.f ? m.y : r.y; return o;
}

template <int ACT  > struct EpiBf16 {
    static constexpr bool PERM = true, AFTER_DRAIN = false; static_assert(ACT == 0 || ACT == 1, "EpiBf16: ACT is 0 (none) or 1 (gelu_pk)");
    bf16_t* O; int ldc; const float* bias; int split_cols; size_t split_stride; float scale0;
    __device__ __forceinline__ void operator()(const f32x4 (&acc)[2][2][4][2], const Unit& u, int wr, int wc, int fr, int fq) const {
        const int row0 = u.pm * BM + wr * 64 + fr; int colt = u.pn * BM; bf16_t* base = O;
        float sc = 1.f; if (split_cols) { const int t = colt / split_cols; base += (size_t)t * split_stride; colt -= t * split_cols; if (t == 0) sc = scale0; }
        const int col0 = colt + wc * 32 + 8 * fq, bcol0 = u.pn * BM + wc * 32 + 8 * fq;
        f32x4 bv[2][2];
#pragma unroll
        for (int bj = 0; bj < 2; ++bj)
#pragma unroll
            for (int n = 0; n < 2; ++n) bv[bj][n] = bias ? *(const f32x4*)(bias + bcol0 + bj * HALF + 4 * n) : (f32x4){0.f, 0.f, 0.f, 0.f};
#pragma unroll
        for (int ai = 0; ai < 2; ++ai)
#pragma unroll
            for (int m = 0; m < 4; ++m) { bf16_t* rowp = base + (size_t)(row0 + ai * HALF + m * 16) * ldc + col0;
#pragma unroll
                for (int bj = 0; bj < 2; ++bj) { f32x4 v0 = acc[ai][bj][m][0] + bv[bj][0], v1 = acc[ai][bj][m][1] + bv[bj][1];
                    if (ACT == 1) { f32x2 a = gelu_pk((f32x2){v0[0], v0[1]}), b = gelu_pk((f32x2){v0[2], v0[3]}), c = gelu_pk((f32x2){v1[0], v1[1]}), d = gelu_pk((f32x2){v1[2], v1[3]});
                        v0 = (f32x4){a.x, a.y, b.x, b.y}; v1 = (f32x4){c.x, c.y, d.x, d.y}; }
                    v0 = v0 * sc; v1 = v1 * sc; u32x4 w; w.x = cvt_pk_bf16(v0[0], v0[1]); w.y = cvt_pk_bf16(v0[2], v0[3]); w.z = cvt_pk_bf16(v1[0], v1[1]); w.w = cvt_pk_bf16(v1[2], v1[3]);
                    *(u32x4*)(rowp + bj * HALF) = w; } }
    }
};
template <class Epi, class Sched, bool ALIGN_EPI = false, bool SP2 = false>
__device__ __forceinline__ void gemm_phase(PG8_LAS unsigned char* lds, const Gemm g, const Sched& S, const Epi& E, int tid_in) {
    int tid_ = tid_in; asm volatile("" : "+v"(tid_));
    const int tid = tid_, wid = __builtin_amdgcn_readfirstlane(tid >> 6), lane = tid & 63, wr = wid >> 2, wc = wid & 3, fr = lane & 15, fq = lane >> 4;
    const int K = g.K, nt = K / BK;
    unsigned voffA[2], voffB[2];
#pragma unroll
    for (int i = 0; i < 2; ++i) { int R, C; stage_rc(tid * 16 + i * 8192, R, C); const int Rb = Epi::PERM ? ((R & ~31) + perm32(R & 31)) : R;
        voffA[i] = (unsigned)(R * g.lda + C) * 2u; voffB[i] = (unsigned)(Rb * K + C) * 2u; }
    const size_t kstep = (size_t)(BK * 2);
    const size_t hstep = (size_t)HALF * K * 2;
    const size_t tstep = 2 * hstep; const size_t hstepA = (size_t)HALF * g.lda * 2, tstepA = 2 * hstepA;
    const unsigned ldsw = (unsigned)wid * 1024u;
    const int aoff = lds_byte(wr * 64 + fr, fq * 8), boff = lds_byte(wc * 32 + fr, fq * 8);
#define PG8_SA(b, h) (((b) * 2 + (h)) * HTB)
#define PG8_SB(b, h) ((4 + (b) * 2 + (h)) * HTB)
#define PG8_STAGE(bufoff, gbase, voff) do { _Pragma("unroll") for (int _i = 0; _i < 2; ++_i) \
        __builtin_amdgcn_global_load_lds((const unsigned*)((const char*)(gbase) + (voff)[_i]), (PG8_LAS unsigned*)(lds + (bufoff) + ldsw + _i * 8192), 16, 0, 0); } while (0)
#define PG8_LDA(dst, b, h) do { _Pragma("unroll") for (int m = 0; m < 4; ++m) _Pragma("unroll") for (int k = 0; k < 2; ++k) dst[m][k] = *(const PG8_LAS bf16x8*)(lds + PG8_SA(b, h) + aoff + m * 2048 + k * 1024); } while (0)
#define PG8_LDB(dst, b, h) do { _Pragma("unroll") for (int n = 0; n < 2; ++n) _Pragma("unroll") for (int k = 0; k < 2; ++k) dst[n][k] = *(const PG8_LAS bf16x8*)(lds + PG8_SB(b, h) + boff + n * 2048 + k * 1024); } while (0)
#define PG8_MMA(ai, bj, At, Bt) do { __builtin_amdgcn_s_setprio(1); _Pragma("unroll") for (int m = 0; m < 4; ++m) _Pragma("unroll") for (int n = 0; n < 2; ++n) _Pragma("unroll") for (int k = 0; k < 2; ++k) \
        acc[ai][bj][m][n] = __builtin_amdgcn_mfma_f32_16x16x32_bf16(Bt[n][k], At[m][k], acc[ai][bj][m][n], 0, 0, 0); __builtin_amdgcn_s_setprio(0); } while (0)
#define PG8_WAIT_V(n) asm volatile("s_waitcnt vmcnt(" #n ")" ::: "memory")
#define PG8_WAIT_L(n) asm volatile("s_waitcnt lgkmcnt(" #n ")" ::: "memory")
#define PG8_BAR __builtin_amdgcn_s_barrier()
#define PG8_SCHED __builtin_amdgcn_sched_barrier(0)
    Unit cur, nxt; int ui = 0;
    if (!S.next(0, cur)) return;
    f32x4 acc[2][2][4][2];
#pragma unroll
    for (int a = 0; a < 2; ++a)
#pragma unroll
        for (int b = 0; b < 2; ++b)
#pragma unroll
            for (int m = 0; m < 4; ++m)
#pragma unroll
                for (int n = 0; n < 2; ++n) acc[a][b][m][n] = (f32x4){0.f, 0.f, 0.f, 0.f};
    bf16x8 At[4][2], B0[2][2], B1[2][2];
    const char* cA = (const char*)g.A + (size_t)cur.pm * tstepA; const char* cB = (const char*)g.Bt + (size_t)cur.pn * tstep;
    S.a_ready(cur);
    if constexpr (SP2) {
        PG8_STAGE(PG8_SB(0, 0), cB, voffB); PG8_STAGE(PG8_SB(0, 1), cB + hstep, voffB); PG8_STAGE(PG8_SA(0, 0), cA, voffA); PG8_STAGE(PG8_SA(0, 1), cA + hstepA, voffA);
        if (wr == 1) PG8_BAR;
        PG8_WAIT_V(2); PG8_BAR;
        PG8_STAGE(PG8_SB(1, 0), cB + kstep, voffB); PG8_STAGE(PG8_SA(1, 0), cA + kstep, voffA); PG8_STAGE(PG8_SB(1, 1), cB + hstep + kstep, voffB);
        PG8_WAIT_V(6); PG8_BAR;
    } else {
        PG8_STAGE(PG8_SB(0, 0), cB, voffB); PG8_STAGE(PG8_SA(0, 0), cA, voffA); PG8_STAGE(PG8_SB(0, 1), cB + hstep, voffB); PG8_STAGE(PG8_SA(0, 1), cA + hstepA, voffA);
        if (wr == 1) PG8_BAR;
        PG8_WAIT_V(4); PG8_BAR;
        PG8_STAGE(PG8_SB(1, 0), cB + kstep, voffB); PG8_STAGE(PG8_SA(1, 0), cA + kstep, voffA); PG8_STAGE(PG8_SB(1, 1), cB + hstep + kstep, voffB);
        PG8_WAIT_V(6); PG8_BAR;
    }
    for (;;) {
        const bool has_next = S.next(ui + 1, nxt);
        const char* nA = has_next ? (const char*)g.A + (size_t)nxt.pm * tstepA : cA; const char* nB = has_next ? (const char*)g.Bt + (size_t)nxt.pn * tstep : cB;
        for (int t = 0; t < nt; t += 2) {
            const bool last = (t == nt - 2);
            const char* a1 = cA + (size_t)(t + 1) * kstep;
            const char* a2 = last ? nA : cA + (size_t)(t + 2) * kstep; const char* b2 = last ? nB : cB + (size_t)(t + 2) * kstep;
            const char* a3 = a2 + kstep; const char* b3 = b2 + kstep;
            if (last && has_next) S.a_ready(nxt);
            if constexpr (SP2) {
            PG8_LDB(B0, 0, 0); PG8_LDB(B1, 0, 1); PG8_SCHED; PG8_LDA(At, 0, 0); PG8_STAGE(PG8_SA(1, 1), a1 + hstepA, voffA);
            PG8_WAIT_V(8); PG8_WAIT_L(0); PG8_BAR; PG8_MMA(0, 0, At, B0); PG8_MMA(0, 1, At, B1); PG8_BAR; PG8_SCHED;
            PG8_LDA(At, 0, 1); PG8_STAGE(PG8_SB(0, 0), b2, voffB); PG8_STAGE(PG8_SB(0, 1), b2 + hstep, voffB); PG8_STAGE(PG8_SA(0, 0), a2, voffA);
            PG8_WAIT_V(8); PG8_WAIT_L(0); PG8_BAR; PG8_MMA(1, 0, At, B0); PG8_MMA(1, 1, At, B1); PG8_BAR; PG8_SCHED;
            PG8_LDB(B0, 1, 0); PG8_LDB(B1, 1, 1); PG8_SCHED; PG8_LDA(At, 1, 0); PG8_STAGE(PG8_SA(0, 1), a2 + hstepA, voffA);
            PG8_WAIT_V(8); PG8_WAIT_L(0); PG8_BAR; PG8_MMA(0, 0, At, B0); PG8_MMA(0, 1, At, B1); PG8_BAR; PG8_SCHED;
            PG8_LDA(At, 1, 1); PG8_STAGE(PG8_SB(1, 0), b3, voffB); PG8_STAGE(PG8_SB(1, 1), b3 + hstep, voffB); PG8_STAGE(PG8_SA(1, 0), a3, voffA);
            PG8_WAIT_V(8); PG8_WAIT_L(0); PG8_BAR; PG8_MMA(1, 0, At, B0); PG8_MMA(1, 1, At, B1); PG8_BAR; PG8_SCHED;
            } else {
            PG8_LDB(B0, 0, 0); PG8_SCHED; PG8_LDA(At, 0, 0); PG8_STAGE(PG8_SA(1, 1), a1 + hstepA, voffA);
            PG8_WAIT_L(8); PG8_BAR; PG8_WAIT_L(0); PG8_MMA(0, 0, At, B0); PG8_BAR; PG8_SCHED;
            PG8_LDB(B1, 0, 1); PG8_STAGE(PG8_SB(0, 0), b2, voffB);
            PG8_BAR; PG8_WAIT_L(0); PG8_MMA(0, 1, At, B1); PG8_BAR;
            PG8_LDA(At, 0, 1); PG8_STAGE(PG8_SA(0, 0), a2, voffA);
            PG8_BAR; PG8_WAIT_L(0); PG8_MMA(1, 0, At, B0); PG8_BAR; PG8_SCHED;
            PG8_STAGE(PG8_SB(0, 1), b2 + hstep, voffB);
            PG8_WAIT_V(6); PG8_BAR; PG8_MMA(1, 1, At, B1); PG8_BAR;
            PG8_LDB(B0, 1, 0); PG8_SCHED; PG8_LDA(At, 1, 0); PG8_STAGE(PG8_SA(0, 1), a2 + hstepA, voffA);
            PG8_WAIT_L(8); PG8_BAR; PG8_WAIT_L(0); PG8_MMA(0, 0, At, B0); PG8_BAR; PG8_SCHED;
            PG8_LDB(B1, 1, 1); PG8_STAGE(PG8_SB(1, 0), b3, voffB);
            PG8_BAR; PG8_WAIT_L(0); PG8_MMA(0, 1, At, B1); PG8_BAR;
            PG8_LDA(At, 1, 1); PG8_STAGE(PG8_SA(1, 0), a3, voffA);
            PG8_BAR; PG8_WAIT_L(0); PG8_MMA(1, 0, At, B0); PG8_BAR; PG8_SCHED;
            PG8_STAGE(PG8_SB(1, 1), b3 + hstep, voffB);
            PG8_WAIT_V(6); PG8_BAR; PG8_MMA(1, 1, At, B1); PG8_BAR;
            }
        }
        if constexpr (ALIGN_EPI) { if (wr == 0) PG8_BAR; }
        if constexpr (!Epi::AFTER_DRAIN) { E(acc, cur, wr, wc, fr, fq); S.done(cur); }
        if (!has_next) break;
#pragma unroll
        for (int a = 0; a < 2; ++a)
#pragma unroll
            for (int b = 0; b < 2; ++b)
#pragma unroll
                for (int m = 0; m < 4; ++m)
#pragma unroll
                    for (int n = 0; n < 2; ++n) acc[a][b][m][n] = (f32x4){0.f, 0.f, 0.f, 0.f};
        cur = nxt; cA = nA; cB = nB; ++ui;
        if constexpr (ALIGN_EPI) { if (wr == 1) PG8_BAR; }
    }
    PG8_WAIT_V(0);
    if constexpr (!ALIGN_EPI) { if (wr == 0) PG8_BAR; }
    PG8_BAR;
    if constexpr (Epi::AFTER_DRAIN) { E.fused(acc, cur, wr, wc, fr, fq, lds, wid, lane); S.done(cur); }
#undef PG8_SA
#undef PG8_SB
#undef PG8_STAGE
#undef PG8_LDA
#undef PG8_LDB
#undef PG8_MMA
#undef PG8_WAIT_V
#undef PG8_WAIT_L
#undef PG8_BAR
#undef PG8_SCHED
}
}
namespace pg8 {
template <class T> __device__ __forceinline__ T* uni_ptr(T* p) {
    const unsigned long long v = (unsigned long long)p; unsigned lo = __builtin_amdgcn_readfirstlane((unsigned)v), hi = __builtin_amdgcn_readfirstlane((unsigned)(v >> 32)); asm volatile("" : "+s"(lo), "+s"(hi)); return (T*)(((unsigned long long)hi << 32) | lo); }
template <bool XB16> struct EpiResid {
    static constexpr bool PERM = true, AFTER_DRAIN = false;
    const void* xin_; bf16_t* out_; const float* gate_;
    __device__ __forceinline__ void operator()(const f32x4 (&acc)[2][2][4][2], const Unit& u, int wr, int wc, int fr, int fq) const {
        const void* xin = uni_ptr(xin_); bf16_t* out = uni_ptr(out_); const float* gate = uni_ptr(gate_);
        const int row0 = u.pm * BM + wr * 64 + fr, col0 = u.pn * BM + wc * 32 + 8 * fq;
        const float* gp = gate + (size_t)(u.pm >> 5) * 6144 + col0;
        f32x4 gv[2][2];
#pragma unroll
        for (int bj = 0; bj < 2; ++bj)
#pragma unroll
            for (int n = 0; n < 2; ++n) gv[bj][n] = *(const f32x4*)(gp + bj * HALF + 4 * n);
#pragma unroll
        for (int ai = 0; ai < 2; ++ai)
#pragma unroll
            for (int m = 0; m < 4; ++m) { const size_t off = (size_t)(row0 + ai * HALF + m * 16) * 1024 + col0;
#pragma unroll
                for (int bj = 0; bj < 2; ++bj) { f32x4 x0, x1;
                    if (XB16) { const u32x4 xr = *(const u32x4*)((const bf16_t*)xin + off + bj * HALF);
                        x0 = (f32x4){__uint_as_float(xr.x << 16), __uint_as_float(xr.x & 0xffff0000u), __uint_as_float(xr.y << 16), __uint_as_float(xr.y & 0xffff0000u)};
                        x1 = (f32x4){__uint_as_float(xr.z << 16), __uint_as_float(xr.z & 0xffff0000u), __uint_as_float(xr.w << 16), __uint_as_float(xr.w & 0xffff0000u)}; }
                    else { x0 = *(const f32x4*)((const float*)xin + off + bj * HALF); x1 = *(const f32x4*)((const float*)xin + off + bj * HALF + 4); }
                    const f32x4 y0 = x0 + gv[bj][0] * acc[ai][bj][m][0], y1 = x1 + gv[bj][1] * acc[ai][bj][m][1];
                    u32x4 w; w.x = cvt_pk_bf16(y0[0], y0[1]); w.y = cvt_pk_bf16(y0[2], y0[3]); w.z = cvt_pk_bf16(y1[0], y1[1]); w.w = cvt_pk_bf16(y1[2], y1[3]);
                    *(u32x4*)(out + off + bj * HALF) = w; }
                if (m & 1) asm volatile("" ::: "memory"); }
    }
};
struct EpiRelu2 {
    static constexpr bool PERM = true, AFTER_DRAIN = false;
    bf16_t* O_; int ldc;
    __device__ __forceinline__ void operator()(const f32x4 (&acc)[2][2][4][2], const Unit& u, int wr, int wc, int fr, int fq) const {
        bf16_t* O = uni_ptr(O_);
        const int row0 = u.pm * BM + wr * 64 + fr, col0 = u.pn * BM + wc * 32 + 8 * fq;
#pragma unroll
        for (int ai = 0; ai < 2; ++ai)
#pragma unroll
            for (int m = 0; m < 4; ++m) { bf16_t* rowp = O + (size_t)(row0 + ai * HALF + m * 16) * ldc + col0;
#pragma unroll
                for (int bj = 0; bj < 2; ++bj) { f32x4 v0 = acc[ai][bj][m][0], v1 = acc[ai][bj][m][1];
                    v0 = __builtin_elementwise_max(v0, (f32x4){0.f, 0.f, 0.f, 0.f}); v1 = __builtin_elementwise_max(v1, (f32x4){0.f, 0.f, 0.f, 0.f}); v0 = v0 * v0; v1 = v1 * v1;
                    u32x4 w; w.x = cvt_pk_bf16(v0[0], v0[1]); w.y = cvt_pk_bf16(v0[2], v0[3]); w.z = cvt_pk_bf16(v1[0], v1[1]); w.w = cvt_pk_bf16(v1[2], v1[3]);
                    *(u32x4*)(rowp + bj * HALF) = w; } }
    }
};
struct EpiMlaQ {
    static constexpr bool PERM = true, AFTER_DRAIN = false;
    bf16_t* QM_;
    __device__ __forceinline__ void operator()(const f32x4 (&acc)[2][2][4][2], const Unit& u, int wr, int wc, int fr, int fq) const {
        bf16_t* QM = uni_ptr(QM_);
        const int row0 = u.pm * BM + wr * 64 + fr, cw = wc * 32 + 8 * fq;
        const int nbj = (u.pn != 0) ? 1 : 2;
#pragma unroll
        for (int ai = 0; ai < 2; ++ai)
#pragma unroll
            for (int m = 0; m < 4; ++m) { bf16_t* qr = QM + (size_t)(row0 + ai * HALF + m * 16) * 384 + u.pn * 256 + cw;
#pragma unroll
                for (int bj = 0; bj < 2; ++bj) if (bj < nbj) { const f32x4 v0 = acc[ai][bj][m][0], v1 = acc[ai][bj][m][1];
                    u32x4 o; o.x = cvt_pk_bf16(v0[0], v0[1]); o.y = cvt_pk_bf16(v0[2], v0[3]); o.z = cvt_pk_bf16(v1[0], v1[1]); o.w = cvt_pk_bf16(v1[2], v1[3]);
                    *(u32x4*)(qr + bj * HALF) = o; } }
    }
};
struct EpiMlaKV {
    static constexpr bool PERM = true, AFTER_DRAIN = false;
    bf16_t* KM_; bf16_t* VM_; const float* rskv_;
    __device__ __forceinline__ void operator()(const f32x4 (&acc)[2][2][4][2], const Unit& u, int wr, int wc, int fr, int fq) const {
        bf16_t* KM = uni_ptr(KM_); bf16_t* VM = uni_ptr(VM_); const float* rskv = uni_ptr(rskv_);
        const int row0 = u.pm * BM + wr * 64 + fr, w = wc * 32 + 8 * fq;
        const bool isk = wc < 2;
#pragma unroll
        for (int ai = 0; ai < 2; ++ai)
#pragma unroll
            for (int m = 0; m < 4; ++m) { const int row = row0 + ai * HALF + m * 16; const float rs = rskv[row];
#pragma unroll
                for (int bj = 0; bj < 2; ++bj) { const int head = u.pn * 2 + bj;
                    const f32x4 v0 = acc[ai][bj][m][0] * rs, v1 = acc[ai][bj][m][1] * rs;
                    u32x4 o; o.x = cvt_pk_bf16(v0[0], v0[1]); o.y = cvt_pk_bf16(v0[2], v0[3]); o.z = cvt_pk_bf16(v1[0], v1[1]); o.w = cvt_pk_bf16(v1[2], v1[3]);
                    if (isk) *(u32x4*)(KM + (size_t)row * 384 + head * 96 + w) = o; else *(u32x4*)(VM + (size_t)row * 256 + head * 64 + (w - 64)) = o; }
                asm volatile("" ::: "memory"); }
    }
};
}
#define GAS __attribute__((address_space(1)))
#define LAS __attribute__((address_space(3)))
typedef unsigned short bf16;
typedef unsigned v4u __attribute__((ext_vector_type(4)));
typedef float f32x4 __attribute__((ext_vector_type(4)));
typedef short bf16x8 __attribute__((ext_vector_type(8)));
typedef GAS unsigned gu32;
typedef GAS unsigned long long gu64;
#define RLX_AGENT __ATOMIC_RELAXED, __HIP_MEMORY_SCOPE_AGENT
#define LDS_WAIT() asm volatile("s_waitcnt lgkmcnt(0)" ::: "memory")
#define VM_WAIT() asm volatile("s_waitcnt vmcnt(0)" ::: "memory")
__device__ __forceinline__ unsigned long long rt() { return __builtin_amdgcn_s_memrealtime(); }
__device__ __forceinline__ unsigned f2bf(float f) { unsigned u = __builtin_bit_cast(unsigned, f); return (u + 0x7fffu + ((u >> 16) & 1u)) >> 16; }
__device__ __forceinline__ unsigned pk2(float lo, float hi) { return f2bf(lo) | (f2bf(hi) << 16); }

#define XB_TMO      128
#define XB_XCNT(j)  (256  + 64 * (j))
#define XB_XSUB(j)  (1280 + 64 * (j))
#define XB_XGEN(j)  (2304 + 64 * (j))
#define XB_TOP      3328
#define XB_TOPGEN   3392
#define XCD_BAR_WORDS 3456
#define XB_SPIN_CAP (1u << 18)

__device__ __forceinline__ unsigned xb_ld(unsigned* p)              { return __hip_atomic_load(p, __ATOMIC_RELAXED, __HIP_MEMORY_SCOPE_AGENT); }
__device__ __forceinline__ unsigned xb_add(unsigned* p, unsigned v) { return __hip_atomic_fetch_add(p, v, __ATOMIC_RELAXED, __HIP_MEMORY_SCOPE_AGENT); }
__device__ __forceinline__ unsigned xb_xcc_id() { return (unsigned)__builtin_amdgcn_s_getreg((3 << 11) | 20) & 0xFu; }
#define XB_SPIN(cond, bar) do { unsigned _sp = 0; while (cond) { __builtin_amdgcn_s_sleep(1); \
    if ((++_sp & 255u) == 0u) { if (xb_ld(&(bar)[XB_TMO])) break; if (_sp > XB_SPIN_CAP) { atomicAdd(&(bar)[XB_TMO], 1u); break; } } } } while (0)

struct XcdBarrier {
    unsigned* bar; unsigned x;
    volatile LAS unsigned* st;
};

__device__ __forceinline__ XcdBarrier xcd_barrier_post(unsigned* bar, volatile LAS unsigned* st) {
    XcdBarrier b; b.bar = bar; b.x = xb_xcc_id(); b.st = st;
    if (threadIdx.x == 0) (void)xb_add(&bar[XB_XCNT(b.x)], 1u);
    return b;
}
__device__ __forceinline__ void xcd_barrier_complete(unsigned* bar, unsigned x, unsigned& nloc, unsigned& nx) {
    const unsigned G = gridDim.x * gridDim.y * gridDim.z;
    unsigned sum, cnt, mine, sp = 0u;
    for (;;) {
        sum = 0u; cnt = 0u; mine = 0u;
#pragma unroll
        for (unsigned j = 0; j < 16; ++j) { const unsigned c = xb_ld(&bar[XB_XCNT(j)]); sum += c; cnt += (c > 0u) ? 1u : 0u; mine = (j == x) ? c : mine; }
        if (sum == G) break;
        __builtin_amdgcn_s_sleep(1);
        if ((++sp & 255u) == 0u) { if (xb_ld(&bar[XB_TMO])) break; if (sp > XB_SPIN_CAP) { atomicAdd(&bar[XB_TMO], 1u); break; } }
    }
    nloc = mine > 0u ? mine : 1u; nx = cnt > 0u ? cnt : 1u;
}

__device__ __forceinline__ void xcd_barrier(const XcdBarrier& b) {
    asm volatile("s_waitcnt vmcnt(0)" ::: "memory");
    __syncthreads();
    if (threadIdx.x == 0) {
        unsigned* bar = b.bar;
        __builtin_amdgcn_s_waitcnt(0);
        unsigned nloc = b.st[0], nx = b.st[1];
        if (nloc == 0u) { xcd_barrier_complete(bar, b.x, nloc, nx); b.st[0] = nloc; b.st[1] = nx; }
        const unsigned old = xb_add(&bar[XB_XSUB(b.x)], 1u);
        const unsigned gen = old / nloc;
        if (old + 1u == (gen + 1u) * nloc) {
            __builtin_amdgcn_fence(__ATOMIC_RELEASE, "agent");
            asm volatile("s_waitcnt vmcnt(0)" ::: "memory");
            const unsigned og = xb_add(&bar[XB_TOP], 1u);
            const unsigned tg = og / nx;
            if (og + 1u == (tg + 1u) * nx) xb_add(&bar[XB_TOPGEN], 1u);
            else XB_SPIN(xb_ld(&bar[XB_TOPGEN]) == tg, bar);
            __builtin_amdgcn_fence(__ATOMIC_ACQUIRE, "agent");
            xb_add(&bar[XB_XGEN(b.x)], 1u);
            asm volatile("s_waitcnt vmcnt(0)" ::: "memory");
        } else {
            XB_SPIN(xb_ld(&bar[XB_XGEN(b.x)]) == gen, bar);
            __builtin_amdgcn_fence(__ATOMIC_ACQUIRE, "agent");
            asm volatile("s_waitcnt vmcnt(0)" ::: "memory");
        }
    }
    __syncthreads();
}
#ifndef FA_PROBE
#define FA_PROBE 0
#endif
#ifndef FA_EXP
#define FA_EXP 0
#endif
namespace fa {
typedef unsigned short bf16;
typedef short bf16x8 __attribute__((ext_vector_type(8)));
typedef short s16x4 __attribute__((ext_vector_type(4)));
typedef float f32x16 __attribute__((ext_vector_type(16)));
typedef float f32x4v __attribute__((ext_vector_type(4)));
typedef unsigned u32x4 __attribute__((ext_vector_type(4)));
typedef unsigned u32x2 __attribute__((ext_vector_type(2)));
typedef float f32x2_t __attribute__((ext_vector_type(2)));
typedef __bf16 bf16x2_t __attribute__((ext_vector_type(2)));
#define FLAS __attribute__((address_space(3)))
#define FGAS __attribute__((address_space(1)))
constexpr float MASKV = -1e30f, MINIT = -5e29f, TINYF = 1e-30f, LOG2E = 1.4426950408889634f;
constexpr int OSTR = 144;

__device__ __forceinline__ float ex2(float x) { return __builtin_amdgcn_exp2f(x); }
__device__ __forceinline__ unsigned cvtpk(float lo, float hi) { f32x2_t v = {lo, hi}; bf16x2_t b = __builtin_convertvector(v, bf16x2_t); return __builtin_bit_cast(unsigned, b); }
__device__ __forceinline__ float xhalf_max(float m) { auto rr = __builtin_amdgcn_permlane32_swap(__float_as_uint(m), __float_as_uint(m), false, false); return fmaxf(__uint_as_float(rr[0]), __uint_as_float(rr[1])); }
__device__ __forceinline__ float xhalf_sum(float m) { auto rr = __builtin_amdgcn_permlane32_swap(__float_as_uint(m), __float_as_uint(m), false, false); return __uint_as_float(rr[0]) + __uint_as_float(rr[1]); }
__device__ __forceinline__ float bf2f(unsigned short b) { return __uint_as_float((unsigned)b << 16); }

struct SM { float m, l; f32x16 o[2]; };
__device__ __forceinline__ void sm_init(SM& s) { s.m = MINIT; s.l = 0.f; s.o[0] = f32x16{}; s.o[1] = f32x16{}; }

template <int DQ> struct Stg { u32x4 k0, k1, v; };
template <int DQ> __device__ __forceinline__ void stg_load(Stg<DQ>& s, const FGAS char* ws, unsigned koff, unsigned ksb, unsigned voff, unsigned vsb, int key0, int kmax, int tid) {
    const int row = tid >> 3, ch = tid & 7; int kr = key0 + row; kr = kr < kmax ? kr : kmax;
    s.k0 = *(const FGAS u32x4*)(ws + (koff + (unsigned)kr * ksb + (unsigned)ch * 16u));
    s.v = *(const FGAS u32x4*)(ws + (voff + (unsigned)kr * vsb + (unsigned)ch * 16u));
    if (DQ == 96) { if (tid < 256) { const int r2 = tid >> 2, c2 = tid & 3; int k2 = key0 + r2; k2 = k2 < kmax ? k2 : kmax; s.k1 = *(const FGAS u32x4*)(ws + (koff + (unsigned)k2 * ksb + 128u + (unsigned)c2 * 16u)); } }
}
template <int DQ> __device__ __forceinline__ void stg_store(const Stg<DQ>& s, FLAS char* buf, int tid) {
    const int row = tid >> 3, ch = tid & 7, p = ch >> 2, c = ch & 3;
    *(FLAS u32x4*)(buf + p * 4096 + row * 64 + ((c ^ ((row >> 2) & 3)) << 4)) = s.k0;
    *(FLAS u32x4*)(buf + (DQ / 32) * 4096 + row * 128 + ((p ^ ((row >> 1) & 1)) << 6) + (c << 4)) = s.v;
    if (DQ == 96) { if (tid < 256) { const int r2 = tid >> 2, c2 = tid & 3; *(FLAS u32x4*)(buf + 2 * 4096 + r2 * 64 + ((c2 ^ ((r2 >> 2) & 3)) << 4)) = s.k1; } }
}
template <int DQ> constexpr int stage_bytes() { return (DQ / 32) * 4096 + 8192; }

template <int DQ> __device__ __forceinline__ void compute_S(f32x16& p0, f32x16& p1, const FLAS char* buf, const bf16x8 (&qf)[DQ / 16], int lane) {
    const int r = lane & 31, h = lane >> 5, sw = (r >> 2) & 3;
#pragma unroll
    for (int d0 = 0; d0 < DQ / 16; ++d0) {
        const int p = d0 >> 1, c = 2 * (d0 & 1) + h;
        const FLAS char* a = buf + p * 4096 + r * 64 + ((c ^ sw) << 4);
        const bf16x8 a0 = *(const FLAS bf16x8*)a, a1 = *(const FLAS bf16x8*)(a + 2048);
        p0 = __builtin_amdgcn_mfma_f32_32x32x16_bf16(a0, qf[d0], p0, 0, 0, 0);
        p1 = __builtin_amdgcn_mfma_f32_32x32x16_bf16(a1, qf[d0], p1, 0, 0, 0);
    }
#if FA_EXP & 2
    __builtin_amdgcn_sched_group_barrier(0x100, 4, 0);
#pragma unroll
    for (int i = 0; i < DQ / 16 - 2; ++i) { __builtin_amdgcn_sched_group_barrier(0x008, 2, 0); __builtin_amdgcn_sched_group_barrier(0x100, 2, 0); }
    __builtin_amdgcn_sched_group_barrier(0x008, 4, 0);
#endif
}
__device__ __forceinline__ s16x4 vtr(const FLAS char* p) { typedef short v4i16_t __attribute__((ext_vector_type(4))); return __builtin_bit_cast(s16x4, __builtin_amdgcn_ds_read_tr16_b64_v4i16((FLAS v4i16_t*)p)); }
__device__ __forceinline__ void pv(f32x16 (&o)[2], const FLAS char* vbuf, const bf16x8 (&pf)[4], int lane) {
    const int g = lane >> 4, i = lane & 15, q4 = i >> 2, pp = i & 3, h = lane >> 5;
    const int sw = (q4 >> 1) & 1;
#pragma unroll
    for (int db = 0; db < 2; ++db) {
        const FLAS char* base = vbuf + (4 * h + q4) * 128 + ((db ^ sw) << 6) + (16 * (g & 1) + 4 * pp) * 2;
#pragma unroll
        for (int ks = 0; ks < 4; ++ks) {
            const s16x4 lo = vtr(base + ks * 2048), hi = vtr(base + ks * 2048 + 1024);
            const bf16x8 a = (bf16x8){lo[0], lo[1], lo[2], lo[3], hi[0], hi[1], hi[2], hi[3]};
            o[db] = __builtin_amdgcn_mfma_f32_32x32x16_bf16(a, pf[ks], o[db], 0, 0, 0);
        }
    }
#if FA_EXP & 2
    __builtin_amdgcn_sched_group_barrier(0x100, 8, 0);
    __builtin_amdgcn_sched_group_barrier(0x008, 2, 0); __builtin_amdgcn_sched_group_barrier(0x100, 4, 0);
    __builtin_amdgcn_sched_group_barrier(0x008, 2, 0); __builtin_amdgcn_sched_group_barrier(0x100, 4, 0);
    __builtin_amdgcn_sched_group_barrier(0x008, 4, 0);
#endif
}
__device__ __forceinline__ void mask_ew(f32x16& p0, f32x16& p1, int lo, int hi, int h) {
    const int lo2 = lo - 4 * h, hi2 = hi - 4 * h;
#pragma unroll
    for (int v = 0; v < 16; ++v) { const int k0 = (v & 3) + 8 * (v >> 2);
        if (k0 < lo2 || k0 > hi2) p0[v] = MASKV;
        if (k0 + 32 < lo2 || k0 + 32 > hi2) p1[v] = MASKV; }
}
__device__ __forceinline__ void sm_step(SM& st, f32x16& p0, f32x16& p1, bf16x8 (&pf)[4]) {
#define FA_MX3(a, b, c) __builtin_fmaxf(__builtin_fmaxf((a), (b)), (c))
    float ma = FA_MX3(p0[0], p0[1], p1[0]), mb = FA_MX3(p0[2], p0[3], p1[1]); ma = FA_MX3(ma, p1[2], p1[3]);
#pragma unroll
    for (int v = 4; v < 16; v += 4) { ma = FA_MX3(ma, p0[v], p0[v + 1]); mb = FA_MX3(mb, p0[v + 2], p0[v + 3]); ma = FA_MX3(ma, p1[v], p1[v + 1]); mb = FA_MX3(mb, p1[v + 2], p1[v + 3]); }
#undef FA_MX3
    const float mx = xhalf_max(__builtin_fmaxf(ma, mb));
    if (__any(mx > st.m)) {
        const float mn2 = fmaxf(st.m, mx), alpha = ex2(st.m - mn2);
        st.m = mn2; st.l *= alpha; st.o[0] *= alpha; st.o[1] *= alpha;
    }
    const float mn = st.m;
    float s0 = 0.f, s1 = 0.f;
#pragma unroll
    for (int v = 0; v < 16; ++v) { p0[v] = ex2(p0[v] - mn); p1[v] = ex2(p1[v] - mn); s0 += p0[v]; s1 += p1[v]; }
    st.l += s0 + s1;
    u32x4 w;
    w.x = cvtpk(p0[0], p0[1]); w.y = cvtpk(p0[2], p0[3]); w.z = cvtpk(p0[4], p0[5]); w.w = cvtpk(p0[6], p0[7]); pf[0] = __builtin_bit_cast(bf16x8, w);
    w.x = cvtpk(p0[8], p0[9]); w.y = cvtpk(p0[10], p0[11]); w.z = cvtpk(p0[12], p0[13]); w.w = cvtpk(p0[14], p0[15]); pf[1] = __builtin_bit_cast(bf16x8, w);
    w.x = cvtpk(p1[0], p1[1]); w.y = cvtpk(p1[2], p1[3]); w.z = cvtpk(p1[4], p1[5]); w.w = cvtpk(p1[6], p1[7]); pf[2] = __builtin_bit_cast(bf16x8, w);
    w.x = cvtpk(p1[8], p1[9]); w.y = cvtpk(p1[10], p1[11]); w.z = cvtpk(p1[12], p1[13]); w.w = cvtpk(p1[14], p1[15]); pf[3] = __builtin_bit_cast(bf16x8, w);
}
template <int DQ, bool ALIBI> __device__ __forceinline__ void score_tile(f32x16& p0, f32x16& p1, const FLAS char* buf, const bf16x8 (&qf)[DQ / 16], float cb, float sl, int lane) {
    if (ALIBI) {
#pragma unroll
        for (int v = 0; v < 16; ++v) { const float c = (float)((v & 3) + 8 * (v >> 2)); p0[v] = fmaf(sl, c, cb); p1[v] = fmaf(sl, c + 32.f, cb); }
    } else { p0 = f32x16{}; p1 = f32x16{}; }
    compute_S<DQ>(p0, p1, buf, qf, lane);
}
template <int DQ, bool ALIBI> __device__ __forceinline__ void tile_compute(SM& st, const FLAS char* buf, const bf16x8 (&qf)[DQ / 16], float cb, float sl, bool ew, int lo, int hi, int lane) {
    f32x16 p0, p1; bf16x8 pf[4];
    score_tile<DQ, ALIBI>(p0, p1, buf, qf, cb, sl, lane);
    if (ew) mask_ew(p0, p1, lo, hi, lane >> 5);
    sm_step(st, p0, p1, pf);
    pv(st.o, buf + (DQ / 32) * 4096, pf, lane);
}
template <int DQ, bool ALIBI, class K0, class PAR>
__device__ __forceinline__ void fa_loop(SM& st, const bf16x8 (&qf)[DQ / 16], const FGAS char* ws, unsigned koff, unsigned ksb, unsigned voff, unsigned vsb, int kmax, int ntile, K0 k0f, PAR parf, float sl, FLAS char* lds, int tid, int lane) {
    constexpr int STG = stage_bytes<DQ>();
    Stg<DQ> sgA, sgB;
    stg_load<DQ>(sgB, ws, koff, ksb, voff, vsb, k0f(0), kmax, tid); stg_store<DQ>(sgB, lds, tid);
    if (ntile > 1) stg_load<DQ>(sgA, ws, koff, ksb, voff, vsb, k0f(1), kmax, tid);
    if (ntile > 2) stg_load<DQ>(sgB, ws, koff, ksb, voff, vsb, k0f(2), kmax, tid);
    __syncthreads();
#if FA_PROBE && FA_PROBE < 9
    unsigned long long pr_c = 0, pr_w = 0, pr_b = 0, pr_t = 0; const unsigned long long pr_start = __builtin_amdgcn_s_memtime();
#define FA_P0 const unsigned long long q0_ = __builtin_amdgcn_s_memtime();
#define FA_P1 asm volatile("s_waitcnt vmcnt(0)" ::: "memory"); const unsigned long long q1_ = __builtin_amdgcn_s_memtime();
#define FA_P2 asm volatile("s_waitcnt lgkmcnt(0)" ::: "memory"); asm volatile("" : "+v"(st.o[0]), "+v"(st.o[1])); const unsigned long long q2_ = __builtin_amdgcn_s_memtime();
#define FA_P3 const unsigned long long q3_ = __builtin_amdgcn_s_memtime(); pr_w += q1_ - q0_; pr_c += q2_ - q1_; pr_b += q3_ - q2_; pr_t += 1;
#else
#define FA_P0
#define FA_P1
#define FA_P2
#define FA_P3
#endif
#define FA_ITER(SG) { \
        FA_P0 \
        if (t + 1 < ntile) stg_store<DQ>(SG, lds + ((t + 1) & 1) * STG, tid); \
        if (t + 3 < ntile) stg_load<DQ>(SG, ws, koff, ksb, voff, vsb, k0f(t + 3), kmax, tid); \
        FA_P1 \
        bool act, ew; float cb; int lo, hi; \
        parf(t, act, ew, cb, lo, hi); \
        if (act) tile_compute<DQ, ALIBI>(st, lds + (t & 1) * STG, qf, cb, sl, ew, lo, hi, lane); \
        FA_P2 \
        __syncthreads(); \
        FA_P3 }
    int t = 0;
    for (; t + 1 < ntile; t += 2) { FA_ITER(sgA) ++t; FA_ITER(sgB) --t; }
    if (t < ntile) FA_ITER(sgA)
#undef FA_ITER
#if FA_PROBE && FA_PROBE < 9
    if (DQ == 96 && lane == 0) { unsigned long long* pp = (unsigned long long*)((FGAS char*)ws + 32768);
        atomicAdd(pp + 0, pr_c); atomicAdd(pp + 1, pr_w); atomicAdd(pp + 2, pr_b); atomicAdd(pp + 3, pr_t); atomicAdd(pp + 4, __builtin_amdgcn_s_memtime() - pr_start); }
#endif
}
__device__ __forceinline__ void sm_finish(const SM& st, float gate, f32x16 (&acc)[2]) {
    const float inv = gate / fmaxf(xhalf_sum(st.l), TINYF);
    acc[0] += st.o[0] * inv; acc[1] += st.o[1] * inv;
}
template <class DST> __device__ __forceinline__ void store_out(const f32x16 (&acc)[2], FLAS char* ost, FGAS char* ws, DST dstf, int lane) {
    const int r = lane & 31, h = lane >> 5;
#pragma unroll
    for (int db = 0; db < 2; ++db)
#pragma unroll
        for (int g = 0; g < 4; ++g) { u32x2 w; w.x = cvtpk(acc[db][4 * g], acc[db][4 * g + 1]); w.y = cvtpk(acc[db][4 * g + 2], acc[db][4 * g + 3]);
            *(FLAS u32x2*)(ost + r * OSTR + (32 * db + 8 * g + 4 * h) * 2) = w; }
    asm volatile("s_waitcnt lgkmcnt(0)" ::: "memory");
#pragma unroll
    for (int i = 0; i < 4; ++i) { const int idx = i * 64 + lane, col = idx >> 3, ch = idx & 7;
        const u32x4 v = *(const FLAS u32x4*)(ost + col * OSTR + ch * 16);
        *(FGAS u32x4*)(ws + (dstf(col) + (unsigned)ch * 16u)) = v; }
    asm volatile("s_waitcnt lgkmcnt(0)" ::: "memory");
}
template <int DQ> __device__ __forceinline__ void load_q(bf16x8 (&qf)[DQ / 16], const FGAS char* ws, unsigned qoff, int h) {
#pragma unroll
    for (int d0 = 0; d0 < DQ / 16; ++d0) qf[d0] = *(const FGAS bf16x8*)(ws + (qoff + (unsigned)(d0 * 32 + 16 * h)));
}
}
namespace mk {
typedef unsigned short bf16;
typedef float f32x4 __attribute__((ext_vector_type(4)));
typedef unsigned v4u __attribute__((ext_vector_type(4)));
typedef unsigned v2u __attribute__((ext_vector_type(2)));
typedef short bf16x8 __attribute__((ext_vector_type(8)));
typedef float f32x16 __attribute__((ext_vector_type(16)));
using fa::SM;

constexpr int D = 1024, NB = 4, SEQ = 8192, M = NB * SEQ, DEPTH = 2, DFF = 4096, ZLD = 2304, DIN = 2284;
constexpr int ZA_Q = 0, ZA_K = 256, ZA_V = 384, ZB_CQ = 512, ZB_CKV = 704, ZB_PE = 832, ZC_Q = 864, ZC_KC = 1120, ZC_VC = 1184, ZC_KS = 1248, ZC_VS = 1312, ZC_KW = 1376, ZC_VW = 1440, ZC_GL = 1504, ZD_Q = 1520, ZD_K = 1776, ZD_V = 2032;
constexpr float LOG2E = 1.4426950408889634f;
constexpr float QS = 0.125f * LOG2E;
constexpr float C_MLA = 0.10206207261596577f * LOG2E;
constexpr float RMS_EPS = 1e-6f;
constexpr int NWAVES = 8, NTHR = 512;

constexpr size_t MiB = 1u << 20;
constexpr size_t WS_CTL = 0, CTL_ZERO_BYTES = 64 * 1024;
constexpr size_t WS_MOD = 1 * MiB;
constexpr size_t WS_ROPE = WS_MOD + 256 * 1024;
constexpr size_t WS_POSP = WS_ROPE + 1 * MiB;
constexpr size_t WS_POSB = WS_POSP + 64 * 1024;
constexpr size_t WS_RSQ = WS_POSB + 64 * 1024;
constexpr size_t WS_RSKV = WS_RSQ + 128 * 1024;
constexpr size_t WS_KMH = WS_RSKV + 128 * 1024;
constexpr size_t WS_KML = WS_KMH + 64 * 1024;
constexpr size_t WS_KCMP = WS_KML + 64 * 1024;
constexpr size_t WS_VCMP = WS_KCMP + 256 * 1024;
constexpr size_t WS_XB = 436 * MiB;
constexpr size_t WS_PARK = 401 * MiB;
constexpr size_t WS_W = 4 * MiB, WS_WL = 26 * MiB;
constexpr size_t W_IN = 0, W_OUT = 4608 * 1024, W_UP = W_OUT + 2 * MiB, W_DN = W_UP + 8 * MiB, W_UQ = W_DN + 8 * MiB, W_UKV = W_UQ + 256 * 1024, W_1K = W_UKV + 256 * 1024, W_1V = W_1K + 512 * 1024, W_2K = W_1V + 512 * 1024, W_2V = W_2K + 16 * 1024;
static_assert(W_2V + 16 * 1024 <= WS_WL && WS_VCMP + 256 * 1024 <= WS_W, "ws map");
constexpr size_t WS_H = 56 * MiB;
constexpr size_t WS_Z = 120 * MiB;
constexpr size_t WS_QM = 265 * MiB, WS_KM = 297 * MiB, WS_VM = 321 * MiB, WS_O = 337 * MiB, WS_U = 120 * MiB, WS_END = 401 * MiB;
static_assert(WS_Z + (size_t)(M + 64) * ZLD * 2 <= WS_QM && WS_U + (size_t)M * DFF * 2 <= WS_END, "ws map 2");

constexpr int LDS_RING = 131072, LDS_BYTES = 163840, LDS_MISC = LDS_BYTES - 256;
constexpr int FA_STAGES = 0, FA_OST = 61440, FA_IMP = FA_OST + 8 * 32 * fa::OSTR  , FA_SELM = FA_IMP + 32768, FA_UM = FA_SELM + 1024, FA_VALS = FA_UM + 64;
static_assert(FA_VALS + 8 * 512 <= LDS_MISC, "fa lds map");
constexpr int MB_OS = 65;
constexpr int MB_T = 0, MB_O = 65536, MB_ML = MB_O + 256 * MB_OS * 4, MB_CNT = MB_ML + 2048, MB_LST = MB_CNT + 128, MB_PS = MB_LST + 8192, MB_PM = MB_PS + 4 * 32 * 33 * 4;
static_assert(MB_PM + 1024 <= LDS_MISC, "moba lds map");

#define GAS __attribute__((address_space(1)))
#define LAS __attribute__((address_space(3)))
#define LDS_WAIT() asm volatile("s_waitcnt lgkmcnt(0)" ::: "memory")
__device__ __forceinline__ unsigned f2bf(float f) { unsigned u = __builtin_bit_cast(unsigned, f); return (u + 0x7fffu + ((u >> 16) & 1u)) >> 16; }
__device__ __forceinline__ unsigned pk2(float lo, float hi) { return f2bf(lo) | (f2bf(hi) << 16); }
__device__ __forceinline__ float bf2f(unsigned short b) { return __uint_as_float((unsigned)b << 16); }
__device__ __forceinline__ float wave_sum(float v) {
#pragma unroll
    for (int o = 1; o < 64; o <<= 1) v += __shfl_xor(v, o);
    return v;
}
__device__ __forceinline__ float slope2_of(int i) { return exp2f(-8.0f * (float)(i + 1) / 12.0f) * LOG2E; }

struct Args { const float* in[22]; float* out; unsigned char* ws; int ph_lo, ph_hi, skip, rep; };
typedef const __attribute__((address_space(4))) Args* KArgsP;
struct Frame {
    LAS unsigned char* lds;
    int tid, lane, wave, vcu, G, bx;
    unsigned char* ws;
};

template <int MODE> __device__ __forceinline__ int dmap(int n) {
    if (MODE == 1) { if (n < 832) return n; if (n < 848) return 832 + 2 * (n - 832); if (n < 864) return 832 + 2 * (n - 848) + 1; if (n < 1516) return n; return n + 4; }
    if (MODE == 2) { const int hd = n / 96, w = n - hd * 96; if (w < 64) return hd * 64 + w; if (w < 80) return 256 + hd * 32 + 2 * (w - 64); return 256 + hd * 32 + 2 * (w - 80) + 1; }
    return n;
}
template <int MODE> __device__ __forceinline__ float cscale(int n) {
    if (MODE == 1) { return (n < 256 || (n >= 864 && n < 1120) || (n >= 1516 && n < 1772)) ? QS : 1.f; }
    if (MODE == 2) return C_MLA;
    return 1.f;
}
template <int MODE> __device__ __forceinline__ void transpose_item(const float* W, int N, bf16* WT, int KT, const float* kscale, LAS float* scr, int item, int lane) {
    const int nblk = (N + 31) / 32, kb = item / nblk, nb = item % nblk, k0 = 64 * kb, n0 = 32 * nb;
    const int nl = lane & 31, n = n0 + nl;
#pragma unroll 8
    for (int i = 0; i < 32; ++i) { const int kk = 2 * i + (lane >> 5); float v = (n < N) ? W[(size_t)(k0 + kk) * N + n] : 0.f; if (kscale) v *= kscale[k0 + kk]; scr[kk * 33 + nl] = v; }
    LDS_WAIT(); asm volatile("" ::: "memory");
    const int c = lane & 7;
#pragma unroll
    for (int j = 0; j < 4; ++j) { const int nn = (lane >> 3) + 8 * j, ng = n0 + nn;
        if (ng < N) { const float cs = cscale<MODE>(ng); const LAS float* s = scr + (8 * c) * 33 + nn;
            v4u o; o.x = pk2(s[0 * 33] * cs, s[1 * 33] * cs); o.y = pk2(s[2 * 33] * cs, s[3 * 33] * cs); o.z = pk2(s[4 * 33] * cs, s[5 * 33] * cs); o.w = pk2(s[6 * 33] * cs, s[7 * 33] * cs);
            *(GAS v4u*)(WT + (size_t)dmap<MODE>(ng) * KT + k0 + 8 * c) = o; } }
    LDS_WAIT(); asm volatile("" ::: "memory");
}
__device__ __forceinline__ void zero_fill16(bf16* p, size_t n16, int gtid, int gthreads) {
    for (size_t i = gtid; i < n16; i += gthreads) ((GAS v4u*)p)[i] = (v4u){0u, 0u, 0u, 0u};
}

__device__ __forceinline__ void p_prologue(Frame& F, KArgsP ap_) {
#define a (*ap_)
    LAS float* scr = (LAS float*)(F.lds + F.wave * 16384);
    const int gw = F.vcu * NWAVES + F.wave, NGW = F.G * NWAVES;
    const int gtid = F.vcu * NTHR + F.tid, GT = F.G * NTHR;
    constexpr int I_IN = 16 * 72, I_OUT = 16 * 32, I_UP = 16 * 128, I_DN = 64 * 32, I_UQ = 3 * 12, I_UKV = 2 * 16, I_W1 = 32 * 4, I_W2 = 2 * 2;
    constexpr int PER_L = I_IN + I_OUT + I_UP + I_DN + I_UQ + I_UKV + 2 * I_W1 + 2 * I_W2;
    for (int it = gw; it < DEPTH * PER_L; it += NGW) {
        const int l = it / PER_L; int r = it - l * PER_L;
        unsigned char* wb = F.ws + WS_W + (size_t)l * WS_WL;
        if (r < I_IN) { transpose_item<1>(a.in[6] + (size_t)l * D * DIN, DIN, (bf16*)(wb + W_IN), D, nullptr, scr, r, F.lane); continue; } r -= I_IN;
        if (r < I_OUT) { transpose_item<0>(a.in[7] + (size_t)l * D * D, D, (bf16*)(wb + W_OUT), D, nullptr, scr, r, F.lane); continue; } r -= I_OUT;
        if (r < I_UP) { transpose_item<0>(a.in[19] + (size_t)l * D * DFF, DFF, (bf16*)(wb + W_UP), D, nullptr, scr, r, F.lane); continue; } r -= I_UP;
        if (r < I_DN) { transpose_item<0>(a.in[20] + (size_t)l * DFF * D, D, (bf16*)(wb + W_DN), DFF, nullptr, scr, r, F.lane); continue; } r -= I_DN;
        if (r < I_UQ) { transpose_item<2>(a.in[11] + (size_t)l * 192 * 384, 384, (bf16*)(wb + W_UQ), 256, a.in[9] + l * 192, scr, r, F.lane); continue; } r -= I_UQ;
        if (r < I_UKV) { transpose_item<0>(a.in[12] + (size_t)l * 128 * 512, 512, (bf16*)(wb + W_UKV), 256, a.in[10] + l * 128, scr, r, F.lane); continue; } r -= I_UKV;
        if (r < I_W1) { transpose_item<0>(a.in[15] + (size_t)l * 2048 * 128, 128, (bf16*)(wb + W_1K), 2048, nullptr, scr, r, F.lane); continue; } r -= I_W1;
        if (r < I_W1) { transpose_item<0>(a.in[17] + (size_t)l * 2048 * 128, 128, (bf16*)(wb + W_1V), 2048, nullptr, scr, r, F.lane); continue; } r -= I_W1;
        if (r < I_W2) { transpose_item<0>(a.in[16] + (size_t)l * 128 * 64, 64, (bf16*)(wb + W_2K), 128, nullptr, scr, r, F.lane); continue; } r -= I_W2;
        transpose_item<0>(a.in[18] + (size_t)l * 128 * 64, 64, (bf16*)(wb + W_2V), 128, nullptr, scr, r, F.lane);
    }
    for (int l = 0; l < DEPTH; ++l) {
        unsigned char* wb = F.ws + WS_W + (size_t)l * WS_WL;
        zero_fill16((bf16*)(wb + W_IN) + (size_t)1516 * D, 4 * D / 8, gtid, GT);
        zero_fill16((bf16*)(wb + W_IN) + (size_t)2288 * D, 16 * D / 8, gtid, GT);
        zero_fill16((bf16*)(wb + W_UQ) + (size_t)384 * 256, 128 * 256 / 8, gtid, GT);
        for (int i = gtid; i < 384 * 8; i += GT) ((GAS v4u*)((bf16*)(wb + W_UQ) + (size_t)(i >> 3) * 256 + 192))[i & 7] = (v4u){0u, 0u, 0u, 0u};
        for (int i = gtid; i < 512 * 16; i += GT) ((GAS v4u*)((bf16*)(wb + W_UKV) + (size_t)(i >> 4) * 256 + 128))[i & 15] = (v4u){0u, 0u, 0u, 0u};
    }
    { float* rt = (float*)(F.ws + WS_ROPE);
      for (int i = gtid; i < SEQ * 16; i += GT) { const int ii = i & 15, t = i >> 4; const float freq = powf(10000.f, -(float)ii / 16.f), ang = (float)t * freq; rt[2 * i] = cosf(ang); rt[2 * i + 1] = sinf(ang); } }
    { float* pp = (float*)(F.ws + WS_POSP);
      for (int i = gtid; i < DEPTH * 2 * 32 * 128; i += GT) { const int j = i & 127, kr = (i >> 7) & 31, wh = (i >> 12) & 1, l = i >> 13;
          const float* pos = a.in[wh ? 14 : 13] + l * 2048 + kr * 64; const float* w1 = a.in[wh ? 17 : 15] + (size_t)l * 2048 * 128 + (size_t)kr * 64 * 128 + j;
          float s = 0.f;
#pragma unroll 8
          for (int k = 0; k < 64; ++k) s += pos[k] * w1[(size_t)k * 128];
          pp[i] = s; } }
    { LAS float* sc = (LAS float*)(F.lds);
      LAS float* part = (LAS float*)(F.lds + 16384);
      __syncthreads();
      bool have = false;
      for (int it = F.vcu; it < DEPTH * 96; it += F.G) {
          if (!have) { for (int i = F.tid; i < NB * D; i += NTHR) { const float cv = a.in[1][i]; sc[i] = cv / (1.f + expf(-cv)); } have = true; __syncthreads(); }
          const int l = it / 96, ch = it % 96; const int j = ch * 64 + F.lane;
          const float* w = a.in[4] + (size_t)l * D * 6 * D + j;
          float acc[4] = {0.f, 0.f, 0.f, 0.f};
#pragma unroll 8
          for (int k = 128 * F.wave; k < 128 * F.wave + 128; ++k) { const float wv = w[(size_t)k * 6 * D]; acc[0] += sc[k] * wv; acc[1] += sc[D + k] * wv; acc[2] += sc[2 * D + k] * wv; acc[3] += sc[3 * D + k] * wv; }
#pragma unroll
          for (int b = 0; b < 4; ++b) part[(F.wave * 4 + b) * 64 + F.lane] = acc[b];
          __syncthreads();
          if (F.tid < 256) { const int b = F.tid >> 6, ln = F.tid & 63; float s = a.in[5][l * 6 * D + ch * 64 + ln];
#pragma unroll
              for (int w8 = 0; w8 < 8; ++w8) s += part[(w8 * 4 + b) * 64 + ln];
              ((float*)(F.ws + WS_MOD))[((size_t)l * NB + b) * 6 * D + ch * 64 + ln] = s; }
          __syncthreads();
      } }
}

#undef a
template <int MODE, bool XB16> __device__ __forceinline__ void p_norm(Frame& F, const void* x, const float* g, const float* modsh, const float* modsc, bf16* hout, float* fout) {
    const int gw = F.vcu * NWAVES + F.wave, NGW = F.G * NWAVES;
    for (int blk = gw; blk < M / 16; blk += NGW) {
        const int row0 = blk * 16, b = row0 >> 13;
        f32x4 ga[4], sh[4];
#pragma unroll
        for (int j = 0; j < 4; ++j) { const int c = 4 * F.lane + 256 * j; ga[j] = *(const f32x4*)(g + c);
            if (MODE == 0) { const f32x4 s = *(const f32x4*)(modsc + (size_t)b * 6 * D + c); ga[j] = ga[j] * (s + 1.0f); sh[j] = *(const f32x4*)(modsh + (size_t)b * 6 * D + c); } }
        for (int rr = 0; rr < 16; rr += 4) {
            f32x4 v[4][4];
#pragma unroll
            for (int q = 0; q < 4; ++q) { const int row = row0 + rr + q;
                if (XB16) { const GAS unsigned long long* xr = (const GAS unsigned long long*)((const bf16*)x + (size_t)row * D) + F.lane;
#pragma unroll
                    for (int j = 0; j < 4; ++j) { const unsigned long long qq = xr[64 * j]; const unsigned lo = (unsigned)qq, hi = (unsigned)(qq >> 32);
                        v[q][j] = (f32x4){__uint_as_float(lo << 16), __uint_as_float(lo & 0xffff0000u), __uint_as_float(hi << 16), __uint_as_float(hi & 0xffff0000u)}; } }
                else { const GAS f32x4* xr = (const GAS f32x4*)((const float*)x + (size_t)row * D) + F.lane;
#pragma unroll
                    for (int j = 0; j < 4; ++j) v[q][j] = xr[64 * j]; } }
#pragma unroll
            for (int q = 0; q < 4; ++q) { const int row = row0 + rr + q; float s = 0.f;
#pragma unroll
                for (int j = 0; j < 4; ++j) s += (v[q][j].x * v[q][j].x + v[q][j].y * v[q][j].y) + (v[q][j].z * v[q][j].z + v[q][j].w * v[q][j].w);
                const float r = rsqrtf(wave_sum(s) * (1.f / D) + RMS_EPS);
                if (MODE == 0) { GAS unsigned long long* o8 = (GAS unsigned long long*)(hout + (size_t)row * D) + F.lane;
#pragma unroll
                    for (int j = 0; j < 4; ++j) { const f32x4 y = v[q][j] * r * ga[j] + sh[j]; o8[64 * j] = (unsigned long long)pk2(y.x, y.y) | ((unsigned long long)pk2(y.z, y.w) << 32); } }
                else { GAS f32x4* o = (GAS f32x4*)(fout + (size_t)row * D) + F.lane;
#pragma unroll
                    for (int j = 0; j < 4; ++j) o[64 * j] = v[q][j] * r * ga[j]; } }
        }
    }
}

__device__ __forceinline__ void p_prep(Frame& F, int l) {
    const int gw = F.vcu * NWAVES + F.wave, NGW = F.G * NWAVES;
    const bf16* Z = (const bf16*)(F.ws + WS_Z); bf16* KM = (bf16*)(F.ws + WS_KM);
    float* rsq = (float*)(F.ws + WS_RSQ); float* rskv = (float*)(F.ws + WS_RSKV); const float* rope = (const float*)(F.ws + WS_ROPE);
    for (int row = gw; row < M; row += NGW) {
        const bf16* zr = Z + (size_t)row * ZLD;
        const float a0 = bf2f(zr[ZB_CQ + F.lane]), a1 = bf2f(zr[ZB_CQ + 64 + F.lane]), a2 = bf2f(zr[ZB_CQ + 128 + F.lane]);
        const float b0 = bf2f(zr[ZB_CKV + F.lane]), b1 = bf2f(zr[ZB_CKV + 64 + F.lane]);
        const float sq = wave_sum(a0 * a0 + a1 * a1 + a2 * a2), skv = wave_sum(b0 * b0 + b1 * b1);
        if (F.lane == 0) { rsq[row] = rsqrtf(sq * (1.f / 192.f) + RMS_EPS); rskv[row] = rsqrtf(skv * (1.f / 128.f) + RMS_EPS); }
        if (F.lane < 16) { const unsigned pr = *(const unsigned*)(zr + ZB_PE + 2 * F.lane); const float x1 = bf2f((unsigned short)(pr & 0xffffu)), x2 = bf2f((unsigned short)(pr >> 16));
            const float cs = rope[((size_t)(row & 8191) * 16 + F.lane) * 2], sn = rope[((size_t)(row & 8191) * 16 + F.lane) * 2 + 1];
            const unsigned o = pk2(x1 * cs - x2 * sn, x1 * sn + x2 * cs);
#pragma unroll
            for (int hd = 0; hd < 4; ++hd) *(unsigned*)(KM + (size_t)row * 384 + hd * 96 + 64 + 2 * F.lane) = o; }
    }
    { bf16* KMH = (bf16*)(F.ws + WS_KMH); bf16* KML = (bf16*)(F.ws + WS_KML);
      for (int it = gw; it < NB * 4 * 32; it += NGW) { const int j = it & 31, hd = (it >> 5) & 3, b = it >> 7; const int ts = F.lane >> 3, ch = F.lane & 7;
          float acc[8] = {0.f, 0.f, 0.f, 0.f, 0.f, 0.f, 0.f, 0.f};
          for (int i = 0; i < 32; ++i) { const v4u w = *(const v4u*)(Z + (size_t)(b * SEQ + j * 256 + 8 * i + ts) * ZLD + ZD_K + hd * 64 + ch * 8);
#pragma unroll
              for (int e = 0; e < 4; ++e) { acc[2 * e] += __uint_as_float(w[e] << 16); acc[2 * e + 1] += __uint_as_float(w[e] & 0xffff0000u); } }
#pragma unroll
          for (int e = 0; e < 8; ++e) { acc[e] += __shfl_xor(acc[e], 8); acc[e] += __shfl_xor(acc[e], 16); acc[e] += __shfl_xor(acc[e], 32); }
          if (F.lane < 8) { unsigned hi[4], lo[4];
#pragma unroll
              for (int e = 0; e < 4; ++e) { const float m0 = acc[2 * e] * (1.f / 256.f), m1 = acc[2 * e + 1] * (1.f / 256.f); const unsigned h0 = f2bf(m0), h1 = f2bf(m1);
                  hi[e] = h0 | (h1 << 16); lo[e] = pk2(m0 - __uint_as_float(h0 << 16), m1 - __uint_as_float(h1 << 16)); }
              *(v4u*)(KMH + (size_t)it * 64 + ch * 8) = (v4u){hi[0], hi[1], hi[2], hi[3]}; *(v4u*)(KML + (size_t)it * 64 + ch * 8) = (v4u){lo[0], lo[1], lo[2], lo[3]}; } } }
    if (gw == 0) { const float* pp = (const float*)(F.ws + WS_POSP) + (size_t)l * 2 * 32 * 128; float* pb = (float*)(F.ws + WS_POSB) + l * 256;
        for (int i = F.lane; i < 256; i += 64) { const int j = i & 127, wh = i >> 7; float s = 0.f; for (int kr = 0; kr < 32; ++kr) s += pp[(wh * 32 + kr) * 128 + j]; pb[i] = s; } }
}

__device__ __forceinline__ float gelu_tanh(float x) { const float u = 0.7978845608028654f * (x + 0.044715f * x * x * x); const float e = __expf(2.f * u); return x * (1.f - 1.f / (e + 1.f)); }
__device__ __forceinline__ void p_compress(Frame& F, int l) {
    const bf16* Z = (const bf16*)(F.ws + WS_Z);
    unsigned char* wb = F.ws + WS_W + (size_t)l * WS_WL;
    LAS float* red = (LAS float*)F.lds;
    const int r = F.lane & 31, h = F.lane >> 5;
    for (int it = F.vcu; it < NB * 16 * 2; it += F.G) {
        const int which = it & 1, itile = (it >> 1) & 15, b = it >> 5;
        const bf16* W1T = (const bf16*)(wb + (which ? W_1V : W_1K)); const bf16* W2T = (const bf16*)(wb + (which ? W_2V : W_2K));
        const int coff = which ? ZC_VC : ZC_KC;
        f32x16 acc[4] = {f32x16{}, f32x16{}, f32x16{}, f32x16{}};
        const bf16* brow = Z + (size_t)(b * SEQ + 16 * (32 * itile + r)) * ZLD + coff + 8 * h;
#pragma unroll 2
        for (int ks = 0; ks < 16; ++ks) { const int tt = 4 * F.wave + (ks >> 2), d0 = ks & 3;
            const bf16x8 bf = *(const bf16x8*)(brow + (size_t)tt * ZLD + d0 * 16);
#pragma unroll
            for (int hb = 0; hb < 4; ++hb) { const bf16x8 af = *(const bf16x8*)(W1T + (size_t)(hb * 32 + r) * 2048 + tt * 64 + d0 * 16 + 8 * h);
                acc[hb] = __builtin_amdgcn_mfma_f32_32x32x16_bf16(af, bf, acc[hb], 0, 0, 0); } }
#pragma unroll
        for (int hb = 0; hb < 4; ++hb)
#pragma unroll
            for (int v = 0; v < 16; ++v) red[((F.wave * 4 + hb) * 16 + v) * 64 + F.lane] = acc[hb][v];
        __syncthreads();
        if (F.wave < 2) {
            const float* pb = (const float*)(F.ws + WS_POSB) + l * 256 + which * 128;
            f32x16 o = f32x16{};
#pragma unroll
            for (int hb = 0; hb < 4; ++hb) { float x[16];
#pragma unroll
                for (int v = 0; v < 16; ++v) { float s = pb[hb * 32 + (v & 3) + 8 * (v >> 2) + 4 * h];
#pragma unroll
                    for (int w8 = 0; w8 < 8; ++w8) s += red[((w8 * 4 + hb) * 16 + v) * 64 + F.lane];
                    x[v] = gelu_tanh(s); }
#pragma unroll
                for (int s2 = 0; s2 < 2; ++s2) {
                    v4u pw; pw.x = fa::cvtpk(x[8 * s2], x[8 * s2 + 1]); pw.y = fa::cvtpk(x[8 * s2 + 2], x[8 * s2 + 3]); pw.z = fa::cvtpk(x[8 * s2 + 4], x[8 * s2 + 5]); pw.w = fa::cvtpk(x[8 * s2 + 6], x[8 * s2 + 7]);
                    const bf16* wr = W2T + (size_t)(F.wave * 32 + r) * 128 + hb * 32 + 16 * s2 + 4 * h;
                    const v2u a0 = *(const v2u*)wr, a1 = *(const v2u*)(wr + 8);
                    const v4u aw = (v4u){a0.x, a0.y, a1.x, a1.y};
                    o = __builtin_amdgcn_mfma_f32_32x32x16_bf16(__builtin_bit_cast(bf16x8, aw), __builtin_bit_cast(bf16x8, pw), o, 0, 0, 0); } }
            bf16* dst = (bf16*)(F.ws + (which ? WS_VCMP : WS_KCMP)) + (size_t)(b * 512 + 32 * itile + r) * 64 + F.wave * 32 + 4 * h;
#pragma unroll
            for (int g = 0; g < 4; ++g) { v2u w; w.x = fa::cvtpk(o[4 * g], o[4 * g + 1]); w.y = fa::cvtpk(o[4 * g + 2], o[4 * g + 3]); *(v2u*)(dst + 8 * g) = w; }
        }
        __syncthreads();
    }
}
using fa::bf16x8;
__device__ __forceinline__ unsigned char* launder_ptr(unsigned char* p) { const unsigned long long v = (unsigned long long)p; unsigned lo = __builtin_amdgcn_readfirstlane((unsigned)v), hi = __builtin_amdgcn_readfirstlane((unsigned)(v >> 32)); asm volatile("" : "+s"(lo), "+s"(hi)); return (unsigned char*)(((unsigned long long)hi << 32) | lo); }
#define UNIT_BEGIN() Frame F = F0; { int tid_ = F0.tid; asm volatile("" : "+v"(tid_)); int bx_ = __builtin_amdgcn_readfirstlane(F0.bx); asm volatile("" : "+s"(bx_)); \
    F.ws = launder_ptr(F0.ws); F.tid = tid_; F.lane = tid_ & 63; F.wave = __builtin_amdgcn_readfirstlane(tid_ >> 6); F.bx = bx_; }
__device__ __forceinline__ void u_mla(const Frame& F0, int b, int hd, int u) {
    UNIT_BEGIN();
    GAS char* ws = (GAS char*)F.ws;
    const int r = F.lane & 31, h = F.lane >> 5, q0 = 256 * u, wq0 = q0 + 32 * F.wave, tq = wq0 + r;
    bf16x8 qf[6]; { const unsigned qrow = (unsigned)WS_QM + (unsigned)(b * SEQ + tq) * 1024u;
      const float rs = *(const GAS float*)(ws + ((unsigned)WS_RSQ + (unsigned)(b * SEQ + tq) * 4u));
#pragma unroll
      for (int d0 = 0; d0 < 4; ++d0) { const fa::u32x4 raw = *(const GAS fa::u32x4*)(ws + (qrow + (unsigned)(hd * 128 + d0 * 32 + 16 * h))); fa::u32x4 o;
          o.x = fa::cvtpk(__uint_as_float(raw.x << 16) * rs, __uint_as_float(raw.x & 0xffff0000u) * rs); o.y = fa::cvtpk(__uint_as_float(raw.y << 16) * rs, __uint_as_float(raw.y & 0xffff0000u) * rs);
          o.z = fa::cvtpk(__uint_as_float(raw.z << 16) * rs, __uint_as_float(raw.z & 0xffff0000u) * rs); o.w = fa::cvtpk(__uint_as_float(raw.w << 16) * rs, __uint_as_float(raw.w & 0xffff0000u) * rs);
          qf[d0] = __builtin_bit_cast(bf16x8, o); }
#pragma unroll
      for (int d0 = 0; d0 < 2; ++d0) {
          const fa::u32x4 raw = *(const GAS fa::u32x4*)(ws + (qrow + (unsigned)(512 + hd * 64 + d0 * 32 + 16 * h)));
          const GAS float* rp = (const GAS float*)(ws + ((unsigned)WS_ROPE + (unsigned)((tq * 16 + d0 * 8 + 4 * h) * 8)));
          const fa::f32x4v r0 = *(const GAS fa::f32x4v*)rp * rs, r1 = *(const GAS fa::f32x4v*)(rp + 4) * rs;
          fa::u32x4 o;
          { const float x1 = __uint_as_float(raw.x << 16), x2 = __uint_as_float(raw.x & 0xffff0000u); o.x = fa::cvtpk(x1 * r0[0] - x2 * r0[1], x1 * r0[1] + x2 * r0[0]); }
          { const float x1 = __uint_as_float(raw.y << 16), x2 = __uint_as_float(raw.y & 0xffff0000u); o.y = fa::cvtpk(x1 * r0[2] - x2 * r0[3], x1 * r0[3] + x2 * r0[2]); }
          { const float x1 = __uint_as_float(raw.z << 16), x2 = __uint_as_float(raw.z & 0xffff0000u); o.z = fa::cvtpk(x1 * r1[0] - x2 * r1[1], x1 * r1[1] + x2 * r1[0]); }
          { const float x1 = __uint_as_float(raw.w << 16), x2 = __uint_as_float(raw.w & 0xffff0000u); o.w = fa::cvtpk(x1 * r1[2] - x2 * r1[3], x1 * r1[3] + x2 * r1[2]); }
          qf[4 + d0] = __builtin_bit_cast(bf16x8, o); } }
    SM st; fa::sm_init(st);
    LAS char* lds = (LAS char*)F.lds;
    fa::fa_loop<96, false>(st, qf, ws, (unsigned)WS_KM + (unsigned)b * (SEQ * 768u) + (unsigned)hd * 192u, 768u, (unsigned)WS_VM + (unsigned)b * (SEQ * 512u) + (unsigned)hd * 128u, 512u, SEQ - 1, 4 * u + 4,
        [](int t) { return 64 * t; },
        [=](int t, bool& act, bool& ew, float& cb, int& lo, int& hi) { const int key0 = 64 * t; act = key0 <= wq0 + 31; ew = key0 + 63 > wq0; cb = 0.f; lo = -100000; hi = tq - key0; },
        0.f, lds + FA_STAGES, F.tid, F.lane);
    f32x16 acc[2] = {f32x16{}, f32x16{}}; fa::sm_finish(st, 1.f, acc);
    fa::store_out(acc, lds + FA_OST + F.wave * 32 * fa::OSTR, ws, [=](int col) { return (unsigned)WS_O + (unsigned)(b * SEQ + wq0 + col) * 2048u + (unsigned)(256 + hd * 64) * 2u; }, F.lane);
}
__device__ __forceinline__ void u_moba(const Frame& F0, int b, int hd, int i) {
    UNIT_BEGIN();
    GAS char* ws = (GAS char*)F.ws;
    const int r = F.lane & 31, h = F.lane >> 5, q0 = 256 * i, wq0 = q0 + 32 * F.wave, tq = wq0 + r;
    bf16x8 qf[4]; fa::load_q<64>(qf, ws, (unsigned)WS_Z + (unsigned)(b * SEQ + tq) * (ZLD * 2u) + (unsigned)(ZD_Q + hd * 64) * 2u, h);
    unsigned bits = 0u;
    if (i > 0) {
        const GAS bf16* KMH = (const GAS bf16*)(ws + ((unsigned)WS_KMH + (unsigned)(((b * 4 + hd) * 32 + r) * 64 + 8 * h) * 2u)); const GAS bf16* KML = (const GAS bf16*)(ws + ((unsigned)WS_KML + (unsigned)(((b * 4 + hd) * 32 + r) * 64 + 8 * h) * 2u));
        f32x16 g = f32x16{};
#pragma unroll
        for (int d0 = 0; d0 < 4; ++d0) { const bf16x8 ah = *(const GAS bf16x8*)(KMH + d0 * 16), al = *(const GAS bf16x8*)(KML + d0 * 16);
            g = __builtin_amdgcn_mfma_f32_32x32x16_bf16(ah, qf[d0], g, 0, 0, 0); g = __builtin_amdgcn_mfma_f32_32x32x16_bf16(al, qf[d0], g, 0, 0, 0); }
        float og[16];
#pragma unroll
        for (int v = 0; v < 16; ++v) { const int j = (v & 3) + 8 * (v >> 2) + 4 * h; if (j >= i) g[v] = -INFINITY; og[v] = __shfl_xor(g[v], 32); }
#pragma unroll
        for (int v = 0; v < 16; ++v) { const int j = (v & 3) + 8 * (v >> 2) + 4 * h; int rank = 0;
#pragma unroll
            for (int w = 0; w < 16; ++w) { const int jm = (w & 3) + 8 * (w >> 2) + 4 * h, jo = (w & 3) + 8 * (w >> 2) + 4 * (1 - h);
                rank += (g[w] > g[v] || (g[w] == g[v] && jm < j)) ? 1 : 0; rank += (og[w] > g[v] || (og[w] == g[v] && jo < j)) ? 1 : 0; }
            if (rank < 3 && j < i) bits |= 1u << j; }
        bits |= __shfl_xor(bits, 32);
    }
    const float sl = slope2_of(2 + 3 * hd);
    LAS char* lds = (LAS char*)F.lds;
    LAS float* Ost = (LAS float*)(lds + MB_O);
    LAS float* MLst = (LAS float*)(lds + MB_ML);
    LAS unsigned* cnt = (LAS unsigned*)(lds + MB_CNT);
    LAS unsigned char* lst = (LAS unsigned char*)(lds + MB_LST);
    const unsigned koff = (unsigned)WS_Z + (unsigned)b * (SEQ * ZLD * 2u) + (unsigned)(ZD_K + hd * 64) * 2u, voff = (unsigned)WS_Z + (unsigned)b * (SEQ * ZLD * 2u) + (unsigned)(ZD_V + hd * 64) * 2u;
    if (F.tid < 32) cnt[F.tid] = 0u;
    {
        SM st; fa::sm_init(st);
        fa::fa_loop<64, true>(st, qf, ws, koff, ZLD * 2u, voff, ZLD * 2u, SEQ - 1, 4,
            [=](int t) { return q0 + 64 * t; },
            [=](int t, bool& act, bool& ew, float& cb, int& lo, int& hi) { const int key0 = q0 + 64 * t; act = key0 <= wq0 + 31; ew = key0 + 63 > wq0; cb = sl * (float)(64 * t + 4 * h); lo = -100000; hi = tq - key0; },
            sl, lds + FA_STAGES, F.tid, F.lane);
        const float lt = fa::xhalf_sum(st.l);
        LAS float* orow = Ost + (32 * F.wave + r) * MB_OS;
#pragma unroll
        for (int db = 0; db < 2; ++db)
#pragma unroll
            for (int g = 0; g < 4; ++g)
#pragma unroll
                for (int e = 0; e < 4; ++e) orow[32 * db + 8 * g + 4 * h + e] = st.o[db][4 * g + e];
        if (h == 0) { MLst[(32 * F.wave + r) * 2] = st.m; MLst[(32 * F.wave + r) * 2 + 1] = lt; }
    }
    if (h == 0) { unsigned bb = bits;
        while (bb) { const int j = __ffs(bb) - 1; bb &= bb - 1u; const unsigned slot = __hip_atomic_fetch_add(&cnt[j], 1u, __ATOMIC_RELAXED, __HIP_MEMORY_SCOPE_WORKGROUP); lst[j * 256 + slot] = (unsigned char)(32 * F.wave + r); } }
    LDS_WAIT(); __syncthreads();
    if (i > 0) {
        LAS unsigned* PS = (LAS unsigned*)(lds + MB_PS);
        LAS float* PM = (LAS float*)(lds + MB_PM);
        const unsigned qbase = (unsigned)WS_Z + (unsigned)(b * SEQ + q0) * (ZLD * 2u) + (unsigned)(ZD_Q + hd * 64) * 2u;
        const int tt = F.wave & 3, g4 = F.wave >> 2;
        fa::Stg<64> s0, s1, s2, s3;
#define MB_LOADBLK(J) { fa::stg_load<64>(s0, ws, koff, ZLD * 2u, voff, ZLD * 2u, 256 * (J), SEQ - 1, F.tid); fa::stg_load<64>(s1, ws, koff, ZLD * 2u, voff, ZLD * 2u, 256 * (J) + 64, SEQ - 1, F.tid); \
                        fa::stg_load<64>(s2, ws, koff, ZLD * 2u, voff, ZLD * 2u, 256 * (J) + 128, SEQ - 1, F.tid); fa::stg_load<64>(s3, ws, koff, ZLD * 2u, voff, ZLD * 2u, 256 * (J) + 192, SEQ - 1, F.tid); }
        MB_LOADBLK(0)
        const int ql = 8 * tt + (F.lane >> 3), l7 = F.lane & 7;
        for (int j = 0; j < i; ++j) {
            const int n = (int)cnt[j];
            bool myact = 32 * g4 < n, colv = (32 * g4 + r) < n; int qsel = colv ? (int)lst[j * 256 + 32 * g4 + r] : 0;
            bf16x8 qfb[4] = {qf[0], qf[1], qf[2], qf[3]};
            if (myact) fa::load_q<64>(qfb, ws, qbase + (unsigned)qsel * (ZLD * 2u), h);
            fa::stg_store<64>(s0, lds + MB_T, F.tid); fa::stg_store<64>(s1, lds + MB_T + 16384, F.tid); fa::stg_store<64>(s2, lds + MB_T + 32768, F.tid); fa::stg_store<64>(s3, lds + MB_T + 49152, F.tid);
            if (j + 1 < i) MB_LOADBLK(j + 1)
            LDS_WAIT(); __syncthreads();
            for (int rd = 0; 64 * rd < n; ++rd) {
                const int grp = 2 * rd + g4;
                if (rd > 0) { LDS_WAIT(); __syncthreads();
                    myact = 32 * grp < n; colv = (32 * grp + r) < n; qsel = colv ? (int)lst[j * 256 + 32 * grp + r] : 0;
                    if (myact) fa::load_q<64>(qfb, ws, qbase + (unsigned)qsel * (ZLD * 2u), h); }
                const bool two = 32 * (2 * rd + 1) < n;
                const bool fv = (32 * grp + ql) < n; const int qs = fv ? (int)lst[j * 256 + 32 * grp + ql] : 0;
                const float ms = MLst[qs * 2], ls = MLst[qs * 2 + 1];
                LAS float* orow = Ost + qs * MB_OS + 8 * l7;
                float acc8[8];
#pragma unroll
                for (int x = 0; x < 8; ++x) acc8[x] = orow[x];
                SM st; fa::sm_init(st); float lp = 0.f;
                if (myact) {
                    const LAS char* buf = lds + MB_T + tt * 16384;
                    fa::f32x16 p0, p1; bf16x8 pf[4];
                    fa::score_tile<64, true>(p0, p1, buf, qfb, colv ? sl * (float)(256 * j + 64 * tt - q0 + 4 * h) : fa::MASKV, sl, F.lane);
                    fa::sm_step(st, p0, p1, pf);
                    fa::pv(st.o, buf + 8192, pf, F.lane);
                    lp = fa::xhalf_sum(st.l);
                }
#pragma unroll 1
                for (int ph = 0; ph < 2; ++ph) {
                    if (ph == 1 && !two) break;
                    if (ph == 1) { LDS_WAIT(); __syncthreads(); }
                    if (g4 == ph && myact) {
                        LAS unsigned* ps = PS + (tt * 32 + r) * 33 + 2 * h;
#pragma unroll
                        for (int db = 0; db < 2; ++db)
#pragma unroll
                            for (int g = 0; g < 4; ++g) { ps[16 * db + 4 * g] = fa::cvtpk(st.o[db][4 * g], st.o[db][4 * g + 1]); ps[16 * db + 4 * g + 1] = fa::cvtpk(st.o[db][4 * g + 2], st.o[db][4 * g + 3]); }
                        if (h == 0) { PM[(tt * 32 + r) * 2] = st.m; PM[(tt * 32 + r) * 2 + 1] = lp; }
                    }
                    LDS_WAIT(); __syncthreads();
                    if (g4 == ph && fv) {
                        const float m0 = PM[ql * 2], l0 = PM[ql * 2 + 1], m1 = PM[(32 + ql) * 2], l1 = PM[(32 + ql) * 2 + 1], m2 = PM[(64 + ql) * 2], l2 = PM[(64 + ql) * 2 + 1], m3 = PM[(96 + ql) * 2], l3 = PM[(96 + ql) * 2 + 1];
                        const float mn = fmaxf(fmaxf(fmaxf(m0, m1), fmaxf(m2, m3)), ms);
                        const float ea = fa::ex2(ms - mn), e0 = fa::ex2(m0 - mn), e1 = fa::ex2(m1 - mn), e2 = fa::ex2(m2 - mn), e3 = fa::ex2(m3 - mn);
                        const LAS unsigned* pr = PS + ql * 33 + 4 * l7;
#pragma unroll
                        for (int x = 0; x < 4; ++x) { const unsigned w0 = pr[x], w1 = pr[32 * 33 + x], w2 = pr[64 * 33 + x], w3 = pr[96 * 33 + x];
                            orow[2 * x] = acc8[2 * x] * ea + ((__uint_as_float(w0 << 16) * e0 + __uint_as_float(w1 << 16) * e1) + (__uint_as_float(w2 << 16) * e2 + __uint_as_float(w3 << 16) * e3));
                            orow[2 * x + 1] = acc8[2 * x + 1] * ea + ((__uint_as_float(w0 & 0xffff0000u) * e0 + __uint_as_float(w1 & 0xffff0000u) * e1) + (__uint_as_float(w2 & 0xffff0000u) * e2 + __uint_as_float(w3 & 0xffff0000u) * e3)); }
                        if (l7 == 0) { MLst[qs * 2] = mn; MLst[qs * 2 + 1] = ls * ea + ((l0 * e0 + l1 * e1) + (l2 * e2 + l3 * e3)); }
                    }
                }
            }
        }
#undef MB_LOADBLK
        LDS_WAIT(); __syncthreads();
#if FA_PROBE == 9
        if (F.lane == 0 && F.wave == FA_KO) { unsigned long long* pp = (unsigned long long*)((GAS char*)ws + 32768);
            atomicAdd(pp + 0, pq0); atomicAdd(pp + 1, pq1); atomicAdd(pp + 2, pq2); atomicAdd(pp + 3, pqn); atomicAdd(pp + 4, pq3); }
#endif
    }
    { const int q = 32 * F.wave + (F.lane >> 1), hf = F.lane & 1; const float inv = 1.f / fmaxf(MLst[q * 2 + 1], fa::TINYF);
      const LAS float* orow = Ost + q * MB_OS + 32 * hf;
      GAS char* dst = ws + ((unsigned)WS_O + (unsigned)(b * SEQ + q0 + q) * 2048u + (unsigned)(768 + hd * 64 + 32 * hf) * 2u);
#pragma unroll
      for (int c = 0; c < 4; ++c) { float x[8];
#pragma unroll
          for (int e = 0; e < 8; ++e) x[e] = orow[8 * c + e] * inv;
          fa::u32x4 w; w.x = fa::cvtpk(x[0], x[1]); w.y = fa::cvtpk(x[2], x[3]); w.z = fa::cvtpk(x[4], x[5]); w.w = fa::cvtpk(x[6], x[7]);
          *(GAS fa::u32x4*)(dst + 16 * c) = w; } }
    LDS_WAIT(); __syncthreads();
}
__device__ __forceinline__ void u_swa(const Frame& F0, int b, int kvh, int u, const float* sinks) {
    UNIT_BEGIN();
    GAS char* ws = (GAS char*)F.ws;
    const int r = F.lane & 31, h = F.lane >> 5, q0 = 128 * u, wq0 = q0 + 16 * F.wave, tq = wq0 + (r >> 1), hd = kvh * 2 + (r & 1);
    bf16x8 qf[4]; fa::load_q<64>(qf, ws, (unsigned)WS_Z + (unsigned)(b * SEQ + tq) * (ZLD * 2u) + (unsigned)(ZA_Q + hd * 64) * 2u, h);
    const float sl = slope2_of(3 * hd);
    const int t0 = (2 * u - 2) > 0 ? (2 * u - 2) : 0, nt = 2 * u + 2 - t0;
    SM st; fa::sm_init(st);
    LAS char* lds = (LAS char*)F.lds;
    fa::fa_loop<64, true>(st, qf, ws, (unsigned)WS_Z + (unsigned)b * (SEQ * ZLD * 2u) + (unsigned)(ZA_K + kvh * 64) * 2u, ZLD * 2u, (unsigned)WS_Z + (unsigned)b * (SEQ * ZLD * 2u) + (unsigned)(ZA_V + kvh * 64) * 2u, ZLD * 2u, SEQ - 1, nt,
        [=](int t) { return 64 * (t0 + t); },
        [=](int t, bool& act, bool& ew, float& cb, int& lo, int& hi) { const int key0 = 64 * (t0 + t); act = (key0 <= wq0 + 15) && (key0 + 63 >= wq0 - 127); ew = true;
            cb = sl * (float)(key0 - q0 + 4 * h); lo = tq - 127 - key0; hi = tq - key0; },
        sl, lds + FA_STAGES, F.tid, F.lane);
    const float sk = sinks[hd] * LOG2E + sl * (float)(tq - q0), mf = fmaxf(st.m, sk), a = fa::ex2(st.m - mf);
    const float ltot = fa::xhalf_sum(st.l) * a + fa::ex2(sk - mf), inv = a / fmaxf(ltot, fa::TINYF);
    f32x16 acc[2]; acc[0] = st.o[0] * inv; acc[1] = st.o[1] * inv;
    fa::store_out(acc, lds + FA_OST + F.wave * 32 * fa::OSTR, ws, [=](int col) { return (unsigned)WS_O + (unsigned)(b * SEQ + wq0 + (col >> 1)) * 2048u + (unsigned)((kvh * 2 + (col & 1)) * 64) * 2u; }, F.lane);
}
__device__ __forceinline__ void u_nsa(const Frame& F0, int b, int qi) {
    UNIT_BEGIN();
    GAS char* ws = (GAS char*)F.ws;
    const unsigned KC = (unsigned)WS_KCMP + (unsigned)b * (512u * 128u), VC = (unsigned)WS_VCMP + (unsigned)b * (512u * 128u), ZB = (unsigned)WS_Z + (unsigned)b * (SEQ * ZLD * 2u);
    const int r = F.lane & 31, h = F.lane >> 5, q0 = 64 * qi, wq0 = q0 + 8 * F.wave, qloc = 8 * F.wave + (r >> 2), tq = q0 + qloc, hd = r & 3;
    const unsigned zrow_off = ZB + (unsigned)tq * (ZLD * 2u); const GAS bf16* zrow = (const GAS bf16*)(ws + zrow_off);
    bf16x8 qf[4]; fa::load_q<64>(qf, ws, zrow_off + (unsigned)(ZC_Q + hd * 64) * 2u, h);
    const float sl = slope2_of(1 + 3 * hd);
    const float g0 = 1.f / (1.f + __expf(-bf2f(zrow[ZC_GL + hd]))), g1 = 1.f / (1.f + __expf(-bf2f(zrow[ZC_GL + 4 + hd]))), g2 = 1.f / (1.f + __expf(-bf2f(zrow[ZC_GL + 8 + hd])));
    LAS char* lds = (LAS char*)F.lds;
    LAS float* impA = (LAS float*)(lds + FA_IMP) + F.wave * 1024;
    LAS float* impB = (LAS float*)(lds + FA_OST) + F.wave * 1024;
    LAS unsigned* selm = (LAS unsigned*)(lds + FA_SELM);
    LAS unsigned* um = (LAS unsigned*)(lds + FA_UM);
    LAS float* vals = (LAS float*)(lds + FA_VALS) + F.wave * 128;
    if (F.tid < 4) um[F.tid] = 0u;
    const unsigned parko = (unsigned)WS_PARK + (unsigned)((F.bx * NWAVES + F.wave) * 2 * 32 * 64 + F.lane) * 4u;
#define PARK(i) (*(GAS float*)(ws + (parkl + (unsigned)((i) * 256))))
    const int ntc = ((4 * qi + 3) >> 6) + 1;
    const int cvis = (tq - 31) >> 4;
    const int cvis_min = (q0 - 31) >> 4;
    const float slc = 16.f * sl;
    SM st; fa::sm_init(st);
    fa::fa_loop<64, true>(st, qf, ws, KC, 128u, VC, 128u, 510, ntc,
        [](int t) { return 64 * t; },
        [=](int t, bool& act, bool& ew, float& cb, int& lo, int& hi) { const int c0 = 64 * t; act = true; ew = c0 + 63 > cvis_min; cb = slc * (float)(c0 - 4 * qi + 4 * h); lo = -100000; hi = cvis - c0; },
        slc, lds + FA_STAGES, F.tid, F.lane);
    { f32x16 t2[2] = {f32x16{}, f32x16{}}; fa::sm_finish(st, g0, t2); unsigned parkl = parko; asm volatile("" : "+v"(parkl));
#pragma unroll
      for (int v = 0; v < 16; ++v) { PARK(v) = t2[0][v]; PARK(16 + v) = t2[1][v]; } }
    {
        const float mfin = st.m, invl = 1.f / fmaxf(fa::xhalf_sum(st.l), fa::TINYF);
        constexpr int STG = fa::stage_bytes<64>();
        fa::Stg<64> sg;
        fa::stg_load<64>(sg, ws, KC, 128u, VC, 128u, 0, 510, F.tid); fa::stg_store<64>(sg, lds + FA_STAGES, F.tid); __syncthreads();
        for (int t = 0; t < ntc; ++t) {
            const LAS char* buf = lds + FA_STAGES + (t & 1) * STG;
            if (t + 1 < ntc) fa::stg_load<64>(sg, ws, KC, 128u, VC, 128u, 64 * (t + 1), 510, F.tid);
            const int c0 = 64 * t;
            f32x16 p0, p1; fa::score_tile<64, true>(p0, p1, buf, qf, slc * (float)(c0 - 4 * qi + 4 * h), slc, F.lane);
            if (c0 + 63 > cvis_min) fa::mask_ew(p0, p1, -100000, cvis - c0, h);
#pragma unroll
            for (int kh = 0; kh < 2; ++kh)
#pragma unroll
                for (int g = 0; g < 4; ++g) {
                    float e0, e1, e2, e3;
                    if (kh == 0) { e0 = fa::ex2(p0[4 * g] - mfin); e1 = fa::ex2(p0[4 * g + 1] - mfin); e2 = fa::ex2(p0[4 * g + 2] - mfin); e3 = fa::ex2(p0[4 * g + 3] - mfin); }
                    else { e0 = fa::ex2(p1[4 * g] - mfin); e1 = fa::ex2(p1[4 * g + 1] - mfin); e2 = fa::ex2(p1[4 * g + 2] - mfin); e3 = fa::ex2(p1[4 * g + 3] - mfin); }
                    e0 *= invl; e1 *= invl; e2 *= invl; e3 *= invl;
                    float s4 = ((e0 + e1) + e2) + e3;
                    s4 += __shfl_xor(s4, 1); s4 += __shfl_xor(s4, 2); e3 += __shfl_xor(e3, 1); e3 += __shfl_xor(e3, 2);
                    const int j = 16 * t + 8 * kh + 2 * g + h;
                    if (hd == 0) { impA[(r >> 2) * 128 + j] = s4; impB[(r >> 2) * 128 + j] = e3; }
                }
            if (t + 1 < ntc) fa::stg_store<64>(sg, lds + FA_STAGES + ((t + 1) & 1) * STG, F.tid);
            __syncthreads();
        }
    }
    {
        const int cur = qi;
        for (int qq = 0; qq < 8; ++qq) {
            unsigned long long m0, m1;
            if (cur < 16) { m0 = (cur >= 63) ? ~0ull : ((1ull << (cur + 1)) - 1ull); m1 = 0ull; }
            else {
                const int ja = F.lane, jb2 = F.lane + 64;
                const bool fca = (ja == 0 || ja == cur || ja == cur - 1), fcb = (jb2 == cur || jb2 == cur - 1);
                const float va = impA[qq * 128 + ja] + (ja > 0 ? impB[qq * 128 + ja - 1] : 0.f), vb = impA[qq * 128 + jb2] + impB[qq * 128 + jb2 - 1];
                const unsigned ka = (ja <= cur && !fca) ? (__float_as_uint(va) + 1u) : 0u, kb = (jb2 <= cur && !fcb) ? (__float_as_uint(vb) + 1u) : 0u;
                unsigned T = 0u;
                for (int bit = 31; bit >= 0; --bit) { const unsigned cand = T | (1u << bit); const int c = __popcll(__ballot(ka >= cand)) + __popcll(__ballot(kb >= cand)); if (c >= 13) T = cand; }
                if (T == 0u) T = 1u;
                const unsigned long long ga = __ballot(ka > T), gb = __ballot(kb > T), ea = __ballot(ka == T), eb = __ballot(kb == T);
                const int R = 13 - (__popcll(ga) + __popcll(gb)), na = __popcll(ea);
                const int pa = (int)__builtin_amdgcn_mbcnt_hi((unsigned)(ea >> 32), __builtin_amdgcn_mbcnt_lo((unsigned)ea, 0u)), pb = (int)__builtin_amdgcn_mbcnt_hi((unsigned)(eb >> 32), __builtin_amdgcn_mbcnt_lo((unsigned)eb, 0u));
                m0 = ga | __ballot(ka == T && pa < R) | 1ull; m1 = gb | __ballot(kb == T && (na + pb) < R);
                if (cur < 64) m0 |= 1ull << cur; else m1 |= 1ull << (cur - 64);
                if (cur - 1 < 64) m0 |= 1ull << (cur - 1); else m1 |= 1ull << (cur - 65);
            }
            if (F.lane == 0) { LAS unsigned* sp = selm + (8 * F.wave + qq) * 4; sp[0] = (unsigned)m0; sp[1] = (unsigned)(m0 >> 32); sp[2] = (unsigned)m1; sp[3] = (unsigned)(m1 >> 32);
                __hip_atomic_fetch_or(&um[0], (unsigned)m0, __ATOMIC_RELAXED, __HIP_MEMORY_SCOPE_WORKGROUP); __hip_atomic_fetch_or(&um[1], (unsigned)(m0 >> 32), __ATOMIC_RELAXED, __HIP_MEMORY_SCOPE_WORKGROUP); __hip_atomic_fetch_or(&um[2], (unsigned)m1, __ATOMIC_RELAXED, __HIP_MEMORY_SCOPE_WORKGROUP); __hip_atomic_fetch_or(&um[3], (unsigned)(m1 >> 32), __ATOMIC_RELAXED, __HIP_MEMORY_SCOPE_WORKGROUP); }
        }
        LDS_WAIT(); __syncthreads();
    }
    {
        const unsigned uw0 = um[0], uw1 = um[1], uw2 = um[2], uw3 = um[3];
        const LAS unsigned* selq = selm + qloc * 4;
        const int nsel = __builtin_amdgcn_readfirstlane(__popc(uw0) + __popc(uw1) + __popc(uw2) + __popc(uw3));
        LAS unsigned char* slist = (LAS unsigned char*)(lds + FA_VALS);
        if (F.tid < 128) { const int j = F.tid; const unsigned w = (j < 32) ? uw0 : (j < 64) ? uw1 : (j < 96) ? uw2 : uw3;
            if ((w >> (j & 31)) & 1u) { int pos = __popc(w & ((1u << (j & 31)) - 1u)); if (j >= 32) pos += __popc(uw0); if (j >= 64) pos += __popc(uw1); if (j >= 96) pos += __popc(uw2); slist[pos] = (unsigned char)j; } }
        LDS_WAIT(); __syncthreads();
        fa::sm_init(st);
        fa::fa_loop<64, true>(st, qf, ws, ZB + ZC_KS * 2u, ZLD * 2u, ZB + ZC_VS * 2u, ZLD * 2u, SEQ - 1, nsel,
            [=](int t) { return 64 * (int)slist[t]; },
            [=](int t, bool& act, bool& ew, float& cb, int& lo, int& hi) { const int j = (int)slist[t], key0 = 64 * j; const unsigned mw = selq[j >> 5];
                const bool on = (mw >> (j & 31)) & 1u; act = __any(on) != 0; ew = (j == qi); cb = on ? sl * (float)(key0 - q0 + 4 * h) : fa::MASKV; lo = -100000; hi = tq - key0; },
            sl, lds + FA_STAGES, F.tid, F.lane);
        { f32x16 t2[2] = {f32x16{}, f32x16{}}; fa::sm_finish(st, g1, t2); unsigned parkl = parko; asm volatile("" : "+v"(parkl));
#pragma unroll
          for (int v = 0; v < 16; ++v) { PARK(32 + v) = t2[0][v]; PARK(48 + v) = t2[1][v]; } }
    }
    {
        const int t0 = (qi - 8) > 0 ? (qi - 8) : 0, nt = qi + 1 - t0;
        fa::sm_init(st);
        fa::fa_loop<64, true>(st, qf, ws, ZB + ZC_KW * 2u, ZLD * 2u, ZB + ZC_VW * 2u, ZLD * 2u, SEQ - 1, nt,
            [=](int t) { return 64 * (t0 + t); },
            [=](int t, bool& act, bool& ew, float& cb, int& lo, int& hi) { const int j = t0 + t, key0 = 64 * j; act = true; ew = (j == qi) || (j == qi - 8);
                cb = sl * (float)(key0 - q0 + 4 * h); lo = tq - 511 - key0; hi = tq - key0; },
            sl, lds + FA_STAGES, F.tid, F.lane);
    }
    f32x16 acc[2] = {f32x16{}, f32x16{}}; fa::sm_finish(st, g2, acc); unsigned parkl = parko; asm volatile("" : "+v"(parkl));
#pragma unroll
    for (int v = 0; v < 16; ++v) { acc[0][v] += PARK(v) + PARK(32 + v); acc[1][v] += PARK(16 + v) + PARK(48 + v); }
#undef PARK
    fa::store_out(acc, lds + FA_OST + F.wave * 32 * fa::OSTR, ws, [=](int col) { return (unsigned)WS_O + (unsigned)(b * SEQ + wq0 + (col >> 2)) * 2048u + (unsigned)(512 + (col & 3) * 64) * 2u; }, F.lane);
}

__device__ __forceinline__ void p_attn(Frame& F, const float* sinks, int mskip) {
    const int id = F.vcu;
    if (F.G != 256) return;
    { const int bh = id >> 4, s = id & 15;
#pragma unroll 1
      for (int k = 0; k < (((mskip >> 9) & 1) ? 4 : 2); ++k) u_mla(F, bh >> 2, bh & 3, (k & 1) ? s : 31 - s); }
    { const int bh = id >> 4, s = id & 15;
#pragma unroll 1
      for (int k = 0; k < (((mskip >> 11) & 1) ? 4 : 2); ++k) u_moba(F, bh >> 2, bh & 3, (k & 1) ? s : 31 - s); }
    if (!(mskip & 4)) { const int b = id >> 6, s = id & 63;
#pragma unroll 1
      for (int k = 0; k < (((mskip >> 10) & 1) ? 4 : 2); ++k) u_nsa(F, b, (k & 1) ? s : 127 - s); }
    {
#pragma unroll 1
      for (int k = 0; k < (((mskip >> 8) & 1) ? 4 : 2); ++k) { const int u0 = 2 * id + (k & 1); u_swa(F, u0 >> 7, (u0 >> 6) & 1, u0 & 63, sinks); } }
}
constexpr int PH_PRO = 0, PH_L0 = 1, PH_PER_L = 9, PH_FIN = 19, PH_END = 20;
constexpr int PO_NORM1 = 0, PO_ZG = 1, PO_PREP = 2, PO_UP = 3, PO_ATTN = 4, PO_OG = 5, PO_NORM2 = 6, PO_UPG = 7, PO_DNG = 8;
#ifndef MK_PHASE_MASK
#define MK_PHASE_MASK 0xFFFFFu
#endif

__global__ void __launch_bounds__(NTHR, 2) mega(Args args) {
    extern __shared__ __attribute__((aligned(16))) unsigned char lds_raw[];
    Frame F;
    F.lds = (LAS unsigned char*)lds_raw;
    int wave_s = __builtin_amdgcn_readfirstlane((int)threadIdx.x >> 6); asm volatile("" : "+s"(wave_s));
    F.tid = threadIdx.x; F.lane = F.tid & 63; F.wave = wave_s;
    F.G = gridDim.x; { const int bx = blockIdx.x; F.vcu = (F.G % 8 == 0) ? (bx % 8) * (F.G / 8) + bx / 8 : bx; }
    volatile LAS unsigned* misc = (volatile LAS unsigned*)(F.lds + LDS_MISC);
    if (F.tid < 64) misc[F.tid] = 0u;
    __syncthreads();
    (void)xcd_barrier_post((unsigned*)(args.ws + WS_CTL), misc + 8);
    float* fo; KArgsP ap;
#define KARGS() ({ KArgsP q_ = (KArgsP)__builtin_amdgcn_kernarg_segment_ptr(); asm volatile("" : "+s"(q_)); q_; })
#define IN(k) ({ KArgsP q2_ = KARGS(); q2_->ph_lo <= (k) && (k) < q2_->ph_hi; })
#define PHASE_BEGIN() do { asm volatile("; PHASE_MARK %0" :: "i"(__LINE__)); ap = KARGS(); F.G = gridDim.x; \
        { int w_ = wave_s; asm volatile("" : "+s"(w_)); int t_ = (w_ << 6) | (int)__builtin_amdgcn_mbcnt_hi(~0u, __builtin_amdgcn_mbcnt_lo(~0u, 0u)); asm volatile("" : "+v"(t_)); F.tid = t_; F.lane = t_ & 63; F.wave = w_; } F.ws = ap->ws; int bx_ = (int)blockIdx.x; asm volatile("" : "+s"(bx_)); F.bx = bx_; F.vcu = (F.G % 8 == 0) ? (bx_ % 8) * (F.G / 8) + bx_ / 8 : bx_; fo = ap->out; } while (0)
#define INP(i) (ap->in[i])
#define SEAM(k) do { if (IN(k) && IN((k) + 1)) { XcdBarrier b_; b_.bar = (unsigned*)(KARGS()->ws + WS_CTL); b_.x = xb_xcc_id(); b_.st = (volatile LAS unsigned*)(F.lds + LDS_MISC) + 8; xcd_barrier(b_); } } while (0)

    if (IN(PH_PRO)) { PHASE_BEGIN(); p_prologue(F, ap); }
#ifdef MK_PRO_TWICE
    if (IN(PH_PRO)) { PHASE_BEGIN(); p_prologue(F, ap); }
#endif
    SEAM(PH_PRO);

    { constexpr int l = 0;
        const int pb = PH_L0 + PH_PER_L * l;
#define WB (F.ws + WS_W + (size_t)l * WS_WL)
#define MOD ((const float*)(F.ws + WS_MOD) + (size_t)l * NB * 6 * D)
#define XB ((bf16*)(F.ws + WS_XB))
#define XIN ((l == 0) ? (const void*)INP(0) : (const void*)XB)
#define H ((bf16*)(F.ws + WS_H))
#define Z ((bf16*)(F.ws + WS_Z))
#define OB ((bf16*)(F.ws + WS_O))
#define U ((bf16*)(F.ws + WS_U))

        if (IN(pb + PO_NORM1) && !((KARGS()->skip >> PO_NORM1) & 1)) { PHASE_BEGIN(); p_norm<0, (l != 0)>(F, XIN, INP(2) + l * D, MOD, MOD + D, H, nullptr); }
        SEAM(pb + PO_NORM1);

        if (IN(pb + PO_ZG) && !((KARGS()->skip >> PO_ZG) & 1)) { PHASE_BEGIN();
            pg8::Gemm g{H, (const bf16*)(WB + W_IN), M, ZLD, D, D}; pg8::StaticOrder S; S.init(M, ZLD, F.G, F.bx);
            pg8::EpiBf16<0> E{Z, ZLD, nullptr, 0, 0, 1.f};
            pg8::gemm_phase<pg8::EpiBf16<0>, pg8::StaticOrder, true, true>(F.lds, g, S, E, F.tid);
        }
        SEAM(pb + PO_ZG);

        if (IN(pb + PO_PREP) && !((KARGS()->skip >> PO_PREP) & 1)) { PHASE_BEGIN(); p_prep(F, l); }
        SEAM(pb + PO_PREP);

        if (IN(pb + PO_UP) && !((KARGS()->skip >> PO_UP) & 1)) { PHASE_BEGIN();
            { pg8::Gemm g{Z + ZB_CQ, (const bf16*)(WB + W_UQ), M, 512, 256, ZLD}; pg8::StaticOrder S; S.init(M, 512, F.G, F.bx);
              pg8::EpiBf16<0> E{(bf16*)(F.ws + WS_QM), 512, nullptr, 0, 0, 1.f};
              pg8::gemm_phase<pg8::EpiBf16<0>, pg8::StaticOrder, true, true>(F.lds, g, S, E, F.tid); }
            PHASE_BEGIN();
            { pg8::Gemm g{Z + ZB_CKV, (const bf16*)(WB + W_UKV), M, 512, 256, ZLD}; pg8::StaticOrder S; S.init(M, 512, F.G, F.bx);
              pg8::EpiMlaKV E{(bf16*)(F.ws + WS_KM), (bf16*)(F.ws + WS_VM), (const float*)(F.ws + WS_RSKV)};
              pg8::gemm_phase<pg8::EpiMlaKV, pg8::StaticOrder, true, false>(F.lds, g, S, E, F.tid); }
            PHASE_BEGIN();
            p_compress(F, l);
        }
        SEAM(pb + PO_UP);

        if (IN(pb + PO_ATTN) && !((KARGS()->skip >> PO_ATTN) & 1)) { PHASE_BEGIN(); p_attn(F, INP(8) + l * 4, (ap->skip >> 16) | ((ap->rep >> 20) << 8)); }
        SEAM(pb + PO_ATTN);

        if (IN(pb + PO_OG) && !((KARGS()->skip >> PO_OG) & 1)) { PHASE_BEGIN();
            pg8::Gemm g{OB, (const bf16*)(WB + W_OUT), M, D, D, D}; pg8::StaticOrder S; S.init(M, D, F.G, F.bx);
            pg8::EpiResid<(l != 0)> E{XIN, XB, MOD + 2 * D};
            pg8::gemm_phase<pg8::EpiResid<(l != 0)>, pg8::StaticOrder, true, true>(F.lds, g, S, E, F.tid);
        }
        SEAM(pb + PO_OG);

        if (IN(pb + PO_NORM2) && !((KARGS()->skip >> PO_NORM2) & 1)) { PHASE_BEGIN(); p_norm<0, true>(F, XB, INP(3) + l * D, MOD + 3 * D, MOD + 4 * D, H, nullptr); }
        SEAM(pb + PO_NORM2);

        if (IN(pb + PO_UPG) && !((KARGS()->skip >> PO_UPG) & 1)) { PHASE_BEGIN();
            pg8::Gemm g{H, (const bf16*)(WB + W_UP), M, DFF, D, D}; pg8::StaticOrder S; S.init(M, DFF, F.G, F.bx);
            pg8::EpiRelu2 E{U, DFF};
            pg8::gemm_phase<pg8::EpiRelu2, pg8::StaticOrder, true, true>(F.lds, g, S, E, F.tid);
        }
        SEAM(pb + PO_UPG);

        if (IN(pb + PO_DNG) && !((KARGS()->skip >> PO_DNG) & 1)) { PHASE_BEGIN();
            pg8::Gemm g{U, (const bf16*)(WB + W_DN), M, D, DFF, DFF}; pg8::StaticOrder S; S.init(M, D, F.G, F.bx);
            pg8::EpiResid<true> E{XB, XB, MOD + 5 * D};
            pg8::gemm_phase<pg8::EpiResid<true>, pg8::StaticOrder, true, true>(F.lds, g, S, E, F.tid);
        }
        SEAM(pb + PO_DNG);
    }
    { constexpr int l = 1;
        const int pb = PH_L0 + PH_PER_L * l;
#define WB (F.ws + WS_W + (size_t)l * WS_WL)
#define MOD ((const float*)(F.ws + WS_MOD) + (size_t)l * NB * 6 * D)
#define XB ((bf16*)(F.ws + WS_XB))
#define XIN ((l == 0) ? (const void*)INP(0) : (const void*)XB)
#define H ((bf16*)(F.ws + WS_H))
#define Z ((bf16*)(F.ws + WS_Z))
#define OB ((bf16*)(F.ws + WS_O))
#define U ((bf16*)(F.ws + WS_U))

        if (IN(pb + PO_NORM1) && !((KARGS()->skip >> PO_NORM1) & 1)) { PHASE_BEGIN(); p_norm<0, (l != 0)>(F, XIN, INP(2) + l * D, MOD, MOD + D, H, nullptr); }
        SEAM(pb + PO_NORM1);

        if (IN(pb + PO_ZG) && !((KARGS()->skip >> PO_ZG) & 1)) { PHASE_BEGIN();
            pg8::Gemm g{H, (const bf16*)(WB + W_IN), M, ZLD, D, D}; pg8::StaticOrder S; S.init(M, ZLD, F.G, F.bx);
            pg8::EpiBf16<0> E{Z, ZLD, nullptr, 0, 0, 1.f};
            pg8::gemm_phase<pg8::EpiBf16<0>, pg8::StaticOrder, true, true>(F.lds, g, S, E, F.tid);
        }
        SEAM(pb + PO_ZG);

        if (IN(pb + PO_PREP) && !((KARGS()->skip >> PO_PREP) & 1)) { PHASE_BEGIN(); p_prep(F, l); }
        SEAM(pb + PO_PREP);

        if (IN(pb + PO_UP) && !((KARGS()->skip >> PO_UP) & 1)) { PHASE_BEGIN();
            { pg8::Gemm g{Z + ZB_CQ, (const bf16*)(WB + W_UQ), M, 512, 256, ZLD}; pg8::StaticOrder S; S.init(M, 512, F.G, F.bx);
              pg8::EpiBf16<0> E{(bf16*)(F.ws + WS_QM), 512, nullptr, 0, 0, 1.f};
              pg8::gemm_phase<pg8::EpiBf16<0>, pg8::StaticOrder, true, true>(F.lds, g, S, E, F.tid); }
            PHASE_BEGIN();
            { pg8::Gemm g{Z + ZB_CKV, (const bf16*)(WB + W_UKV), M, 512, 256, ZLD}; pg8::StaticOrder S; S.init(M, 512, F.G, F.bx);
              pg8::EpiMlaKV E{(bf16*)(F.ws + WS_KM), (bf16*)(F.ws + WS_VM), (const float*)(F.ws + WS_RSKV)};
              pg8::gemm_phase<pg8::EpiMlaKV, pg8::StaticOrder, true, false>(F.lds, g, S, E, F.tid); }
            PHASE_BEGIN();
            p_compress(F, l);
        }
        SEAM(pb + PO_UP);

        if (IN(pb + PO_ATTN) && !((KARGS()->skip >> PO_ATTN) & 1)) { PHASE_BEGIN(); p_attn(F, INP(8) + l * 4, (ap->skip >> 16) | ((ap->rep >> 20) << 8)); }
        SEAM(pb + PO_ATTN);

        if (IN(pb + PO_OG) && !((KARGS()->skip >> PO_OG) & 1)) { PHASE_BEGIN();
            pg8::Gemm g{OB, (const bf16*)(WB + W_OUT), M, D, D, D}; pg8::StaticOrder S; S.init(M, D, F.G, F.bx);
            pg8::EpiResid<(l != 0)> E{XIN, XB, MOD + 2 * D};
            pg8::gemm_phase<pg8::EpiResid<(l != 0)>, pg8::StaticOrder, true, true>(F.lds, g, S, E, F.tid);
        }
        SEAM(pb + PO_OG);

        if (IN(pb + PO_NORM2) && !((KARGS()->skip >> PO_NORM2) & 1)) { PHASE_BEGIN(); p_norm<0, true>(F, XB, INP(3) + l * D, MOD + 3 * D, MOD + 4 * D, H, nullptr); }
        SEAM(pb + PO_NORM2);

        if (IN(pb + PO_UPG) && !((KARGS()->skip >> PO_UPG) & 1)) { PHASE_BEGIN();
            pg8::Gemm g{H, (const bf16*)(WB + W_UP), M, DFF, D, D}; pg8::StaticOrder S; S.init(M, DFF, F.G, F.bx);
            pg8::EpiRelu2 E{U, DFF};
            pg8::gemm_phase<pg8::EpiRelu2, pg8::StaticOrder, true, true>(F.lds, g, S, E, F.tid);
        }
        SEAM(pb + PO_UPG);

        if (IN(pb + PO_DNG) && !((KARGS()->skip >> PO_DNG) & 1)) { PHASE_BEGIN();
            pg8::Gemm g{U, (const bf16*)(WB + W_DN), M, D, DFF, DFF}; pg8::StaticOrder S; S.init(M, D, F.G, F.bx);
            pg8::EpiResid<true> E{XB, XB, MOD + 5 * D};
            pg8::gemm_phase<pg8::EpiResid<true>, pg8::StaticOrder, true, true>(F.lds, g, S, E, F.tid);
        }
        SEAM(pb + PO_DNG);
    }
    if (IN(PH_FIN)) { PHASE_BEGIN(); p_norm<1, true>(F, (const void*)(F.ws + WS_XB), INP(21), nullptr, nullptr, nullptr, fo); }
#undef IN
#undef SEAM
}
}
extern "C" void kernel_launch(void* const* d_in, const int* in_sizes, int n_in, void* d_out, int out_size, void* d_ws, size_t ws_size, hipStream_t stream) {
    using namespace mk;
    static int grid = 0;
    if (grid == 0) {
        int dev = 0, cus = 0;
        if (hipGetDevice(&dev) != hipSuccess || hipDeviceGetAttribute(&cus, hipDeviceAttributeMultiprocessorCount, dev) != hipSuccess) { grid = -1; return; }
        if (hipFuncSetAttribute((const void*)mega, hipFuncAttributeMaxDynamicSharedMemorySize, LDS_BYTES) != hipSuccess) { grid = -1; return; }
        (void)hipGetLastError();
        grid = cus;
    }
    if (grid < 0) return;
    (void)in_sizes; (void)n_in; (void)out_size; (void)ws_size;
    Args a{};
    for (int i = 0; i < 22; ++i) a.in[i] = (const float*)d_in[i];
    a.out = (float*)d_out; a.ws = (unsigned char*)d_ws; a.skip = 0; a.rep = MK_REP;
    auto launch = [&](int lo, int hi) {
        (void)hipMemsetAsync((char*)d_ws + WS_CTL, 0, CTL_ZERO_BYTES, stream);
        a.ph_lo = lo; a.ph_hi = hi;
        hipLaunchKernelGGL(mega, dim3(grid), dim3(NTHR), LDS_BYTES, stream, a);
    };
    launch(0, PH_END);
}
```

```cpp
#include <hip/hip_runtime.h>
#include <cstdio>
#include <cstdint>
#include <math.h>
#define MK_PQ 500.0
#define FA_EXP 2
#define FA_PROBE 0
#define MK_PROBE_IDX 0
#define FA_KO 0
#define MK_MODE 0
#define MK_NAIVE_MASK 0
#define MK_SKIP 0
#define MK_SPLIT 0
#define MK_DBG_PHASE 0
#define MK_DBG_TEST 0
#define MK_REP 0
namespace pg8 {
#define PG8_LAS __attribute__((address_space(3)))
typedef unsigned short bf16_t;
typedef short bf16x8 __attribute__((ext_vector_type(8)));
typedef float f32x4 __attribute__((ext_vector_type(4)));
typedef unsigned u32x4 __attribute__((ext_vector_type(4)));
constexpr int BM = 256, BK = 64, HALF = 128, HTB = HALF * BK * 2  , STAGE_BYTES = 8 * HTB, NXCD = 8, WGM = 8;

__host__ __device__ __forceinline__ int lds_byte(int r, int c) { const int st = (r >> 4) * 2 + (c >> 5), rr = r & 15, cc = c & 31, ob = rr * 64 + cc * 2; return st * 1024 + (ob ^ (((ob >> 9) & 1) << 5)); }
__host__ __device__ __forceinline__ void stage_rc(int b, int& R, int& C) { const int st = b / 1024, sb = b % 1024, swz = sb ^ (((sb >> 9) & 1) << 5); R = (st >> 1) * 16 + swz / 64; C = (st & 1) * 32 + (swz % 64) / 2; }
__host__ __device__ __forceinline__ int perm32(int rho) { const int n = rho >> 4, i = rho & 15; return 8 * (i >> 2) + 4 * n + (i & 3); }

struct Unit { int pm, pn; };
struct Gemm { const bf16_t* A; const bf16_t* Bt; int M, N, K, lda; };

struct StaticOrder {
    int nM, nN, nwg, G, c;
    __host__ __device__ void init(int M, int N, int G_, int c_) { nM = M / BM; nN = N / BM; nwg = nM * nN; G = G_; c = c_; }
    __host__ __device__ bool next(int i, Unit& u) const {
        const long L = (long)i * G + c; if (L >= nwg) return false;
        int wgid = (int)L; { const int q = nwg / NXCD, r = nwg % NXCD, xcd = wgid % NXCD, off = wgid / NXCD; wgid = (xcd < r ? xcd * (q + 1) : r * (q + 1) + (xcd - r) * q) + off; }
        const int nig = WGM * nN, gid = wgid / nig, fm = gid * WGM, gsz = (nM - fm) < WGM ? (nM - fm) : WGM;
        u.pm = fm + ((wgid % nig) % gsz); u.pn = (wgid % nig) / gsz; return true;
    }
    __device__ __forceinline__ void a_ready(const Unit&) const {}
    __device__ __forceinline__ void done(const Unit&) const {}
};
__device__ __forceinline__ unsigned cvt_pk_bf16(float lo, float hi) { unsigned r; asm volatile("v_cvt_pk_bf16_f32 %0, %1, %2" : "=v"(r) : "v"(lo), "v"(hi)); return r; }
typedef float f32x2 __attribute__((ext_vector_type(2)));
__device__ __forceinline__ f32x2 gelu_pk(f32x2 v) {
    const f32x2 av = __builtin_elementwise_abs(v), d = av * 0.2316418882f + 1.0f;
    f32x2 t; t.x = __builtin_amdgcn_rcpf(d.x); t.y = __builtin_amdgcn_rcpf(d.y);
    f32x2 q = t * 0.5307027145f + (-0.7265760135f); q = q * t + 0.7107068705f; q = q * t + (-0.142248368f); q = q * t + 0.127414796f; q = q * t;
    const f32x2 s = (v * v) * (-0.72134752044f);
    f32x2 e; e.x = __builtin_amdgcn_exp2f(s.x); e.y = __builtin_amdgcn_exp2f(s.y);
    const f32x2 m = v * (q * e), r = v - m;
    f32x2 o; o.x = v.x < 0.f ? m.x : r.x; o.y = v.y < 0.f ? m.y : r.y; return o;
}

template <int ACT  > struct EpiBf16 {
    static constexpr bool PERM = true, AFTER_DRAIN = false; static_assert(ACT == 0 || ACT == 1, "EpiBf16: ACT is 0 (none) or 1 (gelu_pk)");
    bf16_t* O; int ldc; const float* bias; int split_cols; size_t split_stride; float scale0;
    __device__ __forceinline__ void operator()(const f32x4 (&acc)[2][2][4][2], const Unit& u, int wr, int wc, int fr, int fq) const {
        const int row0 = u.pm * BM + wr * 64 + fr; int colt = u.pn * BM; bf16_t* base = O;
        float sc = 1.f; if (split_cols) { const int t = colt / split_cols; base += (size_t)t * split_stride; colt -= t * split_cols; if (t == 0) sc = scale0; }
        const int col0 = colt + wc * 32 + 8 * fq, bcol0 = u.pn * BM + wc * 32 + 8 * fq;
        f32x4 bv[2][2];
#pragma unroll
        for (int bj = 0; bj < 2; ++bj)
#pragma unroll
            for (int n = 0; n < 2; ++n) bv[bj][n] = bias ? *(const f32x4*)(bias + bcol0 + bj * HALF + 4 * n) : (f32x4){0.f, 0.f, 0.f, 0.f};
#pragma unroll
        for (int ai = 0; ai < 2; ++ai)
#pragma unroll
            for (int m = 0; m < 4; ++m) { bf16_t* rowp = base + (size_t)(row0 + ai * HALF + m * 16) * ldc + col0;
#pragma unroll
                for (int bj = 0; bj < 2; ++bj) { f32x4 v0 = acc[ai][bj][m][0] + bv[bj][0], v1 = acc[ai][bj][m][1] + bv[bj][1];
                    if (ACT == 1) { f32x2 a = gelu_pk((f32x2){v0[0], v0[1]}), b = gelu_pk((f32x2){v0[2], v0[3]}), c = gelu_pk((f32x2){v1[0], v1[1]}), d = gelu_pk((f32x2){v1[2], v1[3]});
                        v0 = (f32x4){a.x, a.y, b.x, b.y}; v1 = (f32x4){c.x, c.y, d.x, d.y}; }
                    v0 = v0 * sc; v1 = v1 * sc; u32x4 w; w.x = cvt_pk_bf16(v0[0], v0[1]); w.y = cvt_pk_bf16(v0[2], v0[3]); w.z = cvt_pk_bf16(v1[0], v1[1]); w.w = cvt_pk_bf16(v1[2], v1[3]);
                    *(u32x4*)(rowp + bj * HALF) = w; } }
    }
};
template <class Epi, class Sched, bool ALIGN_EPI = false, bool SP2 = false>
__device__ __forceinline__ void gemm_phase(PG8_LAS unsigned char* lds, const Gemm g, const Sched& S, const Epi& E, int tid_in) {
    int tid_ = tid_in; asm volatile("" : "+v"(tid_));
    const int tid = tid_, wid = __builtin_amdgcn_readfirstlane(tid >> 6), lane = tid & 63, wr = wid >> 2, wc = wid & 3, fr = lane & 15, fq = lane >> 4;
    const int K = g.K, nt = K / BK;
    unsigned voffA[2], voffB[2];
#pragma unroll
    for (int i = 0; i < 2; ++i) { int R, C; stage_rc(tid * 16 + i * 8192, R, C); const int Rb = Epi::PERM ? ((R & ~31) + perm32(R & 31)) : R;
        voffA[i] = (unsigned)(R * g.lda + C) * 2u; voffB[i] = (unsigned)(Rb * K + C) * 2u; }
    const size_t kstep = (size_t)(BK * 2);
    const size_t hstep = (size_t)HALF * K * 2;
    const size_t tstep = 2 * hstep; const size_t hstepA = (size_t)HALF * g.lda * 2, tstepA = 2 * hstepA;
    const unsigned ldsw = (unsigned)wid * 1024u;
    const int aoff = lds_byte(wr * 64 + fr, fq * 8), boff = lds_byte(wc * 32 + fr, fq * 8);
#define PG8_SA(b, h) (((b) * 2 + (h)) * HTB)
#define PG8_SB(b, h) ((4 + (b) * 2 + (h)) * HTB)
#define PG8_STAGE(bufoff, gbase, voff) do { _Pragma("unroll") for (int _i = 0; _i < 2; ++_i) \
        __builtin_amdgcn_global_load_lds((const unsigned*)((const char*)(gbase) + (voff)[_i]), (PG8_LAS unsigned*)(lds + (bufoff) + ldsw + _i * 8192), 16, 0, 0); } while (0)
#define PG8_LDA(dst, b, h) do { _Pragma("unroll") for (int m = 0; m < 4; ++m) _Pragma("unroll") for (int k = 0; k < 2; ++k) dst[m][k] = *(const PG8_LAS bf16x8*)(lds + PG8_SA(b, h) + aoff + m * 2048 + k * 1024); } while (0)
#define PG8_LDB(dst, b, h) do { _Pragma("unroll") for (int n = 0; n < 2; ++n) _Pragma("unroll") for (int k = 0; k < 2; ++k) dst[n][k] = *(const PG8_LAS bf16x8*)(lds + PG8_SB(b, h) + boff + n * 2048 + k * 1024); } while (0)
#define PG8_MMA(ai, bj, At, Bt) do { __builtin_amdgcn_s_setprio(1); _Pragma("unroll") for (int m = 0; m < 4; ++m) _Pragma("unroll") for (int n = 0; n < 2; ++n) _Pragma("unroll") for (int k = 0; k < 2; ++k) \
        acc[ai][bj][m][n] = __builtin_amdgcn_mfma_f32_16x16x32_bf16(Bt[n][k], At[m][k], acc[ai][bj][m][n], 0, 0, 0); __builtin_amdgcn_s_setprio(0); } while (0)
#define PG8_WAIT_V(n) asm volatile("s_waitcnt vmcnt(" #n ")" ::: "memory")
#define PG8_WAIT_L(n) asm volatile("s_waitcnt lgkmcnt(" #n ")" ::: "memory")
#define PG8_BAR __builtin_amdgcn_s_barrier()
#define PG8_SCHED __builtin_amdgcn_sched_barrier(0)
    Unit cur, nxt; int ui = 0;
    if (!S.next(0, cur)) return;
    f32x4 acc[2][2][4][2];
#pragma unroll
    for (int a = 0; a < 2; ++a)
#pragma unroll
        for (int b = 0; b < 2; ++b)
#pragma unroll
            for (int m = 0; m < 4; ++m)
#pragma unroll
                for (int n = 0; n < 2; ++n) acc[a][b][m][n] = (f32x4){0.f, 0.f, 0.f, 0.f};
    bf16x8 At[4][2], B0[2][2], B1[2][2];
    const char* cA = (const char*)g.A + (size_t)cur.pm * tstepA; const char* cB = (const char*)g.Bt + (size_t)cur.pn * tstep;
    S.a_ready(cur);
    if constexpr (SP2) {
        PG8_STAGE(PG8_SB(0, 0), cB, voffB); PG8_STAGE(PG8_SB(0, 1), cB + hstep, voffB); PG8_STAGE(PG8_SA(0, 0), cA, voffA); PG8_STAGE(PG8_SA(0, 1), cA + hstepA, voffA);
        if (wr == 1) PG8_BAR;
        PG8_WAIT_V(2); PG8_BAR;
        PG8_STAGE(PG8_SB(1, 0), cB + kstep, voffB); PG8_STAGE(PG8_SA(1, 0), cA + kstep, voffA); PG8_STAGE(PG8_SB(1, 1), cB + hstep + kstep, voffB);
        PG8_WAIT_V(6); PG8_BAR;
    } else {
        PG8_STAGE(PG8_SB(0, 0), cB, voffB); PG8_STAGE(PG8_SA(0, 0), cA, voffA); PG8_STAGE(PG8_SB(0, 1), cB + hstep, voffB); PG8_STAGE(PG8_SA(0, 1), cA + hstepA, voffA);
        if (wr == 1) PG8_BAR;
        PG8_WAIT_V(4); PG8_BAR;
        PG8_STAGE(PG8_SB(1, 0), cB + kstep, voffB); PG8_STAGE(PG8_SA(1, 0), cA + kstep, voffA); PG8_STAGE(PG8_SB(1, 1), cB + hstep + kstep, voffB);
        PG8_WAIT_V(6); PG8_BAR;
    }
    for (;;) {
        const bool has_next = S.next(ui + 1, nxt);
        const char* nA = has_next ? (const char*)g.A + (size_t)nxt.pm * tstepA : cA; const char* nB = has_next ? (const char*)g.Bt + (size_t)nxt.pn * tstep : cB;
        for (int t = 0; t < nt; t += 2) {
            const bool last = (t == nt - 2);
            const char* a1 = cA + (size_t)(t + 1) * kstep;
            const char* a2 = last ? nA : cA + (size_t)(t + 2) * kstep; const char* b2 = last ? nB : cB + (size_t)(t + 2) * kstep;
            const char* a3 = a2 + kstep; const char* b3 = b2 + kstep;
            if (last && has_next) S.a_ready(nxt);
            if constexpr (SP2) {
            PG8_LDB(B0, 0, 0); PG8_LDB(B1, 0, 1); PG8_SCHED; PG8_LDA(At, 0, 0); PG8_STAGE(PG8_SA(1, 1), a1 + hstepA, voffA);
            PG8_WAIT_V(8); PG8_WAIT_L(0); PG8_BAR; PG8_MMA(0, 0, At, B0); PG8_MMA(0, 1, At, B1); PG8_BAR; PG8_SCHED;
            PG8_LDA(At, 0, 1); PG8_STAGE(PG8_SB(0, 0), b2, voffB); PG8_STAGE(PG8_SB(0, 1), b2 + hstep, voffB); PG8_STAGE(PG8_SA(0, 0), a2, voffA);
            PG8_WAIT_V(8); PG8_WAIT_L(0); PG8_BAR; PG8_MMA(1, 0, At, B0); PG8_MMA(1, 1, At, B1); PG8_BAR; PG8_SCHED;
            PG8_LDB(B0, 1, 0); PG8_LDB(B1, 1, 1); PG8_SCHED; PG8_LDA(At, 1, 0); PG8_STAGE(PG8_SA(0, 1), a2 + hstepA, voffA);
            PG8_WAIT_V(8); PG8_WAIT_L(0); PG8_BAR; PG8_MMA(0, 0, At, B0); PG8_MMA(0, 1, At, B1); PG8_BAR; PG8_SCHED;
            PG8_LDA(At, 1, 1); PG8_STAGE(PG8_SB(1, 0), b3, voffB); PG8_STAGE(PG8_SB(1, 1), b3 + hstep, voffB); PG8_STAGE(PG8_SA(1, 0), a3, voffA);
            PG8_WAIT_V(8); PG8_WAIT_L(0); PG8_BAR; PG8_MMA(1, 0, At, B0); PG8_MMA(1, 1, At, B1); PG8_BAR; PG8_SCHED;
            } else {
            PG8_LDB(B0, 0, 0); PG8_SCHED; PG8_LDA(At, 0, 0); PG8_STAGE(PG8_SA(1, 1), a1 + hstepA, voffA);
            PG8_WAIT_L(8); PG8_BAR; PG8_WAIT_L(0); PG8_MMA(0, 0, At, B0); PG8_BAR; PG8_SCHED;
            PG8_LDB(B1, 0, 1); PG8_STAGE(PG8_SB(0, 0), b2, voffB);
            PG8_BAR; PG8_WAIT_L(0); PG8_MMA(0, 1, At, B1); PG8_BAR;
            PG8_LDA(At, 0, 1); PG8_STAGE(PG8_SA(0, 0), a2, voffA);
            PG8_BAR; PG8_WAIT_L(0); PG8_MMA(1, 0, At, B0); PG8_BAR; PG8_SCHED;
            PG8_STAGE(PG8_SB(0, 1), b2 + hstep, voffB);
            PG8_WAIT_V(6); PG8_BAR; PG8_MMA(1, 1, At, B1); PG8_BAR;
            PG8_LDB(B0, 1, 0); PG8_SCHED; PG8_LDA(At, 1, 0); PG8_STAGE(PG8_SA(0, 1), a2 + hstepA, voffA);
            PG8_WAIT_L(8); PG8_BAR; PG8_WAIT_L(0); PG8_MMA(0, 0, At, B0); PG8_BAR; PG8_SCHED;
            PG8_LDB(B1, 1, 1); PG8_STAGE(PG8_SB(1, 0), b3, voffB);
            PG8_BAR; PG8_WAIT_L(0); PG8_MMA(0, 1, At, B1); PG8_BAR;
            PG8_LDA(At, 1, 1); PG8_STAGE(PG8_SA(1, 0), a3, voffA);
            PG8_BAR; PG8_WAIT_L(0); PG8_MMA(1, 0, At, B0); PG8_BAR; PG8_SCHED;
            PG8_STAGE(PG8_SB(1, 1), b3 + hstep, voffB);
            PG8_WAIT_V(6); PG8_BAR; PG8_MMA(1, 1, At, B1); PG8_BAR;
            }
        }
        if constexpr (ALIGN_EPI) { if (wr == 0) PG8_BAR; }
        if constexpr (!Epi::AFTER_DRAIN) { E(acc, cur, wr, wc, fr, fq); S.done(cur); }
        if (!has_next) break;
#pragma unroll
        for (int a = 0; a < 2; ++a)
#pragma unroll
            for (int b = 0; b < 2; ++b)
#pragma unroll
                for (int m = 0; m < 4; ++m)
#pragma unroll
                    for (int n = 0; n < 2; ++n) acc[a][b][m][n] = (f32x4){0.f, 0.f, 0.f, 0.f};
        cur = nxt; cA = nA; cB = nB; ++ui;
        if constexpr (ALIGN_EPI) { if (wr == 1) PG8_BAR; }
    }
    PG8_WAIT_V(0);
    if constexpr (!ALIGN_EPI) { if (wr == 0) PG8_BAR; }
    PG8_BAR;
    if constexpr (Epi::AFTER_DRAIN) { E.fused(acc, cur, wr, wc, fr, fq, lds, wid, lane); S.done(cur); }
#undef PG8_SA
#undef PG8_SB
#undef PG8_STAGE
#undef PG8_LDA
#undef PG8_LDB
#undef PG8_MMA
#undef PG8_WAIT_V
#undef PG8_WAIT_L
#undef PG8_BAR
#undef PG8_SCHED
}
}
namespace pg8 {
template <class T> __device__ __forceinline__ T* uni_ptr(T* p) {
    const unsigned long long v = (unsigned long long)p; unsigned lo = __builtin_amdgcn_readfirstlane((unsigned)v), hi = __builtin_amdgcn_readfirstlane((unsigned)(v >> 32)); asm volatile("" : "+s"(lo), "+s"(hi)); return (T*)(((unsigned long long)hi << 32) | lo); }
template <bool XB16> struct EpiResid {
    static constexpr bool PERM = true, AFTER_DRAIN = false;
    const void* xin_; bf16_t* out_; const float* gate_;
    __device__ __forceinline__ void operator()(const f32x4 (&acc)[2][2][4][2], const Unit& u, int wr, int wc, int fr, int fq) const {
        const void* xin = uni_ptr(xin_); bf16_t* out = uni_ptr(out_); const float* gate = uni_ptr(gate_);
        const int row0 = u.pm * BM + wr * 64 + fr, col0 = u.pn * BM + wc * 32 + 8 * fq;
        const float* gp = gate + (size_t)(u.pm >> 5) * 6144 + col0;
        f32x4 gv[2][2];
#pragma unroll
        for (int bj = 0; bj < 2; ++bj)
#pragma unroll
            for (int n = 0; n < 2; ++n) gv[bj][n] = *(const f32x4*)(gp + bj * HALF + 4 * n);
#pragma unroll
        for (int ai = 0; ai < 2; ++ai)
#pragma unroll
            for (int m = 0; m < 4; ++m) { const size_t off = (size_t)(row0 + ai * HALF + m * 16) * 1024 + col0;
#pragma unroll
                for (int bj = 0; bj < 2; ++bj) { f32x4 x0, x1;
                    if (XB16) { const u32x4 xr = *(const u32x4*)((const bf16_t*)xin + off + bj * HALF);
                        x0 = (f32x4){__uint_as_float(xr.x << 16), __uint_as_float(xr.x & 0xffff0000u), __uint_as_float(xr.y << 16), __uint_as_float(xr.y & 0xffff0000u)};
                        x1 = (f32x4){__uint_as_float(xr.z << 16), __uint_as_float(xr.z & 0xffff0000u), __uint_as_float(xr.w << 16), __uint_as_float(xr.w & 0xffff0000u)}; }
                    else { x0 = *(const f32x4*)((const float*)xin + off + bj * HALF); x1 = *(const f32x4*)((const float*)xin + off + bj * HALF + 4); }
                    const f32x4 y0 = x0 + gv[bj][0] * acc[ai][bj][m][0], y1 = x1 + gv[bj][1] * acc[ai][bj][m][1];
                    u32x4 w; w.x = cvt_pk_bf16(y0[0], y0[1]); w.y = cvt_pk_bf16(y0[2], y0[3]); w.z = cvt_pk_bf16(y1[0], y1[1]); w.w = cvt_pk_bf16(y1[2], y1[3]);
                    *(u32x4*)(out + off + bj * HALF) = w; }
                if (m & 1) asm volatile("" ::: "memory"); }
    }
};
struct EpiRelu2 {
    static constexpr bool PERM = true, AFTER_DRAIN = false;
    bf16_t* O_; int ldc;
    __device__ __forceinline__ void operator()(const f32x4 (&acc)[2][2][4][2], const Unit& u, int wr, int wc, int fr, int fq) const {
        bf16_t* O = uni_ptr(O_);
        const int row0 = u.pm * BM + wr * 64 + fr, col0 = u.pn * BM + wc * 32 + 8 * fq;
#pragma unroll
        for (int ai = 0; ai < 2; ++ai)
#pragma unroll
            for (int m = 0; m < 4; ++m) { bf16_t* rowp = O + (size_t)(row0 + ai * HALF + m * 16) * ldc + col0;
#pragma unroll
                for (int bj = 0; bj < 2; ++bj) { f32x4 v0 = acc[ai][bj][m][0], v1 = acc[ai][bj][m][1];
                    v0 = __builtin_elementwise_max(v0, (f32x4){0.f, 0.f, 0.f, 0.f}); v1 = __builtin_elementwise_max(v1, (f32x4){0.f, 0.f, 0.f, 0.f}); v0 = v0 * v0; v1 = v1 * v1;
                    u32x4 w; w.x = cvt_pk_bf16(v0[0], v0[1]); w.y = cvt_pk_bf16(v0[2], v0[3]); w.z = cvt_pk_bf16(v1[0], v1[1]); w.w = cvt_pk_bf16(v1[2], v1[3]);
                    *(u32x4*)(rowp + bj * HALF) = w; } }
    }
};
struct EpiMlaQ {
    static constexpr bool PERM = true, AFTER_DRAIN = false;
    bf16_t* QM_;
    __device__ __forceinline__ void operator()(const f32x4 (&acc)[2][2][4][2], const Unit& u, int wr, int wc, int fr, int fq) const {
        bf16_t* QM = uni_ptr(QM_);
        const int row0 = u.pm * BM + wr * 64 + fr, cw = wc * 32 + 8 * fq;
        const int nbj = (u.pn != 0) ? 1 : 2;
#pragma unroll
        for (int ai = 0; ai < 2; ++ai)
#pragma unroll
            for (int m = 0; m < 4; ++m) { bf16_t* qr = QM + (size_t)(row0 + ai * HALF + m * 16) * 384 + u.pn * 256 + cw;
#pragma unroll
                for (int bj = 0; bj < 2; ++bj) if (bj < nbj) { const f32x4 v0 = acc[ai][bj][m][0], v1 = acc[ai][bj][m][1];
                    u32x4 o; o.x = cvt_pk_bf16(v0[0], v0[1]); o.y = cvt_pk_bf16(v0[2], v0[3]); o.z = cvt_pk_bf16(v1[0], v1[1]); o.w = cvt_pk_bf16(v1[2], v1[3]);
                    *(u32x4*)(qr + bj * HALF) = o; } }
    }
};
struct EpiMlaKV {
    static constexpr bool PERM = true, AFTER_DRAIN = false;
    bf16_t* KM_; bf16_t* VM_; const float* rskv_;
    __device__ __forceinline__ void operator()(const f32x4 (&acc)[2][2][4][2], const Unit& u, int wr, int wc, int fr, int fq) const {
        bf16_t* KM = uni_ptr(KM_); bf16_t* VM = uni_ptr(VM_); const float* rskv = uni_ptr(rskv_);
        const int row0 = u.pm * BM + wr * 64 + fr, w = wc * 32 + 8 * fq;
        const bool isk = wc < 2;
#pragma unroll
        for (int ai = 0; ai < 2; ++ai)
#pragma unroll
            for (int m = 0; m < 4; ++m) { const int row = row0 + ai * HALF + m * 16; const float rs = rskv[row];
#pragma unroll
                for (int bj = 0; bj < 2; ++bj) { const int head = u.pn * 2 + bj;
                    const f32x4 v0 = acc[ai][bj][m][0] * rs, v1 = acc[ai][bj][m][1] * rs;
                    u32x4 o; o.x = cvt_pk_bf16(v0[0], v0[1]); o.y = cvt_pk_bf16(v0[2], v0[3]); o.z = cvt_pk_bf16(v1[0], v1[1]); o.w = cvt_pk_bf16(v1[2], v1[3]);
                    if (isk) *(u32x4*)(KM + (size_t)row * 384 + head * 96 + w) = o; else *(u32x4*)(VM + (size_t)row * 256 + head * 64 + (w - 64)) = o; }
                asm volatile("" ::: "memory"); }
    }
};
}
#define GAS __attribute__((address_space(1)))
#define LAS __attribute__((address_space(3)))
typedef unsigned short bf16;
typedef unsigned v4u __attribute__((ext_vector_type(4)));
typedef float f32x4 __attribute__((ext_vector_type(4)));
typedef short bf16x8 __attribute__((ext_vector_type(8)));
typedef GAS unsigned gu32;
typedef GAS unsigned long long gu64;
#define RLX_AGENT __ATOMIC_RELAXED, __HIP_MEMORY_SCOPE_AGENT
#define LDS_WAIT() asm volatile("s_waitcnt lgkmcnt(0)" ::: "memory")
#define VM_WAIT() asm volatile("s_waitcnt vmcnt(0)" ::: "memory")
__device__ __forceinline__ unsigned long long rt() { return __builtin_amdgcn_s_memrealtime(); }
__device__ __forceinline__ unsigned f2bf(float f) { unsigned u = __builtin_bit_cast(unsigned, f); return (u + 0x7fffu + ((u >> 16) & 1u)) >> 16; }
__device__ __forceinline__ unsigned pk2(float lo, float hi) { return f2bf(lo) | (f2bf(hi) << 16); }

#define XB_TMO      128
#define XB_XCNT(j)  (256  + 64 * (j))
#define XB_XSUB(j)  (1280 + 64 * (j))
#define XB_XGEN(j)  (2304 + 64 * (j))
#define XB_TOP      3328
#define XB_TOPGEN   3392
#define XCD_BAR_WORDS 3456
#define XB_SPIN_CAP (1u << 18)

__device__ __forceinline__ unsigned xb_ld(unsigned* p)              { return __hip_atomic_load(p, __ATOMIC_RELAXED, __HIP_MEMORY_SCOPE_AGENT); }
__device__ __forceinline__ unsigned xb_add(unsigned* p, unsigned v) { return __hip_atomic_fetch_add(p, v, __ATOMIC_RELAXED, __HIP_MEMORY_SCOPE_AGENT); }
__device__ __forceinline__ unsigned xb_xcc_id() { return (unsigned)__builtin_amdgcn_s_getreg((3 << 11) | 20) & 0xFu; }
#define XB_SPIN(cond, bar) do { unsigned _sp = 0; while (cond) { __builtin_amdgcn_s_sleep(1); \
    if ((++_sp & 255u) == 0u) { if (xb_ld(&(bar)[XB_TMO])) break; if (_sp > XB_SPIN_CAP) { atomicAdd(&(bar)[XB_TMO], 1u); break; } } } } while (0)

struct XcdBarrier {
    unsigned* bar; unsigned x;
    volatile LAS unsigned* st;
};

__device__ __forceinline__ XcdBarrier xcd_barrier_post(unsigned* bar, volatile LAS unsigned* st) {
    XcdBarrier b; b.bar = bar; b.x = xb_xcc_id(); b.st = st;
    if (threadIdx.x == 0) (void)xb_add(&bar[XB_XCNT(b.x)], 1u);
    return b;
}
__device__ __forceinline__ void xcd_barrier_complete(unsigned* bar, unsigned x, unsigned& nloc, unsigned& nx) {
    const unsigned G = gridDim.x * gridDim.y * gridDim.z;
    unsigned sum, cnt, mine, sp = 0u;
    for (;;) {
        sum = 0u; cnt = 0u; mine = 0u;
#pragma unroll
        for (unsigned j = 0; j < 16; ++j) { const unsigned c = xb_ld(&bar[XB_XCNT(j)]); sum += c; cnt += (c > 0u) ? 1u : 0u; mine = (j == x) ? c : mine; }
        if (sum == G) break;
        __builtin_amdgcn_s_sleep(1);
        if ((++sp & 255u) == 0u) { if (xb_ld(&bar[XB_TMO])) break; if (sp > XB_SPIN_CAP) { atomicAdd(&bar[XB_TMO], 1u); break; } }
    }
    nloc = mine > 0u ? mine : 1u; nx = cnt > 0u ? cnt : 1u;
}

__device__ __forceinline__ void xcd_barrier(const XcdBarrier& b) {
    asm volatile("s_waitcnt vmcnt(0)" ::: "memory");
    __syncthreads();
    if (threadIdx.x == 0) {
        unsigned* bar = b.bar;
        __builtin_amdgcn_s_waitcnt(0);
        unsigned nloc = b.st[0], nx = b.st[1];
        if (nloc == 0u) { xcd_barrier_complete(bar, b.x, nloc, nx); b.st[0] = nloc; b.st[1] = nx; }
        const unsigned old = xb_add(&bar[XB_XSUB(b.x)], 1u);
        const unsigned gen = old / nloc;
        if (old + 1u == (gen + 1u) * nloc) {
            __builtin_amdgcn_fence(__ATOMIC_RELEASE, "agent");
            asm volatile("s_waitcnt vmcnt(0)" ::: "memory");
            const unsigned og = xb_add(&bar[XB_TOP], 1u);
            const unsigned tg = og / nx;
            if (og + 1u == (tg + 1u) * nx) xb_add(&bar[XB_TOPGEN], 1u);
            else XB_SPIN(xb_ld(&bar[XB_TOPGEN]) == tg, bar);
            __builtin_amdgcn_fence(__ATOMIC_ACQUIRE, "agent");
            xb_add(&bar[XB_XGEN(b.x)], 1u);
            asm volatile("s_waitcnt vmcnt(0)" ::: "memory");
        } else {
            XB_SPIN(xb_ld(&bar[XB_XGEN(b.x)]) == gen, bar);
            __builtin_amdgcn_fence(__ATOMIC_ACQUIRE, "agent");
            asm volatile("s_waitcnt vmcnt(0)" ::: "memory");
        }
    }
    __syncthreads();
}
#ifndef FA_PROBE
#define FA_PROBE 0
#endif
#ifndef FA_EXP
#define FA_EXP 0
#endif
namespace fa {
typedef unsigned short bf16;
typedef short bf16x8 __attribute__((ext_vector_type(8)));
typedef short s16x4 __attribute__((ext_vector_type(4)));
typedef float f32x16 __attribute__((ext_vector_type(16)));
typedef float f32x4v __attribute__((ext_vector_type(4)));
typedef unsigned u32x4 __attribute__((ext_vector_type(4)));
typedef unsigned u32x2 __attribute__((ext_vector_type(2)));
typedef float f32x2_t __attribute__((ext_vector_type(2)));
typedef __bf16 bf16x2_t __attribute__((ext_vector_type(2)));
#define FLAS __attribute__((address_space(3)))
#define FGAS __attribute__((address_space(1)))
constexpr float MASKV = -1e30f, MINIT = -5e29f, TINYF = 1e-30f, LOG2E = 1.4426950408889634f;
constexpr int OSTR = 144;

__device__ __forceinline__ float ex2(float x) { return __builtin_amdgcn_exp2f(x); }
__device__ __forceinline__ unsigned cvtpk(float lo, float hi) { f32x2_t v = {lo, hi}; bf16x2_t b = __builtin_convertvector(v, bf16x2_t); return __builtin_bit_cast(unsigned, b); }
__device__ __forceinline__ float xhalf_max(float m) { auto rr = __builtin_amdgcn_permlane32_swap(__float_as_uint(m), __float_as_uint(m), false, false); return fmaxf(__uint_as_float(rr[0]), __uint_as_float(rr[1])); }
__device__ __forceinline__ float xhalf_sum(float m) { auto rr = __builtin_amdgcn_permlane32_swap(__float_as_uint(m), __float_as_uint(m), false, false); return __uint_as_float(rr[0]) + __uint_as_float(rr[1]); }
__device__ __forceinline__ float bf2f(unsigned short b) { return __uint_as_float((unsigned)b << 16); }

struct SM { float m, l; f32x16 o[2]; };
__device__ __forceinline__ void sm_init(SM& s) { s.m = MINIT; s.l = 0.f; s.o[0] = f32x16{}; s.o[1] = f32x16{}; }

template <int DQ> struct Stg { u32x4 k0, k1, v; };
template <int DQ> __device__ __forceinline__ void stg_load(Stg<DQ>& s, const FGAS char* ws, unsigned koff, unsigned ksb, unsigned voff, unsigned vsb, int key0, int kmax, int tid) {
    const int row = tid >> 3, ch = tid & 7; int kr = key0 + row; kr = kr < kmax ? kr : kmax;
    s.k0 = *(const FGAS u32x4*)(ws + (koff + (unsigned)kr * ksb + (unsigned)ch * 16u));
    s.v = *(const FGAS u32x4*)(ws + (voff + (unsigned)kr * vsb + (unsigned)ch * 16u));
    if (DQ == 96) { if (tid < 256) { const int r2 = tid >> 2, c2 = tid & 3; int k2 = key0 + r2; k2 = k2 < kmax ? k2 : kmax; s.k1 = *(const FGAS u32x4*)(ws + (koff + (unsigned)k2 * ksb + 128u + (unsigned)c2 * 16u)); } }
}
template <int DQ> __device__ __forceinline__ void stg_store(const Stg<DQ>& s, FLAS char* buf, int tid) {
    const int row = tid >> 3, ch = tid & 7, p = ch >> 2, c = ch & 3;
    *(FLAS u32x4*)(buf + p * 4096 + row * 64 + ((c ^ ((row >> 2) & 3)) << 4)) = s.k0;
    *(FLAS u32x4*)(buf + (DQ / 32) * 4096 + row * 128 + ((p ^ ((row >> 1) & 1)) << 6) + (c << 4)) = s.v;
    if (DQ == 96) { if (tid < 256) { const int r2 = tid >> 2, c2 = tid & 3; *(FLAS u32x4*)(buf + 2 * 4096 + r2 * 64 + ((c2 ^ ((r2 >> 2) & 3)) << 4)) = s.k1; } }
}
template <int DQ> constexpr int stage_bytes() { return (DQ / 32) * 4096 + 8192; }

template <int DQ> __device__ __forceinline__ void compute_S(f32x16& p0, f32x16& p1, const FLAS char* buf, const bf16x8 (&qf)[DQ / 16], int lane) {
    const int r = lane & 31, h = lane >> 5, sw = (r >> 2) & 3;
#pragma unroll
    for (int d0 = 0; d0 < DQ / 16; ++d0) {
        const int p = d0 >> 1, c = 2 * (d0 & 1) + h;
        const FLAS char* a = buf + p * 4096 + r * 64 + ((c ^ sw) << 4);
        const bf16x8 a0 = *(const FLAS bf16x8*)a, a1 = *(const FLAS bf16x8*)(a + 2048);
        p0 = __builtin_amdgcn_mfma_f32_32x32x16_bf16(a0, qf[d0], p0, 0, 0, 0);
        p1 = __builtin_amdgcn_mfma_f32_32x32x16_bf16(a1, qf[d0], p1, 0, 0, 0);
    }
#if FA_EXP & 2
    __builtin_amdgcn_sched_group_barrier(0x100, 4, 0);
#pragma unroll
    for (int i = 0; i < DQ / 16 - 2; ++i) { __builtin_amdgcn_sched_group_barrier(0x008, 2, 0); __builtin_amdgcn_sched_group_barrier(0x100, 2, 0); }
    __builtin_amdgcn_sched_group_barrier(0x008, 4, 0);
#endif
}
__device__ __forceinline__ s16x4 vtr(const FLAS char* p) { typedef short v4i16_t __attribute__((ext_vector_type(4))); return __builtin_bit_cast(s16x4, __builtin_amdgcn_ds_read_tr16_b64_v4i16((FLAS v4i16_t*)p)); }
__device__ __forceinline__ void pv(f32x16 (&o)[2], const FLAS char* vbuf, const bf16x8 (&pf)[4], int lane) {
    const int g = lane >> 4, i = lane & 15, q4 = i >> 2, pp = i & 3, h = lane >> 5;
    const int sw = (q4 >> 1) & 1;
#pragma unroll
    for (int db = 0; db < 2; ++db) {
        const FLAS char* base = vbuf + (4 * h + q4) * 128 + ((db ^ sw) << 6) + (16 * (g & 1) + 4 * pp) * 2;
#pragma unroll
        for (int ks = 0; ks < 4; ++ks) {
            const s16x4 lo = vtr(base + ks * 2048), hi = vtr(base + ks * 2048 + 1024);
            const bf16x8 a = (bf16x8){lo[0], lo[1], lo[2], lo[3], hi[0], hi[1], hi[2], hi[3]};
            o[db] = __builtin_amdgcn_mfma_f32_32x32x16_bf16(a, pf[ks], o[db], 0, 0, 0);
        }
    }
#if FA_EXP & 2
    __builtin_amdgcn_sched_group_barrier(0x100, 8, 0);
    __builtin_amdgcn_sched_group_barrier(0x008, 2, 0); __builtin_amdgcn_sched_group_barrier(0x100, 4, 0);
    __builtin_amdgcn_sched_group_barrier(0x008, 2, 0); __builtin_amdgcn_sched_group_barrier(0x100, 4, 0);
    __builtin_amdgcn_sched_group_barrier(0x008, 4, 0);
#endif
}
__device__ __forceinline__ void mask_ew(f32x16& p0, f32x16& p1, int lo, int hi, int h) {
    const int lo2 = lo - 4 * h, hi2 = hi - 4 * h;
#pragma unroll
    for (int v = 0; v < 16; ++v) { const int k0 = (v & 3) + 8 * (v >> 2);
        if (k0 < lo2 || k0 > hi2) p0[v] = MASKV;
        if (k0 + 32 < lo2 || k0 + 32 > hi2) p1[v] = MASKV; }
}
__device__ __forceinline__ void sm_step(SM& st, f32x16& p0, f32x16& p1, bf16x8 (&pf)[4]) {
#define FA_MX3(a, b, c) __builtin_fmaxf(__builtin_fmaxf((a), (b)), (c))
    float ma = FA_MX3(p0[0], p0[1], p1[0]), mb = FA_MX3(p0[2], p0[3], p1[1]); ma = FA_MX3(ma, p1[2], p1[3]);
#pragma unroll
    for (int v = 4; v < 16; v += 4) { ma = FA_MX3(ma, p0[v], p0[v + 1]); mb = FA_MX3(mb, p0[v + 2], p0[v + 3]); ma = FA_MX3(ma, p1[v], p1[v + 1]); mb = FA_MX3(mb, p1[v + 2], p1[v + 3]); }
#undef FA_MX3
    const float mx = xhalf_max(__builtin_fmaxf(ma, mb));
    if (__any(mx > st.m)) {
        const float mn2 = fmaxf(st.m, mx), alpha = ex2(st.m - mn2);
        st.m = mn2; st.l *= alpha; st.o[0] *= alpha; st.o[1] *= alpha;
    }
    const float mn = st.m;
    float s0 = 0.f, s1 = 0.f;
#pragma unroll
    for (int v = 0; v < 16; ++v) { p0[v] = ex2(p0[v] - mn); p1[v] = ex2(p1[v] - mn); s0 += p0[v]; s1 += p1[v]; }
    st.l += s0 + s1;
    u32x4 w;
    w.x = cvtpk(p0[0], p0[1]); w.y = cvtpk(p0[2], p0[3]); w.z = cvtpk(p0[4], p0[5]); w.w = cvtpk(p0[6], p0[7]); pf[0] = __builtin_bit_cast(bf16x8, w);
    w.x = cvtpk(p0[8], p0[9]); w.y = cvtpk(p0[10], p0[11]); w.z = cvtpk(p0[12], p0[13]); w.w = cvtpk(p0[14], p0[15]); pf[1] = __builtin_bit_cast(bf16x8, w);
    w.x = cvtpk(p1[0], p1[1]); w.y = cvtpk(p1[2], p1[3]); w.z = cvtpk(p1[4], p1[5]); w.w = cvtpk(p1[6], p1[7]); pf[2] = __builtin_bit_cast(bf16x8, w);
    w.x = cvtpk(p1[8], p1[9]); w.y = cvtpk(p1[10], p1[11]); w.z = cvtpk(p1[12], p1[13]); w.w = cvtpk(p1[14], p1[15]); pf[3] = __builtin_bit_cast(bf16x8, w);
}
template <int DQ, bool ALIBI> __device__ __forceinline__ void score_tile(f32x16& p0, f32x16& p1, const FLAS char* buf, const bf16x8 (&qf)[DQ / 16], float cb, float sl, int lane) {
    if (ALIBI) {
#pragma unroll
        for (int v = 0; v < 16; ++v) { const float c = (float)((v & 3) + 8 * (v >> 2)); p0[v] = fmaf(sl, c, cb); p1[v] = fmaf(sl, c + 32.f, cb); }
    } else { p0 = f32x16{}; p1 = f32x16{}; }
    compute_S<DQ>(p0, p1, buf, qf, lane);
}
template <int DQ, bool ALIBI> __device__ __forceinline__ void tile_compute(SM& st, const FLAS char* buf, const bf16x8 (&qf)[DQ / 16], float cb, float sl, bool ew, int lo, int hi, int lane) {
    f32x16 p0, p1; bf16x8 pf[4];
    score_tile<DQ, ALIBI>(p0, p1, buf, qf, cb, sl, lane);
    if (ew) mask_ew(p0, p1, lo, hi, lane >> 5);
    sm_step(st, p0, p1, pf);
    pv(st.o, buf + (DQ / 32) * 4096, pf, lane);
}
template <int DQ, bool ALIBI, class K0, class PAR>
__device__ __forceinline__ void fa_loop(SM& st, const bf16x8 (&qf)[DQ / 16], const FGAS char* ws, unsigned koff, unsigned ksb, unsigned voff, unsigned vsb, int kmax, int ntile, K0 k0f, PAR parf, float sl, FLAS char* lds, int tid, int lane) {
    constexpr int STG = stage_bytes<DQ>();
    Stg<DQ> sgA, sgB;
    stg_load<DQ>(sgB, ws, koff, ksb, voff, vsb, k0f(0), kmax, tid); stg_store<DQ>(sgB, lds, tid);
    if (ntile > 1) stg_load<DQ>(sgA, ws, koff, ksb, voff, vsb, k0f(1), kmax, tid);
    if (ntile > 2) stg_load<DQ>(sgB, ws, koff, ksb, voff, vsb, k0f(2), kmax, tid);
    __syncthreads();
#if FA_PROBE && FA_PROBE < 9
    unsigned long long pr_c = 0, pr_w = 0, pr_b = 0, pr_t = 0; const unsigned long long pr_start = __builtin_amdgcn_s_memtime();
#define FA_P0 const unsigned long long q0_ = __builtin_amdgcn_s_memtime();
#define FA_P1 asm volatile("s_waitcnt vmcnt(0)" ::: "memory"); const unsigned long long q1_ = __builtin_amdgcn_s_memtime();
#define FA_P2 asm volatile("s_waitcnt lgkmcnt(0)" ::: "memory"); asm volatile("" : "+v"(st.o[0]), "+v"(st.o[1])); const unsigned long long q2_ = __builtin_amdgcn_s_memtime();
#define FA_P3 const unsigned long long q3_ = __builtin_amdgcn_s_memtime(); pr_w += q1_ - q0_; pr_c += q2_ - q1_; pr_b += q3_ - q2_; pr_t += 1;
#else
#define FA_P0
#define FA_P1
#define FA_P2
#define FA_P3
#endif
#define FA_ITER(SG) { \
        FA_P0 \
        if (t + 1 < ntile) stg_store<DQ>(SG, lds + ((t + 1) & 1) * STG, tid); \
        if (t + 3 < ntile) stg_load<DQ>(SG, ws, koff, ksb, voff, vsb, k0f(t + 3), kmax, tid); \
        FA_P1 \
        bool act, ew; float cb; int lo, hi; \
        parf(t, act, ew, cb, lo, hi); \
        if (act) tile_compute<DQ, ALIBI>(st, lds + (t & 1) * STG, qf, cb, sl, ew, lo, hi, lane); \
        FA_P2 \
        __syncthreads(); \
        FA_P3 }
    int t = 0;
    for (; t + 1 < ntile; t += 2) { FA_ITER(sgA) ++t; FA_ITER(sgB) --t; }
    if (t < ntile) FA_ITER(sgA)
#undef FA_ITER
#if FA_PROBE && FA_PROBE < 9
    if (DQ == 96 && lane == 0) { unsigned long long* pp = (unsigned long long*)((FGAS char*)ws + 32768);
        atomicAdd(pp + 0, pr_c); atomicAdd(pp + 1, pr_w); atomicAdd(pp + 2, pr_b); atomicAdd(pp + 3, pr_t); atomicAdd(pp + 4, __builtin_amdgcn_s_memtime() - pr_start); }
#endif
}
__device__ __forceinline__ void sm_finish(const SM& st, float gate, f32x16 (&acc)[2]) {
    const float inv = gate / fmaxf(xhalf_sum(st.l), TINYF);
    acc[0] += st.o[0] * inv; acc[1] += st.o[1] * inv;
}
template <class DST> __device__ __forceinline__ void store_out(const f32x16 (&acc)[2], FLAS char* ost, FGAS char* ws, DST dstf, int lane) {
    const int r = lane & 31, h = lane >> 5;
#pragma unroll
    for (int db = 0; db < 2; ++db)
#pragma unroll
        for (int g = 0; g < 4; ++g) { u32x2 w; w.x = cvtpk(acc[db][4 * g], acc[db][4 * g + 1]); w.y = cvtpk(acc[db][4 * g + 2], acc[db][4 * g + 3]);
            *(FLAS u32x2*)(ost + r * OSTR + (32 * db + 8 * g + 4 * h) * 2) = w; }
    asm volatile("s_waitcnt lgkmcnt(0)" ::: "memory");
#pragma unroll
    for (int i = 0; i < 4; ++i) { const int idx = i * 64 + lane, col = idx >> 3, ch = idx & 7;
        const u32x4 v = *(const FLAS u32x4*)(ost + col * OSTR + ch * 16);
        *(FGAS u32x4*)(ws + (dstf(col) + (unsigned)ch * 16u)) = v; }
    asm volatile("s_waitcnt lgkmcnt(0)" ::: "memory");
}
template <int DQ> __device__ __forceinline__ void load_q(bf16x8 (&qf)[DQ / 16], const FGAS char* ws, unsigned qoff, int h) {
#pragma unroll
    for (int d0 = 0; d0 < DQ / 16; ++d0) qf[d0] = *(const FGAS bf16x8*)(ws + (qoff + (unsigned)(d0 * 32 + 16 * h)));
}
}
namespace mk {
typedef unsigned short bf16;
typedef float f32x4 __attribute__((ext_vector_type(4)));
typedef unsigned v4u __attribute__((ext_vector_type(4)));
typedef unsigned v2u __attribute__((ext_vector_type(2)));
typedef short bf16x8 __attribute__((ext_vector_type(8)));
typedef float f32x16 __attribute__((ext_vector_type(16)));
using fa::SM;

constexpr int D = 1024, NB = 4, SEQ = 8192, M = NB * SEQ, DEPTH = 2, DFF = 4096, ZLD = 2304, DIN = 2284;
constexpr int ZA_Q = 0, ZA_K = 256, ZA_V = 384, ZB_CQ = 512, ZB_CKV = 704, ZB_PE = 832, ZC_Q = 864, ZC_KC = 1120, ZC_VC = 1184, ZC_KS = 1248, ZC_VS = 1312, ZC_KW = 1376, ZC_VW = 1440, ZC_GL = 1504, ZD_Q = 1520, ZD_K = 1776, ZD_V = 2032;
constexpr float LOG2E = 1.4426950408889634f;
constexpr float QS = 0.125f * LOG2E;
constexpr float C_MLA = 0.10206207261596577f * LOG2E;
constexpr float RMS_EPS = 1e-6f;
constexpr int NWAVES = 8, NTHR = 512;

constexpr size_t MiB = 1u << 20;
constexpr size_t WS_CTL = 0, CTL_ZERO_BYTES = 64 * 1024;
constexpr size_t WS_MOD = 1 * MiB;
constexpr size_t WS_ROPE = WS_MOD + 256 * 1024;
constexpr size_t WS_POSP = WS_ROPE + 1 * MiB;
constexpr size_t WS_POSB = WS_POSP + 64 * 1024;
constexpr size_t WS_RSQ = WS_POSB + 64 * 1024;
constexpr size_t WS_RSKV = WS_RSQ + 128 * 1024;
constexpr size_t WS_KMH = WS_RSKV + 128 * 1024;
constexpr size_t WS_KML = WS_KMH + 64 * 1024;
constexpr size_t WS_KCMP = WS_KML + 64 * 1024;
constexpr size_t WS_VCMP = WS_KCMP + 256 * 1024;
constexpr size_t WS_XB = 436 * MiB;
constexpr size_t WS_PARK = 401 * MiB;
constexpr size_t WS_W = 4 * MiB, WS_WL = 26 * MiB;
constexpr size_t W_IN = 0, W_OUT = 4608 * 1024, W_UP = W_OUT + 2 * MiB, W_DN = W_UP + 8 * MiB, W_UQ = W_DN + 8 * MiB, W_UKV = W_UQ + 256 * 1024, W_1K = W_UKV + 256 * 1024, W_1V = W_1K + 512 * 1024, W_2K = W_1V + 512 * 1024, W_2V = W_2K + 16 * 1024;
static_assert(W_2V + 16 * 1024 <= WS_WL && WS_VCMP + 256 * 1024 <= WS_W, "ws map");
constexpr size_t WS_H = 56 * MiB;
constexpr size_t WS_Z = 120 * MiB;
constexpr size_t WS_QM = 265 * MiB, WS_KM = 297 * MiB, WS_VM = 321 * MiB, WS_O = 337 * MiB, WS_U = 120 * MiB, WS_END = 401 * MiB;
static_assert(WS_Z + (size_t)(M + 64) * ZLD * 2 <= WS_QM && WS_U + (size_t)M * DFF * 2 <= WS_END, "ws map 2");

constexpr int LDS_RING = 131072, LDS_BYTES = 163840, LDS_MISC = LDS_BYTES - 256;
constexpr int FA_STAGES = 0, FA_OST = 61440, FA_IMP = FA_OST + 8 * 32 * fa::OSTR  , FA_SELM = FA_IMP + 32768, FA_UM = FA_SELM + 1024, FA_VALS = FA_UM + 64;
static_assert(FA_VALS + 8 * 512 <= LDS_MISC, "fa lds map");
constexpr int MB_OS = 65;
constexpr int MB_T = 0, MB_O = 65536, MB_ML = MB_O + 256 * MB_OS * 4, MB_CNT = MB_ML + 2048, MB_LST = MB_CNT + 128, MB_PS = MB_LST + 8192, MB_PM = MB_PS + 4 * 32 * 33 * 4;
static_assert(MB_PM + 1024 <= LDS_MISC, "moba lds map");

#define GAS __attribute__((address_space(1)))
#define LAS __attribute__((address_space(3)))
#define LDS_WAIT() asm volatile("s_waitcnt lgkmcnt(0)" ::: "memory")
__device__ __forceinline__ unsigned f2bf(float f) { unsigned u = __builtin_bit_cast(unsigned, f); return (u + 0x7fffu + ((u >> 16) & 1u)) >> 16; }
__device__ __forceinline__ unsigned pk2(float lo, float hi) { return f2bf(lo) | (f2bf(hi) << 16); }
__device__ __forceinline__ float bf2f(unsigned short b) { return __uint_as_float((unsigned)b << 16); }
__device__ __forceinline__ float wave_sum(float v) {
#pragma unroll
    for (int o = 1; o < 64; o <<= 1) v += __shfl_xor(v, o);
    return v;
}
__device__ __forceinline__ float slope2_of(int i) { return exp2f(-8.0f * (float)(i + 1) / 12.0f) * LOG2E; }

struct Args { const float* in[22]; float* out; unsigned char* ws; int ph_lo, ph_hi, skip, rep; };
typedef const __attribute__((address_space(4))) Args* KArgsP;
struct Frame {
    LAS unsigned char* lds;
    int tid, lane, wave, vcu, G, bx;
    unsigned char* ws;
};

template <int MODE> __device__ __forceinline__ int dmap(int n) {
    if (MODE == 1) { if (n < 832) return n; if (n < 848) return 832 + 2 * (n - 832); if (n < 864) return 832 + 2 * (n - 848) + 1; if (n < 1516) return n; return n + 4; }
    if (MODE == 2) { const int hd = n / 96, w = n - hd * 96; if (w < 64) return hd * 64 + w; if (w < 80) return 256 + hd * 32 + 2 * (w - 64); return 256 + hd * 32 + 2 * (w - 80) + 1; }
    return n;
}
template <int MODE> __device__ __forceinline__ float cscale(int n) {
    if (MODE == 1) { return (n < 256 || (n >= 864 && n < 1120) || (n >= 1516 && n < 1772)) ? QS : 1.f; }
    if (MODE == 2) return C_MLA;
    return 1.f;
}
template <int MODE> __device__ __forceinline__ void transpose_item(const float* W, int N, bf16* WT, int KT, const float* kscale, LAS float* scr, int item, int lane) {
    const int nblk = (N + 31) / 32, kb = item / nblk, nb = item % nblk, k0 = 64 * kb, n0 = 32 * nb;
    const int nl = lane & 31, n = n0 + nl;
#pragma unroll 8
    for (int i = 0; i < 32; ++i) { const int kk = 2 * i + (lane >> 5); float v = (n < N) ? W[(size_t)(k0 + kk) * N + n] : 0.f; if (kscale) v *= kscale[k0 + kk]; scr[kk * 33 + nl] = v; }
    LDS_WAIT(); asm volatile("" ::: "memory");
    const int c = lane & 7;
#pragma unroll
    for (int j = 0; j < 4; ++j) { const int nn = (lane >> 3) + 8 * j, ng = n0 + nn;
        if (ng < N) { const float cs = cscale<MODE>(ng); const LAS float* s = scr + (8 * c) * 33 + nn;
            v4u o; o.x = pk2(s[0 * 33] * cs, s[1 * 33] * cs); o.y = pk2(s[2 * 33] * cs, s[3 * 33] * cs); o.z = pk2(s[4 * 33] * cs, s[5 * 33] * cs); o.w = pk2(s[6 * 33] * cs, s[7 * 33] * cs);
            *(GAS v4u*)(WT + (size_t)dmap<MODE>(ng) * KT + k0 + 8 * c) = o; } }
    LDS_WAIT(); asm volatile("" ::: "memory");
}
__device__ __forceinline__ void zero_fill16(bf16* p, size_t n16, int gtid, int gthreads) {
    for (size_t i = gtid; i < n16; i += gthreads) ((GAS v4u*)p)[i] = (v4u){0u, 0u, 0u, 0u};
}

__device__ __forceinline__ void p_prologue(Frame& F, KArgsP ap_) {
#define a (*ap_)
    LAS float* scr = (LAS float*)(F.lds + F.wave * 16384);
    const int gw = F.vcu * NWAVES + F.wave, NGW = F.G * NWAVES;
    const int gtid = F.vcu * NTHR + F.tid, GT = F.G * NTHR;
    constexpr int I_IN = 16 * 72, I_OUT = 16 * 32, I_UP = 16 * 128, I_DN = 64 * 32, I_UQ = 3 * 12, I_UKV = 2 * 16, I_W1 = 32 * 4, I_W2 = 2 * 2;
    constexpr int PER_L = I_IN + I_OUT + I_UP + I_DN + I_UQ + I_UKV + 2 * I_W1 + 2 * I_W2;
    for (int it = gw; it < DEPTH * PER_L; it += NGW) {
        const int l = it / PER_L; int r = it - l * PER_L;
        unsigned char* wb = F.ws + WS_W + (size_t)l * WS_WL;
        if (r < I_IN) { transpose_item<1>(a.in[6] + (size_t)l * D * DIN, DIN, (bf16*)(wb + W_IN), D, nullptr, scr, r, F.lane); continue; } r -= I_IN;
        if (r < I_OUT) { transpose_item<0>(a.in[7] + (size_t)l * D * D, D, (bf16*)(wb + W_OUT), D, nullptr, scr, r, F.lane); continue; } r -= I_OUT;
        if (r < I_UP) { transpose_item<0>(a.in[19] + (size_t)l * D * DFF, DFF, (bf16*)(wb + W_UP), D, nullptr, scr, r, F.lane); continue; } r -= I_UP;
        if (r < I_DN) { transpose_item<0>(a.in[20] + (size_t)l * DFF * D, D, (bf16*)(wb + W_DN), DFF, nullptr, scr, r, F.lane); continue; } r -= I_DN;
        if (r < I_UQ) { transpose_item<2>(a.in[11] + (size_t)l * 192 * 384, 384, (bf16*)(wb + W_UQ), 256, a.in[9] + l * 192, scr, r, F.lane); continue; } r -= I_UQ;
        if (r < I_UKV) { transpose_item<0>(a.in[12] + (size_t)l * 128 * 512, 512, (bf16*)(wb + W_UKV), 256, a.in[10] + l * 128, scr, r, F.lane); continue; } r -= I_UKV;
        if (r < I_W1) { transpose_item<0>(a.in[15] + (size_t)l * 2048 * 128, 128, (bf16*)(wb + W_1K), 2048, nullptr, scr, r, F.lane); continue; } r -= I_W1;
        if (r < I_W1) { transpose_item<0>(a.in[17] + (size_t)l * 2048 * 128, 128, (bf16*)(wb + W_1V), 2048, nullptr, scr, r, F.lane); continue; } r -= I_W1;
        if (r < I_W2) { transpose_item<0>(a.in[16] + (size_t)l * 128 * 64, 64, (bf16*)(wb + W_2K), 128, nullptr, scr, r, F.lane); continue; } r -= I_W2;
        transpose_item<0>(a.in[18] + (size_t)l * 128 * 64, 64, (bf16*)(wb + W_2V), 128, nullptr, scr, r, F.lane);
    }
    for (int l = 0; l < DEPTH; ++l) {
        unsigned char* wb = F.ws + WS_W + (size_t)l * WS_WL;
        zero_fill16((bf16*)(wb + W_IN) + (size_t)1516 * D, 4 * D / 8, gtid, GT);
        zero_fill16((bf16*)(wb + W_IN) + (size_t)2288 * D, 16 * D / 8, gtid, GT);
        zero_fill16((bf16*)(wb + W_UQ) + (size_t)384 * 256, 128 * 256 / 8, gtid, GT);
        for (int i = gtid; i < 384 * 8; i += GT) ((GAS v4u*)((bf16*)(wb + W_UQ) + (size_t)(i >> 3) * 256 + 192))[i & 7] = (v4u){0u, 0u, 0u, 0u};
        for (int i = gtid; i < 512 * 16; i += GT) ((GAS v4u*)((bf16*)(wb + W_UKV) + (size_t)(i >> 4) * 256 + 128))[i & 15] = (v4u){0u, 0u, 0u, 0u};
    }
    { float* rt = (float*)(F.ws + WS_ROPE);
      for (int i = gtid; i < SEQ * 16; i += GT) { const int ii = i & 15, t = i >> 4; const float freq = powf(10000.f, -(float)ii / 16.f), ang = (float)t * freq; rt[2 * i] = cosf(ang); rt[2 * i + 1] = sinf(ang); } }
    { float* pp = (float*)(F.ws + WS_POSP);
      for (int i = gtid; i < DEPTH * 2 * 32 * 128; i += GT) { const int j = i & 127, kr = (i >> 7) & 31, wh = (i >> 12) & 1, l = i >> 13;
          const float* pos = a.in[wh ? 14 : 13] + l * 2048 + kr * 64; const float* w1 = a.in[wh ? 17 : 15] + (size_t)l * 2048 * 128 + (size_t)kr * 64 * 128 + j;
          float s = 0.f;
#pragma unroll 8
          for (int k = 0; k < 64; ++k) s += pos[k] * w1[(size_t)k * 128];
          pp[i] = s; } }
    { LAS float* sc = (LAS float*)(F.lds);
      LAS float* part = (LAS float*)(F.lds + 16384);
      __syncthreads();
      bool have = false;
      for (int it = F.vcu; it < DEPTH * 96; it += F.G) {
          if (!have) { for (int i = F.tid; i < NB * D; i += NTHR) { const float cv = a.in[1][i]; sc[i] = cv / (1.f + expf(-cv)); } have = true; __syncthreads(); }
          const int l = it / 96, ch = it % 96; const int j = ch * 64 + F.lane;
          const float* w = a.in[4] + (size_t)l * D * 6 * D + j;
          float acc[4] = {0.f, 0.f, 0.f, 0.f};
#pragma unroll 8
          for (int k = 128 * F.wave; k < 128 * F.wave + 128; ++k) { const float wv = w[(size_t)k * 6 * D]; acc[0] += sc[k] * wv; acc[1] += sc[D + k] * wv; acc[2] += sc[2 * D + k] * wv; acc[3] += sc[3 * D + k] * wv; }
#pragma unroll
          for (int b = 0; b < 4; ++b) part[(F.wave * 4 + b) * 64 + F.lane] = acc[b];
          __syncthreads();
          if (F.tid < 256) { const int b = F.tid >> 6, ln = F.tid & 63; float s = a.in[5][l * 6 * D + ch * 64 + ln];
#pragma unroll
              for (int w8 = 0; w8 < 8; ++w8) s += part[(w8 * 4 + b) * 64 + ln];
              ((float*)(F.ws + WS_MOD))[((size_t)l * NB + b) * 6 * D + ch * 64 + ln] = s; }
          __syncthreads();
      } }
}

#undef a
template <int MODE, bool XB16> __device__ __forceinline__ void p_norm(Frame& F, const void* x, const float* g, const float* modsh, const float* modsc, bf16* hout, float* fout) {
    const int gw = F.vcu * NWAVES + F.wave, NGW = F.G * NWAVES;
    for (int blk = gw; blk < M / 16; blk += NGW) {
        const int row0 = blk * 16, b = row0 >> 13;
        f32x4 ga[4], sh[4];
#pragma unroll
        for (int j = 0; j < 4; ++j) { const int c = 4 * F.lane + 256 * j; ga[j] = *(const f32x4*)(g + c);
            if (MODE == 0) { const f32x4 s = *(const f32x4*)(modsc + (size_t)b * 6 * D + c); ga[j] = ga[j] * (s + 1.0f); sh[j] = *(const f32x4*)(modsh + (size_t)b * 6 * D + c); } }
        for (int rr = 0; rr < 16; rr += 4) {
            f32x4 v[4][4];
#pragma unroll
            for (int q = 0; q < 4; ++q) { const int row = row0 + rr + q;
                if (XB16) { const GAS unsigned long long* xr = (const GAS unsigned long long*)((const bf16*)x + (size_t)row * D) + F.lane;
#pragma unroll
                    for (int j = 0; j < 4; ++j) { const unsigned long long qq = xr[64 * j]; const unsigned lo = (unsigned)qq, hi = (unsigned)(qq >> 32);
                        v[q][j] = (f32x4){__uint_as_float(lo << 16), __uint_as_float(lo & 0xffff0000u), __uint_as_float(hi << 16), __uint_as_float(hi & 0xffff0000u)}; } }
                else { const GAS f32x4* xr = (const GAS f32x4*)((const float*)x + (size_t)row * D) + F.lane;
#pragma unroll
                    for (int j = 0; j < 4; ++j) v[q][j] = xr[64 * j]; } }
#pragma unroll
            for (int q = 0; q < 4; ++q) { const int row = row0 + rr + q; float s = 0.f;
#pragma unroll
                for (int j = 0; j < 4; ++j) s += (v[q][j].x * v[q][j].x + v[q][j].y * v[q][j].y) + (v[q][j].z * v[q][j].z + v[q][j].w * v[q][j].w);
                const float r = rsqrtf(wave_sum(s) * (1.f / D) + RMS_EPS);
                if (MODE == 0) { GAS unsigned long long* o8 = (GAS unsigned long long*)(hout + (size_t)row * D) + F.lane;
#pragma unroll
                    for (int j = 0; j < 4; ++j) { const f32x4 y = v[q][j] * r * ga[j] + sh[j]; o8[64 * j] = (unsigned long long)pk2(y.x, y.y) | ((unsigned long long)pk2(y.z, y.w) << 32); } }
                else { GAS f32x4* o = (GAS f32x4*)(fout + (size_t)row * D) + F.lane;
#pragma unroll
                    for (int j = 0; j < 4; ++j) o[64 * j] = v[q][j] * r * ga[j]; } }
        }
    }
}

__device__ __forceinline__ void p_prep(Frame& F, int l) {
    const int gw = F.vcu * NWAVES + F.wave, NGW = F.G * NWAVES;
    const bf16* Z = (const bf16*)(F.ws + WS_Z); bf16* KM = (bf16*)(F.ws + WS_KM);
    float* rsq = (float*)(F.ws + WS_RSQ); float* rskv = (float*)(F.ws + WS_RSKV); const float* rope = (const float*)(F.ws + WS_ROPE);
    for (int rb = gw; rb < M / 4; rb += NGW) {
        float a0[4], a1[4], a2[4], b0[4], b1[4]; unsigned pr[4] = {0u, 0u, 0u, 0u}; float cs[4] = {0.f, 0.f, 0.f, 0.f}, sn[4] = {0.f, 0.f, 0.f, 0.f};
#pragma unroll
        for (int q = 0; q < 4; ++q) { const int row = rb * 4 + q; const bf16* zr = Z + (size_t)row * ZLD;
            a0[q] = bf2f(zr[ZB_CQ + F.lane]); a1[q] = bf2f(zr[ZB_CQ + 64 + F.lane]); a2[q] = bf2f(zr[ZB_CQ + 128 + F.lane]);
            b0[q] = bf2f(zr[ZB_CKV + F.lane]); b1[q] = bf2f(zr[ZB_CKV + 64 + F.lane]);
            if (F.lane < 16) { pr[q] = *(const unsigned*)(zr + ZB_PE + 2 * F.lane); cs[q] = rope[((size_t)(row & 8191) * 16 + F.lane) * 2]; sn[q] = rope[((size_t)(row & 8191) * 16 + F.lane) * 2 + 1]; } }
#pragma unroll
        for (int q = 0; q < 4; ++q) { const int row = rb * 4 + q;
            const float sq = wave_sum(a0[q] * a0[q] + a1[q] * a1[q] + a2[q] * a2[q]), skv = wave_sum(b0[q] * b0[q] + b1[q] * b1[q]);
            if (F.lane == 0) { rsq[row] = rsqrtf(sq * (1.f / 192.f) + RMS_EPS); rskv[row] = rsqrtf(skv * (1.f / 128.f) + RMS_EPS); }
            if (F.lane < 16) { const float x1 = bf2f((unsigned short)(pr[q] & 0xffffu)), x2 = bf2f((unsigned short)(pr[q] >> 16));
                const unsigned o = pk2(x1 * cs[q] - x2 * sn[q], x1 * sn[q] + x2 * cs[q]);
#pragma unroll
                for (int hd = 0; hd < 4; ++hd) *(unsigned*)(KM + (size_t)row * 384 + hd * 96 + 64 + 2 * F.lane) = o; } }
    }
    { bf16* KMH = (bf16*)(F.ws + WS_KMH); bf16* KML = (bf16*)(F.ws + WS_KML);
      for (int it = gw; it < NB * 4 * 32; it += NGW) { const int j = it & 31, hd = (it >> 5) & 3, b = it >> 7; const int ts = F.lane >> 3, ch = F.lane & 7;
          float acc[8] = {0.f, 0.f, 0.f, 0.f, 0.f, 0.f, 0.f, 0.f};
#pragma unroll 8
          for (int i = 0; i < 32; ++i) { const v4u w = *(const v4u*)(Z + (size_t)(b * SEQ + j * 256 + 8 * i + ts) * ZLD + ZD_K + hd * 64 + ch * 8);
#pragma unroll
              for (int e = 0; e < 4; ++e) { acc[2 * e] += __uint_as_float(w[e] << 16); acc[2 * e + 1] += __uint_as_float(w[e] & 0xffff0000u); } }
#pragma unroll
          for (int e = 0; e < 8; ++e) { acc[e] += __shfl_xor(acc[e], 8); acc[e] += __shfl_xor(acc[e], 16); acc[e] += __shfl_xor(acc[e], 32); }
          if (F.lane < 8) { unsigned hi[4], lo[4];
#pragma unroll
              for (int e = 0; e < 4; ++e) { const float m0 = acc[2 * e] * (1.f / 256.f), m1 = acc[2 * e + 1] * (1.f / 256.f); const unsigned h0 = f2bf(m0), h1 = f2bf(m1);
                  hi[e] = h0 | (h1 << 16); lo[e] = pk2(m0 - __uint_as_float(h0 << 16), m1 - __uint_as_float(h1 << 16)); }
              *(v4u*)(KMH + (size_t)it * 64 + ch * 8) = (v4u){hi[0], hi[1], hi[2], hi[3]}; *(v4u*)(KML + (size_t)it * 64 + ch * 8) = (v4u){lo[0], lo[1], lo[2], lo[3]}; } } }
    if (gw == 0) { const float* pp = (const float*)(F.ws + WS_POSP) + (size_t)l * 2 * 32 * 128; float* pb = (float*)(F.ws + WS_POSB) + l * 256;
        for (int i = F.lane; i < 256; i += 64) { const int j = i & 127, wh = i >> 7; float s = 0.f; for (int kr = 0; kr < 32; ++kr) s += pp[(wh * 32 + kr) * 128 + j]; pb[i] = s; } }
}

__device__ __forceinline__ float gelu_tanh(float x) { const float u = 0.7978845608028654f * (x + 0.044715f * x * x * x); const float e = __expf(2.f * u); return x * (1.f - 1.f / (e + 1.f)); }
__device__ __forceinline__ void p_compress(Frame& F, int l) {
    const bf16* Z = (const bf16*)(F.ws + WS_Z);
    unsigned char* wb = F.ws + WS_W + (size_t)l * WS_WL;
    LAS float* red = (LAS float*)F.lds;
    const int r = F.lane & 31, h = F.lane >> 5;
    for (int it = F.vcu; it < NB * 16 * 2; it += F.G) {
        const int which = it & 1, itile = (it >> 1) & 15, b = it >> 5;
        const bf16* W1T = (const bf16*)(wb + (which ? W_1V : W_1K)); const bf16* W2T = (const bf16*)(wb + (which ? W_2V : W_2K));
        const int coff = which ? ZC_VC : ZC_KC;
        f32x16 acc[4] = {f32x16{}, f32x16{}, f32x16{}, f32x16{}};
        const bf16* brow = Z + (size_t)(b * SEQ + 16 * (32 * itile + r)) * ZLD + coff + 8 * h;
#pragma unroll 2
        for (int ks = 0; ks < 16; ++ks) { const int tt = 4 * F.wave + (ks >> 2), d0 = ks & 3;
            const bf16x8 bf = *(const bf16x8*)(brow + (size_t)tt * ZLD + d0 * 16);
#pragma unroll
            for (int hb = 0; hb < 4; ++hb) { const bf16x8 af = *(const bf16x8*)(W1T + (size_t)(hb * 32 + r) * 2048 + tt * 64 + d0 * 16 + 8 * h);
                acc[hb] = __builtin_amdgcn_mfma_f32_32x32x16_bf16(af, bf, acc[hb], 0, 0, 0); } }
#pragma unroll
        for (int hb = 0; hb < 4; ++hb)
#pragma unroll
            for (int v = 0; v < 16; ++v) red[((F.wave * 4 + hb) * 16 + v) * 64 + F.lane] = acc[hb][v];
        __syncthreads();
        if (F.wave < 2) {
            const float* pb = (const float*)(F.ws + WS_POSB) + l * 256 + which * 128;
            f32x16 o = f32x16{};
#pragma unroll
            for (int hb = 0; hb < 4; ++hb) { float x[16];
#pragma unroll
                for (int v = 0; v < 16; ++v) { float s = pb[hb * 32 + (v & 3) + 8 * (v >> 2) + 4 * h];
#pragma unroll
                    for (int w8 = 0; w8 < 8; ++w8) s += red[((w8 * 4 + hb) * 16 + v) * 64 + F.lane];
                    x[v] = gelu_tanh(s); }
#pragma unroll
                for (int s2 = 0; s2 < 2; ++s2) {
                    v4u pw; pw.x = fa::cvtpk(x[8 * s2], x[8 * s2 + 1]); pw.y = fa::cvtpk(x[8 * s2 + 2], x[8 * s2 + 3]); pw.z = fa::cvtpk(x[8 * s2 + 4], x[8 * s2 + 5]); pw.w = fa::cvtpk(x[8 * s2 + 6], x[8 * s2 + 7]);
                    const bf16* wr = W2T + (size_t)(F.wave * 32 + r) * 128 + hb * 32 + 16 * s2 + 4 * h;
                    const v2u a0 = *(const v2u*)wr, a1 = *(const v2u*)(wr + 8);
                    const v4u aw = (v4u){a0.x, a0.y, a1.x, a1.y};
                    o = __builtin_amdgcn_mfma_f32_32x32x16_bf16(__builtin_bit_cast(bf16x8, aw), __builtin_bit_cast(bf16x8, pw), o, 0, 0, 0); } }
            bf16* dst = (bf16*)(F.ws + (which ? WS_VCMP : WS_KCMP)) + (size_t)(b * 512 + 32 * itile + r) * 64 + F.wave * 32 + 4 * h;
#pragma unroll
            for (int g = 0; g < 4; ++g) { v2u w; w.x = fa::cvtpk(o[4 * g], o[4 * g + 1]); w.y = fa::cvtpk(o[4 * g + 2], o[4 * g + 3]); *(v2u*)(dst + 8 * g) = w; }
        }
        __syncthreads();
    }
}
using fa::bf16x8;
__device__ __forceinline__ unsigned char* launder_ptr(unsigned char* p) { const unsigned long long v = (unsigned long long)p; unsigned lo = __builtin_amdgcn_readfirstlane((unsigned)v), hi = __builtin_amdgcn_readfirstlane((unsigned)(v >> 32)); asm volatile("" : "+s"(lo), "+s"(hi)); return (unsigned char*)(((unsigned long long)hi << 32) | lo); }
#define UNIT_BEGIN() Frame F = F0; { int tid_ = F0.tid; asm volatile("" : "+v"(tid_)); int bx_ = __builtin_amdgcn_readfirstlane(F0.bx); asm volatile("" : "+s"(bx_)); \
    F.ws = launder_ptr(F0.ws); F.tid = tid_; F.lane = tid_ & 63; F.wave = __builtin_amdgcn_readfirstlane(tid_ >> 6); F.bx = bx_; }
__device__ __forceinline__ void u_mla(const Frame& F0, int b, int hd, int u) {
    UNIT_BEGIN();
    GAS char* ws = (GAS char*)F.ws;
    const int r = F.lane & 31, h = F.lane >> 5, q0 = 256 * u, wq0 = q0 + 32 * F.wave, tq = wq0 + r;
    bf16x8 qf[6]; { const unsigned qrow = (unsigned)WS_QM + (unsigned)(b * SEQ + tq) * 1024u;
      const float rs = *(const GAS float*)(ws + ((unsigned)WS_RSQ + (unsigned)(b * SEQ + tq) * 4u));
#pragma unroll
      for (int d0 = 0; d0 < 4; ++d0) { const fa::u32x4 raw = *(const GAS fa::u32x4*)(ws + (qrow + (unsigned)(hd * 128 + d0 * 32 + 16 * h))); fa::u32x4 o;
          o.x = fa::cvtpk(__uint_as_float(raw.x << 16) * rs, __uint_as_float(raw.x & 0xffff0000u) * rs); o.y = fa::cvtpk(__uint_as_float(raw.y << 16) * rs, __uint_as_float(raw.y & 0xffff0000u) * rs);
          o.z = fa::cvtpk(__uint_as_float(raw.z << 16) * rs, __uint_as_float(raw.z & 0xffff0000u) * rs); o.w = fa::cvtpk(__uint_as_float(raw.w << 16) * rs, __uint_as_float(raw.w & 0xffff0000u) * rs);
          qf[d0] = __builtin_bit_cast(bf16x8, o); }
#pragma unroll
      for (int d0 = 0; d0 < 2; ++d0) {
          const fa::u32x4 raw = *(const GAS fa::u32x4*)(ws + (qrow + (unsigned)(512 + hd * 64 + d0 * 32 + 16 * h)));
          const GAS float* rp = (const GAS float*)(ws + ((unsigned)WS_ROPE + (unsigned)((tq * 16 + d0 * 8 + 4 * h) * 8)));
          const fa::f32x4v r0 = *(const GAS fa::f32x4v*)rp * rs, r1 = *(const GAS fa::f32x4v*)(rp + 4) * rs;
          fa::u32x4 o;
          { const float x1 = __uint_as_float(raw.x << 16), x2 = __uint_as_float(raw.x & 0xffff0000u); o.x = fa::cvtpk(x1 * r0[0] - x2 * r0[1], x1 * r0[1] + x2 * r0[0]); }
          { const float x1 = __uint_as_float(raw.y << 16), x2 = __uint_as_float(raw.y & 0xffff0000u); o.y = fa::cvtpk(x1 * r0[2] - x2 * r0[3], x1 * r0[3] + x2 * r0[2]); }
          { const float x1 = __uint_as_float(raw.z << 16), x2 = __uint_as_float(raw.z & 0xffff0000u); o.z = fa::cvtpk(x1 * r1[0] - x2 * r1[1], x1 * r1[1] + x2 * r1[0]); }
          { const float x1 = __uint_as_float(raw.w << 16), x2 = __uint_as_float(raw.w & 0xffff0000u); o.w = fa::cvtpk(x1 * r1[2] - x2 * r1[3], x1 * r1[3] + x2 * r1[2]); }
          qf[4 + d0] = __builtin_bit_cast(bf16x8, o); } }
    SM st; fa::sm_init(st);
    LAS char* lds = (LAS char*)F.lds;
    fa::fa_loop<96, false>(st, qf, ws, (unsigned)WS_KM + (unsigned)b * (SEQ * 768u) + (unsigned)hd * 192u, 768u, (unsigned)WS_VM + (unsigned)b * (SEQ * 512u) + (unsigned)hd * 128u, 512u, SEQ - 1, 4 * u + 4,
        [](int t) { return 64 * t; },
        [=](int t, bool& act, bool& ew, float& cb, int& lo, int& hi) { const int key0 = 64 * t; act = key0 <= wq0 + 31; ew = key0 + 63 > wq0; cb = 0.f; lo = -100000; hi = tq - key0; },
        0.f, lds + FA_STAGES, F.tid, F.lane);
    f32x16 acc[2] = {f32x16{}, f32x16{}}; fa::sm_finish(st, 1.f, acc);
    fa::store_out(acc, lds + FA_OST + F.wave * 32 * fa::OSTR, ws, [=](int col) { return (unsigned)WS_O + (unsigned)(b * SEQ + wq0 + col) * 2048u + (unsigned)(256 + hd * 64) * 2u; }, F.lane);
}
__device__ __forceinline__ void u_moba(const Frame& F0, int b, int hd, int i) {
    UNIT_BEGIN();
    GAS char* ws = (GAS char*)F.ws;
    const int r = F.lane & 31, h = F.lane >> 5, q0 = 256 * i, wq0 = q0 + 32 * F.wave, tq = wq0 + r;
    bf16x8 qf[4]; fa::load_q<64>(qf, ws, (unsigned)WS_Z + (unsigned)(b * SEQ + tq) * (ZLD * 2u) + (unsigned)(ZD_Q + hd * 64) * 2u, h);
    unsigned bits = 0u;
    if (i > 0) {
        const GAS bf16* KMH = (const GAS bf16*)(ws + ((unsigned)WS_KMH + (unsigned)(((b * 4 + hd) * 32 + r) * 64 + 8 * h) * 2u)); const GAS bf16* KML = (const GAS bf16*)(ws + ((unsigned)WS_KML + (unsigned)(((b * 4 + hd) * 32 + r) * 64 + 8 * h) * 2u));
        f32x16 g = f32x16{};
#pragma unroll
        for (int d0 = 0; d0 < 4; ++d0) { const bf16x8 ah = *(const GAS bf16x8*)(KMH + d0 * 16), al = *(const GAS bf16x8*)(KML + d0 * 16);
            g = __builtin_amdgcn_mfma_f32_32x32x16_bf16(ah, qf[d0], g, 0, 0, 0); g = __builtin_amdgcn_mfma_f32_32x32x16_bf16(al, qf[d0], g, 0, 0, 0); }
        float og[16];
#pragma unroll
        for (int v = 0; v < 16; ++v) { const int j = (v & 3) + 8 * (v >> 2) + 4 * h; if (j >= i) g[v] = -INFINITY; og[v] = __shfl_xor(g[v], 32); }
#pragma unroll
        for (int v = 0; v < 16; ++v) { const int j = (v & 3) + 8 * (v >> 2) + 4 * h; int rank = 0;
#pragma unroll
            for (int w = 0; w < 16; ++w) { const int jm = (w & 3) + 8 * (w >> 2) + 4 * h, jo = (w & 3) + 8 * (w >> 2) + 4 * (1 - h);
                rank += (g[w] > g[v] || (g[w] == g[v] && jm < j)) ? 1 : 0; rank += (og[w] > g[v] || (og[w] == g[v] && jo < j)) ? 1 : 0; }
            if (rank < 3 && j < i) bits |= 1u << j; }
        bits |= __shfl_xor(bits, 32);
    }
    const float sl = slope2_of(2 + 3 * hd);
    LAS char* lds = (LAS char*)F.lds;
    LAS float* Ost = (LAS float*)(lds + MB_O);
    LAS float* MLst = (LAS float*)(lds + MB_ML);
    LAS unsigned* cnt = (LAS unsigned*)(lds + MB_CNT);
    LAS unsigned char* lst = (LAS unsigned char*)(lds + MB_LST);
    const unsigned koff = (unsigned)WS_Z + (unsigned)b * (SEQ * ZLD * 2u) + (unsigned)(ZD_K + hd * 64) * 2u, voff = (unsigned)WS_Z + (unsigned)b * (SEQ * ZLD * 2u) + (unsigned)(ZD_V + hd * 64) * 2u;
    if (F.tid < 32) cnt[F.tid] = 0u;
    {
        SM st; fa::sm_init(st);
        fa::fa_loop<64, true>(st, qf, ws, koff, ZLD * 2u, voff, ZLD * 2u, SEQ - 1, 4,
            [=](int t) { return q0 + 64 * t; },
            [=](int t, bool& act, bool& ew, float& cb, int& lo, int& hi) { const int key0 = q0 + 64 * t; act = key0 <= wq0 + 31; ew = key0 + 63 > wq0; cb = sl * (float)(64 * t + 4 * h); lo = -100000; hi = tq - key0; },
            sl, lds + FA_STAGES, F.tid, F.lane);
        const float lt = fa::xhalf_sum(st.l);
        LAS float* orow = Ost + (32 * F.wave + r) * MB_OS;
#pragma unroll
        for (int db = 0; db < 2; ++db)
#pragma unroll
            for (int g = 0; g < 4; ++g)
#pragma unroll
                for (int e = 0; e < 4; ++e) orow[32 * db + 8 * g + 4 * h + e] = st.o[db][4 * g + e];
        if (h == 0) { MLst[(32 * F.wave + r) * 2] = st.m; MLst[(32 * F.wave + r) * 2 + 1] = lt; }
    }
    if (h == 0) { unsigned bb = bits;
        while (bb) { const int j = __ffs(bb) - 1; bb &= bb - 1u; const unsigned slot = __hip_atomic_fetch_add(&cnt[j], 1u, __ATOMIC_RELAXED, __HIP_MEMORY_SCOPE_WORKGROUP); lst[j * 256 + slot] = (unsigned char)(32 * F.wave + r); } }
    LDS_WAIT(); __syncthreads();
    if (i > 0) {
        LAS unsigned* PS = (LAS unsigned*)(lds + MB_PS);
        LAS float* PM = (LAS float*)(lds + MB_PM);
        const unsigned qbase = (unsigned)WS_Z + (unsigned)(b * SEQ + q0) * (ZLD * 2u) + (unsigned)(ZD_Q + hd * 64) * 2u;
        const int tt = F.wave & 3, g4 = F.wave >> 2;
        fa::Stg<64> s0, s1, s2, s3;
#define MB_LOADBLK(J) { fa::stg_load<64>(s0, ws, koff, ZLD * 2u, voff, ZLD * 2u, 256 * (J), SEQ - 1, F.tid); fa::stg_load<64>(s1, ws, koff, ZLD * 2u, voff, ZLD * 2u, 256 * (J) + 64, SEQ - 1, F.tid); \
                        fa::stg_load<64>(s2, ws, koff, ZLD * 2u, voff, ZLD * 2u, 256 * (J) + 128, SEQ - 1, F.tid); fa::stg_load<64>(s3, ws, koff, ZLD * 2u, voff, ZLD * 2u, 256 * (J) + 192, SEQ - 1, F.tid); }
        MB_LOADBLK(0)
        const int ql = 8 * tt + (F.lane >> 3), l7 = F.lane & 7;
        for (int j = 0; j < i; ++j) {
            const int n = (int)cnt[j];
            bool myact = 32 * g4 < n, colv = (32 * g4 + r) < n; int qsel = colv ? (int)lst[j * 256 + 32 * g4 + r] : 0;
            bf16x8 qfb[4] = {qf[0], qf[1], qf[2], qf[3]};
            if (myact) fa::load_q<64>(qfb, ws, qbase + (unsigned)qsel * (ZLD * 2u), h);
            fa::stg_store<64>(s0, lds + MB_T, F.tid); fa::stg_store<64>(s1, lds + MB_T + 16384, F.tid); fa::stg_store<64>(s2, lds + MB_T + 32768, F.tid); fa::stg_store<64>(s3, lds + MB_T + 49152, F.tid);
            if (j + 1 < i) MB_LOADBLK(j + 1)
            LDS_WAIT(); __syncthreads();
            for (int rd = 0; 64 * rd < n; ++rd) {
                const int grp = 2 * rd + g4;
                if (rd > 0) { LDS_WAIT(); __syncthreads();
                    myact = 32 * grp < n; colv = (32 * grp + r) < n; qsel = colv ? (int)lst[j * 256 + 32 * grp + r] : 0;
                    if (myact) fa::load_q<64>(qfb, ws, qbase + (unsigned)qsel * (ZLD * 2u), h); }
                const bool two = 32 * (2 * rd + 1) < n;
                const bool fv = (32 * grp + ql) < n; const int qs = fv ? (int)lst[j * 256 + 32 * grp + ql] : 0;
                const float ms = MLst[qs * 2], ls = MLst[qs * 2 + 1];
                LAS float* orow = Ost + qs * MB_OS + 8 * l7;
                float acc8[8];
#pragma unroll
                for (int x = 0; x < 8; ++x) acc8[x] = orow[x];
                SM st; fa::sm_init(st); float lp = 0.f;
                if (myact) {
                    const LAS char* buf = lds + MB_T + tt * 16384;
                    fa::f32x16 p0, p1; bf16x8 pf[4];
                    fa::score_tile<64, true>(p0, p1, buf, qfb, colv ? sl * (float)(256 * j + 64 * tt - q0 + 4 * h) : fa::MASKV, sl, F.lane);
                    fa::sm_step(st, p0, p1, pf);
                    fa::pv(st.o, buf + 8192, pf, F.lane);
                    lp = fa::xhalf_sum(st.l);
                }
#pragma unroll 1
                for (int ph = 0; ph < 2; ++ph) {
                    if (ph == 1 && !two) break;
                    if (ph == 1) { LDS_WAIT(); __syncthreads(); }
                    if (g4 == ph && myact) {
                        LAS unsigned* ps = PS + (tt * 32 + r) * 33 + 2 * h;
#pragma unroll
                        for (int db = 0; db < 2; ++db)
#pragma unroll
                            for (int g = 0; g < 4; ++g) { ps[16 * db + 4 * g] = fa::cvtpk(st.o[db][4 * g], st.o[db][4 * g + 1]); ps[16 * db + 4 * g + 1] = fa::cvtpk(st.o[db][4 * g + 2], st.o[db][4 * g + 3]); }
                        if (h == 0) { PM[(tt * 32 + r) * 2] = st.m; PM[(tt * 32 + r) * 2 + 1] = lp; }
                    }
                    LDS_WAIT(); __syncthreads();
                    if (g4 == ph && fv) {
                        const float m0 = PM[ql * 2], l0 = PM[ql * 2 + 1], m1 = PM[(32 + ql) * 2], l1 = PM[(32 + ql) * 2 + 1], m2 = PM[(64 + ql) * 2], l2 = PM[(64 + ql) * 2 + 1], m3 = PM[(96 + ql) * 2], l3 = PM[(96 + ql) * 2 + 1];
                        const float mn = fmaxf(fmaxf(fmaxf(m0, m1), fmaxf(m2, m3)), ms);
                        const float ea = fa::ex2(ms - mn), e0 = fa::ex2(m0 - mn), e1 = fa::ex2(m1 - mn), e2 = fa::ex2(m2 - mn), e3 = fa::ex2(m3 - mn);
                        const LAS unsigned* pr = PS + ql * 33 + 4 * l7;
#pragma unroll
                        for (int x = 0; x < 4; ++x) { const unsigned w0 = pr[x], w1 = pr[32 * 33 + x], w2 = pr[64 * 33 + x], w3 = pr[96 * 33 + x];
                            orow[2 * x] = acc8[2 * x] * ea + ((__uint_as_float(w0 << 16) * e0 + __uint_as_float(w1 << 16) * e1) + (__uint_as_float(w2 << 16) * e2 + __uint_as_float(w3 << 16) * e3));
                            orow[2 * x + 1] = acc8[2 * x + 1] * ea + ((__uint_as_float(w0 & 0xffff0000u) * e0 + __uint_as_float(w1 & 0xffff0000u) * e1) + (__uint_as_float(w2 & 0xffff0000u) * e2 + __uint_as_float(w3 & 0xffff0000u) * e3)); }
                        if (l7 == 0) { MLst[qs * 2] = mn; MLst[qs * 2 + 1] = ls * ea + ((l0 * e0 + l1 * e1) + (l2 * e2 + l3 * e3)); }
                    }
                }
            }
        }
#undef MB_LOADBLK
        LDS_WAIT(); __syncthreads();
#if FA_PROBE == 9
        if (F.lane == 0 && F.wave == FA_KO) { unsigned long long* pp = (unsigned long long*)((GAS char*)ws + 32768);
            atomicAdd(pp + 0, pq0); atomicAdd(pp + 1, pq1); atomicAdd(pp + 2, pq2); atomicAdd(pp + 3, pqn); atomicAdd(pp + 4, pq3); }
#endif
    }
    { const int q = 32 * F.wave + (F.lane >> 1), hf = F.lane & 1; const float inv = 1.f / fmaxf(MLst[q * 2 + 1], fa::TINYF);
      const LAS float* orow = Ost + q * MB_OS + 32 * hf;
      GAS char* dst = ws + ((unsigned)WS_O + (unsigned)(b * SEQ + q0 + q) * 2048u + (unsigned)(768 + hd * 64 + 32 * hf) * 2u);
#pragma unroll
      for (int c = 0; c < 4; ++c) { float x[8];
#pragma unroll
          for (int e = 0; e < 8; ++e) x[e] = orow[8 * c + e] * inv;
          fa::u32x4 w; w.x = fa::cvtpk(x[0], x[1]); w.y = fa::cvtpk(x[2], x[3]); w.z = fa::cvtpk(x[4], x[5]); w.w = fa::cvtpk(x[6], x[7]);
          *(GAS fa::u32x4*)(dst + 16 * c) = w; } }
    LDS_WAIT(); __syncthreads();
}
__device__ __forceinline__ void u_swa(const Frame& F0, int b, int kvh, int u, const float* sinks) {
    UNIT_BEGIN();
    GAS char* ws = (GAS char*)F.ws;
    const int r = F.lane & 31, h = F.lane >> 5, q0 = 128 * u, wq0 = q0 + 16 * F.wave, tq = wq0 + (r >> 1), hd = kvh * 2 + (r & 1);
    bf16x8 qf[4]; fa::load_q<64>(qf, ws, (unsigned)WS_Z + (unsigned)(b * SEQ + tq) * (ZLD * 2u) + (unsigned)(ZA_Q + hd * 64) * 2u, h);
    const float sl = slope2_of(3 * hd);
    const int t0 = (2 * u - 2) > 0 ? (2 * u - 2) : 0, nt = 2 * u + 2 - t0;
    SM st; fa::sm_init(st);
    LAS char* lds = (LAS char*)F.lds;
    fa::fa_loop<64, true>(st, qf, ws, (unsigned)WS_Z + (unsigned)b * (SEQ * ZLD * 2u) + (unsigned)(ZA_K + kvh * 64) * 2u, ZLD * 2u, (unsigned)WS_Z + (unsigned)b * (SEQ * ZLD * 2u) + (unsigned)(ZA_V + kvh * 64) * 2u, ZLD * 2u, SEQ - 1, nt,
        [=](int t) { return 64 * (t0 + t); },
        [=](int t, bool& act, bool& ew, float& cb, int& lo, int& hi) { const int key0 = 64 * (t0 + t); act = (key0 <= wq0 + 15) && (key0 + 63 >= wq0 - 127); ew = true;
            cb = sl * (float)(key0 - q0 + 4 * h); lo = tq - 127 - key0; hi = tq - key0; },
        sl, lds + FA_STAGES, F.tid, F.lane);
    const float sk = sinks[hd] * LOG2E + sl * (float)(tq - q0), mf = fmaxf(st.m, sk), a = fa::ex2(st.m - mf);
    const float ltot = fa::xhalf_sum(st.l) * a + fa::ex2(sk - mf), inv = a / fmaxf(ltot, fa::TINYF);
    f32x16 acc[2]; acc[0] = st.o[0] * inv; acc[1] = st.o[1] * inv;
    fa::store_out(acc, lds + FA_OST + F.wave * 32 * fa::OSTR, ws, [=](int col) { return (unsigned)WS_O + (unsigned)(b * SEQ + wq0 + (col >> 1)) * 2048u + (unsigned)((kvh * 2 + (col & 1)) * 64) * 2u; }, F.lane);
}
__device__ __forceinline__ void u_nsa(const Frame& F0, int b, int qi) {
    UNIT_BEGIN();
    GAS char* ws = (GAS char*)F.ws;
    const unsigned KC = (unsigned)WS_KCMP + (unsigned)b * (512u * 128u), VC = (unsigned)WS_VCMP + (unsigned)b * (512u * 128u), ZB = (unsigned)WS_Z + (unsigned)b * (SEQ * ZLD * 2u);
    const int r = F.lane & 31, h = F.lane >> 5, q0 = 64 * qi, wq0 = q0 + 8 * F.wave, qloc = 8 * F.wave + (r >> 2), tq = q0 + qloc, hd = r & 3;
    const unsigned zrow_off = ZB + (unsigned)tq * (ZLD * 2u); const GAS bf16* zrow = (const GAS bf16*)(ws + zrow_off);
    bf16x8 qf[4]; fa::load_q<64>(qf, ws, zrow_off + (unsigned)(ZC_Q + hd * 64) * 2u, h);
    const float sl = slope2_of(1 + 3 * hd);
    const float g0 = 1.f / (1.f + __expf(-bf2f(zrow[ZC_GL + hd]))), g1 = 1.f / (1.f + __expf(-bf2f(zrow[ZC_GL + 4 + hd]))), g2 = 1.f / (1.f + __expf(-bf2f(zrow[ZC_GL + 8 + hd])));
    LAS char* lds = (LAS char*)F.lds;
    LAS float* impA = (LAS float*)(lds + FA_IMP) + F.wave * 1024;
    LAS float* impB = (LAS float*)(lds + FA_OST) + F.wave * 1024;
    LAS unsigned* selm = (LAS unsigned*)(lds + FA_SELM);
    LAS unsigned* um = (LAS unsigned*)(lds + FA_UM);
    LAS float* vals = (LAS float*)(lds + FA_VALS) + F.wave * 128;
    if (F.tid < 4) um[F.tid] = 0u;
    const unsigned parko = (unsigned)WS_PARK + (unsigned)((F.bx * NWAVES + F.wave) * 2 * 32 * 64 + F.lane) * 4u;
#define PARK(i) (*(GAS float*)(ws + (parkl + (unsigned)((i) * 256))))
    const int ntc = ((4 * qi + 3) >> 6) + 1;
    const int cvis = (tq - 31) >> 4;
    const int cvis_min = (q0 - 31) >> 4;
    const float slc = 16.f * sl;
    SM st; fa::sm_init(st);
    fa::fa_loop<64, true>(st, qf, ws, KC, 128u, VC, 128u, 510, ntc,
        [](int t) { return 64 * t; },
        [=](int t, bool& act, bool& ew, float& cb, int& lo, int& hi) { const int c0 = 64 * t; act = true; ew = c0 + 63 > cvis_min; cb = slc * (float)(c0 - 4 * qi + 4 * h); lo = -100000; hi = cvis - c0; },
        slc, lds + FA_STAGES, F.tid, F.lane);
    { f32x16 t2[2] = {f32x16{}, f32x16{}}; fa::sm_finish(st, g0, t2); unsigned parkl = parko; asm volatile("" : "+v"(parkl));
#pragma unroll
      for (int v = 0; v < 16; ++v) { PARK(v) = t2[0][v]; PARK(16 + v) = t2[1][v]; } }
    {
        const float mfin = st.m, invl = 1.f / fmaxf(fa::xhalf_sum(st.l), fa::TINYF);
        constexpr int STG = fa::stage_bytes<64>();
        fa::Stg<64> sg;
        fa::stg_load<64>(sg, ws, KC, 128u, VC, 128u, 0, 510, F.tid); fa::stg_store<64>(sg, lds + FA_STAGES, F.tid); __syncthreads();
        for (int t = 0; t < ntc; ++t) {
            const LAS char* buf = lds + FA_STAGES + (t & 1) * STG;
            if (t + 1 < ntc) fa::stg_load<64>(sg, ws, KC, 128u, VC, 128u, 64 * (t + 1), 510, F.tid);
            const int c0 = 64 * t;
            f32x16 p0, p1; fa::score_tile<64, true>(p0, p1, buf, qf, slc * (float)(c0 - 4 * qi + 4 * h), slc, F.lane);
            if (c0 + 63 > cvis_min) fa::mask_ew(p0, p1, -100000, cvis - c0, h);
#pragma unroll
            for (int kh = 0; kh < 2; ++kh)
#pragma unroll
                for (int g = 0; g < 4; ++g) {
                    float e0, e1, e2, e3;
                    if (kh == 0) { e0 = fa::ex2(p0[4 * g] - mfin); e1 = fa::ex2(p0[4 * g + 1] - mfin); e2 = fa::ex2(p0[4 * g + 2] - mfin); e3 = fa::ex2(p0[4 * g + 3] - mfin); }
                    else { e0 = fa::ex2(p1[4 * g] - mfin); e1 = fa::ex2(p1[4 * g + 1] - mfin); e2 = fa::ex2(p1[4 * g + 2] - mfin); e3 = fa::ex2(p1[4 * g + 3] - mfin); }
                    e0 *= invl; e1 *= invl; e2 *= invl; e3 *= invl;
                    float s4 = ((e0 + e1) + e2) + e3;
                    s4 += __shfl_xor(s4, 1); s4 += __shfl_xor(s4, 2); e3 += __shfl_xor(e3, 1); e3 += __shfl_xor(e3, 2);
                    const int j = 16 * t + 8 * kh + 2 * g + h;
                    if (hd == 0) { impA[(r >> 2) * 128 + j] = s4; impB[(r >> 2) * 128 + j] = e3; }
                }
            if (t + 1 < ntc) fa::stg_store<64>(sg, lds + FA_STAGES + ((t + 1) & 1) * STG, F.tid);
            __syncthreads();
        }
    }
    {
        const int cur = qi;
        for (int qq = 0; qq < 8; ++qq) {
            unsigned long long m0, m1;
            if (cur < 16) { m0 = (cur >= 63) ? ~0ull : ((1ull << (cur + 1)) - 1ull); m1 = 0ull; }
            else {
                const int ja = F.lane, jb2 = F.lane + 64;
                const bool fca = (ja == 0 || ja == cur || ja == cur - 1), fcb = (jb2 == cur || jb2 == cur - 1);
                const float va = impA[qq * 128 + ja] + (ja > 0 ? impB[qq * 128 + ja - 1] : 0.f), vb = impA[qq * 128 + jb2] + impB[qq * 128 + jb2 - 1];
                const unsigned ka = (ja <= cur && !fca) ? (__float_as_uint(va) + 1u) : 0u, kb = (jb2 <= cur && !fcb) ? (__float_as_uint(vb) + 1u) : 0u;
                unsigned T = 0u;
                for (int bit = 31; bit >= 0; --bit) { const unsigned cand = T | (1u << bit); const int c = __popcll(__ballot(ka >= cand)) + __popcll(__ballot(kb >= cand)); if (c >= 13) T = cand; }
                if (T == 0u) T = 1u;
                const unsigned long long ga = __ballot(ka > T), gb = __ballot(kb > T), ea = __ballot(ka == T), eb = __ballot(kb == T);
                const int R = 13 - (__popcll(ga) + __popcll(gb)), na = __popcll(ea);
                const int pa = (int)__builtin_amdgcn_mbcnt_hi((unsigned)(ea >> 32), __builtin_amdgcn_mbcnt_lo((unsigned)ea, 0u)), pb = (int)__builtin_amdgcn_mbcnt_hi((unsigned)(eb >> 32), __builtin_amdgcn_mbcnt_lo((unsigned)eb, 0u));
                m0 = ga | __ballot(ka == T && pa < R) | 1ull; m1 = gb | __ballot(kb == T && (na + pb) < R);
                if (cur < 64) m0 |= 1ull << cur; else m1 |= 1ull << (cur - 64);
                if (cur - 1 < 64) m0 |= 1ull << (cur - 1); else m1 |= 1ull << (cur - 65);
            }
            if (F.lane == 0) { LAS unsigned* sp = selm + (8 * F.wave + qq) * 4; sp[0] = (unsigned)m0; sp[1] = (unsigned)(m0 >> 32); sp[2] = (unsigned)m1; sp[3] = (unsigned)(m1 >> 32);
                __hip_atomic_fetch_or(&um[0], (unsigned)m0, __ATOMIC_RELAXED, __HIP_MEMORY_SCOPE_WORKGROUP); __hip_atomic_fetch_or(&um[1], (unsigned)(m0 >> 32), __ATOMIC_RELAXED, __HIP_MEMORY_SCOPE_WORKGROUP); __hip_atomic_fetch_or(&um[2], (unsigned)m1, __ATOMIC_RELAXED, __HIP_MEMORY_SCOPE_WORKGROUP); __hip_atomic_fetch_or(&um[3], (unsigned)(m1 >> 32), __ATOMIC_RELAXED, __HIP_MEMORY_SCOPE_WORKGROUP); }
        }
        LDS_WAIT(); __syncthreads();
    }
    {
        const unsigned uw0 = um[0], uw1 = um[1], uw2 = um[2], uw3 = um[3];
        const LAS unsigned* selq = selm + qloc * 4;
        const int nsel = __builtin_amdgcn_readfirstlane(__popc(uw0) + __popc(uw1) + __popc(uw2) + __popc(uw3));
        LAS unsigned char* slist = (LAS unsigned char*)(lds + FA_VALS);
        if (F.tid < 128) { const int j = F.tid; const unsigned w = (j < 32) ? uw0 : (j < 64) ? uw1 : (j < 96) ? uw2 : uw3;
            if ((w >> (j & 31)) & 1u) { int pos = __popc(w & ((1u << (j & 31)) - 1u)); if (j >= 32) pos += __popc(uw0); if (j >= 64) pos += __popc(uw1); if (j >= 96) pos += __popc(uw2); slist[pos] = (unsigned char)j; } }
        LDS_WAIT(); __syncthreads();
        fa::sm_init(st);
        fa::fa_loop<64, true>(st, qf, ws, ZB + ZC_KS * 2u, ZLD * 2u, ZB + ZC_VS * 2u, ZLD * 2u, SEQ - 1, nsel,
            [=](int t) { return 64 * (int)slist[t]; },
            [=](int t, bool& act, bool& ew, float& cb, int& lo, int& hi) { const int j = (int)slist[t], key0 = 64 * j; const unsigned mw = selq[j >> 5];
                const bool on = (mw >> (j & 31)) & 1u; act = __any(on) != 0; ew = (j == qi); cb = on ? sl * (float)(key0 - q0 + 4 * h) : fa::MASKV; lo = -100000; hi = tq - key0; },
            sl, lds + FA_STAGES, F.tid, F.lane);
        { f32x16 t2[2] = {f32x16{}, f32x16{}}; fa::sm_finish(st, g1, t2); unsigned parkl = parko; asm volatile("" : "+v"(parkl));
#pragma unroll
          for (int v = 0; v < 16; ++v) { PARK(32 + v) = t2[0][v]; PARK(48 + v) = t2[1][v]; } }
    }
    {
        const int t0 = (qi - 8) > 0 ? (qi - 8) : 0, nt = qi + 1 - t0;
        fa::sm_init(st);
        fa::fa_loop<64, true>(st, qf, ws, ZB + ZC_KW * 2u, ZLD * 2u, ZB + ZC_VW * 2u, ZLD * 2u, SEQ - 1, nt,
            [=](int t) { return 64 * (t0 + t); },
            [=](int t, bool& act, bool& ew, float& cb, int& lo, int& hi) { const int j = t0 + t, key0 = 64 * j; act = true; ew = (j == qi) || (j == qi - 8);
                cb = sl * (float)(key0 - q0 + 4 * h); lo = tq - 511 - key0; hi = tq - key0; },
            sl, lds + FA_STAGES, F.tid, F.lane);
    }
    f32x16 acc[2] = {f32x16{}, f32x16{}}; fa::sm_finish(st, g2, acc); unsigned parkl = parko; asm volatile("" : "+v"(parkl));
#pragma unroll
    for (int v = 0; v < 16; ++v) { acc[0][v] += PARK(v) + PARK(32 + v); acc[1][v] += PARK(16 + v) + PARK(48 + v); }
#undef PARK
    fa::store_out(acc, lds + FA_OST + F.wave * 32 * fa::OSTR, ws, [=](int col) { return (unsigned)WS_O + (unsigned)(b * SEQ + wq0 + (col >> 2)) * 2048u + (unsigned)(512 + (col & 3) * 64) * 2u; }, F.lane);
}

__device__ __forceinline__ void p_attn(Frame& F, const float* sinks, int mskip) {
    const int id = F.vcu;
    if (F.G != 256) return;
    { const int bh = id >> 4, s = id & 15;
#pragma unroll 1
      for (int k = 0; k < (((mskip >> 9) & 1) ? 4 : 2); ++k) u_mla(F, bh >> 2, bh & 3, (k & 1) ? s : 31 - s); }
    { const int bh = id >> 4, s = id & 15;
#pragma unroll 1
      for (int k = 0; k < (((mskip >> 11) & 1) ? 4 : 2); ++k) u_moba(F, bh >> 2, bh & 3, (k & 1) ? s : 31 - s); }
    if (!(mskip & 4)) { const int b = id >> 6, s = id & 63;
#pragma unroll 1
      for (int k = 0; k < (((mskip >> 10) & 1) ? 4 : 2); ++k) u_nsa(F, b, (k & 1) ? s : 127 - s); }
    {
#pragma unroll 1
      for (int k = 0; k < (((mskip >> 8) & 1) ? 4 : 2); ++k) { const int u0 = 2 * id + (k & 1); u_swa(F, u0 >> 7, (u0 >> 6) & 1, u0 & 63, sinks); } }
}
constexpr int PH_PRO = 0, PH_L0 = 1, PH_PER_L = 9, PH_FIN = 19, PH_END = 20;
constexpr int PO_NORM1 = 0, PO_ZG = 1, PO_PREP = 2, PO_UP = 3, PO_ATTN = 4, PO_OG = 5, PO_NORM2 = 6, PO_UPG = 7, PO_DNG = 8;
#ifndef MK_PHASE_MASK
#define MK_PHASE_MASK 0xFFFFFu
#endif

__global__ void __launch_bounds__(NTHR, 2) mega(Args args) {
    extern __shared__ __attribute__((aligned(16))) unsigned char lds_raw[];
    Frame F;
    F.lds = (LAS unsigned char*)lds_raw;
    int wave_s = __builtin_amdgcn_readfirstlane((int)threadIdx.x >> 6); asm volatile("" : "+s"(wave_s));
    F.tid = threadIdx.x; F.lane = F.tid & 63; F.wave = wave_s;
    F.G = gridDim.x; { const int bx = blockIdx.x; F.vcu = (F.G % 8 == 0) ? (bx % 8) * (F.G / 8) + bx / 8 : bx; }
    volatile LAS unsigned* misc = (volatile LAS unsigned*)(F.lds + LDS_MISC);
    if (F.tid < 64) misc[F.tid] = 0u;
    __syncthreads();
    (void)xcd_barrier_post((unsigned*)(args.ws + WS_CTL), misc + 8);
    float* fo; KArgsP ap;
#define KARGS() ({ KArgsP q_ = (KArgsP)__builtin_amdgcn_kernarg_segment_ptr(); asm volatile("" : "+s"(q_)); q_; })
#define IN(k) ({ KArgsP q2_ = KARGS(); q2_->ph_lo <= (k) && (k) < q2_->ph_hi; })
#define PHASE_BEGIN() do { asm volatile("; PHASE_MARK %0" :: "i"(__LINE__)); ap = KARGS(); F.G = gridDim.x; \
        { int w_ = wave_s; asm volatile("" : "+s"(w_)); int t_ = (w_ << 6) | (int)__builtin_amdgcn_mbcnt_hi(~0u, __builtin_amdgcn_mbcnt_lo(~0u, 0u)); asm volatile("" : "+v"(t_)); F.tid = t_; F.lane = t_ & 63; F.wave = w_; } F.ws = ap->ws; int bx_ = (int)blockIdx.x; asm volatile("" : "+s"(bx_)); F.bx = bx_; F.vcu = (F.G % 8 == 0) ? (bx_ % 8) * (F.G / 8) + bx_ / 8 : bx_; fo = ap->out; } while (0)
#define INP(i) (ap->in[i])
#define SEAM(k) do { if (IN(k) && IN((k) + 1)) { XcdBarrier b_; b_.bar = (unsigned*)(KARGS()->ws + WS_CTL); b_.x = xb_xcc_id(); b_.st = (volatile LAS unsigned*)(F.lds + LDS_MISC) + 8; xcd_barrier(b_); } } while (0)

    if (IN(PH_PRO)) { PHASE_BEGIN(); p_prologue(F, ap); }
#ifdef MK_PRO_TWICE
    if (IN(PH_PRO)) { PHASE_BEGIN(); p_prologue(F, ap); }
#endif
    SEAM(PH_PRO);

    { constexpr int l = 0;
        const int pb = PH_L0 + PH_PER_L * l;
#define WB (F.ws + WS_W + (size_t)l * WS_WL)
#define MOD ((const float*)(F.ws + WS_MOD) + (size_t)l * NB * 6 * D)
#define XB ((bf16*)(F.ws + WS_XB))
#define XIN ((l == 0) ? (const void*)INP(0) : (const void*)XB)
#define H ((bf16*)(F.ws + WS_H))
#define Z ((bf16*)(F.ws + WS_Z))
#define OB ((bf16*)(F.ws + WS_O))
#define U ((bf16*)(F.ws + WS_U))

        if (IN(pb + PO_NORM1) && !((KARGS()->skip >> PO_NORM1) & 1)) { PHASE_BEGIN(); p_norm<0, (l != 0)>(F, XIN, INP(2) + l * D, MOD, MOD + D, H, nullptr); }
        SEAM(pb + PO_NORM1);

        if (IN(pb + PO_ZG) && !((KARGS()->skip >> PO_ZG) & 1)) { PHASE_BEGIN();
            pg8::Gemm g{H, (const bf16*)(WB + W_IN), M, ZLD, D, D}; pg8::StaticOrder S; S.init(M, ZLD, F.G, F.bx);
            pg8::EpiBf16<0> E{Z, ZLD, nullptr, 0, 0, 1.f};
            pg8::gemm_phase<pg8::EpiBf16<0>, pg8::StaticOrder, true, true>(F.lds, g, S, E, F.tid);
        }
        SEAM(pb + PO_ZG);

        if (IN(pb + PO_PREP) && !((KARGS()->skip >> PO_PREP) & 1)) { PHASE_BEGIN(); p_prep(F, l); }
        SEAM(pb + PO_PREP);

        if (IN(pb + PO_UP) && !((KARGS()->skip >> PO_UP) & 1)) { PHASE_BEGIN();
            { pg8::Gemm g{Z + ZB_CQ, (const bf16*)(WB + W_UQ), M, 512, 256, ZLD}; pg8::StaticOrder S; S.init(M, 512, F.G, F.bx);
              pg8::EpiBf16<0> E{(bf16*)(F.ws + WS_QM), 512, nullptr, 0, 0, 1.f};
              pg8::gemm_phase<pg8::EpiBf16<0>, pg8::StaticOrder, true, true>(F.lds, g, S, E, F.tid); }
            PHASE_BEGIN();
            { pg8::Gemm g{Z + ZB_CKV, (const bf16*)(WB + W_UKV), M, 512, 256, ZLD}; pg8::StaticOrder S; S.init(M, 512, F.G, F.bx);
              pg8::EpiMlaKV E{(bf16*)(F.ws + WS_KM), (bf16*)(F.ws + WS_VM), (const float*)(F.ws + WS_RSKV)};
              pg8::gemm_phase<pg8::EpiMlaKV, pg8::StaticOrder, true, false>(F.lds, g, S, E, F.tid); }
            PHASE_BEGIN();
            p_compress(F, l);
        }
        SEAM(pb + PO_UP);

        if (IN(pb + PO_ATTN) && !((KARGS()->skip >> PO_ATTN) & 1)) { PHASE_BEGIN(); p_attn(F, INP(8) + l * 4, (ap->skip >> 16) | ((ap->rep >> 20) << 8)); }
        SEAM(pb + PO_ATTN);

        if (IN(pb + PO_OG) && !((KARGS()->skip >> PO_OG) & 1)) { PHASE_BEGIN();
            pg8::Gemm g{OB, (const bf16*)(WB + W_OUT), M, D, D, D}; pg8::StaticOrder S; S.init(M, D, F.G, F.bx);
            pg8::EpiResid<(l != 0)> E{XIN, XB, MOD + 2 * D};
            pg8::gemm_phase<pg8::EpiResid<(l != 0)>, pg8::StaticOrder, true, true>(F.lds, g, S, E, F.tid);
        }
        SEAM(pb + PO_OG);

        if (IN(pb + PO_NORM2) && !((KARGS()->skip >> PO_NORM2) & 1)) { PHASE_BEGIN(); p_norm<0, true>(F, XB, INP(3) + l * D, MOD + 3 * D, MOD + 4 * D, H, nullptr); }
        SEAM(pb + PO_NORM2);

        if (IN(pb + PO_UPG) && !((KARGS()->skip >> PO_UPG) & 1)) { PHASE_BEGIN();
            pg8::Gemm g{H, (const bf16*)(WB + W_UP), M, DFF, D, D}; pg8::StaticOrder S; S.init(M, DFF, F.G, F.bx);
            pg8::EpiRelu2 E{U, DFF};
            pg8::gemm_phase<pg8::EpiRelu2, pg8::StaticOrder, true, true>(F.lds, g, S, E, F.tid);
        }
        SEAM(pb + PO_UPG);

        if (IN(pb + PO_DNG) && !((KARGS()->skip >> PO_DNG) & 1)) { PHASE_BEGIN();
            pg8::Gemm g{U, (const bf16*)(WB + W_DN), M, D, DFF, DFF}; pg8::StaticOrder S; S.init(M, D, F.G, F.bx);
            pg8::EpiResid<true> E{XB, XB, MOD + 5 * D};
            pg8::gemm_phase<pg8::EpiResid<true>, pg8::StaticOrder, true, true>(F.lds, g, S, E, F.tid);
        }
        SEAM(pb + PO_DNG);
    }
    { constexpr int l = 1;
        const int pb = PH_L0 + PH_PER_L * l;
#define WB (F.ws + WS_W + (size_t)l * WS_WL)
#define MOD ((const float*)(F.ws + WS_MOD) + (size_t)l * NB * 6 * D)
#define XB ((bf16*)(F.ws + WS_XB))
#define XIN ((l == 0) ? (const void*)INP(0) : (const void*)XB)
#define H ((bf16*)(F.ws + WS_H))
#define Z ((bf16*)(F.ws + WS_Z))
#define OB ((bf16*)(F.ws + WS_O))
#define U ((bf16*)(F.ws + WS_U))

        if (IN(pb + PO_NORM1) && !((KARGS()->skip >> PO_NORM1) & 1)) { PHASE_BEGIN(); p_norm<0, (l != 0)>(F, XIN, INP(2) + l * D, MOD, MOD + D, H, nullptr); }
        SEAM(pb + PO_NORM1);

        if (IN(pb + PO_ZG) && !((KARGS()->skip >> PO_ZG) & 1)) { PHASE_BEGIN();
            pg8::Gemm g{H, (const bf16*)(WB + W_IN), M, ZLD, D, D}; pg8::StaticOrder S; S.init(M, ZLD, F.G, F.bx);
            pg8::EpiBf16<0> E{Z, ZLD, nullptr, 0, 0, 1.f};
            pg8::gemm_phase<pg8::EpiBf16<0>, pg8::StaticOrder, true, true>(F.lds, g, S, E, F.tid);
        }
        SEAM(pb + PO_ZG);

        if (IN(pb + PO_PREP) && !((KARGS()->skip >> PO_PREP) & 1)) { PHASE_BEGIN(); p_prep(F, l); }
        SEAM(pb + PO_PREP);

        if (IN(pb + PO_UP) && !((KARGS()->skip >> PO_UP) & 1)) { PHASE_BEGIN();
            { pg8::Gemm g{Z + ZB_CQ, (const bf16*)(WB + W_UQ), M, 512, 256, ZLD}; pg8::StaticOrder S; S.init(M, 512, F.G, F.bx);
              pg8::EpiBf16<0> E{(bf16*)(F.ws + WS_QM), 512, nullptr, 0, 0, 1.f};
              pg8::gemm_phase<pg8::EpiBf16<0>, pg8::StaticOrder, true, true>(F.lds, g, S, E, F.tid); }
            PHASE_BEGIN();
            { pg8::Gemm g{Z + ZB_CKV, (const bf16*)(WB + W_UKV), M, 512, 256, ZLD}; pg8::StaticOrder S; S.init(M, 512, F.G, F.bx);
              pg8::EpiMlaKV E{(bf16*)(F.ws + WS_KM), (bf16*)(F.ws + WS_VM), (const float*)(F.ws + WS_RSKV)};
              pg8::gemm_phase<pg8::EpiMlaKV, pg8::StaticOrder, true, false>(F.lds, g, S, E, F.tid); }
            PHASE_BEGIN();
            p_compress(F, l);
        }
        SEAM(pb + PO_UP);

        if (IN(pb + PO_ATTN) && !((KARGS()->skip >> PO_ATTN) & 1)) { PHASE_BEGIN(); p_attn(F, INP(8) + l * 4, (ap->skip >> 16) | ((ap->rep >> 20) << 8)); }
        SEAM(pb + PO_ATTN);

        if (IN(pb + PO_OG) && !((KARGS()->skip >> PO_OG) & 1)) { PHASE_BEGIN();
            pg8::Gemm g{OB, (const bf16*)(WB + W_OUT), M, D, D, D}; pg8::StaticOrder S; S.init(M, D, F.G, F.bx);
            pg8::EpiResid<(l != 0)> E{XIN, XB, MOD + 2 * D};
            pg8::gemm_phase<pg8::EpiResid<(l != 0)>, pg8::StaticOrder, true, true>(F.lds, g, S, E, F.tid);
        }
        SEAM(pb + PO_OG);

        if (IN(pb + PO_NORM2) && !((KARGS()->skip >> PO_NORM2) & 1)) { PHASE_BEGIN(); p_norm<0, true>(F, XB, INP(3) + l * D, MOD + 3 * D, MOD + 4 * D, H, nullptr); }
        SEAM(pb + PO_NORM2);

        if (IN(pb + PO_UPG) && !((KARGS()->skip >> PO_UPG) & 1)) { PHASE_BEGIN();
            pg8::Gemm g{H, (const bf16*)(WB + W_UP), M, DFF, D, D}; pg8::StaticOrder S; S.init(M, DFF, F.G, F.bx);
            pg8::EpiRelu2 E{U, DFF};
            pg8::gemm_phase<pg8::EpiRelu2, pg8::StaticOrder, true, true>(F.lds, g, S, E, F.tid);
        }
        SEAM(pb + PO_UPG);

        if (IN(pb + PO_DNG) && !((KARGS()->skip >> PO_DNG) & 1)) { PHASE_BEGIN();
            pg8::Gemm g{U, (const bf16*)(WB + W_DN), M, D, DFF, DFF}; pg8::StaticOrder S; S.init(M, D, F.G, F.bx);
            pg8::EpiResid<true> E{XB, XB, MOD + 5 * D};
            pg8::gemm_phase<pg8::EpiResid<true>, pg8::StaticOrder, true, true>(F.lds, g, S, E, F.tid);
        }
        SEAM(pb + PO_DNG);
    }
    if (IN(PH_FIN)) { PHASE_BEGIN(); p_norm<1, true>(F, (const void*)(F.ws + WS_XB), INP(21), nullptr, nullptr, nullptr, fo); }
#undef IN
#undef SEAM
}
}
extern "C" void kernel_launch(void* const* d_in, const int* in_sizes, int n_in, void* d_out, int out_size, void* d_ws, size_t ws_size, hipStream_t stream) {
    using namespace mk;
    static int grid = 0;
    if (grid == 0) {
        int dev = 0, cus = 0;
        if (hipGetDevice(&dev) != hipSuccess || hipDeviceGetAttribute(&cus, hipDeviceAttributeMultiprocessorCount, dev) != hipSuccess) { grid = -1; return; }
        if (hipFuncSetAttribute((const void*)mega, hipFuncAttributeMaxDynamicSharedMemorySize, LDS_BYTES) != hipSuccess) { grid = -1; return; }
        (void)hipGetLastError();
        grid = cus;
    }
    if (grid < 0) return;
    (void)in_sizes; (void)n_in; (void)out_size; (void)ws_size;
    Args a{};
    for (int i = 0; i < 22; ++i) a.in[i] = (const float*)d_in[i];
    a.out = (float*)d_out; a.ws = (unsigned char*)d_ws; a.skip = 0; a.rep = MK_REP;
    auto launch = [&](int lo, int hi) {
        (void)hipMemsetAsync((char*)d_ws + WS_CTL, 0, CTL_ZERO_BYTES, stream);
        a.ph_lo = lo; a.ph_hi = hi;
        hipLaunchKernelGGL(mega, dim3(grid), dim3(NTHR), LDS_BYTES, stream, a);
    };
    launch(0, PH_END);
}
```

```cpp
#include <hip/hip_runtime.h>
#include <cstdio>
#include <cstdint>
#include <math.h>
#define MK_PQ 500.0
#define FA_EXP 2
#define FA_PROBE 0
#define MK_PROBE_IDX 0
#define FA_KO 0
#define MK_MODE 0
#define MK_NAIVE_MASK 0
#define MK_SKIP 0
#define MK_SPLIT 0
#define MK_DBG_PHASE 0
#define MK_DBG_TEST 0
#define MK_REP 0
namespace pg8 {
#define PG8_LAS __attribute__((address_space(3)))
typedef unsigned short bf16_t;
typedef short bf16x8 __attribute__((ext_vector_type(8)));
typedef float f32x4 __attribute__((ext_vector_type(4)));
typedef unsigned u32x4 __attribute__((ext_vector_type(4)));
constexpr int BM = 256, BK = 64, HALF = 128, HTB = HALF * BK * 2  , STAGE_BYTES = 8 * HTB, NXCD = 8, WGM = 8;

__host__ __device__ __forceinline__ int lds_byte(int r, int c) { const int st = (r >> 4) * 2 + (c >> 5), rr = r & 15, cc = c & 31, ob = rr * 64 + cc * 2; return st * 1024 + (ob ^ (((ob >> 9) & 1) << 5)); }
__host__ __device__ __forceinline__ void stage_rc(int b, int& R, int& C) { const int st = b / 1024, sb = b % 1024, swz = sb ^ (((sb >> 9) & 1) << 5); R = (st >> 1) * 16 + swz / 64; C = (st & 1) * 32 + (swz % 64) / 2; }
__host__ __device__ __forceinline__ int perm32(int rho) { const int n = rho >> 4, i = rho & 15; return 8 * (i >> 2) + 4 * n + (i & 3); }

struct Unit { int pm, pn; };
struct Gemm { const bf16_t* A; const bf16_t* Bt; int M, N, K, lda; };

struct StaticOrder {
    int nM, nN, nwg, G, c;
    __host__ __device__ void init(int M, int N, int G_, int c_) { nM = M / BM; nN = N / BM; nwg = nM * nN; G = G_; c = c_; }
    __host__ __device__ bool next(int i, Unit& u) const {
        const long L = (long)i * G + c; if (L >= nwg) return false;
        int wgid = (int)L; { const int q = nwg / NXCD, r = nwg % NXCD, xcd = wgid % NXCD, off = wgid / NXCD; wgid = (xcd < r ? xcd * (q + 1) : r * (q + 1) + (xcd - r) * q) + off; }
        const int nig = WGM * nN, gid = wgid / nig, fm = gid * WGM, gsz = (nM - fm) < WGM ? (nM - fm) : WGM;
        u.pm = fm + ((wgid % nig) % gsz); u.pn = (wgid % nig) / gsz; return true;
    }
    __device__ __forceinline__ void a_ready(const Unit&) const {}
    __device__ __forceinline__ void done(const Unit&) const {}
};
__device__ __forceinline__ unsigned cvt_pk_bf16(float lo, float hi) { unsigned r; asm volatile("v_cvt_pk_bf16_f32 %0, %1, %2" : "=v"(r) : "v"(lo), "v"(hi)); return r; }
typedef float f32x2 __attribute__((ext_vector_type(2)));
__device__ __forceinline__ f32x2 gelu_pk(f32x2 v) {
    const f32x2 av = __builtin_elementwise_abs(v), d = av * 0.2316418882f + 1.0f;
    f32x2 t; t.x = __builtin_amdgcn_rcpf(d.x); t.y = __builtin_amdgcn_rcpf(d.y);
    f32x2 q = t * 0.5307027145f + (-0.7265760135f); q = q * t + 0.7107068705f; q = q * t + (-0.142248368f); q = q * t + 0.127414796f; q = q * t;
    const f32x2 s = (v * v) * (-0.72134752044f);
    f32x2 e; e.x = __builtin_amdgcn_exp2f(s.x); e.y = __builtin_amdgcn_exp2f(s.y);
    const f32x2 m = v * (q * e), r = v - m;
    f32x2 o; o.x = v.x < 0.f ? m.x : r.x; o.y = v.y < 0.f ? m.y : r.y; return o;
}

template <int ACT  > struct EpiBf16 {
    static constexpr bool PERM = true, AFTER_DRAIN = false; static_assert(ACT == 0 || ACT == 1, "EpiBf16: ACT is 0 (none) or 1 (gelu_pk)");
    bf16_t* O; int ldc; const float* bias; int split_cols; size_t split_stride; float scale0;
    __device__ __forceinline__ void operator()(const f32x4 (&acc)[2][2][4][2], const Unit& u, int wr, int wc, int fr, int fq) const {
        const int row0 = u.pm * BM + wr * 64 + fr; int colt = u.pn * BM; bf16_t* base = O;
        float sc = 1.f; if (split_cols) { const int t = colt / split_cols; base += (size_t)t * split_stride; colt -= t * split_cols; if (t == 0) sc = scale0; }
        const int col0 = colt + wc * 32 + 8 * fq, bcol0 = u.pn * BM + wc * 32 + 8 * fq;
        f32x4 bv[2][2];
#pragma unroll
        for (int bj = 0; bj < 2; ++bj)
#pragma unroll
            for (int n = 0; n < 2; ++n) bv[bj][n] = bias ? *(const f32x4*)(bias + bcol0 + bj * HALF + 4 * n) : (f32x4){0.f, 0.f, 0.f, 0.f};
#pragma unroll
        for (int ai = 0; ai < 2; ++ai)
#pragma unroll
            for (int m = 0; m < 4; ++m) { bf16_t* rowp = base + (size_t)(row0 + ai * HALF + m * 16) * ldc + col0;
#pragma unroll
                for (int bj = 0; bj < 2; ++bj) { f32x4 v0 = acc[ai][bj][m][0] + bv[bj][0], v1 = acc[ai][bj][m][1] + bv[bj][1];
                    if (ACT == 1) { f32x2 a = gelu_pk((f32x2){v0[0], v0[1]}), b = gelu_pk((f32x2){v0[2], v0[3]}), c = gelu_pk((f32x2){v1[0], v1[1]}), d = gelu_pk((f32x2){v1[2], v1[3]});
                        v0 = (f32x4){a.x, a.y, b.x, b.y}; v1 = (f32x4){c.x, c.y, d.x, d.y}; }
                    v0 = v0 * sc; v1 = v1 * sc; u32x4 w; w.x = cvt_pk_bf16(v0[0], v0[1]); w.y = cvt_pk_bf16(v0[2], v0[3]); w.z = cvt_pk_bf16(v1[0], v1[1]); w.w = cvt_pk_bf16(v1[2], v1[3]);
                    *(u32x4*)(rowp + bj * HALF) = w; } }
    }
};
template <class Epi, class Sched, bool ALIGN_EPI = false, bool SP2 = false>
__device__ __forceinline__ void gemm_phase(PG8_LAS unsigned char* lds, const Gemm g, const Sched& S, const Epi& E, int tid_in) {
    int tid_ = tid_in; asm volatile("" : "+v"(tid_));
    const int tid = tid_, wid = __builtin_amdgcn_readfirstlane(tid >> 6), lane = tid & 63, wr = wid >> 2, wc = wid & 3, fr = lane & 15, fq = lane >> 4;
    const int K = g.K, nt = K / BK;
    unsigned voffA[2], voffB[2];
#pragma unroll
    for (int i = 0; i < 2; ++i) { int R, C; stage_rc(tid * 16 + i * 8192, R, C); const int Rb = Epi::PERM ? ((R & ~31) + perm32(R & 31)) : R;
        voffA[i] = (unsigned)(R * g.lda + C) * 2u; voffB[i] = (unsigned)(Rb * K + C) * 2u; }
    const size_t kstep = (size_t)(BK * 2);
    const size_t hstep = (size_t)HALF * K * 2;
    const size_t tstep = 2 * hstep; const size_t hstepA = (size_t)HALF * g.lda * 2, tstepA = 2 * hstepA;
    const unsigned ldsw = (unsigned)wid * 1024u;
    const int aoff = lds_byte(wr * 64 + fr, fq * 8), boff = lds_byte(wc * 32 + fr, fq * 8);
#define PG8_SA(b, h) (((b) * 2 + (h)) * HTB)
#define PG8_SB(b, h) ((4 + (b) * 2 + (h)) * HTB)
#define PG8_STAGE(bufoff, gbase, voff) do { _Pragma("unroll") for (int _i = 0; _i < 2; ++_i) \
        __builtin_amdgcn_global_load_lds((const unsigned*)((const char*)(gbase) + (voff)[_i]), (PG8_LAS unsigned*)(lds + (bufoff) + ldsw + _i * 8192), 16, 0, 0); } while (0)
#define PG8_LDA(dst, b, h) do { _Pragma("unroll") for (int m = 0; m < 4; ++m) _Pragma("unroll") for (int k = 0; k < 2; ++k) dst[m][k] = *(const PG8_LAS bf16x8*)(lds + PG8_SA(b, h) + aoff + m * 2048 + k * 1024); } while (0)
#define PG8_LDB(dst, b, h) do { _Pragma("unroll") for (int n = 0; n < 2; ++n) _Pragma("unroll") for (int k = 0; k < 2; ++k) dst[n][k] = *(const PG8_LAS bf16x8*)(lds + PG8_SB(b, h) + boff + n * 2048 + k * 1024); } while (0)
#define PG8_MMA(ai, bj, At, Bt) do { __builtin_amdgcn_s_setprio(1); _Pragma("unroll") for (int m = 0; m < 4; ++m) _Pragma("unroll") for (int n = 0; n < 2; ++n) _Pragma("unroll") for (int k = 0; k < 2; ++k) \
        acc[ai][bj][m][n] = __builtin_amdgcn_mfma_f32_16x16x32_bf16(Bt[n][k], At[m][k], acc[ai][bj][m][n], 0, 0, 0); __builtin_amdgcn_s_setprio(0); } while (0)
#define PG8_WAIT_V(n) asm volatile("s_waitcnt vmcnt(" #n ")" ::: "memory")
#define PG8_WAIT_L(n) asm volatile("s_waitcnt lgkmcnt(" #n ")" ::: "memory")
#define PG8_BAR __builtin_amdgcn_s_barrier()
#define PG8_SCHED __builtin_amdgcn_sched_barrier(0)
    Unit cur, nxt; int ui = 0;
    if (!S.next(0, cur)) return;
    f32x4 acc[2][2][4][2];
#pragma unroll
    for (int a = 0; a < 2; ++a)
#pragma unroll
        for (int b = 0; b < 2; ++b)
#pragma unroll
            for (int m = 0; m < 4; ++m)
#pragma unroll
                for (int n = 0; n < 2; ++n) acc[a][b][m][n] = (f32x4){0.f, 0.f, 0.f, 0.f};
    bf16x8 At[4][2], B0[2][2], B1[2][2];
    const char* cA = (const char*)g.A + (size_t)cur.pm * tstepA; const char* cB = (const char*)g.Bt + (size_t)cur.pn * tstep;
    S.a_ready(cur);
    if constexpr (SP2) {
        PG8_STAGE(PG8_SB(0, 0), cB, voffB); PG8_STAGE(PG8_SB(0, 1), cB + hstep, voffB); PG8_STAGE(PG8_SA(0, 0), cA, voffA); PG8_STAGE(PG8_SA(0, 1), cA + hstepA, voffA);
        if (wr == 1) PG8_BAR;
        PG8_WAIT_V(2); PG8_BAR;
        PG8_STAGE(PG8_SB(1, 0), cB + kstep, voffB); PG8_STAGE(PG8_SA(1, 0), cA + kstep, voffA); PG8_STAGE(PG8_SB(1, 1), cB + hstep + kstep, voffB);
        PG8_WAIT_V(6); PG8_BAR;
    } else {
        PG8_STAGE(PG8_SB(0, 0), cB, voffB); PG8_STAGE(PG8_SA(0, 0), cA, voffA); PG8_STAGE(PG8_SB(0, 1), cB + hstep, voffB); PG8_STAGE(PG8_SA(0, 1), cA + hstepA, voffA);
        if (wr == 1) PG8_BAR;
        PG8_WAIT_V(4); PG8_BAR;
        PG8_STAGE(PG8_SB(1, 0), cB + kstep, voffB); PG8_STAGE(PG8_SA(1, 0), cA + kstep, voffA); PG8_STAGE(PG8_SB(1, 1), cB + hstep + kstep, voffB);
        PG8_WAIT_V(6); PG8_BAR;
    }
    for (;;) {
        const bool has_next = S.next(ui + 1, nxt);
        const char* nA = has_next ? (const char*)g.A + (size_t)nxt.pm * tstepA : cA; const char* nB = has_next ? (const char*)g.Bt + (size_t)nxt.pn * tstep : cB;
        for (int t = 0; t < nt; t += 2) {
            const bool last = (t == nt - 2);
            const char* a1 = cA + (size_t)(t + 1) * kstep;
            const char* a2 = last ? nA : cA + (size_t)(t + 2) * kstep; const char* b2 = last ? nB : cB + (size_t)(t + 2) * kstep;
            const char* a3 = a2 + kstep; const char* b3 = b2 + kstep;
            if (last && has_next) S.a_ready(nxt);
            if constexpr (SP2) {
            PG8_LDB(B0, 0, 0); PG8_LDB(B1, 0, 1); PG8_SCHED; PG8_LDA(At, 0, 0); PG8_STAGE(PG8_SA(1, 1), a1 + hstepA, voffA);
            PG8_WAIT_V(8); PG8_WAIT_L(0); PG8_BAR; PG8_MMA(0, 0, At, B0); PG8_MMA(0, 1, At, B1); PG8_BAR; PG8_SCHED;
            PG8_LDA(At, 0, 1); PG8_STAGE(PG8_SB(0, 0), b2, voffB); PG8_STAGE(PG8_SB(0, 1), b2 + hstep, voffB); PG8_STAGE(PG8_SA(0, 0), a2, voffA);
            PG8_WAIT_V(8); PG8_WAIT_L(0); PG8_BAR; PG8_MMA(1, 0, At, B0); PG8_MMA(1, 1, At, B1); PG8_BAR; PG8_SCHED;
            PG8_LDB(B0, 1, 0); PG8_LDB(B1, 1, 1); PG8_SCHED; PG8_LDA(At, 1, 0); PG8_STAGE(PG8_SA(0, 1), a2 + hstepA, voffA);
            PG8_WAIT_V(8); PG8_WAIT_L(0); PG8_BAR; PG8_MMA(0, 0, At, B0); PG8_MMA(0, 1, At, B1); PG8_BAR; PG8_SCHED;
            PG8_LDA(At, 1, 1); PG8_STAGE(PG8_SB(1, 0), b3, voffB); PG8_STAGE(PG8_SB(1, 1), b3 + hstep, voffB); PG8_STAGE(PG8_SA(1, 0), a3, voffA);
            PG8_WAIT_V(8); PG8_WAIT_L(0); PG8_BAR; PG8_MMA(1, 0, At, B0); PG8_MMA(1, 1, At, B1); PG8_BAR; PG8_SCHED;
            } else {
            PG8_LDB(B0, 0, 0); PG8_SCHED; PG8_LDA(At, 0, 0); PG8_STAGE(PG8_SA(1, 1), a1 + hstepA, voffA);
            PG8_WAIT_L(8); PG8_BAR; PG8_WAIT_L(0); PG8_MMA(0, 0, At, B0); PG8_BAR; PG8_SCHED;
            PG8_LDB(B1, 0, 1); PG8_STAGE(PG8_SB(0, 0), b2, voffB);
            PG8_BAR; PG8_WAIT_L(0); PG8_MMA(0, 1, At, B1); PG8_BAR;
            PG8_LDA(At, 0, 1); PG8_STAGE(PG8_SA(0, 0), a2, voffA);
            PG8_BAR; PG8_WAIT_L(0); PG8_MMA(1, 0, At, B0); PG8_BAR; PG8_SCHED;
            PG8_STAGE(PG8_SB(0, 1), b2 + hstep, voffB);
            PG8_WAIT_V(6); PG8_BAR; PG8_MMA(1, 1, At, B1); PG8_BAR;
            PG8_LDB(B0, 1, 0); PG8_SCHED; PG8_LDA(At, 1, 0); PG8_STAGE(PG8_SA(0, 1), a2 + hstepA, voffA);
            PG8_WAIT_L(8); PG8_BAR; PG8_WAIT_L(0); PG8_MMA(0, 0, At, B0); PG8_BAR; PG8_SCHED;
            PG8_LDB(B1, 1, 1); PG8_STAGE(PG8_SB(1, 0), b3, voffB);
            PG8_BAR; PG8_WAIT_L(0); PG8_MMA(0, 1, At, B1); PG8_BAR;
            PG8_LDA(At, 1, 1); PG8_STAGE(PG8_SA(1, 0), a3, voffA);
            PG8_BAR; PG8_WAIT_L(0); PG8_MMA(1, 0, At, B0); PG8_BAR; PG8_SCHED;
            PG8_STAGE(PG8_SB(1, 1), b3 + hstep, voffB);
            PG8_WAIT_V(6); PG8_BAR; PG8_MMA(1, 1, At, B1); PG8_BAR;
            }
        }
        if constexpr (ALIGN_EPI) { if (wr == 0) PG8_BAR; }
        if constexpr (!Epi::AFTER_DRAIN) { E(acc, cur, wr, wc, fr, fq); S.done(cur); }
        if (!has_next) break;
#pragma unroll
        for (int a = 0; a < 2; ++a)
#pragma unroll
            for (int b = 0; b < 2; ++b)
#pragma unroll
                for (int m = 0; m < 4; ++m)
#pragma unroll
                    for (int n = 0; n < 2; ++n) acc[a][b][m][n] = (f32x4){0.f, 0.f, 0.f, 0.f};
        cur = nxt; cA = nA; cB = nB; ++ui;
        if constexpr (ALIGN_EPI) { if (wr == 1) PG8_BAR; }
    }
    PG8_WAIT_V(0);
    if constexpr (!ALIGN_EPI) { if (wr == 0) PG8_BAR; }
    PG8_BAR;
    if constexpr (Epi::AFTER_DRAIN) { E.fused(acc, cur, wr, wc, fr, fq, lds, wid, lane); S.done(cur); }
#undef PG8_SA
#undef PG8_SB
#undef PG8_STAGE
#undef PG8_LDA
#undef PG8_LDB
#undef PG8_MMA
#undef PG8_WAIT_V
#undef PG8_WAIT_L
#undef PG8_BAR
#undef PG8_SCHED
}
}
namespace pg8 {
template <class T> __device__ __forceinline__ T* uni_ptr(T* p) {
    const unsigned long long v = (unsigned long long)p; unsigned lo = __builtin_amdgcn_readfirstlane((unsigned)v), hi = __builtin_amdgcn_readfirstlane((unsigned)(v >> 32)); asm volatile("" : "+s"(lo), "+s"(hi)); return (T*)(((unsigned long long)hi << 32) | lo); }
template <bool XB16> struct EpiResid {
    static constexpr bool PERM = true, AFTER_DRAIN = false;
    const void* xin_; bf16_t* out_; const float* gate_;
    __device__ __forceinline__ void operator()(const f32x4 (&acc)[2][2][4][2], const Unit& u, int wr, int wc, int fr, int fq) const {
        const void* xin = uni_ptr(xin_); bf16_t* out = uni_ptr(out_); const float* gate = uni_ptr(gate_);
        const int row0 = u.pm * BM + wr * 64 + fr, col0 = u.pn * BM + wc * 32 + 8 * fq;
        const float* gp = gate + (size_t)(u.pm >> 5) * 6144 + col0;
        f32x4 gv[2][2];
#pragma unroll
        for (int bj = 0; bj < 2; ++bj)
#pragma unroll
            for (int n = 0; n < 2; ++n) gv[bj][n] = *(const f32x4*)(gp + bj * HALF + 4 * n);
        if (XB16) {
#pragma unroll
            for (int ai = 0; ai < 2; ++ai) { u32x4 xr[4][2];
#pragma unroll
                for (int m = 0; m < 4; ++m)
#pragma unroll
                    for (int bj = 0; bj < 2; ++bj) xr[m][bj] = *(const u32x4*)((const bf16_t*)xin + (size_t)(row0 + ai * HALF + m * 16) * 1024 + col0 + bj * HALF);
#pragma unroll
                for (int m = 0; m < 4; ++m)
#pragma unroll
                    for (int bj = 0; bj < 2; ++bj) { const u32x4 q = xr[m][bj];
                        const f32x4 x0 = (f32x4){__uint_as_float(q.x << 16), __uint_as_float(q.x & 0xffff0000u), __uint_as_float(q.y << 16), __uint_as_float(q.y & 0xffff0000u)};
                        const f32x4 x1 = (f32x4){__uint_as_float(q.z << 16), __uint_as_float(q.z & 0xffff0000u), __uint_as_float(q.w << 16), __uint_as_float(q.w & 0xffff0000u)};
                        const f32x4 y0 = x0 + gv[bj][0] * acc[ai][bj][m][0], y1 = x1 + gv[bj][1] * acc[ai][bj][m][1];
                        u32x4 w; w.x = cvt_pk_bf16(y0[0], y0[1]); w.y = cvt_pk_bf16(y0[2], y0[3]); w.z = cvt_pk_bf16(y1[0], y1[1]); w.w = cvt_pk_bf16(y1[2], y1[3]);
                        *(u32x4*)(out + (size_t)(row0 + ai * HALF + m * 16) * 1024 + col0 + bj * HALF) = w; }
                asm volatile("" ::: "memory"); }
        } else {
#pragma unroll
            for (int ai = 0; ai < 2; ++ai)
#pragma unroll
                for (int m = 0; m < 4; ++m) { const size_t off = (size_t)(row0 + ai * HALF + m * 16) * 1024 + col0;
#pragma unroll
                    for (int bj = 0; bj < 2; ++bj) { const f32x4 x0 = *(const f32x4*)((const float*)xin + off + bj * HALF), x1 = *(const f32x4*)((const float*)xin + off + bj * HALF + 4);
                        const f32x4 y0 = x0 + gv[bj][0] * acc[ai][bj][m][0], y1 = x1 + gv[bj][1] * acc[ai][bj][m][1];
                        u32x4 w; w.x = cvt_pk_bf16(y0[0], y0[1]); w.y = cvt_pk_bf16(y0[2], y0[3]); w.z = cvt_pk_bf16(y1[0], y1[1]); w.w = cvt_pk_bf16(y1[2], y1[3]);
                        *(u32x4*)(out + off + bj * HALF) = w; }
                    if (m & 1) asm volatile("" ::: "memory"); }
        }
    }
};
struct EpiRelu2 {
    static constexpr bool PERM = true, AFTER_DRAIN = false;
    bf16_t* O_; int ldc;
    __device__ __forceinline__ void operator()(const f32x4 (&acc)[2][2][4][2], const Unit& u, int wr, int wc, int fr, int fq) const {
        bf16_t* O = uni_ptr(O_);
        const int row0 = u.pm * BM + wr * 64 + fr, col0 = u.pn * BM + wc * 32 + 8 * fq;
#pragma unroll
        for (int ai = 0; ai < 2; ++ai)
#pragma unroll
            for (int m = 0; m < 4; ++m) { bf16_t* rowp = O + (size_t)(row0 + ai * HALF + m * 16) * ldc + col0;
#pragma unroll
                for (int bj = 0; bj < 2; ++bj) { f32x4 v0 = acc[ai][bj][m][0], v1 = acc[ai][bj][m][1];
                    v0 = __builtin_elementwise_max(v0, (f32x4){0.f, 0.f, 0.f, 0.f}); v1 = __builtin_elementwise_max(v1, (f32x4){0.f, 0.f, 0.f, 0.f}); v0 = v0 * v0; v1 = v1 * v1;
                    u32x4 w; w.x = cvt_pk_bf16(v0[0], v0[1]); w.y = cvt_pk_bf16(v0[2], v0[3]); w.z = cvt_pk_bf16(v1[0], v1[1]); w.w = cvt_pk_bf16(v1[2], v1[3]);
                    *(u32x4*)(rowp + bj * HALF) = w; } }
    }
};
struct EpiMlaQ {
    static constexpr bool PERM = true, AFTER_DRAIN = false;
    bf16_t* QM_;
    __device__ __forceinline__ void operator()(const f32x4 (&acc)[2][2][4][2], const Unit& u, int wr, int wc, int fr, int fq) const {
        bf16_t* QM = uni_ptr(QM_);
        const int row0 = u.pm * BM + wr * 64 + fr, cw = wc * 32 + 8 * fq;
        const int nbj = (u.pn != 0) ? 1 : 2;
#pragma unroll
        for (int ai = 0; ai < 2; ++ai)
#pragma unroll
            for (int m = 0; m < 4; ++m) { bf16_t* qr = QM + (size_t)(row0 + ai * HALF + m * 16) * 384 + u.pn * 256 + cw;
#pragma unroll
                for (int bj = 0; bj < 2; ++bj) if (bj < nbj) { const f32x4 v0 = acc[ai][bj][m][0], v1 = acc[ai][bj][m][1];
                    u32x4 o; o.x = cvt_pk_bf16(v0[0], v0[1]); o.y = cvt_pk_bf16(v0[2], v0[3]); o.z = cvt_pk_bf16(v1[0], v1[1]); o.w = cvt_pk_bf16(v1[2], v1[3]);
                    *(u32x4*)(qr + bj * HALF) = o; } }
    }
};
struct EpiMlaKV {
    static constexpr bool PERM = true, AFTER_DRAIN = false;
    bf16_t* KM_; bf16_t* VM_; const float* rskv_;
    __device__ __forceinline__ void operator()(const f32x4 (&acc)[2][2][4][2], const Unit& u, int wr, int wc, int fr, int fq) const {
        bf16_t* KM = uni_ptr(KM_); bf16_t* VM = uni_ptr(VM_); const float* rskv = uni_ptr(rskv_);
        const int row0 = u.pm * BM + wr * 64 + fr, w = wc * 32 + 8 * fq;
        const bool isk = wc < 2;
#pragma unroll
        for (int ai = 0; ai < 2; ++ai)
#pragma unroll
            for (int m = 0; m < 4; ++m) { const int row = row0 + ai * HALF + m * 16; const float rs = rskv[row];
#pragma unroll
                for (int bj = 0; bj < 2; ++bj) { const int head = u.pn * 2 + bj;
                    const f32x4 v0 = acc[ai][bj][m][0] * rs, v1 = acc[ai][bj][m][1] * rs;
                    u32x4 o; o.x = cvt_pk_bf16(v0[0], v0[1]); o.y = cvt_pk_bf16(v0[2], v0[3]); o.z = cvt_pk_bf16(v1[0], v1[1]); o.w = cvt_pk_bf16(v1[2], v1[3]);
                    if (isk) *(u32x4*)(KM + (size_t)row * 384 + head * 96 + w) = o; else *(u32x4*)(VM + (size_t)row * 256 + head * 64 + (w - 64)) = o; }
                asm volatile("" ::: "memory"); }
    }
};
}
#define GAS __attribute__((address_space(1)))
#define LAS __attribute__((address_space(3)))
typedef unsigned short bf16;
typedef unsigned v4u __attribute__((ext_vector_type(4)));
typedef float f32x4 __attribute__((ext_vector_type(4)));
typedef short bf16x8 __attribute__((ext_vector_type(8)));
typedef GAS unsigned gu32;
typedef GAS unsigned long long gu64;
#define RLX_AGENT __ATOMIC_RELAXED, __HIP_MEMORY_SCOPE_AGENT
#define LDS_WAIT() asm volatile("s_waitcnt lgkmcnt(0)" ::: "memory")
#define VM_WAIT() asm volatile("s_waitcnt vmcnt(0)" ::: "memory")
__device__ __forceinline__ unsigned long long rt() { return __builtin_amdgcn_s_memrealtime(); }
__device__ __forceinline__ unsigned f2bf(float f) { unsigned u = __builtin_bit_cast(unsigned, f); return (u + 0x7fffu + ((u >> 16) & 1u)) >> 16; }
__device__ __forceinline__ unsigned pk2(float lo, float hi) { return f2bf(lo) | (f2bf(hi) << 16); }

#define XB_TMO      128
#define XB_XCNT(j)  (256  + 64 * (j))
#define XB_XSUB(j)  (1280 + 64 * (j))
#define XB_XGEN(j)  (2304 + 64 * (j))
#define XB_TOP      3328
#define XB_TOPGEN   3392
#define XCD_BAR_WORDS 3456
#define XB_SPIN_CAP (1u << 18)

__device__ __forceinline__ unsigned xb_ld(unsigned* p)              { return __hip_atomic_load(p, __ATOMIC_RELAXED, __HIP_MEMORY_SCOPE_AGENT); }
__device__ __forceinline__ unsigned xb_add(unsigned* p, unsigned v) { return __hip_atomic_fetch_add(p, v, __ATOMIC_RELAXED, __HIP_MEMORY_SCOPE_AGENT); }
__device__ __forceinline__ unsigned xb_xcc_id() { return (unsigned)__builtin_amdgcn_s_getreg((3 << 11) | 20) & 0xFu; }
#define XB_SPIN(cond, bar) do { unsigned _sp = 0; while (cond) { __builtin_amdgcn_s_sleep(1); \
    if ((++_sp & 255u) == 0u) { if (xb_ld(&(bar)[XB_TMO])) break; if (_sp > XB_SPIN_CAP) { atomicAdd(&(bar)[XB_TMO], 1u); break; } } } } while (0)

struct XcdBarrier {
    unsigned* bar; unsigned x;
    volatile LAS unsigned* st;
};

__device__ __forceinline__ XcdBarrier xcd_barrier_post(unsigned* bar, volatile LAS unsigned* st) {
    XcdBarrier b; b.bar = bar; b.x = xb_xcc_id(); b.st = st;
    if (threadIdx.x == 0) (void)xb_add(&bar[XB_XCNT(b.x)], 1u);
    return b;
}
__device__ __forceinline__ void xcd_barrier_complete(unsigned* bar, unsigned x, unsigned& nloc, unsigned& nx) {
    const unsigned G = gridDim.x * gridDim.y * gridDim.z;
    unsigned sum, cnt, mine, sp = 0u;
    for (;;) {
        sum = 0u; cnt = 0u; mine = 0u;
#pragma unroll
        for (unsigned j = 0; j < 16; ++j) { const unsigned c = xb_ld(&bar[XB_XCNT(j)]); sum += c; cnt += (c > 0u) ? 1u : 0u; mine = (j == x) ? c : mine; }
        if (sum == G) break;
        __builtin_amdgcn_s_sleep(1);
        if ((++sp & 255u) == 0u) { if (xb_ld(&bar[XB_TMO])) break; if (sp > XB_SPIN_CAP) { atomicAdd(&bar[XB_TMO], 1u); break; } }
    }
    nloc = mine > 0u ? mine : 1u; nx = cnt > 0u ? cnt : 1u;
}

__device__ __forceinline__ void xcd_barrier(const XcdBarrier& b) {
    asm volatile("s_waitcnt vmcnt(0)" ::: "memory");
    __syncthreads();
    if (threadIdx.x == 0) {
        unsigned* bar = b.bar;
        __builtin_amdgcn_s_waitcnt(0);
        unsigned nloc = b.st[0], nx = b.st[1];
        if (nloc == 0u) { xcd_barrier_complete(bar, b.x, nloc, nx); b.st[0] = nloc; b.st[1] = nx; }
        const unsigned old = xb_add(&bar[XB_XSUB(b.x)], 1u);
        const unsigned gen = old / nloc;
        if (old + 1u == (gen + 1u) * nloc) {
            __builtin_amdgcn_fence(__ATOMIC_RELEASE, "agent");
            asm volatile("s_waitcnt vmcnt(0)" ::: "memory");
            const unsigned og = xb_add(&bar[XB_TOP], 1u);
            const unsigned tg = og / nx;
            if (og + 1u == (tg + 1u) * nx) xb_add(&bar[XB_TOPGEN], 1u);
            else XB_SPIN(xb_ld(&bar[XB_TOPGEN]) == tg, bar);
            __builtin_amdgcn_fence(__ATOMIC_ACQUIRE, "agent");
            xb_add(&bar[XB_XGEN(b.x)], 1u);
            asm volatile("s_waitcnt vmcnt(0)" ::: "memory");
        } else {
            XB_SPIN(xb_ld(&bar[XB_XGEN(b.x)]) == gen, bar);
            __builtin_amdgcn_fence(__ATOMIC_ACQUIRE, "agent");
            asm volatile("s_waitcnt vmcnt(0)" ::: "memory");
        }
    }
    __syncthreads();
}
#ifndef FA_PROBE
#define FA_PROBE 0
#endif
#ifndef FA_EXP
#define FA_EXP 0
#endif
namespace fa {
typedef unsigned short bf16;
typedef short bf16x8 __attribute__((ext_vector_type(8)));
typedef short s16x4 __attribute__((ext_vector_type(4)));
typedef float f32x16 __attribute__((ext_vector_type(16)));
typedef float f32x4v __attribute__((ext_vector_type(4)));
typedef unsigned u32x4 __attribute__((ext_vector_type(4)));
typedef unsigned u32x2 __attribute__((ext_vector_type(2)));
typedef float f32x2_t __attribute__((ext_vector_type(2)));
typedef __bf16 bf16x2_t __attribute__((ext_vector_type(2)));
#define FLAS __attribute__((address_space(3)))
#define FGAS __attribute__((address_space(1)))
constexpr float MASKV = -1e30f, MINIT = -5e29f, TINYF = 1e-30f, LOG2E = 1.4426950408889634f;
constexpr int OSTR = 144;

__device__ __forceinline__ float ex2(float x) { return __builtin_amdgcn_exp2f(x); }
__device__ __forceinline__ unsigned cvtpk(float lo, float hi) { f32x2_t v = {lo, hi}; bf16x2_t b = __builtin_convertvector(v, bf16x2_t); return __builtin_bit_cast(unsigned, b); }
__device__ __forceinline__ float xhalf_max(float m) { auto rr = __builtin_amdgcn_permlane32_swap(__float_as_uint(m), __float_as_uint(m), false, false); return fmaxf(__uint_as_float(rr[0]), __uint_as_float(rr[1])); }
__device__ __forceinline__ float xhalf_sum(float m) { auto rr = __builtin_amdgcn_permlane32_swap(__float_as_uint(m), __float_as_uint(m), false, false); return __uint_as_float(rr[0]) + __uint_as_float(rr[1]); }
__device__ __forceinline__ float bf2f(unsigned short b) { return __uint_as_float((unsigned)b << 16); }

struct SM { float m, l; f32x16 o[2]; };
__device__ __forceinline__ void sm_init(SM& s) { s.m = MINIT; s.l = 0.f; s.o[0] = f32x16{}; s.o[1] = f32x16{}; }

template <int DQ> struct Stg { u32x4 k0, k1, v; };
template <int DQ> __device__ __forceinline__ void stg_load(Stg<DQ>& s, const FGAS char* ws, unsigned koff, unsigned ksb, unsigned voff, unsigned vsb, int key0, int kmax, int tid) {
    const int row = tid >> 3, ch = tid & 7; int kr = key0 + row; kr = kr < kmax ? kr : kmax;
    s.k0 = *(const FGAS u32x4*)(ws + (koff + (unsigned)kr * ksb + (unsigned)ch * 16u));
    s.v = *(const FGAS u32x4*)(ws + (voff + (unsigned)kr * vsb + (unsigned)ch * 16u));
    if (DQ == 96) { if (tid < 256) { const int r2 = tid >> 2, c2 = tid & 3; int k2 = key0 + r2; k2 = k2 < kmax ? k2 : kmax; s.k1 = *(const FGAS u32x4*)(ws + (koff + (unsigned)k2 * ksb + 128u + (unsigned)c2 * 16u)); } }
}
template <int DQ> __device__ __forceinline__ void stg_store(const Stg<DQ>& s, FLAS char* buf, int tid) {
    const int row = tid >> 3, ch = tid & 7, p = ch >> 2, c = ch & 3;
    *(FLAS u32x4*)(buf + p * 4096 + row * 64 + ((c ^ ((row >> 2) & 3)) << 4)) = s.k0;
    *(FLAS u32x4*)(buf + (DQ / 32) * 4096 + row * 128 + ((p ^ ((row >> 1) & 1)) << 6) + (c << 4)) = s.v;
    if (DQ == 96) { if (tid < 256) { const int r2 = tid >> 2, c2 = tid & 3; *(FLAS u32x4*)(buf + 2 * 4096 + r2 * 64 + ((c2 ^ ((r2 >> 2) & 3)) << 4)) = s.k1; } }
}
template <int DQ> constexpr int stage_bytes() { return (DQ / 32) * 4096 + 8192; }

template <int DQ> __device__ __forceinline__ void compute_S(f32x16& p0, f32x16& p1, const FLAS char* buf, const bf16x8 (&qf)[DQ / 16], int lane) {
    const int r = lane & 31, h = lane >> 5, sw = (r >> 2) & 3;
#pragma unroll
    for (int d0 = 0; d0 < DQ / 16; ++d0) {
        const int p = d0 >> 1, c = 2 * (d0 & 1) + h;
        const FLAS char* a = buf + p * 4096 + r * 64 + ((c ^ sw) << 4);
        const bf16x8 a0 = *(const FLAS bf16x8*)a, a1 = *(const FLAS bf16x8*)(a + 2048);
        p0 = __builtin_amdgcn_mfma_f32_32x32x16_bf16(a0, qf[d0], p0, 0, 0, 0);
        p1 = __builtin_amdgcn_mfma_f32_32x32x16_bf16(a1, qf[d0], p1, 0, 0, 0);
    }
#if FA_EXP & 2
    __builtin_amdgcn_sched_group_barrier(0x100, 4, 0);
#pragma unroll
    for (int i = 0; i < DQ / 16 - 2; ++i) { __builtin_amdgcn_sched_group_barrier(0x008, 2, 0); __builtin_amdgcn_sched_group_barrier(0x100, 2, 0); }
    __builtin_amdgcn_sched_group_barrier(0x008, 4, 0);
#endif
}
__device__ __forceinline__ s16x4 vtr(const FLAS char* p) { typedef short v4i16_t __attribute__((ext_vector_type(4))); return __builtin_bit_cast(s16x4, __builtin_amdgcn_ds_read_tr16_b64_v4i16((FLAS v4i16_t*)p)); }
__device__ __forceinline__ void pv(f32x16 (&o)[2], const FLAS char* vbuf, const bf16x8 (&pf)[4], int lane) {
    const int g = lane >> 4, i = lane & 15, q4 = i >> 2, pp = i & 3, h = lane >> 5;
    const int sw = (q4 >> 1) & 1;
#pragma unroll
    for (int db = 0; db < 2; ++db) {
        const FLAS char* base = vbuf + (4 * h + q4) * 128 + ((db ^ sw) << 6) + (16 * (g & 1) + 4 * pp) * 2;
#pragma unroll
        for (int ks = 0; ks < 4; ++ks) {
            const s16x4 lo = vtr(base + ks * 2048), hi = vtr(base + ks * 2048 + 1024);
            const bf16x8 a = (bf16x8){lo[0], lo[1], lo[2], lo[3], hi[0], hi[1], hi[2], hi[3]};
            o[db] = __builtin_amdgcn_mfma_f32_32x32x16_bf16(a, pf[ks], o[db], 0, 0, 0);
        }
    }
#if FA_EXP & 2
    __builtin_amdgcn_sched_group_barrier(0x100, 8, 0);
    __builtin_amdgcn_sched_group_barrier(0x008, 2, 0); __builtin_amdgcn_sched_group_barrier(0x100, 4, 0);
    __builtin_amdgcn_sched_group_barrier(0x008, 2, 0); __builtin_amdgcn_sched_group_barrier(0x100, 4, 0);
    __builtin_amdgcn_sched_group_barrier(0x008, 4, 0);
#endif
}
__device__ __forceinline__ void mask_ew(f32x16& p0, f32x16& p1, int lo, int hi, int h) {
    const int lo2 = lo - 4 * h, hi2 = hi - 4 * h;
#pragma unroll
    for (int v = 0; v < 16; ++v) { const int k0 = (v & 3) + 8 * (v >> 2);
        if (k0 < lo2 || k0 > hi2) p0[v] = MASKV;
        if (k0 + 32 < lo2 || k0 + 32 > hi2) p1[v] = MASKV; }
}
__device__ __forceinline__ void sm_step(SM& st, f32x16& p0, f32x16& p1, bf16x8 (&pf)[4]) {
#define FA_MX3(a, b, c) __builtin_fmaxf(__builtin_fmaxf((a), (b)), (c))
    float ma = FA_MX3(p0[0], p0[1], p1[0]), mb = FA_MX3(p0[2], p0[3], p1[1]); ma = FA_MX3(ma, p1[2], p1[3]);
#pragma unroll
    for (int v = 4; v < 16; v += 4) { ma = FA_MX3(ma, p0[v], p0[v + 1]); mb = FA_MX3(mb, p0[v + 2], p0[v + 3]); ma = FA_MX3(ma, p1[v], p1[v + 1]); mb = FA_MX3(mb, p1[v + 2], p1[v + 3]); }
#undef FA_MX3
    const float mx = xhalf_max(__builtin_fmaxf(ma, mb));
    if (__any(mx > st.m)) {
        const float mn2 = fmaxf(st.m, mx), alpha = ex2(st.m - mn2);
        st.m = mn2; st.l *= alpha; st.o[0] *= alpha; st.o[1] *= alpha;
    }
    const float mn = st.m;
    float s0 = 0.f, s1 = 0.f;
#pragma unroll
    for (int v = 0; v < 16; ++v) { p0[v] = ex2(p0[v] - mn); p1[v] = ex2(p1[v] - mn); s0 += p0[v]; s1 += p1[v]; }
    st.l += s0 + s1;
    u32x4 w;
    w.x = cvtpk(p0[0], p0[1]); w.y = cvtpk(p0[2], p0[3]); w.z = cvtpk(p0[4], p0[5]); w.w = cvtpk(p0[6], p0[7]); pf[0] = __builtin_bit_cast(bf16x8, w);
    w.x = cvtpk(p0[8], p0[9]); w.y = cvtpk(p0[10], p0[11]); w.z = cvtpk(p0[12], p0[13]); w.w = cvtpk(p0[14], p0[15]); pf[1] = __builtin_bit_cast(bf16x8, w);
    w.x = cvtpk(p1[0], p1[1]); w.y = cvtpk(p1[2], p1[3]); w.z = cvtpk(p1[4], p1[5]); w.w = cvtpk(p1[6], p1[7]); pf[2] = __builtin_bit_cast(bf16x8, w);
    w.x = cvtpk(p1[8], p1[9]); w.y = cvtpk(p1[10], p1[11]); w.z = cvtpk(p1[12], p1[13]); w.w = cvtpk(p1[14], p1[15]); pf[3] = __builtin_bit_cast(bf16x8, w);
}
template <int DQ, bool ALIBI> __device__ __forceinline__ void score_tile(f32x16& p0, f32x16& p1, const FLAS char* buf, const bf16x8 (&qf)[DQ / 16], float cb, float sl, int lane) {
    if (ALIBI) {
#pragma unroll
        for (int v = 0; v < 16; ++v) { const float c = (float)((v & 3) + 8 * (v >> 2)); p0[v] = fmaf(sl, c, cb); p1[v] = fmaf(sl, c + 32.f, cb); }
    } else { p0 = f32x16{}; p1 = f32x16{}; }
    compute_S<DQ>(p0, p1, buf, qf, lane);
}
template <int DQ, bool ALIBI> __device__ __forceinline__ void tile_compute(SM& st, const FLAS char* buf, const bf16x8 (&qf)[DQ / 16], float cb, float sl, bool ew, int lo, int hi, int lane) {
    f32x16 p0, p1; bf16x8 pf[4];
    score_tile<DQ, ALIBI>(p0, p1, buf, qf, cb, sl, lane);
    if (ew) mask_ew(p0, p1, lo, hi, lane >> 5);
    sm_step(st, p0, p1, pf);
    pv(st.o, buf + (DQ / 32) * 4096, pf, lane);
}
template <int DQ, bool ALIBI, class K0, class PAR>
__device__ __forceinline__ void fa_loop(SM& st, const bf16x8 (&qf)[DQ / 16], const FGAS char* ws, unsigned koff, unsigned ksb, unsigned voff, unsigned vsb, int kmax, int ntile, K0 k0f, PAR parf, float sl, FLAS char* lds, int tid, int lane) {
    constexpr int STG = stage_bytes<DQ>();
    Stg<DQ> sgA, sgB;
    stg_load<DQ>(sgB, ws, koff, ksb, voff, vsb, k0f(0), kmax, tid); stg_store<DQ>(sgB, lds, tid);
    if (ntile > 1) stg_load<DQ>(sgA, ws, koff, ksb, voff, vsb, k0f(1), kmax, tid);
    if (ntile > 2) stg_load<DQ>(sgB, ws, koff, ksb, voff, vsb, k0f(2), kmax, tid);
    __syncthreads();
#if FA_PROBE && FA_PROBE < 9
    unsigned long long pr_c = 0, pr_w = 0, pr_b = 0, pr_t = 0; const unsigned long long pr_start = __builtin_amdgcn_s_memtime();
#define FA_P0 const unsigned long long q0_ = __builtin_amdgcn_s_memtime();
#define FA_P1 asm volatile("s_waitcnt vmcnt(0)" ::: "memory"); const unsigned long long q1_ = __builtin_amdgcn_s_memtime();
#define FA_P2 asm volatile("s_waitcnt lgkmcnt(0)" ::: "memory"); asm volatile("" : "+v"(st.o[0]), "+v"(st.o[1])); const unsigned long long q2_ = __builtin_amdgcn_s_memtime();
#define FA_P3 const unsigned long long q3_ = __builtin_amdgcn_s_memtime(); pr_w += q1_ - q0_; pr_c += q2_ - q1_; pr_b += q3_ - q2_; pr_t += 1;
#else
#define FA_P0
#define FA_P1
#define FA_P2
#define FA_P3
#endif
#define FA_ITER(SG) { \
        FA_P0 \
        if (t + 1 < ntile) stg_store<DQ>(SG, lds + ((t + 1) & 1) * STG, tid); \
        if (t + 3 < ntile) stg_load<DQ>(SG, ws, koff, ksb, voff, vsb, k0f(t + 3), kmax, tid); \
        FA_P1 \
        bool act, ew; float cb; int lo, hi; \
        parf(t, act, ew, cb, lo, hi); \
        if (act) tile_compute<DQ, ALIBI>(st, lds + (t & 1) * STG, qf, cb, sl, ew, lo, hi, lane); \
        FA_P2 \
        __syncthreads(); \
        FA_P3 }
    int t = 0;
    for (; t + 1 < ntile; t += 2) { FA_ITER(sgA) ++t; FA_ITER(sgB) --t; }
    if (t < ntile) FA_ITER(sgA)
#undef FA_ITER
#if FA_PROBE && FA_PROBE < 9
    if (DQ == 96 && lane == 0) { unsigned long long* pp = (unsigned long long*)((FGAS char*)ws + 32768);
        atomicAdd(pp + 0, pr_c); atomicAdd(pp + 1, pr_w); atomicAdd(pp + 2, pr_b); atomicAdd(pp + 3, pr_t); atomicAdd(pp + 4, __builtin_amdgcn_s_memtime() - pr_start); }
#endif
}
__device__ __forceinline__ void sm_finish(const SM& st, float gate, f32x16 (&acc)[2]) {
    const float inv = gate / fmaxf(xhalf_sum(st.l), TINYF);
    acc[0] += st.o[0] * inv; acc[1] += st.o[1] * inv;
}
template <class DST> __device__ __forceinline__ void store_out(const f32x16 (&acc)[2], FLAS char* ost, FGAS char* ws, DST dstf, int lane) {
    const int r = lane & 31, h = lane >> 5;
#pragma unroll
    for (int db = 0; db < 2; ++db)
#pragma unroll
        for (int g = 0; g < 4; ++g) { u32x2 w; w.x = cvtpk(acc[db][4 * g], acc[db][4 * g + 1]); w.y = cvtpk(acc[db][4 * g + 2], acc[db][4 * g + 3]);
            *(FLAS u32x2*)(ost + r * OSTR + (32 * db + 8 * g + 4 * h) * 2) = w; }
    asm volatile("s_waitcnt lgkmcnt(0)" ::: "memory");
#pragma unroll
    for (int i = 0; i < 4; ++i) { const int idx = i * 64 + lane, col = idx >> 3, ch = idx & 7;
        const u32x4 v = *(const FLAS u32x4*)(ost + col * OSTR + ch * 16);
        *(FGAS u32x4*)(ws + (dstf(col) + (unsigned)ch * 16u)) = v; }
    asm volatile("s_waitcnt lgkmcnt(0)" ::: "memory");
}
template <int DQ> __device__ __forceinline__ void load_q(bf16x8 (&qf)[DQ / 16], const FGAS char* ws, unsigned qoff, int h) {
#pragma unroll
    for (int d0 = 0; d0 < DQ / 16; ++d0) qf[d0] = *(const FGAS bf16x8*)(ws + (qoff + (unsigned)(d0 * 32 + 16 * h)));
}
}
namespace mk {
typedef unsigned short bf16;
typedef float f32x4 __attribute__((ext_vector_type(4)));
typedef unsigned v4u __attribute__((ext_vector_type(4)));
typedef unsigned v2u __attribute__((ext_vector_type(2)));
typedef short bf16x8 __attribute__((ext_vector_type(8)));
typedef float f32x16 __attribute__((ext_vector_type(16)));
using fa::SM;

constexpr int D = 1024, NB = 4, SEQ = 8192, M = NB * SEQ, DEPTH = 2, DFF = 4096, ZLD = 2304, DIN = 2284;
constexpr int ZA_Q = 0, ZA_K = 256, ZA_V = 384, ZB_CQ = 512, ZB_CKV = 704, ZB_PE = 832, ZC_Q = 864, ZC_KC = 1120, ZC_VC = 1184, ZC_KS = 1248, ZC_VS = 1312, ZC_KW = 1376, ZC_VW = 1440, ZC_GL = 1504, ZD_Q = 1520, ZD_K = 1776, ZD_V = 2032;
constexpr float LOG2E = 1.4426950408889634f;
constexpr float QS = 0.125f * LOG2E;
constexpr float C_MLA = 0.10206207261596577f * LOG2E;
constexpr float RMS_EPS = 1e-6f;
constexpr int NWAVES = 8, NTHR = 512;

constexpr size_t MiB = 1u << 20;
constexpr size_t WS_CTL = 0, CTL_ZERO_BYTES = 64 * 1024;
constexpr size_t WS_MOD = 1 * MiB;
constexpr size_t WS_ROPE = WS_MOD + 256 * 1024;
constexpr size_t WS_POSP = WS_ROPE + 1 * MiB;
constexpr size_t WS_POSB = WS_POSP + 64 * 1024;
constexpr size_t WS_RSQ = WS_POSB + 64 * 1024;
constexpr size_t WS_RSKV = WS_RSQ + 128 * 1024;
constexpr size_t WS_KMH = WS_RSKV + 128 * 1024;
constexpr size_t WS_KML = WS_KMH + 64 * 1024;
constexpr size_t WS_KCMP = WS_KML + 64 * 1024;
constexpr size_t WS_VCMP = WS_KCMP + 256 * 1024;
constexpr size_t WS_XB = 436 * MiB;
constexpr size_t WS_PARK = 401 * MiB;
constexpr size_t WS_W = 4 * MiB, WS_WL = 26 * MiB;
constexpr size_t W_IN = 0, W_OUT = 4608 * 1024, W_UP = W_OUT + 2 * MiB, W_DN = W_UP + 8 * MiB, W_UQ = W_DN + 8 * MiB, W_UKV = W_UQ + 256 * 1024, W_1K = W_UKV + 256 * 1024, W_1V = W_1K + 512 * 1024, W_2K = W_1V + 512 * 1024, W_2V = W_2K + 16 * 1024;
static_assert(W_2V + 16 * 1024 <= WS_WL && WS_VCMP + 256 * 1024 <= WS_W, "ws map");
constexpr size_t WS_H = 56 * MiB;
constexpr size_t WS_Z = 120 * MiB;
constexpr size_t WS_QM = 265 * MiB, WS_KM = 297 * MiB, WS_VM = 321 * MiB, WS_O = 337 * MiB, WS_U = 120 * MiB, WS_END = 401 * MiB;
static_assert(WS_Z + (size_t)(M + 64) * ZLD * 2 <= WS_QM && WS_U + (size_t)M * DFF * 2 <= WS_END, "ws map 2");

constexpr int LDS_RING = 131072, LDS_BYTES = 163840, LDS_MISC = LDS_BYTES - 256;
constexpr int FA_STAGES = 0, FA_OST = 61440, FA_IMP = FA_OST + 8 * 32 * fa::OSTR  , FA_SELM = FA_IMP + 32768, FA_UM = FA_SELM + 1024, FA_VALS = FA_UM + 64;
static_assert(FA_VALS + 8 * 512 <= LDS_MISC, "fa lds map");
constexpr int MB_OS = 65;
constexpr int MB_T = 0, MB_O = 65536, MB_ML = MB_O + 256 * MB_OS * 4, MB_CNT = MB_ML + 2048, MB_LST = MB_CNT + 128, MB_PS = MB_LST + 8192, MB_PM = MB_PS + 4 * 32 * 33 * 4;
static_assert(MB_PM + 1024 <= LDS_MISC, "moba lds map");

#define GAS __attribute__((address_space(1)))
#define LAS __attribute__((address_space(3)))
#define LDS_WAIT() asm volatile("s_waitcnt lgkmcnt(0)" ::: "memory")
__device__ __forceinline__ unsigned f2bf(float f) { unsigned u = __builtin_bit_cast(unsigned, f); return (u + 0x7fffu + ((u >> 16) & 1u)) >> 16; }
__device__ __forceinline__ unsigned pk2(float lo, float hi) { return f2bf(lo) | (f2bf(hi) << 16); }
__device__ __forceinline__ float bf2f(unsigned short b) { return __uint_as_float((unsigned)b << 16); }
__device__ __forceinline__ float wave_sum(float v) {
#pragma unroll
    for (int o = 1; o < 64; o <<= 1) v += __shfl_xor(v, o);
    return v;
}
__device__ __forceinline__ float slope2_of(int i) { return exp2f(-8.0f * (float)(i + 1) / 12.0f) * LOG2E; }

struct Args { const float* in[22]; float* out; unsigned char* ws; int ph_lo, ph_hi, skip, rep; };
typedef const __attribute__((address_space(4))) Args* KArgsP;
struct Frame {
    LAS unsigned char* lds;
    int tid, lane, wave, vcu, G, bx;
    unsigned char* ws;
};

template <int MODE> __device__ __forceinline__ int dmap(int n) {
    if (MODE == 1) { if (n < 832) return n; if (n < 848) return 832 + 2 * (n - 832); if (n < 864) return 832 + 2 * (n - 848) + 1; if (n < 1516) return n; return n + 4; }
    if (MODE == 2) { const int hd = n / 96, w = n - hd * 96; if (w < 64) return hd * 64 + w; if (w < 80) return 256 + hd * 32 + 2 * (w - 64); return 256 + hd * 32 + 2 * (w - 80) + 1; }
    return n;
}
template <int MODE> __device__ __forceinline__ float cscale(int n) {
    if (MODE == 1) { return (n < 256 || (n >= 864 && n < 1120) || (n >= 1516 && n < 1772)) ? QS : 1.f; }
    if (MODE == 2) return C_MLA;
    return 1.f;
}
template <int MODE> __device__ __forceinline__ void transpose_item(const float* W, int N, bf16* WT, int KT, const float* kscale, LAS float* scr, int item, int lane) {
    const int nblk = (N + 31) / 32, kb = item / nblk, nb = item % nblk, k0 = 64 * kb, n0 = 32 * nb;
    const int nl = lane & 31, n = n0 + nl;
    float tv[32];
#pragma unroll
    for (int i = 0; i < 32; ++i) { const int kk = 2 * i + (lane >> 5); tv[i] = (n < N) ? W[(size_t)(k0 + kk) * N + n] : 0.f; }
#pragma unroll
    for (int i = 0; i < 32; ++i) { const int kk = 2 * i + (lane >> 5); float v = tv[i]; if (kscale) v *= kscale[k0 + kk]; scr[kk * 33 + nl] = v; }
    LDS_WAIT(); asm volatile("" ::: "memory");
    const int c = lane & 7;
#pragma unroll
    for (int j = 0; j < 4; ++j) { const int nn = (lane >> 3) + 8 * j, ng = n0 + nn;
        if (ng < N) { const float cs = cscale<MODE>(ng); const LAS float* s = scr + (8 * c) * 33 + nn;
            v4u o; o.x = pk2(s[0 * 33] * cs, s[1 * 33] * cs); o.y = pk2(s[2 * 33] * cs, s[3 * 33] * cs); o.z = pk2(s[4 * 33] * cs, s[5 * 33] * cs); o.w = pk2(s[6 * 33] * cs, s[7 * 33] * cs);
            *(GAS v4u*)(WT + (size_t)dmap<MODE>(ng) * KT + k0 + 8 * c) = o; } }
    LDS_WAIT(); asm volatile("" ::: "memory");
}
__device__ __forceinline__ void zero_fill16(bf16* p, size_t n16, int gtid, int gthreads) {
    for (size_t i = gtid; i < n16; i += gthreads) ((GAS v4u*)p)[i] = (v4u){0u, 0u, 0u, 0u};
}

__device__ __forceinline__ void p_prologue(Frame& F, KArgsP ap_) {
#define a (*ap_)
    LAS float* scr = (LAS float*)(F.lds + F.wave * 16384);
    const int gw = F.vcu * NWAVES + F.wave, NGW = F.G * NWAVES;
    const int gtid = F.vcu * NTHR + F.tid, GT = F.G * NTHR;
    constexpr int I_IN = 16 * 72, I_OUT = 16 * 32, I_UP = 16 * 128, I_DN = 64 * 32, I_UQ = 3 * 12, I_UKV = 2 * 16, I_W1 = 32 * 4, I_W2 = 2 * 2;
    constexpr int PER_L = I_IN + I_OUT + I_UP + I_DN + I_UQ + I_UKV + 2 * I_W1 + 2 * I_W2;
    for (int it = gw; it < DEPTH * PER_L; it += NGW) {
        const int l = it / PER_L; int r = it - l * PER_L;
        unsigned char* wb = F.ws + WS_W + (size_t)l * WS_WL;
        if (r < I_IN) { transpose_item<1>(a.in[6] + (size_t)l * D * DIN, DIN, (bf16*)(wb + W_IN), D, nullptr, scr, r, F.lane); continue; } r -= I_IN;
        if (r < I_OUT) { transpose_item<0>(a.in[7] + (size_t)l * D * D, D, (bf16*)(wb + W_OUT), D, nullptr, scr, r, F.lane); continue; } r -= I_OUT;
        if (r < I_UP) { transpose_item<0>(a.in[19] + (size_t)l * D * DFF, DFF, (bf16*)(wb + W_UP), D, nullptr, scr, r, F.lane); continue; } r -= I_UP;
        if (r < I_DN) { transpose_item<0>(a.in[20] + (size_t)l * DFF * D, D, (bf16*)(wb + W_DN), DFF, nullptr, scr, r, F.lane); continue; } r -= I_DN;
        if (r < I_UQ) { transpose_item<2>(a.in[11] + (size_t)l * 192 * 384, 384, (bf16*)(wb + W_UQ), 256, a.in[9] + l * 192, scr, r, F.lane); continue; } r -= I_UQ;
        if (r < I_UKV) { transpose_item<0>(a.in[12] + (size_t)l * 128 * 512, 512, (bf16*)(wb + W_UKV), 256, a.in[10] + l * 128, scr, r, F.lane); continue; } r -= I_UKV;
        if (r < I_W1) { transpose_item<0>(a.in[15] + (size_t)l * 2048 * 128, 128, (bf16*)(wb + W_1K), 2048, nullptr, scr, r, F.lane); continue; } r -= I_W1;
        if (r < I_W1) { transpose_item<0>(a.in[17] + (size_t)l * 2048 * 128, 128, (bf16*)(wb + W_1V), 2048, nullptr, scr, r, F.lane); continue; } r -= I_W1;
        if (r < I_W2) { transpose_item<0>(a.in[16] + (size_t)l * 128 * 64, 64, (bf16*)(wb + W_2K), 128, nullptr, scr, r, F.lane); continue; } r -= I_W2;
        transpose_item<0>(a.in[18] + (size_t)l * 128 * 64, 64, (bf16*)(wb + W_2V), 128, nullptr, scr, r, F.lane);
    }
    for (int l = 0; l < DEPTH; ++l) {
        unsigned char* wb = F.ws + WS_W + (size_t)l * WS_WL;
        zero_fill16((bf16*)(wb + W_IN) + (size_t)1516 * D, 4 * D / 8, gtid, GT);
        zero_fill16((bf16*)(wb + W_IN) + (size_t)2288 * D, 16 * D / 8, gtid, GT);
        zero_fill16((bf16*)(wb + W_UQ) + (size_t)384 * 256, 128 * 256 / 8, gtid, GT);
        for (int i = gtid; i < 384 * 8; i += GT) ((GAS v4u*)((bf16*)(wb + W_UQ) + (size_t)(i >> 3) * 256 + 192))[i & 7] = (v4u){0u, 0u, 0u, 0u};
        for (int i = gtid; i < 512 * 16; i += GT) ((GAS v4u*)((bf16*)(wb + W_UKV) + (size_t)(i >> 4) * 256 + 128))[i & 15] = (v4u){0u, 0u, 0u, 0u};
    }
    { float* rt = (float*)(F.ws + WS_ROPE);
      for (int i = gtid; i < SEQ * 16; i += GT) { const int ii = i & 15, t = i >> 4; const float freq = powf(10000.f, -(float)ii / 16.f), ang = (float)t * freq; rt[2 * i] = cosf(ang); rt[2 * i + 1] = sinf(ang); } }
    { float* pp = (float*)(F.ws + WS_POSP);
      for (int i = gtid; i < DEPTH * 2 * 32 * 128; i += GT) { const int j = i & 127, kr = (i >> 7) & 31, wh = (i >> 12) & 1, l = i >> 13;
          const float* pos = a.in[wh ? 14 : 13] + l * 2048 + kr * 64; const float* w1 = a.in[wh ? 17 : 15] + (size_t)l * 2048 * 128 + (size_t)kr * 64 * 128 + j;
          float s = 0.f;
#pragma unroll 32
          for (int k = 0; k < 64; ++k) s += pos[k] * w1[(size_t)k * 128];
          pp[i] = s; } }
    { LAS float* sc = (LAS float*)(F.lds);
      LAS float* part = (LAS float*)(F.lds + 16384);
      __syncthreads();
      bool have = false;
      for (int it = F.vcu; it < DEPTH * 96; it += F.G) {
          if (!have) { for (int i = F.tid; i < NB * D; i += NTHR) { const float cv = a.in[1][i]; sc[i] = cv / (1.f + expf(-cv)); } have = true; __syncthreads(); }
          const int l = it / 96, ch = it % 96; const int j = ch * 64 + F.lane;
          const float* w = a.in[4] + (size_t)l * D * 6 * D + j;
          float acc[4] = {0.f, 0.f, 0.f, 0.f};
#pragma unroll 32
          for (int k = 128 * F.wave; k < 128 * F.wave + 128; ++k) { const float wv = w[(size_t)k * 6 * D]; acc[0] += sc[k] * wv; acc[1] += sc[D + k] * wv; acc[2] += sc[2 * D + k] * wv; acc[3] += sc[3 * D + k] * wv; }
#pragma unroll
          for (int b = 0; b < 4; ++b) part[(F.wave * 4 + b) * 64 + F.lane] = acc[b];
          __syncthreads();
          if (F.tid < 256) { const int b = F.tid >> 6, ln = F.tid & 63; float s = a.in[5][l * 6 * D + ch * 64 + ln];
#pragma unroll
              for (int w8 = 0; w8 < 8; ++w8) s += part[(w8 * 4 + b) * 64 + ln];
              ((float*)(F.ws + WS_MOD))[((size_t)l * NB + b) * 6 * D + ch * 64 + ln] = s; }
          __syncthreads();
      } }
}

#undef a
template <int MODE, bool XB16> __device__ __forceinline__ void p_norm(Frame& F, const void* x, const float* g, const float* modsh, const float* modsc, bf16* hout, float* fout) {
    const int gw = F.vcu * NWAVES + F.wave, NGW = F.G * NWAVES;
    for (int blk = gw; blk < M / 16; blk += NGW) {
        const int row0 = blk * 16, b = row0 >> 13;
        f32x4 ga[4], sh[4];
#pragma unroll
        for (int j = 0; j < 4; ++j) { const int c = 4 * F.lane + 256 * j; ga[j] = *(const f32x4*)(g + c);
            if (MODE == 0) { const f32x4 s = *(const f32x4*)(modsc + (size_t)b * 6 * D + c); ga[j] = ga[j] * (s + 1.0f); sh[j] = *(const f32x4*)(modsh + (size_t)b * 6 * D + c); } }
        for (int rr = 0; rr < 16; rr += 4) {
            f32x4 v[4][4];
#pragma unroll
            for (int q = 0; q < 4; ++q) { const int row = row0 + rr + q;
                if (XB16) { const GAS unsigned long long* xr = (const GAS unsigned long long*)((const bf16*)x + (size_t)row * D) + F.lane;
#pragma unroll
                    for (int j = 0; j < 4; ++j) { const unsigned long long qq = xr[64 * j]; const unsigned lo = (unsigned)qq, hi = (unsigned)(qq >> 32);
                        v[q][j] = (f32x4){__uint_as_float(lo << 16), __uint_as_float(lo & 0xffff0000u), __uint_as_float(hi << 16), __uint_as_float(hi & 0xffff0000u)}; } }
                else { const GAS f32x4* xr = (const GAS f32x4*)((const float*)x + (size_t)row * D) + F.lane;
#pragma unroll
                    for (int j = 0; j < 4; ++j) v[q][j] = xr[64 * j]; } }
#pragma unroll
            for (int q = 0; q < 4; ++q) { const int row = row0 + rr + q; float s = 0.f;
#pragma unroll
                for (int j = 0; j < 4; ++j) s += (v[q][j].x * v[q][j].x + v[q][j].y * v[q][j].y) + (v[q][j].z * v[q][j].z + v[q][j].w * v[q][j].w);
                const float r = rsqrtf(wave_sum(s) * (1.f / D) + RMS_EPS);
                if (MODE == 0) { GAS unsigned long long* o8 = (GAS unsigned long long*)(hout + (size_t)row * D) + F.lane;
#pragma unroll
                    for (int j = 0; j < 4; ++j) { const f32x4 y = v[q][j] * r * ga[j] + sh[j]; o8[64 * j] = (unsigned long long)pk2(y.x, y.y) | ((unsigned long long)pk2(y.z, y.w) << 32); } }
                else { GAS f32x4* o = (GAS f32x4*)(fout + (size_t)row * D) + F.lane;
#pragma unroll
                    for (int j = 0; j < 4; ++j) o[64 * j] = v[q][j] * r * ga[j]; } }
        }
    }
}

__device__ __forceinline__ void p_prep(Frame& F, int l) {
    const int gw = F.vcu * NWAVES + F.wave, NGW = F.G * NWAVES;
    const bf16* Z = (const bf16*)(F.ws + WS_Z); bf16* KM = (bf16*)(F.ws + WS_KM);
    float* rsq = (float*)(F.ws + WS_RSQ); float* rskv = (float*)(F.ws + WS_RSKV); const float* rope = (const float*)(F.ws + WS_ROPE);
    for (int rb = gw; rb < M / 4; rb += NGW) {
        float a0[4], a1[4], a2[4], b0[4], b1[4]; unsigned pr[4] = {0u, 0u, 0u, 0u}; float cs[4] = {0.f, 0.f, 0.f, 0.f}, sn[4] = {0.f, 0.f, 0.f, 0.f};
#pragma unroll
        for (int q = 0; q < 4; ++q) { const int row = rb * 4 + q; const bf16* zr = Z + (size_t)row * ZLD;
            a0[q] = bf2f(zr[ZB_CQ + F.lane]); a1[q] = bf2f(zr[ZB_CQ + 64 + F.lane]); a2[q] = bf2f(zr[ZB_CQ + 128 + F.lane]);
            b0[q] = bf2f(zr[ZB_CKV + F.lane]); b1[q] = bf2f(zr[ZB_CKV + 64 + F.lane]);
            if (F.lane < 16) { pr[q] = *(const unsigned*)(zr + ZB_PE + 2 * F.lane); cs[q] = rope[((size_t)(row & 8191) * 16 + F.lane) * 2]; sn[q] = rope[((size_t)(row & 8191) * 16 + F.lane) * 2 + 1]; } }
#pragma unroll
        for (int q = 0; q < 4; ++q) { const int row = rb * 4 + q;
            const float sq = wave_sum(a0[q] * a0[q] + a1[q] * a1[q] + a2[q] * a2[q]), skv = wave_sum(b0[q] * b0[q] + b1[q] * b1[q]);
            if (F.lane == 0) { rsq[row] = rsqrtf(sq * (1.f / 192.f) + RMS_EPS); rskv[row] = rsqrtf(skv * (1.f / 128.f) + RMS_EPS); }
            if (F.lane < 16) { const float x1 = bf2f((unsigned short)(pr[q] & 0xffffu)), x2 = bf2f((unsigned short)(pr[q] >> 16));
                const unsigned o = pk2(x1 * cs[q] - x2 * sn[q], x1 * sn[q] + x2 * cs[q]);
#pragma unroll
                for (int hd = 0; hd < 4; ++hd) *(unsigned*)(KM + (size_t)row * 384 + hd * 96 + 64 + 2 * F.lane) = o; } }
    }
    { bf16* KMH = (bf16*)(F.ws + WS_KMH); bf16* KML = (bf16*)(F.ws + WS_KML);
      for (int it = gw; it < NB * 4 * 32; it += NGW) { const int j = it & 31, hd = (it >> 5) & 3, b = it >> 7; const int ts = F.lane >> 3, ch = F.lane & 7;
          float acc[8] = {0.f, 0.f, 0.f, 0.f, 0.f, 0.f, 0.f, 0.f};
#pragma unroll 8
          for (int i = 0; i < 32; ++i) { const v4u w = *(const v4u*)(Z + (size_t)(b * SEQ + j * 256 + 8 * i + ts) * ZLD + ZD_K + hd * 64 + ch * 8);
#pragma unroll
              for (int e = 0; e < 4; ++e) { acc[2 * e] += __uint_as_float(w[e] << 16); acc[2 * e + 1] += __uint_as_float(w[e] & 0xffff0000u); } }
#pragma unroll
          for (int e = 0; e < 8; ++e) { acc[e] += __shfl_xor(acc[e], 8); acc[e] += __shfl_xor(acc[e], 16); acc[e] += __shfl_xor(acc[e], 32); }
          if (F.lane < 8) { unsigned hi[4], lo[4];
#pragma unroll
              for (int e = 0; e < 4; ++e) { const float m0 = acc[2 * e] * (1.f / 256.f), m1 = acc[2 * e + 1] * (1.f / 256.f); const unsigned h0 = f2bf(m0), h1 = f2bf(m1);
                  hi[e] = h0 | (h1 << 16); lo[e] = pk2(m0 - __uint_as_float(h0 << 16), m1 - __uint_as_float(h1 << 16)); }
              *(v4u*)(KMH + (size_t)it * 64 + ch * 8) = (v4u){hi[0], hi[1], hi[2], hi[3]}; *(v4u*)(KML + (size_t)it * 64 + ch * 8) = (v4u){lo[0], lo[1], lo[2], lo[3]}; } } }
    if (gw == 0) { const float* pp = (const float*)(F.ws + WS_POSP) + (size_t)l * 2 * 32 * 128; float* pb = (float*)(F.ws + WS_POSB) + l * 256;
        for (int i = F.lane; i < 256; i += 64) { const int j = i & 127, wh = i >> 7; float s = 0.f; for (int kr = 0; kr < 32; ++kr) s += pp[(wh * 32 + kr) * 128 + j]; pb[i] = s; } }
}

__device__ __forceinline__ float gelu_tanh(float x) { const float u = 0.7978845608028654f * (x + 0.044715f * x * x * x); const float e = __expf(2.f * u); return x * (1.f - 1.f / (e + 1.f)); }
__device__ __forceinline__ void p_compress(Frame& F, int l) {
    const bf16* Z = (const bf16*)(F.ws + WS_Z);
    unsigned char* wb = F.ws + WS_W + (size_t)l * WS_WL;
    LAS float* red = (LAS float*)F.lds;
    const int r = F.lane & 31, h = F.lane >> 5;
    for (int it = F.vcu; it < NB * 16 * 2; it += F.G) {
        const int which = it & 1, itile = (it >> 1) & 15, b = it >> 5;
        const bf16* W1T = (const bf16*)(wb + (which ? W_1V : W_1K)); const bf16* W2T = (const bf16*)(wb + (which ? W_2V : W_2K));
        const int coff = which ? ZC_VC : ZC_KC;
        f32x16 acc[4] = {f32x16{}, f32x16{}, f32x16{}, f32x16{}};
        const bf16* brow = Z + (size_t)(b * SEQ + 16 * (32 * itile + r)) * ZLD + coff + 8 * h;
#pragma unroll 2
        for (int ks = 0; ks < 16; ++ks) { const int tt = 4 * F.wave + (ks >> 2), d0 = ks & 3;
            const bf16x8 bf = *(const bf16x8*)(brow + (size_t)tt * ZLD + d0 * 16);
#pragma unroll
            for (int hb = 0; hb < 4; ++hb) { const bf16x8 af = *(const bf16x8*)(W1T + (size_t)(hb * 32 + r) * 2048 + tt * 64 + d0 * 16 + 8 * h);
                acc[hb] = __builtin_amdgcn_mfma_f32_32x32x16_bf16(af, bf, acc[hb], 0, 0, 0); } }
#pragma unroll
        for (int hb = 0; hb < 4; ++hb)
#pragma unroll
            for (int v = 0; v < 16; ++v) red[((F.wave * 4 + hb) * 16 + v) * 64 + F.lane] = acc[hb][v];
        __syncthreads();
        if (F.wave < 2) {
            const float* pb = (const float*)(F.ws + WS_POSB) + l * 256 + which * 128;
            f32x16 o = f32x16{};
#pragma unroll
            for (int hb = 0; hb < 4; ++hb) { float x[16];
#pragma unroll
                for (int v = 0; v < 16; ++v) { float s = pb[hb * 32 + (v & 3) + 8 * (v >> 2) + 4 * h];
#pragma unroll
                    for (int w8 = 0; w8 < 8; ++w8) s += red[((w8 * 4 + hb) * 16 + v) * 64 + F.lane];
                    x[v] = gelu_tanh(s); }
#pragma unroll
                for (int s2 = 0; s2 < 2; ++s2) {
                    v4u pw; pw.x = fa::cvtpk(x[8 * s2], x[8 * s2 + 1]); pw.y = fa::cvtpk(x[8 * s2 + 2], x[8 * s2 + 3]); pw.z = fa::cvtpk(x[8 * s2 + 4], x[8 * s2 + 5]); pw.w = fa::cvtpk(x[8 * s2 + 6], x[8 * s2 + 7]);
                    const bf16* wr = W2T + (size_t)(F.wave * 32 + r) * 128 + hb * 32 + 16 * s2 + 4 * h;
                    const v2u a0 = *(const v2u*)wr, a1 = *(const v2u*)(wr + 8);
                    const v4u aw = (v4u){a0.x, a0.y, a1.x, a1.y};
                    o = __builtin_amdgcn_mfma_f32_32x32x16_bf16(__builtin_bit_cast(bf16x8, aw), __builtin_bit_cast(bf16x8, pw), o, 0, 0, 0); } }
            bf16* dst = (bf16*)(F.ws + (which ? WS_VCMP : WS_KCMP)) + (size_t)(b * 512 + 32 * itile + r) * 64 + F.wave * 32 + 4 * h;
#pragma unroll
            for (int g = 0; g < 4; ++g) { v2u w; w.x = fa::cvtpk(o[4 * g], o[4 * g + 1]); w.y = fa::cvtpk(o[4 * g + 2], o[4 * g + 3]); *(v2u*)(dst + 8 * g) = w; }
        }
        __syncthreads();
    }
}
using fa::bf16x8;
__device__ __forceinline__ unsigned char* launder_ptr(unsigned char* p) { const unsigned long long v = (unsigned long long)p; unsigned lo = __builtin_amdgcn_readfirstlane((unsigned)v), hi = __builtin_amdgcn_readfirstlane((unsigned)(v >> 32)); asm volatile("" : "+s"(lo), "+s"(hi)); return (unsigned char*)(((unsigned long long)hi << 32) | lo); }
#define UNIT_BEGIN() Frame F = F0; { int tid_ = F0.tid; asm volatile("" : "+v"(tid_)); int bx_ = __builtin_amdgcn_readfirstlane(F0.bx); asm volatile("" : "+s"(bx_)); \
    F.ws = launder_ptr(F0.ws); F.tid = tid_; F.lane = tid_ & 63; F.wave = __builtin_amdgcn_readfirstlane(tid_ >> 6); F.bx = bx_; }
__device__ __forceinline__ void u_mla(const Frame& F0, int b, int hd, int u) {
    UNIT_BEGIN();
    GAS char* ws = (GAS char*)F.ws;
    const int r = F.lane & 31, h = F.lane >> 5, q0 = 256 * u, wq0 = q0 + 32 * F.wave, tq = wq0 + r;
    bf16x8 qf[6]; { const unsigned qrow = (unsigned)WS_QM + (unsigned)(b * SEQ + tq) * 1024u;
      const float rs = *(const GAS float*)(ws + ((unsigned)WS_RSQ + (unsigned)(b * SEQ + tq) * 4u));
#pragma unroll
      for (int d0 = 0; d0 < 4; ++d0) { const fa::u32x4 raw = *(const GAS fa::u32x4*)(ws + (qrow + (unsigned)(hd * 128 + d0 * 32 + 16 * h))); fa::u32x4 o;
          o.x = fa::cvtpk(__uint_as_float(raw.x << 16) * rs, __uint_as_float(raw.x & 0xffff0000u) * rs); o.y = fa::cvtpk(__uint_as_float(raw.y << 16) * rs, __uint_as_float(raw.y & 0xffff0000u) * rs);
          o.z = fa::cvtpk(__uint_as_float(raw.z << 16) * rs, __uint_as_float(raw.z & 0xffff0000u) * rs); o.w = fa::cvtpk(__uint_as_float(raw.w << 16) * rs, __uint_as_float(raw.w & 0xffff0000u) * rs);
          qf[d0] = __builtin_bit_cast(bf16x8, o); }
#pragma unroll
      for (int d0 = 0; d0 < 2; ++d0) {
          const fa::u32x4 raw = *(const GAS fa::u32x4*)(ws + (qrow + (unsigned)(512 + hd * 64 + d0 * 32 + 16 * h)));
          const GAS float* rp = (const GAS float*)(ws + ((unsigned)WS_ROPE + (unsigned)((tq * 16 + d0 * 8 + 4 * h) * 8)));
          const fa::f32x4v r0 = *(const GAS fa::f32x4v*)rp * rs, r1 = *(const GAS fa::f32x4v*)(rp + 4) * rs;
          fa::u32x4 o;
          { const float x1 = __uint_as_float(raw.x << 16), x2 = __uint_as_float(raw.x & 0xffff0000u); o.x = fa::cvtpk(x1 * r0[0] - x2 * r0[1], x1 * r0[1] + x2 * r0[0]); }
          { const float x1 = __uint_as_float(raw.y << 16), x2 = __uint_as_float(raw.y & 0xffff0000u); o.y = fa::cvtpk(x1 * r0[2] - x2 * r0[3], x1 * r0[3] + x2 * r0[2]); }
          { const float x1 = __uint_as_float(raw.z << 16), x2 = __uint_as_float(raw.z & 0xffff0000u); o.z = fa::cvtpk(x1 * r1[0] - x2 * r1[1], x1 * r1[1] + x2 * r1[0]); }
          { const float x1 = __uint_as_float(raw.w << 16), x2 = __uint_as_float(raw.w & 0xffff0000u); o.w = fa::cvtpk(x1 * r1[2] - x2 * r1[3], x1 * r1[3] + x2 * r1[2]); }
          qf[4 + d0] = __builtin_bit_cast(bf16x8, o); } }
    SM st; fa::sm_init(st);
    LAS char* lds = (LAS char*)F.lds;
    fa::fa_loop<96, false>(st, qf, ws, (unsigned)WS_KM + (unsigned)b * (SEQ * 768u) + (unsigned)hd * 192u, 768u, (unsigned)WS_VM + (unsigned)b * (SEQ * 512u) + (unsigned)hd * 128u, 512u, SEQ - 1, 4 * u + 4,
        [](int t) { return 64 * t; },
        [=](int t, bool& act, bool& ew, float& cb, int& lo, int& hi) { const int key0 = 64 * t; act = key0 <= wq0 + 31; ew = key0 + 63 > wq0; cb = 0.f; lo = -100000; hi = tq - key0; },
        0.f, lds + FA_STAGES, F.tid, F.lane);
    f32x16 acc[2] = {f32x16{}, f32x16{}}; fa::sm_finish(st, 1.f, acc);
    fa::store_out(acc, lds + FA_OST + F.wave * 32 * fa::OSTR, ws, [=](int col) { return (unsigned)WS_O + (unsigned)(b * SEQ + wq0 + col) * 2048u + (unsigned)(256 + hd * 64) * 2u; }, F.lane);
}
__device__ __forceinline__ void u_moba(const Frame& F0, int b, int hd, int i) {
    UNIT_BEGIN();
    GAS char* ws = (GAS char*)F.ws;
    const int r = F.lane & 31, h = F.lane >> 5, q0 = 256 * i, wq0 = q0 + 32 * F.wave, tq = wq0 + r;
    bf16x8 qf[4]; fa::load_q<64>(qf, ws, (unsigned)WS_Z + (unsigned)(b * SEQ + tq) * (ZLD * 2u) + (unsigned)(ZD_Q + hd * 64) * 2u, h);
    unsigned bits = 0u;
    if (i > 0) {
        const GAS bf16* KMH = (const GAS bf16*)(ws + ((unsigned)WS_KMH + (unsigned)(((b * 4 + hd) * 32 + r) * 64 + 8 * h) * 2u)); const GAS bf16* KML = (const GAS bf16*)(ws + ((unsigned)WS_KML + (unsigned)(((b * 4 + hd) * 32 + r) * 64 + 8 * h) * 2u));
        f32x16 g = f32x16{};
#pragma unroll
        for (int d0 = 0; d0 < 4; ++d0) { const bf16x8 ah = *(const GAS bf16x8*)(KMH + d0 * 16), al = *(const GAS bf16x8*)(KML + d0 * 16);
            g = __builtin_amdgcn_mfma_f32_32x32x16_bf16(ah, qf[d0], g, 0, 0, 0); g = __builtin_amdgcn_mfma_f32_32x32x16_bf16(al, qf[d0], g, 0, 0, 0); }
        float og[16];
#pragma unroll
        for (int v = 0; v < 16; ++v) { const int j = (v & 3) + 8 * (v >> 2) + 4 * h; if (j >= i) g[v] = -INFINITY; og[v] = __shfl_xor(g[v], 32); }
#pragma unroll
        for (int v = 0; v < 16; ++v) { const int j = (v & 3) + 8 * (v >> 2) + 4 * h; int rank = 0;
#pragma unroll
            for (int w = 0; w < 16; ++w) { const int jm = (w & 3) + 8 * (w >> 2) + 4 * h, jo = (w & 3) + 8 * (w >> 2) + 4 * (1 - h);
                rank += (g[w] > g[v] || (g[w] == g[v] && jm < j)) ? 1 : 0; rank += (og[w] > g[v] || (og[w] == g[v] && jo < j)) ? 1 : 0; }
            if (rank < 3 && j < i) bits |= 1u << j; }
        bits |= __shfl_xor(bits, 32);
    }
    const float sl = slope2_of(2 + 3 * hd);
    LAS char* lds = (LAS char*)F.lds;
    LAS float* Ost = (LAS float*)(lds + MB_O);
    LAS float* MLst = (LAS float*)(lds + MB_ML);
    LAS unsigned* cnt = (LAS unsigned*)(lds + MB_CNT);
    LAS unsigned char* lst = (LAS unsigned char*)(lds + MB_LST);
    const unsigned koff = (unsigned)WS_Z + (unsigned)b * (SEQ * ZLD * 2u) + (unsigned)(ZD_K + hd * 64) * 2u, voff = (unsigned)WS_Z + (unsigned)b * (SEQ * ZLD * 2u) + (unsigned)(ZD_V + hd * 64) * 2u;
    if (F.tid < 32) cnt[F.tid] = 0u;
    {
        SM st; fa::sm_init(st);
        fa::fa_loop<64, true>(st, qf, ws, koff, ZLD * 2u, voff, ZLD * 2u, SEQ - 1, 4,
            [=](int t) { return q0 + 64 * t; },
            [=](int t, bool& act, bool& ew, float& cb, int& lo, int& hi) { const int key0 = q0 + 64 * t; act = key0 <= wq0 + 31; ew = key0 + 63 > wq0; cb = sl * (float)(64 * t + 4 * h); lo = -100000; hi = tq - key0; },
            sl, lds + FA_STAGES, F.tid, F.lane);
        const float lt = fa::xhalf_sum(st.l);
        LAS float* orow = Ost + (32 * F.wave + r) * MB_OS;
#pragma unroll
        for (int db = 0; db < 2; ++db)
#pragma unroll
            for (int g = 0; g < 4; ++g)
#pragma unroll
                for (int e = 0; e < 4; ++e) orow[32 * db + 8 * g + 4 * h + e] = st.o[db][4 * g + e];
        if (h == 0) { MLst[(32 * F.wave + r) * 2] = st.m; MLst[(32 * F.wave + r) * 2 + 1] = lt; }
    }
    if (h == 0) { unsigned bb = bits;
        while (bb) { const int j = __ffs(bb) - 1; bb &= bb - 1u; const unsigned slot = __hip_atomic_fetch_add(&cnt[j], 1u, __ATOMIC_RELAXED, __HIP_MEMORY_SCOPE_WORKGROUP); lst[j * 256 + slot] = (unsigned char)(32 * F.wave + r); } }
    LDS_WAIT(); __syncthreads();
    if (i > 0) {
        LAS unsigned* PS = (LAS unsigned*)(lds + MB_PS);
        LAS float* PM = (LAS float*)(lds + MB_PM);
        const unsigned qbase = (unsigned)WS_Z + (unsigned)(b * SEQ + q0) * (ZLD * 2u) + (unsigned)(ZD_Q + hd * 64) * 2u;
        const int tt = F.wave & 3, g4 = F.wave >> 2;
        fa::Stg<64> s0, s1, s2, s3;
#define MB_LOADBLK(J) { fa::stg_load<64>(s0, ws, koff, ZLD * 2u, voff, ZLD * 2u, 256 * (J), SEQ - 1, F.tid); fa::stg_load<64>(s1, ws, koff, ZLD * 2u, voff, ZLD * 2u, 256 * (J) + 64, SEQ - 1, F.tid); \
                        fa::stg_load<64>(s2, ws, koff, ZLD * 2u, voff, ZLD * 2u, 256 * (J) + 128, SEQ - 1, F.tid); fa::stg_load<64>(s3, ws, koff, ZLD * 2u, voff, ZLD * 2u, 256 * (J) + 192, SEQ - 1, F.tid); }
        MB_LOADBLK(0)
        const int ql = 8 * tt + (F.lane >> 3), l7 = F.lane & 7;
        for (int j = 0; j < i; ++j) {
            const int n = (int)cnt[j];
            bool myact = 32 * g4 < n, colv = (32 * g4 + r) < n; int qsel = colv ? (int)lst[j * 256 + 32 * g4 + r] : 0;
            bf16x8 qfb[4] = {qf[0], qf[1], qf[2], qf[3]};
            if (myact) fa::load_q<64>(qfb, ws, qbase + (unsigned)qsel * (ZLD * 2u), h);
            fa::stg_store<64>(s0, lds + MB_T, F.tid); fa::stg_store<64>(s1, lds + MB_T + 16384, F.tid); fa::stg_store<64>(s2, lds + MB_T + 32768, F.tid); fa::stg_store<64>(s3, lds + MB_T + 49152, F.tid);
            if (j + 1 < i) MB_LOADBLK(j + 1)
            LDS_WAIT(); __syncthreads();
            for (int rd = 0; 64 * rd < n; ++rd) {
                const int grp = 2 * rd + g4;
                if (rd > 0) { LDS_WAIT(); __syncthreads();
                    myact = 32 * grp < n; colv = (32 * grp + r) < n; qsel = colv ? (int)lst[j * 256 + 32 * grp + r] : 0;
                    if (myact) fa::load_q<64>(qfb, ws, qbase + (unsigned)qsel * (ZLD * 2u), h); }
                const bool two = 32 * (2 * rd + 1) < n;
                const bool fv = (32 * grp + ql) < n; const int qs = fv ? (int)lst[j * 256 + 32 * grp + ql] : 0;
                const float ms = MLst[qs * 2], ls = MLst[qs * 2 + 1];
                LAS float* orow = Ost + qs * MB_OS + 8 * l7;
                float acc8[8];
#pragma unroll
                for (int x = 0; x < 8; ++x) acc8[x] = orow[x];
                SM st; fa::sm_init(st); float lp = 0.f;
                if (myact) {
                    const LAS char* buf = lds + MB_T + tt * 16384;
                    fa::f32x16 p0, p1; bf16x8 pf[4];
                    fa::score_tile<64, true>(p0, p1, buf, qfb, colv ? sl * (float)(256 * j + 64 * tt - q0 + 4 * h) : fa::MASKV, sl, F.lane);
                    fa::sm_step(st, p0, p1, pf);
                    fa::pv(st.o, buf + 8192, pf, F.lane);
                    lp = fa::xhalf_sum(st.l);
                }
#pragma unroll 1
                for (int ph = 0; ph < 2; ++ph) {
                    if (ph == 1 && !two) break;
                    if (ph == 1) { LDS_WAIT(); __syncthreads(); }
                    if (g4 == ph && myact) {
                        LAS unsigned* ps = PS + (tt * 32 + r) * 33 + 2 * h;
#pragma unroll
                        for (int db = 0; db < 2; ++db)
#pragma unroll
                            for (int g = 0; g < 4; ++g) { ps[16 * db + 4 * g] = fa::cvtpk(st.o[db][4 * g], st.o[db][4 * g + 1]); ps[16 * db + 4 * g + 1] = fa::cvtpk(st.o[db][4 * g + 2], st.o[db][4 * g + 3]); }
                        if (h == 0) { PM[(tt * 32 + r) * 2] = st.m; PM[(tt * 32 + r) * 2 + 1] = lp; }
                    }
                    LDS_WAIT(); __syncthreads();
                    if (g4 == ph && fv) {
                        const float m0 = PM[ql * 2], l0 = PM[ql * 2 + 1], m1 = PM[(32 + ql) * 2], l1 = PM[(32 + ql) * 2 + 1], m2 = PM[(64 + ql) * 2], l2 = PM[(64 + ql) * 2 + 1], m3 = PM[(96 + ql) * 2], l3 = PM[(96 + ql) * 2 + 1];
                        const float mn = fmaxf(fmaxf(fmaxf(m0, m1), fmaxf(m2, m3)), ms);
                        const float ea = fa::ex2(ms - mn), e0 = fa::ex2(m0 - mn), e1 = fa::ex2(m1 - mn), e2 = fa::ex2(m2 - mn), e3 = fa::ex2(m3 - mn);
                        const LAS unsigned* pr = PS + ql * 33 + 4 * l7;
#pragma unroll
                        for (int x = 0; x < 4; ++x) { const unsigned w0 = pr[x], w1 = pr[32 * 33 + x], w2 = pr[64 * 33 + x], w3 = pr[96 * 33 + x];
                            orow[2 * x] = acc8[2 * x] * ea + ((__uint_as_float(w0 << 16) * e0 + __uint_as_float(w1 << 16) * e1) + (__uint_as_float(w2 << 16) * e2 + __uint_as_float(w3 << 16) * e3));
                            orow[2 * x + 1] = acc8[2 * x + 1] * ea + ((__uint_as_float(w0 & 0xffff0000u) * e0 + __uint_as_float(w1 & 0xffff0000u) * e1) + (__uint_as_float(w2 & 0xffff0000u) * e2 + __uint_as_float(w3 & 0xffff0000u) * e3)); }
                        if (l7 == 0) { MLst[qs * 2] = mn; MLst[qs * 2 + 1] = ls * ea + ((l0 * e0 + l1 * e1) + (l2 * e2 + l3 * e3)); }
                    }
                }
            }
        }
#undef MB_LOADBLK
        LDS_WAIT(); __syncthreads();
#if FA_PROBE == 9
        if (F.lane == 0 && F.wave == FA_KO) { unsigned long long* pp = (unsigned long long*)((GAS char*)ws + 32768);
            atomicAdd(pp + 0, pq0); atomicAdd(pp + 1, pq1); atomicAdd(pp + 2, pq2); atomicAdd(pp + 3, pqn); atomicAdd(pp + 4, pq3); }
#endif
    }
    { const int q = 32 * F.wave + (F.lane >> 1), hf = F.lane & 1; const float inv = 1.f / fmaxf(MLst[q * 2 + 1], fa::TINYF);
      const LAS float* orow = Ost + q * MB_OS + 32 * hf;
      GAS char* dst = ws + ((unsigned)WS_O + (unsigned)(b * SEQ + q0 + q) * 2048u + (unsigned)(768 + hd * 64 + 32 * hf) * 2u);
#pragma unroll
      for (int c = 0; c < 4; ++c) { float x[8];
#pragma unroll
          for (int e = 0; e < 8; ++e) x[e] = orow[8 * c + e] * inv;
          fa::u32x4 w; w.x = fa::cvtpk(x[0], x[1]); w.y = fa::cvtpk(x[2], x[3]); w.z = fa::cvtpk(x[4], x[5]); w.w = fa::cvtpk(x[6], x[7]);
          *(GAS fa::u32x4*)(dst + 16 * c) = w; } }
    LDS_WAIT(); __syncthreads();
}
__device__ __forceinline__ void u_swa(const Frame& F0, int b, int kvh, int u, const float* sinks) {
    UNIT_BEGIN();
    GAS char* ws = (GAS char*)F.ws;
    const int r = F.lane & 31, h = F.lane >> 5, q0 = 128 * u, wq0 = q0 + 16 * F.wave, tq = wq0 + (r >> 1), hd = kvh * 2 + (r & 1);
    bf16x8 qf[4]; fa::load_q<64>(qf, ws, (unsigned)WS_Z + (unsigned)(b * SEQ + tq) * (ZLD * 2u) + (unsigned)(ZA_Q + hd * 64) * 2u, h);
    const float sl = slope2_of(3 * hd);
    const int t0 = (2 * u - 2) > 0 ? (2 * u - 2) : 0, nt = 2 * u + 2 - t0;
    SM st; fa::sm_init(st);
    LAS char* lds = (LAS char*)F.lds;
    fa::fa_loop<64, true>(st, qf, ws, (unsigned)WS_Z + (unsigned)b * (SEQ * ZLD * 2u) + (unsigned)(ZA_K + kvh * 64) * 2u, ZLD * 2u, (unsigned)WS_Z + (unsigned)b * (SEQ * ZLD * 2u) + (unsigned)(ZA_V + kvh * 64) * 2u, ZLD * 2u, SEQ - 1, nt,
        [=](int t) { return 64 * (t0 + t); },
        [=](int t, bool& act, bool& ew, float& cb, int& lo, int& hi) { const int key0 = 64 * (t0 + t); act = (key0 <= wq0 + 15) && (key0 + 63 >= wq0 - 127); ew = true;
            cb = sl * (float)(key0 - q0 + 4 * h); lo = tq - 127 - key0; hi = tq - key0; },
        sl, lds + FA_STAGES, F.tid, F.lane);
    const float sk = sinks[hd] * LOG2E + sl * (float)(tq - q0), mf = fmaxf(st.m, sk), a = fa::ex2(st.m - mf);
    const float ltot = fa::xhalf_sum(st.l) * a + fa::ex2(sk - mf), inv = a / fmaxf(ltot, fa::TINYF);
    f32x16 acc[2]; acc[0] = st.o[0] * inv; acc[1] = st.o[1] * inv;
    fa::store_out(acc, lds + FA_OST + F.wave * 32 * fa::OSTR, ws, [=](int col) { return (unsigned)WS_O + (unsigned)(b * SEQ + wq0 + (col >> 1)) * 2048u + (unsigned)((kvh * 2 + (col & 1)) * 64) * 2u; }, F.lane);
}
__device__ __forceinline__ void u_nsa(const Frame& F0, int b, int qi) {
    UNIT_BEGIN();
    GAS char* ws = (GAS char*)F.ws;
    const unsigned KC = (unsigned)WS_KCMP + (unsigned)b * (512u * 128u), VC = (unsigned)WS_VCMP + (unsigned)b * (512u * 128u), ZB = (unsigned)WS_Z + (unsigned)b * (SEQ * ZLD * 2u);
    const int r = F.lane & 31, h = F.lane >> 5, q0 = 64 * qi, wq0 = q0 + 8 * F.wave, qloc = 8 * F.wave + (r >> 2), tq = q0 + qloc, hd = r & 3;
    const unsigned zrow_off = ZB + (unsigned)tq * (ZLD * 2u); const GAS bf16* zrow = (const GAS bf16*)(ws + zrow_off);
    bf16x8 qf[4]; fa::load_q<64>(qf, ws, zrow_off + (unsigned)(ZC_Q + hd * 64) * 2u, h);
    const float sl = slope2_of(1 + 3 * hd);
    const float g0 = 1.f / (1.f + __expf(-bf2f(zrow[ZC_GL + hd]))), g1 = 1.f / (1.f + __expf(-bf2f(zrow[ZC_GL + 4 + hd]))), g2 = 1.f / (1.f + __expf(-bf2f(zrow[ZC_GL + 8 + hd])));
    LAS char* lds = (LAS char*)F.lds;
    LAS float* impA = (LAS float*)(lds + FA_IMP) + F.wave * 1024;
    LAS float* impB = (LAS float*)(lds + FA_OST) + F.wave * 1024;
    LAS unsigned* selm = (LAS unsigned*)(lds + FA_SELM);
    LAS unsigned* um = (LAS unsigned*)(lds + FA_UM);
    LAS float* vals = (LAS float*)(lds + FA_VALS) + F.wave * 128;
    if (F.tid < 4) um[F.tid] = 0u;
    const unsigned parko = (unsigned)WS_PARK + (unsigned)((F.bx * NWAVES + F.wave) * 2 * 32 * 64 + F.lane) * 4u;
#define PARK(i) (*(GAS float*)(ws + (parkl + (unsigned)((i) * 256))))
    const int ntc = ((4 * qi + 3) >> 6) + 1;
    const int cvis = (tq - 31) >> 4;
    const int cvis_min = (q0 - 31) >> 4;
    const float slc = 16.f * sl;
    SM st; fa::sm_init(st);
    fa::fa_loop<64, true>(st, qf, ws, KC, 128u, VC, 128u, 510, ntc,
        [](int t) { return 64 * t; },
        [=](int t, bool& act, bool& ew, float& cb, int& lo, int& hi) { const int c0 = 64 * t; act = true; ew = c0 + 63 > cvis_min; cb = slc * (float)(c0 - 4 * qi + 4 * h); lo = -100000; hi = cvis - c0; },
        slc, lds + FA_STAGES, F.tid, F.lane);
    { f32x16 t2[2] = {f32x16{}, f32x16{}}; fa::sm_finish(st, g0, t2); unsigned parkl = parko; asm volatile("" : "+v"(parkl));
#pragma unroll
      for (int v = 0; v < 16; ++v) { PARK(v) = t2[0][v]; PARK(16 + v) = t2[1][v]; } }
    {
        const float mfin = st.m, invl = 1.f / fmaxf(fa::xhalf_sum(st.l), fa::TINYF);
        constexpr int STG = fa::stage_bytes<64>();
        fa::Stg<64> sg;
        fa::stg_load<64>(sg, ws, KC, 128u, VC, 128u, 0, 510, F.tid); fa::stg_store<64>(sg, lds + FA_STAGES, F.tid); __syncthreads();
        for (int t = 0; t < ntc; ++t) {
            const LAS char* buf = lds + FA_STAGES + (t & 1) * STG;
            if (t + 1 < ntc) fa::stg_load<64>(sg, ws, KC, 128u, VC, 128u, 64 * (t + 1), 510, F.tid);
            const int c0 = 64 * t;
            f32x16 p0, p1; fa::score_tile<64, true>(p0, p1, buf, qf, slc * (float)(c0 - 4 * qi + 4 * h), slc, F.lane);
            if (c0 + 63 > cvis_min) fa::mask_ew(p0, p1, -100000, cvis - c0, h);
#pragma unroll
            for (int kh = 0; kh < 2; ++kh)
#pragma unroll
                for (int g = 0; g < 4; ++g) {
                    float e0, e1, e2, e3;
                    if (kh == 0) { e0 = fa::ex2(p0[4 * g] - mfin); e1 = fa::ex2(p0[4 * g + 1] - mfin); e2 = fa::ex2(p0[4 * g + 2] - mfin); e3 = fa::ex2(p0[4 * g + 3] - mfin); }
                    else { e0 = fa::ex2(p1[4 * g] - mfin); e1 = fa::ex2(p1[4 * g + 1] - mfin); e2 = fa::ex2(p1[4 * g + 2] - mfin); e3 = fa::ex2(p1[4 * g + 3] - mfin); }
                    e0 *= invl; e1 *= invl; e2 *= invl; e3 *= invl;
                    float s4 = ((e0 + e1) + e2) + e3;
                    s4 += __shfl_xor(s4, 1); s4 += __shfl_xor(s4, 2); e3 += __shfl_xor(e3, 1); e3 += __shfl_xor(e3, 2);
                    const int j = 16 * t + 8 * kh + 2 * g + h;
                    if (hd == 0) { impA[(r >> 2) * 128 + j] = s4; impB[(r >> 2) * 128 + j] = e3; }
                }
            if (t + 1 < ntc) fa::stg_store<64>(sg, lds + FA_STAGES + ((t + 1) & 1) * STG, F.tid);
            __syncthreads();
        }
    }
    {
        const int cur = qi;
        for (int qq = 0; qq < 8; ++qq) {
            unsigned long long m0, m1;
            if (cur < 16) { m0 = (cur >= 63) ? ~0ull : ((1ull << (cur + 1)) - 1ull); m1 = 0ull; }
            else {
                const int ja = F.lane, jb2 = F.lane + 64;
                const bool fca = (ja == 0 || ja == cur || ja == cur - 1), fcb = (jb2 == cur || jb2 == cur - 1);
                const float va = impA[qq * 128 + ja] + (ja > 0 ? impB[qq * 128 + ja - 1] : 0.f), vb = impA[qq * 128 + jb2] + impB[qq * 128 + jb2 - 1];
                const unsigned ka = (ja <= cur && !fca) ? (__float_as_uint(va) + 1u) : 0u, kb = (jb2 <= cur && !fcb) ? (__float_as_uint(vb) + 1u) : 0u;
                unsigned T = 0u;
                for (int bit = 31; bit >= 0; --bit) { const unsigned cand = T | (1u << bit); const int c = __popcll(__ballot(ka >= cand)) + __popcll(__ballot(kb >= cand)); if (c >= 13) T = cand; }
                if (T == 0u) T = 1u;
                const unsigned long long ga = __ballot(ka > T), gb = __ballot(kb > T), ea = __ballot(ka == T), eb = __ballot(kb == T);
                const int R = 13 - (__popcll(ga) + __popcll(gb)), na = __popcll(ea);
                const int pa = (int)__builtin_amdgcn_mbcnt_hi((unsigned)(ea >> 32), __builtin_amdgcn_mbcnt_lo((unsigned)ea, 0u)), pb = (int)__builtin_amdgcn_mbcnt_hi((unsigned)(eb >> 32), __builtin_amdgcn_mbcnt_lo((unsigned)eb, 0u));
                m0 = ga | __ballot(ka == T && pa < R) | 1ull; m1 = gb | __ballot(kb == T && (na + pb) < R);
                if (cur < 64) m0 |= 1ull << cur; else m1 |= 1ull << (cur - 64);
                if (cur - 1 < 64) m0 |= 1ull << (cur - 1); else m1 |= 1ull << (cur - 65);
            }
            if (F.lane == 0) { LAS unsigned* sp = selm + (8 * F.wave + qq) * 4; sp[0] = (unsigned)m0; sp[1] = (unsigned)(m0 >> 32); sp[2] = (unsigned)m1; sp[3] = (unsigned)(m1 >> 32);
                __hip_atomic_fetch_or(&um[0], (unsigned)m0, __ATOMIC_RELAXED, __HIP_MEMORY_SCOPE_WORKGROUP); __hip_atomic_fetch_or(&um[1], (unsigned)(m0 >> 32), __ATOMIC_RELAXED, __HIP_MEMORY_SCOPE_WORKGROUP); __hip_atomic_fetch_or(&um[2], (unsigned)m1, __ATOMIC_RELAXED, __HIP_MEMORY_SCOPE_WORKGROUP); __hip_atomic_fetch_or(&um[3], (unsigned)(m1 >> 32), __ATOMIC_RELAXED, __HIP_MEMORY_SCOPE_WORKGROUP); }
        }
        LDS_WAIT(); __syncthreads();
    }
    {
        const unsigned uw0 = um[0], uw1 = um[1], uw2 = um[2], uw3 = um[3];
        const LAS unsigned* selq = selm + qloc * 4;
        const int nsel = __builtin_amdgcn_readfirstlane(__popc(uw0) + __popc(uw1) + __popc(uw2) + __popc(uw3));
        LAS unsigned char* slist = (LAS unsigned char*)(lds + FA_VALS);
        if (F.tid < 128) { const int j = F.tid; const unsigned w = (j < 32) ? uw0 : (j < 64) ? uw1 : (j < 96) ? uw2 : uw3;
            if ((w >> (j & 31)) & 1u) { int pos = __popc(w & ((1u << (j & 31)) - 1u)); if (j >= 32) pos += __popc(uw0); if (j >= 64) pos += __popc(uw1); if (j >= 96) pos += __popc(uw2); slist[pos] = (unsigned char)j; } }
        LDS_WAIT(); __syncthreads();
        fa::sm_init(st);
        fa::fa_loop<64, true>(st, qf, ws, ZB + ZC_KS * 2u, ZLD * 2u, ZB + ZC_VS * 2u, ZLD * 2u, SEQ - 1, nsel,
            [=](int t) { return 64 * (int)slist[t]; },
            [=](int t, bool& act, bool& ew, float& cb, int& lo, int& hi) { const int j = (int)slist[t], key0 = 64 * j; const unsigned mw = selq[j >> 5];
                const bool on = (mw >> (j & 31)) & 1u; act = __any(on) != 0; ew = (j == qi); cb = on ? sl * (float)(key0 - q0 + 4 * h) : fa::MASKV; lo = -100000; hi = tq - key0; },
            sl, lds + FA_STAGES, F.tid, F.lane);
        { f32x16 t2[2] = {f32x16{}, f32x16{}}; fa::sm_finish(st, g1, t2); unsigned parkl = parko; asm volatile("" : "+v"(parkl));
#pragma unroll
          for (int v = 0; v < 16; ++v) { PARK(32 + v) = t2[0][v]; PARK(48 + v) = t2[1][v]; } }
    }
    {
        const int t0 = (qi - 8) > 0 ? (qi - 8) : 0, nt = qi + 1 - t0;
        fa::sm_init(st);
        fa::fa_loop<64, true>(st, qf, ws, ZB + ZC_KW * 2u, ZLD * 2u, ZB + ZC_VW * 2u, ZLD * 2u, SEQ - 1, nt,
            [=](int t) { return 64 * (t0 + t); },
            [=](int t, bool& act, bool& ew, float& cb, int& lo, int& hi) { const int j = t0 + t, key0 = 64 * j; act = true; ew = (j == qi) || (j == qi - 8);
                cb = sl * (float)(key0 - q0 + 4 * h); lo = tq - 511 - key0; hi = tq - key0; },
            sl, lds + FA_STAGES, F.tid, F.lane);
    }
    f32x16 acc[2] = {f32x16{}, f32x16{}}; fa::sm_finish(st, g2, acc); unsigned parkl = parko; asm volatile("" : "+v"(parkl));
#pragma unroll
    for (int v = 0; v < 16; ++v) { acc[0][v] += PARK(v) + PARK(32 + v); acc[1][v] += PARK(16 + v) + PARK(48 + v); }
#undef PARK
    fa::store_out(acc, lds + FA_OST + F.wave * 32 * fa::OSTR, ws, [=](int col) { return (unsigned)WS_O + (unsigned)(b * SEQ + wq0 + (col >> 2)) * 2048u + (unsigned)(512 + (col & 3) * 64) * 2u; }, F.lane);
}

__device__ __forceinline__ void p_attn(Frame& F, const float* sinks, int mskip) {
    const int id = F.vcu;
    if (F.G != 256) return;
    { const int bh = id >> 4, s = id & 15;
#pragma unroll 1
      for (int k = 0; k < (((mskip >> 9) & 1) ? 4 : 2); ++k) u_mla(F, bh >> 2, bh & 3, (k & 1) ? s : 31 - s); }
    { const int bh = id >> 4, s = id & 15;
#pragma unroll 1
      for (int k = 0; k < (((mskip >> 11) & 1) ? 4 : 2); ++k) u_moba(F, bh >> 2, bh & 3, (k & 1) ? s : 31 - s); }
    if (!(mskip & 4)) { const int b = id >> 6, s = id & 63;
#pragma unroll 1
      for (int k = 0; k < (((mskip >> 10) & 1) ? 4 : 2); ++k) u_nsa(F, b, (k & 1) ? s : 127 - s); }
    {
#pragma unroll 1
      for (int k = 0; k < (((mskip >> 8) & 1) ? 4 : 2); ++k) { const int u0 = 2 * id + (k & 1); u_swa(F, u0 >> 7, (u0 >> 6) & 1, u0 & 63, sinks); } }
}
constexpr int PH_PRO = 0, PH_L0 = 1, PH_PER_L = 9, PH_FIN = 19, PH_END = 20;
constexpr int PO_NORM1 = 0, PO_ZG = 1, PO_PREP = 2, PO_UP = 3, PO_ATTN = 4, PO_OG = 5, PO_NORM2 = 6, PO_UPG = 7, PO_DNG = 8;
#ifndef MK_PHASE_MASK
#define MK_PHASE_MASK 0xFFFFFu
#endif

__global__ void __launch_bounds__(NTHR, 2) mega(Args args) {
    extern __shared__ __attribute__((aligned(16))) unsigned char lds_raw[];
    Frame F;
    F.lds = (LAS unsigned char*)lds_raw;
    int wave_s = __builtin_amdgcn_readfirstlane((int)threadIdx.x >> 6); asm volatile("" : "+s"(wave_s));
    F.tid = threadIdx.x; F.lane = F.tid & 63; F.wave = wave_s;
    F.G = gridDim.x; { const int bx = blockIdx.x; F.vcu = (F.G % 8 == 0) ? (bx % 8) * (F.G / 8) + bx / 8 : bx; }
    volatile LAS unsigned* misc = (volatile LAS unsigned*)(F.lds + LDS_MISC);
    if (F.tid < 64) misc[F.tid] = 0u;
    __syncthreads();
    (void)xcd_barrier_post((unsigned*)(args.ws + WS_CTL), misc + 8);
    float* fo; KArgsP ap;
#define KARGS() ({ KArgsP q_ = (KArgsP)__builtin_amdgcn_kernarg_segment_ptr(); asm volatile("" : "+s"(q_)); q_; })
#define IN(k) ({ KArgsP q2_ = KARGS(); q2_->ph_lo <= (k) && (k) < q2_->ph_hi; })
#define PHASE_BEGIN() do { asm volatile("; PHASE_MARK %0" :: "i"(__LINE__)); ap = KARGS(); F.G = gridDim.x; \
        { int w_ = wave_s; asm volatile("" : "+s"(w_)); int t_ = (w_ << 6) | (int)__builtin_amdgcn_mbcnt_hi(~0u, __builtin_amdgcn_mbcnt_lo(~0u, 0u)); asm volatile("" : "+v"(t_)); F.tid = t_; F.lane = t_ & 63; F.wave = w_; } F.ws = ap->ws; int bx_ = (int)blockIdx.x; asm volatile("" : "+s"(bx_)); F.bx = bx_; F.vcu = (F.G % 8 == 0) ? (bx_ % 8) * (F.G / 8) + bx_ / 8 : bx_; fo = ap->out; } while (0)
#define INP(i) (ap->in[i])
#define SEAM(k) do { if (IN(k) && IN((k) + 1)) { XcdBarrier b_; b_.bar = (unsigned*)(KARGS()->ws + WS_CTL); b_.x = xb_xcc_id(); b_.st = (volatile LAS unsigned*)(F.lds + LDS_MISC) + 8; xcd_barrier(b_); } } while (0)

    if (IN(PH_PRO)) { PHASE_BEGIN(); p_prologue(F, ap); }
#ifdef MK_PRO_TWICE
    if (IN(PH_PRO)) { PHASE_BEGIN(); p_prologue(F, ap); }
#endif
    SEAM(PH_PRO);

    { constexpr int l = 0;
        const int pb = PH_L0 + PH_PER_L * l;
#define WB (F.ws + WS_W + (size_t)l * WS_WL)
#define MOD ((const float*)(F.ws + WS_MOD) + (size_t)l * NB * 6 * D)
#define XB ((bf16*)(F.ws + WS_XB))
#define XIN ((l == 0) ? (const void*)INP(0) : (const void*)XB)
#define H ((bf16*)(F.ws + WS_H))
#define Z ((bf16*)(F.ws + WS_Z))
#define OB ((bf16*)(F.ws + WS_O))
#define U ((bf16*)(F.ws + WS_U))

        if (IN(pb + PO_NORM1) && !((KARGS()->skip >> PO_NORM1) & 1)) { PHASE_BEGIN(); p_norm<0, (l != 0)>(F, XIN, INP(2) + l * D, MOD, MOD + D, H, nullptr); }
        SEAM(pb + PO_NORM1);

        if (IN(pb + PO_ZG) && !((KARGS()->skip >> PO_ZG) & 1)) { PHASE_BEGIN();
            pg8::Gemm g{H, (const bf16*)(WB + W_IN), M, ZLD, D, D}; pg8::StaticOrder S; S.init(M, ZLD, F.G, F.bx);
            pg8::EpiBf16<0> E{Z, ZLD, nullptr, 0, 0, 1.f};
            pg8::gemm_phase<pg8::EpiBf16<0>, pg8::StaticOrder, true, true>(F.lds, g, S, E, F.tid);
        }
        SEAM(pb + PO_ZG);

        if (IN(pb + PO_PREP) && !((KARGS()->skip >> PO_PREP) & 1)) { PHASE_BEGIN(); p_prep(F, l); }
        SEAM(pb + PO_PREP);

        if (IN(pb + PO_UP) && !((KARGS()->skip >> PO_UP) & 1)) { PHASE_BEGIN();
            { pg8::Gemm g{Z + ZB_CQ, (const bf16*)(WB + W_UQ), M, 512, 256, ZLD}; pg8::StaticOrder S; S.init(M, 512, F.G, F.bx);
              pg8::EpiBf16<0> E{(bf16*)(F.ws + WS_QM), 512, nullptr, 0, 0, 1.f};
              pg8::gemm_phase<pg8::EpiBf16<0>, pg8::StaticOrder, true, true>(F.lds, g, S, E, F.tid); }
            PHASE_BEGIN();
            { pg8::Gemm g{Z + ZB_CKV, (const bf16*)(WB + W_UKV), M, 512, 256, ZLD}; pg8::StaticOrder S; S.init(M, 512, F.G, F.bx);
              pg8::EpiMlaKV E{(bf16*)(F.ws + WS_KM), (bf16*)(F.ws + WS_VM), (const float*)(F.ws + WS_RSKV)};
              pg8::gemm_phase<pg8::EpiMlaKV, pg8::StaticOrder, true, false>(F.lds, g, S, E, F.tid); }
            PHASE_BEGIN();
            p_compress(F, l);
        }
        SEAM(pb + PO_UP);

        if (IN(pb + PO_ATTN) && !((KARGS()->skip >> PO_ATTN) & 1)) { PHASE_BEGIN(); p_attn(F, INP(8) + l * 4, (ap->skip >> 16) | ((ap->rep >> 20) << 8)); }
        SEAM(pb + PO_ATTN);

        if (IN(pb + PO_OG) && !((KARGS()->skip >> PO_OG) & 1)) { PHASE_BEGIN();
            pg8::Gemm g{OB, (const bf16*)(WB + W_OUT), M, D, D, D}; pg8::StaticOrder S; S.init(M, D, F.G, F.bx);
            pg8::EpiResid<(l != 0)> E{XIN, XB, MOD + 2 * D};
            pg8::gemm_phase<pg8::EpiResid<(l != 0)>, pg8::StaticOrder, true, true>(F.lds, g, S, E, F.tid);
        }
        SEAM(pb + PO_OG);

        if (IN(pb + PO_NORM2) && !((KARGS()->skip >> PO_NORM2) & 1)) { PHASE_BEGIN(); p_norm<0, true>(F, XB, INP(3) + l * D, MOD + 3 * D, MOD + 4 * D, H, nullptr); }
        SEAM(pb + PO_NORM2);

        if (IN(pb + PO_UPG) && !((KARGS()->skip >> PO_UPG) & 1)) { PHASE_BEGIN();
            pg8::Gemm g{H, (const bf16*)(WB + W_UP), M, DFF, D, D}; pg8::StaticOrder S; S.init(M, DFF, F.G, F.bx);
            pg8::EpiRelu2 E{U, DFF};
            pg8::gemm_phase<pg8::EpiRelu2, pg8::StaticOrder, true, true>(F.lds, g, S, E, F.tid);
        }
        SEAM(pb + PO_UPG);

        if (IN(pb + PO_DNG) && !((KARGS()->skip >> PO_DNG) & 1)) { PHASE_BEGIN();
            pg8::Gemm g{U, (const bf16*)(WB + W_DN), M, D, DFF, DFF}; pg8::StaticOrder S; S.init(M, D, F.G, F.bx);
            pg8::EpiResid<true> E{XB, XB, MOD + 5 * D};
            pg8::gemm_phase<pg8::EpiResid<true>, pg8::StaticOrder, true, true>(F.lds, g, S, E, F.tid);
        }
        SEAM(pb + PO_DNG);
    }
    { constexpr int l = 1;
        const int pb = PH_L0 + PH_PER_L * l;
#define WB (F.ws + WS_W + (size_t)l * WS_WL)
#define MOD ((const float*)(F.ws + WS_MOD) + (size_t)l * NB * 6 * D)
#define XB ((bf16*)(F.ws + WS_XB))
#define XIN ((l == 0) ? (const void*)INP(0) : (const void*)XB)
#define H ((bf16*)(F.ws + WS_H))
#define Z ((bf16*)(F.ws + WS_Z))
#define OB ((bf16*)(F.ws + WS_O))
#define U ((bf16*)(F.ws + WS_U))

        if (IN(pb + PO_NORM1) && !((KARGS()->skip >> PO_NORM1) & 1)) { PHASE_BEGIN(); p_norm<0, (l != 0)>(F, XIN, INP(2) + l * D, MOD, MOD + D, H, nullptr); }
        SEAM(pb + PO_NORM1);

        if (IN(pb + PO_ZG) && !((KARGS()->skip >> PO_ZG) & 1)) { PHASE_BEGIN();
            pg8::Gemm g{H, (const bf16*)(WB + W_IN), M, ZLD, D, D}; pg8::StaticOrder S; S.init(M, ZLD, F.G, F.bx);
            pg8::EpiBf16<0> E{Z, ZLD, nullptr, 0, 0, 1.f};
            pg8::gemm_phase<pg8::EpiBf16<0>, pg8::StaticOrder, true, true>(F.lds, g, S, E, F.tid);
        }
        SEAM(pb + PO_ZG);

        if (IN(pb + PO_PREP) && !((KARGS()->skip >> PO_PREP) & 1)) { PHASE_BEGIN(); p_prep(F, l); }
        SEAM(pb + PO_PREP);

        if (IN(pb + PO_UP) && !((KARGS()->skip >> PO_UP) & 1)) { PHASE_BEGIN();
            { pg8::Gemm g{Z + ZB_CQ, (const bf16*)(WB + W_UQ), M, 512, 256, ZLD}; pg8::StaticOrder S; S.init(M, 512, F.G, F.bx);
              pg8::EpiBf16<0> E{(bf16*)(F.ws + WS_QM), 512, nullptr, 0, 0, 1.f};
              pg8::gemm_phase<pg8::EpiBf16<0>, pg8::StaticOrder, true, true>(F.lds, g, S, E, F.tid); }
            PHASE_BEGIN();
            { pg8::Gemm g{Z + ZB_CKV, (const bf16*)(WB + W_UKV), M, 512, 256, ZLD}; pg8::StaticOrder S; S.init(M, 512, F.G, F.bx);
              pg8::EpiMlaKV E{(bf16*)(F.ws + WS_KM), (bf16*)(F.ws + WS_VM), (const float*)(F.ws + WS_RSKV)};
              pg8::gemm_phase<pg8::EpiMlaKV, pg8::StaticOrder, true, false>(F.lds, g, S, E, F.tid); }
            PHASE_BEGIN();
            p_compress(F, l);
        }
        SEAM(pb + PO_UP);

        if (IN(pb + PO_ATTN) && !((KARGS()->skip >> PO_ATTN) & 1)) { PHASE_BEGIN(); p_attn(F, INP(8) + l * 4, (ap->skip >> 16) | ((ap->rep >> 20) << 8)); }
        SEAM(pb + PO_ATTN);

        if (IN(pb + PO_OG) && !((KARGS()->skip >> PO_OG) & 1)) { PHASE_BEGIN();
            pg8::Gemm g{OB, (const bf16*)(WB + W_OUT), M, D, D, D}; pg8::StaticOrder S; S.init(M, D, F.G, F.bx);
            pg8::EpiResid<(l != 0)> E{XIN, XB, MOD + 2 * D};
            pg8::gemm_phase<pg8::EpiResid<(l != 0)>, pg8::StaticOrder, true, true>(F.lds, g, S, E, F.tid);
        }
        SEAM(pb + PO_OG);

        if (IN(pb + PO_NORM2) && !((KARGS()->skip >> PO_NORM2) & 1)) { PHASE_BEGIN(); p_norm<0, true>(F, XB, INP(3) + l * D, MOD + 3 * D, MOD + 4 * D, H, nullptr); }
        SEAM(pb + PO_NORM2);

        if (IN(pb + PO_UPG) && !((KARGS()->skip >> PO_UPG) & 1)) { PHASE_BEGIN();
            pg8::Gemm g{H, (const bf16*)(WB + W_UP), M, DFF, D, D}; pg8::StaticOrder S; S.init(M, DFF, F.G, F.bx);
            pg8::EpiRelu2 E{U, DFF};
            pg8::gemm_phase<pg8::EpiRelu2, pg8::StaticOrder, true, true>(F.lds, g, S, E, F.tid);
        }
        SEAM(pb + PO_UPG);

        if (IN(pb + PO_DNG) && !((KARGS()->skip >> PO_DNG) & 1)) { PHASE_BEGIN();
            pg8::Gemm g{U, (const bf16*)(WB + W_DN), M, D, DFF, DFF}; pg8::StaticOrder S; S.init(M, D, F.G, F.bx);
            pg8::EpiResid<true> E{XB, XB, MOD + 5 * D};
            pg8::gemm_phase<pg8::EpiResid<true>, pg8::StaticOrder, true, true>(F.lds, g, S, E, F.tid);
        }
        SEAM(pb + PO_DNG);
    }
    if (IN(PH_FIN)) { PHASE_BEGIN(); p_norm<1, true>(F, (const void*)(F.ws + WS_XB), INP(21), nullptr, nullptr, nullptr, fo); }
#undef IN
#undef SEAM
}
}
extern "C" void kernel_launch(void* const* d_in, const int* in_sizes, int n_in, void* d_out, int out_size, void* d_ws, size_t ws_size, hipStream_t stream) {
    using namespace mk;
    static int grid = 0;
    if (grid == 0) {
        int dev = 0, cus = 0;
        if (hipGetDevice(&dev) != hipSuccess || hipDeviceGetAttribute(&cus, hipDeviceAttributeMultiprocessorCount, dev) != hipSuccess) { grid = -1; return; }
        if (hipFuncSetAttribute((const void*)mega, hipFuncAttributeMaxDynamicSharedMemorySize, LDS_BYTES) != hipSuccess) { grid = -1; return; }
        (void)hipGetLastError();
        grid = cus;
    }
    if (grid < 0) return;
    (void)in_sizes; (void)n_in; (void)out_size; (void)ws_size;
    Args a{};
    for (int i = 0; i < 22; ++i) a.in[i] = (const float*)d_in[i];
    a.out = (float*)d_out; a.ws = (unsigned char*)d_ws; a.skip = 0; a.rep = MK_REP;
    auto launch = [&](int lo, int hi) {
        (void)hipMemsetAsync((char*)d_ws + WS_CTL, 0, CTL_ZERO_BYTES, stream);
        a.ph_lo = lo; a.ph_hi = hi;
        hipLaunchKernelGGL(mega, dim3(grid), dim3(NTHR), LDS_BYTES, stream, a);
    };
    launch(0, PH_END);
}
```

```cpp
#include <hip/hip_runtime.h>
#include <cstdio>
#include <cstdint>
#include <math.h>
#define MK_PQ 500.0
#define FA_EXP 2
#define FA_PROBE 0
#define MK_PROBE_IDX 0
#define FA_KO 0
#define MK_MODE 0
#define MK_NAIVE_MASK 0
#define MK_SKIP 0
#define MK_SPLIT 0
#define MK_DBG_PHASE 0
#define MK_DBG_TEST 0
#define MK_REP 0
namespace pg8 {
#define PG8_LAS __attribute__((address_space(3)))
typedef unsigned short bf16_t;
typedef short bf16x8 __attribute__((ext_vector_type(8)));
typedef float f32x4 __attribute__((ext_vector_type(4)));
typedef unsigned u32x4 __attribute__((ext_vector_type(4)));
constexpr int BM = 256, BK = 64, HALF = 128, HTB = HALF * BK * 2  , STAGE_BYTES = 8 * HTB, NXCD = 8, WGM = 8;

__host__ __device__ __forceinline__ int lds_byte(int r, int c) { const int st = (r >> 4) * 2 + (c >> 5), rr = r & 15, cc = c & 31, ob = rr * 64 + cc * 2; return st * 1024 + (ob ^ (((ob >> 9) & 1) << 5)); }
__host__ __device__ __forceinline__ void stage_rc(int b, int& R, int& C) { const int st = b / 1024, sb = b % 1024, swz = sb ^ (((sb >> 9) & 1) << 5); R = (st >> 1) * 16 + swz / 64; C = (st & 1) * 32 + (swz % 64) / 2; }
__host__ __device__ __forceinline__ int perm32(int rho) { const int n = rho >> 4, i = rho & 15; return 8 * (i >> 2) + 4 * n + (i & 3); }

struct Unit { int pm, pn; };
struct Gemm { const bf16_t* A; const bf16_t* Bt; int M, N, K, lda; };

struct StaticOrder {
    int nM, nN, nwg, G, c;
    __host__ __device__ void init(int M, int N, int G_, int c_) { nM = M / BM; nN = N / BM; nwg = nM * nN; G = G_; c = c_; }
    __host__ __device__ bool next(int i, Unit& u) const {
        const long L = (long)i * G + c; if (L >= nwg) return false;
        int wgid = (int)L; { const int q = nwg / NXCD, r = nwg % NXCD, xcd = wgid % NXCD, off = wgid / NXCD; wgid = (xcd < r ? xcd * (q + 1) : r * (q + 1) + (xcd - r) * q) + off; }
        const int nig = WGM * nN, gid = wgid / nig, fm = gid * WGM, gsz = (nM - fm) < WGM ? (nM - fm) : WGM;
        u.pm = fm + ((wgid % nig) % gsz); u.pn = (wgid % nig) / gsz; return true;
    }
    __device__ __forceinline__ void a_ready(const Unit&) const {}
    __device__ __forceinline__ void done(const Unit&) const {}
};
__device__ __forceinline__ unsigned cvt_pk_bf16(float lo, float hi) { unsigned r; asm volatile("v_cvt_pk_bf16_f32 %0, %1, %2" : "=v"(r) : "v"(lo), "v"(hi)); return r; }
typedef float f32x2 __attribute__((ext_vector_type(2)));
__device__ __forceinline__ f32x2 gelu_pk(f32x2 v) {
    const f32x2 av = __builtin_elementwise_abs(v), d = av * 0.2316418882f + 1.0f;
    f32x2 t; t.x = __builtin_amdgcn_rcpf(d.x); t.y = __builtin_amdgcn_rcpf(d.y);
    f32x2 q = t * 0.5307027145f + (-0.7265760135f); q = q * t + 0.7107068705f; q = q * t + (-0.142248368f); q = q * t + 0.127414796f; q = q * t;
    const f32x2 s = (v * v) * (-0.72134752044f);
    f32x2 e; e.x = __builtin_amdgcn_exp2f(s.x); e.y = __builtin_amdgcn_exp2f(s.y);
    const f32x2 m = v * (q * e), r = v - m;
    f32x2 o; o.x = v.x < 0.f ? m.x : r.x; o.y = v.y < 0.f ? m.y : r.y; return o;
}

template <int ACT  > struct EpiBf16 {
    static constexpr bool PERM = true, AFTER_DRAIN = false; static_assert(ACT == 0 || ACT == 1, "EpiBf16: ACT is 0 (none) or 1 (gelu_pk)");
    bf16_t* O; int ldc; const float* bias; int split_cols; size_t split_stride; float scale0;
    __device__ __forceinline__ void operator()(const f32x4 (&acc)[2][2][4][2], const Unit& u, int wr, int wc, int fr, int fq) const {
        const int row0 = u.pm * BM + wr * 64 + fr; int colt = u.pn * BM; bf16_t* base = O;
        float sc = 1.f; if (split_cols) { const int t = colt / split_cols; base += (size_t)t * split_stride; colt -= t * split_cols; if (t == 0) sc = scale0; }
        const int col0 = colt + wc * 32 + 8 * fq, bcol0 = u.pn * BM + wc * 32 + 8 * fq;
        f32x4 bv[2][2];
#pragma unroll
        for (int bj = 0; bj < 2; ++bj)
#pragma unroll
            for (int n = 0; n < 2; ++n) bv[bj][n] = bias ? *(const f32x4*)(bias + bcol0 + bj * HALF + 4 * n) : (f32x4){0.f, 0.f, 0.f, 0.f};
#pragma unroll
        for (int ai = 0; ai < 2; ++ai)
#pragma unroll
            for (int m = 0; m < 4; ++m) { bf16_t* rowp = base + (size_t)(row0 + ai * HALF + m * 16) * ldc + col0;
#pragma unroll
                for (int bj = 0; bj < 2; ++bj) { f32x4 v0 = acc[ai][bj][m][0] + bv[bj][0], v1 = acc[ai][bj][m][1] + bv[bj][1];
                    if (ACT == 1) { f32x2 a = gelu_pk((f32x2){v0[0], v0[1]}), b = gelu_pk((f32x2){v0[2], v0[3]}), c = gelu_pk((f32x2){v1[0], v1[1]}), d = gelu_pk((f32x2){v1[2], v1[3]});
                        v0 = (f32x4){a.x, a.y, b.x, b.y}; v1 = (f32x4){c.x, c.y, d.x, d.y}; }
                    v0 = v0 * sc; v1 = v1 * sc; u32x4 w; w.x = cvt_pk_bf16(v0[0], v0[1]); w.y = cvt_pk_bf16(v0[2], v0[3]); w.z = cvt_pk_bf16(v1[0], v1[1]); w.w = cvt_pk_bf16(v1[2], v1[3]);
                    *(u32x4*)(rowp + bj * HALF) = w; } }
    }
};
template <class Epi, class Sched, bool ALIGN_EPI = false, bool SP2 = false>
__device__ __forceinline__ void gemm_phase(PG8_LAS unsigned char* lds, const Gemm g, const Sched& S, const Epi& E, int tid_in) {
    int tid_ = tid_in; asm volatile("" : "+v"(tid_));
    const int tid = tid_, wid = __builtin_amdgcn_readfirstlane(tid >> 6), lane = tid & 63, wr = wid >> 2, wc = wid & 3, fr = lane & 15, fq = lane >> 4;
    const int K = g.K, nt = K / BK;
    unsigned voffA[2], voffB[2];
#pragma unroll
    for (int i = 0; i < 2; ++i) { int R, C; stage_rc(tid * 16 + i * 8192, R, C); const int Rb = Epi::PERM ? ((R & ~31) + perm32(R & 31)) : R;
        voffA[i] = (unsigned)(R * g.lda + C) * 2u; voffB[i] = (unsigned)(Rb * K + C) * 2u; }
    const size_t kstep = (size_t)(BK * 2);
    const size_t hstep = (size_t)HALF * K * 2;
    const size_t tstep = 2 * hstep; const size_t hstepA = (size_t)HALF * g.lda * 2, tstepA = 2 * hstepA;
    const unsigned ldsw = (unsigned)wid * 1024u;
    const int aoff = lds_byte(wr * 64 + fr, fq * 8), boff = lds_byte(wc * 32 + fr, fq * 8);
#define PG8_SA(b, h) (((b) * 2 + (h)) * HTB)
#define PG8_SB(b, h) ((4 + (b) * 2 + (h)) * HTB)
#define PG8_STAGE(bufoff, gbase, voff) do { _Pragma("unroll") for (int _i = 0; _i < 2; ++_i) \
        __builtin_amdgcn_global_load_lds((const unsigned*)((const char*)(gbase) + (voff)[_i]), (PG8_LAS unsigned*)(lds + (bufoff) + ldsw + _i * 8192), 16, 0, 0); } while (0)
#define PG8_LDA(dst, b, h) do { _Pragma("unroll") for (int m = 0; m < 4; ++m) _Pragma("unroll") for (int k = 0; k < 2; ++k) dst[m][k] = *(const PG8_LAS bf16x8*)(lds + PG8_SA(b, h) + aoff + m * 2048 + k * 1024); } while (0)
#define PG8_LDB(dst, b, h) do { _Pragma("unroll") for (int n = 0; n < 2; ++n) _Pragma("unroll") for (int k = 0; k < 2; ++k) dst[n][k] = *(const PG8_LAS bf16x8*)(lds + PG8_SB(b, h) + boff + n * 2048 + k * 1024); } while (0)
#define PG8_MMA(ai, bj, At, Bt) do { __builtin_amdgcn_s_setprio(1); _Pragma("unroll") for (int m = 0; m < 4; ++m) _Pragma("unroll") for (int n = 0; n < 2; ++n) _Pragma("unroll") for (int k = 0; k < 2; ++k) \
        acc[ai][bj][m][n] = __builtin_amdgcn_mfma_f32_16x16x32_bf16(Bt[n][k], At[m][k], acc[ai][bj][m][n], 0, 0, 0); __builtin_amdgcn_s_setprio(0); } while (0)
#define PG8_WAIT_V(n) asm volatile("s_waitcnt vmcnt(" #n ")" ::: "memory")
#define PG8_WAIT_L(n) asm volatile("s_waitcnt lgkmcnt(" #n ")" ::: "memory")
#define PG8_BAR __builtin_amdgcn_s_barrier()
#define PG8_SCHED __builtin_amdgcn_sched_barrier(0)
    Unit cur, nxt; int ui = 0;
    if (!S.next(0, cur)) return;
    f32x4 acc[2][2][4][2];
#pragma unroll
    for (int a = 0; a < 2; ++a)
#pragma unroll
        for (int b = 0; b < 2; ++b)
#pragma unroll
            for (int m = 0; m < 4; ++m)
#pragma unroll
                for (int n = 0; n < 2; ++n) acc[a][b][m][n] = (f32x4){0.f, 0.f, 0.f, 0.f};
    bf16x8 At[4][2], B0[2][2], B1[2][2];
    const char* cA = (const char*)g.A + (size_t)cur.pm * tstepA; const char* cB = (const char*)g.Bt + (size_t)cur.pn * tstep;
    S.a_ready(cur);
    if constexpr (SP2) {
        PG8_STAGE(PG8_SB(0, 0), cB, voffB); PG8_STAGE(PG8_SB(0, 1), cB + hstep, voffB); PG8_STAGE(PG8_SA(0, 0), cA, voffA); PG8_STAGE(PG8_SA(0, 1), cA + hstepA, voffA);
        if (wr == 1) PG8_BAR;
        PG8_WAIT_V(2); PG8_BAR;
        PG8_STAGE(PG8_SB(1, 0), cB + kstep, voffB); PG8_STAGE(PG8_SA(1, 0), cA + kstep, voffA); PG8_STAGE(PG8_SB(1, 1), cB + hstep + kstep, voffB);
        PG8_WAIT_V(6); PG8_BAR;
    } else {
        PG8_STAGE(PG8_SB(0, 0), cB, voffB); PG8_STAGE(PG8_SA(0, 0), cA, voffA); PG8_STAGE(PG8_SB(0, 1), cB + hstep, voffB); PG8_STAGE(PG8_SA(0, 1), cA + hstepA, voffA);
        if (wr == 1) PG8_BAR;
        PG8_WAIT_V(4); PG8_BAR;
        PG8_STAGE(PG8_SB(1, 0), cB + kstep, voffB); PG8_STAGE(PG8_SA(1, 0), cA + kstep, voffA); PG8_STAGE(PG8_SB(1, 1), cB + hstep + kstep, voffB);
        PG8_WAIT_V(6); PG8_BAR;
    }
    for (;;) {
        const bool has_next = S.next(ui + 1, nxt);
        const char* nA = has_next ? (const char*)g.A + (size_t)nxt.pm * tstepA : cA; const char* nB = has_next ? (const char*)g.Bt + (size_t)nxt.pn * tstep : cB;
        for (int t = 0; t < nt; t += 2) {
            const bool last = (t == nt - 2);
            const char* a1 = cA + (size_t)(t + 1) * kstep;
            const char* a2 = last ? nA : cA + (size_t)(t + 2) * kstep; const char* b2 = last ? nB : cB + (size_t)(t + 2) * kstep;
            const char* a3 = a2 + kstep; const char* b3 = b2 + kstep;
            if (last && has_next) S.a_ready(nxt);
            if constexpr (SP2) {
            PG8_LDB(B0, 0, 0); PG8_LDB(B1, 0, 1); PG8_SCHED; PG8_LDA(At, 0, 0); PG8_STAGE(PG8_SA(1, 1), a1 + hstepA, voffA);
            PG8_WAIT_V(8); PG8_WAIT_L(0); PG8_BAR; PG8_MMA(0, 0, At, B0); PG8_MMA(0, 1, At, B1); PG8_BAR; PG8_SCHED;
            PG8_LDA(At, 0, 1); PG8_STAGE(PG8_SB(0, 0), b2, voffB); PG8_STAGE(PG8_SB(0, 1), b2 + hstep, voffB); PG8_STAGE(PG8_SA(0, 0), a2, voffA);
            PG8_WAIT_V(8); PG8_WAIT_L(0); PG8_BAR; PG8_MMA(1, 0, At, B0); PG8_MMA(1, 1, At, B1); PG8_BAR; PG8_SCHED;
            PG8_LDB(B0, 1, 0); PG8_LDB(B1, 1, 1); PG8_SCHED; PG8_LDA(At, 1, 0); PG8_STAGE(PG8_SA(0, 1), a2 + hstepA, voffA);
            PG8_WAIT_V(8); PG8_WAIT_L(0); PG8_BAR; PG8_MMA(0, 0, At, B0); PG8_MMA(0, 1, At, B1); PG8_BAR; PG8_SCHED;
            PG8_LDA(At, 1, 1); PG8_STAGE(PG8_SB(1, 0), b3, voffB); PG8_STAGE(PG8_SB(1, 1), b3 + hstep, voffB); PG8_STAGE(PG8_SA(1, 0), a3, voffA);
            PG8_WAIT_V(8); PG8_WAIT_L(0); PG8_BAR; PG8_MMA(1, 0, At, B0); PG8_MMA(1, 1, At, B1); PG8_BAR; PG8_SCHED;
            } else {
            PG8_LDB(B0, 0, 0); PG8_SCHED; PG8_LDA(At, 0, 0); PG8_STAGE(PG8_SA(1, 1), a1 + hstepA, voffA);
            PG8_WAIT_L(8); PG8_BAR; PG8_WAIT_L(0); PG8_MMA(0, 0, At, B0); PG8_BAR; PG8_SCHED;
            PG8_LDB(B1, 0, 1); PG8_STAGE(PG8_SB(0, 0), b2, voffB);
            PG8_BAR; PG8_WAIT_L(0); PG8_MMA(0, 1, At, B1); PG8_BAR;
            PG8_LDA(At, 0, 1); PG8_STAGE(PG8_SA(0, 0), a2, voffA);
            PG8_BAR; PG8_WAIT_L(0); PG8_MMA(1, 0, At, B0); PG8_BAR; PG8_SCHED;
            PG8_STAGE(PG8_SB(0, 1), b2 + hstep, voffB);
            PG8_WAIT_V(6); PG8_BAR; PG8_MMA(1, 1, At, B1); PG8_BAR;
            PG8_LDB(B0, 1, 0); PG8_SCHED; PG8_LDA(At, 1, 0); PG8_STAGE(PG8_SA(0, 1), a2 + hstepA, voffA);
            PG8_WAIT_L(8); PG8_BAR; PG8_WAIT_L(0); PG8_MMA(0, 0, At, B0); PG8_BAR; PG8_SCHED;
            PG8_LDB(B1, 1, 1); PG8_STAGE(PG8_SB(1, 0), b3, voffB);
            PG8_BAR; PG8_WAIT_L(0); PG8_MMA(0, 1, At, B1); PG8_BAR;
            PG8_LDA(At, 1, 1); PG8_STAGE(PG8_SA(1, 0), a3, voffA);
            PG8_BAR; PG8_WAIT_L(0); PG8_MMA(1, 0, At, B0); PG8_BAR; PG8_SCHED;
            PG8_STAGE(PG8_SB(1, 1), b3 + hstep, voffB);
            PG8_WAIT_V(6); PG8_BAR; PG8_MMA(1, 1, At, B1); PG8_BAR;
            }
        }
        if constexpr (ALIGN_EPI) { if (wr == 0) PG8_BAR; }
        if constexpr (!Epi::AFTER_DRAIN) { E(acc, cur, wr, wc, fr, fq); S.done(cur); }
        if (!has_next) break;
#pragma unroll
        for (int a = 0; a < 2; ++a)
#pragma unroll
            for (int b = 0; b < 2; ++b)
#pragma unroll
                for (int m = 0; m < 4; ++m)
#pragma unroll
                    for (int n = 0; n < 2; ++n) acc[a][b][m][n] = (f32x4){0.f, 0.f, 0.f, 0.f};
        cur = nxt; cA = nA; cB = nB; ++ui;
        if constexpr (ALIGN_EPI) { if (wr == 1) PG8_BAR; }
    }
    PG8_WAIT_V(0);
    if constexpr (!ALIGN_EPI) { if (wr == 0) PG8_BAR; }
    PG8_BAR;
    if constexpr (Epi::AFTER_DRAIN) { E.fused(acc, cur, wr, wc, fr, fq, lds, wid, lane); S.done(cur); }
#undef PG8_SA
#undef PG8_SB
#undef PG8_STAGE
#undef PG8_LDA
#undef PG8_LDB
#undef PG8_MMA
#undef PG8_WAIT_V
#undef PG8_WAIT_L
#undef PG8_BAR
#undef PG8_SCHED
}
}
namespace pg8 {
template <class T> __device__ __forceinline__ T* uni_ptr(T* p) {
    const unsigned long long v = (unsigned long long)p; unsigned lo = __builtin_amdgcn_readfirstlane((unsigned)v), hi = __builtin_amdgcn_readfirstlane((unsigned)(v >> 32)); asm volatile("" : "+s"(lo), "+s"(hi)); return (T*)(((unsigned long long)hi << 32) | lo); }
template <bool XB16> struct EpiResid {
    static constexpr bool PERM = true, AFTER_DRAIN = false;
    const void* xin_; bf16_t* out_; const float* gate_;
    __device__ __forceinline__ void operator()(const f32x4 (&acc)[2][2][4][2], const Unit& u, int wr, int wc, int fr, int fq) const {
        const void* xin = uni_ptr(xin_); bf16_t* out = uni_ptr(out_); const float* gate = uni_ptr(gate_);
        const int row0 = u.pm * BM + wr * 64 + fr, col0 = u.pn * BM + wc * 32 + 8 * fq;
        const float* gp = gate + (size_t)(u.pm >> 5) * 6144 + col0;
        f32x4 gv[2][2];
#pragma unroll
        for (int bj = 0; bj < 2; ++bj)
#pragma unroll
            for (int n = 0; n < 2; ++n) gv[bj][n] = *(const f32x4*)(gp + bj * HALF + 4 * n);
        if (XB16) {
#pragma unroll
            for (int ai = 0; ai < 2; ++ai) { u32x4 xr[4][2];
#pragma unroll
                for (int m = 0; m < 4; ++m)
#pragma unroll
                    for (int bj = 0; bj < 2; ++bj) xr[m][bj] = *(const u32x4*)((const bf16_t*)xin + (size_t)(row0 + ai * HALF + m * 16) * 1024 + col0 + bj * HALF);
#pragma unroll
                for (int m = 0; m < 4; ++m)
#pragma unroll
                    for (int bj = 0; bj < 2; ++bj) { const u32x4 q = xr[m][bj];
                        const f32x4 x0 = (f32x4){__uint_as_float(q.x << 16), __uint_as_float(q.x & 0xffff0000u), __uint_as_float(q.y << 16), __uint_as_float(q.y & 0xffff0000u)};
                        const f32x4 x1 = (f32x4){__uint_as_float(q.z << 16), __uint_as_float(q.z & 0xffff0000u), __uint_as_float(q.w << 16), __uint_as_float(q.w & 0xffff0000u)};
                        const f32x4 y0 = x0 + gv[bj][0] * acc[ai][bj][m][0], y1 = x1 + gv[bj][1] * acc[ai][bj][m][1];
                        u32x4 w; w.x = cvt_pk_bf16(y0[0], y0[1]); w.y = cvt_pk_bf16(y0[2], y0[3]); w.z = cvt_pk_bf16(y1[0], y1[1]); w.w = cvt_pk_bf16(y1[2], y1[3]);
                        *(u32x4*)(out + (size_t)(row0 + ai * HALF + m * 16) * 1024 + col0 + bj * HALF) = w; }
                asm volatile("" ::: "memory"); }
        } else {
#pragma unroll
            for (int ai = 0; ai < 2; ++ai) { f32x4 xr[4][2][2];
#pragma unroll
                for (int m = 0; m < 4; ++m)
#pragma unroll
                    for (int bj = 0; bj < 2; ++bj) { const float* xp = (const float*)xin + (size_t)(row0 + ai * HALF + m * 16) * 1024 + col0 + bj * HALF; xr[m][bj][0] = *(const f32x4*)xp; xr[m][bj][1] = *(const f32x4*)(xp + 4); }
#pragma unroll
                for (int m = 0; m < 4; ++m)
#pragma unroll
                    for (int bj = 0; bj < 2; ++bj) { const f32x4 y0 = xr[m][bj][0] + gv[bj][0] * acc[ai][bj][m][0], y1 = xr[m][bj][1] + gv[bj][1] * acc[ai][bj][m][1];
                        u32x4 w; w.x = cvt_pk_bf16(y0[0], y0[1]); w.y = cvt_pk_bf16(y0[2], y0[3]); w.z = cvt_pk_bf16(y1[0], y1[1]); w.w = cvt_pk_bf16(y1[2], y1[3]);
                        *(u32x4*)(out + (size_t)(row0 + ai * HALF + m * 16) * 1024 + col0 + bj * HALF) = w; }
                asm volatile("" ::: "memory"); }
        }
    }
};
struct EpiRelu2 {
    static constexpr bool PERM = true, AFTER_DRAIN = false;
    bf16_t* O_; int ldc;
    __device__ __forceinline__ void operator()(const f32x4 (&acc)[2][2][4][2], const Unit& u, int wr, int wc, int fr, int fq) const {
        bf16_t* O = uni_ptr(O_);
        const int row0 = u.pm * BM + wr * 64 + fr, col0 = u.pn * BM + wc * 32 + 8 * fq;
#pragma unroll
        for (int ai = 0; ai < 2; ++ai)
#pragma unroll
            for (int m = 0; m < 4; ++m) { bf16_t* rowp = O + (size_t)(row0 + ai * HALF + m * 16) * ldc + col0;
#pragma unroll
                for (int bj = 0; bj < 2; ++bj) { f32x4 v0 = acc[ai][bj][m][0], v1 = acc[ai][bj][m][1];
                    v0 = __builtin_elementwise_max(v0, (f32x4){0.f, 0.f, 0.f, 0.f}); v1 = __builtin_elementwise_max(v1, (f32x4){0.f, 0.f, 0.f, 0.f}); v0 = v0 * v0; v1 = v1 * v1;
                    u32x4 w; w.x = cvt_pk_bf16(v0[0], v0[1]); w.y = cvt_pk_bf16(v0[2], v0[3]); w.z = cvt_pk_bf16(v1[0], v1[1]); w.w = cvt_pk_bf16(v1[2], v1[3]);
                    *(u32x4*)(rowp + bj * HALF) = w; } }
    }
};
struct EpiMlaQ {
    static constexpr bool PERM = true, AFTER_DRAIN = false;
    bf16_t* QM_;
    __device__ __forceinline__ void operator()(const f32x4 (&acc)[2][2][4][2], const Unit& u, int wr, int wc, int fr, int fq) const {
        bf16_t* QM = uni_ptr(QM_);
        const int row0 = u.pm * BM + wr * 64 + fr, cw = wc * 32 + 8 * fq;
        const int nbj = (u.pn != 0) ? 1 : 2;
#pragma unroll
        for (int ai = 0; ai < 2; ++ai)
#pragma unroll
            for (int m = 0; m < 4; ++m) { bf16_t* qr = QM + (size_t)(row0 + ai * HALF + m * 16) * 384 + u.pn * 256 + cw;
#pragma unroll
                for (int bj = 0; bj < 2; ++bj) if (bj < nbj) { const f32x4 v0 = acc[ai][bj][m][0], v1 = acc[ai][bj][m][1];
                    u32x4 o; o.x = cvt_pk_bf16(v0[0], v0[1]); o.y = cvt_pk_bf16(v0[2], v0[3]); o.z = cvt_pk_bf16(v1[0], v1[1]); o.w = cvt_pk_bf16(v1[2], v1[3]);
                    *(u32x4*)(qr + bj * HALF) = o; } }
    }
};
struct EpiMlaKV {
    static constexpr bool PERM = true, AFTER_DRAIN = false;
    bf16_t* KM_; bf16_t* VM_; const float* rskv_;
    __device__ __forceinline__ void operator()(const f32x4 (&acc)[2][2][4][2], const Unit& u, int wr, int wc, int fr, int fq) const {
        bf16_t* KM = uni_ptr(KM_); bf16_t* VM = uni_ptr(VM_); const float* rskv = uni_ptr(rskv_);
        const int row0 = u.pm * BM + wr * 64 + fr, w = wc * 32 + 8 * fq;
        const bool isk = wc < 2;
        float rsv[2][4];
#pragma unroll
        for (int ai = 0; ai < 2; ++ai)
#pragma unroll
            for (int m = 0; m < 4; ++m) rsv[ai][m] = rskv[row0 + ai * HALF + m * 16];
#pragma unroll
        for (int ai = 0; ai < 2; ++ai)
#pragma unroll
            for (int m = 0; m < 4; ++m) { const int row = row0 + ai * HALF + m * 16; const float rs = rsv[ai][m];
#pragma unroll
                for (int bj = 0; bj < 2; ++bj) { const int head = u.pn * 2 + bj;
                    const f32x4 v0 = acc[ai][bj][m][0] * rs, v1 = acc[ai][bj][m][1] * rs;
                    u32x4 o; o.x = cvt_pk_bf16(v0[0], v0[1]); o.y = cvt_pk_bf16(v0[2], v0[3]); o.z = cvt_pk_bf16(v1[0], v1[1]); o.w = cvt_pk_bf16(v1[2], v1[3]);
                    if (isk) *(u32x4*)(KM + (size_t)row * 384 + head * 96 + w) = o; else *(u32x4*)(VM + (size_t)row * 256 + head * 64 + (w - 64)) = o; }
                asm volatile("" ::: "memory"); }
    }
};
}
#define GAS __attribute__((address_space(1)))
#define LAS __attribute__((address_space(3)))
typedef unsigned short bf16;
typedef unsigned v4u __attribute__((ext_vector_type(4)));
typedef float f32x4 __attribute__((ext_vector_type(4)));
typedef short bf16x8 __attribute__((ext_vector_type(8)));
typedef GAS unsigned gu32;
typedef GAS unsigned long long gu64;
#define RLX_AGENT __ATOMIC_RELAXED, __HIP_MEMORY_SCOPE_AGENT
#define LDS_WAIT() asm volatile("s_waitcnt lgkmcnt(0)" ::: "memory")
#define VM_WAIT() asm volatile("s_waitcnt vmcnt(0)" ::: "memory")
__device__ __forceinline__ unsigned long long rt() { return __builtin_amdgcn_s_memrealtime(); }
__device__ __forceinline__ unsigned f2bf(float f) { unsigned u = __builtin_bit_cast(unsigned, f); return (u + 0x7fffu + ((u >> 16) & 1u)) >> 16; }
__device__ __forceinline__ unsigned pk2(float lo, float hi) { return f2bf(lo) | (f2bf(hi) << 16); }

#define XB_TMO      128
#define XB_XCNT(j)  (256  + 64 * (j))
#define XB_XSUB(j)  (1280 + 64 * (j))
#define XB_XGEN(j)  (2304 + 64 * (j))
#define XB_TOP      3328
#define XB_TOPGEN   3392
#define XCD_BAR_WORDS 3456
#define XB_SPIN_CAP (1u << 18)

__device__ __forceinline__ unsigned xb_ld(unsigned* p)              { return __hip_atomic_load(p, __ATOMIC_RELAXED, __HIP_MEMORY_SCOPE_AGENT); }
__device__ __forceinline__ unsigned xb_add(unsigned* p, unsigned v) { return __hip_atomic_fetch_add(p, v, __ATOMIC_RELAXED, __HIP_MEMORY_SCOPE_AGENT); }
__device__ __forceinline__ unsigned xb_xcc_id() { return (unsigned)__builtin_amdgcn_s_getreg((3 << 11) | 20) & 0xFu; }
#define XB_SPIN(cond, bar) do { unsigned _sp = 0; while (cond) { __builtin_amdgcn_s_sleep(1); \
    if ((++_sp & 255u) == 0u) { if (xb_ld(&(bar)[XB_TMO])) break; if (_sp > XB_SPIN_CAP) { atomicAdd(&(bar)[XB_TMO], 1u); break; } } } } while (0)

struct XcdBarrier {
    unsigned* bar; unsigned x;
    volatile LAS unsigned* st;
};

__device__ __forceinline__ XcdBarrier xcd_barrier_post(unsigned* bar, volatile LAS unsigned* st) {
    XcdBarrier b; b.bar = bar; b.x = xb_xcc_id(); b.st = st;
    if (threadIdx.x == 0) (void)xb_add(&bar[XB_XCNT(b.x)], 1u);
    return b;
}
__device__ __forceinline__ void xcd_barrier_complete(unsigned* bar, unsigned x, unsigned& nloc, unsigned& nx) {
    const unsigned G = gridDim.x * gridDim.y * gridDim.z;
    unsigned sum, cnt, mine, sp = 0u;
    for (;;) {
        sum = 0u; cnt = 0u; mine = 0u;
#pragma unroll
        for (unsigned j = 0; j < 16; ++j) { const unsigned c = xb_ld(&bar[XB_XCNT(j)]); sum += c; cnt += (c > 0u) ? 1u : 0u; mine = (j == x) ? c : mine; }
        if (sum == G) break;
        __builtin_amdgcn_s_sleep(1);
        if ((++sp & 255u) == 0u) { if (xb_ld(&bar[XB_TMO])) break; if (sp > XB_SPIN_CAP) { atomicAdd(&bar[XB_TMO], 1u); break; } }
    }
    nloc = mine > 0u ? mine : 1u; nx = cnt > 0u ? cnt : 1u;
}

__device__ __forceinline__ void xcd_barrier(const XcdBarrier& b) {
    asm volatile("s_waitcnt vmcnt(0)" ::: "memory");
    __syncthreads();
    if (threadIdx.x == 0) {
        unsigned* bar = b.bar;
        __builtin_amdgcn_s_waitcnt(0);
        unsigned nloc = b.st[0], nx = b.st[1];
        if (nloc == 0u) { xcd_barrier_complete(bar, b.x, nloc, nx); b.st[0] = nloc; b.st[1] = nx; }
        const unsigned old = xb_add(&bar[XB_XSUB(b.x)], 1u);
        const unsigned gen = old / nloc;
        if (old + 1u == (gen + 1u) * nloc) {
            __builtin_amdgcn_fence(__ATOMIC_RELEASE, "agent");
            asm volatile("s_waitcnt vmcnt(0)" ::: "memory");
            const unsigned og = xb_add(&bar[XB_TOP], 1u);
            const unsigned tg = og / nx;
            if (og + 1u == (tg + 1u) * nx) xb_add(&bar[XB_TOPGEN], 1u);
            else XB_SPIN(xb_ld(&bar[XB_TOPGEN]) == tg, bar);
            __builtin_amdgcn_fence(__ATOMIC_ACQUIRE, "agent");
            xb_add(&bar[XB_XGEN(b.x)], 1u);
            asm volatile("s_waitcnt vmcnt(0)" ::: "memory");
        } else {
            XB_SPIN(xb_ld(&bar[XB_XGEN(b.x)]) == gen, bar);
            __builtin_amdgcn_fence(__ATOMIC_ACQUIRE, "agent");
            asm volatile("s_waitcnt vmcnt(0)" ::: "memory");
        }
    }
    __syncthreads();
}
#ifndef FA_PROBE
#define FA_PROBE 0
#endif
#ifndef FA_EXP
#define FA_EXP 0
#endif
namespace fa {
typedef unsigned short bf16;
typedef short bf16x8 __attribute__((ext_vector_type(8)));
typedef short s16x4 __attribute__((ext_vector_type(4)));
typedef float f32x16 __attribute__((ext_vector_type(16)));
typedef float f32x4v __attribute__((ext_vector_type(4)));
typedef unsigned u32x4 __attribute__((ext_vector_type(4)));
typedef unsigned u32x2 __attribute__((ext_vector_type(2)));
typedef float f32x2_t __attribute__((ext_vector_type(2)));
typedef __bf16 bf16x2_t __attribute__((ext_vector_type(2)));
#define FLAS __attribute__((address_space(3)))
#define FGAS __attribute__((address_space(1)))
constexpr float MASKV = -1e30f, MINIT = -5e29f, TINYF = 1e-30f, LOG2E = 1.4426950408889634f;
constexpr int OSTR = 144;

__device__ __forceinline__ float ex2(float x) { return __builtin_amdgcn_exp2f(x); }
__device__ __forceinline__ unsigned cvtpk(float lo, float hi) { f32x2_t v = {lo, hi}; bf16x2_t b = __builtin_convertvector(v, bf16x2_t); return __builtin_bit_cast(unsigned, b); }
__device__ __forceinline__ float xhalf_max(float m) { auto rr = __builtin_amdgcn_permlane32_swap(__float_as_uint(m), __float_as_uint(m), false, false); return fmaxf(__uint_as_float(rr[0]), __uint_as_float(rr[1])); }
__device__ __forceinline__ float xhalf_sum(float m) { auto rr = __builtin_amdgcn_permlane32_swap(__float_as_uint(m), __float_as_uint(m), false, false); return __uint_as_float(rr[0]) + __uint_as_float(rr[1]); }
__device__ __forceinline__ float bf2f(unsigned short b) { return __uint_as_float((unsigned)b << 16); }

struct SM { float m, l; f32x16 o[2]; };
__device__ __forceinline__ void sm_init(SM& s) { s.m = MINIT; s.l = 0.f; s.o[0] = f32x16{}; s.o[1] = f32x16{}; }

template <int DQ> struct Stg { u32x4 k0, k1, v; };
template <int DQ> __device__ __forceinline__ void stg_load(Stg<DQ>& s, const FGAS char* ws, unsigned koff, unsigned ksb, unsigned voff, unsigned vsb, int key0, int kmax, int tid) {
    const int row = tid >> 3, ch = tid & 7; int kr = key0 + row; kr = kr < kmax ? kr : kmax;
    s.k0 = *(const FGAS u32x4*)(ws + (koff + (unsigned)kr * ksb + (unsigned)ch * 16u));
    s.v = *(const FGAS u32x4*)(ws + (voff + (unsigned)kr * vsb + (unsigned)ch * 16u));
    if (DQ == 96) { if (tid < 256) { const int r2 = tid >> 2, c2 = tid & 3; int k2 = key0 + r2; k2 = k2 < kmax ? k2 : kmax; s.k1 = *(const FGAS u32x4*)(ws + (koff + (unsigned)k2 * ksb + 128u + (unsigned)c2 * 16u)); } }
}
template <int DQ> __device__ __forceinline__ void stg_store(const Stg<DQ>& s, FLAS char* buf, int tid) {
    const int row = tid >> 3, ch = tid & 7, p = ch >> 2, c = ch & 3;
    *(FLAS u32x4*)(buf + p * 4096 + row * 64 + ((c ^ ((row >> 2) & 3)) << 4)) = s.k0;
    *(FLAS u32x4*)(buf + (DQ / 32) * 4096 + row * 128 + ((p ^ ((row >> 1) & 1)) << 6) + (c << 4)) = s.v;
    if (DQ == 96) { if (tid < 256) { const int r2 = tid >> 2, c2 = tid & 3; *(FLAS u32x4*)(buf + 2 * 4096 + r2 * 64 + ((c2 ^ ((r2 >> 2) & 3)) << 4)) = s.k1; } }
}
template <int DQ> constexpr int stage_bytes() { return (DQ / 32) * 4096 + 8192; }

template <int DQ> __device__ __forceinline__ void compute_S(f32x16& p0, f32x16& p1, const FLAS char* buf, const bf16x8 (&qf)[DQ / 16], int lane) {
    const int r = lane & 31, h = lane >> 5, sw = (r >> 2) & 3;
#pragma unroll
    for (int d0 = 0; d0 < DQ / 16; ++d0) {
        const int p = d0 >> 1, c = 2 * (d0 & 1) + h;
        const FLAS char* a = buf + p * 4096 + r * 64 + ((c ^ sw) << 4);
        const bf16x8 a0 = *(const FLAS bf16x8*)a, a1 = *(const FLAS bf16x8*)(a + 2048);
        p0 = __builtin_amdgcn_mfma_f32_32x32x16_bf16(a0, qf[d0], p0, 0, 0, 0);
        p1 = __builtin_amdgcn_mfma_f32_32x32x16_bf16(a1, qf[d0], p1, 0, 0, 0);
    }
#if FA_EXP & 2
    __builtin_amdgcn_sched_group_barrier(0x100, 4, 0);
#pragma unroll
    for (int i = 0; i < DQ / 16 - 2; ++i) { __builtin_amdgcn_sched_group_barrier(0x008, 2, 0); __builtin_amdgcn_sched_group_barrier(0x100, 2, 0); }
    __builtin_amdgcn_sched_group_barrier(0x008, 4, 0);
#endif
}
__device__ __forceinline__ s16x4 vtr(const FLAS char* p) { typedef short v4i16_t __attribute__((ext_vector_type(4))); return __builtin_bit_cast(s16x4, __builtin_amdgcn_ds_read_tr16_b64_v4i16((FLAS v4i16_t*)p)); }
__device__ __forceinline__ void pv(f32x16 (&o)[2], const FLAS char* vbuf, const bf16x8 (&pf)[4], int lane) {
    const int g = lane >> 4, i = lane & 15, q4 = i >> 2, pp = i & 3, h = lane >> 5;
    const int sw = (q4 >> 1) & 1;
#pragma unroll
    for (int db = 0; db < 2; ++db) {
        const FLAS char* base = vbuf + (4 * h + q4) * 128 + ((db ^ sw) << 6) + (16 * (g & 1) + 4 * pp) * 2;
#pragma unroll
        for (int ks = 0; ks < 4; ++ks) {
            const s16x4 lo = vtr(base + ks * 2048), hi = vtr(base + ks * 2048 + 1024);
            const bf16x8 a = (bf16x8){lo[0], lo[1], lo[2], lo[3], hi[0], hi[1], hi[2], hi[3]};
            o[db] = __builtin_amdgcn_mfma_f32_32x32x16_bf16(a, pf[ks], o[db], 0, 0, 0);
        }
    }
#if FA_EXP & 2
    __builtin_amdgcn_sched_group_barrier(0x100, 8, 0);
    __builtin_amdgcn_sched_group_barrier(0x008, 2, 0); __builtin_amdgcn_sched_group_barrier(0x100, 4, 0);
    __builtin_amdgcn_sched_group_barrier(0x008, 2, 0); __builtin_amdgcn_sched_group_barrier(0x100, 4, 0);
    __builtin_amdgcn_sched_group_barrier(0x008, 4, 0);
#endif
}
__device__ __forceinline__ void mask_ew(f32x16& p0, f32x16& p1, int lo, int hi, int h) {
    const int lo2 = lo - 4 * h, hi2 = hi - 4 * h;
#pragma unroll
    for (int v = 0; v < 16; ++v) { const int k0 = (v & 3) + 8 * (v >> 2);
        if (k0 < lo2 || k0 > hi2) p0[v] = MASKV;
        if (k0 + 32 < lo2 || k0 + 32 > hi2) p1[v] = MASKV; }
}
__device__ __forceinline__ void sm_step(SM& st, f32x16& p0, f32x16& p1, bf16x8 (&pf)[4]) {
#define FA_MX3(a, b, c) __builtin_fmaxf(__builtin_fmaxf((a), (b)), (c))
    float ma = FA_MX3(p0[0], p0[1], p1[0]), mb = FA_MX3(p0[2], p0[3], p1[1]); ma = FA_MX3(ma, p1[2], p1[3]);
#pragma unroll
    for (int v = 4; v < 16; v += 4) { ma = FA_MX3(ma, p0[v], p0[v + 1]); mb = FA_MX3(mb, p0[v + 2], p0[v + 3]); ma = FA_MX3(ma, p1[v], p1[v + 1]); mb = FA_MX3(mb, p1[v + 2], p1[v + 3]); }
#undef FA_MX3
    const float mx = xhalf_max(__builtin_fmaxf(ma, mb));
    if (__any(mx > st.m)) {
        const float mn2 = fmaxf(st.m, mx), alpha = ex2(st.m - mn2);
        st.m = mn2; st.l *= alpha; st.o[0] *= alpha; st.o[1] *= alpha;
    }
    const float mn = st.m;
    float s0 = 0.f, s1 = 0.f;
#pragma unroll
    for (int v = 0; v < 16; ++v) { p0[v] = ex2(p0[v] - mn); p1[v] = ex2(p1[v] - mn); s0 += p0[v]; s1 += p1[v]; }
    st.l += s0 + s1;
    u32x4 w;
    w.x = cvtpk(p0[0], p0[1]); w.y = cvtpk(p0[2], p0[3]); w.z = cvtpk(p0[4], p0[5]); w.w = cvtpk(p0[6], p0[7]); pf[0] = __builtin_bit_cast(bf16x8, w);
    w.x = cvtpk(p0[8], p0[9]); w.y = cvtpk(p0[10], p0[11]); w.z = cvtpk(p0[12], p0[13]); w.w = cvtpk(p0[14], p0[15]); pf[1] = __builtin_bit_cast(bf16x8, w);
    w.x = cvtpk(p1[0], p1[1]); w.y = cvtpk(p1[2], p1[3]); w.z = cvtpk(p1[4], p1[5]); w.w = cvtpk(p1[6], p1[7]); pf[2] = __builtin_bit_cast(bf16x8, w);
    w.x = cvtpk(p1[8], p1[9]); w.y = cvtpk(p1[10], p1[11]); w.z = cvtpk(p1[12], p1[13]); w.w = cvtpk(p1[14], p1[15]); pf[3] = __builtin_bit_cast(bf16x8, w);
}
template <int DQ, bool ALIBI> __device__ __forceinline__ void score_tile(f32x16& p0, f32x16& p1, const FLAS char* buf, const bf16x8 (&qf)[DQ / 16], float cb, float sl, int lane) {
    if (ALIBI) {
#pragma unroll
        for (int v = 0; v < 16; ++v) { const float c = (float)((v & 3) + 8 * (v >> 2)); p0[v] = fmaf(sl, c, cb); p1[v] = fmaf(sl, c + 32.f, cb); }
    } else { p0 = f32x16{}; p1 = f32x16{}; }
    compute_S<DQ>(p0, p1, buf, qf, lane);
}
template <int DQ, bool ALIBI> __device__ __forceinline__ void tile_compute(SM& st, const FLAS char* buf, const bf16x8 (&qf)[DQ / 16], float cb, float sl, bool ew, int lo, int hi, int lane) {
    f32x16 p0, p1; bf16x8 pf[4];
    score_tile<DQ, ALIBI>(p0, p1, buf, qf, cb, sl, lane);
    if (ew) mask_ew(p0, p1, lo, hi, lane >> 5);
    sm_step(st, p0, p1, pf);
    pv(st.o, buf + (DQ / 32) * 4096, pf, lane);
}
template <int DQ, bool ALIBI, class K0, class PAR>
__device__ __forceinline__ void fa_loop(SM& st, const bf16x8 (&qf)[DQ / 16], const FGAS char* ws, unsigned koff, unsigned ksb, unsigned voff, unsigned vsb, int kmax, int ntile, K0 k0f, PAR parf, float sl, FLAS char* lds, int tid, int lane) {
    constexpr int STG = stage_bytes<DQ>();
    Stg<DQ> sgA, sgB;
    stg_load<DQ>(sgB, ws, koff, ksb, voff, vsb, k0f(0), kmax, tid); stg_store<DQ>(sgB, lds, tid);
    if (ntile > 1) stg_load<DQ>(sgA, ws, koff, ksb, voff, vsb, k0f(1), kmax, tid);
    if (ntile > 2) stg_load<DQ>(sgB, ws, koff, ksb, voff, vsb, k0f(2), kmax, tid);
    __syncthreads();
#if FA_PROBE && FA_PROBE < 9
    unsigned long long pr_c = 0, pr_w = 0, pr_b = 0, pr_t = 0; const unsigned long long pr_start = __builtin_amdgcn_s_memtime();
#define FA_P0 const unsigned long long q0_ = __builtin_amdgcn_s_memtime();
#define FA_P1 asm volatile("s_waitcnt vmcnt(0)" ::: "memory"); const unsigned long long q1_ = __builtin_amdgcn_s_memtime();
#define FA_P2 asm volatile("s_waitcnt lgkmcnt(0)" ::: "memory"); asm volatile("" : "+v"(st.o[0]), "+v"(st.o[1])); const unsigned long long q2_ = __builtin_amdgcn_s_memtime();
#define FA_P3 const unsigned long long q3_ = __builtin_amdgcn_s_memtime(); pr_w += q1_ - q0_; pr_c += q2_ - q1_; pr_b += q3_ - q2_; pr_t += 1;
#else
#define FA_P0
#define FA_P1
#define FA_P2
#define FA_P3
#endif
#define FA_ITER(SG) { \
        FA_P0 \
        if (t + 1 < ntile) stg_store<DQ>(SG, lds + ((t + 1) & 1) * STG, tid); \
        if (t + 3 < ntile) stg_load<DQ>(SG, ws, koff, ksb, voff, vsb, k0f(t + 3), kmax, tid); \
        FA_P1 \
        bool act, ew; float cb; int lo, hi; \
        parf(t, act, ew, cb, lo, hi); \
        if (act) tile_compute<DQ, ALIBI>(st, lds + (t & 1) * STG, qf, cb, sl, ew, lo, hi, lane); \
        FA_P2 \
        __syncthreads(); \
        FA_P3 }
    int t = 0;
    for (; t + 1 < ntile; t += 2) { FA_ITER(sgA) ++t; FA_ITER(sgB) --t; }
    if (t < ntile) FA_ITER(sgA)
#undef FA_ITER
#if FA_PROBE && FA_PROBE < 9
    if (DQ == 96 && lane == 0) { unsigned long long* pp = (unsigned long long*)((FGAS char*)ws + 32768);
        atomicAdd(pp + 0, pr_c); atomicAdd(pp + 1, pr_w); atomicAdd(pp + 2, pr_b); atomicAdd(pp + 3, pr_t); atomicAdd(pp + 4, __builtin_amdgcn_s_memtime() - pr_start); }
#endif
}
__device__ __forceinline__ void sm_finish(const SM& st, float gate, f32x16 (&acc)[2]) {
    const float inv = gate / fmaxf(xhalf_sum(st.l), TINYF);
    acc[0] += st.o[0] * inv; acc[1] += st.o[1] * inv;
}
template <class DST> __device__ __forceinline__ void store_out(const f32x16 (&acc)[2], FLAS char* ost, FGAS char* ws, DST dstf, int lane) {
    const int r = lane & 31, h = lane >> 5;
#pragma unroll
    for (int db = 0; db < 2; ++db)
#pragma unroll
        for (int g = 0; g < 4; ++g) { u32x2 w; w.x = cvtpk(acc[db][4 * g], acc[db][4 * g + 1]); w.y = cvtpk(acc[db][4 * g + 2], acc[db][4 * g + 3]);
            *(FLAS u32x2*)(ost + r * OSTR + (32 * db + 8 * g + 4 * h) * 2) = w; }
    asm volatile("s_waitcnt lgkmcnt(0)" ::: "memory");
#pragma unroll
    for (int i = 0; i < 4; ++i) { const int idx = i * 64 + lane, col = idx >> 3, ch = idx & 7;
        const u32x4 v = *(const FLAS u32x4*)(ost + col * OSTR + ch * 16);
        *(FGAS u32x4*)(ws + (dstf(col) + (unsigned)ch * 16u)) = v; }
    asm volatile("s_waitcnt lgkmcnt(0)" ::: "memory");
}
template <int DQ> __device__ __forceinline__ void load_q(bf16x8 (&qf)[DQ / 16], const FGAS char* ws, unsigned qoff, int h) {
#pragma unroll
    for (int d0 = 0; d0 < DQ / 16; ++d0) qf[d0] = *(const FGAS bf16x8*)(ws + (qoff + (unsigned)(d0 * 32 + 16 * h)));
}
}
namespace mk {
typedef unsigned short bf16;
typedef float f32x4 __attribute__((ext_vector_type(4)));
typedef unsigned v4u __attribute__((ext_vector_type(4)));
typedef unsigned v2u __attribute__((ext_vector_type(2)));
typedef short bf16x8 __attribute__((ext_vector_type(8)));
typedef float f32x16 __attribute__((ext_vector_type(16)));
using fa::SM;

constexpr int D = 1024, NB = 4, SEQ = 8192, M = NB * SEQ, DEPTH = 2, DFF = 4096, ZLD = 2304, DIN = 2284;
constexpr int ZA_Q = 0, ZA_K = 256, ZA_V = 384, ZB_CQ = 512, ZB_CKV = 704, ZB_PE = 832, ZC_Q = 864, ZC_KC = 1120, ZC_VC = 1184, ZC_KS = 1248, ZC_VS = 1312, ZC_KW = 1376, ZC_VW = 1440, ZC_GL = 1504, ZD_Q = 1520, ZD_K = 1776, ZD_V = 2032;
constexpr float LOG2E = 1.4426950408889634f;
constexpr float QS = 0.125f * LOG2E;
constexpr float C_MLA = 0.10206207261596577f * LOG2E;
constexpr float RMS_EPS = 1e-6f;
constexpr int NWAVES = 8, NTHR = 512;

constexpr size_t MiB = 1u << 20;
constexpr size_t WS_CTL = 0, CTL_ZERO_BYTES = 64 * 1024;
constexpr size_t WS_MOD = 1 * MiB;
constexpr size_t WS_ROPE = WS_MOD + 256 * 1024;
constexpr size_t WS_POSP = WS_ROPE + 1 * MiB;
constexpr size_t WS_POSB = WS_POSP + 64 * 1024;
constexpr size_t WS_RSQ = WS_POSB + 64 * 1024;
constexpr size_t WS_RSKV = WS_RSQ + 128 * 1024;
constexpr size_t WS_KMH = WS_RSKV + 128 * 1024;
constexpr size_t WS_KML = WS_KMH + 64 * 1024;
constexpr size_t WS_KCMP = WS_KML + 64 * 1024;
constexpr size_t WS_VCMP = WS_KCMP + 256 * 1024;
constexpr size_t WS_XB = 436 * MiB;
constexpr size_t WS_PARK = 401 * MiB;
constexpr size_t WS_W = 4 * MiB, WS_WL = 26 * MiB;
constexpr size_t W_IN = 0, W_OUT = 4608 * 1024, W_UP = W_OUT + 2 * MiB, W_DN = W_UP + 8 * MiB, W_UQ = W_DN + 8 * MiB, W_UKV = W_UQ + 256 * 1024, W_1K = W_UKV + 256 * 1024, W_1V = W_1K + 512 * 1024, W_2K = W_1V + 512 * 1024, W_2V = W_2K + 16 * 1024;
static_assert(W_2V + 16 * 1024 <= WS_WL && WS_VCMP + 256 * 1024 <= WS_W, "ws map");
constexpr size_t WS_H = 56 * MiB;
constexpr size_t WS_Z = 120 * MiB;
constexpr size_t WS_QM = 265 * MiB, WS_KM = 297 * MiB, WS_VM = 321 * MiB, WS_O = 337 * MiB, WS_U = 120 * MiB, WS_END = 401 * MiB;
static_assert(WS_Z + (size_t)(M + 64) * ZLD * 2 <= WS_QM && WS_U + (size_t)M * DFF * 2 <= WS_END, "ws map 2");

constexpr int LDS_RING = 131072, LDS_BYTES = 163840, LDS_MISC = LDS_BYTES - 256;
constexpr int FA_STAGES = 0, FA_OST = 61440, FA_IMP = FA_OST + 8 * 32 * fa::OSTR  , FA_SELM = FA_IMP + 32768, FA_UM = FA_SELM + 1024, FA_VALS = FA_UM + 64;
static_assert(FA_VALS + 8 * 512 <= LDS_MISC, "fa lds map");
constexpr int MB_OS = 65;
constexpr int MB_T = 0, MB_O = 65536, MB_ML = MB_O + 256 * MB_OS * 4, MB_CNT = MB_ML + 2048, MB_LST = MB_CNT + 128, MB_PS = MB_LST + 8192, MB_PM = MB_PS + 4 * 32 * 33 * 4;
static_assert(MB_PM + 1024 <= LDS_MISC, "moba lds map");

#define GAS __attribute__((address_space(1)))
#define LAS __attribute__((address_space(3)))
#define LDS_WAIT() asm volatile("s_waitcnt lgkmcnt(0)" ::: "memory")
__device__ __forceinline__ unsigned f2bf(float f) { unsigned u = __builtin_bit_cast(unsigned, f); return (u + 0x7fffu + ((u >> 16) & 1u)) >> 16; }
__device__ __forceinline__ unsigned pk2(float lo, float hi) { return f2bf(lo) | (f2bf(hi) << 16); }
__device__ __forceinline__ float bf2f(unsigned short b) { return __uint_as_float((unsigned)b << 16); }
__device__ __forceinline__ float wave_sum(float v) {
#pragma unroll
    for (int o = 1; o < 64; o <<= 1) v += __shfl_xor(v, o);
    return v;
}
__device__ __forceinline__ float slope2_of(int i) { return exp2f(-8.0f * (float)(i + 1) / 12.0f) * LOG2E; }

struct Args { const float* in[22]; float* out; unsigned char* ws; int ph_lo, ph_hi, skip, rep; };
typedef const __attribute__((address_space(4))) Args* KArgsP;
struct Frame {
    LAS unsigned char* lds;
    int tid, lane, wave, vcu, G, bx;
    unsigned char* ws;
};

template <int MODE> __device__ __forceinline__ int dmap(int n) {
    if (MODE == 1) { if (n < 832) return n; if (n < 848) return 832 + 2 * (n - 832); if (n < 864) return 832 + 2 * (n - 848) + 1; if (n < 1516) return n; return n + 4; }
    if (MODE == 2) { const int hd = n / 96, w = n - hd * 96; if (w < 64) return hd * 64 + w; if (w < 80) return 256 + hd * 32 + 2 * (w - 64); return 256 + hd * 32 + 2 * (w - 80) + 1; }
    return n;
}
template <int MODE> __device__ __forceinline__ float cscale(int n) {
    if (MODE == 1) { return (n < 256 || (n >= 864 && n < 1120) || (n >= 1516 && n < 1772)) ? QS : 1.f; }
    if (MODE == 2) return C_MLA;
    return 1.f;
}
template <int MODE> __device__ __forceinline__ void transpose_item(const float* W, int N, bf16* WT, int KT, const float* kscale, LAS float* scr, int item, int lane) {
    const int nblk = (N + 31) / 32, kb = item / nblk, nb = item % nblk, k0 = 64 * kb, n0 = 32 * nb;
    const int nl = lane & 31, n = n0 + nl;
    float tv[32];
#pragma unroll
    for (int i = 0; i < 32; ++i) { const int kk = 2 * i + (lane >> 5); tv[i] = (n < N) ? W[(size_t)(k0 + kk) * N + n] : 0.f; }
#pragma unroll
    for (int i = 0; i < 32; ++i) { const int kk = 2 * i + (lane >> 5); float v = tv[i]; if (kscale) v *= kscale[k0 + kk]; scr[kk * 33 + nl] = v; }
    LDS_WAIT(); asm volatile("" ::: "memory");
    const int c = lane & 7;
#pragma unroll
    for (int j = 0; j < 4; ++j) { const int nn = (lane >> 3) + 8 * j, ng = n0 + nn;
        if (ng < N) { const float cs = cscale<MODE>(ng); const LAS float* s = scr + (8 * c) * 33 + nn;
            v4u o; o.x = pk2(s[0 * 33] * cs, s[1 * 33] * cs); o.y = pk2(s[2 * 33] * cs, s[3 * 33] * cs); o.z = pk2(s[4 * 33] * cs, s[5 * 33] * cs); o.w = pk2(s[6 * 33] * cs, s[7 * 33] * cs);
            *(GAS v4u*)(WT + (size_t)dmap<MODE>(ng) * KT + k0 + 8 * c) = o; } }
    LDS_WAIT(); asm volatile("" ::: "memory");
}
__device__ __forceinline__ void zero_fill16(bf16* p, size_t n16, int gtid, int gthreads) {
    for (size_t i = gtid; i < n16; i += gthreads) ((GAS v4u*)p)[i] = (v4u){0u, 0u, 0u, 0u};
}

__device__ __forceinline__ void p_prologue(Frame& F, KArgsP ap_) {
#define a (*ap_)
    LAS float* scr = (LAS float*)(F.lds + F.wave * 16384);
    const int gw = F.vcu * NWAVES + F.wave, NGW = F.G * NWAVES;
    const int gtid = F.vcu * NTHR + F.tid, GT = F.G * NTHR;
    constexpr int I_IN = 16 * 72, I_OUT = 16 * 32, I_UP = 16 * 128, I_DN = 64 * 32, I_UQ = 3 * 12, I_UKV = 2 * 16, I_W1 = 32 * 4, I_W2 = 2 * 2;
    constexpr int PER_L = I_IN + I_OUT + I_UP + I_DN + I_UQ + I_UKV + 2 * I_W1 + 2 * I_W2;
    for (int it = gw; it < DEPTH * PER_L; it += NGW) {
        const int l = it / PER_L; int r = it - l * PER_L;
        unsigned char* wb = F.ws + WS_W + (size_t)l * WS_WL;
        if (r < I_IN) { transpose_item<1>(a.in[6] + (size_t)l * D * DIN, DIN, (bf16*)(wb + W_IN), D, nullptr, scr, r, F.lane); continue; } r -= I_IN;
        if (r < I_OUT) { transpose_item<0>(a.in[7] + (size_t)l * D * D, D, (bf16*)(wb + W_OUT), D, nullptr, scr, r, F.lane); continue; } r -= I_OUT;
        if (r < I_UP) { transpose_item<0>(a.in[19] + (size_t)l * D * DFF, DFF, (bf16*)(wb + W_UP), D, nullptr, scr, r, F.lane); continue; } r -= I_UP;
        if (r < I_DN) { transpose_item<0>(a.in[20] + (size_t)l * DFF * D, D, (bf16*)(wb + W_DN), DFF, nullptr, scr, r, F.lane); continue; } r -= I_DN;
        if (r < I_UQ) { transpose_item<2>(a.in[11] + (size_t)l * 192 * 384, 384, (bf16*)(wb + W_UQ), 256, a.in[9] + l * 192, scr, r, F.lane); continue; } r -= I_UQ;
        if (r < I_UKV) { transpose_item<0>(a.in[12] + (size_t)l * 128 * 512, 512, (bf16*)(wb + W_UKV), 256, a.in[10] + l * 128, scr, r, F.lane); continue; } r -= I_UKV;
        if (r < I_W1) { transpose_item<0>(a.in[15] + (size_t)l * 2048 * 128, 128, (bf16*)(wb + W_1K), 2048, nullptr, scr, r, F.lane); continue; } r -= I_W1;
        if (r < I_W1) { transpose_item<0>(a.in[17] + (size_t)l * 2048 * 128, 128, (bf16*)(wb + W_1V), 2048, nullptr, scr, r, F.lane); continue; } r -= I_W1;
        if (r < I_W2) { transpose_item<0>(a.in[16] + (size_t)l * 128 * 64, 64, (bf16*)(wb + W_2K), 128, nullptr, scr, r, F.lane); continue; } r -= I_W2;
        transpose_item<0>(a.in[18] + (size_t)l * 128 * 64, 64, (bf16*)(wb + W_2V), 128, nullptr, scr, r, F.lane);
    }
    for (int l = 0; l < DEPTH; ++l) {
        unsigned char* wb = F.ws + WS_W + (size_t)l * WS_WL;
        zero_fill16((bf16*)(wb + W_IN) + (size_t)1516 * D, 4 * D / 8, gtid, GT);
        zero_fill16((bf16*)(wb + W_IN) + (size_t)2288 * D, 16 * D / 8, gtid, GT);
        zero_fill16((bf16*)(wb + W_UQ) + (size_t)384 * 256, 128 * 256 / 8, gtid, GT);
        for (int i = gtid; i < 384 * 8; i += GT) ((GAS v4u*)((bf16*)(wb + W_UQ) + (size_t)(i >> 3) * 256 + 192))[i & 7] = (v4u){0u, 0u, 0u, 0u};
        for (int i = gtid; i < 512 * 16; i += GT) ((GAS v4u*)((bf16*)(wb + W_UKV) + (size_t)(i >> 4) * 256 + 128))[i & 15] = (v4u){0u, 0u, 0u, 0u};
    }
    { float* rt = (float*)(F.ws + WS_ROPE);
      for (int i = gtid; i < SEQ * 16; i += GT) { const int ii = i & 15, t = i >> 4; const float freq = powf(10000.f, -(float)ii / 16.f), ang = (float)t * freq; rt[2 * i] = cosf(ang); rt[2 * i + 1] = sinf(ang); } }
    { float* pp = (float*)(F.ws + WS_POSP);
      for (int i = gtid; i < DEPTH * 2 * 32 * 128; i += GT) { const int j = i & 127, kr = (i >> 7) & 31, wh = (i >> 12) & 1, l = i >> 13;
          const float* pos = a.in[wh ? 14 : 13] + l * 2048 + kr * 64; const float* w1 = a.in[wh ? 17 : 15] + (size_t)l * 2048 * 128 + (size_t)kr * 64 * 128 + j;
          float s = 0.f;
#pragma unroll 32
          for (int k = 0; k < 64; ++k) s += pos[k] * w1[(size_t)k * 128];
          pp[i] = s; } }
    { LAS float* sc = (LAS float*)(F.lds);
      LAS float* part = (LAS float*)(F.lds + 16384);
      __syncthreads();
      bool have = false;
      for (int it = F.vcu; it < DEPTH * 96; it += F.G) {
          if (!have) { for (int i = F.tid; i < NB * D; i += NTHR) { const float cv = a.in[1][i]; sc[i] = cv / (1.f + expf(-cv)); } have = true; __syncthreads(); }
          const int l = it / 96, ch = it % 96; const int j = ch * 64 + F.lane;
          const float* w = a.in[4] + (size_t)l * D * 6 * D + j;
          float acc[4] = {0.f, 0.f, 0.f, 0.f};
#pragma unroll 32
          for (int k = 128 * F.wave; k < 128 * F.wave + 128; ++k) { const float wv = w[(size_t)k * 6 * D]; acc[0] += sc[k] * wv; acc[1] += sc[D + k] * wv; acc[2] += sc[2 * D + k] * wv; acc[3] += sc[3 * D + k] * wv; }
#pragma unroll
          for (int b = 0; b < 4; ++b) part[(F.wave * 4 + b) * 64 + F.lane] = acc[b];
          __syncthreads();
          if (F.tid < 256) { const int b = F.tid >> 6, ln = F.tid & 63; float s = a.in[5][l * 6 * D + ch * 64 + ln];
#pragma unroll
              for (int w8 = 0; w8 < 8; ++w8) s += part[(w8 * 4 + b) * 64 + ln];
              ((float*)(F.ws + WS_MOD))[((size_t)l * NB + b) * 6 * D + ch * 64 + ln] = s; }
          __syncthreads();
      } }
}

#undef a
template <int MODE, bool XB16> __device__ __forceinline__ void p_norm(Frame& F, const void* x, const float* g, const float* modsh, const float* modsc, bf16* hout, float* fout) {
    const int gw = F.vcu * NWAVES + F.wave, NGW = F.G * NWAVES;
    for (int blk = gw; blk < M / 16; blk += NGW) {
        const int row0 = blk * 16, b = row0 >> 13;
        f32x4 ga[4], sh[4];
#pragma unroll
        for (int j = 0; j < 4; ++j) { const int c = 4 * F.lane + 256 * j; ga[j] = *(const f32x4*)(g + c);
            if (MODE == 0) { const f32x4 s = *(const f32x4*)(modsc + (size_t)b * 6 * D + c); ga[j] = ga[j] * (s + 1.0f); sh[j] = *(const f32x4*)(modsh + (size_t)b * 6 * D + c); } }
        for (int rr = 0; rr < 16; rr += 4) {
            f32x4 v[4][4];
#pragma unroll
            for (int q = 0; q < 4; ++q) { const int row = row0 + rr + q;
                if (XB16) { const GAS unsigned long long* xr = (const GAS unsigned long long*)((const bf16*)x + (size_t)row * D) + F.lane;
#pragma unroll
                    for (int j = 0; j < 4; ++j) { const unsigned long long qq = xr[64 * j]; const unsigned lo = (unsigned)qq, hi = (unsigned)(qq >> 32);
                        v[q][j] = (f32x4){__uint_as_float(lo << 16), __uint_as_float(lo & 0xffff0000u), __uint_as_float(hi << 16), __uint_as_float(hi & 0xffff0000u)}; } }
                else { const GAS f32x4* xr = (const GAS f32x4*)((const float*)x + (size_t)row * D) + F.lane;
#pragma unroll
                    for (int j = 0; j < 4; ++j) v[q][j] = xr[64 * j]; } }
#pragma unroll
            for (int q = 0; q < 4; ++q) { const int row = row0 + rr + q; float s = 0.f;
#pragma unroll
                for (int j = 0; j < 4; ++j) s += (v[q][j].x * v[q][j].x + v[q][j].y * v[q][j].y) + (v[q][j].z * v[q][j].z + v[q][j].w * v[q][j].w);
                const float r = rsqrtf(wave_sum(s) * (1.f / D) + RMS_EPS);
                if (MODE == 0) { GAS unsigned long long* o8 = (GAS unsigned long long*)(hout + (size_t)row * D) + F.lane;
#pragma unroll
                    for (int j = 0; j < 4; ++j) { const f32x4 y = v[q][j] * r * ga[j] + sh[j]; o8[64 * j] = (unsigned long long)pk2(y.x, y.y) | ((unsigned long long)pk2(y.z, y.w) << 32); } }
                else { GAS f32x4* o = (GAS f32x4*)(fout + (size_t)row * D) + F.lane;
#pragma unroll
                    for (int j = 0; j < 4; ++j) o[64 * j] = v[q][j] * r * ga[j]; } }
        }
    }
}

__device__ __forceinline__ void p_prep(Frame& F, int l) {
    const int gw = F.vcu * NWAVES + F.wave, NGW = F.G * NWAVES;
    const bf16* Z = (const bf16*)(F.ws + WS_Z); bf16* KM = (bf16*)(F.ws + WS_KM);
    float* rsq = (float*)(F.ws + WS_RSQ); float* rskv = (float*)(F.ws + WS_RSKV); const float* rope = (const float*)(F.ws + WS_ROPE);
    for (int rb = gw; rb < M / 4; rb += NGW) {
        float a0[4], a1[4], a2[4], b0[4], b1[4]; unsigned pr[4] = {0u, 0u, 0u, 0u}; float cs[4] = {0.f, 0.f, 0.f, 0.f}, sn[4] = {0.f, 0.f, 0.f, 0.f};
#pragma unroll
        for (int q = 0; q < 4; ++q) { const int row = rb * 4 + q; const bf16* zr = Z + (size_t)row * ZLD;
            a0[q] = bf2f(zr[ZB_CQ + F.lane]); a1[q] = bf2f(zr[ZB_CQ + 64 + F.lane]); a2[q] = bf2f(zr[ZB_CQ + 128 + F.lane]);
            b0[q] = bf2f(zr[ZB_CKV + F.lane]); b1[q] = bf2f(zr[ZB_CKV + 64 + F.lane]);
            if (F.lane < 16) { pr[q] = *(const unsigned*)(zr + ZB_PE + 2 * F.lane); cs[q] = rope[((size_t)(row & 8191) * 16 + F.lane) * 2]; sn[q] = rope[((size_t)(row & 8191) * 16 + F.lane) * 2 + 1]; } }
#pragma unroll
        for (int q = 0; q < 4; ++q) { const int row = rb * 4 + q;
            const float sq = wave_sum(a0[q] * a0[q] + a1[q] * a1[q] + a2[q] * a2[q]), skv = wave_sum(b0[q] * b0[q] + b1[q] * b1[q]);
            if (F.lane == 0) { rsq[row] = rsqrtf(sq * (1.f / 192.f) + RMS_EPS); rskv[row] = rsqrtf(skv * (1.f / 128.f) + RMS_EPS); }
            if (F.lane < 16) { const float x1 = bf2f((unsigned short)(pr[q] & 0xffffu)), x2 = bf2f((unsigned short)(pr[q] >> 16));
                const unsigned o = pk2(x1 * cs[q] - x2 * sn[q], x1 * sn[q] + x2 * cs[q]);
#pragma unroll
                for (int hd = 0; hd < 4; ++hd) *(unsigned*)(KM + (size_t)row * 384 + hd * 96 + 64 + 2 * F.lane) = o; } }
    }
    { bf16* KMH = (bf16*)(F.ws + WS_KMH); bf16* KML = (bf16*)(F.ws + WS_KML);
      for (int it = gw; it < NB * 4 * 32; it += NGW) { const int j = it & 31, hd = (it >> 5) & 3, b = it >> 7; const int ts = F.lane >> 3, ch = F.lane & 7;
          float acc[8] = {0.f, 0.f, 0.f, 0.f, 0.f, 0.f, 0.f, 0.f};
#pragma unroll 8
          for (int i = 0; i < 32; ++i) { const v4u w = *(const v4u*)(Z + (size_t)(b * SEQ + j * 256 + 8 * i + ts) * ZLD + ZD_K + hd * 64 + ch * 8);
#pragma unroll
              for (int e = 0; e < 4; ++e) { acc[2 * e] += __uint_as_float(w[e] << 16); acc[2 * e + 1] += __uint_as_float(w[e] & 0xffff0000u); } }
#pragma unroll
          for (int e = 0; e < 8; ++e) { acc[e] += __shfl_xor(acc[e], 8); acc[e] += __shfl_xor(acc[e], 16); acc[e] += __shfl_xor(acc[e], 32); }
          if (F.lane < 8) { unsigned hi[4], lo[4];
#pragma unroll
              for (int e = 0; e < 4; ++e) { const float m0 = acc[2 * e] * (1.f / 256.f), m1 = acc[2 * e + 1] * (1.f / 256.f); const unsigned h0 = f2bf(m0), h1 = f2bf(m1);
                  hi[e] = h0 | (h1 << 16); lo[e] = pk2(m0 - __uint_as_float(h0 << 16), m1 - __uint_as_float(h1 << 16)); }
              *(v4u*)(KMH + (size_t)it * 64 + ch * 8) = (v4u){hi[0], hi[1], hi[2], hi[3]}; *(v4u*)(KML + (size_t)it * 64 + ch * 8) = (v4u){lo[0], lo[1], lo[2], lo[3]}; } } }
    if (gw == 0) { const float* pp = (const float*)(F.ws + WS_POSP) + (size_t)l * 2 * 32 * 128; float* pb = (float*)(F.ws + WS_POSB) + l * 256;
        for (int i = F.lane; i < 256; i += 64) { const int j = i & 127, wh = i >> 7; float s = 0.f; for (int kr = 0; kr < 32; ++kr) s += pp[(wh * 32 + kr) * 128 + j]; pb[i] = s; } }
}

__device__ __forceinline__ float gelu_tanh(float x) { const float u = 0.7978845608028654f * (x + 0.044715f * x * x * x); const float e = __expf(2.f * u); return x * (1.f - 1.f / (e + 1.f)); }
__device__ __forceinline__ void p_compress(Frame& F, int l) {
    const bf16* Z = (const bf16*)(F.ws + WS_Z);
    unsigned char* wb = F.ws + WS_W + (size_t)l * WS_WL;
    LAS float* red = (LAS float*)F.lds;
    const int r = F.lane & 31, h = F.lane >> 5;
    for (int it = F.vcu; it < NB * 16 * 2; it += F.G) {
        const int which = it & 1, itile = (it >> 1) & 15, b = it >> 5;
        const bf16* W1T = (const bf16*)(wb + (which ? W_1V : W_1K)); const bf16* W2T = (const bf16*)(wb + (which ? W_2V : W_2K));
        const int coff = which ? ZC_VC : ZC_KC;
        f32x16 acc[4] = {f32x16{}, f32x16{}, f32x16{}, f32x16{}};
        const bf16* brow = Z + (size_t)(b * SEQ + 16 * (32 * itile + r)) * ZLD + coff + 8 * h;
#pragma unroll 2
        for (int ks = 0; ks < 16; ++ks) { const int tt = 4 * F.wave + (ks >> 2), d0 = ks & 3;
            const bf16x8 bf = *(const bf16x8*)(brow + (size_t)tt * ZLD + d0 * 16);
#pragma unroll
            for (int hb = 0; hb < 4; ++hb) { const bf16x8 af = *(const bf16x8*)(W1T + (size_t)(hb * 32 + r) * 2048 + tt * 64 + d0 * 16 + 8 * h);
                acc[hb] = __builtin_amdgcn_mfma_f32_32x32x16_bf16(af, bf, acc[hb], 0, 0, 0); } }
#pragma unroll
        for (int hb = 0; hb < 4; ++hb)
#pragma unroll
            for (int v = 0; v < 16; ++v) red[((F.wave * 4 + hb) * 16 + v) * 64 + F.lane] = acc[hb][v];
        __syncthreads();
        if (F.wave < 2) {
            const float* pb = (const float*)(F.ws + WS_POSB) + l * 256 + which * 128;
            f32x16 o = f32x16{};
#pragma unroll
            for (int hb = 0; hb < 4; ++hb) { float x[16];
#pragma unroll
                for (int v = 0; v < 16; ++v) { float s = pb[hb * 32 + (v & 3) + 8 * (v >> 2) + 4 * h];
#pragma unroll
                    for (int w8 = 0; w8 < 8; ++w8) s += red[((w8 * 4 + hb) * 16 + v) * 64 + F.lane];
                    x[v] = gelu_tanh(s); }
#pragma unroll
                for (int s2 = 0; s2 < 2; ++s2) {
                    v4u pw; pw.x = fa::cvtpk(x[8 * s2], x[8 * s2 + 1]); pw.y = fa::cvtpk(x[8 * s2 + 2], x[8 * s2 + 3]); pw.z = fa::cvtpk(x[8 * s2 + 4], x[8 * s2 + 5]); pw.w = fa::cvtpk(x[8 * s2 + 6], x[8 * s2 + 7]);
                    const bf16* wr = W2T + (size_t)(F.wave * 32 + r) * 128 + hb * 32 + 16 * s2 + 4 * h;
                    const v2u a0 = *(const v2u*)wr, a1 = *(const v2u*)(wr + 8);
                    const v4u aw = (v4u){a0.x, a0.y, a1.x, a1.y};
                    o = __builtin_amdgcn_mfma_f32_32x32x16_bf16(__builtin_bit_cast(bf16x8, aw), __builtin_bit_cast(bf16x8, pw), o, 0, 0, 0); } }
            bf16* dst = (bf16*)(F.ws + (which ? WS_VCMP : WS_KCMP)) + (size_t)(b * 512 + 32 * itile + r) * 64 + F.wave * 32 + 4 * h;
#pragma unroll
            for (int g = 0; g < 4; ++g) { v2u w; w.x = fa::cvtpk(o[4 * g], o[4 * g + 1]); w.y = fa::cvtpk(o[4 * g + 2], o[4 * g + 3]); *(v2u*)(dst + 8 * g) = w; }
        }
        __syncthreads();
    }
}
using fa::bf16x8;
__device__ __forceinline__ unsigned char* launder_ptr(unsigned char* p) { const unsigned long long v = (unsigned long long)p; unsigned lo = __builtin_amdgcn_readfirstlane((unsigned)v), hi = __builtin_amdgcn_readfirstlane((unsigned)(v >> 32)); asm volatile("" : "+s"(lo), "+s"(hi)); return (unsigned char*)(((unsigned long long)hi << 32) | lo); }
#define UNIT_BEGIN() Frame F = F0; { int tid_ = F0.tid; asm volatile("" : "+v"(tid_)); int bx_ = __builtin_amdgcn_readfirstlane(F0.bx); asm volatile("" : "+s"(bx_)); \
    F.ws = launder_ptr(F0.ws); F.tid = tid_; F.lane = tid_ & 63; F.wave = __builtin_amdgcn_readfirstlane(tid_ >> 6); F.bx = bx_; }
__device__ __forceinline__ void u_mla(const Frame& F0, int b, int hd, int u) {
    UNIT_BEGIN();
    GAS char* ws = (GAS char*)F.ws;
    const int r = F.lane & 31, h = F.lane >> 5, q0 = 256 * u, wq0 = q0 + 32 * F.wave, tq = wq0 + r;
    bf16x8 qf[6]; { const unsigned qrow = (unsigned)WS_QM + (unsigned)(b * SEQ + tq) * 1024u;
      const float rs = *(const GAS float*)(ws + ((unsigned)WS_RSQ + (unsigned)(b * SEQ + tq) * 4u));
#pragma unroll
      for (int d0 = 0; d0 < 4; ++d0) { const fa::u32x4 raw = *(const GAS fa::u32x4*)(ws + (qrow + (unsigned)(hd * 128 + d0 * 32 + 16 * h))); fa::u32x4 o;
          o.x = fa::cvtpk(__uint_as_float(raw.x << 16) * rs, __uint_as_float(raw.x & 0xffff0000u) * rs); o.y = fa::cvtpk(__uint_as_float(raw.y << 16) * rs, __uint_as_float(raw.y & 0xffff0000u) * rs);
          o.z = fa::cvtpk(__uint_as_float(raw.z << 16) * rs, __uint_as_float(raw.z & 0xffff0000u) * rs); o.w = fa::cvtpk(__uint_as_float(raw.w << 16) * rs, __uint_as_float(raw.w & 0xffff0000u) * rs);
          qf[d0] = __builtin_bit_cast(bf16x8, o); }
#pragma unroll
      for (int d0 = 0; d0 < 2; ++d0) {
          const fa::u32x4 raw = *(const GAS fa::u32x4*)(ws + (qrow + (unsigned)(512 + hd * 64 + d0 * 32 + 16 * h)));
          const GAS float* rp = (const GAS float*)(ws + ((unsigned)WS_ROPE + (unsigned)((tq * 16 + d0 * 8 + 4 * h) * 8)));
          const fa::f32x4v r0 = *(const GAS fa::f32x4v*)rp * rs, r1 = *(const GAS fa::f32x4v*)(rp + 4) * rs;
          fa::u32x4 o;
          { const float x1 = __uint_as_float(raw.x << 16), x2 = __uint_as_float(raw.x & 0xffff0000u); o.x = fa::cvtpk(x1 * r0[0] - x2 * r0[1], x1 * r0[1] + x2 * r0[0]); }
          { const float x1 = __uint_as_float(raw.y << 16), x2 = __uint_as_float(raw.y & 0xffff0000u); o.y = fa::cvtpk(x1 * r0[2] - x2 * r0[3], x1 * r0[3] + x2 * r0[2]); }
          { const float x1 = __uint_as_float(raw.z << 16), x2 = __uint_as_float(raw.z & 0xffff0000u); o.z = fa::cvtpk(x1 * r1[0] - x2 * r1[1], x1 * r1[1] + x2 * r1[0]); }
          { const float x1 = __uint_as_float(raw.w << 16), x2 = __uint_as_float(raw.w & 0xffff0000u); o.w = fa::cvtpk(x1 * r1[2] - x2 * r1[3], x1 * r1[3] + x2 * r1[2]); }
          qf[4 + d0] = __builtin_bit_cast(bf16x8, o); } }
    SM st; fa::sm_init(st);
    LAS char* lds = (LAS char*)F.lds;
    fa::fa_loop<96, false>(st, qf, ws, (unsigned)WS_KM + (unsigned)b * (SEQ * 768u) + (unsigned)hd * 192u, 768u, (unsigned)WS_VM + (unsigned)b * (SEQ * 512u) + (unsigned)hd * 128u, 512u, SEQ - 1, 4 * u + 4,
        [](int t) { return 64 * t; },
        [=](int t, bool& act, bool& ew, float& cb, int& lo, int& hi) { const int key0 = 64 * t; act = key0 <= wq0 + 31; ew = key0 + 63 > wq0; cb = 0.f; lo = -100000; hi = tq - key0; },
        0.f, lds + FA_STAGES, F.tid, F.lane);
    f32x16 acc[2] = {f32x16{}, f32x16{}}; fa::sm_finish(st, 1.f, acc);
    fa::store_out(acc, lds + FA_OST + F.wave * 32 * fa::OSTR, ws, [=](int col) { return (unsigned)WS_O + (unsigned)(b * SEQ + wq0 + col) * 2048u + (unsigned)(256 + hd * 64) * 2u; }, F.lane);
}
__device__ __forceinline__ void u_moba(const Frame& F0, int b, int hd, int i) {
    UNIT_BEGIN();
    GAS char* ws = (GAS char*)F.ws;
    const int r = F.lane & 31, h = F.lane >> 5, q0 = 256 * i, wq0 = q0 + 32 * F.wave, tq = wq0 + r;
    bf16x8 qf[4]; fa::load_q<64>(qf, ws, (unsigned)WS_Z + (unsigned)(b * SEQ + tq) * (ZLD * 2u) + (unsigned)(ZD_Q + hd * 64) * 2u, h);
    unsigned bits = 0u;
    if (i > 0) {
        const GAS bf16* KMH = (const GAS bf16*)(ws + ((unsigned)WS_KMH + (unsigned)(((b * 4 + hd) * 32 + r) * 64 + 8 * h) * 2u)); const GAS bf16* KML = (const GAS bf16*)(ws + ((unsigned)WS_KML + (unsigned)(((b * 4 + hd) * 32 + r) * 64 + 8 * h) * 2u));
        f32x16 g = f32x16{};
#pragma unroll
        for (int d0 = 0; d0 < 4; ++d0) { const bf16x8 ah = *(const GAS bf16x8*)(KMH + d0 * 16), al = *(const GAS bf16x8*)(KML + d0 * 16);
            g = __builtin_amdgcn_mfma_f32_32x32x16_bf16(ah, qf[d0], g, 0, 0, 0); g = __builtin_amdgcn_mfma_f32_32x32x16_bf16(al, qf[d0], g, 0, 0, 0); }
        float og[16];
#pragma unroll
        for (int v = 0; v < 16; ++v) { const int j = (v & 3) + 8 * (v >> 2) + 4 * h; if (j >= i) g[v] = -INFINITY; og[v] = __shfl_xor(g[v], 32); }
#pragma unroll
        for (int v = 0; v < 16; ++v) { const int j = (v & 3) + 8 * (v >> 2) + 4 * h; int rank = 0;
#pragma unroll
            for (int w = 0; w < 16; ++w) { const int jm = (w & 3) + 8 * (w >> 2) + 4 * h, jo = (w & 3) + 8 * (w >> 2) + 4 * (1 - h);
                rank += (g[w] > g[v] || (g[w] == g[v] && jm < j)) ? 1 : 0; rank += (og[w] > g[v] || (og[w] == g[v] && jo < j)) ? 1 : 0; }
            if (rank < 3 && j < i) bits |= 1u << j; }
        bits |= __shfl_xor(bits, 32);
    }
    const float sl = slope2_of(2 + 3 * hd);
    LAS char* lds = (LAS char*)F.lds;
    LAS float* Ost = (LAS float*)(lds + MB_O);
    LAS float* MLst = (LAS float*)(lds + MB_ML);
    LAS unsigned* cnt = (LAS unsigned*)(lds + MB_CNT);
    LAS unsigned char* lst = (LAS unsigned char*)(lds + MB_LST);
    const unsigned koff = (unsigned)WS_Z + (unsigned)b * (SEQ * ZLD * 2u) + (unsigned)(ZD_K + hd * 64) * 2u, voff = (unsigned)WS_Z + (unsigned)b * (SEQ * ZLD * 2u) + (unsigned)(ZD_V + hd * 64) * 2u;
    if (F.tid < 32) cnt[F.tid] = 0u;
    {
        SM st; fa::sm_init(st);
        fa::fa_loop<64, true>(st, qf, ws, koff, ZLD * 2u, voff, ZLD * 2u, SEQ - 1, 4,
            [=](int t) { return q0 + 64 * t; },
            [=](int t, bool& act, bool& ew, float& cb, int& lo, int& hi) { const int key0 = q0 + 64 * t; act = key0 <= wq0 + 31; ew = key0 + 63 > wq0; cb = sl * (float)(64 * t + 4 * h); lo = -100000; hi = tq - key0; },
            sl, lds + FA_STAGES, F.tid, F.lane);
        const float lt = fa::xhalf_sum(st.l);
        LAS float* orow = Ost + (32 * F.wave + r) * MB_OS;
#pragma unroll
        for (int db = 0; db < 2; ++db)
#pragma unroll
            for (int g = 0; g < 4; ++g)
#pragma unroll
                for (int e = 0; e < 4; ++e) orow[32 * db + 8 * g + 4 * h + e] = st.o[db][4 * g + e];
        if (h == 0) { MLst[(32 * F.wave + r) * 2] = st.m; MLst[(32 * F.wave + r) * 2 + 1] = lt; }
    }
    if (h == 0) { unsigned bb = bits;
        while (bb) { const int j = __ffs(bb) - 1; bb &= bb - 1u; const unsigned slot = __hip_atomic_fetch_add(&cnt[j], 1u, __ATOMIC_RELAXED, __HIP_MEMORY_SCOPE_WORKGROUP); lst[j * 256 + slot] = (unsigned char)(32 * F.wave + r); } }
    LDS_WAIT(); __syncthreads();
    if (i > 0) {
        LAS unsigned* PS = (LAS unsigned*)(lds + MB_PS);
        LAS float* PM = (LAS float*)(lds + MB_PM);
        const unsigned qbase = (unsigned)WS_Z + (unsigned)(b * SEQ + q0) * (ZLD * 2u) + (unsigned)(ZD_Q + hd * 64) * 2u;
        const int tt = F.wave & 3, g4 = F.wave >> 2;
        fa::Stg<64> s0, s1, s2, s3;
#define MB_LOADBLK(J) { fa::stg_load<64>(s0, ws, koff, ZLD * 2u, voff, ZLD * 2u, 256 * (J), SEQ - 1, F.tid); fa::stg_load<64>(s1, ws, koff, ZLD * 2u, voff, ZLD * 2u, 256 * (J) + 64, SEQ - 1, F.tid); \
                        fa::stg_load<64>(s2, ws, koff, ZLD * 2u, voff, ZLD * 2u, 256 * (J) + 128, SEQ - 1, F.tid); fa::stg_load<64>(s3, ws, koff, ZLD * 2u, voff, ZLD * 2u, 256 * (J) + 192, SEQ - 1, F.tid); }
        MB_LOADBLK(0)
        const int ql = 8 * tt + (F.lane >> 3), l7 = F.lane & 7;
        for (int j = 0; j < i; ++j) {
            const int n = (int)cnt[j];
            bool myact = 32 * g4 < n, colv = (32 * g4 + r) < n; int qsel = colv ? (int)lst[j * 256 + 32 * g4 + r] : 0;
            bf16x8 qfb[4] = {qf[0], qf[1], qf[2], qf[3]};
            if (myact) fa::load_q<64>(qfb, ws, qbase + (unsigned)qsel * (ZLD * 2u), h);
            fa::stg_store<64>(s0, lds + MB_T, F.tid); fa::stg_store<64>(s1, lds + MB_T + 16384, F.tid); fa::stg_store<64>(s2, lds + MB_T + 32768, F.tid); fa::stg_store<64>(s3, lds + MB_T + 49152, F.tid);
            if (j + 1 < i) MB_LOADBLK(j + 1)
            LDS_WAIT(); __syncthreads();
            for (int rd = 0; 64 * rd < n; ++rd) {
                const int grp = 2 * rd + g4;
                if (rd > 0) { LDS_WAIT(); __syncthreads();
                    myact = 32 * grp < n; colv = (32 * grp + r) < n; qsel = colv ? (int)lst[j * 256 + 32 * grp + r] : 0;
                    if (myact) fa::load_q<64>(qfb, ws, qbase + (unsigned)qsel * (ZLD * 2u), h); }
                const bool two = 32 * (2 * rd + 1) < n;
                const bool fv = (32 * grp + ql) < n; const int qs = fv ? (int)lst[j * 256 + 32 * grp + ql] : 0;
                const float ms = MLst[qs * 2], ls = MLst[qs * 2 + 1];
                LAS float* orow = Ost + qs * MB_OS + 8 * l7;
                float acc8[8];
#pragma unroll
                for (int x = 0; x < 8; ++x) acc8[x] = orow[x];
                SM st; fa::sm_init(st); float lp = 0.f;
                if (myact) {
                    const LAS char* buf = lds + MB_T + tt * 16384;
                    fa::f32x16 p0, p1; bf16x8 pf[4];
                    fa::score_tile<64, true>(p0, p1, buf, qfb, colv ? sl * (float)(256 * j + 64 * tt - q0 + 4 * h) : fa::MASKV, sl, F.lane);
                    fa::sm_step(st, p0, p1, pf);
                    fa::pv(st.o, buf + 8192, pf, F.lane);
                    lp = fa::xhalf_sum(st.l);
                }
#pragma unroll 1
                for (int ph = 0; ph < 2; ++ph) {
                    if (ph == 1 && !two) break;
                    if (ph == 1) { LDS_WAIT(); __syncthreads(); }
                    if (g4 == ph && myact) {
                        LAS unsigned* ps = PS + (tt * 32 + r) * 33 + 2 * h;
#pragma unroll
                        for (int db = 0; db < 2; ++db)
#pragma unroll
                            for (int g = 0; g < 4; ++g) { ps[16 * db + 4 * g] = fa::cvtpk(st.o[db][4 * g], st.o[db][4 * g + 1]); ps[16 * db + 4 * g + 1] = fa::cvtpk(st.o[db][4 * g + 2], st.o[db][4 * g + 3]); }
                        if (h == 0) { PM[(tt * 32 + r) * 2] = st.m; PM[(tt * 32 + r) * 2 + 1] = lp; }
                    }
                    LDS_WAIT(); __syncthreads();
                    if (g4 == ph && fv) {
                        const float m0 = PM[ql * 2], l0 = PM[ql * 2 + 1], m1 = PM[(32 + ql) * 2], l1 = PM[(32 + ql) * 2 + 1], m2 = PM[(64 + ql) * 2], l2 = PM[(64 + ql) * 2 + 1], m3 = PM[(96 + ql) * 2], l3 = PM[(96 + ql) * 2 + 1];
                        const float mn = fmaxf(fmaxf(fmaxf(m0, m1), fmaxf(m2, m3)), ms);
                        const float ea = fa::ex2(ms - mn), e0 = fa::ex2(m0 - mn), e1 = fa::ex2(m1 - mn), e2 = fa::ex2(m2 - mn), e3 = fa::ex2(m3 - mn);
                        const LAS unsigned* pr = PS + ql * 33 + 4 * l7;
#pragma unroll
                        for (int x = 0; x < 4; ++x) { const unsigned w0 = pr[x], w1 = pr[32 * 33 + x], w2 = pr[64 * 33 + x], w3 = pr[96 * 33 + x];
                            orow[2 * x] = acc8[2 * x] * ea + ((__uint_as_float(w0 << 16) * e0 + __uint_as_float(w1 << 16) * e1) + (__uint_as_float(w2 << 16) * e2 + __uint_as_float(w3 << 16) * e3));
                            orow[2 * x + 1] = acc8[2 * x + 1] * ea + ((__uint_as_float(w0 & 0xffff0000u) * e0 + __uint_as_float(w1 & 0xffff0000u) * e1) + (__uint_as_float(w2 & 0xffff0000u) * e2 + __uint_as_float(w3 & 0xffff0000u) * e3)); }
                        if (l7 == 0) { MLst[qs * 2] = mn; MLst[qs * 2 + 1] = ls * ea + ((l0 * e0 + l1 * e1) + (l2 * e2 + l3 * e3)); }
                    }
                }
            }
        }
#undef MB_LOADBLK
        LDS_WAIT(); __syncthreads();
#if FA_PROBE == 9
        if (F.lane == 0 && F.wave == FA_KO) { unsigned long long* pp = (unsigned long long*)((GAS char*)ws + 32768);
            atomicAdd(pp + 0, pq0); atomicAdd(pp + 1, pq1); atomicAdd(pp + 2, pq2); atomicAdd(pp + 3, pqn); atomicAdd(pp + 4, pq3); }
#endif
    }
    { const int q = 32 * F.wave + (F.lane >> 1), hf = F.lane & 1; const float inv = 1.f / fmaxf(MLst[q * 2 + 1], fa::TINYF);
      const LAS float* orow = Ost + q * MB_OS + 32 * hf;
      GAS char* dst = ws + ((unsigned)WS_O + (unsigned)(b * SEQ + q0 + q) * 2048u + (unsigned)(768 + hd * 64 + 32 * hf) * 2u);
#pragma unroll
      for (int c = 0; c < 4; ++c) { float x[8];
#pragma unroll
          for (int e = 0; e < 8; ++e) x[e] = orow[8 * c + e] * inv;
          fa::u32x4 w; w.x = fa::cvtpk(x[0], x[1]); w.y = fa::cvtpk(x[2], x[3]); w.z = fa::cvtpk(x[4], x[5]); w.w = fa::cvtpk(x[6], x[7]);
          *(GAS fa::u32x4*)(dst + 16 * c) = w; } }
    LDS_WAIT(); __syncthreads();
}
__device__ __forceinline__ void u_swa(const Frame& F0, int b, int kvh, int u, const float* sinks) {
    UNIT_BEGIN();
    GAS char* ws = (GAS char*)F.ws;
    const int r = F.lane & 31, h = F.lane >> 5, q0 = 128 * u, wq0 = q0 + 16 * F.wave, tq = wq0 + (r >> 1), hd = kvh * 2 + (r & 1);
    bf16x8 qf[4]; fa::load_q<64>(qf, ws, (unsigned)WS_Z + (unsigned)(b * SEQ + tq) * (ZLD * 2u) + (unsigned)(ZA_Q + hd * 64) * 2u, h);
    const float sl = slope2_of(3 * hd);
    const int t0 = (2 * u - 2) > 0 ? (2 * u - 2) : 0, nt = 2 * u + 2 - t0;
    SM st; fa::sm_init(st);
    LAS char* lds = (LAS char*)F.lds;
    fa::fa_loop<64, true>(st, qf, ws, (unsigned)WS_Z + (unsigned)b * (SEQ * ZLD * 2u) + (unsigned)(ZA_K + kvh * 64) * 2u, ZLD * 2u, (unsigned)WS_Z + (unsigned)b * (SEQ * ZLD * 2u) + (unsigned)(ZA_V + kvh * 64) * 2u, ZLD * 2u, SEQ - 1, nt,
        [=](int t) { return 64 * (t0 + t); },
        [=](int t, bool& act, bool& ew, float& cb, int& lo, int& hi) { const int key0 = 64 * (t0 + t); act = (key0 <= wq0 + 15) && (key0 + 63 >= wq0 - 127); ew = true;
            cb = sl * (float)(key0 - q0 + 4 * h); lo = tq - 127 - key0; hi = tq - key0; },
        sl, lds + FA_STAGES, F.tid, F.lane);
    const float sk = sinks[hd] * LOG2E + sl * (float)(tq - q0), mf = fmaxf(st.m, sk), a = fa::ex2(st.m - mf);
    const float ltot = fa::xhalf_sum(st.l) * a + fa::ex2(sk - mf), inv = a / fmaxf(ltot, fa::TINYF);
    f32x16 acc[2]; acc[0] = st.o[0] * inv; acc[1] = st.o[1] * inv;
    fa::store_out(acc, lds + FA_OST + F.wave * 32 * fa::OSTR, ws, [=](int col) { return (unsigned)WS_O + (unsigned)(b * SEQ + wq0 + (col >> 1)) * 2048u + (unsigned)((kvh * 2 + (col & 1)) * 64) * 2u; }, F.lane);
}
__device__ __forceinline__ void u_nsa(const Frame& F0, int b, int qi) {
    UNIT_BEGIN();
    GAS char* ws = (GAS char*)F.ws;
    const unsigned KC = (unsigned)WS_KCMP + (unsigned)b * (512u * 128u), VC = (unsigned)WS_VCMP + (unsigned)b * (512u * 128u), ZB = (unsigned)WS_Z + (unsigned)b * (SEQ * ZLD * 2u);
    const int r = F.lane & 31, h = F.lane >> 5, q0 = 64 * qi, wq0 = q0 + 8 * F.wave, qloc = 8 * F.wave + (r >> 2), tq = q0 + qloc, hd = r & 3;
    const unsigned zrow_off = ZB + (unsigned)tq * (ZLD * 2u); const GAS bf16* zrow = (const GAS bf16*)(ws + zrow_off);
    bf16x8 qf[4]; fa::load_q<64>(qf, ws, zrow_off + (unsigned)(ZC_Q + hd * 64) * 2u, h);
    const float sl = slope2_of(1 + 3 * hd);
    const float g0 = 1.f / (1.f + __expf(-bf2f(zrow[ZC_GL + hd]))), g1 = 1.f / (1.f + __expf(-bf2f(zrow[ZC_GL + 4 + hd]))), g2 = 1.f / (1.f + __expf(-bf2f(zrow[ZC_GL + 8 + hd])));
    LAS char* lds = (LAS char*)F.lds;
    LAS float* impA = (LAS float*)(lds + FA_IMP) + F.wave * 1024;
    LAS float* impB = (LAS float*)(lds + FA_OST) + F.wave * 1024;
    LAS unsigned* selm = (LAS unsigned*)(lds + FA_SELM);
    LAS unsigned* um = (LAS unsigned*)(lds + FA_UM);
    LAS float* vals = (LAS float*)(lds + FA_VALS) + F.wave * 128;
    if (F.tid < 4) um[F.tid] = 0u;
    const unsigned parko = (unsigned)WS_PARK + (unsigned)((F.bx * NWAVES + F.wave) * 2 * 32 * 64 + F.lane) * 4u;
#define PARK(i) (*(GAS float*)(ws + (parkl + (unsigned)((i) * 256))))
    const int ntc = ((4 * qi + 3) >> 6) + 1;
    const int cvis = (tq - 31) >> 4;
    const int cvis_min = (q0 - 31) >> 4;
    const float slc = 16.f * sl;
    SM st; fa::sm_init(st);
    fa::fa_loop<64, true>(st, qf, ws, KC, 128u, VC, 128u, 510, ntc,
        [](int t) { return 64 * t; },
        [=](int t, bool& act, bool& ew, float& cb, int& lo, int& hi) { const int c0 = 64 * t; act = true; ew = c0 + 63 > cvis_min; cb = slc * (float)(c0 - 4 * qi + 4 * h); lo = -100000; hi = cvis - c0; },
        slc, lds + FA_STAGES, F.tid, F.lane);
    { f32x16 t2[2] = {f32x16{}, f32x16{}}; fa::sm_finish(st, g0, t2); unsigned parkl = parko; asm volatile("" : "+v"(parkl));
#pragma unroll
      for (int v = 0; v < 16; ++v) { PARK(v) = t2[0][v]; PARK(16 + v) = t2[1][v]; } }
    {
        const float mfin = st.m, invl = 1.f / fmaxf(fa::xhalf_sum(st.l), fa::TINYF);
        constexpr int STG = fa::stage_bytes<64>();
        fa::Stg<64> sg;
        fa::stg_load<64>(sg, ws, KC, 128u, VC, 128u, 0, 510, F.tid); fa::stg_store<64>(sg, lds + FA_STAGES, F.tid); __syncthreads();
        for (int t = 0; t < ntc; ++t) {
            const LAS char* buf = lds + FA_STAGES + (t & 1) * STG;
            if (t + 1 < ntc) fa::stg_load<64>(sg, ws, KC, 128u, VC, 128u, 64 * (t + 1), 510, F.tid);
            const int c0 = 64 * t;
            f32x16 p0, p1; fa::score_tile<64, true>(p0, p1, buf, qf, slc * (float)(c0 - 4 * qi + 4 * h), slc, F.lane);
            if (c0 + 63 > cvis_min) fa::mask_ew(p0, p1, -100000, cvis - c0, h);
#pragma unroll
            for (int kh = 0; kh < 2; ++kh)
#pragma unroll
                for (int g = 0; g < 4; ++g) {
                    float e0, e1, e2, e3;
                    if (kh == 0) { e0 = fa::ex2(p0[4 * g] - mfin); e1 = fa::ex2(p0[4 * g + 1] - mfin); e2 = fa::ex2(p0[4 * g + 2] - mfin); e3 = fa::ex2(p0[4 * g + 3] - mfin); }
                    else { e0 = fa::ex2(p1[4 * g] - mfin); e1 = fa::ex2(p1[4 * g + 1] - mfin); e2 = fa::ex2(p1[4 * g + 2] - mfin); e3 = fa::ex2(p1[4 * g + 3] - mfin); }
                    e0 *= invl; e1 *= invl; e2 *= invl; e3 *= invl;
                    float s4 = ((e0 + e1) + e2) + e3;
                    s4 += __shfl_xor(s4, 1); s4 += __shfl_xor(s4, 2); e3 += __shfl_xor(e3, 1); e3 += __shfl_xor(e3, 2);
                    const int j = 16 * t + 8 * kh + 2 * g + h;
                    if (hd == 0) { impA[(r >> 2) * 128 + j] = s4; impB[(r >> 2) * 128 + j] = e3; }
                }
            if (t + 1 < ntc) fa::stg_store<64>(sg, lds + FA_STAGES + ((t + 1) & 1) * STG, F.tid);
            __syncthreads();
        }
    }
    {
        const int cur = qi;
        for (int qq = 0; qq < 8; ++qq) {
            unsigned long long m0, m1;
            if (cur < 16) { m0 = (cur >= 63) ? ~0ull : ((1ull << (cur + 1)) - 1ull); m1 = 0ull; }
            else {
                const int ja = F.lane, jb2 = F.lane + 64;
                const bool fca = (ja == 0 || ja == cur || ja == cur - 1), fcb = (jb2 == cur || jb2 == cur - 1);
                const float va = impA[qq * 128 + ja] + (ja > 0 ? impB[qq * 128 + ja - 1] : 0.f), vb = impA[qq * 128 + jb2] + impB[qq * 128 + jb2 - 1];
                const unsigned ka = (ja <= cur && !fca) ? (__float_as_uint(va) + 1u) : 0u, kb = (jb2 <= cur && !fcb) ? (__float_as_uint(vb) + 1u) : 0u;
                unsigned T = 0u;
                for (int bit = 31; bit >= 0; --bit) { const unsigned cand = T | (1u << bit); const int c = __popcll(__ballot(ka >= cand)) + __popcll(__ballot(kb >= cand)); if (c >= 13) T = cand; }
                if (T == 0u) T = 1u;
                const unsigned long long ga = __ballot(ka > T), gb = __ballot(kb > T), ea = __ballot(ka == T), eb = __ballot(kb == T);
                const int R = 13 - (__popcll(ga) + __popcll(gb)), na = __popcll(ea);
                const int pa = (int)__builtin_amdgcn_mbcnt_hi((unsigned)(ea >> 32), __builtin_amdgcn_mbcnt_lo((unsigned)ea, 0u)), pb = (int)__builtin_amdgcn_mbcnt_hi((unsigned)(eb >> 32), __builtin_amdgcn_mbcnt_lo((unsigned)eb, 0u));
                m0 = ga | __ballot(ka == T && pa < R) | 1ull; m1 = gb | __ballot(kb == T && (na + pb) < R);
                if (cur < 64) m0 |= 1ull << cur; else m1 |= 1ull << (cur - 64);
                if (cur - 1 < 64) m0 |= 1ull << (cur - 1); else m1 |= 1ull << (cur - 65);
            }
            if (F.lane == 0) { LAS unsigned* sp = selm + (8 * F.wave + qq) * 4; sp[0] = (unsigned)m0; sp[1] = (unsigned)(m0 >> 32); sp[2] = (unsigned)m1; sp[3] = (unsigned)(m1 >> 32);
                __hip_atomic_fetch_or(&um[0], (unsigned)m0, __ATOMIC_RELAXED, __HIP_MEMORY_SCOPE_WORKGROUP); __hip_atomic_fetch_or(&um[1], (unsigned)(m0 >> 32), __ATOMIC_RELAXED, __HIP_MEMORY_SCOPE_WORKGROUP); __hip_atomic_fetch_or(&um[2], (unsigned)m1, __ATOMIC_RELAXED, __HIP_MEMORY_SCOPE_WORKGROUP); __hip_atomic_fetch_or(&um[3], (unsigned)(m1 >> 32), __ATOMIC_RELAXED, __HIP_MEMORY_SCOPE_WORKGROUP); }
        }
        LDS_WAIT(); __syncthreads();
    }
    {
        const unsigned uw0 = um[0], uw1 = um[1], uw2 = um[2], uw3 = um[3];
        const LAS unsigned* selq = selm + qloc * 4;
        const int nsel = __builtin_amdgcn_readfirstlane(__popc(uw0) + __popc(uw1) + __popc(uw2) + __popc(uw3));
        LAS unsigned char* slist = (LAS unsigned char*)(lds + FA_VALS);
        if (F.tid < 128) { const int j = F.tid; const unsigned w = (j < 32) ? uw0 : (j < 64) ? uw1 : (j < 96) ? uw2 : uw3;
            if ((w >> (j & 31)) & 1u) { int pos = __popc(w & ((1u << (j & 31)) - 1u)); if (j >= 32) pos += __popc(uw0); if (j >= 64) pos += __popc(uw1); if (j >= 96) pos += __popc(uw2); slist[pos] = (unsigned char)j; } }
        LDS_WAIT(); __syncthreads();
        fa::sm_init(st);
        fa::fa_loop<64, true>(st, qf, ws, ZB + ZC_KS * 2u, ZLD * 2u, ZB + ZC_VS * 2u, ZLD * 2u, SEQ - 1, nsel,
            [=](int t) { return 64 * (int)slist[t]; },
            [=](int t, bool& act, bool& ew, float& cb, int& lo, int& hi) { const int j = (int)slist[t], key0 = 64 * j; const unsigned mw = selq[j >> 5];
                const bool on = (mw >> (j & 31)) & 1u; act = __any(on) != 0; ew = (j == qi); cb = on ? sl * (float)(key0 - q0 + 4 * h) : fa::MASKV; lo = -100000; hi = tq - key0; },
            sl, lds + FA_STAGES, F.tid, F.lane);
        { f32x16 t2[2] = {f32x16{}, f32x16{}}; fa::sm_finish(st, g1, t2); unsigned parkl = parko; asm volatile("" : "+v"(parkl));
#pragma unroll
          for (int v = 0; v < 16; ++v) { PARK(32 + v) = t2[0][v]; PARK(48 + v) = t2[1][v]; } }
    }
    {
        const int t0 = (qi - 8) > 0 ? (qi - 8) : 0, nt = qi + 1 - t0;
        fa::sm_init(st);
        fa::fa_loop<64, true>(st, qf, ws, ZB + ZC_KW * 2u, ZLD * 2u, ZB + ZC_VW * 2u, ZLD * 2u, SEQ - 1, nt,
            [=](int t) { return 64 * (t0 + t); },
            [=](int t, bool& act, bool& ew, float& cb, int& lo, int& hi) { const int j = t0 + t, key0 = 64 * j; act = true; ew = (j == qi) || (j == qi - 8);
                cb = sl * (float)(key0 - q0 + 4 * h); lo = tq - 511 - key0; hi = tq - key0; },
            sl, lds + FA_STAGES, F.tid, F.lane);
    }
    f32x16 acc[2] = {f32x16{}, f32x16{}}; fa::sm_finish(st, g2, acc); unsigned parkl = parko; asm volatile("" : "+v"(parkl));
#pragma unroll
    for (int v = 0; v < 16; ++v) { acc[0][v] += PARK(v) + PARK(32 + v); acc[1][v] += PARK(16 + v) + PARK(48 + v); }
#undef PARK
    fa::store_out(acc, lds + FA_OST + F.wave * 32 * fa::OSTR, ws, [=](int col) { return (unsigned)WS_O + (unsigned)(b * SEQ + wq0 + (col >> 2)) * 2048u + (unsigned)(512 + (col & 3) * 64) * 2u; }, F.lane);
}

__device__ __forceinline__ void p_attn(Frame& F, const float* sinks, int mskip) {
    const int id = F.vcu;
    if (F.G != 256) return;
    { const int bh = id >> 4, s = id & 15;
#pragma unroll 1
      for (int k = 0; k < (((mskip >> 9) & 1) ? 4 : 2); ++k) u_mla(F, bh >> 2, bh & 3, (k & 1) ? s : 31 - s); }
    { const int bh = id >> 4, s = id & 15;
#pragma unroll 1
      for (int k = 0; k < (((mskip >> 11) & 1) ? 4 : 2); ++k) u_moba(F, bh >> 2, bh & 3, (k & 1) ? s : 31 - s); }
    if (!(mskip & 4)) { const int b = id >> 6, s = id & 63;
#pragma unroll 1
      for (int k = 0; k < (((mskip >> 10) & 1) ? 4 : 2); ++k) u_nsa(F, b, (k & 1) ? s : 127 - s); }
    {
#pragma unroll 1
      for (int k = 0; k < (((mskip >> 8) & 1) ? 4 : 2); ++k) { const int u0 = 2 * id + (k & 1); u_swa(F, u0 >> 7, (u0 >> 6) & 1, u0 & 63, sinks); } }
}
constexpr int PH_PRO = 0, PH_L0 = 1, PH_PER_L = 9, PH_FIN = 19, PH_END = 20;
constexpr int PO_NORM1 = 0, PO_ZG = 1, PO_PREP = 2, PO_UP = 3, PO_ATTN = 4, PO_OG = 5, PO_NORM2 = 6, PO_UPG = 7, PO_DNG = 8;
#ifndef MK_PHASE_MASK
#define MK_PHASE_MASK 0xFFFFFu
#endif

__global__ void __launch_bounds__(NTHR, 2) mega(Args args) {
    extern __shared__ __attribute__((aligned(16))) unsigned char lds_raw[];
    Frame F;
    F.lds = (LAS unsigned char*)lds_raw;
    int wave_s = __builtin_amdgcn_readfirstlane((int)threadIdx.x >> 6); asm volatile("" : "+s"(wave_s));
    F.tid = threadIdx.x; F.lane = F.tid & 63; F.wave = wave_s;
    F.G = gridDim.x; { const int bx = blockIdx.x; F.vcu = (F.G % 8 == 0) ? (bx % 8) * (F.G / 8) + bx / 8 : bx; }
    volatile LAS unsigned* misc = (volatile LAS unsigned*)(F.lds + LDS_MISC);
    if (F.tid < 64) misc[F.tid] = 0u;
    __syncthreads();
    (void)xcd_barrier_post((unsigned*)(args.ws + WS_CTL), misc + 8);
    float* fo; KArgsP ap;
#define KARGS() ({ KArgsP q_ = (KArgsP)__builtin_amdgcn_kernarg_segment_ptr(); asm volatile("" : "+s"(q_)); q_; })
#define IN(k) ({ KArgsP q2_ = KARGS(); q2_->ph_lo <= (k) && (k) < q2_->ph_hi; })
#define PHASE_BEGIN() do { asm volatile("; PHASE_MARK %0" :: "i"(__LINE__)); ap = KARGS(); F.G = gridDim.x; \
        { int w_ = wave_s; asm volatile("" : "+s"(w_)); int t_ = (w_ << 6) | (int)__builtin_amdgcn_mbcnt_hi(~0u, __builtin_amdgcn_mbcnt_lo(~0u, 0u)); asm volatile("" : "+v"(t_)); F.tid = t_; F.lane = t_ & 63; F.wave = w_; } F.ws = ap->ws; int bx_ = (int)blockIdx.x; asm volatile("" : "+s"(bx_)); F.bx = bx_; F.vcu = (F.G % 8 == 0) ? (bx_ % 8) * (F.G / 8) + bx_ / 8 : bx_; fo = ap->out; } while (0)
#define INP(i) (ap->in[i])
#define SEAM(k) do { if (IN(k) && IN((k) + 1)) { XcdBarrier b_; b_.bar = (unsigned*)(KARGS()->ws + WS_CTL); b_.x = xb_xcc_id(); b_.st = (volatile LAS unsigned*)(F.lds + LDS_MISC) + 8; xcd_barrier(b_); } } while (0)

    if (IN(PH_PRO)) { PHASE_BEGIN(); p_prologue(F, ap); }
#ifdef MK_PRO_TWICE
    if (IN(PH_PRO)) { PHASE_BEGIN(); p_prologue(F, ap); }
#endif
    SEAM(PH_PRO);

    { constexpr int l = 0;
        const int pb = PH_L0 + PH_PER_L * l;
#define WB (F.ws + WS_W + (size_t)l * WS_WL)
#define MOD ((const float*)(F.ws + WS_MOD) + (size_t)l * NB * 6 * D)
#define XB ((bf16*)(F.ws + WS_XB))
#define XIN ((l == 0) ? (const void*)INP(0) : (const void*)XB)
#define H ((bf16*)(F.ws + WS_H))
#define Z ((bf16*)(F.ws + WS_Z))
#define OB ((bf16*)(F.ws + WS_O))
#define U ((bf16*)(F.ws + WS_U))

        if (IN(pb + PO_NORM1) && !((KARGS()->skip >> PO_NORM1) & 1)) { PHASE_BEGIN(); p_norm<0, (l != 0)>(F, XIN, INP(2) + l * D, MOD, MOD + D, H, nullptr); }
        SEAM(pb + PO_NORM1);

        if (IN(pb + PO_ZG) && !((KARGS()->skip >> PO_ZG) & 1)) { PHASE_BEGIN();
            pg8::Gemm g{H, (const bf16*)(WB + W_IN), M, ZLD, D, D}; pg8::StaticOrder S; S.init(M, ZLD, F.G, F.bx);
            pg8::EpiBf16<0> E{Z, ZLD, nullptr, 0, 0, 1.f};
            pg8::gemm_phase<pg8::EpiBf16<0>, pg8::StaticOrder, true, true>(F.lds, g, S, E, F.tid);
        }
        SEAM(pb + PO_ZG);

        if (IN(pb + PO_PREP) && !((KARGS()->skip >> PO_PREP) & 1)) { PHASE_BEGIN(); p_prep(F, l); }
        SEAM(pb + PO_PREP);

        if (IN(pb + PO_UP) && !((KARGS()->skip >> PO_UP) & 1)) { PHASE_BEGIN();
            { pg8::Gemm g{Z + ZB_CQ, (const bf16*)(WB + W_UQ), M, 512, 256, ZLD}; pg8::StaticOrder S; S.init(M, 512, F.G, F.bx);
              pg8::EpiBf16<0> E{(bf16*)(F.ws + WS_QM), 512, nullptr, 0, 0, 1.f};
              pg8::gemm_phase<pg8::EpiBf16<0>, pg8::StaticOrder, true, true>(F.lds, g, S, E, F.tid); }
            PHASE_BEGIN();
            { pg8::Gemm g{Z + ZB_CKV, (const bf16*)(WB + W_UKV), M, 512, 256, ZLD}; pg8::StaticOrder S; S.init(M, 512, F.G, F.bx);
              pg8::EpiMlaKV E{(bf16*)(F.ws + WS_KM), (bf16*)(F.ws + WS_VM), (const float*)(F.ws + WS_RSKV)};
              pg8::gemm_phase<pg8::EpiMlaKV, pg8::StaticOrder, true, false>(F.lds, g, S, E, F.tid); }
            PHASE_BEGIN();
            p_compress(F, l);
        }
        SEAM(pb + PO_UP);

        if (IN(pb + PO_ATTN) && !((KARGS()->skip >> PO_ATTN) & 1)) { PHASE_BEGIN(); p_attn(F, INP(8) + l * 4, (ap->skip >> 16) | ((ap->rep >> 20) << 8)); }
        SEAM(pb + PO_ATTN);

        if (IN(pb + PO_OG) && !((KARGS()->skip >> PO_OG) & 1)) { PHASE_BEGIN();
            pg8::Gemm g{OB, (const bf16*)(WB + W_OUT), M, D, D, D}; pg8::StaticOrder S; S.init(M, D, F.G, F.bx);
            pg8::EpiResid<(l != 0)> E{XIN, XB, MOD + 2 * D};
            pg8::gemm_phase<pg8::EpiResid<(l != 0)>, pg8::StaticOrder, true, true>(F.lds, g, S, E, F.tid);
        }
        SEAM(pb + PO_OG);

        if (IN(pb + PO_NORM2) && !((KARGS()->skip >> PO_NORM2) & 1)) { PHASE_BEGIN(); p_norm<0, true>(F, XB, INP(3) + l * D, MOD + 3 * D, MOD + 4 * D, H, nullptr); }
        SEAM(pb + PO_NORM2);

        if (IN(pb + PO_UPG) && !((KARGS()->skip >> PO_UPG) & 1)) { PHASE_BEGIN();
            pg8::Gemm g{H, (const bf16*)(WB + W_UP), M, DFF, D, D}; pg8::StaticOrder S; S.init(M, DFF, F.G, F.bx);
            pg8::EpiRelu2 E{U, DFF};
            pg8::gemm_phase<pg8::EpiRelu2, pg8::StaticOrder, true, true>(F.lds, g, S, E, F.tid);
        }
        SEAM(pb + PO_UPG);

        if (IN(pb + PO_DNG) && !((KARGS()->skip >> PO_DNG) & 1)) { PHASE_BEGIN();
            pg8::Gemm g{U, (const bf16*)(WB + W_DN), M, D, DFF, DFF}; pg8::StaticOrder S; S.init(M, D, F.G, F.bx);
            pg8::EpiResid<true> E{XB, XB, MOD + 5 * D};
            pg8::gemm_phase<pg8::EpiResid<true>, pg8::StaticOrder, true, true>(F.lds, g, S, E, F.tid);
        }
        SEAM(pb + PO_DNG);
    }
    { constexpr int l = 1;
        const int pb = PH_L0 + PH_PER_L * l;
#define WB (F.ws + WS_W + (size_t)l * WS_WL)
#define MOD ((const float*)(F.ws + WS_MOD) + (size_t)l * NB * 6 * D)
#define XB ((bf16*)(F.ws + WS_XB))
#define XIN ((l == 0) ? (const void*)INP(0) : (const void*)XB)
#define H ((bf16*)(F.ws + WS_H))
#define Z ((bf16*)(F.ws + WS_Z))
#define OB ((bf16*)(F.ws + WS_O))
#define U ((bf16*)(F.ws + WS_U))

        if (IN(pb + PO_NORM1) && !((KARGS()->skip >> PO_NORM1) & 1)) { PHASE_BEGIN(); p_norm<0, (l != 0)>(F, XIN, INP(2) + l * D, MOD, MOD + D, H, nullptr); }
        SEAM(pb + PO_NORM1);

        if (IN(pb + PO_ZG) && !((KARGS()->skip >> PO_ZG) & 1)) { PHASE_BEGIN();
            pg8::Gemm g{H, (const bf16*)(WB + W_IN), M, ZLD, D, D}; pg8::StaticOrder S; S.init(M, ZLD, F.G, F.bx);
            pg8::EpiBf16<0> E{Z, ZLD, nullptr, 0, 0, 1.f};
            pg8::gemm_phase<pg8::EpiBf16<0>, pg8::StaticOrder, true, true>(F.lds, g, S, E, F.tid);
        }
        SEAM(pb + PO_ZG);

        if (IN(pb + PO_PREP) && !((KARGS()->skip >> PO_PREP) & 1)) { PHASE_BEGIN(); p_prep(F, l); }
        SEAM(pb + PO_PREP);

        if (IN(pb + PO_UP) && !((KARGS()->skip >> PO_UP) & 1)) { PHASE_BEGIN();
            { pg8::Gemm g{Z + ZB_CQ, (const bf16*)(WB + W_UQ), M, 512, 256, ZLD}; pg8::StaticOrder S; S.init(M, 512, F.G, F.bx);
              pg8::EpiBf16<0> E{(bf16*)(F.ws + WS_QM), 512, nullptr, 0, 0, 1.f};
              pg8::gemm_phase<pg8::EpiBf16<0>, pg8::StaticOrder, true, true>(F.lds, g, S, E, F.tid); }
            PHASE_BEGIN();
            { pg8::Gemm g{Z + ZB_CKV, (const bf16*)(WB + W_UKV), M, 512, 256, ZLD}; pg8::StaticOrder S; S.init(M, 512, F.G, F.bx);
              pg8::EpiMlaKV E{(bf16*)(F.ws + WS_KM), (bf16*)(F.ws + WS_VM), (const float*)(F.ws + WS_RSKV)};
              pg8::gemm_phase<pg8::EpiMlaKV, pg8::StaticOrder, true, false>(F.lds, g, S, E, F.tid); }
            PHASE_BEGIN();
            p_compress(F, l);
        }
        SEAM(pb + PO_UP);

        if (IN(pb + PO_ATTN) && !((KARGS()->skip >> PO_ATTN) & 1)) { PHASE_BEGIN(); p_attn(F, INP(8) + l * 4, (ap->skip >> 16) | ((ap->rep >> 20) << 8)); }
        SEAM(pb + PO_ATTN);

        if (IN(pb + PO_OG) && !((KARGS()->skip >> PO_OG) & 1)) { PHASE_BEGIN();
            pg8::Gemm g{OB, (const bf16*)(WB + W_OUT), M, D, D, D}; pg8::StaticOrder S; S.init(M, D, F.G, F.bx);
            pg8::EpiResid<(l != 0)> E{XIN, XB, MOD + 2 * D};
            pg8::gemm_phase<pg8::EpiResid<(l != 0)>, pg8::StaticOrder, true, true>(F.lds, g, S, E, F.tid);
        }
        SEAM(pb + PO_OG);

        if (IN(pb + PO_NORM2) && !((KARGS()->skip >> PO_NORM2) & 1)) { PHASE_BEGIN(); p_norm<0, true>(F, XB, INP(3) + l * D, MOD + 3 * D, MOD + 4 * D, H, nullptr); }
        SEAM(pb + PO_NORM2);

        if (IN(pb + PO_UPG) && !((KARGS()->skip >> PO_UPG) & 1)) { PHASE_BEGIN();
            pg8::Gemm g{H, (const bf16*)(WB + W_UP), M, DFF, D, D}; pg8::StaticOrder S; S.init(M, DFF, F.G, F.bx);
            pg8::EpiRelu2 E{U, DFF};
            pg8::gemm_phase<pg8::EpiRelu2, pg8::StaticOrder, true, true>(F.lds, g, S, E, F.tid);
        }
        SEAM(pb + PO_UPG);

        if (IN(pb + PO_DNG) && !((KARGS()->skip >> PO_DNG) & 1)) { PHASE_BEGIN();
            pg8::Gemm g{U, (const bf16*)(WB + W_DN), M, D, DFF, DFF}; pg8::StaticOrder S; S.init(M, D, F.G, F.bx);
            pg8::EpiResid<true> E{XB, XB, MOD + 5 * D};
            pg8::gemm_phase<pg8::EpiResid<true>, pg8::StaticOrder, true, true>(F.lds, g, S, E, F.tid);
        }
        SEAM(pb + PO_DNG);
    }
    if (IN(PH_FIN)) { PHASE_BEGIN(); p_norm<1, true>(F, (const void*)(F.ws + WS_XB), INP(21), nullptr, nullptr, nullptr, fo); }
#undef IN
#undef SEAM
}
}
extern "C" void kernel_launch(void* const* d_in, const int* in_sizes, int n_in, void* d_out, int out_size, void* d_ws, size_t ws_size, hipStream_t stream) {
    using namespace mk;
    static int grid = 0;
    if (grid == 0) {
        int dev = 0, cus = 0;
        if (hipGetDevice(&dev) != hipSuccess || hipDeviceGetAttribute(&cus, hipDeviceAttributeMultiprocessorCount, dev) != hipSuccess) { grid = -1; return; }
        if (hipFuncSetAttribute((const void*)mega, hipFuncAttributeMaxDynamicSharedMemorySize, LDS_BYTES) != hipSuccess) { grid = -1; return; }
        (void)hipGetLastError();
        grid = cus;
    }
    if (grid < 0) return;
    (void)in_sizes; (void)n_in; (void)out_size; (void)ws_size;
    Args a{};
    for (int i = 0; i < 22; ++i) a.in[i] = (const float*)d_in[i];
    a.out = (float*)d_out; a.ws = (unsigned char*)d_ws; a.skip = 0; a.rep = MK_REP;
    auto launch = [&](int lo, int hi) {
        (void)hipMemsetAsync((char*)d_ws + WS_CTL, 0, CTL_ZERO_BYTES, stream);
        a.ph_lo = lo; a.ph_hi = hi;
        hipLaunchKernelGGL(mega, dim3(grid), dim3(NTHR), LDS_BYTES, stream, a);
    };
    launch(0, PH_END);
}
```

```cpp
#include <hip/hip_runtime.h>
#include <cstdio>
#include <cstdint>
#include <math.h>
#define MK_PQ 500.0
#define FA_EXP 2
#define FA_PROBE 0
#define MK_PROBE_IDX 0
#define FA_KO 0
#define MK_MODE 0
#define MK_NAIVE_MASK 0
#define MK_SKIP 0
#define MK_SPLIT 0
#define MK_DBG_PHASE 0
#define MK_DBG_TEST 0
#define MK_REP 0
namespace pg8 {
#define PG8_LAS __attribute__((address_space(3)))
typedef unsigned short bf16_t;
typedef short bf16x8 __attribute__((ext_vector_type(8)));
typedef float f32x4 __attribute__((ext_vector_type(4)));
typedef unsigned u32x4 __attribute__((ext_vector_type(4)));
constexpr int BM = 256, BK = 64, HALF = 128, HTB = HALF * BK * 2  , STAGE_BYTES = 8 * HTB, NXCD = 8, WGM = 8;

__host__ __device__ __forceinline__ int lds_byte(int r, int c) { const int st = (r >> 4) * 2 + (c >> 5), rr = r & 15, cc = c & 31, ob = rr * 64 + cc * 2; return st * 1024 + (ob ^ (((ob >> 9) & 1) << 5)); }
__host__ __device__ __forceinline__ void stage_rc(int b, int& R, int& C) { const int st = b / 1024, sb = b % 1024, swz = sb ^ (((sb >> 9) & 1) << 5); R = (st >> 1) * 16 + swz / 64; C = (st & 1) * 32 + (swz % 64) / 2; }
__host__ __device__ __forceinline__ int perm32(int rho) { const int n = rho >> 4, i = rho & 15; return 8 * (i >> 2) + 4 * n + (i & 3); }

struct Unit { int pm, pn; };
struct Gemm { const bf16_t* A; const bf16_t* Bt; int M, N, K, lda; };

struct StaticOrder {
    int nM, nN, nwg, G, c;
    __host__ __device__ void init(int M, int N, int G_, int c_) { nM = M / BM; nN = N / BM; nwg = nM * nN; G = G_; c = c_; }
    __host__ __device__ bool next(int i, Unit& u) const {
        const long L = (long)i * G + c; if (L >= nwg) return false;
        int wgid = (int)L; { const int q = nwg / NXCD, r = nwg % NXCD, xcd = wgid % NXCD, off = wgid / NXCD; wgid = (xcd < r ? xcd * (q + 1) : r * (q + 1) + (xcd - r) * q) + off; }
        const int nig = WGM * nN, gid = wgid / nig, fm = gid * WGM, gsz = (nM - fm) < WGM ? (nM - fm) : WGM;
        u.pm = fm + ((wgid % nig) % gsz); u.pn = (wgid % nig) / gsz; return true;
    }
    __device__ __forceinline__ void a_ready(const Unit&) const {}
    __device__ __forceinline__ void done(const Unit&) const {}
};
__device__ __forceinline__ unsigned cvt_pk_bf16(float lo, float hi) { unsigned r; asm volatile("v_cvt_pk_bf16_f32 %0, %1, %2" : "=v"(r) : "v"(lo), "v"(hi)); return r; }
typedef float f32x2 __attribute__((ext_vector_type(2)));
__device__ __forceinline__ f32x2 gelu_pk(f32x2 v) {
    const f32x2 av = __builtin_elementwise_abs(v), d = av * 0.2316418882f + 1.0f;
    f32x2 t; t.x = __builtin_amdgcn_rcpf(d.x); t.y = __builtin_amdgcn_rcpf(d.y);
    f32x2 q = t * 0.5307027145f + (-0.7265760135f); q = q * t + 0.7107068705f; q = q * t + (-0.142248368f); q = q * t + 0.127414796f; q = q * t;
    const f32x2 s = (v * v) * (-0.72134752044f);
    f32x2 e; e.x = __builtin_amdgcn_exp2f(s.x); e.y = __builtin_amdgcn_exp2f(s.y);
    const f32x2 m = v * (q * e), r = v - m;
    f32x2 o; o.x = v.x < 0.f ? m.x : r.x; o.y = v.y < 0.f ? m.y : r.y; return o;
}

template <int ACT  > struct EpiBf16 {
    static constexpr bool PERM = true, AFTER_DRAIN = false; static_assert(ACT == 0 || ACT == 1, "EpiBf16: ACT is 0 (none) or 1 (gelu_pk)");
    bf16_t* O; int ldc; const float* bias; int split_cols; size_t split_stride; float scale0;
    __device__ __forceinline__ void operator()(const f32x4 (&acc)[2][2][4][2], const Unit& u, int wr, int wc, int fr, int fq) const {
        const int row0 = u.pm * BM + wr * 64 + fr; int colt = u.pn * BM; bf16_t* base = O;
        float sc = 1.f; if (split_cols) { const int t = colt / split_cols; base += (size_t)t * split_stride; colt -= t * split_cols; if (t == 0) sc = scale0; }
        const int col0 = colt + wc * 32 + 8 * fq, bcol0 = u.pn * BM + wc * 32 + 8 * fq;
        f32x4 bv[2][2];
#pragma unroll
        for (int bj = 0; bj < 2; ++bj)
#pragma unroll
            for (int n = 0; n < 2; ++n) bv[bj][n] = bias ? *(const f32x4*)(bias + bcol0 + bj * HALF + 4 * n) : (f32x4){0.f, 0.f, 0.f, 0.f};
#pragma unroll
        for (int ai = 0; ai < 2; ++ai)
#pragma unroll
            for (int m = 0; m < 4; ++m) { bf16_t* rowp = base + (size_t)(row0 + ai * HALF + m * 16) * ldc + col0;
#pragma unroll
                for (int bj = 0; bj < 2; ++bj) { f32x4 v0 = acc[ai][bj][m][0] + bv[bj][0], v1 = acc[ai][bj][m][1] + bv[bj][1];
                    if (ACT == 1) { f32x2 a = gelu_pk((f32x2){v0[0], v0[1]}), b = gelu_pk((f32x2){v0[2], v0[3]}), c = gelu_pk((f32x2){v1[0], v1[1]}), d = gelu_pk((f32x2){v1[2], v1[3]});
                        v0 = (f32x4){a.x, a.y, b.x, b.y}; v1 = (f32x4){c.x, c.y, d.x, d.y}; }
                    v0 = v0 * sc; v1 = v1 * sc; u32x4 w; w.x = cvt_pk_bf16(v0[0], v0[1]); w.y = cvt_pk_bf16(v0[2], v0[3]); w.z = cvt_pk_bf16(v1[0], v1[1]); w.w = cvt_pk_bf16(v1[2], v1[3]);
                    *(u32x4*)(rowp + bj * HALF) = w; } }
    }
};
template <class Epi, class Sched, bool ALIGN_EPI = false, bool SP2 = false>
__device__ __forceinline__ void gemm_phase(PG8_LAS unsigned char* lds, const Gemm g, const Sched& S, const Epi& E, int tid_in) {
    int tid_ = tid_in; asm volatile("" : "+v"(tid_));
    const int tid = tid_, wid = __builtin_amdgcn_readfirstlane(tid >> 6), lane = tid & 63, wr = wid >> 2, wc = wid & 3, fr = lane & 15, fq = lane >> 4;
    const int K = g.K, nt = K / BK;
    unsigned voffA[2], voffB[2];
#pragma unroll
    for (int i = 0; i < 2; ++i) { int R, C; stage_rc(tid * 16 + i * 8192, R, C); const int Rb = Epi::PERM ? ((R & ~31) + perm32(R & 31)) : R;
        voffA[i] = (unsigned)(R * g.lda + C) * 2u; voffB[i] = (unsigned)(Rb * K + C) * 2u; }
    const size_t kstep = (size_t)(BK * 2);
    const size_t hstep = (size_t)HALF * K * 2;
    const size_t tstep = 2 * hstep; const size_t hstepA = (size_t)HALF * g.lda * 2, tstepA = 2 * hstepA;
    const unsigned ldsw = (unsigned)wid * 1024u;
    const int aoff = lds_byte(wr * 64 + fr, fq * 8), boff = lds_byte(wc * 32 + fr, fq * 8);
#define PG8_SA(b, h) (((b) * 2 + (h)) * HTB)
#define PG8_SB(b, h) ((4 + (b) * 2 + (h)) * HTB)
#define PG8_STAGE(bufoff, gbase, voff) do { _Pragma("unroll") for (int _i = 0; _i < 2; ++_i) \
        __builtin_amdgcn_global_load_lds((const unsigned*)((const char*)(gbase) + (voff)[_i]), (PG8_LAS unsigned*)(lds + (bufoff) + ldsw + _i * 8192), 16, 0, 0); } while (0)
#define PG8_LDA(dst, b, h) do { _Pragma("unroll") for (int m = 0; m < 4; ++m) _Pragma("unroll") for (int k = 0; k < 2; ++k) dst[m][k] = *(const PG8_LAS bf16x8*)(lds + PG8_SA(b, h) + aoff + m * 2048 + k * 1024); } while (0)
#define PG8_LDB(dst, b, h) do { _Pragma("unroll") for (int n = 0; n < 2; ++n) _Pragma("unroll") for (int k = 0; k < 2; ++k) dst[n][k] = *(const PG8_LAS bf16x8*)(lds + PG8_SB(b, h) + boff + n * 2048 + k * 1024); } while (0)
#define PG8_MMA(ai, bj, At, Bt) do { __builtin_amdgcn_s_setprio(1); _Pragma("unroll") for (int m = 0; m < 4; ++m) _Pragma("unroll") for (int n = 0; n < 2; ++n) _Pragma("unroll") for (int k = 0; k < 2; ++k) \
        acc[ai][bj][m][n] = __builtin_amdgcn_mfma_f32_16x16x32_bf16(Bt[n][k], At[m][k], acc[ai][bj][m][n], 0, 0, 0); __builtin_amdgcn_s_setprio(0); } while (0)
#define PG8_WAIT_V(n) asm volatile("s_waitcnt vmcnt(" #n ")" ::: "memory")
#define PG8_WAIT_L(n) asm volatile("s_waitcnt lgkmcnt(" #n ")" ::: "memory")
#define PG8_BAR __builtin_amdgcn_s_barrier()
#define PG8_SCHED __builtin_amdgcn_sched_barrier(0)
    Unit cur, nxt; int ui = 0;
    if (!S.next(0, cur)) return;
    f32x4 acc[2][2][4][2];
#pragma unroll
    for (int a = 0; a < 2; ++a)
#pragma unroll
        for (int b = 0; b < 2; ++b)
#pragma unroll
            for (int m = 0; m < 4; ++m)
#pragma unroll
                for (int n = 0; n < 2; ++n) acc[a][b][m][n] = (f32x4){0.f, 0.f, 0.f, 0.f};
    bf16x8 At[4][2], B0[2][2], B1[2][2];
    const char* cA = (const char*)g.A + (size_t)cur.pm * tstepA; const char* cB = (const char*)g.Bt + (size_t)cur.pn * tstep;
    S.a_ready(cur);
    if constexpr (SP2) {
        PG8_STAGE(PG8_SB(0, 0), cB, voffB); PG8_STAGE(PG8_SB(0, 1), cB + hstep, voffB); PG8_STAGE(PG8_SA(0, 0), cA, voffA); PG8_STAGE(PG8_SA(0, 1), cA + hstepA, voffA);
        if (wr == 1) PG8_BAR;
        PG8_WAIT_V(2); PG8_BAR;
        PG8_STAGE(PG8_SB(1, 0), cB + kstep, voffB); PG8_STAGE(PG8_SA(1, 0), cA + kstep, voffA); PG8_STAGE(PG8_SB(1, 1), cB + hstep + kstep, voffB);
        PG8_WAIT_V(6); PG8_BAR;
    } else {
        PG8_STAGE(PG8_SB(0, 0), cB, voffB); PG8_STAGE(PG8_SA(0, 0), cA, voffA); PG8_STAGE(PG8_SB(0, 1), cB + hstep, voffB); PG8_STAGE(PG8_SA(0, 1), cA + hstepA, voffA);
        if (wr == 1) PG8_BAR;
        PG8_WAIT_V(4); PG8_BAR;
        PG8_STAGE(PG8_SB(1, 0), cB + kstep, voffB); PG8_STAGE(PG8_SA(1, 0), cA + kstep, voffA); PG8_STAGE(PG8_SB(1, 1), cB + hstep + kstep, voffB);
        PG8_WAIT_V(6); PG8_BAR;
    }
    for (;;) {
        const bool has_next = S.next(ui + 1, nxt);
        const char* nA = has_next ? (const char*)g.A + (size_t)nxt.pm * tstepA : cA; const char* nB = has_next ? (const char*)g.Bt + (size_t)nxt.pn * tstep : cB;
        for (int t = 0; t < nt; t += 2) {
            const bool last = (t == nt - 2);
            const char* a1 = cA + (size_t)(t + 1) * kstep;
            const char* a2 = last ? nA : cA + (size_t)(t + 2) * kstep; const char* b2 = last ? nB : cB + (size_t)(t + 2) * kstep;
            const char* a3 = a2 + kstep; const char* b3 = b2 + kstep;
            if (last && has_next) S.a_ready(nxt);
            if constexpr (SP2) {
            PG8_LDB(B0, 0, 0); PG8_LDB(B1, 0, 1); PG8_SCHED; PG8_LDA(At, 0, 0); PG8_STAGE(PG8_SA(1, 1), a1 + hstepA, voffA);
            PG8_WAIT_V(8); PG8_WAIT_L(0); PG8_BAR; PG8_MMA(0, 0, At, B0); PG8_MMA(0, 1, At, B1); PG8_BAR; PG8_SCHED;
            PG8_LDA(At, 0, 1); PG8_STAGE(PG8_SB(0, 0), b2, voffB); PG8_STAGE(PG8_SB(0, 1), b2 + hstep, voffB); PG8_STAGE(PG8_SA(0, 0), a2, voffA);
            PG8_WAIT_V(8); PG8_WAIT_L(0); PG8_BAR; PG8_MMA(1, 0, At, B0); PG8_MMA(1, 1, At, B1); PG8_BAR; PG8_SCHED;
            PG8_LDB(B0, 1, 0); PG8_LDB(B1, 1, 1); PG8_SCHED; PG8_LDA(At, 1, 0); PG8_STAGE(PG8_SA(0, 1), a2 + hstepA, voffA);
            PG8_WAIT_V(8); PG8_WAIT_L(0); PG8_BAR; PG8_MMA(0, 0, At, B0); PG8_MMA(0, 1, At, B1); PG8_BAR; PG8_SCHED;
            PG8_LDA(At, 1, 1); PG8_STAGE(PG8_SB(1, 0), b3, voffB); PG8_STAGE(PG8_SB(1, 1), b3 + hstep, voffB); PG8_STAGE(PG8_SA(1, 0), a3, voffA);
            PG8_WAIT_V(8); PG8_WAIT_L(0); PG8_BAR; PG8_MMA(1, 0, At, B0); PG8_MMA(1, 1, At, B1); PG8_BAR; PG8_SCHED;
            } else {
            PG8_LDB(B0, 0, 0); PG8_SCHED; PG8_LDA(At, 0, 0); PG8_STAGE(PG8_SA(1, 1), a1 + hstepA, voffA);
            PG8_WAIT_L(8); PG8_BAR; PG8_WAIT_L(0); PG8_MMA(0, 0, At, B0); PG8_BAR; PG8_SCHED;
            PG8_LDB(B1, 0, 1); PG8_STAGE(PG8_SB(0, 0), b2, voffB);
            PG8_BAR; PG8_WAIT_L(0); PG8_MMA(0, 1, At, B1); PG8_BAR;
            PG8_LDA(At, 0, 1); PG8_STAGE(PG8_SA(0, 0), a2, voffA);
            PG8_BAR; PG8_WAIT_L(0); PG8_MMA(1, 0, At, B0); PG8_BAR; PG8_SCHED;
            PG8_STAGE(PG8_SB(0, 1), b2 + hstep, voffB);
            PG8_WAIT_V(6); PG8_BAR; PG8_MMA(1, 1, At, B1); PG8_BAR;
            PG8_LDB(B0, 1, 0); PG8_SCHED; PG8_LDA(At, 1, 0); PG8_STAGE(PG8_SA(0, 1), a2 + hstepA, voffA);
            PG8_WAIT_L(8); PG8_BAR; PG8_WAIT_L(0); PG8_MMA(0, 0, At, B0); PG8_BAR; PG8_SCHED;
            PG8_LDB(B1, 1, 1); PG8_STAGE(PG8_SB(1, 0), b3, voffB);
            PG8_BAR; PG8_WAIT_L(0); PG8_MMA(0, 1, At, B1); PG8_BAR;
            PG8_LDA(At, 1, 1); PG8_STAGE(PG8_SA(1, 0), a3, voffA);
            PG8_BAR; PG8_WAIT_L(0); PG8_MMA(1, 0, At, B0); PG8_BAR; PG8_SCHED;
            PG8_STAGE(PG8_SB(1, 1), b3 + hstep, voffB);
            PG8_WAIT_V(6); PG8_BAR; PG8_MMA(1, 1, At, B1); PG8_BAR;
            }
        }
        if constexpr (ALIGN_EPI) { if (wr == 0) PG8_BAR; }
        if constexpr (!Epi::AFTER_DRAIN) { E(acc, cur, wr, wc, fr, fq); S.done(cur); }
        if (!has_next) break;
#pragma unroll
        for (int a = 0; a < 2; ++a)
#pragma unroll
            for (int b = 0; b < 2; ++b)
#pragma unroll
                for (int m = 0; m < 4; ++m)
#pragma unroll
                    for (int n = 0; n < 2; ++n) acc[a][b][m][n] = (f32x4){0.f, 0.f, 0.f, 0.f};
        cur = nxt; cA = nA; cB = nB; ++ui;
        if constexpr (ALIGN_EPI) { if (wr == 1) PG8_BAR; }
    }
    PG8_WAIT_V(0);
    if constexpr (!ALIGN_EPI) { if (wr == 0) PG8_BAR; }
    PG8_BAR;
    if constexpr (Epi::AFTER_DRAIN) { E.fused(acc, cur, wr, wc, fr, fq, lds, wid, lane); S.done(cur); }
#undef PG8_SA
#undef PG8_SB
#undef PG8_STAGE
#undef PG8_LDA
#undef PG8_LDB
#undef PG8_MMA
#undef PG8_WAIT_V
#undef PG8_WAIT_L
#undef PG8_BAR
#undef PG8_SCHED
}
}
namespace pg8 {
template <class T> __device__ __forceinline__ T* uni_ptr(T* p) {
    const unsigned long long v = (unsigned long long)p; unsigned lo = __builtin_amdgcn_readfirstlane((unsigned)v), hi = __builtin_amdgcn_readfirstlane((unsigned)(v >> 32)); asm volatile("" : "+s"(lo), "+s"(hi)); return (T*)(((unsigned long long)hi << 32) | lo); }
template <bool XB16> struct EpiResid {
    static constexpr bool PERM = true, AFTER_DRAIN = false;
    const void* xin_; bf16_t* out_; const float* gate_;
    __device__ __forceinline__ void operator()(const f32x4 (&acc)[2][2][4][2], const Unit& u, int wr, int wc, int fr, int fq) const {
        const void* xin = uni_ptr(xin_); bf16_t* out = uni_ptr(out_); const float* gate = uni_ptr(gate_);
        const int row0 = u.pm * BM + wr * 64 + fr, col0 = u.pn * BM + wc * 32 + 8 * fq;
        const float* gp = gate + (size_t)(u.pm >> 5) * 6144 + col0;
        f32x4 gv[2][2];
#pragma unroll
        for (int bj = 0; bj < 2; ++bj)
#pragma unroll
            for (int n = 0; n < 2; ++n) gv[bj][n] = *(const f32x4*)(gp + bj * HALF + 4 * n);
        if (XB16) {
#pragma unroll
            for (int ai = 0; ai < 2; ++ai) { u32x4 xr[4][2];
#pragma unroll
                for (int m = 0; m < 4; ++m)
#pragma unroll
                    for (int bj = 0; bj < 2; ++bj) xr[m][bj] = *(const u32x4*)((const bf16_t*)xin + (size_t)(row0 + ai * HALF + m * 16) * 1024 + col0 + bj * HALF);
#pragma unroll
                for (int m = 0; m < 4; ++m)
#pragma unroll
                    for (int bj = 0; bj < 2; ++bj) { const u32x4 q = xr[m][bj];
                        const f32x4 x0 = (f32x4){__uint_as_float(q.x << 16), __uint_as_float(q.x & 0xffff0000u), __uint_as_float(q.y << 16), __uint_as_float(q.y & 0xffff0000u)};
                        const f32x4 x1 = (f32x4){__uint_as_float(q.z << 16), __uint_as_float(q.z & 0xffff0000u), __uint_as_float(q.w << 16), __uint_as_float(q.w & 0xffff0000u)};
                        const f32x4 y0 = x0 + gv[bj][0] * acc[ai][bj][m][0], y1 = x1 + gv[bj][1] * acc[ai][bj][m][1];
                        u32x4 w; w.x = cvt_pk_bf16(y0[0], y0[1]); w.y = cvt_pk_bf16(y0[2], y0[3]); w.z = cvt_pk_bf16(y1[0], y1[1]); w.w = cvt_pk_bf16(y1[2], y1[3]);
                        *(u32x4*)(out + (size_t)(row0 + ai * HALF + m * 16) * 1024 + col0 + bj * HALF) = w; }
                asm volatile("" ::: "memory"); }
        } else {
#pragma unroll
            for (int ai = 0; ai < 2; ++ai) { f32x4 xr[4][2][2];
#pragma unroll
                for (int m = 0; m < 4; ++m)
#pragma unroll
                    for (int bj = 0; bj < 2; ++bj) { const float* xp = (const float*)xin + (size_t)(row0 + ai * HALF + m * 16) * 1024 + col0 + bj * HALF; xr[m][bj][0] = *(const f32x4*)xp; xr[m][bj][1] = *(const f32x4*)(xp + 4); }
#pragma unroll
                for (int m = 0; m < 4; ++m)
#pragma unroll
                    for (int bj = 0; bj < 2; ++bj) { const f32x4 y0 = xr[m][bj][0] + gv[bj][0] * acc[ai][bj][m][0], y1 = xr[m][bj][1] + gv[bj][1] * acc[ai][bj][m][1];
                        u32x4 w; w.x = cvt_pk_bf16(y0[0], y0[1]); w.y = cvt_pk_bf16(y0[2], y0[3]); w.z = cvt_pk_bf16(y1[0], y1[1]); w.w = cvt_pk_bf16(y1[2], y1[3]);
                        *(u32x4*)(out + (size_t)(row0 + ai * HALF + m * 16) * 1024 + col0 + bj * HALF) = w; }
                asm volatile("" ::: "memory"); }
        }
    }
};
struct EpiRelu2 {
    static constexpr bool PERM = true, AFTER_DRAIN = false;
    bf16_t* O_; int ldc;
    __device__ __forceinline__ void operator()(const f32x4 (&acc)[2][2][4][2], const Unit& u, int wr, int wc, int fr, int fq) const {
        bf16_t* O = uni_ptr(O_);
        const int row0 = u.pm * BM + wr * 64 + fr, col0 = u.pn * BM + wc * 32 + 8 * fq;
#pragma unroll
        for (int ai = 0; ai < 2; ++ai)
#pragma unroll
            for (int m = 0; m < 4; ++m) { bf16_t* rowp = O + (size_t)(row0 + ai * HALF + m * 16) * ldc + col0;
#pragma unroll
                for (int bj = 0; bj < 2; ++bj) { f32x4 v0 = acc[ai][bj][m][0], v1 = acc[ai][bj][m][1];
                    v0 = __builtin_elementwise_max(v0, (f32x4){0.f, 0.f, 0.f, 0.f}); v1 = __builtin_elementwise_max(v1, (f32x4){0.f, 0.f, 0.f, 0.f}); v0 = v0 * v0; v1 = v1 * v1;
                    u32x4 w; w.x = cvt_pk_bf16(v0[0], v0[1]); w.y = cvt_pk_bf16(v0[2], v0[3]); w.z = cvt_pk_bf16(v1[0], v1[1]); w.w = cvt_pk_bf16(v1[2], v1[3]);
                    *(u32x4*)(rowp + bj * HALF) = w; } }
    }
};
struct EpiMlaQ {
    static constexpr bool PERM = true, AFTER_DRAIN = false;
    bf16_t* QM_;
    __device__ __forceinline__ void operator()(const f32x4 (&acc)[2][2][4][2], const Unit& u, int wr, int wc, int fr, int fq) const {
        bf16_t* QM = uni_ptr(QM_);
        const int row0 = u.pm * BM + wr * 64 + fr, cw = wc * 32 + 8 * fq;
        const int nbj = (u.pn != 0) ? 1 : 2;
#pragma unroll
        for (int ai = 0; ai < 2; ++ai)
#pragma unroll
            for (int m = 0; m < 4; ++m) { bf16_t* qr = QM + (size_t)(row0 + ai * HALF + m * 16) * 384 + u.pn * 256 + cw;
#pragma unroll
                for (int bj = 0; bj < 2; ++bj) if (bj < nbj) { const f32x4 v0 = acc[ai][bj][m][0], v1 = acc[ai][bj][m][1];
                    u32x4 o; o.x = cvt_pk_bf16(v0[0], v0[1]); o.y = cvt_pk_bf16(v0[2], v0[3]); o.z = cvt_pk_bf16(v1[0], v1[1]); o.w = cvt_pk_bf16(v1[2], v1[3]);
                    *(u32x4*)(qr + bj * HALF) = o; } }
    }
};
struct EpiMlaKV {
    static constexpr bool PERM = true, AFTER_DRAIN = false;
    bf16_t* KM_; bf16_t* VM_; const float* rskv_;
    __device__ __forceinline__ void operator()(const f32x4 (&acc)[2][2][4][2], const Unit& u, int wr, int wc, int fr, int fq) const {
        bf16_t* KM = uni_ptr(KM_); bf16_t* VM = uni_ptr(VM_); const float* rskv = uni_ptr(rskv_);
        const int row0 = u.pm * BM + wr * 64 + fr, w = wc * 32 + 8 * fq;
        const bool isk = wc < 2;
        float rsv[2][4];
#pragma unroll
        for (int ai = 0; ai < 2; ++ai)
#pragma unroll
            for (int m = 0; m < 4; ++m) rsv[ai][m] = rskv[row0 + ai * HALF + m * 16];
#pragma unroll
        for (int ai = 0; ai < 2; ++ai)
#pragma unroll
            for (int m = 0; m < 4; ++m) { const int row = row0 + ai * HALF + m * 16; const float rs = rsv[ai][m];
#pragma unroll
                for (int bj = 0; bj < 2; ++bj) { const int head = u.pn * 2 + bj;
                    const f32x4 v0 = acc[ai][bj][m][0] * rs, v1 = acc[ai][bj][m][1] * rs;
                    u32x4 o; o.x = cvt_pk_bf16(v0[0], v0[1]); o.y = cvt_pk_bf16(v0[2], v0[3]); o.z = cvt_pk_bf16(v1[0], v1[1]); o.w = cvt_pk_bf16(v1[2], v1[3]);
                    if (isk) *(u32x4*)(KM + (size_t)row * 384 + head * 96 + w) = o; else *(u32x4*)(VM + (size_t)row * 256 + head * 64 + (w - 64)) = o; }
                asm volatile("" ::: "memory"); }
    }
};
}
#define GAS __attribute__((address_space(1)))
#define LAS __attribute__((address_space(3)))
typedef unsigned short bf16;
typedef unsigned v4u __attribute__((ext_vector_type(4)));
typedef float f32x4 __attribute__((ext_vector_type(4)));
typedef short bf16x8 __attribute__((ext_vector_type(8)));
typedef GAS unsigned gu32;
typedef GAS unsigned long long gu64;
#define RLX_AGENT __ATOMIC_RELAXED, __HIP_MEMORY_SCOPE_AGENT
#define LDS_WAIT() asm volatile("s_waitcnt lgkmcnt(0)" ::: "memory")
#define VM_WAIT() asm volatile("s_waitcnt vmcnt(0)" ::: "memory")
__device__ __forceinline__ unsigned long long rt() { return __builtin_amdgcn_s_memrealtime(); }
__device__ __forceinline__ unsigned f2bf(float f) { unsigned u = __builtin_bit_cast(unsigned, f); return (u + 0x7fffu + ((u >> 16) & 1u)) >> 16; }
__device__ __forceinline__ unsigned pk2(float lo, float hi) { return f2bf(lo) | (f2bf(hi) << 16); }

#define XB_TMO      128
#define XB_XCNT(j)  (256  + 64 * (j))
#define XB_XSUB(j)  (1280 + 64 * (j))
#define XB_XGEN(j)  (2304 + 64 * (j))
#define XB_TOP      3328
#define XB_TOPGEN   3392
#define XCD_BAR_WORDS 3456
#define XB_SPIN_CAP (1u << 18)

__device__ __forceinline__ unsigned xb_ld(unsigned* p)              { return __hip_atomic_load(p, __ATOMIC_RELAXED, __HIP_MEMORY_SCOPE_AGENT); }
__device__ __forceinline__ unsigned xb_add(unsigned* p, unsigned v) { return __hip_atomic_fetch_add(p, v, __ATOMIC_RELAXED, __HIP_MEMORY_SCOPE_AGENT); }
__device__ __forceinline__ unsigned xb_xcc_id() { return (unsigned)__builtin_amdgcn_s_getreg((3 << 11) | 20) & 0xFu; }
#define XB_SPIN(cond, bar) do { unsigned _sp = 0; while (cond) { __builtin_amdgcn_s_sleep(1); \
    if ((++_sp & 255u) == 0u) { if (xb_ld(&(bar)[XB_TMO])) break; if (_sp > XB_SPIN_CAP) { atomicAdd(&(bar)[XB_TMO], 1u); break; } } } } while (0)

struct XcdBarrier {
    unsigned* bar; unsigned x;
    volatile LAS unsigned* st;
};

__device__ __forceinline__ XcdBarrier xcd_barrier_post(unsigned* bar, volatile LAS unsigned* st) {
    XcdBarrier b; b.bar = bar; b.x = xb_xcc_id(); b.st = st;
    if (threadIdx.x == 0) (void)xb_add(&bar[XB_XCNT(b.x)], 1u);
    return b;
}
__device__ __forceinline__ void xcd_barrier_complete(unsigned* bar, unsigned x, unsigned& nloc, unsigned& nx) {
    const unsigned G = gridDim.x * gridDim.y * gridDim.z;
    unsigned sum, cnt, mine, sp = 0u;
    for (;;) {
        sum = 0u; cnt = 0u; mine = 0u;
#pragma unroll
        for (unsigned j = 0; j < 16; ++j) { const unsigned c = xb_ld(&bar[XB_XCNT(j)]); sum += c; cnt += (c > 0u) ? 1u : 0u; mine = (j == x) ? c : mine; }
        if (sum == G) break;
        __builtin_amdgcn_s_sleep(1);
        if ((++sp & 255u) == 0u) { if (xb_ld(&bar[XB_TMO])) break; if (sp > XB_SPIN_CAP) { atomicAdd(&bar[XB_TMO], 1u); break; } }
    }
    nloc = mine > 0u ? mine : 1u; nx = cnt > 0u ? cnt : 1u;
}

__device__ __forceinline__ void xcd_barrier(const XcdBarrier& b) {
    asm volatile("s_waitcnt vmcnt(0)" ::: "memory");
    __syncthreads();
    if (threadIdx.x == 0) {
        unsigned* bar = b.bar;
        __builtin_amdgcn_s_waitcnt(0);
        unsigned nloc = b.st[0], nx = b.st[1];
        if (nloc == 0u) { xcd_barrier_complete(bar, b.x, nloc, nx); b.st[0] = nloc; b.st[1] = nx; }
        const unsigned old = xb_add(&bar[XB_XSUB(b.x)], 1u);
        const unsigned gen = old / nloc;
        if (old + 1u == (gen + 1u) * nloc) {
            __builtin_amdgcn_fence(__ATOMIC_RELEASE, "agent");
            asm volatile("s_waitcnt vmcnt(0)" ::: "memory");
            const unsigned og = xb_add(&bar[XB_TOP], 1u);
            const unsigned tg = og / nx;
            if (og + 1u == (tg + 1u) * nx) xb_add(&bar[XB_TOPGEN], 1u);
            else XB_SPIN(xb_ld(&bar[XB_TOPGEN]) == tg, bar);
            __builtin_amdgcn_fence(__ATOMIC_ACQUIRE, "agent");
            xb_add(&bar[XB_XGEN(b.x)], 1u);
            asm volatile("s_waitcnt vmcnt(0)" ::: "memory");
        } else {
            XB_SPIN(xb_ld(&bar[XB_XGEN(b.x)]) == gen, bar);
            __builtin_amdgcn_fence(__ATOMIC_ACQUIRE, "agent");
            asm volatile("s_waitcnt vmcnt(0)" ::: "memory");
        }
    }
    __syncthreads();
}
#ifndef FA_PROBE
#define FA_PROBE 0
#endif
#ifndef FA_EXP
#define FA_EXP 0
#endif
namespace fa {
typedef unsigned short bf16;
typedef short bf16x8 __attribute__((ext_vector_type(8)));
typedef short s16x4 __attribute__((ext_vector_type(4)));
typedef float f32x16 __attribute__((ext_vector_type(16)));
typedef float f32x4v __attribute__((ext_vector_type(4)));
typedef unsigned u32x4 __attribute__((ext_vector_type(4)));
typedef unsigned u32x2 __attribute__((ext_vector_type(2)));
typedef float f32x2_t __attribute__((ext_vector_type(2)));
typedef __bf16 bf16x2_t __attribute__((ext_vector_type(2)));
#define FLAS __attribute__((address_space(3)))
#define FGAS __attribute__((address_space(1)))
constexpr float MASKV = -1e30f, MINIT = -5e29f, TINYF = 1e-30f, LOG2E = 1.4426950408889634f;
constexpr int OSTR = 144;

__device__ __forceinline__ float ex2(float x) { return __builtin_amdgcn_exp2f(x); }
__device__ __forceinline__ unsigned cvtpk(float lo, float hi) { f32x2_t v = {lo, hi}; bf16x2_t b = __builtin_convertvector(v, bf16x2_t); return __builtin_bit_cast(unsigned, b); }
__device__ __forceinline__ float xhalf_max(float m) { auto rr = __builtin_amdgcn_permlane32_swap(__float_as_uint(m), __float_as_uint(m), false, false); return fmaxf(__uint_as_float(rr[0]), __uint_as_float(rr[1])); }
__device__ __forceinline__ float xhalf_sum(float m) { auto rr = __builtin_amdgcn_permlane32_swap(__float_as_uint(m), __float_as_uint(m), false, false); return __uint_as_float(rr[0]) + __uint_as_float(rr[1]); }
__device__ __forceinline__ float bf2f(unsigned short b) { return __uint_as_float((unsigned)b << 16); }

struct SM { float m, l; f32x16 o[2]; };
__device__ __forceinline__ void sm_init(SM& s) { s.m = MINIT; s.l = 0.f; s.o[0] = f32x16{}; s.o[1] = f32x16{}; }

template <int DQ> struct Stg { u32x4 k0, k1, v; };
template <int DQ> __device__ __forceinline__ void stg_load(Stg<DQ>& s, const FGAS char* ws, unsigned koff, unsigned ksb, unsigned voff, unsigned vsb, int key0, int kmax, int tid) {
    const int row = tid >> 3, ch = tid & 7; int kr = key0 + row; kr = kr < kmax ? kr : kmax;
    s.k0 = *(const FGAS u32x4*)(ws + (koff + (unsigned)kr * ksb + (unsigned)ch * 16u));
    s.v = *(const FGAS u32x4*)(ws + (voff + (unsigned)kr * vsb + (unsigned)ch * 16u));
    if (DQ == 96) { if (tid < 256) { const int r2 = tid >> 2, c2 = tid & 3; int k2 = key0 + r2; k2 = k2 < kmax ? k2 : kmax; s.k1 = *(const FGAS u32x4*)(ws + (koff + (unsigned)k2 * ksb + 128u + (unsigned)c2 * 16u)); } }
}
template <int DQ> __device__ __forceinline__ void stg_store(const Stg<DQ>& s, FLAS char* buf, int tid) {
    const int row = tid >> 3, ch = tid & 7, p = ch >> 2, c = ch & 3;
    *(FLAS u32x4*)(buf + p * 4096 + row * 64 + ((c ^ ((row >> 2) & 3)) << 4)) = s.k0;
    *(FLAS u32x4*)(buf + (DQ / 32) * 4096 + row * 128 + ((p ^ ((row >> 1) & 1)) << 6) + (c << 4)) = s.v;
    if (DQ == 96) { if (tid < 256) { const int r2 = tid >> 2, c2 = tid & 3; *(FLAS u32x4*)(buf + 2 * 4096 + r2 * 64 + ((c2 ^ ((r2 >> 2) & 3)) << 4)) = s.k1; } }
}
template <int DQ> constexpr int stage_bytes() { return (DQ / 32) * 4096 + 8192; }

template <int DQ> __device__ __forceinline__ void compute_S(f32x16& p0, f32x16& p1, const FLAS char* buf, const bf16x8 (&qf)[DQ / 16], int lane) {
    const int r = lane & 31, h = lane >> 5, sw = (r >> 2) & 3;
#pragma unroll
    for (int d0 = 0; d0 < DQ / 16; ++d0) {
        const int p = d0 >> 1, c = 2 * (d0 & 1) + h;
        const FLAS char* a = buf + p * 4096 + r * 64 + ((c ^ sw) << 4);
        const bf16x8 a0 = *(const FLAS bf16x8*)a, a1 = *(const FLAS bf16x8*)(a + 2048);
        p0 = __builtin_amdgcn_mfma_f32_32x32x16_bf16(a0, qf[d0], p0, 0, 0, 0);
        p1 = __builtin_amdgcn_mfma_f32_32x32x16_bf16(a1, qf[d0], p1, 0, 0, 0);
    }
#if FA_EXP & 2
    __builtin_amdgcn_sched_group_barrier(0x100, 4, 0);
#pragma unroll
    for (int i = 0; i < DQ / 16 - 2; ++i) { __builtin_amdgcn_sched_group_barrier(0x008, 2, 0); __builtin_amdgcn_sched_group_barrier(0x100, 2, 0); }
    __builtin_amdgcn_sched_group_barrier(0x008, 4, 0);
#endif
}
__device__ __forceinline__ s16x4 vtr(const FLAS char* p) { typedef short v4i16_t __attribute__((ext_vector_type(4))); return __builtin_bit_cast(s16x4, __builtin_amdgcn_ds_read_tr16_b64_v4i16((FLAS v4i16_t*)p)); }
__device__ __forceinline__ void pv(f32x16 (&o)[2], const FLAS char* vbuf, const bf16x8 (&pf)[4], int lane) {
    const int g = lane >> 4, i = lane & 15, q4 = i >> 2, pp = i & 3, h = lane >> 5;
    const int sw = (q4 >> 1) & 1;
#pragma unroll
    for (int db = 0; db < 2; ++db) {
        const FLAS char* base = vbuf + (4 * h + q4) * 128 + ((db ^ sw) << 6) + (16 * (g & 1) + 4 * pp) * 2;
#pragma unroll
        for (int ks = 0; ks < 4; ++ks) {
            const s16x4 lo = vtr(base + ks * 2048), hi = vtr(base + ks * 2048 + 1024);
            const bf16x8 a = (bf16x8){lo[0], lo[1], lo[2], lo[3], hi[0], hi[1], hi[2], hi[3]};
            o[db] = __builtin_amdgcn_mfma_f32_32x32x16_bf16(a, pf[ks], o[db], 0, 0, 0);
        }
    }
#if FA_EXP & 2
    __builtin_amdgcn_sched_group_barrier(0x100, 8, 0);
    __builtin_amdgcn_sched_group_barrier(0x008, 2, 0); __builtin_amdgcn_sched_group_barrier(0x100, 4, 0);
    __builtin_amdgcn_sched_group_barrier(0x008, 2, 0); __builtin_amdgcn_sched_group_barrier(0x100, 4, 0);
    __builtin_amdgcn_sched_group_barrier(0x008, 4, 0);
#endif
}
__device__ __forceinline__ void mask_ew(f32x16& p0, f32x16& p1, int lo, int hi, int h) {
    const int lo2 = lo - 4 * h, hi2 = hi - 4 * h;
#pragma unroll
    for (int v = 0; v < 16; ++v) { const int k0 = (v & 3) + 8 * (v >> 2);
        if (k0 < lo2 || k0 > hi2) p0[v] = MASKV;
        if (k0 + 32 < lo2 || k0 + 32 > hi2) p1[v] = MASKV; }
}
__device__ __forceinline__ void sm_step(SM& st, f32x16& p0, f32x16& p1, bf16x8 (&pf)[4]) {
#define FA_MX3(a, b, c) __builtin_fmaxf(__builtin_fmaxf((a), (b)), (c))
    float ma = FA_MX3(p0[0], p0[1], p1[0]), mb = FA_MX3(p0[2], p0[3], p1[1]); ma = FA_MX3(ma, p1[2], p1[3]);
#pragma unroll
    for (int v = 4; v < 16; v += 4) { ma = FA_MX3(ma, p0[v], p0[v + 1]); mb = FA_MX3(mb, p0[v + 2], p0[v + 3]); ma = FA_MX3(ma, p1[v], p1[v + 1]); mb = FA_MX3(mb, p1[v + 2], p1[v + 3]); }
#undef FA_MX3
    const float mx = xhalf_max(__builtin_fmaxf(ma, mb));
    if (__any(mx > st.m)) {
        const float mn2 = fmaxf(st.m, mx), alpha = ex2(st.m - mn2);
        st.m = mn2; st.l *= alpha; st.o[0] *= alpha; st.o[1] *= alpha;
    }
    const float mn = st.m;
    float s0 = 0.f, s1 = 0.f;
#pragma unroll
    for (int v = 0; v < 16; ++v) { p0[v] = ex2(p0[v] - mn); p1[v] = ex2(p1[v] - mn); s0 += p0[v]; s1 += p1[v]; }
    st.l += s0 + s1;
    u32x4 w;
    w.x = cvtpk(p0[0], p0[1]); w.y = cvtpk(p0[2], p0[3]); w.z = cvtpk(p0[4], p0[5]); w.w = cvtpk(p0[6], p0[7]); pf[0] = __builtin_bit_cast(bf16x8, w);
    w.x = cvtpk(p0[8], p0[9]); w.y = cvtpk(p0[10], p0[11]); w.z = cvtpk(p0[12], p0[13]); w.w = cvtpk(p0[14], p0[15]); pf[1] = __builtin_bit_cast(bf16x8, w);
    w.x = cvtpk(p1[0], p1[1]); w.y = cvtpk(p1[2], p1[3]); w.z = cvtpk(p1[4], p1[5]); w.w = cvtpk(p1[6], p1[7]); pf[2] = __builtin_bit_cast(bf16x8, w);
    w.x = cvtpk(p1[8], p1[9]); w.y = cvtpk(p1[10], p1[11]); w.z = cvtpk(p1[12], p1[13]); w.w = cvtpk(p1[14], p1[15]); pf[3] = __builtin_bit_cast(bf16x8, w);
}
template <int DQ, bool ALIBI> __device__ __forceinline__ void score_tile(f32x16& p0, f32x16& p1, const FLAS char* buf, const bf16x8 (&qf)[DQ / 16], float cb, float sl, int lane) {
    if (ALIBI) {
#pragma unroll
        for (int v = 0; v < 16; ++v) { const float c = (float)((v & 3) + 8 * (v >> 2)); p0[v] = fmaf(sl, c, cb); p1[v] = fmaf(sl, c + 32.f, cb); }
    } else { p0 = f32x16{}; p1 = f32x16{}; }
    compute_S<DQ>(p0, p1, buf, qf, lane);
}
template <int DQ, bool ALIBI> __device__ __forceinline__ void tile_compute(SM& st, const FLAS char* buf, const bf16x8 (&qf)[DQ / 16], float cb, float sl, bool ew, int lo, int hi, int lane) {
    f32x16 p0, p1; bf16x8 pf[4];
    score_tile<DQ, ALIBI>(p0, p1, buf, qf, cb, sl, lane);
    if (ew) mask_ew(p0, p1, lo, hi, lane >> 5);
    sm_step(st, p0, p1, pf);
    pv(st.o, buf + (DQ / 32) * 4096, pf, lane);
}
template <int DQ, bool ALIBI, class K0, class PAR>
__device__ __forceinline__ void fa_loop(SM& st, const bf16x8 (&qf)[DQ / 16], const FGAS char* ws, unsigned koff, unsigned ksb, unsigned voff, unsigned vsb, int kmax, int ntile, K0 k0f, PAR parf, float sl, FLAS char* lds, int tid, int lane) {
    constexpr int STG = stage_bytes<DQ>();
    Stg<DQ> sgA, sgB;
    stg_load<DQ>(sgB, ws, koff, ksb, voff, vsb, k0f(0), kmax, tid); stg_store<DQ>(sgB, lds, tid);
    if (ntile > 1) stg_load<DQ>(sgA, ws, koff, ksb, voff, vsb, k0f(1), kmax, tid);
    if (ntile > 2) stg_load<DQ>(sgB, ws, koff, ksb, voff, vsb, k0f(2), kmax, tid);
    __syncthreads();
#if FA_PROBE && FA_PROBE < 9
    unsigned long long pr_c = 0, pr_w = 0, pr_b = 0, pr_t = 0; const unsigned long long pr_start = __builtin_amdgcn_s_memtime();
#define FA_P0 const unsigned long long q0_ = __builtin_amdgcn_s_memtime();
#define FA_P1 asm volatile("s_waitcnt vmcnt(0)" ::: "memory"); const unsigned long long q1_ = __builtin_amdgcn_s_memtime();
#define FA_P2 asm volatile("s_waitcnt lgkmcnt(0)" ::: "memory"); asm volatile("" : "+v"(st.o[0]), "+v"(st.o[1])); const unsigned long long q2_ = __builtin_amdgcn_s_memtime();
#define FA_P3 const unsigned long long q3_ = __builtin_amdgcn_s_memtime(); pr_w += q1_ - q0_; pr_c += q2_ - q1_; pr_b += q3_ - q2_; pr_t += 1;
#else
#define FA_P0
#define FA_P1
#define FA_P2
#define FA_P3
#endif
#define FA_ITER(SG) { \
        FA_P0 \
        if (t + 1 < ntile) stg_store<DQ>(SG, lds + ((t + 1) & 1) * STG, tid); \
        if (t + 3 < ntile) stg_load<DQ>(SG, ws, koff, ksb, voff, vsb, k0f(t + 3), kmax, tid); \
        FA_P1 \
        bool act, ew; float cb; int lo, hi; \
        parf(t, act, ew, cb, lo, hi); \
        if (act) tile_compute<DQ, ALIBI>(st, lds + (t & 1) * STG, qf, cb, sl, ew, lo, hi, lane); \
        FA_P2 \
        __syncthreads(); \
        FA_P3 }
    int t = 0;
    for (; t + 1 < ntile; t += 2) { FA_ITER(sgA) ++t; FA_ITER(sgB) --t; }
    if (t < ntile) FA_ITER(sgA)
#undef FA_ITER
#if FA_PROBE && FA_PROBE < 9
    if (DQ == 96 && lane == 0) { unsigned long long* pp = (unsigned long long*)((FGAS char*)ws + 32768);
        atomicAdd(pp + 0, pr_c); atomicAdd(pp + 1, pr_w); atomicAdd(pp + 2, pr_b); atomicAdd(pp + 3, pr_t); atomicAdd(pp + 4, __builtin_amdgcn_s_memtime() - pr_start); }
#endif
}
__device__ __forceinline__ void sm_finish(const SM& st, float gate, f32x16 (&acc)[2]) {
    const float inv = gate / fmaxf(xhalf_sum(st.l), TINYF);
    acc[0] += st.o[0] * inv; acc[1] += st.o[1] * inv;
}
template <class DST> __device__ __forceinline__ void store_out(const f32x16 (&acc)[2], FLAS char* ost, FGAS char* ws, DST dstf, int lane) {
    const int r = lane & 31, h = lane >> 5;
#pragma unroll
    for (int db = 0; db < 2; ++db)
#pragma unroll
        for (int g = 0; g < 4; ++g) { u32x2 w; w.x = cvtpk(acc[db][4 * g], acc[db][4 * g + 1]); w.y = cvtpk(acc[db][4 * g + 2], acc[db][4 * g + 3]);
            *(FLAS u32x2*)(ost + r * OSTR + (32 * db + 8 * g + 4 * h) * 2) = w; }
    asm volatile("s_waitcnt lgkmcnt(0)" ::: "memory");
#pragma unroll
    for (int i = 0; i < 4; ++i) { const int idx = i * 64 + lane, col = idx >> 3, ch = idx & 7;
        const u32x4 v = *(const FLAS u32x4*)(ost + col * OSTR + ch * 16);
        *(FGAS u32x4*)(ws + (dstf(col) + (unsigned)ch * 16u)) = v; }
    asm volatile("s_waitcnt lgkmcnt(0)" ::: "memory");
}
template <int DQ> __device__ __forceinline__ void load_q(bf16x8 (&qf)[DQ / 16], const FGAS char* ws, unsigned qoff, int h) {
#pragma unroll
    for (int d0 = 0; d0 < DQ / 16; ++d0) qf[d0] = *(const FGAS bf16x8*)(ws + (qoff + (unsigned)(d0 * 32 + 16 * h)));
}
}
namespace mk {
typedef unsigned short bf16;
typedef float f32x4 __attribute__((ext_vector_type(4)));
typedef unsigned v4u __attribute__((ext_vector_type(4)));
typedef unsigned v2u __attribute__((ext_vector_type(2)));
typedef short bf16x8 __attribute__((ext_vector_type(8)));
typedef float f32x16 __attribute__((ext_vector_type(16)));
using fa::SM;

constexpr int D = 1024, NB = 4, SEQ = 8192, M = NB * SEQ, DEPTH = 2, DFF = 4096, ZLD = 2304, DIN = 2284;
constexpr int ZA_Q = 0, ZA_K = 256, ZA_V = 384, ZB_CQ = 512, ZB_CKV = 704, ZB_PE = 832, ZC_Q = 864, ZC_KC = 1120, ZC_VC = 1184, ZC_KS = 1248, ZC_VS = 1312, ZC_KW = 1376, ZC_VW = 1440, ZC_GL = 1504, ZD_Q = 1520, ZD_K = 1776, ZD_V = 2032;
constexpr float LOG2E = 1.4426950408889634f;
constexpr float QS = 0.125f * LOG2E;
constexpr float C_MLA = 0.10206207261596577f * LOG2E;
constexpr float RMS_EPS = 1e-6f;
constexpr int NWAVES = 8, NTHR = 512;

constexpr size_t MiB = 1u << 20;
constexpr size_t WS_CTL = 0, CTL_ZERO_BYTES = 64 * 1024;
constexpr size_t WS_MOD = 1 * MiB;
constexpr size_t WS_ROPE = WS_MOD + 256 * 1024;
constexpr size_t WS_POSP = WS_ROPE + 1 * MiB;
constexpr size_t WS_POSB = WS_POSP + 64 * 1024;
constexpr size_t WS_RSQ = WS_POSB + 64 * 1024;
constexpr size_t WS_RSKV = WS_RSQ + 128 * 1024;
constexpr size_t WS_KMH = WS_RSKV + 128 * 1024;
constexpr size_t WS_KML = WS_KMH + 64 * 1024;
constexpr size_t WS_KCMP = WS_KML + 64 * 1024;
constexpr size_t WS_VCMP = WS_KCMP + 256 * 1024;
constexpr size_t WS_XB = 436 * MiB;
constexpr size_t WS_PARK = 401 * MiB;
constexpr size_t WS_W = 4 * MiB, WS_WL = 26 * MiB;
constexpr size_t W_IN = 0, W_OUT = 4608 * 1024, W_UP = W_OUT + 2 * MiB, W_DN = W_UP + 8 * MiB, W_UQ = W_DN + 8 * MiB, W_UKV = W_UQ + 256 * 1024, W_1K = W_UKV + 256 * 1024, W_1V = W_1K + 512 * 1024, W_2K = W_1V + 512 * 1024, W_2V = W_2K + 16 * 1024;
static_assert(W_2V + 16 * 1024 <= WS_WL && WS_VCMP + 256 * 1024 <= WS_W, "ws map");
constexpr size_t WS_H = 56 * MiB;
constexpr size_t WS_Z = 120 * MiB;
constexpr size_t WS_QM = 265 * MiB, WS_KM = 297 * MiB, WS_VM = 321 * MiB, WS_O = 337 * MiB, WS_U = 120 * MiB, WS_END = 401 * MiB;
static_assert(WS_Z + (size_t)(M + 64) * ZLD * 2 <= WS_QM && WS_U + (size_t)M * DFF * 2 <= WS_END, "ws map 2");

constexpr int LDS_RING = 131072, LDS_BYTES = 163840, LDS_MISC = LDS_BYTES - 256;
constexpr int FA_STAGES = 0, FA_OST = 61440, FA_IMP = FA_OST + 8 * 32 * fa::OSTR  , FA_SELM = FA_IMP + 32768, FA_UM = FA_SELM + 1024, FA_VALS = FA_UM + 64;
static_assert(FA_VALS + 8 * 512 <= LDS_MISC, "fa lds map");
constexpr int MB_OS = 65;
constexpr int MB_T = 0, MB_O = 65536, MB_ML = MB_O + 256 * MB_OS * 4, MB_CNT = MB_ML + 2048, MB_LST = MB_CNT + 128, MB_PS = MB_LST + 8192, MB_PM = MB_PS + 4 * 32 * 33 * 4;
static_assert(MB_PM + 1024 <= LDS_MISC, "moba lds map");

#define GAS __attribute__((address_space(1)))
#define LAS __attribute__((address_space(3)))
#define LDS_WAIT() asm volatile("s_waitcnt lgkmcnt(0)" ::: "memory")
__device__ __forceinline__ unsigned f2bf(float f) { unsigned u = __builtin_bit_cast(unsigned, f); return (u + 0x7fffu + ((u >> 16) & 1u)) >> 16; }
__device__ __forceinline__ unsigned pk2(float lo, float hi) { return f2bf(lo) | (f2bf(hi) << 16); }
__device__ __forceinline__ float bf2f(unsigned short b) { return __uint_as_float((unsigned)b << 16); }
__device__ __forceinline__ float wave_sum(float v) {
#pragma unroll
    for (int o = 1; o < 64; o <<= 1) v += __shfl_xor(v, o);
    return v;
}
__device__ __forceinline__ float slope2_of(int i) { return exp2f(-8.0f * (float)(i + 1) / 12.0f) * LOG2E; }

struct Args { const float* in[22]; float* out; unsigned char* ws; int ph_lo, ph_hi, skip, rep; };
typedef const __attribute__((address_space(4))) Args* KArgsP;
struct Frame {
    LAS unsigned char* lds;
    int tid, lane, wave, vcu, G, bx;
    unsigned char* ws;
};

template <int MODE> __device__ __forceinline__ int dmap(int n) {
    if (MODE == 1) { if (n < 832) return n; if (n < 848) return 832 + 2 * (n - 832); if (n < 864) return 832 + 2 * (n - 848) + 1; if (n < 1516) return n; return n + 4; }
    if (MODE == 2) { const int hd = n / 96, w = n - hd * 96; if (w < 64) return hd * 64 + w; if (w < 80) return 256 + hd * 32 + 2 * (w - 64); return 256 + hd * 32 + 2 * (w - 80) + 1; }
    return n;
}
template <int MODE> __device__ __forceinline__ float cscale(int n) {
    if (MODE == 1) { return (n < 256 || (n >= 864 && n < 1120) || (n >= 1516 && n < 1772)) ? QS : 1.f; }
    if (MODE == 2) return C_MLA;
    return 1.f;
}
template <int MODE> __device__ __forceinline__ void transpose_item(const float* W, int N, bf16* WT, int KT, const float* kscale, LAS float* scr, int item, int lane) {
    const int nblk = (N + 31) / 32, kb = item / nblk, nb = item % nblk, k0 = 64 * kb, n0 = 32 * nb;
    const int nl = lane & 31, n = n0 + nl;
    float tv[32];
#pragma unroll
    for (int i = 0; i < 32; ++i) { const int kk = 2 * i + (lane >> 5); tv[i] = (n < N) ? W[(size_t)(k0 + kk) * N + n] : 0.f; }
#pragma unroll
    for (int i = 0; i < 32; ++i) { const int kk = 2 * i + (lane >> 5); float v = tv[i]; if (kscale) v *= kscale[k0 + kk]; scr[kk * 33 + nl] = v; }
    LDS_WAIT(); asm volatile("" ::: "memory");
    const int c = lane & 7;
#pragma unroll
    for (int j = 0; j < 4; ++j) { const int nn = (lane >> 3) + 8 * j, ng = n0 + nn;
        if (ng < N) { const float cs = cscale<MODE>(ng); const LAS float* s = scr + (8 * c) * 33 + nn;
            v4u o; o.x = pk2(s[0 * 33] * cs, s[1 * 33] * cs); o.y = pk2(s[2 * 33] * cs, s[3 * 33] * cs); o.z = pk2(s[4 * 33] * cs, s[5 * 33] * cs); o.w = pk2(s[6 * 33] * cs, s[7 * 33] * cs);
            *(GAS v4u*)(WT + (size_t)dmap<MODE>(ng) * KT + k0 + 8 * c) = o; } }
    LDS_WAIT(); asm volatile("" ::: "memory");
}
__device__ __forceinline__ void zero_fill16(bf16* p, size_t n16, int gtid, int gthreads) {
    for (size_t i = gtid; i < n16; i += gthreads) ((GAS v4u*)p)[i] = (v4u){0u, 0u, 0u, 0u};
}

__device__ __forceinline__ void p_prologue(Frame& F, KArgsP ap_) {
#define a (*ap_)
    LAS float* scr = (LAS float*)(F.lds + F.wave * 16384);
    const int gw = F.vcu * NWAVES + F.wave, NGW = F.G * NWAVES;
    const int gtid = F.vcu * NTHR + F.tid, GT = F.G * NTHR;
    constexpr int I_IN = 16 * 72, I_OUT = 16 * 32, I_UP = 16 * 128, I_DN = 64 * 32, I_UQ = 3 * 12, I_UKV = 2 * 16, I_W1 = 32 * 4, I_W2 = 2 * 2;
    constexpr int PER_L = I_IN + I_OUT + I_UP + I_DN + I_UQ + I_UKV + 2 * I_W1 + 2 * I_W2;
    for (int it = gw; it < DEPTH * PER_L; it += NGW) {
        const int l = it / PER_L; int r = it - l * PER_L;
        unsigned char* wb = F.ws + WS_W + (size_t)l * WS_WL;
        if (r < I_IN) { transpose_item<1>(a.in[6] + (size_t)l * D * DIN, DIN, (bf16*)(wb + W_IN), D, nullptr, scr, r, F.lane); continue; } r -= I_IN;
        if (r < I_OUT) { transpose_item<0>(a.in[7] + (size_t)l * D * D, D, (bf16*)(wb + W_OUT), D, nullptr, scr, r, F.lane); continue; } r -= I_OUT;
        if (r < I_UP) { transpose_item<0>(a.in[19] + (size_t)l * D * DFF, DFF, (bf16*)(wb + W_UP), D, nullptr, scr, r, F.lane); continue; } r -= I_UP;
        if (r < I_DN) { transpose_item<0>(a.in[20] + (size_t)l * DFF * D, D, (bf16*)(wb + W_DN), DFF, nullptr, scr, r, F.lane); continue; } r -= I_DN;
        if (r < I_UQ) { transpose_item<2>(a.in[11] + (size_t)l * 192 * 384, 384, (bf16*)(wb + W_UQ), 256, a.in[9] + l * 192, scr, r, F.lane); continue; } r -= I_UQ;
        if (r < I_UKV) { transpose_item<0>(a.in[12] + (size_t)l * 128 * 512, 512, (bf16*)(wb + W_UKV), 256, a.in[10] + l * 128, scr, r, F.lane); continue; } r -= I_UKV;
        if (r < I_W1) { transpose_item<0>(a.in[15] + (size_t)l * 2048 * 128, 128, (bf16*)(wb + W_1K), 2048, nullptr, scr, r, F.lane); continue; } r -= I_W1;
        if (r < I_W1) { transpose_item<0>(a.in[17] + (size_t)l * 2048 * 128, 128, (bf16*)(wb + W_1V), 2048, nullptr, scr, r, F.lane); continue; } r -= I_W1;
        if (r < I_W2) { transpose_item<0>(a.in[16] + (size_t)l * 128 * 64, 64, (bf16*)(wb + W_2K), 128, nullptr, scr, r, F.lane); continue; } r -= I_W2;
        transpose_item<0>(a.in[18] + (size_t)l * 128 * 64, 64, (bf16*)(wb + W_2V), 128, nullptr, scr, r, F.lane);
    }
    for (int l = 0; l < DEPTH; ++l) {
        unsigned char* wb = F.ws + WS_W + (size_t)l * WS_WL;
        zero_fill16((bf16*)(wb + W_IN) + (size_t)1516 * D, 4 * D / 8, gtid, GT);
        zero_fill16((bf16*)(wb + W_IN) + (size_t)2288 * D, 16 * D / 8, gtid, GT);
        zero_fill16((bf16*)(wb + W_UQ) + (size_t)384 * 256, 128 * 256 / 8, gtid, GT);
        for (int i = gtid; i < 384 * 8; i += GT) ((GAS v4u*)((bf16*)(wb + W_UQ) + (size_t)(i >> 3) * 256 + 192))[i & 7] = (v4u){0u, 0u, 0u, 0u};
        for (int i = gtid; i < 512 * 16; i += GT) ((GAS v4u*)((bf16*)(wb + W_UKV) + (size_t)(i >> 4) * 256 + 128))[i & 15] = (v4u){0u, 0u, 0u, 0u};
    }
    { float* rt = (float*)(F.ws + WS_ROPE);
      for (int i = gtid; i < SEQ * 16; i += GT) { const int ii = i & 15, t = i >> 4; const float freq = powf(10000.f, -(float)ii / 16.f), ang = (float)t * freq; rt[2 * i] = cosf(ang); rt[2 * i + 1] = sinf(ang); } }
    { float* pp = (float*)(F.ws + WS_POSP);
      for (int i = gtid; i < DEPTH * 2 * 32 * 128; i += GT) { const int j = i & 127, kr = (i >> 7) & 31, wh = (i >> 12) & 1, l = i >> 13;
          const float* pos = a.in[wh ? 14 : 13] + l * 2048 + kr * 64; const float* w1 = a.in[wh ? 17 : 15] + (size_t)l * 2048 * 128 + (size_t)kr * 64 * 128 + j;
          float s = 0.f;
#pragma unroll 32
          for (int k = 0; k < 64; ++k) s += pos[k] * w1[(size_t)k * 128];
          pp[i] = s; } }
    { LAS float* sc = (LAS float*)(F.lds);
      LAS float* part = (LAS float*)(F.lds + 16384);
      __syncthreads();
      bool have = false;
      for (int it = F.vcu; it < DEPTH * 96; it += F.G) {
          if (!have) { for (int i = F.tid; i < NB * D; i += NTHR) { const float cv = a.in[1][i]; sc[i] = cv / (1.f + expf(-cv)); } have = true; __syncthreads(); }
          const int l = it / 96, ch = it % 96; const int j = ch * 64 + F.lane;
          const float* w = a.in[4] + (size_t)l * D * 6 * D + j;
          float acc[4] = {0.f, 0.f, 0.f, 0.f};
#pragma unroll 32
          for (int k = 128 * F.wave; k < 128 * F.wave + 128; ++k) { const float wv = w[(size_t)k * 6 * D]; acc[0] += sc[k] * wv; acc[1] += sc[D + k] * wv; acc[2] += sc[2 * D + k] * wv; acc[3] += sc[3 * D + k] * wv; }
#pragma unroll
          for (int b = 0; b < 4; ++b) part[(F.wave * 4 + b) * 64 + F.lane] = acc[b];
          __syncthreads();
          if (F.tid < 256) { const int b = F.tid >> 6, ln = F.tid & 63; float s = a.in[5][l * 6 * D + ch * 64 + ln];
#pragma unroll
              for (int w8 = 0; w8 < 8; ++w8) s += part[(w8 * 4 + b) * 64 + ln];
              ((float*)(F.ws + WS_MOD))[((size_t)l * NB + b) * 6 * D + ch * 64 + ln] = s; }
          __syncthreads();
      } }
}

#undef a
template <int MODE, bool XB16> __device__ __forceinline__ void p_norm(Frame& F, const void* x, const float* g, const float* modsh, const float* modsc, bf16* hout, float* fout) {
    const int gw = F.vcu * NWAVES + F.wave, NGW = F.G * NWAVES;
    for (int blk = gw; blk < M / 16; blk += NGW) {
        const int row0 = blk * 16, b = row0 >> 13;
        f32x4 ga[4], sh[4];
#pragma unroll
        for (int j = 0; j < 4; ++j) { const int c = 4 * F.lane + 256 * j; ga[j] = *(const f32x4*)(g + c);
            if (MODE == 0) { const f32x4 s = *(const f32x4*)(modsc + (size_t)b * 6 * D + c); ga[j] = ga[j] * (s + 1.0f); sh[j] = *(const f32x4*)(modsh + (size_t)b * 6 * D + c); } }
        for (int rr = 0; rr < 16; rr += 4) {
            f32x4 v[4][4];
#pragma unroll
            for (int q = 0; q < 4; ++q) { const int row = row0 + rr + q;
                if (XB16) { const GAS unsigned long long* xr = (const GAS unsigned long long*)((const bf16*)x + (size_t)row * D) + F.lane;
#pragma unroll
                    for (int j = 0; j < 4; ++j) { const unsigned long long qq = xr[64 * j]; const unsigned lo = (unsigned)qq, hi = (unsigned)(qq >> 32);
                        v[q][j] = (f32x4){__uint_as_float(lo << 16), __uint_as_float(lo & 0xffff0000u), __uint_as_float(hi << 16), __uint_as_float(hi & 0xffff0000u)}; } }
                else { const GAS f32x4* xr = (const GAS f32x4*)((const float*)x + (size_t)row * D) + F.lane;
#pragma unroll
                    for (int j = 0; j < 4; ++j) v[q][j] = xr[64 * j]; } }
#pragma unroll
            for (int q = 0; q < 4; ++q) { const int row = row0 + rr + q; float s = 0.f;
#pragma unroll
                for (int j = 0; j < 4; ++j) s += (v[q][j].x * v[q][j].x + v[q][j].y * v[q][j].y) + (v[q][j].z * v[q][j].z + v[q][j].w * v[q][j].w);
                const float r = rsqrtf(wave_sum(s) * (1.f / D) + RMS_EPS);
                if (MODE == 0) { GAS unsigned long long* o8 = (GAS unsigned long long*)(hout + (size_t)row * D) + F.lane;
#pragma unroll
                    for (int j = 0; j < 4; ++j) { const f32x4 y = v[q][j] * r * ga[j] + sh[j]; o8[64 * j] = (unsigned long long)pk2(y.x, y.y) | ((unsigned long long)pk2(y.z, y.w) << 32); } }
                else { GAS f32x4* o = (GAS f32x4*)(fout + (size_t)row * D) + F.lane;
#pragma unroll
                    for (int j = 0; j < 4; ++j) o[64 * j] = v[q][j] * r * ga[j]; } }
        }
    }
}

__device__ __forceinline__ void p_prep(Frame& F, int l) {
    const int gw = F.vcu * NWAVES + F.wave, NGW = F.G * NWAVES;
    const bf16* Z = (const bf16*)(F.ws + WS_Z); bf16* KM = (bf16*)(F.ws + WS_KM);
    float* rsq = (float*)(F.ws + WS_RSQ); float* rskv = (float*)(F.ws + WS_RSKV); const float* rope = (const float*)(F.ws + WS_ROPE);
    for (int rb = gw; rb < M / 4; rb += NGW) {
        float a0[4], a1[4], a2[4], b0[4], b1[4]; unsigned pr[4] = {0u, 0u, 0u, 0u}; float cs[4] = {0.f, 0.f, 0.f, 0.f}, sn[4] = {0.f, 0.f, 0.f, 0.f};
#pragma unroll
        for (int q = 0; q < 4; ++q) { const int row = rb * 4 + q; const bf16* zr = Z + (size_t)row * ZLD;
            a0[q] = bf2f(zr[ZB_CQ + F.lane]); a1[q] = bf2f(zr[ZB_CQ + 64 + F.lane]); a2[q] = bf2f(zr[ZB_CQ + 128 + F.lane]);
            b0[q] = bf2f(zr[ZB_CKV + F.lane]); b1[q] = bf2f(zr[ZB_CKV + 64 + F.lane]);
            if (F.lane < 16) { pr[q] = *(const unsigned*)(zr + ZB_PE + 2 * F.lane); cs[q] = rope[((size_t)(row & 8191) * 16 + F.lane) * 2]; sn[q] = rope[((size_t)(row & 8191) * 16 + F.lane) * 2 + 1]; } }
#pragma unroll
        for (int q = 0; q < 4; ++q) { const int row = rb * 4 + q;
            const float sq = wave_sum(a0[q] * a0[q] + a1[q] * a1[q] + a2[q] * a2[q]), skv = wave_sum(b0[q] * b0[q] + b1[q] * b1[q]);
            if (F.lane == 0) { rsq[row] = rsqrtf(sq * (1.f / 192.f) + RMS_EPS); rskv[row] = rsqrtf(skv * (1.f / 128.f) + RMS_EPS); }
            if (F.lane < 16) { const float x1 = bf2f((unsigned short)(pr[q] & 0xffffu)), x2 = bf2f((unsigned short)(pr[q] >> 16));
                const unsigned o = pk2(x1 * cs[q] - x2 * sn[q], x1 * sn[q] + x2 * cs[q]);
#pragma unroll
                for (int hd = 0; hd < 4; ++hd) *(unsigned*)(KM + (size_t)row * 384 + hd * 96 + 64 + 2 * F.lane) = o; } }
    }
    { bf16* KMH = (bf16*)(F.ws + WS_KMH); bf16* KML = (bf16*)(F.ws + WS_KML);
      for (int it = gw; it < NB * 4 * 32; it += NGW) { const int j = it & 31, hd = (it >> 5) & 3, b = it >> 7; const int ts = F.lane >> 3, ch = F.lane & 7;
          float acc[8] = {0.f, 0.f, 0.f, 0.f, 0.f, 0.f, 0.f, 0.f};
#pragma unroll 8
          for (int i = 0; i < 32; ++i) { const v4u w = *(const v4u*)(Z + (size_t)(b * SEQ + j * 256 + 8 * i + ts) * ZLD + ZD_K + hd * 64 + ch * 8);
#pragma unroll
              for (int e = 0; e < 4; ++e) { acc[2 * e] += __uint_as_float(w[e] << 16); acc[2 * e + 1] += __uint_as_float(w[e] & 0xffff0000u); } }
#pragma unroll
          for (int e = 0; e < 8; ++e) { acc[e] += __shfl_xor(acc[e], 8); acc[e] += __shfl_xor(acc[e], 16); acc[e] += __shfl_xor(acc[e], 32); }
          if (F.lane < 8) { unsigned hi[4], lo[4];
#pragma unroll
              for (int e = 0; e < 4; ++e) { const float m0 = acc[2 * e] * (1.f / 256.f), m1 = acc[2 * e + 1] * (1.f / 256.f); const unsigned h0 = f2bf(m0), h1 = f2bf(m1);
                  hi[e] = h0 | (h1 << 16); lo[e] = pk2(m0 - __uint_as_float(h0 << 16), m1 - __uint_as_float(h1 << 16)); }
              *(v4u*)(KMH + (size_t)it * 64 + ch * 8) = (v4u){hi[0], hi[1], hi[2], hi[3]}; *(v4u*)(KML + (size_t)it * 64 + ch * 8) = (v4u){lo[0], lo[1], lo[2], lo[3]}; } } }
    if (gw == 0) { const float* pp = (const float*)(F.ws + WS_POSP) + (size_t)l * 2 * 32 * 128; float* pb = (float*)(F.ws + WS_POSB) + l * 256;
        for (int i = F.lane; i < 256; i += 64) { const int j = i & 127, wh = i >> 7; float s = 0.f; for (int kr = 0; kr < 32; ++kr) s += pp[(wh * 32 + kr) * 128 + j]; pb[i] = s; } }
}

__device__ __forceinline__ float gelu_tanh(float x) { const float u = 0.7978845608028654f * (x + 0.044715f * x * x * x); const float e = __expf(2.f * u); return x * (1.f - 1.f / (e + 1.f)); }
__device__ __forceinline__ void p_compress(Frame& F, int l) {
    const bf16* Z = (const bf16*)(F.ws + WS_Z);
    unsigned char* wb = F.ws + WS_W + (size_t)l * WS_WL;
    LAS float* red = (LAS float*)F.lds;
    const int r = F.lane & 31, h = F.lane >> 5;
    for (int it = F.vcu; it < NB * 16 * 2; it += F.G) {
        const int which = it & 1, itile = (it >> 1) & 15, b = it >> 5;
        const bf16* W1T = (const bf16*)(wb + (which ? W_1V : W_1K)); const bf16* W2T = (const bf16*)(wb + (which ? W_2V : W_2K));
        const int coff = which ? ZC_VC : ZC_KC;
        f32x16 acc[4] = {f32x16{}, f32x16{}, f32x16{}, f32x16{}};
        const bf16* brow = Z + (size_t)(b * SEQ + 16 * (32 * itile + r)) * ZLD + coff + 8 * h;
#pragma unroll 1
        for (int t4 = 0; t4 < 4; ++t4) { const int tt = 4 * F.wave + t4;
            bf16x8 bf[4], af[4][4];
#pragma unroll
            for (int d0 = 0; d0 < 4; ++d0) bf[d0] = *(const bf16x8*)(brow + (size_t)tt * ZLD + d0 * 16);
#pragma unroll
            for (int hb = 0; hb < 4; ++hb)
#pragma unroll
                for (int d0 = 0; d0 < 4; ++d0) af[hb][d0] = *(const bf16x8*)(W1T + (size_t)(hb * 32 + r) * 2048 + tt * 64 + d0 * 16 + 8 * h);
#pragma unroll
            for (int hb = 0; hb < 4; ++hb)
#pragma unroll
                for (int d0 = 0; d0 < 4; ++d0) acc[hb] = __builtin_amdgcn_mfma_f32_32x32x16_bf16(af[hb][d0], bf[d0], acc[hb], 0, 0, 0); }
#pragma unroll
        for (int hb = 0; hb < 4; ++hb)
#pragma unroll
            for (int v = 0; v < 16; ++v) red[((F.wave * 4 + hb) * 16 + v) * 64 + F.lane] = acc[hb][v];
        __syncthreads();
        if (F.wave < 2) {
            const float* pb = (const float*)(F.ws + WS_POSB) + l * 256 + which * 128;
            f32x16 o = f32x16{};
#pragma unroll
            for (int hb = 0; hb < 4; ++hb) { float x[16];
#pragma unroll
                for (int v = 0; v < 16; ++v) { float s = pb[hb * 32 + (v & 3) + 8 * (v >> 2) + 4 * h];
#pragma unroll
                    for (int w8 = 0; w8 < 8; ++w8) s += red[((w8 * 4 + hb) * 16 + v) * 64 + F.lane];
                    x[v] = gelu_tanh(s); }
#pragma unroll
                for (int s2 = 0; s2 < 2; ++s2) {
                    v4u pw; pw.x = fa::cvtpk(x[8 * s2], x[8 * s2 + 1]); pw.y = fa::cvtpk(x[8 * s2 + 2], x[8 * s2 + 3]); pw.z = fa::cvtpk(x[8 * s2 + 4], x[8 * s2 + 5]); pw.w = fa::cvtpk(x[8 * s2 + 6], x[8 * s2 + 7]);
                    const bf16* wr = W2T + (size_t)(F.wave * 32 + r) * 128 + hb * 32 + 16 * s2 + 4 * h;
                    const v2u a0 = *(const v2u*)wr, a1 = *(const v2u*)(wr + 8);
                    const v4u aw = (v4u){a0.x, a0.y, a1.x, a1.y};
                    o = __builtin_amdgcn_mfma_f32_32x32x16_bf16(__builtin_bit_cast(bf16x8, aw), __builtin_bit_cast(bf16x8, pw), o, 0, 0, 0); } }
            bf16* dst = (bf16*)(F.ws + (which ? WS_VCMP : WS_KCMP)) + (size_t)(b * 512 + 32 * itile + r) * 64 + F.wave * 32 + 4 * h;
#pragma unroll
            for (int g = 0; g < 4; ++g) { v2u w; w.x = fa::cvtpk(o[4 * g], o[4 * g + 1]); w.y = fa::cvtpk(o[4 * g + 2], o[4 * g + 3]); *(v2u*)(dst + 8 * g) = w; }
        }
        __syncthreads();
    }
}
using fa::bf16x8;
__device__ __forceinline__ unsigned char* launder_ptr(unsigned char* p) { const unsigned long long v = (unsigned long long)p; unsigned lo = __builtin_amdgcn_readfirstlane((unsigned)v), hi = __builtin_amdgcn_readfirstlane((unsigned)(v >> 32)); asm volatile("" : "+s"(lo), "+s"(hi)); return (unsigned char*)(((unsigned long long)hi << 32) | lo); }
#define UNIT_BEGIN() Frame F = F0; { int tid_ = F0.tid; asm volatile("" : "+v"(tid_)); int bx_ = __builtin_amdgcn_readfirstlane(F0.bx); asm volatile("" : "+s"(bx_)); \
    F.ws = launder_ptr(F0.ws); F.tid = tid_; F.lane = tid_ & 63; F.wave = __builtin_amdgcn_readfirstlane(tid_ >> 6); F.bx = bx_; }
__device__ __forceinline__ void u_mla(const Frame& F0, int b, int hd, int u) {
    UNIT_BEGIN();
    GAS char* ws = (GAS char*)F.ws;
    const int r = F.lane & 31, h = F.lane >> 5, q0 = 256 * u, wq0 = q0 + 32 * F.wave, tq = wq0 + r;
    bf16x8 qf[6]; { const unsigned qrow = (unsigned)WS_QM + (unsigned)(b * SEQ + tq) * 1024u;
      const float rs = *(const GAS float*)(ws + ((unsigned)WS_RSQ + (unsigned)(b * SEQ + tq) * 4u));
#pragma unroll
      for (int d0 = 0; d0 < 4; ++d0) { const fa::u32x4 raw = *(const GAS fa::u32x4*)(ws + (qrow + (unsigned)(hd * 128 + d0 * 32 + 16 * h))); fa::u32x4 o;
          o.x = fa::cvtpk(__uint_as_float(raw.x << 16) * rs, __uint_as_float(raw.x & 0xffff0000u) * rs); o.y = fa::cvtpk(__uint_as_float(raw.y << 16) * rs, __uint_as_float(raw.y & 0xffff0000u) * rs);
          o.z = fa::cvtpk(__uint_as_float(raw.z << 16) * rs, __uint_as_float(raw.z & 0xffff0000u) * rs); o.w = fa::cvtpk(__uint_as_float(raw.w << 16) * rs, __uint_as_float(raw.w & 0xffff0000u) * rs);
          qf[d0] = __builtin_bit_cast(bf16x8, o); }
#pragma unroll
      for (int d0 = 0; d0 < 2; ++d0) {
          const fa::u32x4 raw = *(const GAS fa::u32x4*)(ws + (qrow + (unsigned)(512 + hd * 64 + d0 * 32 + 16 * h)));
          const GAS float* rp = (const GAS float*)(ws + ((unsigned)WS_ROPE + (unsigned)((tq * 16 + d0 * 8 + 4 * h) * 8)));
          const fa::f32x4v r0 = *(const GAS fa::f32x4v*)rp * rs, r1 = *(const GAS fa::f32x4v*)(rp + 4) * rs;
          fa::u32x4 o;
          { const float x1 = __uint_as_float(raw.x << 16), x2 = __uint_as_float(raw.x & 0xffff0000u); o.x = fa::cvtpk(x1 * r0[0] - x2 * r0[1], x1 * r0[1] + x2 * r0[0]); }
          { const float x1 = __uint_as_float(raw.y << 16), x2 = __uint_as_float(raw.y & 0xffff0000u); o.y = fa::cvtpk(x1 * r0[2] - x2 * r0[3], x1 * r0[3] + x2 * r0[2]); }
          { const float x1 = __uint_as_float(raw.z << 16), x2 = __uint_as_float(raw.z & 0xffff0000u); o.z = fa::cvtpk(x1 * r1[0] - x2 * r1[1], x1 * r1[1] + x2 * r1[0]); }
          { const float x1 = __uint_as_float(raw.w << 16), x2 = __uint_as_float(raw.w & 0xffff0000u); o.w = fa::cvtpk(x1 * r1[2] - x2 * r1[3], x1 * r1[3] + x2 * r1[2]); }
          qf[4 + d0] = __builtin_bit_cast(bf16x8, o); } }
    SM st; fa::sm_init(st);
    LAS char* lds = (LAS char*)F.lds;
    fa::fa_loop<96, false>(st, qf, ws, (unsigned)WS_KM + (unsigned)b * (SEQ * 768u) + (unsigned)hd * 192u, 768u, (unsigned)WS_VM + (unsigned)b * (SEQ * 512u) + (unsigned)hd * 128u, 512u, SEQ - 1, 4 * u + 4,
        [](int t) { return 64 * t; },
        [=](int t, bool& act, bool& ew, float& cb, int& lo, int& hi) { const int key0 = 64 * t; act = key0 <= wq0 + 31; ew = key0 + 63 > wq0; cb = 0.f; lo = -100000; hi = tq - key0; },
        0.f, lds + FA_STAGES, F.tid, F.lane);
    f32x16 acc[2] = {f32x16{}, f32x16{}}; fa::sm_finish(st, 1.f, acc);
    fa::store_out(acc, lds + FA_OST + F.wave * 32 * fa::OSTR, ws, [=](int col) { return (unsigned)WS_O + (unsigned)(b * SEQ + wq0 + col) * 2048u + (unsigned)(256 + hd * 64) * 2u; }, F.lane);
}
__device__ __forceinline__ void u_moba(const Frame& F0, int b, int hd, int i) {
    UNIT_BEGIN();
    GAS char* ws = (GAS char*)F.ws;
    const int r = F.lane & 31, h = F.lane >> 5, q0 = 256 * i, wq0 = q0 + 32 * F.wave, tq = wq0 + r;
    bf16x8 qf[4]; fa::load_q<64>(qf, ws, (unsigned)WS_Z + (unsigned)(b * SEQ + tq) * (ZLD * 2u) + (unsigned)(ZD_Q + hd * 64) * 2u, h);
    unsigned bits = 0u;
    if (i > 0) {
        const GAS bf16* KMH = (const GAS bf16*)(ws + ((unsigned)WS_KMH + (unsigned)(((b * 4 + hd) * 32 + r) * 64 + 8 * h) * 2u)); const GAS bf16* KML = (const GAS bf16*)(ws + ((unsigned)WS_KML + (unsigned)(((b * 4 + hd) * 32 + r) * 64 + 8 * h) * 2u));
        f32x16 g = f32x16{};
#pragma unroll
        for (int d0 = 0; d0 < 4; ++d0) { const bf16x8 ah = *(const GAS bf16x8*)(KMH + d0 * 16), al = *(const GAS bf16x8*)(KML + d0 * 16);
            g = __builtin_amdgcn_mfma_f32_32x32x16_bf16(ah, qf[d0], g, 0, 0, 0); g = __builtin_amdgcn_mfma_f32_32x32x16_bf16(al, qf[d0], g, 0, 0, 0); }
        float og[16];
#pragma unroll
        for (int v = 0; v < 16; ++v) { const int j = (v & 3) + 8 * (v >> 2) + 4 * h; if (j >= i) g[v] = -INFINITY; og[v] = __shfl_xor(g[v], 32); }
#pragma unroll
        for (int v = 0; v < 16; ++v) { const int j = (v & 3) + 8 * (v >> 2) + 4 * h; int rank = 0;
#pragma unroll
            for (int w = 0; w < 16; ++w) { const int jm = (w & 3) + 8 * (w >> 2) + 4 * h, jo = (w & 3) + 8 * (w >> 2) + 4 * (1 - h);
                rank += (g[w] > g[v] || (g[w] == g[v] && jm < j)) ? 1 : 0; rank += (og[w] > g[v] || (og[w] == g[v] && jo < j)) ? 1 : 0; }
            if (rank < 3 && j < i) bits |= 1u << j; }
        bits |= __shfl_xor(bits, 32);
    }
    const float sl = slope2_of(2 + 3 * hd);
    LAS char* lds = (LAS char*)F.lds;
    LAS float* Ost = (LAS float*)(lds + MB_O);
    LAS float* MLst = (LAS float*)(lds + MB_ML);
    LAS unsigned* cnt = (LAS unsigned*)(lds + MB_CNT);
    LAS unsigned char* lst = (LAS unsigned char*)(lds + MB_LST);
    const unsigned koff = (unsigned)WS_Z + (unsigned)b * (SEQ * ZLD * 2u) + (unsigned)(ZD_K + hd * 64) * 2u, voff = (unsigned)WS_Z + (unsigned)b * (SEQ * ZLD * 2u) + (unsigned)(ZD_V + hd * 64) * 2u;
    if (F.tid < 32) cnt[F.tid] = 0u;
    {
        SM st; fa::sm_init(st);
        fa::fa_loop<64, true>(st, qf, ws, koff, ZLD * 2u, voff, ZLD * 2u, SEQ - 1, 4,
            [=](int t) { return q0 + 64 * t; },
            [=](int t, bool& act, bool& ew, float& cb, int& lo, int& hi) { const int key0 = q0 + 64 * t; act = key0 <= wq0 + 31; ew = key0 + 63 > wq0; cb = sl * (float)(64 * t + 4 * h); lo = -100000; hi = tq - key0; },
            sl, lds + FA_STAGES, F.tid, F.lane);
        const float lt = fa::xhalf_sum(st.l);
        LAS float* orow = Ost + (32 * F.wave + r) * MB_OS;
#pragma unroll
        for (int db = 0; db < 2; ++db)
#pragma unroll
            for (int g = 0; g < 4; ++g)
#pragma unroll
                for (int e = 0; e < 4; ++e) orow[32 * db + 8 * g + 4 * h + e] = st.o[db][4 * g + e];
        if (h == 0) { MLst[(32 * F.wave + r) * 2] = st.m; MLst[(32 * F.wave + r) * 2 + 1] = lt; }
    }
    if (h == 0) { unsigned bb = bits;
        while (bb) { const int j = __ffs(bb) - 1; bb &= bb - 1u; const unsigned slot = __hip_atomic_fetch_add(&cnt[j], 1u, __ATOMIC_RELAXED, __HIP_MEMORY_SCOPE_WORKGROUP); lst[j * 256 + slot] = (unsigned char)(32 * F.wave + r); } }
    LDS_WAIT(); __syncthreads();
    if (i > 0) {
        LAS unsigned* PS = (LAS unsigned*)(lds + MB_PS);
        LAS float* PM = (LAS float*)(lds + MB_PM);
        const unsigned qbase = (unsigned)WS_Z + (unsigned)(b * SEQ + q0) * (ZLD * 2u) + (unsigned)(ZD_Q + hd * 64) * 2u;
        const int tt = F.wave & 3, g4 = F.wave >> 2;
        fa::Stg<64> s0, s1, s2, s3;
#define MB_LOADBLK(J) { fa::stg_load<64>(s0, ws, koff, ZLD * 2u, voff, ZLD * 2u, 256 * (J), SEQ - 1, F.tid); fa::stg_load<64>(s1, ws, koff, ZLD * 2u, voff, ZLD * 2u, 256 * (J) + 64, SEQ - 1, F.tid); \
                        fa::stg_load<64>(s2, ws, koff, ZLD * 2u, voff, ZLD * 2u, 256 * (J) + 128, SEQ - 1, F.tid); fa::stg_load<64>(s3, ws, koff, ZLD * 2u, voff, ZLD * 2u, 256 * (J) + 192, SEQ - 1, F.tid); }
        MB_LOADBLK(0)
        const int ql = 8 * tt + (F.lane >> 3), l7 = F.lane & 7;
        for (int j = 0; j < i; ++j) {
            const int n = (int)cnt[j];
            bool myact = 32 * g4 < n, colv = (32 * g4 + r) < n; int qsel = colv ? (int)lst[j * 256 + 32 * g4 + r] : 0;
            bf16x8 qfb[4] = {qf[0], qf[1], qf[2], qf[3]};
            if (myact) fa::load_q<64>(qfb, ws, qbase + (unsigned)qsel * (ZLD * 2u), h);
            fa::stg_store<64>(s0, lds + MB_T, F.tid); fa::stg_store<64>(s1, lds + MB_T + 16384, F.tid); fa::stg_store<64>(s2, lds + MB_T + 32768, F.tid); fa::stg_store<64>(s3, lds + MB_T + 49152, F.tid);
            if (j + 1 < i) MB_LOADBLK(j + 1)
            LDS_WAIT(); __syncthreads();
            for (int rd = 0; 64 * rd < n; ++rd) {
                const int grp = 2 * rd + g4;
                if (rd > 0) { LDS_WAIT(); __syncthreads();
                    myact = 32 * grp < n; colv = (32 * grp + r) < n; qsel = colv ? (int)lst[j * 256 + 32 * grp + r] : 0;
                    if (myact) fa::load_q<64>(qfb, ws, qbase + (unsigned)qsel * (ZLD * 2u), h); }
                const bool two = 32 * (2 * rd + 1) < n;
                const bool fv = (32 * grp + ql) < n; const int qs = fv ? (int)lst[j * 256 + 32 * grp + ql] : 0;
                const float ms = MLst[qs * 2], ls = MLst[qs * 2 + 1];
                LAS float* orow = Ost + qs * MB_OS + 8 * l7;
                float acc8[8];
#pragma unroll
                for (int x = 0; x < 8; ++x) acc8[x] = orow[x];
                SM st; fa::sm_init(st); float lp = 0.f;
                if (myact) {
                    const LAS char* buf = lds + MB_T + tt * 16384;
                    fa::f32x16 p0, p1; bf16x8 pf[4];
                    fa::score_tile<64, true>(p0, p1, buf, qfb, colv ? sl * (float)(256 * j + 64 * tt - q0 + 4 * h) : fa::MASKV, sl, F.lane);
                    fa::sm_step(st, p0, p1, pf);
                    fa::pv(st.o, buf + 8192, pf, F.lane);
                    lp = fa::xhalf_sum(st.l);
                }
#pragma unroll 1
                for (int ph = 0; ph < 2; ++ph) {
                    if (ph == 1 && !two) break;
                    if (ph == 1) { LDS_WAIT(); __syncthreads(); }
                    if (g4 == ph && myact) {
                        LAS unsigned* ps = PS + (tt * 32 + r) * 33 + 2 * h;
#pragma unroll
                        for (int db = 0; db < 2; ++db)
#pragma unroll
                            for (int g = 0; g < 4; ++g) { ps[16 * db + 4 * g] = fa::cvtpk(st.o[db][4 * g], st.o[db][4 * g + 1]); ps[16 * db + 4 * g + 1] = fa::cvtpk(st.o[db][4 * g + 2], st.o[db][4 * g + 3]); }
                        if (h == 0) { PM[(tt * 32 + r) * 2] = st.m; PM[(tt * 32 + r) * 2 + 1] = lp; }
                    }
                    LDS_WAIT(); __syncthreads();
                    if (g4 == ph && fv) {
                        const float m0 = PM[ql * 2], l0 = PM[ql * 2 + 1], m1 = PM[(32 + ql) * 2], l1 = PM[(32 + ql) * 2 + 1], m2 = PM[(64 + ql) * 2], l2 = PM[(64 + ql) * 2 + 1], m3 = PM[(96 + ql) * 2], l3 = PM[(96 + ql) * 2 + 1];
                        const float mn = fmaxf(fmaxf(fmaxf(m0, m1), fmaxf(m2, m3)), ms);
                        const float ea = fa::ex2(ms - mn), e0 = fa::ex2(m0 - mn), e1 = fa::ex2(m1 - mn), e2 = fa::ex2(m2 - mn), e3 = fa::ex2(m3 - mn);
                        const LAS unsigned* pr = PS + ql * 33 + 4 * l7;
#pragma unroll
                        for (int x = 0; x < 4; ++x) { const unsigned w0 = pr[x], w1 = pr[32 * 33 + x], w2 = pr[64 * 33 + x], w3 = pr[96 * 33 + x];
                            orow[2 * x] = acc8[2 * x] * ea + ((__uint_as_float(w0 << 16) * e0 + __uint_as_float(w1 << 16) * e1) + (__uint_as_float(w2 << 16) * e2 + __uint_as_float(w3 << 16) * e3));
                            orow[2 * x + 1] = acc8[2 * x + 1] * ea + ((__uint_as_float(w0 & 0xffff0000u) * e0 + __uint_as_float(w1 & 0xffff0000u) * e1) + (__uint_as_float(w2 & 0xffff0000u) * e2 + __uint_as_float(w3 & 0xffff0000u) * e3)); }
                        if (l7 == 0) { MLst[qs * 2] = mn; MLst[qs * 2 + 1] = ls * ea + ((l0 * e0 + l1 * e1) + (l2 * e2 + l3 * e3)); }
                    }
                }
            }
        }
#undef MB_LOADBLK
        LDS_WAIT(); __syncthreads();
#if FA_PROBE == 9
        if (F.lane == 0 && F.wave == FA_KO) { unsigned long long* pp = (unsigned long long*)((GAS char*)ws + 32768);
            atomicAdd(pp + 0, pq0); atomicAdd(pp + 1, pq1); atomicAdd(pp + 2, pq2); atomicAdd(pp + 3, pqn); atomicAdd(pp + 4, pq3); }
#endif
    }
    { const int q = 32 * F.wave + (F.lane >> 1), hf = F.lane & 1; const float inv = 1.f / fmaxf(MLst[q * 2 + 1], fa::TINYF);
      const LAS float* orow = Ost + q * MB_OS + 32 * hf;
      GAS char* dst = ws + ((unsigned)WS_O + (unsigned)(b * SEQ + q0 + q) * 2048u + (unsigned)(768 + hd * 64 + 32 * hf) * 2u);
#pragma unroll
      for (int c = 0; c < 4; ++c) { float x[8];
#pragma unroll
          for (int e = 0; e < 8; ++e) x[e] = orow[8 * c + e] * inv;
          fa::u32x4 w; w.x = fa::cvtpk(x[0], x[1]); w.y = fa::cvtpk(x[2], x[3]); w.z = fa::cvtpk(x[4], x[5]); w.w = fa::cvtpk(x[6], x[7]);
          *(GAS fa::u32x4*)(dst + 16 * c) = w; } }
    LDS_WAIT(); __syncthreads();
}
__device__ __forceinline__ void u_swa(const Frame& F0, int b, int kvh, int u, const float* sinks) {
    UNIT_BEGIN();
    GAS char* ws = (GAS char*)F.ws;
    const int r = F.lane & 31, h = F.lane >> 5, q0 = 128 * u, wq0 = q0 + 16 * F.wave, tq = wq0 + (r >> 1), hd = kvh * 2 + (r & 1);
    bf16x8 qf[4]; fa::load_q<64>(qf, ws, (unsigned)WS_Z + (unsigned)(b * SEQ + tq) * (ZLD * 2u) + (unsigned)(ZA_Q + hd * 64) * 2u, h);
    const float sl = slope2_of(3 * hd);
    const int t0 = (2 * u - 2) > 0 ? (2 * u - 2) : 0, nt = 2 * u + 2 - t0;
    SM st; fa::sm_init(st);
    LAS char* lds = (LAS char*)F.lds;
    fa::fa_loop<64, true>(st, qf, ws, (unsigned)WS_Z + (unsigned)b * (SEQ * ZLD * 2u) + (unsigned)(ZA_K + kvh * 64) * 2u, ZLD * 2u, (unsigned)WS_Z + (unsigned)b * (SEQ * ZLD * 2u) + (unsigned)(ZA_V + kvh * 64) * 2u, ZLD * 2u, SEQ - 1, nt,
        [=](int t) { return 64 * (t0 + t); },
        [=](int t, bool& act, bool& ew, float& cb, int& lo, int& hi) { const int key0 = 64 * (t0 + t); act = (key0 <= wq0 + 15) && (key0 + 63 >= wq0 - 127); ew = true;
            cb = sl * (float)(key0 - q0 + 4 * h); lo = tq - 127 - key0; hi = tq - key0; },
        sl, lds + FA_STAGES, F.tid, F.lane);
    const float sk = sinks[hd] * LOG2E + sl * (float)(tq - q0), mf = fmaxf(st.m, sk), a = fa::ex2(st.m - mf);
    const float ltot = fa::xhalf_sum(st.l) * a + fa::ex2(sk - mf), inv = a / fmaxf(ltot, fa::TINYF);
    f32x16 acc[2]; acc[0] = st.o[0] * inv; acc[1] = st.o[1] * inv;
    fa::store_out(acc, lds + FA_OST + F.wave * 32 * fa::OSTR, ws, [=](int col) { return (unsigned)WS_O + (unsigned)(b * SEQ + wq0 + (col >> 1)) * 2048u + (unsigned)((kvh * 2 + (col & 1)) * 64) * 2u; }, F.lane);
}
__device__ __forceinline__ void u_nsa(const Frame& F0, int b, int qi) {
    UNIT_BEGIN();
    GAS char* ws = (GAS char*)F.ws;
    const unsigned KC = (unsigned)WS_KCMP + (unsigned)b * (512u * 128u), VC = (unsigned)WS_VCMP + (unsigned)b * (512u * 128u), ZB = (unsigned)WS_Z + (unsigned)b * (SEQ * ZLD * 2u);
    const int r = F.lane & 31, h = F.lane >> 5, q0 = 64 * qi, wq0 = q0 + 8 * F.wave, qloc = 8 * F.wave + (r >> 2), tq = q0 + qloc, hd = r & 3;
    const unsigned zrow_off = ZB + (unsigned)tq * (ZLD * 2u); const GAS bf16* zrow = (const GAS bf16*)(ws + zrow_off);
    bf16x8 qf[4]; fa::load_q<64>(qf, ws, zrow_off + (unsigned)(ZC_Q + hd * 64) * 2u, h);
    const float sl = slope2_of(1 + 3 * hd);
    const float g0 = 1.f / (1.f + __expf(-bf2f(zrow[ZC_GL + hd]))), g1 = 1.f / (1.f + __expf(-bf2f(zrow[ZC_GL + 4 + hd]))), g2 = 1.f / (1.f + __expf(-bf2f(zrow[ZC_GL + 8 + hd])));
    LAS char* lds = (LAS char*)F.lds;
    LAS float* impA = (LAS float*)(lds + FA_IMP) + F.wave * 1024;
    LAS float* impB = (LAS float*)(lds + FA_OST) + F.wave * 1024;
    LAS unsigned* selm = (LAS unsigned*)(lds + FA_SELM);
    LAS unsigned* um = (LAS unsigned*)(lds + FA_UM);
    LAS float* vals = (LAS float*)(lds + FA_VALS) + F.wave * 128;
    if (F.tid < 4) um[F.tid] = 0u;
    const unsigned parko = (unsigned)WS_PARK + (unsigned)((F.bx * NWAVES + F.wave) * 2 * 32 * 64 + F.lane) * 4u;
#define PARK(i) (*(GAS float*)(ws + (parkl + (unsigned)((i) * 256))))
    const int ntc = ((4 * qi + 3) >> 6) + 1;
    const int cvis = (tq - 31) >> 4;
    const int cvis_min = (q0 - 31) >> 4;
    const float slc = 16.f * sl;
    SM st; fa::sm_init(st);
    fa::fa_loop<64, true>(st, qf, ws, KC, 128u, VC, 128u, 510, ntc,
        [](int t) { return 64 * t; },
        [=](int t, bool& act, bool& ew, float& cb, int& lo, int& hi) { const int c0 = 64 * t; act = true; ew = c0 + 63 > cvis_min; cb = slc * (float)(c0 - 4 * qi + 4 * h); lo = -100000; hi = cvis - c0; },
        slc, lds + FA_STAGES, F.tid, F.lane);
    { f32x16 t2[2] = {f32x16{}, f32x16{}}; fa::sm_finish(st, g0, t2); unsigned parkl = parko; asm volatile("" : "+v"(parkl));
#pragma unroll
      for (int v = 0; v < 16; ++v) { PARK(v) = t2[0][v]; PARK(16 + v) = t2[1][v]; } }
    {
        const float mfin = st.m, invl = 1.f / fmaxf(fa::xhalf_sum(st.l), fa::TINYF);
        constexpr int STG = fa::stage_bytes<64>();
        fa::Stg<64> sg;
        fa::stg_load<64>(sg, ws, KC, 128u, VC, 128u, 0, 510, F.tid); fa::stg_store<64>(sg, lds + FA_STAGES, F.tid); __syncthreads();
        for (int t = 0; t < ntc; ++t) {
            const LAS char* buf = lds + FA_STAGES + (t & 1) * STG;
            if (t + 1 < ntc) fa::stg_load<64>(sg, ws, KC, 128u, VC, 128u, 64 * (t + 1), 510, F.tid);
            const int c0 = 64 * t;
            f32x16 p0, p1; fa::score_tile<64, true>(p0, p1, buf, qf, slc * (float)(c0 - 4 * qi + 4 * h), slc, F.lane);
            if (c0 + 63 > cvis_min) fa::mask_ew(p0, p1, -100000, cvis - c0, h);
#pragma unroll
            for (int kh = 0; kh < 2; ++kh)
#pragma unroll
                for (int g = 0; g < 4; ++g) {
                    float e0, e1, e2, e3;
                    if (kh == 0) { e0 = fa::ex2(p0[4 * g] - mfin); e1 = fa::ex2(p0[4 * g + 1] - mfin); e2 = fa::ex2(p0[4 * g + 2] - mfin); e3 = fa::ex2(p0[4 * g + 3] - mfin); }
                    else { e0 = fa::ex2(p1[4 * g] - mfin); e1 = fa::ex2(p1[4 * g + 1] - mfin); e2 = fa::ex2(p1[4 * g + 2] - mfin); e3 = fa::ex2(p1[4 * g + 3] - mfin); }
                    e0 *= invl; e1 *= invl; e2 *= invl; e3 *= invl;
                    float s4 = ((e0 + e1) + e2) + e3;
                    s4 += __shfl_xor(s4, 1); s4 += __shfl_xor(s4, 2); e3 += __shfl_xor(e3, 1); e3 += __shfl_xor(e3, 2);
                    const int j = 16 * t + 8 * kh + 2 * g + h;
                    if (hd == 0) { impA[(r >> 2) * 128 + j] = s4; impB[(r >> 2) * 128 + j] = e3; }
                }
            if (t + 1 < ntc) fa::stg_store<64>(sg, lds + FA_STAGES + ((t + 1) & 1) * STG, F.tid);
            __syncthreads();
        }
    }
    {
        const int cur = qi;
        for (int qq = 0; qq < 8; ++qq) {
            unsigned long long m0, m1;
            if (cur < 16) { m0 = (cur >= 63) ? ~0ull : ((1ull << (cur + 1)) - 1ull); m1 = 0ull; }
            else {
                const int ja = F.lane, jb2 = F.lane + 64;
                const bool fca = (ja == 0 || ja == cur || ja == cur - 1), fcb = (jb2 == cur || jb2 == cur - 1);
                const float va = impA[qq * 128 + ja] + (ja > 0 ? impB[qq * 128 + ja - 1] : 0.f), vb = impA[qq * 128 + jb2] + impB[qq * 128 + jb2 - 1];
                const unsigned ka = (ja <= cur && !fca) ? (__float_as_uint(va) + 1u) : 0u, kb = (jb2 <= cur && !fcb) ? (__float_as_uint(vb) + 1u) : 0u;
                unsigned T = 0u;
                for (int bit = 31; bit >= 0; --bit) { const unsigned cand = T | (1u << bit); const int c = __popcll(__ballot(ka >= cand)) + __popcll(__ballot(kb >= cand)); if (c >= 13) T = cand; }
                if (T == 0u) T = 1u;
                const unsigned long long ga = __ballot(ka > T), gb = __ballot(kb > T), ea = __ballot(ka == T), eb = __ballot(kb == T);
                const int R = 13 - (__popcll(ga) + __popcll(gb)), na = __popcll(ea);
                const int pa = (int)__builtin_amdgcn_mbcnt_hi((unsigned)(ea >> 32), __builtin_amdgcn_mbcnt_lo((unsigned)ea, 0u)), pb = (int)__builtin_amdgcn_mbcnt_hi((unsigned)(eb >> 32), __builtin_amdgcn_mbcnt_lo((unsigned)eb, 0u));
                m0 = ga | __ballot(ka == T && pa < R) | 1ull; m1 = gb | __ballot(kb == T && (na + pb) < R);
                if (cur < 64) m0 |= 1ull << cur; else m1 |= 1ull << (cur - 64);
                if (cur - 1 < 64) m0 |= 1ull << (cur - 1); else m1 |= 1ull << (cur - 65);
            }
            if (F.lane == 0) { LAS unsigned* sp = selm + (8 * F.wave + qq) * 4; sp[0] = (unsigned)m0; sp[1] = (unsigned)(m0 >> 32); sp[2] = (unsigned)m1; sp[3] = (unsigned)(m1 >> 32);
                __hip_atomic_fetch_or(&um[0], (unsigned)m0, __ATOMIC_RELAXED, __HIP_MEMORY_SCOPE_WORKGROUP); __hip_atomic_fetch_or(&um[1], (unsigned)(m0 >> 32), __ATOMIC_RELAXED, __HIP_MEMORY_SCOPE_WORKGROUP); __hip_atomic_fetch_or(&um[2], (unsigned)m1, __ATOMIC_RELAXED, __HIP_MEMORY_SCOPE_WORKGROUP); __hip_atomic_fetch_or(&um[3], (unsigned)(m1 >> 32), __ATOMIC_RELAXED, __HIP_MEMORY_SCOPE_WORKGROUP); }
        }
        LDS_WAIT(); __syncthreads();
    }
    {
        const unsigned uw0 = um[0], uw1 = um[1], uw2 = um[2], uw3 = um[3];
        const LAS unsigned* selq = selm + qloc * 4;
        const int nsel = __builtin_amdgcn_readfirstlane(__popc(uw0) + __popc(uw1) + __popc(uw2) + __popc(uw3));
        LAS unsigned char* slist = (LAS unsigned char*)(lds + FA_VALS);
        if (F.tid < 128) { const int j = F.tid; const unsigned w = (j < 32) ? uw0 : (j < 64) ? uw1 : (j < 96) ? uw2 : uw3;
            if ((w >> (j & 31)) & 1u) { int pos = __popc(w & ((1u << (j & 31)) - 1u)); if (j >= 32) pos += __popc(uw0); if (j >= 64) pos += __popc(uw1); if (j >= 96) pos += __popc(uw2); slist[pos] = (unsigned char)j; } }
        LDS_WAIT(); __syncthreads();
        fa::sm_init(st);
        fa::fa_loop<64, true>(st, qf, ws, ZB + ZC_KS * 2u, ZLD * 2u, ZB + ZC_VS * 2u, ZLD * 2u, SEQ - 1, nsel,
            [=](int t) { return 64 * (int)slist[t]; },
            [=](int t, bool& act, bool& ew, float& cb, int& lo, int& hi) { const int j = (int)slist[t], key0 = 64 * j; const unsigned mw = selq[j >> 5];
                const bool on = (mw >> (j & 31)) & 1u; act = __any(on) != 0; ew = (j == qi); cb = on ? sl * (float)(key0 - q0 + 4 * h) : fa::MASKV; lo = -100000; hi = tq - key0; },
            sl, lds + FA_STAGES, F.tid, F.lane);
        { f32x16 t2[2] = {f32x16{}, f32x16{}}; fa::sm_finish(st, g1, t2); unsigned parkl = parko; asm volatile("" : "+v"(parkl));
#pragma unroll
          for (int v = 0; v < 16; ++v) { PARK(32 + v) = t2[0][v]; PARK(48 + v) = t2[1][v]; } }
    }
    {
        const int t0 = (qi - 8) > 0 ? (qi - 8) : 0, nt = qi + 1 - t0;
        fa::sm_init(st);
        fa::fa_loop<64, true>(st, qf, ws, ZB + ZC_KW * 2u, ZLD * 2u, ZB + ZC_VW * 2u, ZLD * 2u, SEQ - 1, nt,
            [=](int t) { return 64 * (t0 + t); },
            [=](int t, bool& act, bool& ew, float& cb, int& lo, int& hi) { const int j = t0 + t, key0 = 64 * j; act = true; ew = (j == qi) || (j == qi - 8);
                cb = sl * (float)(key0 - q0 + 4 * h); lo = tq - 511 - key0; hi = tq - key0; },
            sl, lds + FA_STAGES, F.tid, F.lane);
    }
    f32x16 acc[2] = {f32x16{}, f32x16{}}; fa::sm_finish(st, g2, acc); unsigned parkl = parko; asm volatile("" : "+v"(parkl));
#pragma unroll
    for (int v = 0; v < 16; ++v) { acc[0][v] += PARK(v) + PARK(32 + v); acc[1][v] += PARK(16 + v) + PARK(48 + v); }
#undef PARK
    fa::store_out(acc, lds + FA_OST + F.wave * 32 * fa::OSTR, ws, [=](int col) { return (unsigned)WS_O + (unsigned)(b * SEQ + wq0 + (col >> 2)) * 2048u + (unsigned)(512 + (col & 3) * 64) * 2u; }, F.lane);
}

__device__ __forceinline__ void p_attn(Frame& F, const float* sinks, int mskip) {
    const int id = F.vcu;
    if (F.G != 256) return;
    { const int bh = id >> 4, s = id & 15;
#pragma unroll 1
      for (int k = 0; k < (((mskip >> 9) & 1) ? 4 : 2); ++k) u_mla(F, bh >> 2, bh & 3, (k & 1) ? s : 31 - s); }
    { const int bh = id >> 4, s = id & 15;
#pragma unroll 1
      for (int k = 0; k < (((mskip >> 11) & 1) ? 4 : 2); ++k) u_moba(F, bh >> 2, bh & 3, (k & 1) ? s : 31 - s); }
    if (!(mskip & 4)) { const int b = id >> 6, s = id & 63;
#pragma unroll 1
      for (int k = 0; k < (((mskip >> 10) & 1) ? 4 : 2); ++k) u_nsa(F, b, (k & 1) ? s : 127 - s); }
    {
#pragma unroll 1
      for (int k = 0; k < (((mskip >> 8) & 1) ? 4 : 2); ++k) { const int u0 = 2 * id + (k & 1); u_swa(F, u0 >> 7, (u0 >> 6) & 1, u0 & 63, sinks); } }
}
constexpr int PH_PRO = 0, PH_L0 = 1, PH_PER_L = 9, PH_FIN = 19, PH_END = 20;
constexpr int PO_NORM1 = 0, PO_ZG = 1, PO_PREP = 2, PO_UP = 3, PO_ATTN = 4, PO_OG = 5, PO_NORM2 = 6, PO_UPG = 7, PO_DNG = 8;
#ifndef MK_PHASE_MASK
#define MK_PHASE_MASK 0xFFFFFu
#endif

__global__ void __launch_bounds__(NTHR, 2) mega(Args args) {
    extern __shared__ __attribute__((aligned(16))) unsigned char lds_raw[];
    Frame F;
    F.lds = (LAS unsigned char*)lds_raw;
    int wave_s = __builtin_amdgcn_readfirstlane((int)threadIdx.x >> 6); asm volatile("" : "+s"(wave_s));
    F.tid = threadIdx.x; F.lane = F.tid & 63; F.wave = wave_s;
    F.G = gridDim.x; { const int bx = blockIdx.x; F.vcu = (F.G % 8 == 0) ? (bx % 8) * (F.G / 8) + bx / 8 : bx; }
    volatile LAS unsigned* misc = (volatile LAS unsigned*)(F.lds + LDS_MISC);
    if (F.tid < 64) misc[F.tid] = 0u;
    __syncthreads();
    (void)xcd_barrier_post((unsigned*)(args.ws + WS_CTL), misc + 8);
    float* fo; KArgsP ap;
#define KARGS() ({ KArgsP q_ = (KArgsP)__builtin_amdgcn_kernarg_segment_ptr(); asm volatile("" : "+s"(q_)); q_; })
#define IN(k) ({ KArgsP q2_ = KARGS(); q2_->ph_lo <= (k) && (k) < q2_->ph_hi; })
#define PHASE_BEGIN() do { asm volatile("; PHASE_MARK %0" :: "i"(__LINE__)); ap = KARGS(); F.G = gridDim.x; \
        { int w_ = wave_s; asm volatile("" : "+s"(w_)); int t_ = (w_ << 6) | (int)__builtin_amdgcn_mbcnt_hi(~0u, __builtin_amdgcn_mbcnt_lo(~0u, 0u)); asm volatile("" : "+v"(t_)); F.tid = t_; F.lane = t_ & 63; F.wave = w_; } F.ws = ap->ws; int bx_ = (int)blockIdx.x; asm volatile("" : "+s"(bx_)); F.bx = bx_; F.vcu = (F.G % 8 == 0) ? (bx_ % 8) * (F.G / 8) + bx_ / 8 : bx_; fo = ap->out; } while (0)
#define INP(i) (ap->in[i])
#define SEAM(k) do { if (IN(k) && IN((k) + 1)) { XcdBarrier b_; b_.bar = (unsigned*)(KARGS()->ws + WS_CTL); b_.x = xb_xcc_id(); b_.st = (volatile LAS unsigned*)(F.lds + LDS_MISC) + 8; xcd_barrier(b_); } } while (0)

    if (IN(PH_PRO)) { PHASE_BEGIN(); p_prologue(F, ap); }
#ifdef MK_PRO_TWICE
    if (IN(PH_PRO)) { PHASE_BEGIN(); p_prologue(F, ap); }
#endif
    SEAM(PH_PRO);

    { constexpr int l = 0;
        const int pb = PH_L0 + PH_PER_L * l;
#define WB (F.ws + WS_W + (size_t)l * WS_WL)
#define MOD ((const float*)(F.ws + WS_MOD) + (size_t)l * NB * 6 * D)
#define XB ((bf16*)(F.ws + WS_XB))
#define XIN ((l == 0) ? (const void*)INP(0) : (const void*)XB)
#define H ((bf16*)(F.ws + WS_H))
#define Z ((bf16*)(F.ws + WS_Z))
#define OB ((bf16*)(F.ws + WS_O))
#define U ((bf16*)(F.ws + WS_U))

        if (IN(pb + PO_NORM1) && !((KARGS()->skip >> PO_NORM1) & 1)) { PHASE_BEGIN(); p_norm<0, (l != 0)>(F, XIN, INP(2) + l * D, MOD, MOD + D, H, nullptr); }
        SEAM(pb + PO_NORM1);

        if (IN(pb + PO_ZG) && !((KARGS()->skip >> PO_ZG) & 1)) { PHASE_BEGIN();
            pg8::Gemm g{H, (const bf16*)(WB + W_IN), M, ZLD, D, D}; pg8::StaticOrder S; S.init(M, ZLD, F.G, F.bx);
            pg8::EpiBf16<0> E{Z, ZLD, nullptr, 0, 0, 1.f};
            pg8::gemm_phase<pg8::EpiBf16<0>, pg8::StaticOrder, true, true>(F.lds, g, S, E, F.tid);
        }
        SEAM(pb + PO_ZG);

        if (IN(pb + PO_PREP) && !((KARGS()->skip >> PO_PREP) & 1)) { PHASE_BEGIN(); p_prep(F, l); }
        SEAM(pb + PO_PREP);

        if (IN(pb + PO_UP) && !((KARGS()->skip >> PO_UP) & 1)) { PHASE_BEGIN();
            { pg8::Gemm g{Z + ZB_CQ, (const bf16*)(WB + W_UQ), M, 512, 256, ZLD}; pg8::StaticOrder S; S.init(M, 512, F.G, F.bx);
              pg8::EpiBf16<0> E{(bf16*)(F.ws + WS_QM), 512, nullptr, 0, 0, 1.f};
              pg8::gemm_phase<pg8::EpiBf16<0>, pg8::StaticOrder, true, true>(F.lds, g, S, E, F.tid); }
            PHASE_BEGIN();
            { pg8::Gemm g{Z + ZB_CKV, (const bf16*)(WB + W_UKV), M, 512, 256, ZLD}; pg8::StaticOrder S; S.init(M, 512, F.G, F.bx);
              pg8::EpiMlaKV E{(bf16*)(F.ws + WS_KM), (bf16*)(F.ws + WS_VM), (const float*)(F.ws + WS_RSKV)};
              pg8::gemm_phase<pg8::EpiMlaKV, pg8::StaticOrder, true, false>(F.lds, g, S, E, F.tid); }
            PHASE_BEGIN();
            p_compress(F, l);
        }
        SEAM(pb + PO_UP);

        if (IN(pb + PO_ATTN) && !((KARGS()->skip >> PO_ATTN) & 1)) { PHASE_BEGIN(); p_attn(F, INP(8) + l * 4, (ap->skip >> 16) | ((ap->rep >> 20) << 8)); }
        SEAM(pb + PO_ATTN);

        if (IN(pb + PO_OG) && !((KARGS()->skip >> PO_OG) & 1)) { PHASE_BEGIN();
            pg8::Gemm g{OB, (const bf16*)(WB + W_OUT), M, D, D, D}; pg8::StaticOrder S; S.init(M, D, F.G, F.bx);
            pg8::EpiResid<(l != 0)> E{XIN, XB, MOD + 2 * D};
            pg8::gemm_phase<pg8::EpiResid<(l != 0)>, pg8::StaticOrder, true, true>(F.lds, g, S, E, F.tid);
        }
        SEAM(pb + PO_OG);

        if (IN(pb + PO_NORM2) && !((KARGS()->skip >> PO_NORM2) & 1)) { PHASE_BEGIN(); p_norm<0, true>(F, XB, INP(3) + l * D, MOD + 3 * D, MOD + 4 * D, H, nullptr); }
        SEAM(pb + PO_NORM2);

        if (IN(pb + PO_UPG) && !((KARGS()->skip >> PO_UPG) & 1)) { PHASE_BEGIN();
            pg8::Gemm g{H, (const bf16*)(WB + W_UP), M, DFF, D, D}; pg8::StaticOrder S; S.init(M, DFF, F.G, F.bx);
            pg8::EpiRelu2 E{U, DFF};
            pg8::gemm_phase<pg8::EpiRelu2, pg8::StaticOrder, true, true>(F.lds, g, S, E, F.tid);
        }
        SEAM(pb + PO_UPG);

        if (IN(pb + PO_DNG) && !((KARGS()->skip >> PO_DNG) & 1)) { PHASE_BEGIN();
            pg8::Gemm g{U, (const bf16*)(WB + W_DN), M, D, DFF, DFF}; pg8::StaticOrder S; S.init(M, D, F.G, F.bx);
            pg8::EpiResid<true> E{XB, XB, MOD + 5 * D};
            pg8::gemm_phase<pg8::EpiResid<true>, pg8::StaticOrder, true, true>(F.lds, g, S, E, F.tid);
        }
        SEAM(pb + PO_DNG);
    }
    { constexpr int l = 1;
        const int pb = PH_L0 + PH_PER_L * l;
#define WB (F.ws + WS_W + (size_t)l * WS_WL)
#define MOD ((const float*)(F.ws + WS_MOD) + (size_t)l * NB * 6 * D)
#define XB ((bf16*)(F.ws + WS_XB))
#define XIN ((l == 0) ? (const void*)INP(0) : (const void*)XB)
#define H ((bf16*)(F.ws + WS_H))
#define Z ((bf16*)(F.ws + WS_Z))
#define OB ((bf16*)(F.ws + WS_O))
#define U ((bf16*)(F.ws + WS_U))

        if (IN(pb + PO_NORM1) && !((KARGS()->skip >> PO_NORM1) & 1)) { PHASE_BEGIN(); p_norm<0, (l != 0)>(F, XIN, INP(2) + l * D, MOD, MOD + D, H, nullptr); }
        SEAM(pb + PO_NORM1);

        if (IN(pb + PO_ZG) && !((KARGS()->skip >> PO_ZG) & 1)) { PHASE_BEGIN();
            pg8::Gemm g{H, (const bf16*)(WB + W_IN), M, ZLD, D, D}; pg8::StaticOrder S; S.init(M, ZLD, F.G, F.bx);
            pg8::EpiBf16<0> E{Z, ZLD, nullptr, 0, 0, 1.f};
            pg8::gemm_phase<pg8::EpiBf16<0>, pg8::StaticOrder, true, true>(F.lds, g, S, E, F.tid);
        }
        SEAM(pb + PO_ZG);

        if (IN(pb + PO_PREP) && !((KARGS()->skip >> PO_PREP) & 1)) { PHASE_BEGIN(); p_prep(F, l); }
        SEAM(pb + PO_PREP);

        if (IN(pb + PO_UP) && !((KARGS()->skip >> PO_UP) & 1)) { PHASE_BEGIN();
            { pg8::Gemm g{Z + ZB_CQ, (const bf16*)(WB + W_UQ), M, 512, 256, ZLD}; pg8::StaticOrder S; S.init(M, 512, F.G, F.bx);
              pg8::EpiBf16<0> E{(bf16*)(F.ws + WS_QM), 512, nullptr, 0, 0, 1.f};
              pg8::gemm_phase<pg8::EpiBf16<0>, pg8::StaticOrder, true, true>(F.lds, g, S, E, F.tid); }
            PHASE_BEGIN();
            { pg8::Gemm g{Z + ZB_CKV, (const bf16*)(WB + W_UKV), M, 512, 256, ZLD}; pg8::StaticOrder S; S.init(M, 512, F.G, F.bx);
              pg8::EpiMlaKV E{(bf16*)(F.ws + WS_KM), (bf16*)(F.ws + WS_VM), (const float*)(F.ws + WS_RSKV)};
              pg8::gemm_phase<pg8::EpiMlaKV, pg8::StaticOrder, true, false>(F.lds, g, S, E, F.tid); }
            PHASE_BEGIN();
            p_compress(F, l);
        }
        SEAM(pb + PO_UP);

        if (IN(pb + PO_ATTN) && !((KARGS()->skip >> PO_ATTN) & 1)) { PHASE_BEGIN(); p_attn(F, INP(8) + l * 4, (ap->skip >> 16) | ((ap->rep >> 20) << 8)); }
        SEAM(pb + PO_ATTN);

        if (IN(pb + PO_OG) && !((KARGS()->skip >> PO_OG) & 1)) { PHASE_BEGIN();
            pg8::Gemm g{OB, (const bf16*)(WB + W_OUT), M, D, D, D}; pg8::StaticOrder S; S.init(M, D, F.G, F.bx);
            pg8::EpiResid<(l != 0)> E{XIN, XB, MOD + 2 * D};
            pg8::gemm_phase<pg8::EpiResid<(l != 0)>, pg8::StaticOrder, true, true>(F.lds, g, S, E, F.tid);
        }
        SEAM(pb + PO_OG);

        if (IN(pb + PO_NORM2) && !((KARGS()->skip >> PO_NORM2) & 1)) { PHASE_BEGIN(); p_norm<0, true>(F, XB, INP(3) + l * D, MOD + 3 * D, MOD + 4 * D, H, nullptr); }
        SEAM(pb + PO_NORM2);

        if (IN(pb + PO_UPG) && !((KARGS()->skip >> PO_UPG) & 1)) { PHASE_BEGIN();
            pg8::Gemm g{H, (const bf16*)(WB + W_UP), M, DFF, D, D}; pg8::StaticOrder S; S.init(M, DFF, F.G, F.bx);
            pg8::EpiRelu2 E{U, DFF};
            pg8::gemm_phase<pg8::EpiRelu2, pg8::StaticOrder, true, true>(F.lds, g, S, E, F.tid);
        }
        SEAM(pb + PO_UPG);

        if (IN(pb + PO_DNG) && !((KARGS()->skip >> PO_DNG) & 1)) { PHASE_BEGIN();
            pg8::Gemm g{U, (const bf16*)(WB + W_DN), M, D, DFF, DFF}; pg8::StaticOrder S; S.init(M, D, F.G, F.bx);
            pg8::EpiResid<true> E{XB, XB, MOD + 5 * D};
            pg8::gemm_phase<pg8::EpiResid<true>, pg8::StaticOrder, true, true>(F.lds, g, S, E, F.tid);
        }
        SEAM(pb + PO_DNG);
    }
    if (IN(PH_FIN)) { PHASE_BEGIN(); p_norm<1, true>(F, (const void*)(F.ws + WS_XB), INP(21), nullptr, nullptr, nullptr, fo); }
#undef IN
#undef SEAM
}
}
extern "C" void kernel_launch(void* const* d_in, const int* in_sizes, int n_in, void* d_out, int out_size, void* d_ws, size_t ws_size, hipStream_t stream) {
    using namespace mk;
    static int grid = 0;
    if (grid == 0) {
        int dev = 0, cus = 0;
        if (hipGetDevice(&dev) != hipSuccess || hipDeviceGetAttribute(&cus, hipDeviceAttributeMultiprocessorCount, dev) != hipSuccess) { grid = -1; return; }
        if (hipFuncSetAttribute((const void*)mega, hipFuncAttributeMaxDynamicSharedMemorySize, LDS_BYTES) != hipSuccess) { grid = -1; return; }
        (void)hipGetLastError();
        grid = cus;
    }
    if (grid < 0) return;
    (void)in_sizes; (void)n_in; (void)out_size; (void)ws_size;
    Args a{};
    for (int i = 0; i < 22; ++i) a.in[i] = (const float*)d_in[i];
    a.out = (float*)d_out; a.ws = (unsigned char*)d_ws; a.skip = 0; a.rep = MK_REP;
    auto launch = [&](int lo, int hi) {
        (void)hipMemsetAsync((char*)d_ws + WS_CTL, 0, CTL_ZERO_BYTES, stream);
        a.ph_lo = lo; a.ph_hi = hi;
        hipLaunchKernelGGL(mega, dim3(grid), dim3(NTHR), LDS_BYTES, stream, a);
    };
    launch(0, PH_END);
}
```
